# Optimizing an MI355X kernel written in HIP

```python
import jax, jax.numpy as jnp
from jax import lax

D_MODEL = 1024
BATCH = 4
SEQ = 8192
DEPTH = 2

GRID_W = 64
CTX_LEN = 256
HEAD_DIM = 64
N_NA_HEADS = 8
NA_WIDTH = N_NA_HEADS * HEAD_DIM
N_FOURIER_GROUPS = 4
FOURIER_WIDTH = D_MODEL // 4
FOURIER_GROUP = FOURIER_WIDTH // N_FOURIER_GROUPS
CONV_WIDTH = D_MODEL // 4
CONV_K = 3
WIN_ROWS = 8
WIN_COLS = 16
MLP_HIDDEN = 4 * D_MODEL
N_BRANCHES = 3
N_MOD = 6
SPLIT_SIZES = (FOURIER_WIDTH, CONV_WIDTH, CONV_WIDTH, CONV_WIDTH, NA_WIDTH, NA_WIDTH, NA_WIDTH, D_MODEL, D_MODEL, D_MODEL)
IN_WIDTH = FOURIER_WIDTH + 3 * CONV_WIDTH + 3 * NA_WIDTH + N_BRANCHES * D_MODEL
KV_START = FOURIER_WIDTH + 3 * CONV_WIDTH + NA_WIDTH
KV_END = KV_START + 2 * NA_WIDTH
EPS = 1e-6
NEG = -1e30

kernel_name = "hybrid_fourier_conv_natten_dit_block"


def rmsnorm(x, g):
    xf = x.astype(jnp.float32)
    y = xf * lax.rsqrt(jnp.mean(xf * xf, axis=-1, keepdims=True) + EPS)
    return (y * g.astype(jnp.float32)).astype(x.dtype)


def modulate(h, shift, scale):
    return h * (1 + scale) + shift


def split_proj(p):
    parts, off = [], 0
    for s in SPLIT_SIZES:
        parts.append(p[..., off:off + s])
        off += s
    return parts


def to_heads(t):
    return t.reshape(t.shape[0], t.shape[1], N_NA_HEADS, HEAD_DIM)


def fourier_mix(u):
    b, n, _ = u.shape
    uf = u.astype(jnp.float32).reshape(b, n, N_FOURIER_GROUPS, FOURIER_GROUP)
    y = jnp.fft.fftn(uf, axes=(1, 3), norm="ortho").real
    return y.reshape(b, n, FOURIER_WIDTH).astype(u.dtype)


def short_conv(u, gate_b, gate_c, w):
    z = gate_c * u
    y = lax.conv_general_dilated(
        z, w[:, None, :].astype(z.dtype), window_strides=(1,),
        padding=((CONV_K // 2, CONV_K // 2),),
        dimension_numbers=("NWC", "WIO", "NWC"), feature_group_count=CONV_WIDTH)
    return gate_b * y


def neighbourhood_attention(q, k, v, k_ctx, v_ctx, rel_bias):
    b, n, _ = q.shape
    rows = n // GRID_W
    kr = min(WIN_ROWS, rows)
    kc = WIN_COLS
    grid = (b, rows, GRID_W, N_NA_HEADS, HEAD_DIM)
    q, k, v = q.reshape(grid), k.reshape(grid), v.reshape(grid)
    r = jnp.arange(rows)
    row_start = jnp.clip(r - kr // 2, 0, rows - kr)
    row_idx = row_start[:, None] + jnp.arange(kr)[None, :]
    k_rows = k[:, row_idx]
    v_rows = v[:, row_idx]
    cols = jnp.arange(GRID_W)
    col_start = jnp.clip(cols - kc // 2, 0, GRID_W - kc)
    col_in = (cols[None, :] >= col_start[:, None]) & (cols[None, :] < col_start[:, None] + kc)
    dr = row_idx - r[:, None] + (WIN_ROWS - 1)
    dc = jnp.clip(cols[None, :] - cols[:, None], -(WIN_COLS - 1), WIN_COLS - 1) + (WIN_COLS - 1)
    bias = rel_bias[:, dr[:, None, :, None], dc[None, :, None, :]].astype(jnp.float32)
    scale = HEAD_DIM ** -0.5
    s_win = jnp.einsum('brqhd,brikhd->bhrqik', q, k_rows).astype(jnp.float32) * scale + bias
    s_win = jnp.where(col_in[None, None, None, :, None, :], s_win, NEG)
    s_ctx = jnp.einsum('brqhd,bjhd->bhrqj', q, k_ctx).astype(jnp.float32) * scale
    n_win = kr * GRID_W
    logits = jnp.concatenate([s_win.reshape(b, N_NA_HEADS, rows, GRID_W, n_win), s_ctx], axis=-1)
    p = jax.nn.softmax(logits, axis=-1).astype(v.dtype)
    p_win = p[..., :n_win].reshape(s_win.shape)
    p_ctx = p[..., n_win:]
    out = (jnp.einsum('bhrqik,brikhd->brqhd', p_win, v_rows)
           + jnp.einsum('bhrqj,bjhd->brqhd', p_ctx, v_ctx))
    return out.reshape(b, n, NA_WIDTH)


def context_attention(q, k, v):
    b, l = q.shape[0], q.shape[1]
    s = jnp.einsum('blhd,bmhd->bhlm', q, k).astype(jnp.float32) * (HEAD_DIM ** -0.5)
    p = jax.nn.softmax(s, axis=-1).astype(v.dtype)
    return jnp.einsum('bhlm,bmhd->blhd', p, v).reshape(b, l, NA_WIDTH)


def merge_branches(f, cv, at, g_f, g_c, g_a, w_f, w_c, w_a, w_o):
    m = (jax.nn.sigmoid(g_f) * (f @ w_f) + jax.nn.sigmoid(g_c) * (cv @ w_c)
         + jax.nn.sigmoid(g_a) * (at @ w_a))
    return m @ w_o


def sq_relu_mlp(h, w1, w2):
    a = jax.nn.relu(h @ w1)
    return (a * a) @ w2


def setup_inputs(seed: int = 0) -> dict:
    key = jax.random.key(seed)
    ks = jax.random.split(key, 20)
    nrm = lambda k, shape, s: jax.random.normal(k, shape, jnp.float32) * s
    return {
        "x": nrm(ks[0], (BATCH, SEQ, D_MODEL), 1.0),
        "c": nrm(ks[1], (BATCH, D_MODEL), 1.0),
        "ctx": nrm(ks[2], (BATCH, CTX_LEN, D_MODEL), 1.0),
        "c_ctx": nrm(ks[3], (D_MODEL,), 1.0),
        "ada_w": nrm(ks[4], (DEPTH, D_MODEL, N_MOD * D_MODEL), 0.5 * D_MODEL ** -0.5),
        "ada_b": nrm(ks[5], (DEPTH, N_MOD * D_MODEL), 0.02),
        "norm1_g": 1.0 + nrm(ks[6], (DEPTH, D_MODEL), 0.02),
        "norm2_g": 1.0 + nrm(ks[7], (DEPTH, D_MODEL), 0.02),
        "w_in": nrm(ks[8], (DEPTH, D_MODEL, IN_WIDTH), D_MODEL ** -0.5),
        "conv_w": nrm(ks[9], (DEPTH, CONV_K, CONV_WIDTH), CONV_K ** -0.5),
        "rel_bias": nrm(ks[10], (DEPTH, N_NA_HEADS, 2 * WIN_ROWS - 1, 2 * WIN_COLS - 1), 0.1),
        "w_fourier": nrm(ks[11], (DEPTH, FOURIER_WIDTH, D_MODEL), FOURIER_WIDTH ** -0.5),
        "w_conv": nrm(ks[12], (DEPTH, CONV_WIDTH, D_MODEL), CONV_WIDTH ** -0.5),
        "w_attn": nrm(ks[13], (DEPTH, NA_WIDTH, D_MODEL), NA_WIDTH ** -0.5),
        "w_o": nrm(ks[14], (DEPTH, D_MODEL, D_MODEL), D_MODEL ** -0.5),
        "mlp_w1": nrm(ks[15], (DEPTH, D_MODEL, MLP_HIDDEN), D_MODEL ** -0.5),
        "mlp_w2": nrm(ks[16], (DEPTH, MLP_HIDDEN, D_MODEL), MLP_HIDDEN ** -0.5),
        "final_g": 1.0 + nrm(ks[17], (D_MODEL,), 0.02),
    }


def reference(x, c, ctx, c_ctx, ada_w, ada_b, norm1_g, norm2_g, w_in, conv_w, rel_bias,
              w_fourier, w_conv, w_attn, w_o, mlp_w1, mlp_w2, final_g):
    for l in range(DEPTH):
        last = l == DEPTH - 1
        mod = jax.nn.silu(c) @ ada_w[l] + ada_b[l]
        sh1, sc1, g1, sh2, sc2, g2 = [m[:, None, :] for m in jnp.split(mod, N_MOD, axis=-1)]
        mod_c = jax.nn.silu(c_ctx) @ ada_w[l] + ada_b[l]
        csh1, csc1, cg1, csh2, csc2, cg2 = jnp.split(mod_c, N_MOD, axis=-1)

        hc = modulate(rmsnorm(ctx, norm1_g[l]), csh1, csc1)
        if last:
            kv_c = hc @ w_in[l][:, KV_START:KV_END]
            k_c, v_c = to_heads(kv_c[..., :NA_WIDTH]), to_heads(kv_c[..., NA_WIDTH:])
        else:
            pc = split_proj(hc @ w_in[l])
            k_c, v_c = to_heads(pc[5]), to_heads(pc[6])

        hx = modulate(rmsnorm(x, norm1_g[l]), sh1, sc1)
        px = split_proj(hx @ w_in[l])
        f_x = fourier_mix(px[0])
        cv_x = short_conv(px[1], px[2], px[3], conv_w[l])
        at_x = neighbourhood_attention(px[4], px[5], px[6], k_c, v_c, rel_bias[l])
        x = x + g1 * merge_branches(f_x, cv_x, at_x, px[7], px[8], px[9],
                                    w_fourier[l], w_conv[l], w_attn[l], w_o[l])

        if not last:
            f_c = fourier_mix(pc[0])
            cv_c = short_conv(pc[1], pc[2], pc[3], conv_w[l])
            at_c = context_attention(to_heads(pc[4]), k_c, v_c)
            ctx = ctx + cg1 * merge_branches(f_c, cv_c, at_c, pc[7], pc[8], pc[9],
                                             w_fourier[l], w_conv[l], w_attn[l], w_o[l])

        x = x + g2 * sq_relu_mlp(modulate(rmsnorm(x, norm2_g[l]), sh2, sc2), mlp_w1[l], mlp_w2[l])
        if not last:
            ctx = ctx + cg2 * sq_relu_mlp(modulate(rmsnorm(ctx, norm2_g[l]), csh2, csc2),
                                          mlp_w1[l], mlp_w2[l])
    return rmsnorm(x, final_g)
```

```cpp
#include <hip/hip_runtime.h>
#include <cstdio>
#include <cstdint>

#ifndef MK_MULTI
#define MK_MULTI 0
#endif

namespace pg8 {
#define PG8_LAS __attribute__((address_space(3)))
typedef unsigned short bf16_t;
typedef short bf16x8 __attribute__((ext_vector_type(8)));
typedef float f32x4 __attribute__((ext_vector_type(4)));
typedef unsigned u32x4 __attribute__((ext_vector_type(4)));
constexpr int BM = 256, BK = 64, HALF = 128, HTB = HALF * BK * 2, STAGE_BYTES = 8 * HTB, NXCD = 8, WGM = 8;

__host__ __device__ __forceinline__ int lds_byte(int r, int c) { const int st = (r >> 4) * 2 + (c >> 5), rr = r & 15, cc = c & 31, ob = rr * 64 + cc * 2; return st * 1024 + (ob ^ (((ob >> 9) & 1) << 5)); }
__host__ __device__ __forceinline__ void stage_rc(int b, int& R, int& C) { const int st = b / 1024, sb = b % 1024, swz = sb ^ (((sb >> 9) & 1) << 5); R = (st >> 1) * 16 + swz / 64; C = (st & 1) * 32 + (swz % 64) / 2; }
__host__ __device__ __forceinline__ int perm32(int rho) { const int n = rho >> 4, i = rho & 15; return 8 * (i >> 2) + 4 * n + (i & 3); }

struct Unit { int pm, pn, br; };

template <int REP> struct StaticOrder {
    int nM, nN, nwg, G, c;
    __device__ void init(int M, int N, int G_, int c_) { nM = M / BM; nN = N / BM; nwg = nM * nN; G = G_; c = c_; }
    __device__ __forceinline__ bool next(int i, Unit& u) const {
        const int it = i / REP; u.br = i - it * REP;
        const long L = (long)it * G + c; if (L >= nwg) return false;
        int wgid = (int)L; { const int q = nwg / NXCD, r = nwg % NXCD, xcd = wgid % NXCD, off = wgid / NXCD; wgid = (xcd < r ? xcd * (q + 1) : r * (q + 1) + (xcd - r) * q) + off; }
        const int nig = WGM * nN, gid = wgid / nig, fm = gid * WGM, gsz = (nM - fm) < WGM ? (nM - fm) : WGM;
        u.pm = fm + ((wgid % nig) % gsz); u.pn = (wgid % nig) / gsz; return true;
    }
};

template <bool MERGE> struct Prob {
    const bf16_t* A; const bf16_t* Bt; int lda, ldb, K;
    __device__ __forceinline__ int nt(const Unit& u) const { if (MERGE) return u.br == 2 ? 8 : 4; return K / BK; }
    __device__ __forceinline__ int koff(const Unit& u) const { if (MERGE) return u.br * 256; return 0; }
    __device__ __forceinline__ const char* a(const Unit& u) const { return (const char*)(A + (size_t)u.pm * BM * lda + koff(u)); }
    __device__ __forceinline__ const char* b(const Unit& u) const { return (const char*)(Bt + (size_t)u.pn * BM * ldb + koff(u)); }
};

__device__ __forceinline__ unsigned cvt_pk_bf16(float lo, float hi) { unsigned r; asm volatile("v_cvt_pk_bf16_f32 %0, %1, %2" : "=v"(r) : "v"(lo), "v"(hi)); return r; }

template <class Epi, class Sched, class PROB>
__device__ __forceinline__ void gemm_phase(PG8_LAS unsigned char* lds, const PROB P, const Sched& S, const Epi& E) {
    int tid = threadIdx.x; asm volatile("" : "+v"(tid));
    const int wid = __builtin_amdgcn_readfirstlane(tid >> 6), lane = tid & 63, wr = wid >> 2, wc = wid & 3, fr = lane & 15, fq = lane >> 4;
    unsigned voffA[2], voffB[2];
#pragma unroll
    for (int i = 0; i < 2; ++i) { int R, C; stage_rc(tid * 16 + i * 8192, R, C); const int Rb = Epi::PERM ? ((R & ~31) + perm32(R & 31)) : R;
        voffA[i] = (unsigned)(R * P.lda + C) * 2u; voffB[i] = (unsigned)(Rb * P.ldb + C) * 2u; }
    const size_t kstep = (size_t)(BK * 2);
    const size_t hstepA = (size_t)HALF * P.lda * 2, hstepB = (size_t)HALF * P.ldb * 2;
    const unsigned ldsw = (unsigned)wid * 1024u;
    const int aoff = lds_byte(wr * 64 + fr, fq * 8), boff = lds_byte(wc * 32 + fr, fq * 8);
#define PG8_SA(b, h) (((b) * 2 + (h)) * HTB)
#define PG8_SB(b, h) ((4 + (b) * 2 + (h)) * HTB)
#define PG8_STAGE(bufoff, gbase, voff) do { _Pragma("unroll") for (int _i = 0; _i < 2; ++_i) \
        __builtin_amdgcn_global_load_lds((const unsigned*)((const char*)(gbase) + (voff)[_i]), (PG8_LAS unsigned*)(lds + (bufoff) + ldsw + _i * 8192), 16, 0, 0); } while (0)
#define PG8_LDA(dst, b, h) do { _Pragma("unroll") for (int m = 0; m < 4; ++m) _Pragma("unroll") for (int k = 0; k < 2; ++k) dst[m][k] = *(const PG8_LAS bf16x8*)(lds + PG8_SA(b, h) + aoff + m * 2048 + k * 1024); } while (0)
#define PG8_LDB(dst, b, h) do { _Pragma("unroll") for (int n = 0; n < 2; ++n) _Pragma("unroll") for (int k = 0; k < 2; ++k) dst[n][k] = *(const PG8_LAS bf16x8*)(lds + PG8_SB(b, h) + boff + n * 2048 + k * 1024); } while (0)
#define PG8_MMA(ai, bj, At, Bt) do { __builtin_amdgcn_s_setprio(1); _Pragma("unroll") for (int m = 0; m < 4; ++m) _Pragma("unroll") for (int n = 0; n < 2; ++n) _Pragma("unroll") for (int k = 0; k < 2; ++k) \
        acc[ai][bj][m][n] = __builtin_amdgcn_mfma_f32_16x16x32_bf16(Bt[n][k], At[m][k], acc[ai][bj][m][n], 0, 0, 0); __builtin_amdgcn_s_setprio(0); } while (0)
#define PG8_WAIT_V(n) asm volatile("s_waitcnt vmcnt(" #n ")" ::: "memory")
#define PG8_WAIT_L(n) asm volatile("s_waitcnt lgkmcnt(" #n ")" ::: "memory")
#define PG8_BAR __builtin_amdgcn_s_barrier()
#define PG8_SCHED __builtin_amdgcn_sched_barrier(0)
    Unit cur, nxt; int ui = 0;
    if (!S.next(0, cur)) return;
    f32x4 acc[2][2][4][2];
#pragma unroll
    for (int a = 0; a < 2; ++a)
#pragma unroll
        for (int b = 0; b < 2; ++b)
#pragma unroll
            for (int m = 0; m < 4; ++m)
#pragma unroll
                for (int n = 0; n < 2; ++n) acc[a][b][m][n] = (f32x4){0.f, 0.f, 0.f, 0.f};
    bf16x8 At[4][2], B0[2][2], B1[2][2];
    const char* cA = P.a(cur); const char* cB = P.b(cur);
    PG8_STAGE(PG8_SB(0, 0), cB, voffB); PG8_STAGE(PG8_SB(0, 1), cB + hstepB, voffB); PG8_STAGE(PG8_SA(0, 0), cA, voffA); PG8_STAGE(PG8_SA(0, 1), cA + hstepA, voffA);
    if (wr == 1) PG8_BAR;
    PG8_WAIT_V(2); PG8_BAR;
    PG8_STAGE(PG8_SB(1, 0), cB + kstep, voffB); PG8_STAGE(PG8_SA(1, 0), cA + kstep, voffA); PG8_STAGE(PG8_SB(1, 1), cB + hstepB + kstep, voffB);
    PG8_WAIT_V(6); PG8_BAR;
    for (;;) {
        const bool has_next = S.next(ui + 1, nxt);
        const char* nA = has_next ? P.a(nxt) : cA; const char* nB = has_next ? P.b(nxt) : cB;
        const int nt = P.nt(cur);
        for (int t = 0; t < nt; t += 2) {
            const bool last = (t == nt - 2);
            const char* a1 = cA + (size_t)(t + 1) * kstep;
            const char* a2 = last ? nA : cA + (size_t)(t + 2) * kstep; const char* b2 = last ? nB : cB + (size_t)(t + 2) * kstep;
            const char* a3 = a2 + kstep; const char* b3 = b2 + kstep;
            PG8_LDB(B0, 0, 0); PG8_LDB(B1, 0, 1); PG8_SCHED; PG8_LDA(At, 0, 0); PG8_STAGE(PG8_SA(1, 1), a1 + hstepA, voffA);
            PG8_WAIT_V(8); PG8_WAIT_L(0); PG8_BAR; PG8_MMA(0, 0, At, B0); PG8_MMA(0, 1, At, B1); PG8_BAR; PG8_SCHED;
            PG8_LDA(At, 0, 1); PG8_STAGE(PG8_SB(0, 0), b2, voffB); PG8_STAGE(PG8_SB(0, 1), b2 + hstepB, voffB); PG8_STAGE(PG8_SA(0, 0), a2, voffA);
            PG8_WAIT_V(8); PG8_WAIT_L(0); PG8_BAR; PG8_MMA(1, 0, At, B0); PG8_MMA(1, 1, At, B1); PG8_BAR; PG8_SCHED;
            PG8_LDB(B0, 1, 0); PG8_LDB(B1, 1, 1); PG8_SCHED; PG8_LDA(At, 1, 0); PG8_STAGE(PG8_SA(0, 1), a2 + hstepA, voffA);
            PG8_WAIT_V(8); PG8_WAIT_L(0); PG8_BAR; PG8_MMA(0, 0, At, B0); PG8_MMA(0, 1, At, B1); PG8_BAR; PG8_SCHED;
            PG8_LDA(At, 1, 1); PG8_STAGE(PG8_SB(1, 0), b3, voffB); PG8_STAGE(PG8_SB(1, 1), b3 + hstepB, voffB); PG8_STAGE(PG8_SA(1, 0), a3, voffA);
            PG8_WAIT_V(8); PG8_WAIT_L(0); PG8_BAR; PG8_MMA(1, 0, At, B0); PG8_MMA(1, 1, At, B1); PG8_BAR; PG8_SCHED;
        }
        if (wr == 0) PG8_BAR;
        E(acc, cur, wr, wc, fr, fq);
        if (!has_next) break;
#pragma unroll
        for (int a = 0; a < 2; ++a)
#pragma unroll
            for (int b = 0; b < 2; ++b)
#pragma unroll
                for (int m = 0; m < 4; ++m)
#pragma unroll
                    for (int n = 0; n < 2; ++n) acc[a][b][m][n] = (f32x4){0.f, 0.f, 0.f, 0.f};
        cur = nxt; cA = nA; cB = nB; ++ui;
        if (wr == 1) PG8_BAR;
    }
    PG8_WAIT_V(0);
    PG8_BAR;
#undef PG8_SA
#undef PG8_SB
#undef PG8_STAGE
#undef PG8_LDA
#undef PG8_LDB
#undef PG8_MMA
#undef PG8_WAIT_V
#undef PG8_WAIT_L
#undef PG8_BAR
#undef PG8_SCHED
}
}

constexpr int NWAVES = 8, NTHR = 512;
constexpr int DM = 1024, NB = 4, SEQ = 8192, ML = NB * SEQ, CTXL = 256, MC = NB * CTXL, MT = ML + MC;
constexpr int NIN_ORIG = 5632, NPXA = 2816, NPXG = 3072, NIN = NPXA + NPXG;
constexpr int OFF_P = 0, OFF_Q = 256, OFF_CU = 512, OFF_CB = 768, OFF_CC = 1024, OFF_QQ = 1280, OFF_K = 1792, OFF_V = 2304;
constexpr int FF = 4096, NMOD = 6 * DM, NGRP = 5;
constexpr float EPS = 1e-6f;

constexpr size_t MiB = 1u << 20;
constexpr size_t WS_CTL = 0, CTL_ZERO_BYTES = 1 * MiB;
constexpr size_t WS_TW = 1 * MiB;
constexpr size_t WS_MOD = 1 * MiB + 65536;
constexpr size_t WS_MODP = 2 * MiB;
constexpr size_t WS_CTXX = 4 * MiB;
constexpr size_t WS_WIN = 8 * MiB, WS_WM = 20 * MiB, WS_WO = 22 * MiB, WS_W1 = 24 * MiB, WS_W2 = 32 * MiB;
constexpr size_t WS_HX = 40 * MiB;
constexpr size_t WS_PXA = 106 * MiB;
constexpr size_t WS_PXG = 288 * MiB;
constexpr size_t WS_TB = 486 * MiB;
constexpr size_t WS_M = WS_PXA;
constexpr size_t WS_ACT = WS_PXA;
constexpr size_t WS_END = 502 * MiB;
static_assert(WS_PXA + (size_t)MT * NPXA * 2 <= WS_PXG && WS_PXG + (size_t)MT * NPXG * 2 <= WS_TB && WS_ACT + (size_t)MT * FF * 2 <= WS_TB && WS_HX + (size_t)MT * DM * 2 <= WS_PXA, "ws map");
constexpr int CW_TMO = 0, CW_BAR = 4096;

constexpr int RING_BYTES = 131072, LDSCTL_OFF = RING_BYTES, MISC_OFF = LDSCTL_OFF + 320, LDS_BYTES = 147456;

#define GAS __attribute__((address_space(1)))
#define LAS __attribute__((address_space(3)))
typedef unsigned short bf16;
typedef unsigned v4u __attribute__((ext_vector_type(4)));
typedef unsigned v2u __attribute__((ext_vector_type(2)));
typedef float f32x4 __attribute__((ext_vector_type(4)));
typedef GAS unsigned gu32;
#define RLX_AGENT __ATOMIC_RELAXED, __HIP_MEMORY_SCOPE_AGENT
#define LDS_WAIT() asm volatile("s_waitcnt lgkmcnt(0)" ::: "memory")
__device__ __forceinline__ unsigned f2bf(float f) { unsigned u = __builtin_bit_cast(unsigned, f); return (u + 0x7fffu + ((u >> 16) & 1u)) >> 16; }
__device__ __forceinline__ unsigned pk2(float lo, float hi) { return f2bf(lo) | (f2bf(hi) << 16); }
__device__ __forceinline__ float bf2f(unsigned h) { return __uint_as_float(h << 16); }
__device__ __forceinline__ float bflo(unsigned w) { return __uint_as_float(w << 16); }
__device__ __forceinline__ float bfhi(unsigned w) { return __uint_as_float(w & 0xffff0000u); }

#define XB_TMO      128
#define XB_XCNT(j)  (256  + 64 * (j))
#define XB_XSUB(j)  (1280 + 64 * (j))
#define XB_XGEN(j)  (2304 + 64 * (j))
#define XB_TOP      3328
#define XB_TOPGEN   3392
#define XCD_BAR_WORDS 3456
#define XB_SPIN_CAP (1u << 22)
__device__ __forceinline__ unsigned xb_ld(unsigned* p)              { return __hip_atomic_load(p, __ATOMIC_RELAXED, __HIP_MEMORY_SCOPE_AGENT); }
__device__ __forceinline__ unsigned xb_add(unsigned* p, unsigned v) { return __hip_atomic_fetch_add(p, v, __ATOMIC_RELAXED, __HIP_MEMORY_SCOPE_AGENT); }
__device__ __forceinline__ unsigned xb_xcc_id() { return (unsigned)__builtin_amdgcn_s_getreg((3 << 11) | 20) & 0xFu; }
#define XB_SPIN(cond, bar) do { unsigned _sp = 0; while (cond) { __builtin_amdgcn_s_sleep(1); \
    if ((++_sp & 255u) == 0u) { if (xb_ld(&(bar)[XB_TMO])) break; if (_sp > XB_SPIN_CAP) { atomicAdd(&(bar)[XB_TMO], 1u); break; } } } } while (0)
struct XcdBarrier { unsigned* bar; unsigned x; volatile LAS unsigned* st; };
__device__ __forceinline__ XcdBarrier xcd_barrier_post(unsigned* bar, volatile LAS unsigned* st) {
    XcdBarrier b; b.bar = bar; b.x = xb_xcc_id(); b.st = st;
    if (threadIdx.x == 0) (void)xb_add(&bar[XB_XCNT(b.x)], 1u);
    return b;
}
__device__ __forceinline__ void xcd_barrier_complete(unsigned* bar, unsigned x, unsigned& nloc, unsigned& nx) {
    const unsigned G = gridDim.x * gridDim.y * gridDim.z;
    unsigned sum, cnt, mine, sp = 0u;
    for (;;) {
        sum = 0u; cnt = 0u; mine = 0u;
#pragma unroll
        for (unsigned j = 0; j < 16; ++j) { const unsigned c = xb_ld(&bar[XB_XCNT(j)]); sum += c; cnt += (c > 0u) ? 1u : 0u; mine = (j == x) ? c : mine; }
        if (sum == G) break;
        __builtin_amdgcn_s_sleep(1);
        if ((++sp & 255u) == 0u) { if (xb_ld(&bar[XB_TMO])) break; if (sp > XB_SPIN_CAP) { atomicAdd(&bar[XB_TMO], 1u); break; } }
    }
    nloc = mine > 0u ? mine : 1u; nx = cnt > 0u ? cnt : 1u;
}
__device__ __forceinline__ void xcd_barrier(const XcdBarrier& b) {
    asm volatile("s_waitcnt vmcnt(0)" ::: "memory");
    __syncthreads();
    if (threadIdx.x == 0) {
        unsigned* bar = b.bar;
        __builtin_amdgcn_s_waitcnt(0);
        unsigned nloc = b.st[0], nx = b.st[1];
        if (nloc == 0u) { xcd_barrier_complete(bar, b.x, nloc, nx); b.st[0] = nloc; b.st[1] = nx; }
        const unsigned old = xb_add(&bar[XB_XSUB(b.x)], 1u);
        const unsigned gen = old / nloc;
        if (old + 1u == (gen + 1u) * nloc) {
            __builtin_amdgcn_fence(__ATOMIC_RELEASE, "agent");
            asm volatile("s_waitcnt vmcnt(0)" ::: "memory");
            const unsigned og = xb_add(&bar[XB_TOP], 1u);
            const unsigned tg = og / nx;
            if (og + 1u == (tg + 1u) * nx) xb_add(&bar[XB_TOPGEN], 1u);
            else XB_SPIN(xb_ld(&bar[XB_TOPGEN]) == tg, bar);
            __builtin_amdgcn_fence(__ATOMIC_ACQUIRE, "agent");
            xb_add(&bar[XB_XGEN(b.x)], 1u);
            asm volatile("s_waitcnt vmcnt(0)" ::: "memory");
        } else {
            XB_SPIN(xb_ld(&bar[XB_XGEN(b.x)]) == gen, bar);
            __builtin_amdgcn_fence(__ATOMIC_ACQUIRE, "agent");
            asm volatile("s_waitcnt vmcnt(0)" ::: "memory");
        }
    }
    __syncthreads();
}

__device__ __forceinline__ float wave_sum(float v) {
#pragma unroll
    for (int o = 1; o < 64; o <<= 1) v += __shfl_xor(v, o);
    return v;
}
__device__ __forceinline__ float wave_max(float v) {
#pragma unroll
    for (int o = 1; o < 64; o <<= 1) v = fmaxf(v, __shfl_xor(v, o));
    return v;
}

__device__ __forceinline__ void transpose_item(const float* W, int ldw, int ncols, bf16* WT, int ldwt, int row_off, int k_off, LAS float* scr, int item, int lane) {
    const int nblk = ncols / 32, kb = item / nblk, nb = item % nblk, k0 = 64 * kb, n0 = 32 * nb;
#pragma unroll 8
    for (int i = 0; i < 32; ++i) { const int kk = 2 * i + (lane >> 5); scr[kk * 33 + (lane & 31)] = W[(size_t)(k0 + kk) * ldw + n0 + (lane & 31)]; }
    LDS_WAIT(); asm volatile("" ::: "memory");
    const int c = lane & 7;
#pragma unroll
    for (int j = 0; j < 4; ++j) { const int n = (lane >> 3) + 8 * j; const LAS float* s = scr + (8 * c) * 33 + n;
        v4u o; o.x = pk2(s[0 * 33], s[1 * 33]); o.y = pk2(s[2 * 33], s[3 * 33]); o.z = pk2(s[4 * 33], s[5 * 33]); o.w = pk2(s[6 * 33], s[7 * 33]);
        *(v4u*)(WT + (size_t)(row_off + n0 + n) * ldwt + k_off + k0 + 8 * c) = o; }
    LDS_WAIT(); asm volatile("" ::: "memory");
}

using pg8::Unit; using pg8::cvt_pk_bf16;
struct EpiIn {
    static constexpr bool PERM = true;
    bf16* pxa; bf16* pxg;
    __device__ __forceinline__ void operator()(const f32x4 (&acc)[2][2][4][2], const Unit& u, int wr, int wc, int fr, int fq) const {
        const bool gate = u.pn >= 11; bf16* base = gate ? pxg : pxa; const int ldc = gate ? NPXG : NPXA; const int colt = (gate ? u.pn - 11 : u.pn) * 256;
        const int row0 = u.pm * 256 + wr * 64 + fr, col0 = colt + wc * 32 + 8 * fq;
#pragma unroll
        for (int ai = 0; ai < 2; ++ai)
#pragma unroll
            for (int m = 0; m < 4; ++m) { bf16* rowp = base + (size_t)(row0 + ai * 128 + m * 16) * ldc + col0;
#pragma unroll
                for (int bj = 0; bj < 2; ++bj) { f32x4 v0 = acc[ai][bj][m][0], v1 = acc[ai][bj][m][1];
                    if (gate) {
#pragma unroll
                        for (int e = 0; e < 4; ++e) { v0[e] = 1.0f / (1.0f + __expf(-v0[e])); v1[e] = 1.0f / (1.0f + __expf(-v1[e])); } }
                    v4u w; w.x = cvt_pk_bf16(v0[0], v0[1]); w.y = cvt_pk_bf16(v0[2], v0[3]); w.z = cvt_pk_bf16(v1[0], v1[1]); w.w = cvt_pk_bf16(v1[2], v1[3]);
                    *(v4u*)(rowp + bj * 128) = w; } }
    }
};
struct EpiMerge {
    static constexpr bool PERM = true;
    bf16* m; const bf16* pxg;
    __device__ __forceinline__ void operator()(const f32x4 (&acc)[2][2][4][2], const Unit& u, int wr, int wc, int fr, int fq) const {
        const int row0 = u.pm * 256 + wr * 64 + fr, col0 = u.pn * 256 + wc * 32 + 8 * fq;
#pragma unroll
        for (int ai = 0; ai < 2; ++ai)
#pragma unroll
            for (int mm = 0; mm < 4; ++mm) { const size_t row = (size_t)(row0 + ai * 128 + mm * 16);
#pragma unroll
                for (int bj = 0; bj < 2; ++bj) { const f32x4 v0 = acc[ai][bj][mm][0], v1 = acc[ai][bj][mm][1];
                    const v4u g = *(const v4u*)(pxg + row * NPXG + u.br * 1024 + col0 + bj * 128);
                    bf16* mp = m + row * DM + col0 + bj * 128;
                    float o[8];
                    o[0] = v0[0] * bflo(g.x); o[1] = v0[1] * bfhi(g.x); o[2] = v0[2] * bflo(g.y); o[3] = v0[3] * bfhi(g.y);
                    o[4] = v1[0] * bflo(g.z); o[5] = v1[1] * bfhi(g.z); o[6] = v1[2] * bflo(g.w); o[7] = v1[3] * bfhi(g.w);
                    if (u.br != 0) { const v4u p = *(const v4u*)mp;
                        o[0] += bflo(p.x); o[1] += bfhi(p.x); o[2] += bflo(p.y); o[3] += bfhi(p.y); o[4] += bflo(p.z); o[5] += bfhi(p.z); o[6] += bflo(p.w); o[7] += bfhi(p.w); }
                    v4u w; w.x = cvt_pk_bf16(o[0], o[1]); w.y = cvt_pk_bf16(o[2], o[3]); w.z = cvt_pk_bf16(o[4], o[5]); w.w = cvt_pk_bf16(o[6], o[7]);
                    *(v4u*)mp = w; } }
    }
};
struct EpiRes {
    static constexpr bool PERM = false;
    const float* base_l; const float* base_c; float* out_l; float* out_c; const float* gate;
    __device__ __forceinline__ void operator()(const f32x4 (&acc)[2][2][4][2], const Unit& u, int wr, int wc, int fr, int fq) const {
        const bool isc = u.pm >= 128; const int grp = isc ? 4 : (u.pm >> 5);
        const float* base = isc ? base_c : base_l; float* out = isc ? out_c : out_l;
        const int row0 = (isc ? (u.pm - 128) : u.pm) * 256 + wr * 64 + fr, col0 = u.pn * 256 + wc * 32 + 4 * fq;
        f32x4 gv[2][2];
#pragma unroll
        for (int bj = 0; bj < 2; ++bj)
#pragma unroll
            for (int n = 0; n < 2; ++n) gv[bj][n] = *(const f32x4*)(gate + grp * NMOD + col0 + bj * 128 + n * 16);
#pragma unroll
        for (int ai = 0; ai < 2; ++ai)
#pragma unroll
            for (int m = 0; m < 4; ++m) { const size_t off = (size_t)(row0 + ai * 128 + m * 16) * DM + col0;
#pragma unroll
                for (int bj = 0; bj < 2; ++bj)
#pragma unroll
                    for (int n = 0; n < 2; ++n) { const f32x4 bs = *(const f32x4*)(base + off + bj * 128 + n * 16);
                        *(f32x4*)(out + off + bj * 128 + n * 16) = bs + gv[bj][n] * acc[ai][bj][m][n]; } }
    }
};
struct EpiAct {
    static constexpr bool PERM = true;
    bf16* a;
    __device__ __forceinline__ void operator()(const f32x4 (&acc)[2][2][4][2], const Unit& u, int wr, int wc, int fr, int fq) const {
        const int row0 = u.pm * 256 + wr * 64 + fr, col0 = u.pn * 256 + wc * 32 + 8 * fq;
#pragma unroll
        for (int ai = 0; ai < 2; ++ai)
#pragma unroll
            for (int m = 0; m < 4; ++m) { bf16* rowp = a + (size_t)(row0 + ai * 128 + m * 16) * FF + col0;
#pragma unroll
                for (int bj = 0; bj < 2; ++bj) { f32x4 v0 = acc[ai][bj][m][0], v1 = acc[ai][bj][m][1];
#pragma unroll
                    for (int e = 0; e < 4; ++e) { const float r0 = fmaxf(v0[e], 0.f), r1 = fmaxf(v1[e], 0.f); v0[e] = r0 * r0; v1[e] = r1 * r1; }
                    v4u w; w.x = cvt_pk_bf16(v0[0], v0[1]); w.y = cvt_pk_bf16(v0[2], v0[3]); w.z = cvt_pk_bf16(v1[0], v1[1]); w.w = cvt_pk_bf16(v1[2], v1[3]);
                    *(v4u*)(rowp + bj * 128) = w; } }
    }
};

constexpr int NS = 15;
constexpr int NSTEPS = 2 + 2 * NS + 1;
constexpr int LARGS_OFF = LDSCTL_OFF + 1024;
enum { A_X = 0, A_C, A_CTX, A_CCTX, A_ADAW, A_ADAB, A_N1G, A_N2G, A_WIN, A_CONVW, A_RELB, A_WF, A_WC, A_WA, A_WO, A_W1, A_W2, A_FG, A_OUT, A_WS, A_NARGS };

struct Ctx { LAS unsigned char* lds; int tid, lane, wave, G, bx, gw, NGW, gt, NGT; };
__device__ __forceinline__ unsigned long long ldarg(const Ctx& C, int i) {
    const LAS unsigned* p = (const LAS unsigned*)(C.lds + LARGS_OFF) + 2 * i;
    const unsigned lo = __builtin_amdgcn_readfirstlane(p[0]), hi = __builtin_amdgcn_readfirstlane(p[1]);
    return ((unsigned long long)hi << 32) | lo;
}
#define ARGF(i) ((const float*)(const GAS float*)ldarg(C, (i)))
#define WSP(T, off) ((T*)(GAS T*)((GAS unsigned char*)ldarg(C, A_WS) + (off)))

__device__ __forceinline__ void ph_mod_partial(const Ctx& C) {
    const float* cvec = ARGF(A_C); const float* cctx = ARGF(A_CCTX); const float* ada_w = ARGF(A_ADAW);
    float* modp = WSP(float, WS_MODP); float2* tw = WSP(float2, WS_TW);
    LAS float* sl = (LAS float*)C.lds;
    for (int item = C.bx; item < 2 * 8 * 12; item += C.G) {
        const int l = item / 96, rem = item % 96, kc = rem / 12, jb = rem % 12;
        __syncthreads();
        for (int e = C.tid; e < 5 * 128; e += NTHR) { const int g = e >> 7, k = kc * 128 + (e & 127); const float v = g < 4 ? cvec[g * DM + k] : cctx[k]; sl[e] = v / (1.0f + __expf(-v)); }
        __syncthreads();
        const int j = jb * 512 + C.tid; float a0 = 0.f, a1 = 0.f, a2 = 0.f, a3 = 0.f, a4 = 0.f;
        const float* wp = ada_w + ((size_t)l * DM + kc * 128) * NMOD + j;
#pragma unroll 4
        for (int k = 0; k < 128; ++k) { const float w = wp[(size_t)k * NMOD]; a0 += sl[k] * w; a1 += sl[128 + k] * w; a2 += sl[256 + k] * w; a3 += sl[384 + k] * w; a4 += sl[512 + k] * w; }
        float* pp = modp + ((size_t)(l * 8 + kc) * 5) * NMOD + j;
        pp[0] = a0; pp[NMOD] = a1; pp[2 * NMOD] = a2; pp[3 * NMOD] = a3; pp[4 * NMOD] = a4;
    }
    for (int m = C.gt; m < 8192; m += C.NGT) { float s, c; sincospif((float)m * (1.0f / 4096.0f), &s, &c); tw[m] = make_float2(c, s); }
}
__device__ __forceinline__ void ph_mod_reduce(const Ctx& C) {
    const float* ada_b = ARGF(A_ADAB); const float* modp = WSP(float, WS_MODP); float* mod = WSP(float, WS_MOD);
    for (int e = C.gt; e < 2 * 5 * NMOD; e += C.NGT) { const int l = e / (5 * NMOD), r = e % (5 * NMOD), j = r % NMOD; float s = ada_b[l * NMOD + j];
#pragma unroll
        for (int kc = 0; kc < 8; ++kc) s += modp[(size_t)(l * 8 + kc) * 5 * NMOD + r];
        mod[e] = s; }
}
__device__ __forceinline__ void ph_weights(const Ctx& C, int l) {
    LAS float* scr = (LAS float*)(C.lds + C.wave * 16384);
    const int lane = C.lane;
    const float* Win = ARGF(A_WIN) + (size_t)l * DM * NIN_ORIG;
    bf16* win_t = WSP(bf16, WS_WIN); bf16* wm_t = WSP(bf16, WS_WM);
    constexpr int I_IN = (DM / 64) * ((NIN_ORIG - 256) / 32), I_F = (256 / 64) * (DM / 32), I_A = (512 / 64) * (DM / 32), I_O = (DM / 64) * (DM / 32), I_1 = (DM / 64) * (FF / 32), I_2 = (FF / 64) * (DM / 32);
    constexpr int NITEMS = I_IN + 2 * I_F + I_A + I_O + I_1 + I_2;
    for (int it = C.gw; it < NITEMS; it += C.NGW) {
        int r = it;
        if (r < I_IN) { transpose_item(Win + 256, NIN_ORIG, NIN_ORIG - 256, win_t, DM, 512, 0, scr, r, lane); continue; } r -= I_IN;
        if (r < I_F) { transpose_item(ARGF(A_WF) + (size_t)l * 256 * DM, DM, DM, wm_t, DM, 0, 0, scr, r, lane); continue; } r -= I_F;
        if (r < I_F) { transpose_item(ARGF(A_WC) + (size_t)l * 256 * DM, DM, DM, wm_t, DM, 0, 256, scr, r, lane); continue; } r -= I_F;
        if (r < I_A) { transpose_item(ARGF(A_WA) + (size_t)l * 512 * DM, DM, DM, wm_t, DM, 0, 512, scr, r, lane); continue; } r -= I_A;
        if (r < I_O) { transpose_item(ARGF(A_WO) + (size_t)l * DM * DM, DM, DM, WSP(bf16, WS_WO), DM, 0, 0, scr, r, lane); continue; } r -= I_O;
        if (r < I_1) { transpose_item(ARGF(A_W1) + (size_t)l * DM * FF, FF, FF, WSP(bf16, WS_W1), DM, 0, 0, scr, r, lane); continue; } r -= I_1;
        transpose_item(ARGF(A_W2) + (size_t)l * FF * DM, DM, DM, WSP(bf16, WS_W2), FF, 0, 0, scr, r, lane);
    }
    for (int it = C.gw; it < 4 * 32; it += C.NGW) {
        const int g = it >> 5, k0 = (it & 31) * 32, kl = lane & 31, pq = lane >> 5;
        LAS float* tile = scr;
        LAS float* ct = scr + 32 * 65;
        { float s, c; sincospif((float)lane * (1.0f / 32.0f), &s, &c); ct[lane] = c; ct[64 + lane] = s; }
#pragma unroll 8
        for (int kk = 0; kk < 32; ++kk) tile[kk * 65 + lane] = Win[(size_t)(k0 + kk) * NIN_ORIG + g * 64 + lane];
        LDS_WAIT(); asm volatile("" ::: "memory");
        for (int kc = 0; kc < 64; ++kc) { float p = 0.f;
#pragma unroll 8
            for (int c = 0; c < 64; ++c) p += tile[kl * 65 + c] * ct[pq * 64 + ((c * kc) & 63)];
            win_t[(size_t)(pq * 256 + g * 64 + kc) * DM + k0 + kl] = (bf16)f2bf(p); }
        LDS_WAIT(); asm volatile("" ::: "memory");
    }
}
__device__ __forceinline__ void ph_norm(const Ctx& C, const float* xl, const float* xc, const float* gn, const float* shb  , bf16* dst) {
    const int lane = C.lane;
    for (int row = C.gw; row < MT; row += C.NGW) {
        const bool isc = row >= ML; const int grp = isc ? 4 : (row >> 13);
        const float* xr = isc ? xc + (size_t)(row - ML) * DM : xl + (size_t)row * DM;
        f32x4 v[4]; float s2 = 0.f;
#pragma unroll
        for (int j = 0; j < 4; ++j) { v[j] = *(const f32x4*)(xr + 4 * lane + 256 * j); s2 += (v[j].x * v[j].x + v[j].y * v[j].y) + (v[j].z * v[j].z + v[j].w * v[j].w); }
        const float rstd = 1.0f / sqrtf(wave_sum(s2) * (1.0f / DM) + EPS);
        const float* sh = shb + grp * NMOD; const float* sc = sh + DM;
#pragma unroll
        for (int j = 0; j < 4; ++j) { const int c0 = 4 * lane + 256 * j; const f32x4 gg = *(const f32x4*)(gn + c0), s1 = *(const f32x4*)(sc + c0), h1 = *(const f32x4*)(sh + c0);
            const f32x4 y = (v[j] * rstd * gg) * (s1 + 1.0f) + h1;
            v2u o; o.x = pk2(y.x, y.y); o.y = pk2(y.z, y.w); *(v2u*)(dst + (size_t)row * DM + c0) = o; }
    }
}
__device__ __forceinline__ void ph_dft(const Ctx& C, int fs) {
    const int b = fs >> 1, tid = C.tid;
    const float2* tw = WSP(const float2, WS_TW); const bf16* pxa = WSP(const bf16, WS_PXA); bf16* mix = WSP(bf16, WS_HX);
    float* tbr = WSP(float, WS_TB); float* tbi = tbr + 64 * 128 * 256;
    LAS float* tabc = (LAS float*)(C.lds + 65536); LAS float* tabs = tabc + 128;
    __syncthreads();
    if (tid < 128) { const float2 w = (fs & 1) ? tw[tid * 64] : tw[(tid & 63) * 128]; tabc[tid] = w.x; tabs[tid] = w.y; }
    __syncthreads();
    if (!(fs & 1)) {
        for (int e = C.gt; e < 64 * 128 * 256; e += C.NGT) {
            const int kc = e & 255, n2 = (e >> 8) & 127, k1 = e >> 15;
            const bf16* src = pxa + ((size_t)b * SEQ + n2) * NPXA + kc; float tr = 0.f, ti = 0.f;
#pragma unroll 4
            for (int n1 = 0; n1 < 64; ++n1) { const float p = bf2f(src[(size_t)n1 * 128 * NPXA + OFF_P]), q = bf2f(src[(size_t)n1 * 128 * NPXA + OFF_Q]); const int ix = (n1 * k1) & 63; const float wx = tabc[ix], wy = tabs[ix];
                tr += p * wx - q * wy; ti += p * wy + q * wx; }
            const float2 w = tw[n2 * k1];
            tbr[e] = tr * w.x - ti * w.y; tbi[e] = tr * w.y + ti * w.x;
        }
    } else {
        for (int e = C.gt; e < 64 * 128 * 256; e += C.NGT) {
            const int kc = e & 255, k2 = (e >> 8) & 127, k1 = e >> 15;
            const float* pr = tbr + (size_t)k1 * 128 * 256 + kc; const float* pi = tbi + (size_t)k1 * 128 * 256 + kc; float y = 0.f;
#pragma unroll 4
            for (int n2 = 0; n2 < 128; ++n2) { const int ix = (n2 * k2) & 127; y += pr[n2 * 256] * tabc[ix] - pi[n2 * 256] * tabs[ix]; }
            mix[((size_t)b * SEQ + k1 + 64 * k2) * DM + kc] = (bf16)f2bf(y * 0.001381067932f);
        }
    }
}
__device__ __forceinline__ void ph_mixers(const Ctx& C, int l) {
    const float2* tw = WSP(const float2, WS_TW); const bf16* pxa = WSP(const bf16, WS_PXA); bf16* mix = WSP(bf16, WS_HX);
    const int lane = C.lane;
    for (int e = C.gt; e < NB * 256 * 256; e += C.NGT) {
        const int kc = e & 255, k = (e >> 8) & 255, bb = e >> 16;
        const bf16* src = pxa + ((size_t)ML + bb * 256) * NPXA + kc; float y = 0.f;
#pragma unroll 4
        for (int n = 0; n < 256; ++n) { const float2 w = tw[((n * k) & 255) * 32]; y += bf2f(src[(size_t)n * NPXA + OFF_P]) * w.x - bf2f(src[(size_t)n * NPXA + OFF_Q]) * w.y; }
        mix[((size_t)ML + bb * 256 + k) * DM + kc] = (bf16)f2bf(y * (1.0f / 128.0f));
    }
    const float* cw = ARGF(A_CONVW) + l * 3 * 256;
    for (int e = C.gt; e < MT * 32; e += C.NGT) {
        const int row = e >> 5, ch = (e & 31) * 8;
        const int pos = row < ML ? (row & (SEQ - 1)) : ((row - ML) & 255), len = row < ML ? SEQ : 256;
        const bf16* pr = pxa + (size_t)row * NPXA;
        const v4u u1 = *(const v4u*)(pr + OFF_CU + ch), c1 = *(const v4u*)(pr + OFF_CC + ch), b1 = *(const v4u*)(pr + OFF_CB + ch);
        v4u u0 = (v4u){0, 0, 0, 0}, c0 = u0, u2 = u0, c2 = u0;
        if (pos > 0) { u0 = *(const v4u*)(pr - NPXA + OFF_CU + ch); c0 = *(const v4u*)(pr - NPXA + OFF_CC + ch); }
        if (pos < len - 1) { u2 = *(const v4u*)(pr + NPXA + OFF_CU + ch); c2 = *(const v4u*)(pr + NPXA + OFF_CC + ch); }
        float o[8];
#pragma unroll
        for (int j = 0; j < 4; ++j) {
            const unsigned a0 = u0[j], d0 = c0[j], a1 = u1[j], d1 = c1[j], a2 = u2[j], d2 = c2[j], bb = b1[j];
            const int cA = ch + 2 * j, cB = cA + 1;
            o[2 * j] = bflo(bb) * (cw[cA] * bflo(a0) * bflo(d0) + cw[256 + cA] * bflo(a1) * bflo(d1) + cw[512 + cA] * bflo(a2) * bflo(d2));
            o[2 * j + 1] = bfhi(bb) * (cw[cB] * bfhi(a0) * bfhi(d0) + cw[256 + cB] * bfhi(a1) * bfhi(d1) + cw[512 + cB] * bfhi(a2) * bfhi(d2));
        }
        v4u w; w.x = pk2(o[0], o[1]); w.y = pk2(o[2], o[3]); w.z = pk2(o[4], o[5]); w.w = pk2(o[6], o[7]);
        *(v4u*)(mix + (size_t)row * DM + 256 + ch) = w;
    }
    LAS float* qs = (LAS float*)(C.lds + C.wave * 2048); LAS float* ps = qs + 64;
    const float* rb = ARGF(A_RELB) + (size_t)l * 8 * 15 * 31;
    for (int it = C.gw; it < MT * 8; it += C.NGW) {
        const int token = it >> 3, h = it & 7; const bool isc = token >= ML;
        int b2, r = 0, c = 0, rs = 0, cs = 0;
        if (!isc) { b2 = token >> 13; const int pos = token & (SEQ - 1); r = pos >> 6; c = pos & 63; rs = min(max(r - 4, 0), 120); cs = min(max(c - 8, 0), 48); }
        else b2 = (token - ML) >> 8;
        const int ctxbase = ML + b2 * 256;
        qs[lane] = bf2f(pxa[(size_t)token * NPXA + OFF_QQ + h * 64 + lane]);
        LDS_WAIT(); asm volatile("" ::: "memory");
        float sv[6]; float mx = -1e30f;
#pragma unroll
        for (int i = 0; i < 6; ++i) {
            const int idx = i * 64 + lane; float s = -1e30f;
            if (!(isc && i < 2)) {
                int tk; float bias = 0.f;
                if (i < 2) { const int kr = rs + (idx >> 4), kcol = cs + (idx & 15); tk = b2 * SEQ + kr * 64 + kcol; bias = rb[(h * 15 + (kr - r + 7)) * 31 + (kcol - c + 15)]; }
                else tk = ctxbase + idx - 128;
                const bf16* kp = pxa + (size_t)tk * NPXA + OFF_K + h * 64; float d = 0.f;
#pragma unroll
                for (int j = 0; j < 8; ++j) { const v4u kv = *(const v4u*)(kp + 8 * j);
                    d += qs[8 * j] * bflo(kv.x) + qs[8 * j + 1] * bfhi(kv.x) + qs[8 * j + 2] * bflo(kv.y) + qs[8 * j + 3] * bfhi(kv.y) + qs[8 * j + 4] * bflo(kv.z) + qs[8 * j + 5] * bfhi(kv.z) + qs[8 * j + 6] * bflo(kv.w) + qs[8 * j + 7] * bfhi(kv.w); }
                s = d * 0.125f + bias;
            }
            sv[i] = s; mx = fmaxf(mx, s);
        }
        mx = wave_max(mx); float sum = 0.f;
#pragma unroll
        for (int i = 0; i < 6; ++i) { const float p = (isc && i < 2) ? 0.f : __expf(sv[i] - mx); sum += p; ps[i * 64 + lane] = p; }
        sum = wave_sum(sum);
        LDS_WAIT(); asm volatile("" ::: "memory");
        float o = 0.f;
        if (!isc) {
            for (int idx = 0; idx < 128; ++idx) { const int tk = b2 * SEQ + (rs + (idx >> 4)) * 64 + cs + (idx & 15); o += ps[idx] * bf2f(pxa[(size_t)tk * NPXA + OFF_V + h * 64 + lane]); }
        }
        for (int idx = 0; idx < 256; ++idx) o += ps[128 + idx] * bf2f(pxa[(size_t)(ctxbase + idx) * NPXA + OFF_V + h * 64 + lane]);
        mix[(size_t)token * DM + 512 + h * 64 + lane] = (bf16)f2bf(o / sum);
        LDS_WAIT(); asm volatile("" ::: "memory");
    }
}
__device__ __forceinline__ void ph_final(const Ctx& C) {
    float* out = (float*)(GAS float*)ldarg(C, A_OUT); const float* fg = ARGF(A_FG); const int lane = C.lane;
    for (int row = C.gw; row < ML; row += C.NGW) {
        float* xr = out + (size_t)row * DM;
        f32x4 v[4]; float s2 = 0.f;
#pragma unroll
        for (int j = 0; j < 4; ++j) { v[j] = *(const f32x4*)(xr + 4 * lane + 256 * j); s2 += (v[j].x * v[j].x + v[j].y * v[j].y) + (v[j].z * v[j].z + v[j].w * v[j].w); }
        const float rstd = 1.0f / sqrtf(wave_sum(s2) * (1.0f / DM) + EPS);
#pragma unroll
        for (int j = 0; j < 4; ++j) { const int c0 = 4 * lane + 256 * j; const f32x4 gg = *(const f32x4*)(fg + c0); *(f32x4*)(xr + c0) = v[j] * rstd * gg; }
    }
}

struct Args { const void* p[A_NARGS]; int ph_lo, ph_hi; };

__global__ void __launch_bounds__(NTHR, 2) fwd_kernel(Args args) {
    extern __shared__ __attribute__((aligned(16))) unsigned char lds_raw[];
    Ctx C;
    C.lds = (LAS unsigned char*)lds_raw;
    C.tid = threadIdx.x; C.lane = C.tid & 63; C.wave = __builtin_amdgcn_readfirstlane(C.tid >> 6);
    C.G = gridDim.x; C.bx = blockIdx.x;
    C.gw = C.bx * NWAVES + C.wave; C.NGW = C.G * NWAVES; C.gt = C.bx * NTHR + C.tid; C.NGT = C.G * NTHR;
    for (int u = C.tid; u < (LDS_BYTES - LDSCTL_OFF) / 4; u += NTHR) ((LAS unsigned*)(C.lds + LDSCTL_OFF))[u] = 0u;
    __syncthreads();
    if (C.tid < A_NARGS) ((LAS unsigned long long*)(C.lds + LARGS_OFF))[C.tid] = (unsigned long long)args.p[C.tid];
    __syncthreads();
    volatile LAS unsigned* MISC = (volatile LAS unsigned*)(C.lds + MISC_OFF);
    gu32* ctl = (gu32*)WSP(unsigned, WS_CTL);
    XcdBarrier bar; bar.bar = (unsigned*)(ctl + CW_BAR); bar.x = 0; bar.st = nullptr;
    if (!MK_MULTI) bar = xcd_barrier_post((unsigned*)(ctl + CW_BAR), MISC + 8);
    const int lo = args.ph_lo, hi = args.ph_hi;

    const Ctx C0 = C;
    for (int step = lo; step < hi; ++step) {
        Ctx C = C0;
        asm volatile("" : "+v"(C.tid), "+v"(C.lane), "+v"(C.gt), "+s"(C.wave), "+s"(C.bx), "+s"(C.G), "+s"(C.gw), "+s"(C.NGW), "+s"(C.NGT));
        const int ls = step - 2, l = ls >= NS ? 1 : 0, k = (step < 2) ? -1 - step : (step == NSTEPS - 1 ? 100 : ls - l * NS);
        if (k == -1) ph_mod_partial(C);
        else if (k == -2) ph_mod_reduce(C);
        else if (k == 0) {
            ph_weights(C, l);
            const float* modl = WSP(const float, WS_MOD) + (size_t)l * 5 * NMOD;
            ph_norm(C, l == 0 ? ARGF(A_X) : ARGF(A_OUT), l == 0 ? ARGF(A_CTX) : WSP(const float, WS_CTXX), ARGF(A_N1G) + l * DM, modl, WSP(bf16, WS_HX));
        } else if (k == 1) {
            pg8::Prob<false> P{WSP(const bf16, WS_HX), WSP(const bf16, WS_WIN), DM, DM, DM}; pg8::StaticOrder<1> S; S.init(MT, NIN, C.G, C.bx);
            EpiIn E{WSP(bf16, WS_PXA), WSP(bf16, WS_PXG)};
            pg8::gemm_phase(C.lds, P, S, E);
        } else if (k >= 2 && k <= 9) {
            ph_dft(C, k - 2);
            if (k == 2) ph_mixers(C, l);
        } else if (k == 10) {
            pg8::Prob<true> P{WSP(const bf16, WS_HX), WSP(const bf16, WS_WM), DM, DM, DM}; pg8::StaticOrder<3> S; S.init(MT, DM, C.G, C.bx);
            EpiMerge E{WSP(bf16, WS_M), WSP(const bf16, WS_PXG)};
            pg8::gemm_phase(C.lds, P, S, E);
        } else if (k == 11) {
            pg8::Prob<false> P{WSP(const bf16, WS_M), WSP(const bf16, WS_WO), DM, DM, DM}; pg8::StaticOrder<1> S; S.init(MT, DM, C.G, C.bx);
            EpiRes E{l == 0 ? ARGF(A_X) : ARGF(A_OUT), l == 0 ? ARGF(A_CTX) : WSP(const float, WS_CTXX), (float*)(GAS float*)ldarg(C, A_OUT), WSP(float, WS_CTXX), WSP(const float, WS_MOD) + (size_t)l * 5 * NMOD + 2 * DM};
            pg8::gemm_phase(C.lds, P, S, E);
        } else if (k == 12) {
            const float* modl = WSP(const float, WS_MOD) + (size_t)l * 5 * NMOD;
            ph_norm(C, ARGF(A_OUT), WSP(const float, WS_CTXX), ARGF(A_N2G) + l * DM, modl + 3 * DM, WSP(bf16, WS_HX));
        } else if (k == 13) {
            pg8::Prob<false> P{WSP(const bf16, WS_HX), WSP(const bf16, WS_W1), DM, DM, DM}; pg8::StaticOrder<1> S; S.init(MT, FF, C.G, C.bx);
            EpiAct E{WSP(bf16, WS_ACT)};
            pg8::gemm_phase(C.lds, P, S, E);
        } else if (k == 14) {
            pg8::Prob<false> P{WSP(const bf16, WS_ACT), WSP(const bf16, WS_W2), FF, FF, FF}; pg8::StaticOrder<1> S; S.init(MT, DM, C.G, C.bx);
            EpiRes E{ARGF(A_OUT), WSP(const float, WS_CTXX), (float*)(GAS float*)ldarg(C, A_OUT), WSP(float, WS_CTXX), WSP(const float, WS_MOD) + (size_t)l * 5 * NMOD + 5 * DM};
            pg8::gemm_phase(C.lds, P, S, E);
        } else ph_final(C);
        if (step + 1 < hi) { if (MK_MULTI) { if (C.tid == 0) __hip_atomic_store(ctl + CW_TMO, 0xBADu, RLX_AGENT); } else xcd_barrier(bar); }
    }
}

extern "C" void kernel_launch(void* const* d_in, const int* in_sizes, int n_in, void* d_out, int out_size, void* d_ws, size_t ws_size, hipStream_t stream) {
    static int grid = 0;
    if (grid == 0) {
        if (n_in != 18 || out_size != ML * DM || ws_size < WS_END) { fprintf(stderr, "kernel_launch: unexpected shapes (n_in %d out %d ws %zu)\n", n_in, out_size, ws_size); grid = -1; return; }
        int dev = 0, cus = 0;
        if (hipGetDevice(&dev) != hipSuccess || hipDeviceGetAttribute(&cus, hipDeviceAttributeMultiprocessorCount, dev) != hipSuccess) { grid = -1; return; }
        if (hipFuncSetAttribute((const void*)fwd_kernel, hipFuncAttributeMaxDynamicSharedMemorySize, LDS_BYTES) != hipSuccess) { fprintf(stderr, "kernel_launch: hipFuncSetAttribute failed\n"); grid = -1; return; }
        int per_cu = 0;
        if (hipOccupancyMaxActiveBlocksPerMultiprocessor(&per_cu, (const void*)fwd_kernel, NTHR, LDS_BYTES) != hipSuccess || per_cu < 1) fprintf(stderr, "kernel_launch: occupancy query reports %d\n", per_cu);
        (void)hipGetLastError();
        grid = cus;
    }
    if (grid < 0) return;
    (void)hipMemsetAsync((char*)d_ws + WS_CTL, 0, CTL_ZERO_BYTES, stream);
    Args a{};
    for (int i = 0; i < 18; ++i) a.p[i] = d_in[i];
    a.p[A_OUT] = d_out; a.p[A_WS] = d_ws;
#if MK_MULTI
    for (int s = 0; s < NSTEPS; ++s) { a.ph_lo = s; a.ph_hi = s + 1; hipLaunchKernelGGL(fwd_kernel, dim3(grid), dim3(NTHR), LDS_BYTES, stream, a); }
#else
    a.ph_lo = 0; a.ph_hi = NSTEPS; hipLaunchKernelGGL(fwd_kernel, dim3(grid), dim3(NTHR), LDS_BYTES, stream, a);
#endif
}
```

```cpp
#include <hip/hip_runtime.h>
#include <cstdio>
#include <cstdint>

#ifndef MK_MULTI
#define MK_MULTI 0
#endif

namespace pg8 {
#define PG8_LAS __attribute__((address_space(3)))
typedef unsigned short bf16_t;
typedef short bf16x8 __attribute__((ext_vector_type(8)));
typedef float f32x4 __attribute__((ext_vector_type(4)));
typedef unsigned u32x4 __attribute__((ext_vector_type(4)));
constexpr int BM = 256, BK = 64, HALF = 128, HTB = HALF * BK * 2, STAGE_BYTES = 8 * HTB, NXCD = 8, WGM = 8;

__host__ __device__ __forceinline__ int lds_byte(int r, int c) { const int st = (r >> 4) * 2 + (c >> 5), rr = r & 15, cc = c & 31, ob = rr * 64 + cc * 2; return st * 1024 + (ob ^ (((ob >> 9) & 1) << 5)); }
__host__ __device__ __forceinline__ void stage_rc(int b, int& R, int& C) { const int st = b / 1024, sb = b % 1024, swz = sb ^ (((sb >> 9) & 1) << 5); R = (st >> 1) * 16 + swz / 64; C = (st & 1) * 32 + (swz % 64) / 2; }
__host__ __device__ __forceinline__ int perm32(int rho) { const int n = rho >> 4, i = rho & 15; return 8 * (i >> 2) + 4 * n + (i & 3); }

struct Unit { int pm, pn, br; };

template <int REP> struct StaticOrder {
    int nM, nN, nwg, G, c;
    __device__ void init(int M, int N, int G_, int c_) { nM = M / BM; nN = N / BM; nwg = nM * nN; G = G_; c = c_; }
    __device__ __forceinline__ bool next(int i, Unit& u) const {
        const int it = i / REP; u.br = i - it * REP;
        const long L = (long)it * G + c; if (L >= nwg) return false;
        int wgid = (int)L; { const int q = nwg / NXCD, r = nwg % NXCD, xcd = wgid % NXCD, off = wgid / NXCD; wgid = (xcd < r ? xcd * (q + 1) : r * (q + 1) + (xcd - r) * q) + off; }
        const int nig = WGM * nN, gid = wgid / nig, fm = gid * WGM, gsz = (nM - fm) < WGM ? (nM - fm) : WGM;
        u.pm = fm + ((wgid % nig) % gsz); u.pn = (wgid % nig) / gsz; return true;
    }
};

template <bool MERGE> struct Prob {
    const bf16_t* A; const bf16_t* Bt; int lda, ldb, K;
    __device__ __forceinline__ int nt(const Unit& u) const { if (MERGE) return u.br == 2 ? 8 : 4; return K / BK; }
    __device__ __forceinline__ int koff(const Unit& u) const { if (MERGE) return u.br * 256; return 0; }
    __device__ __forceinline__ const char* a(const Unit& u) const { return (const char*)(A + (size_t)u.pm * BM * lda + koff(u)); }
    __device__ __forceinline__ const char* b(const Unit& u) const { return (const char*)(Bt + (size_t)u.pn * BM * ldb + koff(u)); }
};

__device__ __forceinline__ unsigned cvt_pk_bf16(float lo, float hi) { unsigned r; asm volatile("v_cvt_pk_bf16_f32 %0, %1, %2" : "=v"(r) : "v"(lo), "v"(hi)); return r; }

template <class Epi, class Sched, class PROB>
__device__ __forceinline__ void gemm_phase(PG8_LAS unsigned char* lds, const PROB P, const Sched& S, const Epi& E) {
    int tid = threadIdx.x; asm volatile("" : "+v"(tid));
    const int wid = __builtin_amdgcn_readfirstlane(tid >> 6), lane = tid & 63, wr = wid >> 2, wc = wid & 3, fr = lane & 15, fq = lane >> 4;
    unsigned voffA[2], voffB[2];
#pragma unroll
    for (int i = 0; i < 2; ++i) { int R, C; stage_rc(tid * 16 + i * 8192, R, C); const int Rb = Epi::PERM ? ((R & ~31) + perm32(R & 31)) : R;
        voffA[i] = (unsigned)(R * P.lda + C) * 2u; voffB[i] = (unsigned)(Rb * P.ldb + C) * 2u; }
    const size_t kstep = (size_t)(BK * 2);
    const size_t hstepA = (size_t)HALF * P.lda * 2, hstepB = (size_t)HALF * P.ldb * 2;
    const unsigned ldsw = (unsigned)wid * 1024u;
    const int aoff = lds_byte(wr * 64 + fr, fq * 8), boff = lds_byte(wc * 32 + fr, fq * 8);
#define PG8_SA(b, h) (((b) * 2 + (h)) * HTB)
#define PG8_SB(b, h) ((4 + (b) * 2 + (h)) * HTB)
#define PG8_STAGE(bufoff, gbase, voff) do { _Pragma("unroll") for (int _i = 0; _i < 2; ++_i) \
        __builtin_amdgcn_global_load_lds((const unsigned*)((const char*)(gbase) + (voff)[_i]), (PG8_LAS unsigned*)(lds + (bufoff) + ldsw + _i * 8192), 16, 0, 0); } while (0)
#define PG8_LDA(dst, b, h) do { _Pragma("unroll") for (int m = 0; m < 4; ++m) _Pragma("unroll") for (int k = 0; k < 2; ++k) dst[m][k] = *(const PG8_LAS bf16x8*)(lds + PG8_SA(b, h) + aoff + m * 2048 + k * 1024); } while (0)
#define PG8_LDB(dst, b, h) do { _Pragma("unroll") for (int n = 0; n < 2; ++n) _Pragma("unroll") for (int k = 0; k < 2; ++k) dst[n][k] = *(const PG8_LAS bf16x8*)(lds + PG8_SB(b, h) + boff + n * 2048 + k * 1024); } while (0)
#define PG8_MMA(ai, bj, At, Bt) do { __builtin_amdgcn_s_setprio(1); _Pragma("unroll") for (int m = 0; m < 4; ++m) _Pragma("unroll") for (int n = 0; n < 2; ++n) _Pragma("unroll") for (int k = 0; k < 2; ++k) \
        acc[ai][bj][m][n] = __builtin_amdgcn_mfma_f32_16x16x32_bf16(Bt[n][k], At[m][k], acc[ai][bj][m][n], 0, 0, 0); __builtin_amdgcn_s_setprio(0); } while (0)
#define PG8_WAIT_V(n) asm volatile("s_waitcnt vmcnt(" #n ")" ::: "memory")
#define PG8_WAIT_L(n) asm volatile("s_waitcnt lgkmcnt(" #n ")" ::: "memory")
#define PG8_BAR __builtin_amdgcn_s_barrier()
#define PG8_SCHED __builtin_amdgcn_sched_barrier(0)
    Unit cur, nxt; int ui = 0;
    if (!S.next(0, cur)) return;
    f32x4 acc[2][2][4][2];
#pragma unroll
    for (int a = 0; a < 2; ++a)
#pragma unroll
        for (int b = 0; b < 2; ++b)
#pragma unroll
            for (int m = 0; m < 4; ++m)
#pragma unroll
                for (int n = 0; n < 2; ++n) acc[a][b][m][n] = (f32x4){0.f, 0.f, 0.f, 0.f};
    bf16x8 At[4][2], B0[2][2], B1[2][2];
    const char* cA = P.a(cur); const char* cB = P.b(cur);
    PG8_STAGE(PG8_SB(0, 0), cB, voffB); PG8_STAGE(PG8_SB(0, 1), cB + hstepB, voffB); PG8_STAGE(PG8_SA(0, 0), cA, voffA); PG8_STAGE(PG8_SA(0, 1), cA + hstepA, voffA);
    if (wr == 1) PG8_BAR;
    PG8_WAIT_V(2); PG8_BAR;
    PG8_STAGE(PG8_SB(1, 0), cB + kstep, voffB); PG8_STAGE(PG8_SA(1, 0), cA + kstep, voffA); PG8_STAGE(PG8_SB(1, 1), cB + hstepB + kstep, voffB);
    PG8_WAIT_V(6); PG8_BAR;
    for (;;) {
        const bool has_next = S.next(ui + 1, nxt);
        const char* nA = has_next ? P.a(nxt) : cA; const char* nB = has_next ? P.b(nxt) : cB;
        const int nt = P.nt(cur);
        for (int t = 0; t < nt; t += 2) {
            const bool last = (t == nt - 2);
            const char* a1 = cA + (size_t)(t + 1) * kstep;
            const char* a2 = last ? nA : cA + (size_t)(t + 2) * kstep; const char* b2 = last ? nB : cB + (size_t)(t + 2) * kstep;
            const char* a3 = a2 + kstep; const char* b3 = b2 + kstep;
            PG8_LDB(B0, 0, 0); PG8_LDB(B1, 0, 1); PG8_SCHED; PG8_LDA(At, 0, 0); PG8_STAGE(PG8_SA(1, 1), a1 + hstepA, voffA);
            PG8_WAIT_V(8); PG8_WAIT_L(0); PG8_BAR; PG8_MMA(0, 0, At, B0); PG8_MMA(0, 1, At, B1); PG8_BAR; PG8_SCHED;
            PG8_LDA(At, 0, 1); PG8_STAGE(PG8_SB(0, 0), b2, voffB); PG8_STAGE(PG8_SB(0, 1), b2 + hstepB, voffB); PG8_STAGE(PG8_SA(0, 0), a2, voffA);
            PG8_WAIT_V(8); PG8_WAIT_L(0); PG8_BAR; PG8_MMA(1, 0, At, B0); PG8_MMA(1, 1, At, B1); PG8_BAR; PG8_SCHED;
            PG8_LDB(B0, 1, 0); PG8_LDB(B1, 1, 1); PG8_SCHED; PG8_LDA(At, 1, 0); PG8_STAGE(PG8_SA(0, 1), a2 + hstepA, voffA);
            PG8_WAIT_V(8); PG8_WAIT_L(0); PG8_BAR; PG8_MMA(0, 0, At, B0); PG8_MMA(0, 1, At, B1); PG8_BAR; PG8_SCHED;
            PG8_LDA(At, 1, 1); PG8_STAGE(PG8_SB(1, 0), b3, voffB); PG8_STAGE(PG8_SB(1, 1), b3 + hstepB, voffB); PG8_STAGE(PG8_SA(1, 0), a3, voffA);
            PG8_WAIT_V(8); PG8_WAIT_L(0); PG8_BAR; PG8_MMA(1, 0, At, B0); PG8_MMA(1, 1, At, B1); PG8_BAR; PG8_SCHED;
        }
        if (wr == 0) PG8_BAR;
        E(acc, cur, wr, wc, fr, fq);
        if (!has_next) break;
#pragma unroll
        for (int a = 0; a < 2; ++a)
#pragma unroll
            for (int b = 0; b < 2; ++b)
#pragma unroll
                for (int m = 0; m < 4; ++m)
#pragma unroll
                    for (int n = 0; n < 2; ++n) acc[a][b][m][n] = (f32x4){0.f, 0.f, 0.f, 0.f};
        cur = nxt; cA = nA; cB = nB; ++ui;
        if (wr == 1) PG8_BAR;
    }
    PG8_WAIT_V(0);
    PG8_BAR;
#undef PG8_SA
#undef PG8_SB
#undef PG8_STAGE
#undef PG8_LDA
#undef PG8_LDB
#undef PG8_MMA
#undef PG8_WAIT_V
#undef PG8_WAIT_L
#undef PG8_BAR
#undef PG8_SCHED
}
}

constexpr int NWAVES = 8, NTHR = 512;
constexpr int DM = 1024, NB = 4, SEQ = 8192, ML = NB * SEQ, CTXL = 256, MC = NB * CTXL, MT = ML + MC;
constexpr int NIN_ORIG = 5632, NPXA = 2816, NPXG = 3072, NIN = NPXA + NPXG;
constexpr int OFF_P = 0, OFF_Q = 256, OFF_CU = 512, OFF_CB = 768, OFF_CC = 1024, OFF_QQ = 1280, OFF_K = 1792, OFF_V = 2304;
constexpr int FF = 4096, NMOD = 6 * DM, NGRP = 5;
constexpr float EPS = 1e-6f;

constexpr size_t MiB = 1u << 20;
constexpr size_t WS_CTL = 0, CTL_ZERO_BYTES = 1 * MiB;
constexpr size_t WS_TW = 1 * MiB;
constexpr size_t WS_MOD = 1 * MiB + 65536;
constexpr size_t WS_MODP = 2 * MiB;
constexpr size_t WS_CTXX = 4 * MiB;
constexpr size_t WS_WIN = 8 * MiB, WS_WM = 20 * MiB, WS_WO = 22 * MiB, WS_W1 = 24 * MiB, WS_W2 = 32 * MiB;
constexpr size_t WS_HX = 40 * MiB;
constexpr size_t WS_PXA = 106 * MiB;
constexpr size_t WS_PXG = 288 * MiB;
constexpr size_t WS_TB = 486 * MiB;
constexpr size_t WS_M = WS_PXA;
constexpr size_t WS_ACT = WS_PXA;
constexpr size_t WS_END = 502 * MiB;
static_assert(WS_PXA + (size_t)MT * NPXA * 2 <= WS_PXG && WS_PXG + (size_t)MT * NPXG * 2 <= WS_TB && WS_ACT + (size_t)MT * FF * 2 <= WS_TB && WS_HX + (size_t)MT * DM * 2 <= WS_PXA, "ws map");
constexpr int CW_TMO = 0, CW_BAR = 4096;

constexpr int RING_BYTES = 131072, LDSCTL_OFF = 155648, MISC_OFF = LDSCTL_OFF + 320, LDS_BYTES = 163840;

#define GAS __attribute__((address_space(1)))
#define LAS __attribute__((address_space(3)))
typedef unsigned short bf16;
typedef unsigned v4u __attribute__((ext_vector_type(4)));
typedef unsigned v2u __attribute__((ext_vector_type(2)));
typedef float f32x4 __attribute__((ext_vector_type(4)));
typedef GAS unsigned gu32;
#define RLX_AGENT __ATOMIC_RELAXED, __HIP_MEMORY_SCOPE_AGENT
#define LDS_WAIT() asm volatile("s_waitcnt lgkmcnt(0)" ::: "memory")
__device__ __forceinline__ unsigned f2bf(float f) { unsigned u = __builtin_bit_cast(unsigned, f); return (u + 0x7fffu + ((u >> 16) & 1u)) >> 16; }
__device__ __forceinline__ unsigned pk2(float lo, float hi) { return f2bf(lo) | (f2bf(hi) << 16); }
__device__ __forceinline__ float bf2f(unsigned h) { return __uint_as_float(h << 16); }
__device__ __forceinline__ float bflo(unsigned w) { return __uint_as_float(w << 16); }
__device__ __forceinline__ float bfhi(unsigned w) { return __uint_as_float(w & 0xffff0000u); }

#define XB_TMO      128
#define XB_XCNT(j)  (256  + 64 * (j))
#define XB_XSUB(j)  (1280 + 64 * (j))
#define XB_XGEN(j)  (2304 + 64 * (j))
#define XB_TOP      3328
#define XB_TOPGEN   3392
#define XCD_BAR_WORDS 3456
#define XB_SPIN_CAP (1u << 22)
__device__ __forceinline__ unsigned xb_ld(unsigned* p)              { return __hip_atomic_load(p, __ATOMIC_RELAXED, __HIP_MEMORY_SCOPE_AGENT); }
__device__ __forceinline__ unsigned xb_add(unsigned* p, unsigned v) { return __hip_atomic_fetch_add(p, v, __ATOMIC_RELAXED, __HIP_MEMORY_SCOPE_AGENT); }
__device__ __forceinline__ unsigned xb_xcc_id() { return (unsigned)__builtin_amdgcn_s_getreg((3 << 11) | 20) & 0xFu; }
#define XB_SPIN(cond, bar) do { unsigned _sp = 0; while (cond) { __builtin_amdgcn_s_sleep(1); \
    if ((++_sp & 255u) == 0u) { if (xb_ld(&(bar)[XB_TMO])) break; if (_sp > XB_SPIN_CAP) { atomicAdd(&(bar)[XB_TMO], 1u); break; } } } } while (0)
struct XcdBarrier { unsigned* bar; unsigned x; volatile LAS unsigned* st; };
__device__ __forceinline__ XcdBarrier xcd_barrier_post(unsigned* bar, volatile LAS unsigned* st) {
    XcdBarrier b; b.bar = bar; b.x = xb_xcc_id(); b.st = st;
    if (threadIdx.x == 0) (void)xb_add(&bar[XB_XCNT(b.x)], 1u);
    return b;
}
__device__ __forceinline__ void xcd_barrier_complete(unsigned* bar, unsigned x, unsigned& nloc, unsigned& nx) {
    const unsigned G = gridDim.x * gridDim.y * gridDim.z;
    unsigned sum, cnt, mine, sp = 0u;
    for (;;) {
        sum = 0u; cnt = 0u; mine = 0u;
#pragma unroll
        for (unsigned j = 0; j < 16; ++j) { const unsigned c = xb_ld(&bar[XB_XCNT(j)]); sum += c; cnt += (c > 0u) ? 1u : 0u; mine = (j == x) ? c : mine; }
        if (sum == G) break;
        __builtin_amdgcn_s_sleep(1);
        if ((++sp & 255u) == 0u) { if (xb_ld(&bar[XB_TMO])) break; if (sp > XB_SPIN_CAP) { atomicAdd(&bar[XB_TMO], 1u); break; } }
    }
    nloc = mine > 0u ? mine : 1u; nx = cnt > 0u ? cnt : 1u;
}
__device__ __forceinline__ void xcd_barrier(const XcdBarrier& b) {
    asm volatile("s_waitcnt vmcnt(0)" ::: "memory");
    __syncthreads();
    if (threadIdx.x == 0) {
        unsigned* bar = b.bar;
        __builtin_amdgcn_s_waitcnt(0);
        unsigned nloc = b.st[0], nx = b.st[1];
        if (nloc == 0u) { xcd_barrier_complete(bar, b.x, nloc, nx); b.st[0] = nloc; b.st[1] = nx; }
        const unsigned old = xb_add(&bar[XB_XSUB(b.x)], 1u);
        const unsigned gen = old / nloc;
        if (old + 1u == (gen + 1u) * nloc) {
            __builtin_amdgcn_fence(__ATOMIC_RELEASE, "agent");
            asm volatile("s_waitcnt vmcnt(0)" ::: "memory");
            const unsigned og = xb_add(&bar[XB_TOP], 1u);
            const unsigned tg = og / nx;
            if (og + 1u == (tg + 1u) * nx) xb_add(&bar[XB_TOPGEN], 1u);
            else XB_SPIN(xb_ld(&bar[XB_TOPGEN]) == tg, bar);
            __builtin_amdgcn_fence(__ATOMIC_ACQUIRE, "agent");
            xb_add(&bar[XB_XGEN(b.x)], 1u);
            asm volatile("s_waitcnt vmcnt(0)" ::: "memory");
        } else {
            XB_SPIN(xb_ld(&bar[XB_XGEN(b.x)]) == gen, bar);
            __builtin_amdgcn_fence(__ATOMIC_ACQUIRE, "agent");
            asm volatile("s_waitcnt vmcnt(0)" ::: "memory");
        }
    }
    __syncthreads();
}

__device__ __forceinline__ float wave_sum(float v) {
#pragma unroll
    for (int o = 1; o < 64; o <<= 1) v += __shfl_xor(v, o);
    return v;
}
__device__ __forceinline__ float wave_max(float v) {
#pragma unroll
    for (int o = 1; o < 64; o <<= 1) v = fmaxf(v, __shfl_xor(v, o));
    return v;
}

__device__ __forceinline__ void transpose_item(const float* W, int ldw, int ncols, bf16* WT, int ldwt, int row_off, int k_off, LAS float* scr, int item, int lane) {
    const int nblk = ncols / 32, kb = item / nblk, nb = item % nblk, k0 = 64 * kb, n0 = 32 * nb;
#pragma unroll 8
    for (int i = 0; i < 32; ++i) { const int kk = 2 * i + (lane >> 5); scr[kk * 33 + (lane & 31)] = W[(size_t)(k0 + kk) * ldw + n0 + (lane & 31)]; }
    LDS_WAIT(); asm volatile("" ::: "memory");
    const int c = lane & 7;
#pragma unroll
    for (int j = 0; j < 4; ++j) { const int n = (lane >> 3) + 8 * j; const LAS float* s = scr + (8 * c) * 33 + n;
        v4u o; o.x = pk2(s[0 * 33], s[1 * 33]); o.y = pk2(s[2 * 33], s[3 * 33]); o.z = pk2(s[4 * 33], s[5 * 33]); o.w = pk2(s[6 * 33], s[7 * 33]);
        *(v4u*)(WT + (size_t)(row_off + n0 + n) * ldwt + k_off + k0 + 8 * c) = o; }
    LDS_WAIT(); asm volatile("" ::: "memory");
}

using pg8::Unit; using pg8::cvt_pk_bf16;
struct EpiIn {
    static constexpr bool PERM = true;
    bf16* pxa; bf16* pxg;
    __device__ __forceinline__ void operator()(const f32x4 (&acc)[2][2][4][2], const Unit& u, int wr, int wc, int fr, int fq) const {
        const bool gate = u.pn >= 11; bf16* base = gate ? pxg : pxa; const int ldc = gate ? NPXG : NPXA; const int colt = (gate ? u.pn - 11 : u.pn) * 256;
        const int row0 = u.pm * 256 + wr * 64 + fr, col0 = colt + wc * 32 + 8 * fq;
#pragma unroll
        for (int ai = 0; ai < 2; ++ai)
#pragma unroll
            for (int m = 0; m < 4; ++m) { bf16* rowp = base + (size_t)(row0 + ai * 128 + m * 16) * ldc + col0;
#pragma unroll
                for (int bj = 0; bj < 2; ++bj) { f32x4 v0 = acc[ai][bj][m][0], v1 = acc[ai][bj][m][1];
                    if (gate) {
#pragma unroll
                        for (int e = 0; e < 4; ++e) { v0[e] = 1.0f / (1.0f + __expf(-v0[e])); v1[e] = 1.0f / (1.0f + __expf(-v1[e])); } }
                    v4u w; w.x = cvt_pk_bf16(v0[0], v0[1]); w.y = cvt_pk_bf16(v0[2], v0[3]); w.z = cvt_pk_bf16(v1[0], v1[1]); w.w = cvt_pk_bf16(v1[2], v1[3]);
                    *(v4u*)(rowp + bj * 128) = w; } }
    }
};
struct EpiMerge {
    static constexpr bool PERM = true;
    bf16* m; const bf16* pxg;
    __device__ __forceinline__ void operator()(const f32x4 (&acc)[2][2][4][2], const Unit& u, int wr, int wc, int fr, int fq) const {
        const int row0 = u.pm * 256 + wr * 64 + fr, col0 = u.pn * 256 + wc * 32 + 8 * fq;
#pragma unroll
        for (int ai = 0; ai < 2; ++ai)
#pragma unroll
            for (int mm = 0; mm < 4; ++mm) { const size_t row = (size_t)(row0 + ai * 128 + mm * 16);
#pragma unroll
                for (int bj = 0; bj < 2; ++bj) { const f32x4 v0 = acc[ai][bj][mm][0], v1 = acc[ai][bj][mm][1];
                    const v4u g = *(const v4u*)(pxg + row * NPXG + u.br * 1024 + col0 + bj * 128);
                    bf16* mp = m + row * DM + col0 + bj * 128;
                    float o[8];
                    o[0] = v0[0] * bflo(g.x); o[1] = v0[1] * bfhi(g.x); o[2] = v0[2] * bflo(g.y); o[3] = v0[3] * bfhi(g.y);
                    o[4] = v1[0] * bflo(g.z); o[5] = v1[1] * bfhi(g.z); o[6] = v1[2] * bflo(g.w); o[7] = v1[3] * bfhi(g.w);
                    if (u.br != 0) { const v4u p = *(const v4u*)mp;
                        o[0] += bflo(p.x); o[1] += bfhi(p.x); o[2] += bflo(p.y); o[3] += bfhi(p.y); o[4] += bflo(p.z); o[5] += bfhi(p.z); o[6] += bflo(p.w); o[7] += bfhi(p.w); }
                    v4u w; w.x = cvt_pk_bf16(o[0], o[1]); w.y = cvt_pk_bf16(o[2], o[3]); w.z = cvt_pk_bf16(o[4], o[5]); w.w = cvt_pk_bf16(o[6], o[7]);
                    *(v4u*)mp = w; } }
    }
};
struct EpiRes {
    static constexpr bool PERM = false;
    const float* base_l; const float* base_c; float* out_l; float* out_c; const float* gate;
    __device__ __forceinline__ void operator()(const f32x4 (&acc)[2][2][4][2], const Unit& u, int wr, int wc, int fr, int fq) const {
        const bool isc = u.pm >= 128; const int grp = isc ? 4 : (u.pm >> 5);
        const float* base = isc ? base_c : base_l; float* out = isc ? out_c : out_l;
        const int row0 = (isc ? (u.pm - 128) : u.pm) * 256 + wr * 64 + fr, col0 = u.pn * 256 + wc * 32 + 4 * fq;
        f32x4 gv[2][2];
#pragma unroll
        for (int bj = 0; bj < 2; ++bj)
#pragma unroll
            for (int n = 0; n < 2; ++n) gv[bj][n] = *(const f32x4*)(gate + grp * NMOD + col0 + bj * 128 + n * 16);
#pragma unroll
        for (int ai = 0; ai < 2; ++ai)
#pragma unroll
            for (int m = 0; m < 4; ++m) { const size_t off = (size_t)(row0 + ai * 128 + m * 16) * DM + col0;
#pragma unroll
                for (int bj = 0; bj < 2; ++bj)
#pragma unroll
                    for (int n = 0; n < 2; ++n) { const f32x4 bs = *(const f32x4*)(base + off + bj * 128 + n * 16);
                        *(f32x4*)(out + off + bj * 128 + n * 16) = bs + gv[bj][n] * acc[ai][bj][m][n]; } }
    }
};
struct EpiAct {
    static constexpr bool PERM = true;
    bf16* a;
    __device__ __forceinline__ void operator()(const f32x4 (&acc)[2][2][4][2], const Unit& u, int wr, int wc, int fr, int fq) const {
        const int row0 = u.pm * 256 + wr * 64 + fr, col0 = u.pn * 256 + wc * 32 + 8 * fq;
#pragma unroll
        for (int ai = 0; ai < 2; ++ai)
#pragma unroll
            for (int m = 0; m < 4; ++m) { bf16* rowp = a + (size_t)(row0 + ai * 128 + m * 16) * FF + col0;
#pragma unroll
                for (int bj = 0; bj < 2; ++bj) { f32x4 v0 = acc[ai][bj][m][0], v1 = acc[ai][bj][m][1];
#pragma unroll
                    for (int e = 0; e < 4; ++e) { const float r0 = fmaxf(v0[e], 0.f), r1 = fmaxf(v1[e], 0.f); v0[e] = r0 * r0; v1[e] = r1 * r1; }
                    v4u w; w.x = cvt_pk_bf16(v0[0], v0[1]); w.y = cvt_pk_bf16(v0[2], v0[3]); w.z = cvt_pk_bf16(v1[0], v1[1]); w.w = cvt_pk_bf16(v1[2], v1[3]);
                    *(v4u*)(rowp + bj * 128) = w; } }
    }
};

constexpr int NS = 15;
constexpr int NSTEPS = 2 + 2 * NS + 1;
constexpr int LARGS_OFF = LDSCTL_OFF + 1024;
enum { A_X = 0, A_C, A_CTX, A_CCTX, A_ADAW, A_ADAB, A_N1G, A_N2G, A_WIN, A_CONVW, A_RELB, A_WF, A_WC, A_WA, A_WO, A_W1, A_W2, A_FG, A_OUT, A_WS, A_NARGS };

struct Ctx { LAS unsigned char* lds; int tid, lane, wave, G, bx, gw, NGW, gt, NGT; };
__device__ __forceinline__ unsigned long long ldarg(const Ctx& C, int i) {
    const LAS unsigned* p = (const LAS unsigned*)(C.lds + LARGS_OFF) + 2 * i;
    const unsigned lo = __builtin_amdgcn_readfirstlane(p[0]), hi = __builtin_amdgcn_readfirstlane(p[1]);
    return ((unsigned long long)hi << 32) | lo;
}
#define ARGF(i) ((const float*)(const GAS float*)ldarg(C, (i)))
#define WSP(T, off) ((T*)(GAS T*)((GAS unsigned char*)ldarg(C, A_WS) + (off)))

__device__ __forceinline__ void ph_mod_partial(const Ctx& C) {
    const float* cvec = ARGF(A_C); const float* cctx = ARGF(A_CCTX); const float* ada_w = ARGF(A_ADAW);
    float* modp = WSP(float, WS_MODP); float2* tw = WSP(float2, WS_TW);
    LAS float* sl = (LAS float*)C.lds;
    for (int item = C.bx; item < 2 * 8 * 12; item += C.G) {
        const int l = item / 96, rem = item % 96, kc = rem / 12, jb = rem % 12;
        __syncthreads();
        for (int e = C.tid; e < 5 * 128; e += NTHR) { const int g = e >> 7, k = kc * 128 + (e & 127); const float v = g < 4 ? cvec[g * DM + k] : cctx[k]; sl[e] = v / (1.0f + __expf(-v)); }
        __syncthreads();
        const int j = jb * 512 + C.tid; float a0 = 0.f, a1 = 0.f, a2 = 0.f, a3 = 0.f, a4 = 0.f;
        const float* wp = ada_w + ((size_t)l * DM + kc * 128) * NMOD + j;
#pragma unroll 4
        for (int k = 0; k < 128; ++k) { const float w = wp[(size_t)k * NMOD]; a0 += sl[k] * w; a1 += sl[128 + k] * w; a2 += sl[256 + k] * w; a3 += sl[384 + k] * w; a4 += sl[512 + k] * w; }
        float* pp = modp + ((size_t)(l * 8 + kc) * 5) * NMOD + j;
        pp[0] = a0; pp[NMOD] = a1; pp[2 * NMOD] = a2; pp[3 * NMOD] = a3; pp[4 * NMOD] = a4;
    }
    for (int m = C.gt; m < 8192; m += C.NGT) { float s, c; sincospif((float)m * (1.0f / 4096.0f), &s, &c); tw[m] = make_float2(c, s); }
}
__device__ __forceinline__ void ph_mod_reduce(const Ctx& C) {
    const float* ada_b = ARGF(A_ADAB); const float* modp = WSP(float, WS_MODP); float* mod = WSP(float, WS_MOD);
    for (int e = C.gt; e < 2 * 5 * NMOD; e += C.NGT) { const int l = e / (5 * NMOD), r = e % (5 * NMOD), j = r % NMOD; float s = ada_b[l * NMOD + j];
#pragma unroll
        for (int kc = 0; kc < 8; ++kc) s += modp[(size_t)(l * 8 + kc) * 5 * NMOD + r];
        mod[e] = s; }
}
__device__ __forceinline__ void ph_weights(const Ctx& C, int l) {
    LAS float* scr = (LAS float*)(C.lds + C.wave * 16384);
    const int lane = C.lane;
    const float* Win = ARGF(A_WIN) + (size_t)l * DM * NIN_ORIG;
    bf16* win_t = WSP(bf16, WS_WIN); bf16* wm_t = WSP(bf16, WS_WM);
    constexpr int I_IN = (DM / 64) * ((NIN_ORIG - 256) / 32), I_F = (256 / 64) * (DM / 32), I_A = (512 / 64) * (DM / 32), I_O = (DM / 64) * (DM / 32), I_1 = (DM / 64) * (FF / 32), I_2 = (FF / 64) * (DM / 32);
    constexpr int NITEMS = I_IN + 2 * I_F + I_A + I_O + I_1 + I_2;
    for (int it = C.gw; it < NITEMS; it += C.NGW) {
        int r = it;
        if (r < I_IN) { transpose_item(Win + 256, NIN_ORIG, NIN_ORIG - 256, win_t, DM, 512, 0, scr, r, lane); continue; } r -= I_IN;
        if (r < I_F) { transpose_item(ARGF(A_WF) + (size_t)l * 256 * DM, DM, DM, wm_t, DM, 0, 0, scr, r, lane); continue; } r -= I_F;
        if (r < I_F) { transpose_item(ARGF(A_WC) + (size_t)l * 256 * DM, DM, DM, wm_t, DM, 0, 256, scr, r, lane); continue; } r -= I_F;
        if (r < I_A) { transpose_item(ARGF(A_WA) + (size_t)l * 512 * DM, DM, DM, wm_t, DM, 0, 512, scr, r, lane); continue; } r -= I_A;
        if (r < I_O) { transpose_item(ARGF(A_WO) + (size_t)l * DM * DM, DM, DM, WSP(bf16, WS_WO), DM, 0, 0, scr, r, lane); continue; } r -= I_O;
        if (r < I_1) { transpose_item(ARGF(A_W1) + (size_t)l * DM * FF, FF, FF, WSP(bf16, WS_W1), DM, 0, 0, scr, r, lane); continue; } r -= I_1;
        transpose_item(ARGF(A_W2) + (size_t)l * FF * DM, DM, DM, WSP(bf16, WS_W2), FF, 0, 0, scr, r, lane);
    }
    for (int it = C.gw; it < 4 * 32; it += C.NGW) {
        const int g = it >> 5, k0 = (it & 31) * 32, kl = lane & 31, pq = lane >> 5;
        LAS float* tile = scr;
        LAS float* ct = scr + 32 * 65;
        { float s, c; sincospif((float)lane * (1.0f / 32.0f), &s, &c); ct[lane] = c; ct[64 + lane] = s; }
#pragma unroll 8
        for (int kk = 0; kk < 32; ++kk) tile[kk * 65 + lane] = Win[(size_t)(k0 + kk) * NIN_ORIG + g * 64 + lane];
        LDS_WAIT(); asm volatile("" ::: "memory");
        for (int kc = 0; kc < 64; ++kc) { float p = 0.f;
#pragma unroll 8
            for (int c = 0; c < 64; ++c) p += tile[kl * 65 + c] * ct[pq * 64 + ((c * kc) & 63)];
            win_t[(size_t)(pq * 256 + g * 64 + kc) * DM + k0 + kl] = (bf16)f2bf(p); }
        LDS_WAIT(); asm volatile("" ::: "memory");
    }
}
__device__ __forceinline__ void ph_norm(const Ctx& C, const float* xl, const float* xc, const float* gn, const float* shb  , bf16* dst) {
    const int lane = C.lane;
    for (int row = C.gw; row < MT; row += C.NGW) {
        const bool isc = row >= ML; const int grp = isc ? 4 : (row >> 13);
        const float* xr = isc ? xc + (size_t)(row - ML) * DM : xl + (size_t)row * DM;
        f32x4 v[4]; float s2 = 0.f;
#pragma unroll
        for (int j = 0; j < 4; ++j) { v[j] = *(const f32x4*)(xr + 4 * lane + 256 * j); s2 += (v[j].x * v[j].x + v[j].y * v[j].y) + (v[j].z * v[j].z + v[j].w * v[j].w); }
        const float rstd = 1.0f / sqrtf(wave_sum(s2) * (1.0f / DM) + EPS);
        const float* sh = shb + grp * NMOD; const float* sc = sh + DM;
#pragma unroll
        for (int j = 0; j < 4; ++j) { const int c0 = 4 * lane + 256 * j; const f32x4 gg = *(const f32x4*)(gn + c0), s1 = *(const f32x4*)(sc + c0), h1 = *(const f32x4*)(sh + c0);
            const f32x4 y = (v[j] * rstd * gg) * (s1 + 1.0f) + h1;
            v2u o; o.x = pk2(y.x, y.y); o.y = pk2(y.z, y.w); *(v2u*)(dst + (size_t)row * DM + c0) = o; }
    }
}
__device__ __forceinline__ void ph_dft(const Ctx& C, int fs) {
    const int b = fs >> 1, tid = C.tid;
    const float2* tw = WSP(const float2, WS_TW); const bf16* pxa = WSP(const bf16, WS_PXA); bf16* mix = WSP(bf16, WS_HX);
    float* tbr = WSP(float, WS_TB); float* tbi = tbr + 64 * 128 * 256;
    LAS float* tabc = (LAS float*)(C.lds + 65536); LAS float* tabs = tabc + 128;
    __syncthreads();
    if (tid < 128) { const float2 w = (fs & 1) ? tw[tid * 64] : tw[(tid & 63) * 128]; tabc[tid] = w.x; tabs[tid] = w.y; }
    __syncthreads();
    if (!(fs & 1)) {
        for (int e = C.gt; e < 64 * 128 * 256; e += C.NGT) {
            const int kc = e & 255, n2 = (e >> 8) & 127, k1 = e >> 15;
            const bf16* src = pxa + ((size_t)b * SEQ + n2) * NPXA + kc; float tr = 0.f, ti = 0.f;
#pragma unroll 4
            for (int n1 = 0; n1 < 64; ++n1) { const float p = bf2f(src[(size_t)n1 * 128 * NPXA + OFF_P]), q = bf2f(src[(size_t)n1 * 128 * NPXA + OFF_Q]); const int ix = (n1 * k1) & 63; const float wx = tabc[ix], wy = tabs[ix];
                tr += p * wx - q * wy; ti += p * wy + q * wx; }
            const float2 w = tw[n2 * k1];
            tbr[e] = tr * w.x - ti * w.y; tbi[e] = tr * w.y + ti * w.x;
        }
    } else {
        for (int e = C.gt; e < 64 * 128 * 256; e += C.NGT) {
            const int kc = e & 255, k2 = (e >> 8) & 127, k1 = e >> 15;
            const float* pr = tbr + (size_t)k1 * 128 * 256 + kc; const float* pi = tbi + (size_t)k1 * 128 * 256 + kc; float y = 0.f;
#pragma unroll 4
            for (int n2 = 0; n2 < 128; ++n2) { const int ix = (n2 * k2) & 127; y += pr[n2 * 256] * tabc[ix] - pi[n2 * 256] * tabs[ix]; }
            mix[((size_t)b * SEQ + k1 + 64 * k2) * DM + kc] = (bf16)f2bf(y * 0.001381067932f);
        }
    }
}
__device__ __forceinline__ void ph_mixers(const Ctx& C, int l) {
    const float2* tw = WSP(const float2, WS_TW); const bf16* pxa = WSP(const bf16, WS_PXA); bf16* mix = WSP(bf16, WS_HX);
    const int lane = C.lane;
    for (int e = C.gt; e < NB * 256 * 256; e += C.NGT) {
        const int kc = e & 255, k = (e >> 8) & 255, bb = e >> 16;
        const bf16* src = pxa + ((size_t)ML + bb * 256) * NPXA + kc; float y = 0.f;
#pragma unroll 4
        for (int n = 0; n < 256; ++n) { const float2 w = tw[((n * k) & 255) * 32]; y += bf2f(src[(size_t)n * NPXA + OFF_P]) * w.x - bf2f(src[(size_t)n * NPXA + OFF_Q]) * w.y; }
        mix[((size_t)ML + bb * 256 + k) * DM + kc] = (bf16)f2bf(y * (1.0f / 128.0f));
    }
    const float* cw = ARGF(A_CONVW) + l * 3 * 256;
    for (int e = C.gt; e < MT * 32; e += C.NGT) {
        const int row = e >> 5, ch = (e & 31) * 8;
        const int pos = row < ML ? (row & (SEQ - 1)) : ((row - ML) & 255), len = row < ML ? SEQ : 256;
        const bf16* pr = pxa + (size_t)row * NPXA;
        const v4u u1 = *(const v4u*)(pr + OFF_CU + ch), c1 = *(const v4u*)(pr + OFF_CC + ch), b1 = *(const v4u*)(pr + OFF_CB + ch);
        v4u u0 = (v4u){0, 0, 0, 0}, c0 = u0, u2 = u0, c2 = u0;
        if (pos > 0) { u0 = *(const v4u*)(pr - NPXA + OFF_CU + ch); c0 = *(const v4u*)(pr - NPXA + OFF_CC + ch); }
        if (pos < len - 1) { u2 = *(const v4u*)(pr + NPXA + OFF_CU + ch); c2 = *(const v4u*)(pr + NPXA + OFF_CC + ch); }
        float o[8];
#pragma unroll
        for (int j = 0; j < 4; ++j) {
            const unsigned a0 = u0[j], d0 = c0[j], a1 = u1[j], d1 = c1[j], a2 = u2[j], d2 = c2[j], bb = b1[j];
            const int cA = ch + 2 * j, cB = cA + 1;
            o[2 * j] = bflo(bb) * (cw[cA] * bflo(a0) * bflo(d0) + cw[256 + cA] * bflo(a1) * bflo(d1) + cw[512 + cA] * bflo(a2) * bflo(d2));
            o[2 * j + 1] = bfhi(bb) * (cw[cB] * bfhi(a0) * bfhi(d0) + cw[256 + cB] * bfhi(a1) * bfhi(d1) + cw[512 + cB] * bfhi(a2) * bfhi(d2));
        }
        v4u w; w.x = pk2(o[0], o[1]); w.y = pk2(o[2], o[3]); w.z = pk2(o[4], o[5]); w.w = pk2(o[6], o[7]);
        *(v4u*)(mix + (size_t)row * DM + 256 + ch) = w;
    }
}

typedef short bf16x8_t __attribute__((ext_vector_type(8)));
typedef short v4i16_t __attribute__((ext_vector_type(4)));
constexpr int AT_KW = 0, AT_VW = 73728, AT_BT = 147456;
__device__ __forceinline__ void attn_tile(LAS unsigned char* lds, const int (&ka)[2][2], const int (&va)[2][4], int rowoff, const bf16x8_t (&qf)[2],
                                          const LAS float* brow  , const int (&dc)[2][4], unsigned vmask, f32x4 (&o)[4], float& m, float& l) {
    constexpr float SC = 0.18033688011112042f;
    f32x4 s[2];
#pragma unroll
    for (int t = 0; t < 2; ++t) { s[t] = (f32x4){0.f, 0.f, 0.f, 0.f};
#pragma unroll
        for (int ks = 0; ks < 2; ++ks) { const bf16x8_t kf = *(const LAS bf16x8_t*)(lds + ka[t][ks] + rowoff); s[t] = __builtin_amdgcn_mfma_f32_16x16x32_bf16(kf, qf[ks], s[t], 0, 0, 0); } }
    float tmax = -1e30f;
#pragma unroll
    for (int t = 0; t < 2; ++t)
#pragma unroll
        for (int i = 0; i < 4; ++i) { float v = s[t][i] * SC; if (brow) { v += brow[dc[t][i]]; if (!((vmask >> (t * 4 + i)) & 1u)) v = -1e30f; } s[t][i] = v; tmax = fmaxf(tmax, v); }
    tmax = fmaxf(tmax, __shfl_xor(tmax, 16)); tmax = fmaxf(tmax, __shfl_xor(tmax, 32));
    const float mn = fmaxf(m, tmax), alpha = __builtin_amdgcn_exp2f(m - mn); m = mn;
    float ps = 0.f;
#pragma unroll
    for (int t = 0; t < 2; ++t)
#pragma unroll
        for (int i = 0; i < 4; ++i) { const float p = __builtin_amdgcn_exp2f(s[t][i] - mn); s[t][i] = p; ps += p; }
    l = l * alpha + ps;
    v4u pw; pw.x = pg8::cvt_pk_bf16(s[0][0], s[0][1]); pw.y = pg8::cvt_pk_bf16(s[0][2], s[0][3]); pw.z = pg8::cvt_pk_bf16(s[1][0], s[1][1]); pw.w = pg8::cvt_pk_bf16(s[1][2], s[1][3]);
    const bf16x8_t pf = __builtin_bit_cast(bf16x8_t, pw);
#pragma unroll
    for (int db = 0; db < 4; ++db) {
        const v4i16_t lo = __builtin_amdgcn_ds_read_tr16_b64_v4i16((LAS v4i16_t*)(lds + va[0][db] + rowoff));
        const v4i16_t hi = __builtin_amdgcn_ds_read_tr16_b64_v4i16((LAS v4i16_t*)(lds + va[1][db] + rowoff));
        const bf16x8_t vf = (bf16x8_t){lo[0], lo[1], lo[2], lo[3], hi[0], hi[1], hi[2], hi[3]};
        o[db] = o[db] * alpha;
        o[db] = __builtin_amdgcn_mfma_f32_16x16x32_bf16(vf, pf, o[db], 0, 0, 0);
    }
}
__device__ __forceinline__ void attn_addr(int kc0off, int li, int fq, int (&ka)[2][2], int (&va)[2][4]) {
#pragma unroll
    for (int t = 0; t < 2; ++t) {
        const int rk = kc0off + 16 * t + li;
#pragma unroll
        for (int ks = 0; ks < 2; ++ks) ka[t][ks] = AT_KW + rk * 128 + (((4 * ks + fq) ^ ((rk >> 1) & 7)) * 16);
        const int rv = kc0off + 16 * t + 4 * fq + (li >> 2), p = li & 3;
#pragma unroll
        for (int db = 0; db < 4; ++db) va[t][db] = AT_VW + rv * 128 + (((2 * db + (p >> 1)) ^ (((rv >> 1) & 3) << 1)) * 16) + (p & 1) * 8;
    }
}
__device__ __forceinline__ void ph_attn(const Ctx& C, int l) {
    const bf16* pxa = WSP(const bf16, WS_PXA); bf16* mix = WSP(bf16, WS_HX);
    const float* rb = ARGF(A_RELB) + (size_t)l * 8 * 15 * 31;
    LAS unsigned char* lds = C.lds; LAS float* biasT = (LAS float*)(lds + AT_BT);
    const int lane = C.lane, w = C.wave, fq = lane >> 4, li = lane & 15, tid = C.tid;
    const int nunits = 2048 + (l == 0 ? 64 : 0);
    for (int u = C.bx; u < nunits; u += C.G) {
        const bool isc = u >= 2048;
        int b, h, rp; if (!isc) { b = u >> 9; h = (u >> 6) & 7; rp = u & 63; } else { const int v = u - 2048; b = v >> 4; h = (v >> 1) & 7; rp = v & 1; }
        __syncthreads();
        for (int e = tid; e < 465; e += NTHR) biasT[e] = rb[h * 465 + e] * 1.4426950408889634f;
        const int R0 = min(max(2 * rp - 4, 0), 120);
        if (!isc) {
            for (int p = w; p < 72; p += 8) {
                const int tokl = p * 8 + (lane >> 3), lr = tokl >> 6, col = tokl & 63, gr = min(R0 + lr, 127), cp = lane & 7;
                const bf16* src = pxa + ((size_t)b * SEQ + gr * 64 + col) * NPXA + h * 64;
                __builtin_amdgcn_global_load_lds((const unsigned*)(src + OFF_K + ((cp ^ ((tokl >> 1) & 7)) * 8)), (LAS unsigned*)(lds + AT_KW + p * 1024), 16, 0, 0);
                __builtin_amdgcn_global_load_lds((const unsigned*)(src + OFF_V + ((cp ^ (((tokl >> 1) & 3) << 1)) * 8)), (LAS unsigned*)(lds + AT_VW + p * 1024), 16, 0, 0);
            }
        }
        int r = 0, qc = 0; size_t token;
        if (!isc) { r = 2 * rp + (w >> 2); qc = 16 * (w & 3) + li; token = (size_t)b * SEQ + r * 64 + qc; }
        else token = (size_t)ML + b * 256 + rp * 128 + 16 * w + li;
        bf16x8_t qf[2];
#pragma unroll
        for (int ks = 0; ks < 2; ++ks) qf[ks] = *(const bf16x8_t*)(pxa + token * NPXA + OFF_QQ + h * 64 + 32 * ks + 8 * fq);
        f32x4 o[4]; float m = -1e30f, lsum = 0.f;
#pragma unroll
        for (int db = 0; db < 4; ++db) o[db] = (f32x4){0.f, 0.f, 0.f, 0.f};
        int ka[2][2], va[2][4], dc[2][4];
        asm volatile("s_waitcnt vmcnt(0)" ::: "memory");
        __syncthreads();
        if (!isc) {
            const int cb = w & 3, kc0 = cb == 0 ? 0 : cb == 1 ? 8 : cb == 2 ? 24 : 32;
            attn_addr(kc0, li, fq, ka, va);
            const int csq = min(max(qc - 8, 0), 48); unsigned vmask = 0u;
#pragma unroll
            for (int t = 0; t < 2; ++t)
#pragma unroll
                for (int i = 0; i < 4; ++i) { const int kcol = kc0 + 16 * t + 4 * fq + i; if (kcol >= csq && kcol < csq + 16) vmask |= 1u << (t * 4 + i); dc[t][i] = min(max(kcol - qc + 15, 0), 30); }
            const int rsr = min(max(r - 4, 0), 120), lr0 = rsr - R0;
            for (int j = 0; j < 8; ++j) {
                const int dr = rsr + j - r + 7;
                attn_tile(lds, ka, va, (lr0 + j) * 8192, qf, biasT + dr * 31, dc, vmask, o, m, lsum);
            }
        }
        __syncthreads();
        for (int p = w; p < 32; p += 8) {
            const int tokl = p * 8 + (lane >> 3), cp = lane & 7;
            const bf16* src = pxa + ((size_t)ML + b * 256 + tokl) * NPXA + h * 64;
            __builtin_amdgcn_global_load_lds((const unsigned*)(src + OFF_K + ((cp ^ ((tokl >> 1) & 7)) * 8)), (LAS unsigned*)(lds + AT_KW + p * 1024), 16, 0, 0);
            __builtin_amdgcn_global_load_lds((const unsigned*)(src + OFF_V + ((cp ^ (((tokl >> 1) & 3) << 1)) * 8)), (LAS unsigned*)(lds + AT_VW + p * 1024), 16, 0, 0);
        }
        attn_addr(0, li, fq, ka, va);
        asm volatile("s_waitcnt vmcnt(0)" ::: "memory");
        __syncthreads();
        for (int ct = 0; ct < 8; ++ct) attn_tile(lds, ka, va, ct * 4096, qf, (const LAS float*)nullptr, dc, 0xffu, o, m, lsum);
        lsum += __shfl_xor(lsum, 16); lsum += __shfl_xor(lsum, 32);
        const float inv = 1.0f / lsum;
        bf16* op = mix + token * DM + 512 + h * 64 + 4 * fq;
#pragma unroll
        for (int db = 0; db < 4; ++db) { v2u ov; ov.x = pk2(o[db][0] * inv, o[db][1] * inv); ov.y = pk2(o[db][2] * inv, o[db][3] * inv); *(v2u*)(op + 16 * db) = ov; }
    }
}
__device__ __forceinline__ void ph_final(const Ctx& C) {
    float* out = (float*)(GAS float*)ldarg(C, A_OUT); const float* fg = ARGF(A_FG); const int lane = C.lane;
    for (int row = C.gw; row < ML; row += C.NGW) {
        float* xr = out + (size_t)row * DM;
        f32x4 v[4]; float s2 = 0.f;
#pragma unroll
        for (int j = 0; j < 4; ++j) { v[j] = *(const f32x4*)(xr + 4 * lane + 256 * j); s2 += (v[j].x * v[j].x + v[j].y * v[j].y) + (v[j].z * v[j].z + v[j].w * v[j].w); }
        const float rstd = 1.0f / sqrtf(wave_sum(s2) * (1.0f / DM) + EPS);
#pragma unroll
        for (int j = 0; j < 4; ++j) { const int c0 = 4 * lane + 256 * j; const f32x4 gg = *(const f32x4*)(fg + c0); *(f32x4*)(xr + c0) = v[j] * rstd * gg; }
    }
}

struct Args { const void* p[A_NARGS]; int ph_lo, ph_hi; };

__global__ void __launch_bounds__(NTHR, 2) fwd_kernel(Args args) {
    extern __shared__ __attribute__((aligned(16))) unsigned char lds_raw[];
    Ctx C;
    C.lds = (LAS unsigned char*)lds_raw;
    C.tid = threadIdx.x; C.lane = C.tid & 63; C.wave = __builtin_amdgcn_readfirstlane(C.tid >> 6);
    C.G = gridDim.x; C.bx = blockIdx.x;
    C.gw = C.bx * NWAVES + C.wave; C.NGW = C.G * NWAVES; C.gt = C.bx * NTHR + C.tid; C.NGT = C.G * NTHR;
    for (int u = C.tid; u < (LDS_BYTES - LDSCTL_OFF) / 4; u += NTHR) ((LAS unsigned*)(C.lds + LDSCTL_OFF))[u] = 0u;
    __syncthreads();
    if (C.tid < A_NARGS) ((LAS unsigned long long*)(C.lds + LARGS_OFF))[C.tid] = (unsigned long long)args.p[C.tid];
    __syncthreads();
    volatile LAS unsigned* MISC = (volatile LAS unsigned*)(C.lds + MISC_OFF);
    gu32* ctl = (gu32*)WSP(unsigned, WS_CTL);
    XcdBarrier bar; bar.bar = (unsigned*)(ctl + CW_BAR); bar.x = 0; bar.st = nullptr;
    if (!MK_MULTI) bar = xcd_barrier_post((unsigned*)(ctl + CW_BAR), MISC + 8);
    const int lo = args.ph_lo, hi = args.ph_hi;

    const Ctx C0 = C;
    for (int step = lo; step < hi; ++step) {
        Ctx C = C0;
        asm volatile("" : "+v"(C.tid), "+v"(C.lane), "+v"(C.gt), "+s"(C.wave), "+s"(C.bx), "+s"(C.G), "+s"(C.gw), "+s"(C.NGW), "+s"(C.NGT));
        const int ls = step - 2, l = ls >= NS ? 1 : 0, k = (step < 2) ? -1 - step : (step == NSTEPS - 1 ? 100 : ls - l * NS);
        if (k == -1) ph_mod_partial(C);
        else if (k == -2) ph_mod_reduce(C);
        else if (k == 0) {
            ph_weights(C, l);
            const float* modl = WSP(const float, WS_MOD) + (size_t)l * 5 * NMOD;
            ph_norm(C, l == 0 ? ARGF(A_X) : ARGF(A_OUT), l == 0 ? ARGF(A_CTX) : WSP(const float, WS_CTXX), ARGF(A_N1G) + l * DM, modl, WSP(bf16, WS_HX));
        } else if (k == 1) {
            pg8::Prob<false> P{WSP(const bf16, WS_HX), WSP(const bf16, WS_WIN), DM, DM, DM}; pg8::StaticOrder<1> S; S.init(MT, NIN, C.G, C.bx);
            EpiIn E{WSP(bf16, WS_PXA), WSP(bf16, WS_PXG)};
            pg8::gemm_phase(C.lds, P, S, E);
        } else if (k >= 2 && k <= 9) {
            ph_dft(C, k - 2);
            if (k == 2) { ph_mixers(C, l); ph_attn(C, l); }
        } else if (k == 10) {
            pg8::Prob<true> P{WSP(const bf16, WS_HX), WSP(const bf16, WS_WM), DM, DM, DM}; pg8::StaticOrder<3> S; S.init(MT, DM, C.G, C.bx);
            EpiMerge E{WSP(bf16, WS_M), WSP(const bf16, WS_PXG)};
            pg8::gemm_phase(C.lds, P, S, E);
        } else if (k == 11) {
            pg8::Prob<false> P{WSP(const bf16, WS_M), WSP(const bf16, WS_WO), DM, DM, DM}; pg8::StaticOrder<1> S; S.init(MT, DM, C.G, C.bx);
            EpiRes E{l == 0 ? ARGF(A_X) : ARGF(A_OUT), l == 0 ? ARGF(A_CTX) : WSP(const float, WS_CTXX), (float*)(GAS float*)ldarg(C, A_OUT), WSP(float, WS_CTXX), WSP(const float, WS_MOD) + (size_t)l * 5 * NMOD + 2 * DM};
            pg8::gemm_phase(C.lds, P, S, E);
        } else if (k == 12) {
            const float* modl = WSP(const float, WS_MOD) + (size_t)l * 5 * NMOD;
            ph_norm(C, ARGF(A_OUT), WSP(const float, WS_CTXX), ARGF(A_N2G) + l * DM, modl + 3 * DM, WSP(bf16, WS_HX));
        } else if (k == 13) {
            pg8::Prob<false> P{WSP(const bf16, WS_HX), WSP(const bf16, WS_W1), DM, DM, DM}; pg8::StaticOrder<1> S; S.init(MT, FF, C.G, C.bx);
            EpiAct E{WSP(bf16, WS_ACT)};
            pg8::gemm_phase(C.lds, P, S, E);
        } else if (k == 14) {
            pg8::Prob<false> P{WSP(const bf16, WS_ACT), WSP(const bf16, WS_W2), FF, FF, FF}; pg8::StaticOrder<1> S; S.init(MT, DM, C.G, C.bx);
            EpiRes E{ARGF(A_OUT), WSP(const float, WS_CTXX), (float*)(GAS float*)ldarg(C, A_OUT), WSP(float, WS_CTXX), WSP(const float, WS_MOD) + (size_t)l * 5 * NMOD + 5 * DM};
            pg8::gemm_phase(C.lds, P, S, E);
        } else ph_final(C);
        if (step + 1 < hi) { if (MK_MULTI) { if (C.tid == 0) __hip_atomic_store(ctl + CW_TMO, 0xBADu, RLX_AGENT); } else xcd_barrier(bar); }
    }
}

extern "C" void kernel_launch(void* const* d_in, const int* in_sizes, int n_in, void* d_out, int out_size, void* d_ws, size_t ws_size, hipStream_t stream) {
    static int grid = 0;
    if (grid == 0) {
        if (n_in != 18 || out_size != ML * DM || ws_size < WS_END) { fprintf(stderr, "kernel_launch: unexpected shapes (n_in %d out %d ws %zu)\n", n_in, out_size, ws_size); grid = -1; return; }
        int dev = 0, cus = 0;
        if (hipGetDevice(&dev) != hipSuccess || hipDeviceGetAttribute(&cus, hipDeviceAttributeMultiprocessorCount, dev) != hipSuccess) { grid = -1; return; }
        if (hipFuncSetAttribute((const void*)fwd_kernel, hipFuncAttributeMaxDynamicSharedMemorySize, LDS_BYTES) != hipSuccess) { fprintf(stderr, "kernel_launch: hipFuncSetAttribute failed\n"); grid = -1; return; }
        int per_cu = 0;
        if (hipOccupancyMaxActiveBlocksPerMultiprocessor(&per_cu, (const void*)fwd_kernel, NTHR, LDS_BYTES) != hipSuccess || per_cu < 1) fprintf(stderr, "kernel_launch: occupancy query reports %d\n", per_cu);
        (void)hipGetLastError();
        grid = cus;
    }
    if (grid < 0) return;
    (void)hipMemsetAsync((char*)d_ws + WS_CTL, 0, CTL_ZERO_BYTES, stream);
    Args a{};
    for (int i = 0; i < 18; ++i) a.p[i] = d_in[i];
    a.p[A_OUT] = d_out; a.p[A_WS] = d_ws;
#if MK_MULTI
    for (int s = 0; s < NSTEPS; ++s) { a.ph_lo = s; a.ph_hi = s + 1; hipLaunchKernelGGL(fwd_kernel, dim3(grid), dim3(NTHR), LDS_BYTES, stream, a); }
#else
    a.ph_lo = 0; a.ph_hi = NSTEPS; hipLaunchKernelGGL(fwd_kernel, dim3(grid), dim3(NTHR), LDS_BYTES, stream, a);
#endif
}
```

```cpp
#include <hip/hip_runtime.h>
#include <cstdio>
#include <cstdint>

#ifndef MK_MULTI
#define MK_MULTI 0
#endif

namespace pg8 {
#define PG8_LAS __attribute__((address_space(3)))
typedef unsigned short bf16_t;
typedef short bf16x8 __attribute__((ext_vector_type(8)));
typedef float f32x4 __attribute__((ext_vector_type(4)));
typedef unsigned u32x4 __attribute__((ext_vector_type(4)));
constexpr int BM = 256, BK = 64, HALF = 128, HTB = HALF * BK * 2, STAGE_BYTES = 8 * HTB, NXCD = 8, WGM = 8;

__host__ __device__ __forceinline__ int lds_byte(int r, int c) { const int st = (r >> 4) * 2 + (c >> 5), rr = r & 15, cc = c & 31, ob = rr * 64 + cc * 2; return st * 1024 + (ob ^ (((ob >> 9) & 1) << 5)); }
__host__ __device__ __forceinline__ void stage_rc(int b, int& R, int& C) { const int st = b / 1024, sb = b % 1024, swz = sb ^ (((sb >> 9) & 1) << 5); R = (st >> 1) * 16 + swz / 64; C = (st & 1) * 32 + (swz % 64) / 2; }
__host__ __device__ __forceinline__ int perm32(int rho) { const int n = rho >> 4, i = rho & 15; return 8 * (i >> 2) + 4 * n + (i & 3); }

struct Unit { int pm, pn, br; };

template <int REP> struct StaticOrder {
    int nM, nN, nwg, G, c;
    __device__ void init(int M, int N, int G_, int c_) { nM = M / BM; nN = N / BM; nwg = nM * nN; G = G_; c = c_; }
    __device__ __forceinline__ bool next(int i, Unit& u) const {
        const int it = i / REP; u.br = i - it * REP;
        const long L = (long)it * G + c; if (L >= nwg) return false;
        int wgid = (int)L; { const int q = nwg / NXCD, r = nwg % NXCD, xcd = wgid % NXCD, off = wgid / NXCD; wgid = (xcd < r ? xcd * (q + 1) : r * (q + 1) + (xcd - r) * q) + off; }
        const int nig = WGM * nN, gid = wgid / nig, fm = gid * WGM, gsz = (nM - fm) < WGM ? (nM - fm) : WGM;
        u.pm = fm + ((wgid % nig) % gsz); u.pn = (wgid % nig) / gsz; return true;
    }
};

template <bool MERGE> struct Prob {
    const bf16_t* A; const bf16_t* Bt; int lda, ldb, K;
    __device__ __forceinline__ int nt(const Unit& u) const { if (MERGE) return u.br == 2 ? 8 : 4; return K / BK; }
    __device__ __forceinline__ int koff(const Unit& u) const { if (MERGE) return u.br * 256; return 0; }
    __device__ __forceinline__ const char* a(const Unit& u) const { return (const char*)(A + (size_t)u.pm * BM * lda + koff(u)); }
    __device__ __forceinline__ const char* b(const Unit& u) const { return (const char*)(Bt + (size_t)u.pn * BM * ldb + koff(u)); }
};

__device__ __forceinline__ unsigned cvt_pk_bf16(float lo, float hi) { unsigned r; asm volatile("v_cvt_pk_bf16_f32 %0, %1, %2" : "=v"(r) : "v"(lo), "v"(hi)); return r; }

template <class Epi, class Sched, class PROB>
__device__ __forceinline__ void gemm_phase(PG8_LAS unsigned char* lds, const PROB P, const Sched& S, const Epi& E) {
    int tid = threadIdx.x; asm volatile("" : "+v"(tid));
    const int wid = __builtin_amdgcn_readfirstlane(tid >> 6), lane = tid & 63, wr = wid >> 2, wc = wid & 3, fr = lane & 15, fq = lane >> 4;
    unsigned voffA[2], voffB[2];
#pragma unroll
    for (int i = 0; i < 2; ++i) { int R, C; stage_rc(tid * 16 + i * 8192, R, C); const int Rb = Epi::PERM ? ((R & ~31) + perm32(R & 31)) : R;
        voffA[i] = (unsigned)(R * P.lda + C) * 2u; voffB[i] = (unsigned)(Rb * P.ldb + C) * 2u; }
    const size_t kstep = (size_t)(BK * 2);
    const size_t hstepA = (size_t)HALF * P.lda * 2, hstepB = (size_t)HALF * P.ldb * 2;
    const unsigned ldsw = (unsigned)wid * 1024u;
    const int aoff = lds_byte(wr * 64 + fr, fq * 8), boff = lds_byte(wc * 32 + fr, fq * 8);
#define PG8_SA(b, h) (((b) * 2 + (h)) * HTB)
#define PG8_SB(b, h) ((4 + (b) * 2 + (h)) * HTB)
#define PG8_STAGE(bufoff, gbase, voff) do { _Pragma("unroll") for (int _i = 0; _i < 2; ++_i) \
        __builtin_amdgcn_global_load_lds((const unsigned*)((const char*)(gbase) + (voff)[_i]), (PG8_LAS unsigned*)(lds + (bufoff) + ldsw + _i * 8192), 16, 0, 0); } while (0)
#define PG8_LDA(dst, b, h) do { _Pragma("unroll") for (int m = 0; m < 4; ++m) _Pragma("unroll") for (int k = 0; k < 2; ++k) dst[m][k] = *(const PG8_LAS bf16x8*)(lds + PG8_SA(b, h) + aoff + m * 2048 + k * 1024); } while (0)
#define PG8_LDB(dst, b, h) do { _Pragma("unroll") for (int n = 0; n < 2; ++n) _Pragma("unroll") for (int k = 0; k < 2; ++k) dst[n][k] = *(const PG8_LAS bf16x8*)(lds + PG8_SB(b, h) + boff + n * 2048 + k * 1024); } while (0)
#define PG8_MMA(ai, bj, At, Bt) do { __builtin_amdgcn_s_setprio(1); _Pragma("unroll") for (int m = 0; m < 4; ++m) _Pragma("unroll") for (int n = 0; n < 2; ++n) _Pragma("unroll") for (int k = 0; k < 2; ++k) \
        acc[ai][bj][m][n] = __builtin_amdgcn_mfma_f32_16x16x32_bf16(Bt[n][k], At[m][k], acc[ai][bj][m][n], 0, 0, 0); __builtin_amdgcn_s_setprio(0); } while (0)
#define PG8_WAIT_V(n) asm volatile("s_waitcnt vmcnt(" #n ")" ::: "memory")
#define PG8_WAIT_L(n) asm volatile("s_waitcnt lgkmcnt(" #n ")" ::: "memory")
#define PG8_BAR __builtin_amdgcn_s_barrier()
#define PG8_SCHED __builtin_amdgcn_sched_barrier(0)
    Unit cur, nxt; int ui = 0;
    if (!S.next(0, cur)) return;
    f32x4 acc[2][2][4][2];
#pragma unroll
    for (int a = 0; a < 2; ++a)
#pragma unroll
        for (int b = 0; b < 2; ++b)
#pragma unroll
            for (int m = 0; m < 4; ++m)
#pragma unroll
                for (int n = 0; n < 2; ++n) acc[a][b][m][n] = (f32x4){0.f, 0.f, 0.f, 0.f};
    bf16x8 At[4][2], B0[2][2], B1[2][2];
    const char* cA = P.a(cur); const char* cB = P.b(cur);
    PG8_STAGE(PG8_SB(0, 0), cB, voffB); PG8_STAGE(PG8_SB(0, 1), cB + hstepB, voffB); PG8_STAGE(PG8_SA(0, 0), cA, voffA); PG8_STAGE(PG8_SA(0, 1), cA + hstepA, voffA);
    if (wr == 1) PG8_BAR;
    PG8_WAIT_V(2); PG8_BAR;
    PG8_STAGE(PG8_SB(1, 0), cB + kstep, voffB); PG8_STAGE(PG8_SA(1, 0), cA + kstep, voffA); PG8_STAGE(PG8_SB(1, 1), cB + hstepB + kstep, voffB);
    PG8_WAIT_V(6); PG8_BAR;
    for (;;) {
        const bool has_next = S.next(ui + 1, nxt);
        const char* nA = has_next ? P.a(nxt) : cA; const char* nB = has_next ? P.b(nxt) : cB;
        const int nt = P.nt(cur);
        for (int t = 0; t < nt; t += 2) {
            const bool last = (t == nt - 2);
            const char* a1 = cA + (size_t)(t + 1) * kstep;
            const char* a2 = last ? nA : cA + (size_t)(t + 2) * kstep; const char* b2 = last ? nB : cB + (size_t)(t + 2) * kstep;
            const char* a3 = a2 + kstep; const char* b3 = b2 + kstep;
            PG8_LDB(B0, 0, 0); PG8_LDB(B1, 0, 1); PG8_SCHED; PG8_LDA(At, 0, 0); PG8_STAGE(PG8_SA(1, 1), a1 + hstepA, voffA);
            PG8_WAIT_V(8); PG8_WAIT_L(0); PG8_BAR; PG8_MMA(0, 0, At, B0); PG8_MMA(0, 1, At, B1); PG8_BAR; PG8_SCHED;
            PG8_LDA(At, 0, 1); PG8_STAGE(PG8_SB(0, 0), b2, voffB); PG8_STAGE(PG8_SB(0, 1), b2 + hstepB, voffB); PG8_STAGE(PG8_SA(0, 0), a2, voffA);
            PG8_WAIT_V(8); PG8_WAIT_L(0); PG8_BAR; PG8_MMA(1, 0, At, B0); PG8_MMA(1, 1, At, B1); PG8_BAR; PG8_SCHED;
            PG8_LDB(B0, 1, 0); PG8_LDB(B1, 1, 1); PG8_SCHED; PG8_LDA(At, 1, 0); PG8_STAGE(PG8_SA(0, 1), a2 + hstepA, voffA);
            PG8_WAIT_V(8); PG8_WAIT_L(0); PG8_BAR; PG8_MMA(0, 0, At, B0); PG8_MMA(0, 1, At, B1); PG8_BAR; PG8_SCHED;
            PG8_LDA(At, 1, 1); PG8_STAGE(PG8_SB(1, 0), b3, voffB); PG8_STAGE(PG8_SB(1, 1), b3 + hstepB, voffB); PG8_STAGE(PG8_SA(1, 0), a3, voffA);
            PG8_WAIT_V(8); PG8_WAIT_L(0); PG8_BAR; PG8_MMA(1, 0, At, B0); PG8_MMA(1, 1, At, B1); PG8_BAR; PG8_SCHED;
        }
        if (wr == 0) PG8_BAR;
        E(acc, cur, wr, wc, fr, fq);
        if (!has_next) break;
#pragma unroll
        for (int a = 0; a < 2; ++a)
#pragma unroll
            for (int b = 0; b < 2; ++b)
#pragma unroll
                for (int m = 0; m < 4; ++m)
#pragma unroll
                    for (int n = 0; n < 2; ++n) acc[a][b][m][n] = (f32x4){0.f, 0.f, 0.f, 0.f};
        cur = nxt; cA = nA; cB = nB; ++ui;
        if (wr == 1) PG8_BAR;
    }
    PG8_WAIT_V(0);
    PG8_BAR;
#undef PG8_SA
#undef PG8_SB
#undef PG8_STAGE
#undef PG8_LDA
#undef PG8_LDB
#undef PG8_MMA
#undef PG8_WAIT_V
#undef PG8_WAIT_L
#undef PG8_BAR
#undef PG8_SCHED
}
}

constexpr int NWAVES = 8, NTHR = 512;
constexpr int DM = 1024, NB = 4, SEQ = 8192, ML = NB * SEQ, CTXL = 256, MC = NB * CTXL, MT = ML + MC;
constexpr int NIN_ORIG = 5632, NPXA = 2816, NPXG = 3072, NIN = NPXA + NPXG;
constexpr int OFF_P = 0, OFF_Q = 256, OFF_CU = 512, OFF_CB = 768, OFF_CC = 1024, OFF_QQ = 1280, OFF_K = 1792, OFF_V = 2304;
constexpr int FF = 4096, NMOD = 6 * DM, NGRP = 5;
constexpr float EPS = 1e-6f;

constexpr size_t MiB = 1u << 20;
constexpr size_t WS_CTL = 0, CTL_ZERO_BYTES = 1 * MiB;
constexpr size_t WS_TW = 1 * MiB;
constexpr size_t WS_MOD = 1 * MiB + 65536;
constexpr size_t WS_MODP = 2 * MiB;
constexpr size_t WS_CTXX = 4 * MiB;
constexpr size_t WS_WIN = 8 * MiB, WS_WM = 20 * MiB, WS_WO = 22 * MiB, WS_W1 = 24 * MiB, WS_W2 = 32 * MiB;
constexpr size_t WS_HX = 40 * MiB;
constexpr size_t WS_PXA = 106 * MiB;
constexpr size_t WS_PXG = 288 * MiB;
constexpr size_t WS_TB = 486 * MiB;
constexpr size_t WS_M = WS_PXA;
constexpr size_t WS_ACT = WS_PXA;
constexpr size_t WS_END = 510 * MiB;
static_assert(WS_PXA + (size_t)MT * NPXA * 2 <= WS_PXG && WS_PXG + (size_t)MT * NPXG * 2 <= WS_TB && WS_ACT + (size_t)MT * FF * 2 <= WS_TB && WS_HX + (size_t)MT * DM * 2 <= WS_PXA, "ws map");
constexpr int CW_TMO = 0, CW_BAR = 4096;

constexpr int RING_BYTES = 131072, LDSCTL_OFF = 155648, MISC_OFF = LDSCTL_OFF + 320, LDS_BYTES = 163840;

#define GAS __attribute__((address_space(1)))
#define LAS __attribute__((address_space(3)))
typedef unsigned short bf16;
typedef unsigned v4u __attribute__((ext_vector_type(4)));
typedef unsigned v2u __attribute__((ext_vector_type(2)));
typedef float f32x4 __attribute__((ext_vector_type(4)));
typedef GAS unsigned gu32;
#define RLX_AGENT __ATOMIC_RELAXED, __HIP_MEMORY_SCOPE_AGENT
#define LDS_WAIT() asm volatile("s_waitcnt lgkmcnt(0)" ::: "memory")
__device__ __forceinline__ unsigned f2bf(float f) { unsigned u = __builtin_bit_cast(unsigned, f); return (u + 0x7fffu + ((u >> 16) & 1u)) >> 16; }
__device__ __forceinline__ unsigned pk2(float lo, float hi) { return f2bf(lo) | (f2bf(hi) << 16); }
__device__ __forceinline__ float bf2f(unsigned h) { return __uint_as_float(h << 16); }
__device__ __forceinline__ float bflo(unsigned w) { return __uint_as_float(w << 16); }
__device__ __forceinline__ float bfhi(unsigned w) { return __uint_as_float(w & 0xffff0000u); }

#define XB_TMO      128
#define XB_XCNT(j)  (256  + 64 * (j))
#define XB_XSUB(j)  (1280 + 64 * (j))
#define XB_XGEN(j)  (2304 + 64 * (j))
#define XB_TOP      3328
#define XB_TOPGEN   3392
#define XCD_BAR_WORDS 3456
#define XB_SPIN_CAP (1u << 22)
__device__ __forceinline__ unsigned xb_ld(unsigned* p)              { return __hip_atomic_load(p, __ATOMIC_RELAXED, __HIP_MEMORY_SCOPE_AGENT); }
__device__ __forceinline__ unsigned xb_add(unsigned* p, unsigned v) { return __hip_atomic_fetch_add(p, v, __ATOMIC_RELAXED, __HIP_MEMORY_SCOPE_AGENT); }
__device__ __forceinline__ unsigned xb_xcc_id() { return (unsigned)__builtin_amdgcn_s_getreg((3 << 11) | 20) & 0xFu; }
#define XB_SPIN(cond, bar) do { unsigned _sp = 0; while (cond) { __builtin_amdgcn_s_sleep(1); \
    if ((++_sp & 255u) == 0u) { if (xb_ld(&(bar)[XB_TMO])) break; if (_sp > XB_SPIN_CAP) { atomicAdd(&(bar)[XB_TMO], 1u); break; } } } } while (0)
struct XcdBarrier { unsigned* bar; unsigned x; volatile LAS unsigned* st; };
__device__ __forceinline__ XcdBarrier xcd_barrier_post(unsigned* bar, volatile LAS unsigned* st) {
    XcdBarrier b; b.bar = bar; b.x = xb_xcc_id(); b.st = st;
    if (threadIdx.x == 0) (void)xb_add(&bar[XB_XCNT(b.x)], 1u);
    return b;
}
__device__ __forceinline__ void xcd_barrier_complete(unsigned* bar, unsigned x, unsigned& nloc, unsigned& nx) {
    const unsigned G = gridDim.x * gridDim.y * gridDim.z;
    unsigned sum, cnt, mine, sp = 0u;
    for (;;) {
        sum = 0u; cnt = 0u; mine = 0u;
#pragma unroll
        for (unsigned j = 0; j < 16; ++j) { const unsigned c = xb_ld(&bar[XB_XCNT(j)]); sum += c; cnt += (c > 0u) ? 1u : 0u; mine = (j == x) ? c : mine; }
        if (sum == G) break;
        __builtin_amdgcn_s_sleep(1);
        if ((++sp & 255u) == 0u) { if (xb_ld(&bar[XB_TMO])) break; if (sp > XB_SPIN_CAP) { atomicAdd(&bar[XB_TMO], 1u); break; } }
    }
    nloc = mine > 0u ? mine : 1u; nx = cnt > 0u ? cnt : 1u;
}
__device__ __forceinline__ void xcd_barrier(const XcdBarrier& b) {
    asm volatile("s_waitcnt vmcnt(0)" ::: "memory");
    __syncthreads();
    if (threadIdx.x == 0) {
        unsigned* bar = b.bar;
        __builtin_amdgcn_s_waitcnt(0);
        unsigned nloc = b.st[0], nx = b.st[1];
        if (nloc == 0u) { xcd_barrier_complete(bar, b.x, nloc, nx); b.st[0] = nloc; b.st[1] = nx; }
        const unsigned old = xb_add(&bar[XB_XSUB(b.x)], 1u);
        const unsigned gen = old / nloc;
        if (old + 1u == (gen + 1u) * nloc) {
            __builtin_amdgcn_fence(__ATOMIC_RELEASE, "agent");
            asm volatile("s_waitcnt vmcnt(0)" ::: "memory");
            const unsigned og = xb_add(&bar[XB_TOP], 1u);
            const unsigned tg = og / nx;
            if (og + 1u == (tg + 1u) * nx) xb_add(&bar[XB_TOPGEN], 1u);
            else XB_SPIN(xb_ld(&bar[XB_TOPGEN]) == tg, bar);
            __builtin_amdgcn_fence(__ATOMIC_ACQUIRE, "agent");
            xb_add(&bar[XB_XGEN(b.x)], 1u);
            asm volatile("s_waitcnt vmcnt(0)" ::: "memory");
        } else {
            XB_SPIN(xb_ld(&bar[XB_XGEN(b.x)]) == gen, bar);
            __builtin_amdgcn_fence(__ATOMIC_ACQUIRE, "agent");
            asm volatile("s_waitcnt vmcnt(0)" ::: "memory");
        }
    }
    __syncthreads();
}

__device__ __forceinline__ float wave_sum(float v) {
#pragma unroll
    for (int o = 1; o < 64; o <<= 1) v += __shfl_xor(v, o);
    return v;
}
__device__ __forceinline__ float wave_max(float v) {
#pragma unroll
    for (int o = 1; o < 64; o <<= 1) v = fmaxf(v, __shfl_xor(v, o));
    return v;
}

__device__ __forceinline__ void transpose_item(const float* W, int ldw, int ncols, bf16* WT, int ldwt, int row_off, int k_off, LAS float* scr, int item, int lane) {
    const int nblk = ncols / 32, kb = item / nblk, nb = item % nblk, k0 = 64 * kb, n0 = 32 * nb;
#pragma unroll 8
    for (int i = 0; i < 32; ++i) { const int kk = 2 * i + (lane >> 5); scr[kk * 33 + (lane & 31)] = W[(size_t)(k0 + kk) * ldw + n0 + (lane & 31)]; }
    LDS_WAIT(); asm volatile("" ::: "memory");
    const int c = lane & 7;
#pragma unroll
    for (int j = 0; j < 4; ++j) { const int n = (lane >> 3) + 8 * j; const LAS float* s = scr + (8 * c) * 33 + n;
        v4u o; o.x = pk2(s[0 * 33], s[1 * 33]); o.y = pk2(s[2 * 33], s[3 * 33]); o.z = pk2(s[4 * 33], s[5 * 33]); o.w = pk2(s[6 * 33], s[7 * 33]);
        *(v4u*)(WT + (size_t)(row_off + n0 + n) * ldwt + k_off + k0 + 8 * c) = o; }
    LDS_WAIT(); asm volatile("" ::: "memory");
}

using pg8::Unit; using pg8::cvt_pk_bf16;
struct EpiIn {
    static constexpr bool PERM = true;
    bf16* pxa; bf16* pxg;
    __device__ __forceinline__ void operator()(const f32x4 (&acc)[2][2][4][2], const Unit& u, int wr, int wc, int fr, int fq) const {
        const bool gate = u.pn >= 11; bf16* base = gate ? pxg : pxa; const int ldc = gate ? NPXG : NPXA; const int colt = (gate ? u.pn - 11 : u.pn) * 256;
        const int row0 = u.pm * 256 + wr * 64 + fr, col0 = colt + wc * 32 + 8 * fq;
#pragma unroll
        for (int ai = 0; ai < 2; ++ai)
#pragma unroll
            for (int m = 0; m < 4; ++m) { bf16* rowp = base + (size_t)(row0 + ai * 128 + m * 16) * ldc + col0;
#pragma unroll
                for (int bj = 0; bj < 2; ++bj) { f32x4 v0 = acc[ai][bj][m][0], v1 = acc[ai][bj][m][1];
                    if (gate) {
#pragma unroll
                        for (int e = 0; e < 4; ++e) { v0[e] = 1.0f / (1.0f + __expf(-v0[e])); v1[e] = 1.0f / (1.0f + __expf(-v1[e])); } }
                    v4u w; w.x = cvt_pk_bf16(v0[0], v0[1]); w.y = cvt_pk_bf16(v0[2], v0[3]); w.z = cvt_pk_bf16(v1[0], v1[1]); w.w = cvt_pk_bf16(v1[2], v1[3]);
                    *(v4u*)(rowp + bj * 128) = w; } }
    }
};
struct EpiMerge {
    static constexpr bool PERM = true;
    bf16* m; const bf16* pxg;
    __device__ __forceinline__ void operator()(const f32x4 (&acc)[2][2][4][2], const Unit& u, int wr, int wc, int fr, int fq) const {
        const int row0 = u.pm * 256 + wr * 64 + fr, col0 = u.pn * 256 + wc * 32 + 8 * fq;
#pragma unroll
        for (int ai = 0; ai < 2; ++ai)
#pragma unroll
            for (int mm = 0; mm < 4; ++mm) { const size_t row = (size_t)(row0 + ai * 128 + mm * 16);
#pragma unroll
                for (int bj = 0; bj < 2; ++bj) { const f32x4 v0 = acc[ai][bj][mm][0], v1 = acc[ai][bj][mm][1];
                    const v4u g = *(const v4u*)(pxg + row * NPXG + u.br * 1024 + col0 + bj * 128);
                    bf16* mp = m + row * DM + col0 + bj * 128;
                    float o[8];
                    o[0] = v0[0] * bflo(g.x); o[1] = v0[1] * bfhi(g.x); o[2] = v0[2] * bflo(g.y); o[3] = v0[3] * bfhi(g.y);
                    o[4] = v1[0] * bflo(g.z); o[5] = v1[1] * bfhi(g.z); o[6] = v1[2] * bflo(g.w); o[7] = v1[3] * bfhi(g.w);
                    if (u.br != 0) { const v4u p = *(const v4u*)mp;
                        o[0] += bflo(p.x); o[1] += bfhi(p.x); o[2] += bflo(p.y); o[3] += bfhi(p.y); o[4] += bflo(p.z); o[5] += bfhi(p.z); o[6] += bflo(p.w); o[7] += bfhi(p.w); }
                    v4u w; w.x = cvt_pk_bf16(o[0], o[1]); w.y = cvt_pk_bf16(o[2], o[3]); w.z = cvt_pk_bf16(o[4], o[5]); w.w = cvt_pk_bf16(o[6], o[7]);
                    *(v4u*)mp = w; } }
    }
};
struct EpiRes {
    static constexpr bool PERM = false;
    const float* base_l; const float* base_c; float* out_l; float* out_c; const float* gate;
    __device__ __forceinline__ void operator()(const f32x4 (&acc)[2][2][4][2], const Unit& u, int wr, int wc, int fr, int fq) const {
        const bool isc = u.pm >= 128; const int grp = isc ? 4 : (u.pm >> 5);
        const float* base = isc ? base_c : base_l; float* out = isc ? out_c : out_l;
        const int row0 = (isc ? (u.pm - 128) : u.pm) * 256 + wr * 64 + fr, col0 = u.pn * 256 + wc * 32 + 4 * fq;
        f32x4 gv[2][2];
#pragma unroll
        for (int bj = 0; bj < 2; ++bj)
#pragma unroll
            for (int n = 0; n < 2; ++n) gv[bj][n] = *(const f32x4*)(gate + grp * NMOD + col0 + bj * 128 + n * 16);
#pragma unroll
        for (int ai = 0; ai < 2; ++ai)
#pragma unroll
            for (int m = 0; m < 4; ++m) { const size_t off = (size_t)(row0 + ai * 128 + m * 16) * DM + col0;
#pragma unroll
                for (int bj = 0; bj < 2; ++bj)
#pragma unroll
                    for (int n = 0; n < 2; ++n) { const f32x4 bs = *(const f32x4*)(base + off + bj * 128 + n * 16);
                        *(f32x4*)(out + off + bj * 128 + n * 16) = bs + gv[bj][n] * acc[ai][bj][m][n]; } }
    }
};
struct EpiAct {
    static constexpr bool PERM = true;
    bf16* a;
    __device__ __forceinline__ void operator()(const f32x4 (&acc)[2][2][4][2], const Unit& u, int wr, int wc, int fr, int fq) const {
        const int row0 = u.pm * 256 + wr * 64 + fr, col0 = u.pn * 256 + wc * 32 + 8 * fq;
#pragma unroll
        for (int ai = 0; ai < 2; ++ai)
#pragma unroll
            for (int m = 0; m < 4; ++m) { bf16* rowp = a + (size_t)(row0 + ai * 128 + m * 16) * FF + col0;
#pragma unroll
                for (int bj = 0; bj < 2; ++bj) { f32x4 v0 = acc[ai][bj][m][0], v1 = acc[ai][bj][m][1];
#pragma unroll
                    for (int e = 0; e < 4; ++e) { const float r0 = fmaxf(v0[e], 0.f), r1 = fmaxf(v1[e], 0.f); v0[e] = r0 * r0; v1[e] = r1 * r1; }
                    v4u w; w.x = cvt_pk_bf16(v0[0], v0[1]); w.y = cvt_pk_bf16(v0[2], v0[3]); w.z = cvt_pk_bf16(v1[0], v1[1]); w.w = cvt_pk_bf16(v1[2], v1[3]);
                    *(v4u*)(rowp + bj * 128) = w; } }
    }
};

constexpr int NS = 9;
constexpr int NSTEPS = 2 + 2 * NS + 1;
constexpr int LARGS_OFF = LDSCTL_OFF + 1024;
enum { A_X = 0, A_C, A_CTX, A_CCTX, A_ADAW, A_ADAB, A_N1G, A_N2G, A_WIN, A_CONVW, A_RELB, A_WF, A_WC, A_WA, A_WO, A_W1, A_W2, A_FG, A_OUT, A_WS, A_NARGS };

struct Ctx { LAS unsigned char* lds; int tid, lane, wave, G, bx, gw, NGW, gt, NGT; };
__device__ __forceinline__ unsigned long long ldarg(const Ctx& C, int i) {
    const LAS unsigned* p = (const LAS unsigned*)(C.lds + LARGS_OFF) + 2 * i;
    const unsigned lo = __builtin_amdgcn_readfirstlane(p[0]), hi = __builtin_amdgcn_readfirstlane(p[1]);
    return ((unsigned long long)hi << 32) | lo;
}
#define ARGF(i) ((const float*)(const GAS float*)ldarg(C, (i)))
#define WSP(T, off) ((T*)(GAS T*)((GAS unsigned char*)ldarg(C, A_WS) + (off)))

__device__ __forceinline__ void ph_mod_partial(const Ctx& C) {
    const float* cvec = ARGF(A_C); const float* cctx = ARGF(A_CCTX); const float* ada_w = ARGF(A_ADAW);
    float* modp = WSP(float, WS_MODP); float2* tw = WSP(float2, WS_TW);
    LAS float* sl = (LAS float*)C.lds;
    for (int item = C.bx; item < 2 * 8 * 12; item += C.G) {
        const int l = item / 96, rem = item % 96, kc = rem / 12, jb = rem % 12;
        __syncthreads();
        for (int e = C.tid; e < 5 * 128; e += NTHR) { const int g = e >> 7, k = kc * 128 + (e & 127); const float v = g < 4 ? cvec[g * DM + k] : cctx[k]; sl[e] = v / (1.0f + __expf(-v)); }
        __syncthreads();
        const int j = jb * 512 + C.tid; float a0 = 0.f, a1 = 0.f, a2 = 0.f, a3 = 0.f, a4 = 0.f;
        const float* wp = ada_w + ((size_t)l * DM + kc * 128) * NMOD + j;
#pragma unroll 4
        for (int k = 0; k < 128; ++k) { const float w = wp[(size_t)k * NMOD]; a0 += sl[k] * w; a1 += sl[128 + k] * w; a2 += sl[256 + k] * w; a3 += sl[384 + k] * w; a4 += sl[512 + k] * w; }
        float* pp = modp + ((size_t)(l * 8 + kc) * 5) * NMOD + j;
        pp[0] = a0; pp[NMOD] = a1; pp[2 * NMOD] = a2; pp[3 * NMOD] = a3; pp[4 * NMOD] = a4;
    }
    for (int m = C.gt; m < 8192; m += C.NGT) { float s, c; sincospif((float)m * (1.0f / 4096.0f), &s, &c); tw[m] = make_float2(c, s); }
}
__device__ __forceinline__ void ph_mod_reduce(const Ctx& C) {
    const float* ada_b = ARGF(A_ADAB); const float* modp = WSP(float, WS_MODP); float* mod = WSP(float, WS_MOD);
    for (int e = C.gt; e < 2 * 5 * NMOD; e += C.NGT) { const int l = e / (5 * NMOD), r = e % (5 * NMOD), j = r % NMOD; float s = ada_b[l * NMOD + j];
#pragma unroll
        for (int kc = 0; kc < 8; ++kc) s += modp[(size_t)(l * 8 + kc) * 5 * NMOD + r];
        mod[e] = s; }
}
__device__ __forceinline__ void ph_weights(const Ctx& C, int l) {
    LAS float* scr = (LAS float*)(C.lds + C.wave * 16384);
    const int lane = C.lane;
    const float* Win = ARGF(A_WIN) + (size_t)l * DM * NIN_ORIG;
    bf16* win_t = WSP(bf16, WS_WIN); bf16* wm_t = WSP(bf16, WS_WM);
    constexpr int I_IN = (DM / 64) * ((NIN_ORIG - 256) / 32), I_F = (256 / 64) * (DM / 32), I_A = (512 / 64) * (DM / 32), I_O = (DM / 64) * (DM / 32), I_1 = (DM / 64) * (FF / 32), I_2 = (FF / 64) * (DM / 32);
    constexpr int NITEMS = I_IN + 2 * I_F + I_A + I_O + I_1 + I_2;
    for (int it = C.gw; it < NITEMS; it += C.NGW) {
        int r = it;
        if (r < I_IN) { transpose_item(Win + 256, NIN_ORIG, NIN_ORIG - 256, win_t, DM, 512, 0, scr, r, lane); continue; } r -= I_IN;
        if (r < I_F) { transpose_item(ARGF(A_WF) + (size_t)l * 256 * DM, DM, DM, wm_t, DM, 0, 0, scr, r, lane); continue; } r -= I_F;
        if (r < I_F) { transpose_item(ARGF(A_WC) + (size_t)l * 256 * DM, DM, DM, wm_t, DM, 0, 256, scr, r, lane); continue; } r -= I_F;
        if (r < I_A) { transpose_item(ARGF(A_WA) + (size_t)l * 512 * DM, DM, DM, wm_t, DM, 0, 512, scr, r, lane); continue; } r -= I_A;
        if (r < I_O) { transpose_item(ARGF(A_WO) + (size_t)l * DM * DM, DM, DM, WSP(bf16, WS_WO), DM, 0, 0, scr, r, lane); continue; } r -= I_O;
        if (r < I_1) { transpose_item(ARGF(A_W1) + (size_t)l * DM * FF, FF, FF, WSP(bf16, WS_W1), DM, 0, 0, scr, r, lane); continue; } r -= I_1;
        transpose_item(ARGF(A_W2) + (size_t)l * FF * DM, DM, DM, WSP(bf16, WS_W2), FF, 0, 0, scr, r, lane);
    }
    for (int it = C.gw; it < 4 * 32; it += C.NGW) {
        const int g = it >> 5, k0 = (it & 31) * 32, kl = lane & 31, pq = lane >> 5;
        LAS float* tile = scr;
        LAS float* ct = scr + 32 * 65;
        { float s, c; sincospif((float)lane * (1.0f / 32.0f), &s, &c); ct[lane] = c; ct[64 + lane] = s; }
#pragma unroll 8
        for (int kk = 0; kk < 32; ++kk) tile[kk * 65 + lane] = Win[(size_t)(k0 + kk) * NIN_ORIG + g * 64 + lane];
        LDS_WAIT(); asm volatile("" ::: "memory");
        for (int kc = 0; kc < 64; ++kc) { float p = 0.f;
#pragma unroll 8
            for (int c = 0; c < 64; ++c) p += tile[kl * 65 + c] * ct[pq * 64 + ((c * kc) & 63)];
            win_t[(size_t)(pq * 256 + g * 64 + kc) * DM + k0 + kl] = (bf16)f2bf(p); }
        LDS_WAIT(); asm volatile("" ::: "memory");
    }
}
__device__ __forceinline__ void ph_norm(const Ctx& C, const float* xl, const float* xc, const float* gn, const float* shb  , bf16* dst) {
    const int lane = C.lane;
    for (int row = C.gw; row < MT; row += C.NGW) {
        const bool isc = row >= ML; const int grp = isc ? 4 : (row >> 13);
        const float* xr = isc ? xc + (size_t)(row - ML) * DM : xl + (size_t)row * DM;
        f32x4 v[4]; float s2 = 0.f;
#pragma unroll
        for (int j = 0; j < 4; ++j) { v[j] = *(const f32x4*)(xr + 4 * lane + 256 * j); s2 += (v[j].x * v[j].x + v[j].y * v[j].y) + (v[j].z * v[j].z + v[j].w * v[j].w); }
        const float rstd = 1.0f / sqrtf(wave_sum(s2) * (1.0f / DM) + EPS);
        const float* sh = shb + grp * NMOD; const float* sc = sh + DM;
#pragma unroll
        for (int j = 0; j < 4; ++j) { const int c0 = 4 * lane + 256 * j; const f32x4 gg = *(const f32x4*)(gn + c0), s1 = *(const f32x4*)(sc + c0), h1 = *(const f32x4*)(sh + c0);
            const f32x4 y = (v[j] * rstd * gg) * (s1 + 1.0f) + h1;
            v2u o; o.x = pk2(y.x, y.y); o.y = pk2(y.z, y.w); *(v2u*)(dst + (size_t)row * DM + c0) = o; }
    }
}
__device__ __forceinline__ void ph_mixers(const Ctx& C, int l) {
    const float2* tw = WSP(const float2, WS_TW); const bf16* pxa = WSP(const bf16, WS_PXA); bf16* mix = WSP(bf16, WS_HX);
    const int lane = C.lane;
    for (int e = C.gt; e < NB * 256 * 256; e += C.NGT) {
        const int kc = e & 255, k = (e >> 8) & 255, bb = e >> 16;
        const bf16* src = pxa + ((size_t)ML + bb * 256) * NPXA + kc; float y = 0.f;
#pragma unroll 4
        for (int n = 0; n < 256; ++n) { const float2 w = tw[((n * k) & 255) * 32]; y += bf2f(src[(size_t)n * NPXA + OFF_P]) * w.x - bf2f(src[(size_t)n * NPXA + OFF_Q]) * w.y; }
        mix[((size_t)ML + bb * 256 + k) * DM + kc] = (bf16)f2bf(y * (1.0f / 128.0f));
    }
    const float* cw = ARGF(A_CONVW) + l * 3 * 256;
    for (int e = C.gt; e < MT * 32; e += C.NGT) {
        const int row = e >> 5, ch = (e & 31) * 8;
        const int pos = row < ML ? (row & (SEQ - 1)) : ((row - ML) & 255), len = row < ML ? SEQ : 256;
        const bf16* pr = pxa + (size_t)row * NPXA;
        const v4u u1 = *(const v4u*)(pr + OFF_CU + ch), c1 = *(const v4u*)(pr + OFF_CC + ch), b1 = *(const v4u*)(pr + OFF_CB + ch);
        v4u u0 = (v4u){0, 0, 0, 0}, c0 = u0, u2 = u0, c2 = u0;
        if (pos > 0) { u0 = *(const v4u*)(pr - NPXA + OFF_CU + ch); c0 = *(const v4u*)(pr - NPXA + OFF_CC + ch); }
        if (pos < len - 1) { u2 = *(const v4u*)(pr + NPXA + OFF_CU + ch); c2 = *(const v4u*)(pr + NPXA + OFF_CC + ch); }
        float o[8];
#pragma unroll
        for (int j = 0; j < 4; ++j) {
            const unsigned a0 = u0[j], d0 = c0[j], a1 = u1[j], d1 = c1[j], a2 = u2[j], d2 = c2[j], bb = b1[j];
            const int cA = ch + 2 * j, cB = cA + 1;
            o[2 * j] = bflo(bb) * (cw[cA] * bflo(a0) * bflo(d0) + cw[256 + cA] * bflo(a1) * bflo(d1) + cw[512 + cA] * bflo(a2) * bflo(d2));
            o[2 * j + 1] = bfhi(bb) * (cw[cB] * bfhi(a0) * bfhi(d0) + cw[256 + cB] * bfhi(a1) * bfhi(d1) + cw[512 + cB] * bfhi(a2) * bfhi(d2));
        }
        v4u w; w.x = pk2(o[0], o[1]); w.y = pk2(o[2], o[3]); w.z = pk2(o[4], o[5]); w.w = pk2(o[6], o[7]);
        *(v4u*)(mix + (size_t)row * DM + 256 + ch) = w;
    }
}

typedef short bf16x8_t __attribute__((ext_vector_type(8)));
typedef short v4i16_t __attribute__((ext_vector_type(4)));
constexpr int AT_KW = 0, AT_VW = 73728, AT_BT = 147456;
__device__ __forceinline__ void attn_tile(LAS unsigned char* lds, const int (&ka)[2][2], const int (&va)[2][4], int rowoff, const bf16x8_t (&qf)[2],
                                          const LAS float* brow  , const int (&dc)[2][4], unsigned vmask, f32x4 (&o)[4], float& m, float& l) {
    constexpr float SC = 0.18033688011112042f;
    f32x4 s[2];
#pragma unroll
    for (int t = 0; t < 2; ++t) { s[t] = (f32x4){0.f, 0.f, 0.f, 0.f};
#pragma unroll
        for (int ks = 0; ks < 2; ++ks) { const bf16x8_t kf = *(const LAS bf16x8_t*)(lds + ka[t][ks] + rowoff); s[t] = __builtin_amdgcn_mfma_f32_16x16x32_bf16(kf, qf[ks], s[t], 0, 0, 0); } }
    float tmax = -1e30f;
#pragma unroll
    for (int t = 0; t < 2; ++t)
#pragma unroll
        for (int i = 0; i < 4; ++i) { float v = s[t][i] * SC; if (brow) { v += brow[dc[t][i]]; if (!((vmask >> (t * 4 + i)) & 1u)) v = -1e30f; } s[t][i] = v; tmax = fmaxf(tmax, v); }
    tmax = fmaxf(tmax, __shfl_xor(tmax, 16)); tmax = fmaxf(tmax, __shfl_xor(tmax, 32));
    const float mn = fmaxf(m, tmax), alpha = __builtin_amdgcn_exp2f(m - mn); m = mn;
    float ps = 0.f;
#pragma unroll
    for (int t = 0; t < 2; ++t)
#pragma unroll
        for (int i = 0; i < 4; ++i) { const float p = __builtin_amdgcn_exp2f(s[t][i] - mn); s[t][i] = p; ps += p; }
    l = l * alpha + ps;
    v4u pw; pw.x = pg8::cvt_pk_bf16(s[0][0], s[0][1]); pw.y = pg8::cvt_pk_bf16(s[0][2], s[0][3]); pw.z = pg8::cvt_pk_bf16(s[1][0], s[1][1]); pw.w = pg8::cvt_pk_bf16(s[1][2], s[1][3]);
    const bf16x8_t pf = __builtin_bit_cast(bf16x8_t, pw);
#pragma unroll
    for (int db = 0; db < 4; ++db) {
        const v4i16_t lo = __builtin_amdgcn_ds_read_tr16_b64_v4i16((LAS v4i16_t*)(lds + va[0][db] + rowoff));
        const v4i16_t hi = __builtin_amdgcn_ds_read_tr16_b64_v4i16((LAS v4i16_t*)(lds + va[1][db] + rowoff));
        const bf16x8_t vf = (bf16x8_t){lo[0], lo[1], lo[2], lo[3], hi[0], hi[1], hi[2], hi[3]};
        o[db] = o[db] * alpha;
        o[db] = __builtin_amdgcn_mfma_f32_16x16x32_bf16(vf, pf, o[db], 0, 0, 0);
    }
}
__device__ __forceinline__ void attn_addr(int kc0off, int li, int fq, int (&ka)[2][2], int (&va)[2][4]) {
#pragma unroll
    for (int t = 0; t < 2; ++t) {
        const int rk = kc0off + 16 * t + li;
#pragma unroll
        for (int ks = 0; ks < 2; ++ks) ka[t][ks] = AT_KW + rk * 128 + (((4 * ks + fq) ^ ((rk >> 1) & 7)) * 16);
        const int rv = kc0off + 16 * t + 4 * fq + (li >> 2), p = li & 3;
#pragma unroll
        for (int db = 0; db < 4; ++db) va[t][db] = AT_VW + rv * 128 + (((2 * db + (p >> 1)) ^ (((rv >> 1) & 3) << 1)) * 16) + (p & 1) * 8;
    }
}

__device__ __forceinline__ size_t zt_off(int b) { return b < 2 ? WS_TB + (size_t)b * 8 * MiB : (b == 2 ? (size_t)502 * MiB : WS_WIN); }
__device__ __forceinline__ void ph_t1(const Ctx& C) {
    const bf16* pxa = WSP(const bf16, WS_PXA); const int lane = C.lane;
    LAS unsigned short* tile = (LAS unsigned short*)(C.lds + C.wave * 9216);
    for (int it = C.gw; it < 4 * 2 * 128 * 4; it += C.NGW) {
        const int kcb = it & 3, n2 = (it >> 2) & 127, pq = (it >> 9) & 1, b = it >> 10;
#pragma unroll
        for (int i = 0; i < 8; ++i) { const int q = i * 64 + lane, n1 = q >> 3, cc = q & 7;
            const v4u v = *(const v4u*)(pxa + ((size_t)b * SEQ + n1 * 128 + n2) * NPXA + pq * 256 + kcb * 64 + cc * 8);
            *(LAS v4u*)(tile + n1 * 72 + cc * 8) = v; }
        LDS_WAIT(); asm volatile("" ::: "memory");
        bf16* zt = WSP(bf16, zt_off(b)) + ((size_t)(pq * 256 + kcb * 64 + lane) * SEQ + n2 * 64);
#pragma unroll
        for (int c = 0; c < 8; ++c) { v4u o;
            o.x = (unsigned)tile[(8 * c + 0) * 72 + lane] | ((unsigned)tile[(8 * c + 1) * 72 + lane] << 16); o.y = (unsigned)tile[(8 * c + 2) * 72 + lane] | ((unsigned)tile[(8 * c + 3) * 72 + lane] << 16);
            o.z = (unsigned)tile[(8 * c + 4) * 72 + lane] | ((unsigned)tile[(8 * c + 5) * 72 + lane] << 16); o.w = (unsigned)tile[(8 * c + 6) * 72 + lane] | ((unsigned)tile[(8 * c + 7) * 72 + lane] << 16);
            *(v4u*)(zt + 8 * c) = o; }
        LDS_WAIT(); asm volatile("" ::: "memory");
    }
}
typedef float f32x16 __attribute__((ext_vector_type(16)));
constexpr int FT_C64 = 0, FT_S64 = 9216, FT_C128 = 18432, FT_S128 = FT_C128 + 34816, FT_TW = FT_S128 + 34816;
static_assert(FT_TW + 65536 <= LDSCTL_OFF, "fft lds");
__device__ __forceinline__ int crow16(int r, int h) { return (r & 3) + 8 * (r >> 2) + 4 * h; }
__device__ __forceinline__ void ph_fft(const Ctx& C) {
    LAS unsigned char* lds = C.lds; const int tid = C.tid, lane = C.lane, w = C.wave, h = lane >> 5, c = lane & 31;
    const float2* tw = WSP(const float2, WS_TW); bf16* mix = WSP(bf16, WS_HX);
    { LAS float* twl = (LAS float*)(lds + FT_TW);
      for (int m = tid; m < 8192; m += NTHR) { const float2 v = tw[m]; twl[2 * m] = v.x; twl[2 * m + 1] = v.y; }
      LAS unsigned short* c64 = (LAS unsigned short*)(lds + FT_C64); LAS unsigned short* s64 = (LAS unsigned short*)(lds + FT_S64);
      for (int e = tid; e < 4096; e += NTHR) { const int k1 = e >> 6, n1 = e & 63; const float2 v = tw[((n1 * k1) & 63) * 128]; c64[k1 * 72 + n1] = (unsigned short)f2bf(v.x); s64[k1 * 72 + n1] = (unsigned short)f2bf(v.y); }
      LAS unsigned short* c128 = (LAS unsigned short*)(lds + FT_C128); LAS unsigned short* s128 = (LAS unsigned short*)(lds + FT_S128);
      for (int e = tid; e < 16384; e += NTHR) { const int k2 = e >> 7, p = e & 127, q = p & 15, n2 = (p & ~15) + (q & 3) + ((q >> 2) & 1) * 8 + ((q >> 3) & 1) * 4;
          const float2 v = tw[((n2 * k2) & 127) * 64]; c128[k2 * 136 + p] = (unsigned short)f2bf(v.x); s128[k2 * 136 + p] = (unsigned short)f2bf(v.y); }
    }
    __syncthreads();
    const int kb = w >> 2, k1 = 32 * kb + c;
    for (int sq = C.bx * 4 + (w & 3); sq < NB * 256; sq += C.G * 4) {
        const int b = sq >> 8, kc = sq & 255;
        const bf16* zp = WSP(const bf16, zt_off(b)) + (size_t)kc * SEQ; const bf16* zq = zp + (size_t)256 * SEQ;
        f32x16 acc[4];
#pragma unroll
        for (int rb2 = 0; rb2 < 4; ++rb2) acc[rb2] = (f32x16){};
#pragma unroll 1
        for (int rb = 0; rb < 4; ++rb) {
            const int n2 = 32 * rb + c;
            f32x16 xr = {}, xi = {};
#pragma unroll
            for (int ks = 0; ks < 4; ++ks) {
                const bf16x8_t cf = *(const LAS bf16x8_t*)(lds + FT_C64 + (k1 * 72 + 16 * ks + 8 * h) * 2), sf = *(const LAS bf16x8_t*)(lds + FT_S64 + (k1 * 72 + 16 * ks + 8 * h) * 2);
                const bf16x8_t pf = *(const bf16x8_t*)(zp + n2 * 64 + 16 * ks + 8 * h), qf = *(const bf16x8_t*)(zq + n2 * 64 + 16 * ks + 8 * h);
                const v4u t = __builtin_bit_cast(v4u, qf) ^ 0x80008000u; const bf16x8_t qn = __builtin_bit_cast(bf16x8_t, t);
                xr = __builtin_amdgcn_mfma_f32_32x32x16_bf16(pf, cf, xr, 0, 0, 0); xi = __builtin_amdgcn_mfma_f32_32x32x16_bf16(pf, sf, xi, 0, 0, 0);
                xi = __builtin_amdgcn_mfma_f32_32x32x16_bf16(qf, cf, xi, 0, 0, 0); xr = __builtin_amdgcn_mfma_f32_32x32x16_bf16(qn, sf, xr, 0, 0, 0); }
            bf16x8_t bre[2], bim[2];
            const LAS float* twb = (const LAS float*)(lds + FT_TW) + 2 * ((32 * rb + 4 * h) * k1);
#pragma unroll
            for (int sblk = 0; sblk < 2; ++sblk) {
                float tr[8], ti[8];
#pragma unroll
                for (int r8 = 0; r8 < 8; ++r8) { const int r = 8 * sblk + r8; const LAS float* t = twb + 2 * (crow16(r, 0) * k1); const float tc = t[0], ts = t[1];
                    tr[r8] = xr[r] * tc - xi[r] * ts; ti[r8] = -(xr[r] * ts + xi[r] * tc); }
                v4u a, bq;
                a.x = pg8::cvt_pk_bf16(tr[0], tr[1]); a.y = pg8::cvt_pk_bf16(tr[2], tr[3]); a.z = pg8::cvt_pk_bf16(tr[4], tr[5]); a.w = pg8::cvt_pk_bf16(tr[6], tr[7]);
                bq.x = pg8::cvt_pk_bf16(ti[0], ti[1]); bq.y = pg8::cvt_pk_bf16(ti[2], ti[3]); bq.z = pg8::cvt_pk_bf16(ti[4], ti[5]); bq.w = pg8::cvt_pk_bf16(ti[6], ti[7]);
                bre[sblk] = __builtin_bit_cast(bf16x8_t, a); bim[sblk] = __builtin_bit_cast(bf16x8_t, bq); }
#pragma unroll
            for (int rb2 = 0; rb2 < 4; ++rb2) {
                const int k2 = 32 * rb2 + c;
#pragma unroll
                for (int sblk = 0; sblk < 2; ++sblk) {
                    const bf16x8_t ac = *(const LAS bf16x8_t*)(lds + FT_C128 + (k2 * 136 + 32 * rb + 16 * sblk + 8 * h) * 2), as = *(const LAS bf16x8_t*)(lds + FT_S128 + (k2 * 136 + 32 * rb + 16 * sblk + 8 * h) * 2);
                    acc[rb2] = __builtin_amdgcn_mfma_f32_32x32x16_bf16(ac, bre[sblk], acc[rb2], 0, 0, 0); acc[rb2] = __builtin_amdgcn_mfma_f32_32x32x16_bf16(as, bim[sblk], acc[rb2], 0, 0, 0); }
            }
        }
        bf16* op = mix + ((size_t)b * SEQ + k1 + 256 * h) * DM + kc;
#pragma unroll
        for (int rb2 = 0; rb2 < 4; ++rb2)
#pragma unroll
            for (int r = 0; r < 16; ++r) op[(size_t)(64 * (32 * rb2 + crow16(r, 0))) * DM] = (bf16)f2bf(acc[rb2][r] * 0.001381067932f);
    }
}
__device__ __forceinline__ void ph_attn(const Ctx& C, int l) {
    const bf16* pxa = WSP(const bf16, WS_PXA); bf16* mix = WSP(bf16, WS_HX);
    const float* rb = ARGF(A_RELB) + (size_t)l * 8 * 15 * 31;
    LAS unsigned char* lds = C.lds; LAS float* biasT = (LAS float*)(lds + AT_BT);
    const int lane = C.lane, w = C.wave, fq = lane >> 4, li = lane & 15, tid = C.tid;
    const int nunits = 2048 + (l == 0 ? 64 : 0);
    for (int u = C.bx; u < nunits; u += C.G) {
        const bool isc = u >= 2048;
        int b, h, rp; if (!isc) { b = u >> 9; h = (u >> 6) & 7; rp = u & 63; } else { const int v = u - 2048; b = v >> 4; h = (v >> 1) & 7; rp = v & 1; }
        __syncthreads();
        for (int e = tid; e < 465; e += NTHR) biasT[e] = rb[h * 465 + e] * 1.4426950408889634f;
        const int R0 = min(max(2 * rp - 4, 0), 120);
        if (!isc) {
            for (int p = w; p < 72; p += 8) {
                const int tokl = p * 8 + (lane >> 3), lr = tokl >> 6, col = tokl & 63, gr = min(R0 + lr, 127), cp = lane & 7;
                const bf16* src = pxa + ((size_t)b * SEQ + gr * 64 + col) * NPXA + h * 64;
                __builtin_amdgcn_global_load_lds((const unsigned*)(src + OFF_K + ((cp ^ ((tokl >> 1) & 7)) * 8)), (LAS unsigned*)(lds + AT_KW + p * 1024), 16, 0, 0);
                __builtin_amdgcn_global_load_lds((const unsigned*)(src + OFF_V + ((cp ^ (((tokl >> 1) & 3) << 1)) * 8)), (LAS unsigned*)(lds + AT_VW + p * 1024), 16, 0, 0);
            }
        }
        int r = 0, qc = 0; size_t token;
        if (!isc) { r = 2 * rp + (w >> 2); qc = 16 * (w & 3) + li; token = (size_t)b * SEQ + r * 64 + qc; }
        else token = (size_t)ML + b * 256 + rp * 128 + 16 * w + li;
        bf16x8_t qf[2];
#pragma unroll
        for (int ks = 0; ks < 2; ++ks) qf[ks] = *(const bf16x8_t*)(pxa + token * NPXA + OFF_QQ + h * 64 + 32 * ks + 8 * fq);
        f32x4 o[4]; float m = -1e30f, lsum = 0.f;
#pragma unroll
        for (int db = 0; db < 4; ++db) o[db] = (f32x4){0.f, 0.f, 0.f, 0.f};
        int ka[2][2], va[2][4], dc[2][4];
        asm volatile("s_waitcnt vmcnt(0)" ::: "memory");
        __syncthreads();
        if (!isc) {
            const int cb = w & 3, kc0 = cb == 0 ? 0 : cb == 1 ? 8 : cb == 2 ? 24 : 32;
            attn_addr(kc0, li, fq, ka, va);
            const int csq = min(max(qc - 8, 0), 48); unsigned vmask = 0u;
#pragma unroll
            for (int t = 0; t < 2; ++t)
#pragma unroll
                for (int i = 0; i < 4; ++i) { const int kcol = kc0 + 16 * t + 4 * fq + i; if (kcol >= csq && kcol < csq + 16) vmask |= 1u << (t * 4 + i); dc[t][i] = min(max(kcol - qc + 15, 0), 30); }
            const int rsr = min(max(r - 4, 0), 120), lr0 = rsr - R0;
            for (int j = 0; j < 8; ++j) {
                const int dr = rsr + j - r + 7;
                attn_tile(lds, ka, va, (lr0 + j) * 8192, qf, biasT + dr * 31, dc, vmask, o, m, lsum);
            }
        }
        __syncthreads();
        for (int p = w; p < 32; p += 8) {
            const int tokl = p * 8 + (lane >> 3), cp = lane & 7;
            const bf16* src = pxa + ((size_t)ML + b * 256 + tokl) * NPXA + h * 64;
            __builtin_amdgcn_global_load_lds((const unsigned*)(src + OFF_K + ((cp ^ ((tokl >> 1) & 7)) * 8)), (LAS unsigned*)(lds + AT_KW + p * 1024), 16, 0, 0);
            __builtin_amdgcn_global_load_lds((const unsigned*)(src + OFF_V + ((cp ^ (((tokl >> 1) & 3) << 1)) * 8)), (LAS unsigned*)(lds + AT_VW + p * 1024), 16, 0, 0);
        }
        attn_addr(0, li, fq, ka, va);
        asm volatile("s_waitcnt vmcnt(0)" ::: "memory");
        __syncthreads();
        for (int ct = 0; ct < 8; ++ct) attn_tile(lds, ka, va, ct * 4096, qf, (const LAS float*)nullptr, dc, 0xffu, o, m, lsum);
        lsum += __shfl_xor(lsum, 16); lsum += __shfl_xor(lsum, 32);
        const float inv = 1.0f / lsum;
        bf16* op = mix + token * DM + 512 + h * 64 + 4 * fq;
#pragma unroll
        for (int db = 0; db < 4; ++db) { v2u ov; ov.x = pk2(o[db][0] * inv, o[db][1] * inv); ov.y = pk2(o[db][2] * inv, o[db][3] * inv); *(v2u*)(op + 16 * db) = ov; }
    }
}
__device__ __forceinline__ void ph_final(const Ctx& C) {
    float* out = (float*)(GAS float*)ldarg(C, A_OUT); const float* fg = ARGF(A_FG); const int lane = C.lane;
    for (int row = C.gw; row < ML; row += C.NGW) {
        float* xr = out + (size_t)row * DM;
        f32x4 v[4]; float s2 = 0.f;
#pragma unroll
        for (int j = 0; j < 4; ++j) { v[j] = *(const f32x4*)(xr + 4 * lane + 256 * j); s2 += (v[j].x * v[j].x + v[j].y * v[j].y) + (v[j].z * v[j].z + v[j].w * v[j].w); }
        const float rstd = 1.0f / sqrtf(wave_sum(s2) * (1.0f / DM) + EPS);
#pragma unroll
        for (int j = 0; j < 4; ++j) { const int c0 = 4 * lane + 256 * j; const f32x4 gg = *(const f32x4*)(fg + c0); *(f32x4*)(xr + c0) = v[j] * rstd * gg; }
    }
}

struct Args { const void* p[A_NARGS]; int ph_lo, ph_hi; };

__global__ void __launch_bounds__(NTHR, 2) fwd_kernel(Args args) {
    extern __shared__ __attribute__((aligned(16))) unsigned char lds_raw[];
    Ctx C;
    C.lds = (LAS unsigned char*)lds_raw;
    C.tid = threadIdx.x; C.lane = C.tid & 63; C.wave = __builtin_amdgcn_readfirstlane(C.tid >> 6);
    C.G = gridDim.x; C.bx = blockIdx.x;
    C.gw = C.bx * NWAVES + C.wave; C.NGW = C.G * NWAVES; C.gt = C.bx * NTHR + C.tid; C.NGT = C.G * NTHR;
    for (int u = C.tid; u < (LDS_BYTES - LDSCTL_OFF) / 4; u += NTHR) ((LAS unsigned*)(C.lds + LDSCTL_OFF))[u] = 0u;
    __syncthreads();
    if (C.tid < A_NARGS) ((LAS unsigned long long*)(C.lds + LARGS_OFF))[C.tid] = (unsigned long long)args.p[C.tid];
    __syncthreads();
    volatile LAS unsigned* MISC = (volatile LAS unsigned*)(C.lds + MISC_OFF);
    gu32* ctl = (gu32*)WSP(unsigned, WS_CTL);
    XcdBarrier bar; bar.bar = (unsigned*)(ctl + CW_BAR); bar.x = 0; bar.st = nullptr;
    if (!MK_MULTI) bar = xcd_barrier_post((unsigned*)(ctl + CW_BAR), MISC + 8);
    const int lo = args.ph_lo, hi = args.ph_hi;

    const Ctx C0 = C;
    for (int step = lo; step < hi; ++step) {
        Ctx C = C0;
        asm volatile("" : "+v"(C.tid), "+v"(C.lane), "+v"(C.gt), "+s"(C.wave), "+s"(C.bx), "+s"(C.G), "+s"(C.gw), "+s"(C.NGW), "+s"(C.NGT));
        const int ls = step - 2, l = ls >= NS ? 1 : 0, k = (step < 2) ? -1 - step : (step == NSTEPS - 1 ? 100 : ls - l * NS);
        if (k == -1) ph_mod_partial(C);
        else if (k == -2) ph_mod_reduce(C);
        else if (k == 0) {
            ph_weights(C, l);
            const float* modl = WSP(const float, WS_MOD) + (size_t)l * 5 * NMOD;
            ph_norm(C, l == 0 ? ARGF(A_X) : ARGF(A_OUT), l == 0 ? ARGF(A_CTX) : WSP(const float, WS_CTXX), ARGF(A_N1G) + l * DM, modl, WSP(bf16, WS_HX));
        } else if (k == 1) {
            pg8::Prob<false> P{WSP(const bf16, WS_HX), WSP(const bf16, WS_WIN), DM, DM, DM}; pg8::StaticOrder<1> S; S.init(MT, NIN, C.G, C.bx);
            EpiIn E{WSP(bf16, WS_PXA), WSP(bf16, WS_PXG)};
            pg8::gemm_phase(C.lds, P, S, E);
        } else if (k == 2) {
            ph_t1(C); ph_mixers(C, l); ph_attn(C, l);
        } else if (k == 3) {
            ph_fft(C);
        } else if (k == 4) {
            pg8::Prob<true> P{WSP(const bf16, WS_HX), WSP(const bf16, WS_WM), DM, DM, DM}; pg8::StaticOrder<3> S; S.init(MT, DM, C.G, C.bx);
            EpiMerge E{WSP(bf16, WS_M), WSP(const bf16, WS_PXG)};
            pg8::gemm_phase(C.lds, P, S, E);
        } else if (k == 5) {
            pg8::Prob<false> P{WSP(const bf16, WS_M), WSP(const bf16, WS_WO), DM, DM, DM}; pg8::StaticOrder<1> S; S.init(MT, DM, C.G, C.bx);
            EpiRes E{l == 0 ? ARGF(A_X) : ARGF(A_OUT), l == 0 ? ARGF(A_CTX) : WSP(const float, WS_CTXX), (float*)(GAS float*)ldarg(C, A_OUT), WSP(float, WS_CTXX), WSP(const float, WS_MOD) + (size_t)l * 5 * NMOD + 2 * DM};
            pg8::gemm_phase(C.lds, P, S, E);
        } else if (k == 6) {
            const float* modl = WSP(const float, WS_MOD) + (size_t)l * 5 * NMOD;
            ph_norm(C, ARGF(A_OUT), WSP(const float, WS_CTXX), ARGF(A_N2G) + l * DM, modl + 3 * DM, WSP(bf16, WS_HX));
        } else if (k == 7) {
            pg8::Prob<false> P{WSP(const bf16, WS_HX), WSP(const bf16, WS_W1), DM, DM, DM}; pg8::StaticOrder<1> S; S.init(MT, FF, C.G, C.bx);
            EpiAct E{WSP(bf16, WS_ACT)};
            pg8::gemm_phase(C.lds, P, S, E);
        } else if (k == 8) {
            pg8::Prob<false> P{WSP(const bf16, WS_ACT), WSP(const bf16, WS_W2), FF, FF, FF}; pg8::StaticOrder<1> S; S.init(MT, DM, C.G, C.bx);
            EpiRes E{ARGF(A_OUT), WSP(const float, WS_CTXX), (float*)(GAS float*)ldarg(C, A_OUT), WSP(float, WS_CTXX), WSP(const float, WS_MOD) + (size_t)l * 5 * NMOD + 5 * DM};
            pg8::gemm_phase(C.lds, P, S, E);
        } else ph_final(C);
        if (step + 1 < hi) { if (MK_MULTI) { if (C.tid == 0) __hip_atomic_store(ctl + CW_TMO, 0xBADu, RLX_AGENT); } else xcd_barrier(bar); }
    }
}

extern "C" void kernel_launch(void* const* d_in, const int* in_sizes, int n_in, void* d_out, int out_size, void* d_ws, size_t ws_size, hipStream_t stream) {
    static int grid = 0;
    if (grid == 0) {
        if (n_in != 18 || out_size != ML * DM || ws_size < WS_END) { fprintf(stderr, "kernel_launch: unexpected shapes (n_in %d out %d ws %zu)\n", n_in, out_size, ws_size); grid = -1; return; }
        int dev = 0, cus = 0;
        if (hipGetDevice(&dev) != hipSuccess || hipDeviceGetAttribute(&cus, hipDeviceAttributeMultiprocessorCount, dev) != hipSuccess) { grid = -1; return; }
        if (hipFuncSetAttribute((const void*)fwd_kernel, hipFuncAttributeMaxDynamicSharedMemorySize, LDS_BYTES) != hipSuccess) { fprintf(stderr, "kernel_launch: hipFuncSetAttribute failed\n"); grid = -1; return; }
        int per_cu = 0;
        if (hipOccupancyMaxActiveBlocksPerMultiprocessor(&per_cu, (const void*)fwd_kernel, NTHR, LDS_BYTES) != hipSuccess || per_cu < 1) fprintf(stderr, "kernel_launch: occupancy query reports %d\n", per_cu);
        (void)hipGetLastError();
        grid = cus;
    }
    if (grid < 0) return;
    (void)hipMemsetAsync((char*)d_ws + WS_CTL, 0, CTL_ZERO_BYTES, stream);
    Args a{};
    for (int i = 0; i < 18; ++i) a.p[i] = d_in[i];
    a.p[A_OUT] = d_out; a.p[A_WS] = d_ws;
#if MK_MULTI
    for (int s = 0; s < NSTEPS; ++s) { a.ph_lo = s; a.ph_hi = s + 1; hipLaunchKernelGGL(fwd_kernel, dim3(grid), dim3(NTHR), LDS_BYTES, stream, a); }
#else
    a.ph_lo = 0; a.ph_hi = NSTEPS; hipLaunchKernelGGL(fwd_kernel, dim3(grid), dim3(NTHR), LDS_BYTES, stream, a);
#endif
}
```

```cpp
#include <hip/hip_runtime.h>
#include <cstdio>
#include <cstdint>

#ifndef PROBE_K
#define PROBE_K -99
#define PROBE_N 1
#define PROBE_SUB 7
#endif
#ifndef MK_MULTI
#define MK_MULTI 0
#endif

namespace pg8 {
#define PG8_LAS __attribute__((address_space(3)))
typedef unsigned short bf16_t;
typedef short bf16x8 __attribute__((ext_vector_type(8)));
typedef float f32x4 __attribute__((ext_vector_type(4)));
typedef unsigned u32x4 __attribute__((ext_vector_type(4)));
constexpr int BM = 256, BK = 64, HALF = 128, HTB = HALF * BK * 2, STAGE_BYTES = 8 * HTB, NXCD = 8, WGM = 8;

__host__ __device__ __forceinline__ int lds_byte(int r, int c) { const int st = (r >> 4) * 2 + (c >> 5), rr = r & 15, cc = c & 31, ob = rr * 64 + cc * 2; return st * 1024 + (ob ^ (((ob >> 9) & 1) << 5)); }
__host__ __device__ __forceinline__ void stage_rc(int b, int& R, int& C) { const int st = b / 1024, sb = b % 1024, swz = sb ^ (((sb >> 9) & 1) << 5); R = (st >> 1) * 16 + swz / 64; C = (st & 1) * 32 + (swz % 64) / 2; }
__host__ __device__ __forceinline__ int perm32(int rho) { const int n = rho >> 4, i = rho & 15; return 8 * (i >> 2) + 4 * n + (i & 3); }

struct Unit { int pm, pn, br; };

template <int REP> struct StaticOrder {
    int nM, nN, nwg, G, c;
    __device__ void init(int M, int N, int G_, int c_) { nM = M / BM; nN = N / BM; nwg = nM * nN; G = G_; c = c_; }
    __device__ __forceinline__ bool next(int i, Unit& u) const {
        const int it = i / REP; u.br = i - it * REP;
        const long L = (long)it * G + c; if (L >= nwg) return false;
        int wgid = (int)L; { const int q = nwg / NXCD, r = nwg % NXCD, xcd = wgid % NXCD, off = wgid / NXCD; wgid = (xcd < r ? xcd * (q + 1) : r * (q + 1) + (xcd - r) * q) + off; }
        const int nig = WGM * nN, gid = wgid / nig, fm = gid * WGM, gsz = (nM - fm) < WGM ? (nM - fm) : WGM;
        u.pm = fm + ((wgid % nig) % gsz); u.pn = (wgid % nig) / gsz; return true;
    }
};

template <bool MERGE> struct Prob {
    const bf16_t* A; const bf16_t* Bt; int lda, ldb, K;
    __device__ __forceinline__ int nt(const Unit& u) const { if (MERGE) return u.br == 2 ? 8 : 4; return K / BK; }
    __device__ __forceinline__ int koff(const Unit& u) const { if (MERGE) return u.br * 256; return 0; }
    __device__ __forceinline__ const char* a(const Unit& u) const { return (const char*)(A + (size_t)u.pm * BM * lda + koff(u)); }
    __device__ __forceinline__ const char* b(const Unit& u) const { return (const char*)(Bt + (size_t)u.pn * BM * ldb + koff(u)); }
};

__device__ __forceinline__ unsigned cvt_pk_bf16(float lo, float hi) { unsigned r; asm volatile("v_cvt_pk_bf16_f32 %0, %1, %2" : "=v"(r) : "v"(lo), "v"(hi)); return r; }

template <class Epi, class Sched, class PROB>
__device__ __forceinline__ void gemm_phase(PG8_LAS unsigned char* lds, const PROB P, const Sched& S, const Epi& E) {
    int tid = threadIdx.x; asm volatile("" : "+v"(tid));
    const int wid = __builtin_amdgcn_readfirstlane(tid >> 6), lane = tid & 63, wr = wid >> 2, wc = wid & 3, fr = lane & 15, fq = lane >> 4;
    unsigned voffA[2], voffB[2];
#pragma unroll
    for (int i = 0; i < 2; ++i) { int R, C; stage_rc(tid * 16 + i * 8192, R, C); const int Rb = Epi::PERM ? ((R & ~31) + perm32(R & 31)) : R;
        voffA[i] = (unsigned)(R * P.lda + C) * 2u; voffB[i] = (unsigned)(Rb * P.ldb + C) * 2u; }
    const size_t kstep = (size_t)(BK * 2);
    const size_t hstepA = (size_t)HALF * P.lda * 2, hstepB = (size_t)HALF * P.ldb * 2;
    const unsigned ldsw = (unsigned)wid * 1024u;
    const int aoff = lds_byte(wr * 64 + fr, fq * 8), boff = lds_byte(wc * 32 + fr, fq * 8);
#define PG8_SA(b, h) (((b) * 2 + (h)) * HTB)
#define PG8_SB(b, h) ((4 + (b) * 2 + (h)) * HTB)
#define PG8_STAGE(bufoff, gbase, voff) do { _Pragma("unroll") for (int _i = 0; _i < 2; ++_i) \
        __builtin_amdgcn_global_load_lds((const unsigned*)((const char*)(gbase) + (voff)[_i]), (PG8_LAS unsigned*)(lds + (bufoff) + ldsw + _i * 8192), 16, 0, 0); } while (0)
#define PG8_LDA(dst, b, h) do { _Pragma("unroll") for (int m = 0; m < 4; ++m) _Pragma("unroll") for (int k = 0; k < 2; ++k) dst[m][k] = *(const PG8_LAS bf16x8*)(lds + PG8_SA(b, h) + aoff + m * 2048 + k * 1024); } while (0)
#define PG8_LDB(dst, b, h) do { _Pragma("unroll") for (int n = 0; n < 2; ++n) _Pragma("unroll") for (int k = 0; k < 2; ++k) dst[n][k] = *(const PG8_LAS bf16x8*)(lds + PG8_SB(b, h) + boff + n * 2048 + k * 1024); } while (0)
#define PG8_MMA(ai, bj, At, Bt) do { __builtin_amdgcn_s_setprio(1); _Pragma("unroll") for (int m = 0; m < 4; ++m) _Pragma("unroll") for (int n = 0; n < 2; ++n) _Pragma("unroll") for (int k = 0; k < 2; ++k) \
        acc[ai][bj][m][n] = __builtin_amdgcn_mfma_f32_16x16x32_bf16(Bt[n][k], At[m][k], acc[ai][bj][m][n], 0, 0, 0); __builtin_amdgcn_s_setprio(0); } while (0)
#define PG8_WAIT_V(n) asm volatile("s_waitcnt vmcnt(" #n ")" ::: "memory")
#define PG8_WAIT_L(n) asm volatile("s_waitcnt lgkmcnt(" #n ")" ::: "memory")
#define PG8_BAR __builtin_amdgcn_s_barrier()
#define PG8_SCHED __builtin_amdgcn_sched_barrier(0)
    Unit cur, nxt; int ui = 0;
    if (!S.next(0, cur)) return;
    f32x4 acc[2][2][4][2];
#pragma unroll
    for (int a = 0; a < 2; ++a)
#pragma unroll
        for (int b = 0; b < 2; ++b)
#pragma unroll
            for (int m = 0; m < 4; ++m)
#pragma unroll
                for (int n = 0; n < 2; ++n) acc[a][b][m][n] = (f32x4){0.f, 0.f, 0.f, 0.f};
    bf16x8 At[4][2], B0[2][2], B1[2][2];
    const char* cA = P.a(cur); const char* cB = P.b(cur);
    PG8_STAGE(PG8_SB(0, 0), cB, voffB); PG8_STAGE(PG8_SB(0, 1), cB + hstepB, voffB); PG8_STAGE(PG8_SA(0, 0), cA, voffA); PG8_STAGE(PG8_SA(0, 1), cA + hstepA, voffA);
    if (wr == 1) PG8_BAR;
    PG8_WAIT_V(2); PG8_BAR;
    PG8_STAGE(PG8_SB(1, 0), cB + kstep, voffB); PG8_STAGE(PG8_SA(1, 0), cA + kstep, voffA); PG8_STAGE(PG8_SB(1, 1), cB + hstepB + kstep, voffB);
    PG8_WAIT_V(6); PG8_BAR;
    for (;;) {
        const bool has_next = S.next(ui + 1, nxt);
        const char* nA = has_next ? P.a(nxt) : cA; const char* nB = has_next ? P.b(nxt) : cB;
        const int nt = P.nt(cur);
        for (int t = 0; t < nt; t += 2) {
            const bool last = (t == nt - 2);
            const char* a1 = cA + (size_t)(t + 1) * kstep;
            const char* a2 = last ? nA : cA + (size_t)(t + 2) * kstep; const char* b2 = last ? nB : cB + (size_t)(t + 2) * kstep;
            const char* a3 = a2 + kstep; const char* b3 = b2 + kstep;
            PG8_LDB(B0, 0, 0); PG8_LDB(B1, 0, 1); PG8_SCHED; PG8_LDA(At, 0, 0); PG8_STAGE(PG8_SA(1, 1), a1 + hstepA, voffA);
            PG8_WAIT_V(8); PG8_WAIT_L(0); PG8_BAR; PG8_MMA(0, 0, At, B0); PG8_MMA(0, 1, At, B1); PG8_BAR; PG8_SCHED;
            PG8_LDA(At, 0, 1); PG8_STAGE(PG8_SB(0, 0), b2, voffB); PG8_STAGE(PG8_SB(0, 1), b2 + hstepB, voffB); PG8_STAGE(PG8_SA(0, 0), a2, voffA);
            PG8_WAIT_V(8); PG8_WAIT_L(0); PG8_BAR; PG8_MMA(1, 0, At, B0); PG8_MMA(1, 1, At, B1); PG8_BAR; PG8_SCHED;
            PG8_LDB(B0, 1, 0); PG8_LDB(B1, 1, 1); PG8_SCHED; PG8_LDA(At, 1, 0); PG8_STAGE(PG8_SA(0, 1), a2 + hstepA, voffA);
            PG8_WAIT_V(8); PG8_WAIT_L(0); PG8_BAR; PG8_MMA(0, 0, At, B0); PG8_MMA(0, 1, At, B1); PG8_BAR; PG8_SCHED;
            PG8_LDA(At, 1, 1); PG8_STAGE(PG8_SB(1, 0), b3, voffB); PG8_STAGE(PG8_SB(1, 1), b3 + hstepB, voffB); PG8_STAGE(PG8_SA(1, 0), a3, voffA);
            PG8_WAIT_V(8); PG8_WAIT_L(0); PG8_BAR; PG8_MMA(1, 0, At, B0); PG8_MMA(1, 1, At, B1); PG8_BAR; PG8_SCHED;
        }
        if (wr == 0) PG8_BAR;
        E(acc, cur, wr, wc, fr, fq);
        if (!has_next) break;
#pragma unroll
        for (int a = 0; a < 2; ++a)
#pragma unroll
            for (int b = 0; b < 2; ++b)
#pragma unroll
                for (int m = 0; m < 4; ++m)
#pragma unroll
                    for (int n = 0; n < 2; ++n) acc[a][b][m][n] = (f32x4){0.f, 0.f, 0.f, 0.f};
        cur = nxt; cA = nA; cB = nB; ++ui;
        if (wr == 1) PG8_BAR;
    }
    PG8_WAIT_V(0);
    PG8_BAR;
#undef PG8_SA
#undef PG8_SB
#undef PG8_STAGE
#undef PG8_LDA
#undef PG8_LDB
#undef PG8_MMA
#undef PG8_WAIT_V
#undef PG8_WAIT_L
#undef PG8_BAR
#undef PG8_SCHED
}
}

constexpr int NWAVES = 8, NTHR = 512;
constexpr int DM = 1024, NB = 4, SEQ = 8192, ML = NB * SEQ, CTXL = 256, MC = NB * CTXL, MT = ML + MC;
constexpr int NIN_ORIG = 5632, NPXA = 2816, NPXG = 3072, NIN = NPXA + NPXG;
constexpr int OFF_P = 0, OFF_Q = 256, OFF_CU = 512, OFF_CB = 768, OFF_CC = 1024, OFF_QQ = 1280, OFF_K = 1792, OFF_V = 2304;
constexpr int FF = 4096, NMOD = 6 * DM, NGRP = 5;
constexpr float EPS = 1e-6f;

constexpr size_t MiB = 1u << 20;
constexpr size_t WS_CTL = 0, CTL_ZERO_BYTES = 1 * MiB;
constexpr size_t WS_TW = 1 * MiB;
constexpr size_t WS_MOD = 1 * MiB + 65536;
constexpr size_t WS_MODP = 2 * MiB;
constexpr size_t WS_CTXX = 4 * MiB;
constexpr size_t WS_WIN = 8 * MiB, WS_WM = 20 * MiB, WS_WO = 22 * MiB, WS_W1 = 24 * MiB, WS_W2 = 32 * MiB;
constexpr size_t WS_HX = 40 * MiB;
constexpr size_t WS_PXA = 106 * MiB;
constexpr size_t WS_PXG = 288 * MiB;
constexpr size_t WS_TB = 486 * MiB;
constexpr size_t WS_M = WS_PXA;
constexpr size_t WS_ACT = WS_PXA;
constexpr size_t WS_END = 510 * MiB;
static_assert(WS_PXA + (size_t)MT * NPXA * 2 <= WS_PXG && WS_PXG + (size_t)MT * NPXG * 2 <= WS_TB && WS_ACT + (size_t)MT * FF * 2 <= WS_TB && WS_HX + (size_t)MT * DM * 2 <= WS_PXA, "ws map");
constexpr int CW_TMO = 0, CW_BAR = 4096;

constexpr int RING_BYTES = 131072, LDSCTL_OFF = 155648, MISC_OFF = LDSCTL_OFF + 320, LDS_BYTES = 163840;

#define GAS __attribute__((address_space(1)))
#define LAS __attribute__((address_space(3)))
typedef unsigned short bf16;
typedef unsigned v4u __attribute__((ext_vector_type(4)));
typedef unsigned v2u __attribute__((ext_vector_type(2)));
typedef float f32x4 __attribute__((ext_vector_type(4)));
typedef GAS unsigned gu32;
#define RLX_AGENT __ATOMIC_RELAXED, __HIP_MEMORY_SCOPE_AGENT
#define LDS_WAIT() asm volatile("s_waitcnt lgkmcnt(0)" ::: "memory")
__device__ __forceinline__ unsigned f2bf(float f) { unsigned u = __builtin_bit_cast(unsigned, f); return (u + 0x7fffu + ((u >> 16) & 1u)) >> 16; }
__device__ __forceinline__ unsigned pk2(float lo, float hi) { return f2bf(lo) | (f2bf(hi) << 16); }
__device__ __forceinline__ float bf2f(unsigned h) { return __uint_as_float(h << 16); }
__device__ __forceinline__ float bflo(unsigned w) { return __uint_as_float(w << 16); }
__device__ __forceinline__ float bfhi(unsigned w) { return __uint_as_float(w & 0xffff0000u); }

#define XB_TMO      128
#define XB_XCNT(j)  (256  + 64 * (j))
#define XB_XSUB(j)  (1280 + 64 * (j))
#define XB_XGEN(j)  (2304 + 64 * (j))
#define XB_TOP      3328
#define XB_TOPGEN   3392
#define XCD_BAR_WORDS 3456
#define XB_SPIN_CAP (1u << 22)
__device__ __forceinline__ unsigned xb_ld(unsigned* p)              { return __hip_atomic_load(p, __ATOMIC_RELAXED, __HIP_MEMORY_SCOPE_AGENT); }
__device__ __forceinline__ unsigned xb_add(unsigned* p, unsigned v) { return __hip_atomic_fetch_add(p, v, __ATOMIC_RELAXED, __HIP_MEMORY_SCOPE_AGENT); }
__device__ __forceinline__ unsigned xb_xcc_id() { return (unsigned)__builtin_amdgcn_s_getreg((3 << 11) | 20) & 0xFu; }
#define XB_SPIN(cond, bar) do { unsigned _sp = 0; while (cond) { __builtin_amdgcn_s_sleep(1); \
    if ((++_sp & 255u) == 0u) { if (xb_ld(&(bar)[XB_TMO])) break; if (_sp > XB_SPIN_CAP) { atomicAdd(&(bar)[XB_TMO], 1u); break; } } } } while (0)
struct XcdBarrier { unsigned* bar; unsigned x; volatile LAS unsigned* st; };
__device__ __forceinline__ XcdBarrier xcd_barrier_post(unsigned* bar, volatile LAS unsigned* st) {
    XcdBarrier b; b.bar = bar; b.x = xb_xcc_id(); b.st = st;
    if (threadIdx.x == 0) (void)xb_add(&bar[XB_XCNT(b.x)], 1u);
    return b;
}
__device__ __forceinline__ void xcd_barrier_complete(unsigned* bar, unsigned x, unsigned& nloc, unsigned& nx) {
    const unsigned G = gridDim.x * gridDim.y * gridDim.z;
    unsigned sum, cnt, mine, sp = 0u;
    for (;;) {
        sum = 0u; cnt = 0u; mine = 0u;
#pragma unroll
        for (unsigned j = 0; j < 16; ++j) { const unsigned c = xb_ld(&bar[XB_XCNT(j)]); sum += c; cnt += (c > 0u) ? 1u : 0u; mine = (j == x) ? c : mine; }
        if (sum == G) break;
        __builtin_amdgcn_s_sleep(1);
        if ((++sp & 255u) == 0u) { if (xb_ld(&bar[XB_TMO])) break; if (sp > XB_SPIN_CAP) { atomicAdd(&bar[XB_TMO], 1u); break; } }
    }
    nloc = mine > 0u ? mine : 1u; nx = cnt > 0u ? cnt : 1u;
}
__device__ __forceinline__ void xcd_barrier(const XcdBarrier& b) {
    asm volatile("s_waitcnt vmcnt(0)" ::: "memory");
    __syncthreads();
    if (threadIdx.x == 0) {
        unsigned* bar = b.bar;
        __builtin_amdgcn_s_waitcnt(0);
        unsigned nloc = b.st[0], nx = b.st[1];
        if (nloc == 0u) { xcd_barrier_complete(bar, b.x, nloc, nx); b.st[0] = nloc; b.st[1] = nx; }
        const unsigned old = xb_add(&bar[XB_XSUB(b.x)], 1u);
        const unsigned gen = old / nloc;
        if (old + 1u == (gen + 1u) * nloc) {
            __builtin_amdgcn_fence(__ATOMIC_RELEASE, "agent");
            asm volatile("s_waitcnt vmcnt(0)" ::: "memory");
            const unsigned og = xb_add(&bar[XB_TOP], 1u);
            const unsigned tg = og / nx;
            if (og + 1u == (tg + 1u) * nx) xb_add(&bar[XB_TOPGEN], 1u);
            else XB_SPIN(xb_ld(&bar[XB_TOPGEN]) == tg, bar);
            __builtin_amdgcn_fence(__ATOMIC_ACQUIRE, "agent");
            xb_add(&bar[XB_XGEN(b.x)], 1u);
            asm volatile("s_waitcnt vmcnt(0)" ::: "memory");
        } else {
            XB_SPIN(xb_ld(&bar[XB_XGEN(b.x)]) == gen, bar);
            __builtin_amdgcn_fence(__ATOMIC_ACQUIRE, "agent");
            asm volatile("s_waitcnt vmcnt(0)" ::: "memory");
        }
    }
    __syncthreads();
}

__device__ __forceinline__ float wave_sum(float v) {
#pragma unroll
    for (int o = 1; o < 64; o <<= 1) v += __shfl_xor(v, o);
    return v;
}
__device__ __forceinline__ float wave_max(float v) {
#pragma unroll
    for (int o = 1; o < 64; o <<= 1) v = fmaxf(v, __shfl_xor(v, o));
    return v;
}

__device__ __forceinline__ void transpose_item(const float* W, int ldw, int ncols, bf16* WT, int ldwt, int row_off, int k_off, LAS float* scr, int item, int lane) {
    const int nblk = ncols / 32, kb = item / nblk, nb = item % nblk, k0 = 64 * kb, n0 = 32 * nb;
#pragma unroll 8
    for (int i = 0; i < 32; ++i) { const int kk = 2 * i + (lane >> 5); scr[kk * 33 + (lane & 31)] = W[(size_t)(k0 + kk) * ldw + n0 + (lane & 31)]; }
    LDS_WAIT(); asm volatile("" ::: "memory");
    const int c = lane & 7;
#pragma unroll
    for (int j = 0; j < 4; ++j) { const int n = (lane >> 3) + 8 * j; const LAS float* s = scr + (8 * c) * 33 + n;
        v4u o; o.x = pk2(s[0 * 33], s[1 * 33]); o.y = pk2(s[2 * 33], s[3 * 33]); o.z = pk2(s[4 * 33], s[5 * 33]); o.w = pk2(s[6 * 33], s[7 * 33]);
        *(v4u*)(WT + (size_t)(row_off + n0 + n) * ldwt + k_off + k0 + 8 * c) = o; }
    LDS_WAIT(); asm volatile("" ::: "memory");
}

using pg8::Unit; using pg8::cvt_pk_bf16;
struct EpiIn {
    static constexpr bool PERM = true;
    bf16* pxa; bf16* pxg;
    __device__ __forceinline__ void operator()(const f32x4 (&acc)[2][2][4][2], const Unit& u, int wr, int wc, int fr, int fq) const {
        const bool gate = u.pn >= 11; bf16* base = gate ? pxg : pxa; const int ldc = gate ? NPXG : NPXA; const int colt = (gate ? u.pn - 11 : u.pn) * 256;
        const int row0 = u.pm * 256 + wr * 64 + fr, col0 = colt + wc * 32 + 8 * fq;
#pragma unroll
        for (int ai = 0; ai < 2; ++ai)
#pragma unroll
            for (int m = 0; m < 4; ++m) { bf16* rowp = base + (size_t)(row0 + ai * 128 + m * 16) * ldc + col0;
#pragma unroll
                for (int bj = 0; bj < 2; ++bj) { f32x4 v0 = acc[ai][bj][m][0], v1 = acc[ai][bj][m][1];
                    if (gate) {
#pragma unroll
                        for (int e = 0; e < 4; ++e) { v0[e] = 1.0f / (1.0f + __expf(-v0[e])); v1[e] = 1.0f / (1.0f + __expf(-v1[e])); } }
                    v4u w; w.x = cvt_pk_bf16(v0[0], v0[1]); w.y = cvt_pk_bf16(v0[2], v0[3]); w.z = cvt_pk_bf16(v1[0], v1[1]); w.w = cvt_pk_bf16(v1[2], v1[3]);
                    *(v4u*)(rowp + bj * 128) = w; } }
    }
};
struct EpiMerge {
    static constexpr bool PERM = true;
    bf16* m; const bf16* pxg;
    __device__ __forceinline__ void operator()(const f32x4 (&acc)[2][2][4][2], const Unit& u, int wr, int wc, int fr, int fq) const {
        const int row0 = u.pm * 256 + wr * 64 + fr, col0 = u.pn * 256 + wc * 32 + 8 * fq;
#pragma unroll
        for (int ai = 0; ai < 2; ++ai)
#pragma unroll
            for (int mm = 0; mm < 4; ++mm) { const size_t row = (size_t)(row0 + ai * 128 + mm * 16);
#pragma unroll
                for (int bj = 0; bj < 2; ++bj) { const f32x4 v0 = acc[ai][bj][mm][0], v1 = acc[ai][bj][mm][1];
                    const v4u g = *(const v4u*)(pxg + row * NPXG + u.br * 1024 + col0 + bj * 128);
                    bf16* mp = m + row * DM + col0 + bj * 128;
                    float o[8];
                    o[0] = v0[0] * bflo(g.x); o[1] = v0[1] * bfhi(g.x); o[2] = v0[2] * bflo(g.y); o[3] = v0[3] * bfhi(g.y);
                    o[4] = v1[0] * bflo(g.z); o[5] = v1[1] * bfhi(g.z); o[6] = v1[2] * bflo(g.w); o[7] = v1[3] * bfhi(g.w);
                    if (u.br != 0) { const v4u p = *(const v4u*)mp;
                        o[0] += bflo(p.x); o[1] += bfhi(p.x); o[2] += bflo(p.y); o[3] += bfhi(p.y); o[4] += bflo(p.z); o[5] += bfhi(p.z); o[6] += bflo(p.w); o[7] += bfhi(p.w); }
                    v4u w; w.x = cvt_pk_bf16(o[0], o[1]); w.y = cvt_pk_bf16(o[2], o[3]); w.z = cvt_pk_bf16(o[4], o[5]); w.w = cvt_pk_bf16(o[6], o[7]);
                    *(v4u*)mp = w; } }
    }
};
struct EpiRes {
    static constexpr bool PERM = false;
    const float* base_l; const float* base_c; float* out_l; float* out_c; const float* gate;
    __device__ __forceinline__ void operator()(const f32x4 (&acc)[2][2][4][2], const Unit& u, int wr, int wc, int fr, int fq) const {
        const bool isc = u.pm >= 128; const int grp = isc ? 4 : (u.pm >> 5);
        const float* base = isc ? base_c : base_l; float* out = isc ? out_c : out_l;
        const int row0 = (isc ? (u.pm - 128) : u.pm) * 256 + wr * 64 + fr, col0 = u.pn * 256 + wc * 32 + 4 * fq;
        f32x4 gv[2][2];
#pragma unroll
        for (int bj = 0; bj < 2; ++bj)
#pragma unroll
            for (int n = 0; n < 2; ++n) gv[bj][n] = *(const f32x4*)(gate + grp * NMOD + col0 + bj * 128 + n * 16);
#pragma unroll
        for (int ai = 0; ai < 2; ++ai)
#pragma unroll
            for (int m = 0; m < 4; ++m) { const size_t off = (size_t)(row0 + ai * 128 + m * 16) * DM + col0;
#pragma unroll
                for (int bj = 0; bj < 2; ++bj)
#pragma unroll
                    for (int n = 0; n < 2; ++n) { const f32x4 bs = *(const f32x4*)(base + off + bj * 128 + n * 16);
                        *(f32x4*)(out + off + bj * 128 + n * 16) = bs + gv[bj][n] * acc[ai][bj][m][n]; } }
    }
};
struct EpiAct {
    static constexpr bool PERM = true;
    bf16* a;
    __device__ __forceinline__ void operator()(const f32x4 (&acc)[2][2][4][2], const Unit& u, int wr, int wc, int fr, int fq) const {
        const int row0 = u.pm * 256 + wr * 64 + fr, col0 = u.pn * 256 + wc * 32 + 8 * fq;
#pragma unroll
        for (int ai = 0; ai < 2; ++ai)
#pragma unroll
            for (int m = 0; m < 4; ++m) { bf16* rowp = a + (size_t)(row0 + ai * 128 + m * 16) * FF + col0;
#pragma unroll
                for (int bj = 0; bj < 2; ++bj) { f32x4 v0 = acc[ai][bj][m][0], v1 = acc[ai][bj][m][1];
#pragma unroll
                    for (int e = 0; e < 4; ++e) { const float r0 = fmaxf(v0[e], 0.f), r1 = fmaxf(v1[e], 0.f); v0[e] = r0 * r0; v1[e] = r1 * r1; }
                    v4u w; w.x = cvt_pk_bf16(v0[0], v0[1]); w.y = cvt_pk_bf16(v0[2], v0[3]); w.z = cvt_pk_bf16(v1[0], v1[1]); w.w = cvt_pk_bf16(v1[2], v1[3]);
                    *(v4u*)(rowp + bj * 128) = w; } }
    }
};

constexpr int NS = 9;
constexpr int NSTEPS = 2 + 2 * NS + 1;
constexpr int LARGS_OFF = LDSCTL_OFF + 1024;
enum { A_X = 0, A_C, A_CTX, A_CCTX, A_ADAW, A_ADAB, A_N1G, A_N2G, A_WIN, A_CONVW, A_RELB, A_WF, A_WC, A_WA, A_WO, A_W1, A_W2, A_FG, A_OUT, A_WS, A_NARGS };

struct Ctx { LAS unsigned char* lds; int tid, lane, wave, G, bx, gw, NGW, gt, NGT; };
__device__ __forceinline__ unsigned long long ldarg(const Ctx& C, int i) {
    const LAS unsigned* p = (const LAS unsigned*)(C.lds + LARGS_OFF) + 2 * i;
    const unsigned lo = __builtin_amdgcn_readfirstlane(p[0]), hi = __builtin_amdgcn_readfirstlane(p[1]);
    return ((unsigned long long)hi << 32) | lo;
}
#define ARGF(i) ((const float*)(const GAS float*)ldarg(C, (i)))
#define WSP(T, off) ((T*)(GAS T*)((GAS unsigned char*)ldarg(C, A_WS) + (off)))

__device__ __forceinline__ void ph_mod_partial(const Ctx& C) {
    const float* cvec = ARGF(A_C); const float* cctx = ARGF(A_CCTX); const float* ada_w = ARGF(A_ADAW);
    float* modp = WSP(float, WS_MODP); float2* tw = WSP(float2, WS_TW);
    LAS float* sl = (LAS float*)C.lds;
    for (int item = C.bx; item < 2 * 8 * 12; item += C.G) {
        const int l = item / 96, rem = item % 96, kc = rem / 12, jb = rem % 12;
        __syncthreads();
        for (int e = C.tid; e < 5 * 128; e += NTHR) { const int g = e >> 7, k = kc * 128 + (e & 127); const float v = g < 4 ? cvec[g * DM + k] : cctx[k]; sl[e] = v / (1.0f + __expf(-v)); }
        __syncthreads();
        const int j = jb * 512 + C.tid; float a0 = 0.f, a1 = 0.f, a2 = 0.f, a3 = 0.f, a4 = 0.f;
        const float* wp = ada_w + ((size_t)l * DM + kc * 128) * NMOD + j;
#pragma unroll 4
        for (int k = 0; k < 128; ++k) { const float w = wp[(size_t)k * NMOD]; a0 += sl[k] * w; a1 += sl[128 + k] * w; a2 += sl[256 + k] * w; a3 += sl[384 + k] * w; a4 += sl[512 + k] * w; }
        float* pp = modp + ((size_t)(l * 8 + kc) * 5) * NMOD + j;
        pp[0] = a0; pp[NMOD] = a1; pp[2 * NMOD] = a2; pp[3 * NMOD] = a3; pp[4 * NMOD] = a4;
    }
    for (int m = C.gt; m < 8192; m += C.NGT) { float s, c; sincospif((float)m * (1.0f / 4096.0f), &s, &c); tw[m] = make_float2(c, s); }
}
__device__ __forceinline__ void ph_mod_reduce(const Ctx& C) {
    const float* ada_b = ARGF(A_ADAB); const float* modp = WSP(float, WS_MODP); float* mod = WSP(float, WS_MOD);
    for (int e = C.gt; e < 2 * 5 * NMOD; e += C.NGT) { const int l = e / (5 * NMOD), r = e % (5 * NMOD), j = r % NMOD; float s = ada_b[l * NMOD + j];
#pragma unroll
        for (int kc = 0; kc < 8; ++kc) s += modp[(size_t)(l * 8 + kc) * 5 * NMOD + r];
        mod[e] = s; }
}
__device__ __forceinline__ void ph_weights(const Ctx& C, int l) {
    LAS float* scr = (LAS float*)(C.lds + C.wave * 16384);
    const int lane = C.lane;
    const float* Win = ARGF(A_WIN) + (size_t)l * DM * NIN_ORIG;
    bf16* win_t = WSP(bf16, WS_WIN); bf16* wm_t = WSP(bf16, WS_WM);
    constexpr int I_IN = (DM / 64) * ((NIN_ORIG - 256) / 32), I_F = (256 / 64) * (DM / 32), I_A = (512 / 64) * (DM / 32), I_O = (DM / 64) * (DM / 32), I_1 = (DM / 64) * (FF / 32), I_2 = (FF / 64) * (DM / 32);
    constexpr int NITEMS = I_IN + 2 * I_F + I_A + I_O + I_1 + I_2;
    for (int it = C.gw; it < NITEMS; it += C.NGW) {
        int r = it;
        if (r < I_IN) { transpose_item(Win + 256, NIN_ORIG, NIN_ORIG - 256, win_t, DM, 512, 0, scr, r, lane); continue; } r -= I_IN;
        if (r < I_F) { transpose_item(ARGF(A_WF) + (size_t)l * 256 * DM, DM, DM, wm_t, DM, 0, 0, scr, r, lane); continue; } r -= I_F;
        if (r < I_F) { transpose_item(ARGF(A_WC) + (size_t)l * 256 * DM, DM, DM, wm_t, DM, 0, 256, scr, r, lane); continue; } r -= I_F;
        if (r < I_A) { transpose_item(ARGF(A_WA) + (size_t)l * 512 * DM, DM, DM, wm_t, DM, 0, 512, scr, r, lane); continue; } r -= I_A;
        if (r < I_O) { transpose_item(ARGF(A_WO) + (size_t)l * DM * DM, DM, DM, WSP(bf16, WS_WO), DM, 0, 0, scr, r, lane); continue; } r -= I_O;
        if (r < I_1) { transpose_item(ARGF(A_W1) + (size_t)l * DM * FF, FF, FF, WSP(bf16, WS_W1), DM, 0, 0, scr, r, lane); continue; } r -= I_1;
        transpose_item(ARGF(A_W2) + (size_t)l * FF * DM, DM, DM, WSP(bf16, WS_W2), FF, 0, 0, scr, r, lane);
    }
    for (int it = C.gw; it < 4 * 32; it += C.NGW) {
        const int g = it >> 5, k0 = (it & 31) * 32, kl = lane & 31, pq = lane >> 5;
        LAS float* tile = scr;
        LAS float* ct = scr + 32 * 65;
        { float s, c; sincospif((float)lane * (1.0f / 32.0f), &s, &c); ct[lane] = c; ct[64 + lane] = s; }
#pragma unroll 8
        for (int kk = 0; kk < 32; ++kk) tile[kk * 65 + lane] = Win[(size_t)(k0 + kk) * NIN_ORIG + g * 64 + lane];
        LDS_WAIT(); asm volatile("" ::: "memory");
        for (int kc = 0; kc < 64; ++kc) { float p = 0.f;
#pragma unroll 8
            for (int c = 0; c < 64; ++c) p += tile[kl * 65 + c] * ct[pq * 64 + ((c * kc) & 63)];
            win_t[(size_t)(pq * 256 + g * 64 + kc) * DM + k0 + kl] = (bf16)f2bf(p); }
        LDS_WAIT(); asm volatile("" ::: "memory");
    }
}
__device__ __forceinline__ void ph_norm(const Ctx& C, const float* xl, const float* xc, const float* gn, const float* shb  , bf16* dst, int nrows) {
    const int lane = C.lane;
    for (int row = C.gw; row < nrows; row += C.NGW) {
        const bool isc = row >= ML; const int grp = isc ? 4 : (row >> 13);
        const float* xr = isc ? xc + (size_t)(row - ML) * DM : xl + (size_t)row * DM;
        f32x4 v[4]; float s2 = 0.f;
#pragma unroll
        for (int j = 0; j < 4; ++j) { v[j] = *(const f32x4*)(xr + 4 * lane + 256 * j); s2 += (v[j].x * v[j].x + v[j].y * v[j].y) + (v[j].z * v[j].z + v[j].w * v[j].w); }
        const float rstd = 1.0f / sqrtf(wave_sum(s2) * (1.0f / DM) + EPS);
        const float* sh = shb + grp * NMOD; const float* sc = sh + DM;
#pragma unroll
        for (int j = 0; j < 4; ++j) { const int c0 = 4 * lane + 256 * j; const f32x4 gg = *(const f32x4*)(gn + c0), s1 = *(const f32x4*)(sc + c0), h1 = *(const f32x4*)(sh + c0);
            const f32x4 y = (v[j] * rstd * gg) * (s1 + 1.0f) + h1;
            v2u o; o.x = pk2(y.x, y.y); o.y = pk2(y.z, y.w); *(v2u*)(dst + (size_t)row * DM + c0) = o; }
    }
}
__device__ __forceinline__ void ph_mixers(const Ctx& C, int l) {
    const float2* tw = WSP(const float2, WS_TW); const bf16* pxa = WSP(const bf16, WS_PXA); bf16* mix = WSP(bf16, WS_HX);
    const int lane = C.lane;
    if (l == 0) {
        for (int it = C.gw; it < NB * 4 * 128; it += C.NGW) {
            const int kp = it & 127, kcb = (it >> 7) & 3, bb = it >> 9, k0 = 2 * kp, kc = kcb * 64 + lane;
            const bf16* src = pxa + ((size_t)ML + bb * 256) * NPXA + kc; float y0 = 0.f, y1 = 0.f;
#pragma unroll 8
            for (int n = 0; n < 256; ++n) { const float p = bf2f(src[(size_t)n * NPXA + OFF_P]), q = bf2f(src[(size_t)n * NPXA + OFF_Q]);
                const float2 w0 = tw[((n * k0) & 255) * 32], w1 = tw[((n * (k0 + 1)) & 255) * 32];
                y0 += p * w0.x - q * w0.y; y1 += p * w1.x - q * w1.y; }
            mix[((size_t)ML + bb * 256 + k0) * DM + kc] = (bf16)f2bf(y0 * (1.0f / 128.0f));
            mix[((size_t)ML + bb * 256 + k0 + 1) * DM + kc] = (bf16)f2bf(y1 * (1.0f / 128.0f));
        }
    }
    const float* cw = ARGF(A_CONVW) + l * 3 * 256;
    const int nrows = l == 0 ? MT : ML;
    for (int e = C.gt; e < nrows * 32; e += C.NGT) {
        const int row = e >> 5, ch = (e & 31) * 8;
        const int pos = row < ML ? (row & (SEQ - 1)) : ((row - ML) & 255), len = row < ML ? SEQ : 256;
        const bf16* pr = pxa + (size_t)row * NPXA;
        const v4u u1 = *(const v4u*)(pr + OFF_CU + ch), c1 = *(const v4u*)(pr + OFF_CC + ch), b1 = *(const v4u*)(pr + OFF_CB + ch);
        v4u u0 = (v4u){0, 0, 0, 0}, c0 = u0, u2 = u0, c2 = u0;
        if (pos > 0) { u0 = *(const v4u*)(pr - NPXA + OFF_CU + ch); c0 = *(const v4u*)(pr - NPXA + OFF_CC + ch); }
        if (pos < len - 1) { u2 = *(const v4u*)(pr + NPXA + OFF_CU + ch); c2 = *(const v4u*)(pr + NPXA + OFF_CC + ch); }
        float o[8]; float w0[8], w1[8], w2[8];
        { const f32x4 t0 = *(const f32x4*)(cw + ch), t1 = *(const f32x4*)(cw + ch + 4), t2 = *(const f32x4*)(cw + 256 + ch), t3 = *(const f32x4*)(cw + 256 + ch + 4), t4 = *(const f32x4*)(cw + 512 + ch), t5 = *(const f32x4*)(cw + 512 + ch + 4);
#pragma unroll
          for (int j = 0; j < 4; ++j) { w0[j] = t0[j]; w0[4 + j] = t1[j]; w1[j] = t2[j]; w1[4 + j] = t3[j]; w2[j] = t4[j]; w2[4 + j] = t5[j]; } }
#pragma unroll
        for (int j = 0; j < 4; ++j) {
            const unsigned a0 = u0[j], d0 = c0[j], a1 = u1[j], d1 = c1[j], a2 = u2[j], d2 = c2[j], bb = b1[j];
            o[2 * j] = bflo(bb) * (w0[2 * j] * bflo(a0) * bflo(d0) + w1[2 * j] * bflo(a1) * bflo(d1) + w2[2 * j] * bflo(a2) * bflo(d2));
            o[2 * j + 1] = bfhi(bb) * (w0[2 * j + 1] * bfhi(a0) * bfhi(d0) + w1[2 * j + 1] * bfhi(a1) * bfhi(d1) + w2[2 * j + 1] * bfhi(a2) * bfhi(d2));
        }
        v4u w; w.x = pk2(o[0], o[1]); w.y = pk2(o[2], o[3]); w.z = pk2(o[4], o[5]); w.w = pk2(o[6], o[7]);
        *(v4u*)(mix + (size_t)row * DM + 256 + ch) = w;
    }
}

typedef short bf16x8_t __attribute__((ext_vector_type(8)));
typedef short v4i16_t __attribute__((ext_vector_type(4)));
constexpr int AT_KW = 0, AT_VW = 73728, AT_BT = 147456;
__device__ __forceinline__ void attn_tile(LAS unsigned char* lds, const int (&ka)[2][2], const int (&va)[2][4], int rowoff, const bf16x8_t (&qf)[2],
                                          const LAS float* brow  , const int (&dc)[2][4], unsigned vmask, f32x4 (&o)[4], float& m, float& l) {
    constexpr float SC = 0.18033688011112042f;
    f32x4 s[2];
#pragma unroll
    for (int t = 0; t < 2; ++t) { s[t] = (f32x4){0.f, 0.f, 0.f, 0.f};
#pragma unroll
        for (int ks = 0; ks < 2; ++ks) { const bf16x8_t kf = *(const LAS bf16x8_t*)(lds + ka[t][ks] + rowoff); s[t] = __builtin_amdgcn_mfma_f32_16x16x32_bf16(kf, qf[ks], s[t], 0, 0, 0); } }
    float tmax = -1e30f;
#pragma unroll
    for (int t = 0; t < 2; ++t)
#pragma unroll
        for (int i = 0; i < 4; ++i) { float v = s[t][i] * SC; if (brow) { v += brow[dc[t][i]]; if (!((vmask >> (t * 4 + i)) & 1u)) v = -1e30f; } s[t][i] = v; tmax = fmaxf(tmax, v); }
    tmax = fmaxf(tmax, __shfl_xor(tmax, 16)); tmax = fmaxf(tmax, __shfl_xor(tmax, 32));
    const float mn = fmaxf(m, tmax), alpha = __builtin_amdgcn_exp2f(m - mn); m = mn;
    float ps = 0.f;
#pragma unroll
    for (int t = 0; t < 2; ++t)
#pragma unroll
        for (int i = 0; i < 4; ++i) { const float p = __builtin_amdgcn_exp2f(s[t][i] - mn); s[t][i] = p; ps += p; }
    l = l * alpha + ps;
    v4u pw; pw.x = pg8::cvt_pk_bf16(s[0][0], s[0][1]); pw.y = pg8::cvt_pk_bf16(s[0][2], s[0][3]); pw.z = pg8::cvt_pk_bf16(s[1][0], s[1][1]); pw.w = pg8::cvt_pk_bf16(s[1][2], s[1][3]);
    const bf16x8_t pf = __builtin_bit_cast(bf16x8_t, pw);
#pragma unroll
    for (int db = 0; db < 4; ++db) {
        const v4i16_t lo = __builtin_amdgcn_ds_read_tr16_b64_v4i16((LAS v4i16_t*)(lds + va[0][db] + rowoff));
        const v4i16_t hi = __builtin_amdgcn_ds_read_tr16_b64_v4i16((LAS v4i16_t*)(lds + va[1][db] + rowoff));
        const bf16x8_t vf = (bf16x8_t){lo[0], lo[1], lo[2], lo[3], hi[0], hi[1], hi[2], hi[3]};
        o[db] = o[db] * alpha;
        o[db] = __builtin_amdgcn_mfma_f32_16x16x32_bf16(vf, pf, o[db], 0, 0, 0);
    }
}
__device__ __forceinline__ void attn_addr(int kc0off, int li, int fq, int (&ka)[2][2], int (&va)[2][4]) {
#pragma unroll
    for (int t = 0; t < 2; ++t) {
        const int rk = kc0off + 16 * t + li;
#pragma unroll
        for (int ks = 0; ks < 2; ++ks) ka[t][ks] = AT_KW + rk * 128 + (((4 * ks + fq) ^ ((rk >> 1) & 7)) * 16);
        const int rv = kc0off + 16 * t + 4 * fq + (li >> 2), p = li & 3;
#pragma unroll
        for (int db = 0; db < 4; ++db) va[t][db] = AT_VW + rv * 128 + (((2 * db + (p >> 1)) ^ (((rv >> 1) & 3) << 1)) * 16) + (p & 1) * 8;
    }
}

__device__ __forceinline__ size_t zt_off(int b) { return b < 2 ? WS_TB + (size_t)b * 8 * MiB : (b == 2 ? (size_t)502 * MiB : WS_WIN); }
__device__ __forceinline__ void ph_t1(const Ctx& C) {
    const bf16* pxa = WSP(const bf16, WS_PXA); const int lane = C.lane;
    LAS unsigned short* tile = (LAS unsigned short*)(C.lds + C.wave * 9216);
    for (int it = C.gw; it < 4 * 2 * 128 * 4; it += C.NGW) {
        const int kcb = it & 3, n2 = (it >> 2) & 127, pq = (it >> 9) & 1, b = it >> 10;
#pragma unroll
        for (int i = 0; i < 8; ++i) { const int q = i * 64 + lane, n1 = q >> 3, cc = q & 7;
            const v4u v = *(const v4u*)(pxa + ((size_t)b * SEQ + n1 * 128 + n2) * NPXA + pq * 256 + kcb * 64 + cc * 8);
            *(LAS v4u*)(tile + n1 * 72 + cc * 8) = v; }
        LDS_WAIT(); asm volatile("" ::: "memory");
        bf16* zt = WSP(bf16, zt_off(b)) + ((size_t)(pq * 256 + kcb * 64 + lane) * SEQ + n2 * 64);
#pragma unroll
        for (int c = 0; c < 8; ++c) { v4u o;
            o.x = (unsigned)tile[(8 * c + 0) * 72 + lane] | ((unsigned)tile[(8 * c + 1) * 72 + lane] << 16); o.y = (unsigned)tile[(8 * c + 2) * 72 + lane] | ((unsigned)tile[(8 * c + 3) * 72 + lane] << 16);
            o.z = (unsigned)tile[(8 * c + 4) * 72 + lane] | ((unsigned)tile[(8 * c + 5) * 72 + lane] << 16); o.w = (unsigned)tile[(8 * c + 6) * 72 + lane] | ((unsigned)tile[(8 * c + 7) * 72 + lane] << 16);
            *(v4u*)(zt + 8 * c) = o; }
        LDS_WAIT(); asm volatile("" ::: "memory");
    }
}
typedef float f32x16 __attribute__((ext_vector_type(16)));
constexpr int FT_C64 = 0, FT_S64 = 9216, FT_C128 = 18432, FT_S128 = FT_C128 + 34816, FT_TA = FT_S128 + 34816, FT_TR = FT_TA + 4096, FT_ST = FT_TR + 8192;
static_assert(FT_ST + 32768 <= LDSCTL_OFF, "fft lds");
__device__ __forceinline__ int crow16(int r, int h) { return (r & 3) + 8 * (r >> 2) + 4 * h; }
__device__ __forceinline__ void ph_fft(const Ctx& C) {
    LAS unsigned char* lds = C.lds; const int tid = C.tid, lane = C.lane, w = C.wave, h = lane >> 5, c = lane & 31;
    const float2* tw = WSP(const float2, WS_TW); bf16* mix = WSP(bf16, WS_HX);
    { LAS unsigned short* c64 = (LAS unsigned short*)(lds + FT_C64); LAS unsigned short* s64 = (LAS unsigned short*)(lds + FT_S64);
#pragma unroll 8
      for (int e = tid; e < 4096; e += NTHR) { const int k1 = e >> 6, n1 = e & 63; const float2 v = tw[((n1 * k1) & 63) * 128]; c64[k1 * 72 + n1] = (unsigned short)f2bf(v.x); s64[k1 * 72 + n1] = (unsigned short)f2bf(v.y); }
      LAS unsigned short* c128 = (LAS unsigned short*)(lds + FT_C128); LAS unsigned short* s128 = (LAS unsigned short*)(lds + FT_S128);
#pragma unroll 8
      for (int e = tid; e < 16384; e += NTHR) { const int k2 = e >> 7, p = e & 127, q = p & 15, n2 = (p & ~15) + (q & 3) + ((q >> 2) & 1) * 8 + ((q >> 3) & 1) * 4;
          const float2 v = tw[((n2 * k2) & 127) * 64]; c128[k2 * 136 + p] = (unsigned short)f2bf(v.x); s128[k2 * 136 + p] = (unsigned short)f2bf(v.y); }
      LAS float* ta = (LAS float*)(lds + FT_TA); LAS float* trt = (LAS float*)(lds + FT_TR);
      { const int e = tid, g = e >> 6, kk = e & 63; const float2 v = tw[(32 * (g >> 1) + 4 * (g & 1)) * kk]; ta[2 * e] = v.x; ta[2 * e + 1] = v.y; }
      for (int e = tid; e < 1024; e += NTHR) { const int r = e >> 6, kk = e & 63; const float2 v = tw[crow16(r, 0) * kk]; trt[2 * e] = v.x; trt[2 * e + 1] = v.y; }
    }
    __syncthreads();
    const int vcu = (C.G % 8 == 0) ? (C.bx % 8) * (C.G / 8) + C.bx / 8 : C.bx;
    for (int it = vcu; it < 256; it += C.G) {
        const int kb = it & 1, kcg = (it >> 1) & 31, b = it >> 6, kc = kcg * 8 + w, k1 = 32 * kb + c;
        const bf16* zp = WSP(const bf16, zt_off(b)) + (size_t)kc * SEQ; const bf16* zq = zp + (size_t)256 * SEQ;
        f32x16 acc[4];
#pragma unroll
        for (int rb2 = 0; rb2 < 4; ++rb2) acc[rb2] = (f32x16){};
#pragma unroll 1
        for (int rb = 0; rb < 4; ++rb) {
            const int n2 = 32 * rb + c;
            f32x16 xr = {}, xi = {};
#pragma unroll
            for (int ks = 0; ks < 4; ++ks) {
                const bf16x8_t cf = *(const LAS bf16x8_t*)(lds + FT_C64 + (k1 * 72 + 16 * ks + 8 * h) * 2), sf = *(const LAS bf16x8_t*)(lds + FT_S64 + (k1 * 72 + 16 * ks + 8 * h) * 2);
                const bf16x8_t pf = *(const bf16x8_t*)(zp + n2 * 64 + 16 * ks + 8 * h), qf = *(const bf16x8_t*)(zq + n2 * 64 + 16 * ks + 8 * h);
                const v4u t = __builtin_bit_cast(v4u, qf) ^ 0x80008000u; const bf16x8_t qn = __builtin_bit_cast(bf16x8_t, t);
                xr = __builtin_amdgcn_mfma_f32_32x32x16_bf16(pf, cf, xr, 0, 0, 0); xi = __builtin_amdgcn_mfma_f32_32x32x16_bf16(pf, sf, xi, 0, 0, 0);
                xi = __builtin_amdgcn_mfma_f32_32x32x16_bf16(qf, cf, xi, 0, 0, 0); xr = __builtin_amdgcn_mfma_f32_32x32x16_bf16(qn, sf, xr, 0, 0, 0); }
            bf16x8_t bre[2], bim[2];
            const LAS float* tap = (const LAS float*)(lds + FT_TA) + 2 * ((rb * 2 + h) * 64 + k1); const float ac_ = tap[0], as_ = tap[1];
            const LAS float* trp = (const LAS float*)(lds + FT_TR) + 2 * k1;
#pragma unroll
            for (int sblk = 0; sblk < 2; ++sblk) {
                float tr[8], ti[8];
#pragma unroll
                for (int r8 = 0; r8 < 8; ++r8) { const int r = 8 * sblk + r8; const float rc = trp[128 * r], rs = trp[128 * r + 1]; const float tc = ac_ * rc - as_ * rs, ts = ac_ * rs + as_ * rc;
                    tr[r8] = xr[r] * tc - xi[r] * ts; ti[r8] = -(xr[r] * ts + xi[r] * tc); }
                v4u a, bq;
                a.x = pg8::cvt_pk_bf16(tr[0], tr[1]); a.y = pg8::cvt_pk_bf16(tr[2], tr[3]); a.z = pg8::cvt_pk_bf16(tr[4], tr[5]); a.w = pg8::cvt_pk_bf16(tr[6], tr[7]);
                bq.x = pg8::cvt_pk_bf16(ti[0], ti[1]); bq.y = pg8::cvt_pk_bf16(ti[2], ti[3]); bq.z = pg8::cvt_pk_bf16(ti[4], ti[5]); bq.w = pg8::cvt_pk_bf16(ti[6], ti[7]);
                bre[sblk] = __builtin_bit_cast(bf16x8_t, a); bim[sblk] = __builtin_bit_cast(bf16x8_t, bq); }
#pragma unroll
            for (int rb2 = 0; rb2 < 4; ++rb2) {
                const int k2 = 32 * rb2 + c;
#pragma unroll
                for (int sblk = 0; sblk < 2; ++sblk) {
                    const bf16x8_t ac = *(const LAS bf16x8_t*)(lds + FT_C128 + (k2 * 136 + 32 * rb + 16 * sblk + 8 * h) * 2), as = *(const LAS bf16x8_t*)(lds + FT_S128 + (k2 * 136 + 32 * rb + 16 * sblk + 8 * h) * 2);
                    acc[rb2] = __builtin_amdgcn_mfma_f32_32x32x16_bf16(ac, bre[sblk], acc[rb2], 0, 0, 0); acc[rb2] = __builtin_amdgcn_mfma_f32_32x32x16_bf16(as, bim[sblk], acc[rb2], 0, 0, 0); }
            }
        }
#pragma unroll
        for (int rb2 = 0; rb2 < 4; ++rb2) {
            LAS unsigned short* st = (LAS unsigned short*)(lds + FT_ST + (rb2 & 1) * 16384);
#pragma unroll
            for (int r = 0; r < 16; ++r) st[((crow16(r, h) * 32 + c) * 8) + w] = (unsigned short)f2bf(acc[rb2][r] * 0.001381067932f);
            LDS_WAIT(); __syncthreads();
#pragma unroll
            for (int j = 0; j < 2; ++j) { const int idx = tid + 512 * j, k2l = idx >> 5, k1l = idx & 31;
                const v4u v = *(const LAS v4u*)(st + idx * 8);
                *(v4u*)(mix + ((size_t)b * SEQ + 32 * kb + k1l + 64 * (32 * rb2 + k2l)) * DM + kcg * 8) = v; }
        }
        __syncthreads();
    }
}
__device__ __forceinline__ void ph_attn(const Ctx& C, int l) {
    const bf16* pxa = WSP(const bf16, WS_PXA); bf16* mix = WSP(bf16, WS_HX);
    const float* rb = ARGF(A_RELB) + (size_t)l * 8 * 15 * 31;
    LAS unsigned char* lds = C.lds; LAS float* biasT = (LAS float*)(lds + AT_BT);
    const int lane = C.lane, w = C.wave, fq = lane >> 4, li = lane & 15, tid = C.tid;
    const int nunits = 2048 + (l == 0 ? 64 : 0);
    for (int u = C.bx; u < nunits; u += C.G) {
        const bool isc = u >= 2048;
        int b, h, rp; if (!isc) { b = u >> 9; h = (u >> 6) & 7; rp = u & 63; } else { const int v = u - 2048; b = v >> 4; h = (v >> 1) & 7; rp = v & 1; }
        __syncthreads();
        for (int e = tid; e < 465; e += NTHR) biasT[e] = rb[h * 465 + e] * 1.4426950408889634f;
        const int R0 = min(max(2 * rp - 4, 0), 120);
        if (!isc) {
            for (int p = w; p < 72; p += 8) {
                const int tokl = p * 8 + (lane >> 3), lr = tokl >> 6, col = tokl & 63, gr = min(R0 + lr, 127), cp = lane & 7;
                const bf16* src = pxa + ((size_t)b * SEQ + gr * 64 + col) * NPXA + h * 64;
                __builtin_amdgcn_global_load_lds((const unsigned*)(src + OFF_K + ((cp ^ ((tokl >> 1) & 7)) * 8)), (LAS unsigned*)(lds + AT_KW + p * 1024), 16, 0, 0);
                __builtin_amdgcn_global_load_lds((const unsigned*)(src + OFF_V + ((cp ^ (((tokl >> 1) & 3) << 1)) * 8)), (LAS unsigned*)(lds + AT_VW + p * 1024), 16, 0, 0);
            }
        }
        int r = 0, qc = 0; size_t token;
        if (!isc) { r = 2 * rp + (w >> 2); qc = 16 * (w & 3) + li; token = (size_t)b * SEQ + r * 64 + qc; }
        else token = (size_t)ML + b * 256 + rp * 128 + 16 * w + li;
        bf16x8_t qf[2];
#pragma unroll
        for (int ks = 0; ks < 2; ++ks) qf[ks] = *(const bf16x8_t*)(pxa + token * NPXA + OFF_QQ + h * 64 + 32 * ks + 8 * fq);
        f32x4 o[4]; float m = -1e30f, lsum = 0.f;
#pragma unroll
        for (int db = 0; db < 4; ++db) o[db] = (f32x4){0.f, 0.f, 0.f, 0.f};
        int ka[2][2], va[2][4], dc[2][4];
        asm volatile("s_waitcnt vmcnt(0)" ::: "memory");
        __syncthreads();
        if (!isc) {
            const int cb = w & 3, kc0 = cb == 0 ? 0 : cb == 1 ? 8 : cb == 2 ? 24 : 32;
            attn_addr(kc0, li, fq, ka, va);
            const int csq = min(max(qc - 8, 0), 48); unsigned vmask = 0u;
#pragma unroll
            for (int t = 0; t < 2; ++t)
#pragma unroll
                for (int i = 0; i < 4; ++i) { const int kcol = kc0 + 16 * t + 4 * fq + i; if (kcol >= csq && kcol < csq + 16) vmask |= 1u << (t * 4 + i); dc[t][i] = min(max(kcol - qc + 15, 0), 30); }
            const int rsr = min(max(r - 4, 0), 120), lr0 = rsr - R0;
            for (int j = 0; j < 8; ++j) {
                const int dr = rsr + j - r + 7;
                attn_tile(lds, ka, va, (lr0 + j) * 8192, qf, biasT + dr * 31, dc, vmask, o, m, lsum);
            }
        }
        __syncthreads();
        for (int p = w; p < 32; p += 8) {
            const int tokl = p * 8 + (lane >> 3), cp = lane & 7;
            const bf16* src = pxa + ((size_t)ML + b * 256 + tokl) * NPXA + h * 64;
            __builtin_amdgcn_global_load_lds((const unsigned*)(src + OFF_K + ((cp ^ ((tokl >> 1) & 7)) * 8)), (LAS unsigned*)(lds + AT_KW + p * 1024), 16, 0, 0);
            __builtin_amdgcn_global_load_lds((const unsigned*)(src + OFF_V + ((cp ^ (((tokl >> 1) & 3) << 1)) * 8)), (LAS unsigned*)(lds + AT_VW + p * 1024), 16, 0, 0);
        }
        attn_addr(0, li, fq, ka, va);
        asm volatile("s_waitcnt vmcnt(0)" ::: "memory");
        __syncthreads();
        for (int ct = 0; ct < 8; ++ct) attn_tile(lds, ka, va, ct * 4096, qf, (const LAS float*)nullptr, dc, 0xffu, o, m, lsum);
        lsum += __shfl_xor(lsum, 16); lsum += __shfl_xor(lsum, 32);
        const float inv = 1.0f / lsum;
        bf16* op = mix + token * DM + 512 + h * 64 + 4 * fq;
#pragma unroll
        for (int db = 0; db < 4; ++db) { v2u ov; ov.x = pk2(o[db][0] * inv, o[db][1] * inv); ov.y = pk2(o[db][2] * inv, o[db][3] * inv); *(v2u*)(op + 16 * db) = ov; }
    }
}
__device__ __forceinline__ void ph_final(const Ctx& C) {
    float* out = (float*)(GAS float*)ldarg(C, A_OUT); const float* fg = ARGF(A_FG); const int lane = C.lane;
    for (int row = C.gw; row < ML; row += C.NGW) {
        float* xr = out + (size_t)row * DM;
        f32x4 v[4]; float s2 = 0.f;
#pragma unroll
        for (int j = 0; j < 4; ++j) { v[j] = *(const f32x4*)(xr + 4 * lane + 256 * j); s2 += (v[j].x * v[j].x + v[j].y * v[j].y) + (v[j].z * v[j].z + v[j].w * v[j].w); }
        const float rstd = 1.0f / sqrtf(wave_sum(s2) * (1.0f / DM) + EPS);
#pragma unroll
        for (int j = 0; j < 4; ++j) { const int c0 = 4 * lane + 256 * j; const f32x4 gg = *(const f32x4*)(fg + c0); *(f32x4*)(xr + c0) = v[j] * rstd * gg; }
    }
}

struct Args { const void* p[A_NARGS]; int ph_lo, ph_hi; };

__global__ void __launch_bounds__(NTHR, 2) fwd_kernel(Args args) {
    extern __shared__ __attribute__((aligned(16))) unsigned char lds_raw[];
    Ctx C;
    C.lds = (LAS unsigned char*)lds_raw;
    C.tid = threadIdx.x; C.lane = C.tid & 63; C.wave = __builtin_amdgcn_readfirstlane(C.tid >> 6);
    C.G = gridDim.x; C.bx = blockIdx.x;
    C.gw = C.bx * NWAVES + C.wave; C.NGW = C.G * NWAVES; C.gt = C.bx * NTHR + C.tid; C.NGT = C.G * NTHR;
    for (int u = C.tid; u < (LDS_BYTES - LDSCTL_OFF) / 4; u += NTHR) ((LAS unsigned*)(C.lds + LDSCTL_OFF))[u] = 0u;
    __syncthreads();
    if (C.tid < A_NARGS) ((LAS unsigned long long*)(C.lds + LARGS_OFF))[C.tid] = (unsigned long long)args.p[C.tid];
    __syncthreads();
    volatile LAS unsigned* MISC = (volatile LAS unsigned*)(C.lds + MISC_OFF);
    gu32* ctl = (gu32*)WSP(unsigned, WS_CTL);
    XcdBarrier bar; bar.bar = (unsigned*)(ctl + CW_BAR); bar.x = 0; bar.st = nullptr;
    if (!MK_MULTI) bar = xcd_barrier_post((unsigned*)(ctl + CW_BAR), MISC + 8);
    const int lo = args.ph_lo, hi = args.ph_hi;

    const Ctx C0 = C;
    for (int step = lo; step < hi; ++step) {
        const int ls = step - 2, l = ls >= NS ? 1 : 0, k = (step < 2) ? -1 - step : (step == NSTEPS - 1 ? 100 : ls - l * NS);
        const int nrep = (PROBE_K != -99 && k == PROBE_K) ? PROBE_N : 1;
        for (int rep = 0; rep < nrep; ++rep) {
        Ctx C = C0;
        asm volatile("" : "+v"(C.tid), "+v"(C.lane), "+v"(C.gt), "+s"(C.wave), "+s"(C.bx), "+s"(C.G), "+s"(C.gw), "+s"(C.NGW), "+s"(C.NGT));
        if (k == -1) ph_mod_partial(C);
        else if (k == -2) ph_mod_reduce(C);
        else if (k == 0) {
            ph_weights(C, l);
            const float* modl = WSP(const float, WS_MOD) + (size_t)l * 5 * NMOD;
            ph_norm(C, l == 0 ? ARGF(A_X) : ARGF(A_OUT), l == 0 ? ARGF(A_CTX) : WSP(const float, WS_CTXX), ARGF(A_N1G) + l * DM, modl, WSP(bf16, WS_HX), MT);
        } else if (k == 1) {
            pg8::Prob<false> P{WSP(const bf16, WS_HX), WSP(const bf16, WS_WIN), DM, DM, DM}; pg8::StaticOrder<1> S; S.init(MT, NIN, C.G, C.bx);
            EpiIn E{WSP(bf16, WS_PXA), WSP(bf16, WS_PXG)};
            pg8::gemm_phase(C.lds, P, S, E);
        } else if (k == 2) {
            const int sub = rep == 0 ? 7 : PROBE_SUB;
            if (sub & 1) ph_t1(C);
            if (sub & 2) ph_mixers(C, l);
            if (sub & 4) ph_attn(C, l);
        } else if (k == 3) {
            ph_fft(C);
        } else if (k == 4) {
            pg8::Prob<true> P{WSP(const bf16, WS_HX), WSP(const bf16, WS_WM), DM, DM, DM}; pg8::StaticOrder<3> S; S.init(l == 0 ? MT : ML, DM, C.G, C.bx);
            EpiMerge E{WSP(bf16, WS_M), WSP(const bf16, WS_PXG)};
            pg8::gemm_phase(C.lds, P, S, E);
        } else if (k == 5) {
            pg8::Prob<false> P{WSP(const bf16, WS_M), WSP(const bf16, WS_WO), DM, DM, DM}; pg8::StaticOrder<1> S; S.init(l == 0 ? MT : ML, DM, C.G, C.bx);
            EpiRes E{l == 0 ? ARGF(A_X) : ARGF(A_OUT), l == 0 ? ARGF(A_CTX) : WSP(const float, WS_CTXX), (float*)(GAS float*)ldarg(C, A_OUT), WSP(float, WS_CTXX), WSP(const float, WS_MOD) + (size_t)l * 5 * NMOD + 2 * DM};
            pg8::gemm_phase(C.lds, P, S, E);
        } else if (k == 6) {
            const float* modl = WSP(const float, WS_MOD) + (size_t)l * 5 * NMOD;
            ph_norm(C, ARGF(A_OUT), WSP(const float, WS_CTXX), ARGF(A_N2G) + l * DM, modl + 3 * DM, WSP(bf16, WS_HX), l == 0 ? MT : ML);
        } else if (k == 7) {
            pg8::Prob<false> P{WSP(const bf16, WS_HX), WSP(const bf16, WS_W1), DM, DM, DM}; pg8::StaticOrder<1> S; S.init(l == 0 ? MT : ML, FF, C.G, C.bx);
            EpiAct E{WSP(bf16, WS_ACT)};
            pg8::gemm_phase(C.lds, P, S, E);
        } else if (k == 8) {
            pg8::Prob<false> P{WSP(const bf16, WS_ACT), WSP(const bf16, WS_W2), FF, FF, FF}; pg8::StaticOrder<1> S; S.init(l == 0 ? MT : ML, DM, C.G, C.bx);
            EpiRes E{ARGF(A_OUT), WSP(const float, WS_CTXX), (float*)(GAS float*)ldarg(C, A_OUT), WSP(float, WS_CTXX), WSP(const float, WS_MOD) + (size_t)l * 5 * NMOD + 5 * DM};
            pg8::gemm_phase(C.lds, P, S, E);
        } else ph_final(C);
        if (step + 1 < hi || rep + 1 < nrep) { if (MK_MULTI) { if (C.tid == 0) __hip_atomic_store(ctl + CW_TMO, 0xBADu, RLX_AGENT); } else xcd_barrier(bar); }
        }
    }
}

extern "C" void kernel_launch(void* const* d_in, const int* in_sizes, int n_in, void* d_out, int out_size, void* d_ws, size_t ws_size, hipStream_t stream) {
    static int grid = 0;
    if (grid == 0) {
        if (n_in != 18 || out_size != ML * DM || ws_size < WS_END) { fprintf(stderr, "kernel_launch: unexpected shapes (n_in %d out %d ws %zu)\n", n_in, out_size, ws_size); grid = -1; return; }
        int dev = 0, cus = 0;
        if (hipGetDevice(&dev) != hipSuccess || hipDeviceGetAttribute(&cus, hipDeviceAttributeMultiprocessorCount, dev) != hipSuccess) { grid = -1; return; }
        if (hipFuncSetAttribute((const void*)fwd_kernel, hipFuncAttributeMaxDynamicSharedMemorySize, LDS_BYTES) != hipSuccess) { fprintf(stderr, "kernel_launch: hipFuncSetAttribute failed\n"); grid = -1; return; }
        int per_cu = 0;
        if (hipOccupancyMaxActiveBlocksPerMultiprocessor(&per_cu, (const void*)fwd_kernel, NTHR, LDS_BYTES) != hipSuccess || per_cu < 1) fprintf(stderr, "kernel_launch: occupancy query reports %d\n", per_cu);
        (void)hipGetLastError();
        grid = cus;
    }
    if (grid < 0) return;
    (void)hipMemsetAsync((char*)d_ws + WS_CTL, 0, CTL_ZERO_BYTES, stream);
    Args a{};
    for (int i = 0; i < 18; ++i) a.p[i] = d_in[i];
    a.p[A_OUT] = d_out; a.p[A_WS] = d_ws;
#if MK_MULTI
    for (int s = 0; s < NSTEPS; ++s) { a.ph_lo = s; a.ph_hi = s + 1; hipLaunchKernelGGL(fwd_kernel, dim3(grid), dim3(NTHR), LDS_BYTES, stream, a); }
#else
    a.ph_lo = 0; a.ph_hi = NSTEPS; hipLaunchKernelGGL(fwd_kernel, dim3(grid), dim3(NTHR), LDS_BYTES, stream, a);
#endif
}
```

```cpp
#include <hip/hip_runtime.h>
#include <cstdio>
#include <cstdint>

#ifndef PROBE_K
#define PROBE_K -99
#define PROBE_N 1
#define PROBE_SUB 7
#endif
#ifndef MK_MULTI
#define MK_MULTI 0
#endif

namespace pg8 {
#define PG8_LAS __attribute__((address_space(3)))
typedef unsigned short bf16_t;
typedef short bf16x8 __attribute__((ext_vector_type(8)));
typedef float f32x4 __attribute__((ext_vector_type(4)));
typedef unsigned u32x4 __attribute__((ext_vector_type(4)));
constexpr int BM = 256, BK = 64, HALF = 128, HTB = HALF * BK * 2, STAGE_BYTES = 8 * HTB, NXCD = 8, WGM = 8;

__host__ __device__ __forceinline__ int lds_byte(int r, int c) { const int st = (r >> 4) * 2 + (c >> 5), rr = r & 15, cc = c & 31, ob = rr * 64 + cc * 2; return st * 1024 + (ob ^ (((ob >> 9) & 1) << 5)); }
__host__ __device__ __forceinline__ void stage_rc(int b, int& R, int& C) { const int st = b / 1024, sb = b % 1024, swz = sb ^ (((sb >> 9) & 1) << 5); R = (st >> 1) * 16 + swz / 64; C = (st & 1) * 32 + (swz % 64) / 2; }
__host__ __device__ __forceinline__ int perm32(int rho) { const int n = rho >> 4, i = rho & 15; return 8 * (i >> 2) + 4 * n + (i & 3); }

struct Unit { int pm, pn, br; };

template <int REP> struct StaticOrder {
    int nM, nN, nwg, G, c;
    __device__ void init(int M, int N, int G_, int c_) { nM = M / BM; nN = N / BM; nwg = nM * nN; G = G_; c = c_; }
    __device__ __forceinline__ bool next(int i, Unit& u) const {
        const int it = i / REP; u.br = i - it * REP;
        const long L = (long)it * G + c; if (L >= nwg) return false;
        int wgid = (int)L; { const int q = nwg / NXCD, r = nwg % NXCD, xcd = wgid % NXCD, off = wgid / NXCD; wgid = (xcd < r ? xcd * (q + 1) : r * (q + 1) + (xcd - r) * q) + off; }
        const int nig = WGM * nN, gid = wgid / nig, fm = gid * WGM, gsz = (nM - fm) < WGM ? (nM - fm) : WGM;
        u.pm = fm + ((wgid % nig) % gsz); u.pn = (wgid % nig) / gsz; return true;
    }
};

struct DownOrder {
    StaticOrder<1> lat; int G, c;
    __device__ void init(int G_, int c_) { lat.init(32768, 1024, G_, c_); G = G_; c = c_; }
    __device__ __forceinline__ bool next(int i, Unit& u) const {
        const long L = (long)i * G + c;
        if (L < 512) return lat.next(i, u);
        const int j = (int)L - 512; if (j >= 64) return false;
        const int ct = j >> 2; u.pm = 128 + (ct >> 2); u.pn = ct & 3; u.br = j & 3; return true;
    }
};
struct ProbDown {
    const bf16_t* A; const bf16_t* Bt; int lda, ldb, K;
    __device__ __forceinline__ int nt(const Unit& u) const { return u.pm >= 128 ? 16 : 64; }
    __device__ __forceinline__ int koff(const Unit& u) const { return u.pm >= 128 ? u.br * 1024 : 0; }
    __device__ __forceinline__ const char* a(const Unit& u) const { return (const char*)(A + (size_t)u.pm * BM * lda + koff(u)); }
    __device__ __forceinline__ const char* b(const Unit& u) const { return (const char*)(Bt + (size_t)u.pn * BM * ldb + koff(u)); }
};
template <bool MERGE> struct Prob {
    const bf16_t* A; const bf16_t* Bt; int lda, ldb, K;
    __device__ __forceinline__ int nt(const Unit& u) const { if (MERGE) return u.br == 2 ? 8 : 4; return K / BK; }
    __device__ __forceinline__ int koff(const Unit& u) const { if (MERGE) return u.br * 256; return 0; }
    __device__ __forceinline__ const char* a(const Unit& u) const { return (const char*)(A + (size_t)u.pm * BM * lda + koff(u)); }
    __device__ __forceinline__ const char* b(const Unit& u) const { return (const char*)(Bt + (size_t)u.pn * BM * ldb + koff(u)); }
};

__device__ __forceinline__ unsigned cvt_pk_bf16(float lo, float hi) { unsigned r; asm volatile("v_cvt_pk_bf16_f32 %0, %1, %2" : "=v"(r) : "v"(lo), "v"(hi)); return r; }

template <class Epi, class Sched, class PROB>
__device__ __forceinline__ void gemm_phase(PG8_LAS unsigned char* lds, const PROB P, const Sched& S, const Epi& E, const int tid) {
    const int wid = __builtin_amdgcn_readfirstlane(tid >> 6), lane = tid & 63, wr = wid >> 2, wc = wid & 3, fr = lane & 15, fq = lane >> 4;
    unsigned voffA[2], voffB[2];
#pragma unroll
    for (int i = 0; i < 2; ++i) { int R, C; stage_rc(tid * 16 + i * 8192, R, C); const int Rb = Epi::PERM ? ((R & ~31) + perm32(R & 31)) : R;
        voffA[i] = (unsigned)(R * P.lda + C) * 2u; voffB[i] = (unsigned)(Rb * P.ldb + C) * 2u; }
    const size_t kstep = (size_t)(BK * 2);
    const size_t hstepA = (size_t)HALF * P.lda * 2, hstepB = (size_t)HALF * P.ldb * 2;
    const unsigned ldsw = (unsigned)wid * 1024u;
    const int aoff = lds_byte(wr * 64 + fr, fq * 8), boff = lds_byte(wc * 32 + fr, fq * 8);
#define PG8_SA(b, h) (((b) * 2 + (h)) * HTB)
#define PG8_SB(b, h) ((4 + (b) * 2 + (h)) * HTB)
#define PG8_STAGE(bufoff, gbase, voff) do { _Pragma("unroll") for (int _i = 0; _i < 2; ++_i) \
        __builtin_amdgcn_global_load_lds((const unsigned*)((const char*)(gbase) + (voff)[_i]), (PG8_LAS unsigned*)(lds + (bufoff) + ldsw + _i * 8192), 16, 0, 0); } while (0)
#define PG8_LDA(dst, b, h) do { _Pragma("unroll") for (int m = 0; m < 4; ++m) _Pragma("unroll") for (int k = 0; k < 2; ++k) dst[m][k] = *(const PG8_LAS bf16x8*)(lds + PG8_SA(b, h) + aoff + m * 2048 + k * 1024); } while (0)
#define PG8_LDB(dst, b, h) do { _Pragma("unroll") for (int n = 0; n < 2; ++n) _Pragma("unroll") for (int k = 0; k < 2; ++k) dst[n][k] = *(const PG8_LAS bf16x8*)(lds + PG8_SB(b, h) + boff + n * 2048 + k * 1024); } while (0)
#define PG8_MMA(ai, bj, At, Bt) do { __builtin_amdgcn_s_setprio(1); _Pragma("unroll") for (int m = 0; m < 4; ++m) _Pragma("unroll") for (int n = 0; n < 2; ++n) _Pragma("unroll") for (int k = 0; k < 2; ++k) \
        acc[ai][bj][m][n] = __builtin_amdgcn_mfma_f32_16x16x32_bf16(Bt[n][k], At[m][k], acc[ai][bj][m][n], 0, 0, 0); __builtin_amdgcn_s_setprio(0); } while (0)
#define PG8_WAIT_V(n) asm volatile("s_waitcnt vmcnt(" #n ")" ::: "memory")
#define PG8_WAIT_L(n) asm volatile("s_waitcnt lgkmcnt(" #n ")" ::: "memory")
#define PG8_BAR __builtin_amdgcn_s_barrier()
#define PG8_WAIT_SEL1(N) asm volatile("s_waitcnt vmcnt(" #N ")\n\tv_cmp_ne_u32_e32 vcc, 0, %0\n\ts_cbranch_vccnz .Lpg8w%=\n\ts_waitcnt vmcnt(8)\n.Lpg8w%=:" :: "v"(fst) : "memory", "vcc")
#define PG8_WAIT_SEL(NF16, NF32) do { if (Epi::NST == 16) PG8_WAIT_SEL1(NF16); else PG8_WAIT_SEL1(NF32); } while (0)
#define PG8_SCHED __builtin_amdgcn_sched_barrier(0)
    Unit cur, nxt; int ui = 0;
    if (!S.next(0, cur)) return;
    f32x4 acc[2][2][4][2];
#pragma unroll
    for (int a = 0; a < 2; ++a)
#pragma unroll
        for (int b = 0; b < 2; ++b)
#pragma unroll
            for (int m = 0; m < 4; ++m)
#pragma unroll
                for (int n = 0; n < 2; ++n) acc[a][b][m][n] = (f32x4){0.f, 0.f, 0.f, 0.f};
    bf16x8 At[4][2], B0[2][2], B1[2][2];
    const char* cA = P.a(cur); const char* cB = P.b(cur);
    PG8_STAGE(PG8_SB(0, 0), cB, voffB); PG8_STAGE(PG8_SB(0, 1), cB + hstepB, voffB); PG8_STAGE(PG8_SA(0, 0), cA, voffA); PG8_STAGE(PG8_SA(0, 1), cA + hstepA, voffA);
    if (wr == 1) PG8_BAR;
    PG8_WAIT_V(2); PG8_BAR;
    PG8_STAGE(PG8_SB(1, 0), cB + kstep, voffB); PG8_STAGE(PG8_SA(1, 0), cA + kstep, voffA); PG8_STAGE(PG8_SB(1, 1), cB + hstepB + kstep, voffB);
    PG8_WAIT_V(6); PG8_BAR;
    for (;;) {
        const bool has_next = S.next(ui + 1, nxt);
        const char* nA = has_next ? P.a(nxt) : cA; const char* nB = has_next ? P.b(nxt) : cB;
        const int nt = P.nt(cur);
        asm volatile(".p2align 8");
        for (int t = 0; t < nt; t += 2) {
            const bool last = (t == nt - 2); const int fst = (t == 0 && ui > 0) ? 1 : 0;
            if constexpr (Epi::HOOKS) { if (t == 4 || t == 8) E.hook(acc, cur, t, wr, wc, fr, fq); }
            const char* a1 = cA + (size_t)(t + 1) * kstep;
            const char* a2 = last ? nA : cA + (size_t)(t + 2) * kstep; const char* b2 = last ? nB : cB + (size_t)(t + 2) * kstep;
            const char* a3 = a2 + kstep; const char* b3 = b2 + kstep;
            PG8_LDB(B0, 0, 0); PG8_LDB(B1, 0, 1); PG8_SCHED; PG8_LDA(At, 0, 0); PG8_STAGE(PG8_SA(1, 1), a1 + hstepA, voffA);
            PG8_WAIT_SEL(18, 34); PG8_WAIT_L(0); PG8_BAR; PG8_MMA(0, 0, At, B0); PG8_MMA(0, 1, At, B1); PG8_BAR; PG8_SCHED;
            PG8_LDA(At, 0, 1); PG8_STAGE(PG8_SB(0, 0), b2, voffB); PG8_STAGE(PG8_SB(0, 1), b2 + hstepB, voffB); PG8_STAGE(PG8_SA(0, 0), a2, voffA);
            PG8_WAIT_SEL(24, 40); PG8_WAIT_L(0); PG8_BAR; PG8_MMA(1, 0, At, B0); PG8_MMA(1, 1, At, B1); PG8_BAR; PG8_SCHED;
            PG8_LDB(B0, 1, 0); PG8_LDB(B1, 1, 1); PG8_SCHED; PG8_LDA(At, 1, 0); PG8_STAGE(PG8_SA(0, 1), a2 + hstepA, voffA);
            PG8_WAIT_SEL(26, 42); PG8_WAIT_L(0); PG8_BAR; PG8_MMA(0, 0, At, B0); PG8_MMA(0, 1, At, B1); PG8_BAR; PG8_SCHED;
            PG8_LDA(At, 1, 1); PG8_STAGE(PG8_SB(1, 0), b3, voffB); PG8_STAGE(PG8_SB(1, 1), b3 + hstepB, voffB); PG8_STAGE(PG8_SA(1, 0), a3, voffA);
            PG8_WAIT_V(8); PG8_WAIT_L(0); PG8_BAR; PG8_MMA(1, 0, At, B0); PG8_MMA(1, 1, At, B1); PG8_BAR; PG8_SCHED;
        }
        if (wr == 0) PG8_BAR;
        E(acc, cur, wr, wc, fr, fq);
        if (!has_next) break;
#pragma unroll
        for (int a = 0; a < 2; ++a)
#pragma unroll
            for (int b = 0; b < 2; ++b)
#pragma unroll
                for (int m = 0; m < 4; ++m)
#pragma unroll
                    for (int n = 0; n < 2; ++n) acc[a][b][m][n] = (f32x4){0.f, 0.f, 0.f, 0.f};
        cur = nxt; cA = nA; cB = nB; ++ui;
        if (wr == 1) PG8_BAR;
    }
    PG8_WAIT_V(0);
    PG8_BAR;
#undef PG8_SA
#undef PG8_SB
#undef PG8_STAGE
#undef PG8_LDA
#undef PG8_LDB
#undef PG8_MMA
#undef PG8_WAIT_V
#undef PG8_WAIT_L
#undef PG8_BAR
#undef PG8_WAIT_SEL
#undef PG8_WAIT_SEL1
#undef PG8_SCHED
}
}

constexpr int NWAVES = 8, NTHR = 512;
constexpr int DM = 1024, NB = 4, SEQ = 8192, ML = NB * SEQ, CTXL = 256, MC = NB * CTXL, MT = ML + MC;
constexpr int NIN_ORIG = 5632, NPXA = 2816, NPXG = 3072, NIN = NPXA + NPXG;
constexpr int OFF_P = 0, OFF_Q = 256, OFF_CU = 512, OFF_CB = 768, OFF_CC = 1024, OFF_QQ = 1280, OFF_K = 1792, OFF_V = 2304;
constexpr int FF = 4096, NMOD = 6 * DM, NGRP = 5;
constexpr float EPS = 1e-6f;

constexpr size_t MiB = 1u << 20;
constexpr size_t WS_CTL = 0, CTL_ZERO_BYTES = 2 * MiB;
constexpr size_t WS_RS = 262144;
constexpr size_t WS_FCNT = 1441792;
constexpr size_t WS_ZERO = 1572864;
constexpr size_t WS_RS5 = 1703936;
constexpr size_t WS_TW = 2 * MiB;
constexpr size_t WS_MOD = 2 * MiB + 65536;
constexpr size_t WS_GN = 2 * MiB + 524288;
constexpr size_t WS_CIN = 2 * MiB + 786432;
constexpr size_t WS_CUP = 3 * MiB;
constexpr size_t WS_MODP = 510 * MiB;
constexpr size_t WS_CTXX = 4 * MiB;
constexpr size_t WS_WIN = 8 * MiB, WS_WM = 20 * MiB, WS_WO = 22 * MiB, WS_W1 = 24 * MiB, WS_W2 = 32 * MiB;
constexpr size_t WS_HX = 40 * MiB;
constexpr size_t WS_PXA = 106 * MiB;
constexpr size_t WS_PXG = 288 * MiB;
constexpr size_t WS_TB = 486 * MiB;
constexpr size_t WS_M = WS_PXA;
constexpr size_t WS_ACT = WS_PXA;
constexpr size_t WS_PART = 400 * MiB;
constexpr size_t WS_END = 512 * MiB;
static_assert(WS_PXA + (size_t)MT * NPXA * 2 <= WS_PXG && WS_PXG + (size_t)MT * NPXG * 2 <= WS_TB && WS_ACT + (size_t)MT * FF * 2 <= WS_TB && WS_HX + (size_t)MT * DM * 2 <= WS_PXA, "ws map");
constexpr int CW_TMO = 0, CW_BAR = 4096;

constexpr int RING_BYTES = 131072, LDSCTL_OFF = 155648, MISC_OFF = LDSCTL_OFF + 320, LDS_BYTES = 163840;

#define GAS __attribute__((address_space(1)))
#define LAS __attribute__((address_space(3)))
typedef unsigned short bf16;
typedef unsigned v4u __attribute__((ext_vector_type(4)));
typedef unsigned v2u __attribute__((ext_vector_type(2)));
typedef float f32x4 __attribute__((ext_vector_type(4)));
typedef GAS unsigned gu32;
#define RLX_AGENT __ATOMIC_RELAXED, __HIP_MEMORY_SCOPE_AGENT
#define LDS_WAIT() asm volatile("s_waitcnt lgkmcnt(0)" ::: "memory")
__device__ __forceinline__ unsigned f2bf(float f) { unsigned u = __builtin_bit_cast(unsigned, f); return (u + 0x7fffu + ((u >> 16) & 1u)) >> 16; }
__device__ __forceinline__ unsigned pk2(float lo, float hi) { return f2bf(lo) | (f2bf(hi) << 16); }
__device__ __forceinline__ float bf2f(unsigned h) { return __uint_as_float(h << 16); }
__device__ __forceinline__ float bflo(unsigned w) { return __uint_as_float(w << 16); }
__device__ __forceinline__ float bfhi(unsigned w) { return __uint_as_float(w & 0xffff0000u); }

#define XB_TMO      128
#define XB_XCNT(j)  (256  + 64 * (j))
#define XB_XSUB(j)  (1280 + 64 * (j))
#define XB_XGEN(j)  (2304 + 64 * (j))
#define XB_TOP      3328
#define XB_TOPGEN   3392
#define XCD_BAR_WORDS 3456
#define XB_SPIN_CAP (1u << 22)
__device__ __forceinline__ unsigned xb_ld(unsigned* p)              { return __hip_atomic_load(p, __ATOMIC_RELAXED, __HIP_MEMORY_SCOPE_AGENT); }
__device__ __forceinline__ unsigned xb_add(unsigned* p, unsigned v) { return __hip_atomic_fetch_add(p, v, __ATOMIC_RELAXED, __HIP_MEMORY_SCOPE_AGENT); }
__device__ __forceinline__ unsigned xb_xcc_id() { return (unsigned)__builtin_amdgcn_s_getreg((3 << 11) | 20) & 0xFu; }
#define XB_SPIN(cond, bar) do { unsigned _sp = 0; while (cond) { __builtin_amdgcn_s_sleep(1); \
    if ((++_sp & 255u) == 0u) { if (xb_ld(&(bar)[XB_TMO])) break; if (_sp > XB_SPIN_CAP) { atomicAdd(&(bar)[XB_TMO], 1u); break; } } } } while (0)
struct XcdBarrier { unsigned* bar; unsigned x; volatile LAS unsigned* st; };
__device__ __forceinline__ XcdBarrier xcd_barrier_post(unsigned* bar, volatile LAS unsigned* st, bool leader) {
    XcdBarrier b; b.bar = bar; b.x = xb_xcc_id(); b.st = st;
    if (leader) { const unsigned rank = xb_add(&bar[XB_XCNT(b.x)], 1u); st[2] = rank; }
    return b;
}
__device__ __forceinline__ void xcd_barrier_complete(unsigned* bar, unsigned x, unsigned& nloc, unsigned& nx) {
    const unsigned G = gridDim.x * gridDim.y * gridDim.z;
    unsigned sum, cnt, mine, sp = 0u;
    for (;;) {
        sum = 0u; cnt = 0u; mine = 0u;
#pragma unroll
        for (unsigned j = 0; j < 16; ++j) { const unsigned c = xb_ld(&bar[XB_XCNT(j)]); sum += c; cnt += (c > 0u) ? 1u : 0u; mine = (j == x) ? c : mine; }
        if (sum == G) break;
        __builtin_amdgcn_s_sleep(1);
        if ((++sp & 255u) == 0u) { if (xb_ld(&bar[XB_TMO])) break; if (sp > XB_SPIN_CAP) { atomicAdd(&bar[XB_TMO], 1u); break; } }
    }
    nloc = mine > 0u ? mine : 1u; nx = cnt > 0u ? cnt : 1u;
}
__device__ __forceinline__ void xcd_barrier(const XcdBarrier& b, bool leader) {
    asm volatile("s_waitcnt vmcnt(0)" ::: "memory");
    __syncthreads();
    if (leader) {
        unsigned* bar = b.bar;
        __builtin_amdgcn_s_waitcnt(0);
        unsigned nloc = b.st[0], nx = b.st[1];
        if (nloc == 0u) { xcd_barrier_complete(bar, b.x, nloc, nx); b.st[0] = nloc; b.st[1] = nx; }
        const unsigned old = xb_add(&bar[XB_XSUB(b.x)], 1u);
        const unsigned gen = old / nloc;
        if (old + 1u == (gen + 1u) * nloc) {
            __builtin_amdgcn_fence(__ATOMIC_RELEASE, "agent");
            asm volatile("s_waitcnt vmcnt(0)" ::: "memory");
            const unsigned og = xb_add(&bar[XB_TOP], 1u);
            const unsigned tg = og / nx;
            if (og + 1u == (tg + 1u) * nx) xb_add(&bar[XB_TOPGEN], 1u);
            else XB_SPIN(xb_ld(&bar[XB_TOPGEN]) == tg, bar);
            __builtin_amdgcn_fence(__ATOMIC_ACQUIRE, "agent");
            xb_add(&bar[XB_XGEN(b.x)], 1u);
            asm volatile("s_waitcnt vmcnt(0)" ::: "memory");
        } else {
            XB_SPIN(xb_ld(&bar[XB_XGEN(b.x)]) == gen, bar);
            __builtin_amdgcn_fence(__ATOMIC_ACQUIRE, "agent");
            asm volatile("s_waitcnt vmcnt(0)" ::: "memory");
        }
    }
    __syncthreads();
}

__device__ __forceinline__ float wave_sum(float v) {
#pragma unroll
    for (int o = 1; o < 64; o <<= 1) v += __shfl_xor(v, o);
    return v;
}
__device__ __forceinline__ float wave_max(float v) {
#pragma unroll
    for (int o = 1; o < 64; o <<= 1) v = fmaxf(v, __shfl_xor(v, o));
    return v;
}

__device__ __forceinline__ void transpose_item(const float* W, int ldw, int ncols, bf16* WT, int ldwt, int row_off, int k_off, LAS float* scr, int item, int lane) {
    const int nblk = ncols / 32, kb = item / nblk, nb = item % nblk, k0 = 64 * kb, n0 = 32 * nb;
#pragma unroll 8
    for (int i = 0; i < 32; ++i) { const int kk = 2 * i + (lane >> 5); scr[kk * 33 + (lane & 31)] = W[(size_t)(k0 + kk) * ldw + n0 + (lane & 31)]; }
    LDS_WAIT(); asm volatile("" ::: "memory");
    const int c = lane & 7;
#pragma unroll
    for (int j = 0; j < 4; ++j) { const int n = (lane >> 3) + 8 * j; const LAS float* s = scr + (8 * c) * 33 + n;
        v4u o; o.x = pk2(s[0 * 33], s[1 * 33]); o.y = pk2(s[2 * 33], s[3 * 33]); o.z = pk2(s[4 * 33], s[5 * 33]); o.w = pk2(s[6 * 33], s[7 * 33]);
        *(v4u*)(WT + (size_t)(row_off + n0 + n) * ldwt + k_off + k0 + 8 * c) = o; }
    LDS_WAIT(); asm volatile("" ::: "memory");
}

using pg8::Unit; using pg8::cvt_pk_bf16;
typedef unsigned long long u64;
__device__ __forceinline__ float rs_to_rstd(u64 q) { return 1.0f / sqrtf((float)q * (1.0f / (16777216.0f * DM)) + EPS); }
struct EpiIn {
    static constexpr bool PERM = true, HOOKS = false; static constexpr int NST = 16;
    bf16* pxa; bf16* pxg; const u64* rs; const float* cin;
    __device__ __forceinline__ void operator()(const f32x4 (&acc)[2][2][4][2], const Unit& u, int wr, int wc, int fr, int fq) const {
        asm volatile("" : "+v"(fr), "+v"(fq));
        const bool gate = u.pn >= 11; bf16* base = gate ? pxg : pxa; const int ldc = gate ? NPXG : NPXA; const int colt = (gate ? u.pn - 11 : u.pn) * 256;
        const int grp = u.pm >= 128 ? 4 : (u.pm >> 5);
        const int row0 = u.pm * 256 + wr * 64 + fr, col0 = colt + wc * 32 + 8 * fq;
        const float* cp = cin + grp * NIN + u.pn * 256 + wc * 32 + 8 * fq;
        f32x4 cv[2][2];
#pragma unroll
        for (int bj = 0; bj < 2; ++bj) { cv[bj][0] = *(const f32x4*)(cp + bj * 128); cv[bj][1] = *(const f32x4*)(cp + bj * 128 + 4); }
        u64 rq[2][4]; float rsv[2][4];
#pragma unroll
        for (int ai = 0; ai < 2; ++ai)
#pragma unroll
            for (int m = 0; m < 4; ++m) rq[ai][m] = rs[row0 + ai * 128 + m * 16];
        asm volatile("" ::: "memory");
#pragma unroll
        for (int ai = 0; ai < 2; ++ai)
#pragma unroll
            for (int m = 0; m < 4; ++m) rsv[ai][m] = rs_to_rstd(rq[ai][m]);
#pragma unroll
        for (int ai = 0; ai < 2; ++ai)
#pragma unroll
            for (int m = 0; m < 4; ++m) { const int row = row0 + ai * 128 + m * 16; bf16* rowp = base + (size_t)row * ldc + col0; const float rstd = rsv[ai][m];
#pragma unroll
                for (int bj = 0; bj < 2; ++bj) { f32x4 v0 = acc[ai][bj][m][0] * rstd + cv[bj][0], v1 = acc[ai][bj][m][1] * rstd + cv[bj][1];
                    if (gate) {
#pragma unroll
                        for (int e = 0; e < 4; ++e) { v0[e] = __builtin_amdgcn_rcpf(1.0f + __builtin_amdgcn_exp2f(-1.4426950408889634f * v0[e])); v1[e] = __builtin_amdgcn_rcpf(1.0f + __builtin_amdgcn_exp2f(-1.4426950408889634f * v1[e])); } }
                    v4u w; w.x = cvt_pk_bf16(v0[0], v0[1]); w.y = cvt_pk_bf16(v0[2], v0[3]); w.z = cvt_pk_bf16(v1[0], v1[1]); w.w = cvt_pk_bf16(v1[2], v1[3]);
                    *(v4u*)(rowp + bj * 128) = w; } }
    }
};
struct EpiMerge {
    static constexpr bool PERM = true, HOOKS = true; static constexpr int NST = 16;
    bf16* m; const bf16* pxg;
    __device__ __forceinline__ void hook(f32x4 (&acc)[2][2][4][2], const Unit& u, int t, int wr, int wc, int fr, int fq) const {
        asm volatile("" : "+v"(fr), "+v"(fq));
        const int row0 = u.pm * 256 + wr * 64 + fr, col0 = u.pn * 256 + wc * 32 + 8 * fq;
        const bf16* gnum = pxg + (t == 4 ? 0 : 1024) + col0; const bf16* gden = gnum + 1024;
#pragma unroll
        for (int ai = 0; ai < 2; ++ai)
#pragma unroll
            for (int mp = 0; mp < 2; ++mp) {
                v4u gn[2][2], gd[2][2];
#pragma unroll
                for (int mq = 0; mq < 2; ++mq)
#pragma unroll
                    for (int bj = 0; bj < 2; ++bj) { const size_t ro = (size_t)(row0 + ai * 128 + (2 * mp + mq) * 16) * NPXG + bj * 128; gn[mq][bj] = *(const v4u*)(gnum + ro); gd[mq][bj] = *(const v4u*)(gden + ro); }
                asm volatile("" ::: "memory");
#pragma unroll
                for (int mq = 0; mq < 2; ++mq)
#pragma unroll
                    for (int bj = 0; bj < 2; ++bj) { const v4u a = gn[mq][bj], d = gd[mq][bj];
                        f32x4& v0 = acc[ai][bj][2 * mp + mq][0]; f32x4& v1 = acc[ai][bj][2 * mp + mq][1];
                        v0[0] *= bflo(a.x) * __builtin_amdgcn_rcpf(fmaxf(bflo(d.x), 1e-30f)); v0[1] *= bfhi(a.x) * __builtin_amdgcn_rcpf(fmaxf(bfhi(d.x), 1e-30f));
                        v0[2] *= bflo(a.y) * __builtin_amdgcn_rcpf(fmaxf(bflo(d.y), 1e-30f)); v0[3] *= bfhi(a.y) * __builtin_amdgcn_rcpf(fmaxf(bfhi(d.y), 1e-30f));
                        v1[0] *= bflo(a.z) * __builtin_amdgcn_rcpf(fmaxf(bflo(d.z), 1e-30f)); v1[1] *= bfhi(a.z) * __builtin_amdgcn_rcpf(fmaxf(bfhi(d.z), 1e-30f));
                        v1[2] *= bflo(a.w) * __builtin_amdgcn_rcpf(fmaxf(bflo(d.w), 1e-30f)); v1[3] *= bfhi(a.w) * __builtin_amdgcn_rcpf(fmaxf(bfhi(d.w), 1e-30f)); }
            }
    }
    __device__ __forceinline__ void operator()(const f32x4 (&acc)[2][2][4][2], const Unit& u, int wr, int wc, int fr, int fq) const {
        asm volatile("" : "+v"(fr), "+v"(fq));
        const int row0 = u.pm * 256 + wr * 64 + fr, col0 = u.pn * 256 + wc * 32 + 8 * fq;
#pragma unroll
        for (int ai = 0; ai < 2; ++ai) {
            v4u g[4][2];
#pragma unroll
            for (int mm = 0; mm < 4; ++mm)
#pragma unroll
                for (int bj = 0; bj < 2; ++bj) g[mm][bj] = *(const v4u*)(pxg + (size_t)(row0 + ai * 128 + mm * 16) * NPXG + 2048 + col0 + bj * 128);
            asm volatile("" ::: "memory");
#pragma unroll
            for (int mm = 0; mm < 4; ++mm)
#pragma unroll
                for (int bj = 0; bj < 2; ++bj) { const f32x4 v0 = acc[ai][bj][mm][0], v1 = acc[ai][bj][mm][1]; const v4u gg = g[mm][bj];
                    v4u w; w.x = cvt_pk_bf16(v0[0] * bflo(gg.x), v0[1] * bfhi(gg.x)); w.y = cvt_pk_bf16(v0[2] * bflo(gg.y), v0[3] * bfhi(gg.y));
                    w.z = cvt_pk_bf16(v1[0] * bflo(gg.z), v1[1] * bfhi(gg.z)); w.w = cvt_pk_bf16(v1[2] * bflo(gg.w), v1[3] * bfhi(gg.w));
                    *(v4u*)(m + (size_t)(row0 + ai * 128 + mm * 16) * DM + col0 + bj * 128) = w; }
        }
    }
};
struct EpiRes {
    static constexpr bool PERM = true, HOOKS = false; static constexpr int NST = 32;
    const float* base_l; const float* base_c; float* out_l; float* out_c; const float* gate;
    float* part;
    const float* gn; bf16* ap; u64* rs;
    __device__ __forceinline__ void operator()(const f32x4 (&acc)[2][2][4][2], const Unit& u, int wr, int wc, int fr, int fq) const {
        asm volatile("" : "+v"(fr), "+v"(fq));
        const bool isc = u.pm >= 128; const int grp = isc ? 4 : (u.pm >> 5);
        const float* base = isc ? base_c : base_l; float* out = isc ? out_c : out_l;
        const int row0 = (isc ? (u.pm - 128) : u.pm) * 256 + wr * 64 + fr, col0 = u.pn * 256 + wc * 32 + 8 * fq;
        if (part != nullptr && isc) {
            float* po = part + (size_t)u.br * 1024 * 1024;
#pragma unroll
            for (int ai = 0; ai < 2; ++ai)
#pragma unroll
                for (int m = 0; m < 4; ++m)
#pragma unroll
                    for (int bj = 0; bj < 2; ++bj)
#pragma unroll
                        for (int n = 0; n < 2; ++n) *(f32x4*)(po + (size_t)(row0 + ai * 128 + m * 16) * DM + col0 + bj * 128 + n * 4) = acc[ai][bj][m][n];
            return;
        }
        f32x4 gv[2][2], gnv[2][2];
#pragma unroll
        for (int bj = 0; bj < 2; ++bj)
#pragma unroll
            for (int n = 0; n < 2; ++n) { gv[bj][n] = *(const f32x4*)(gate + grp * NMOD + col0 + bj * 128 + n * 4);
                gnv[bj][n] = gn ? *(const f32x4*)(gn + grp * DM + col0 + bj * 128 + n * 4) : (f32x4){0.f, 0.f, 0.f, 0.f}; }
        const int arow0 = u.pm * 256 + wr * 64 + fr;
#pragma unroll
        for (int ai = 0; ai < 2; ++ai)
#pragma unroll
            for (int mp = 0; mp < 2; ++mp) {
                f32x4 bs[2][2][2];
#pragma unroll
                for (int mq = 0; mq < 2; ++mq)
#pragma unroll
                    for (int bj = 0; bj < 2; ++bj)
#pragma unroll
                        for (int n = 0; n < 2; ++n) bs[mq][bj][n] = *(const f32x4*)(base + (size_t)(row0 + ai * 128 + (2 * mp + mq) * 16) * DM + col0 + bj * 128 + n * 4);
                asm volatile("" ::: "memory");
#pragma unroll
                for (int mq = 0; mq < 2; ++mq) { const int m = 2 * mp + mq; float ss = 0.f;
#pragma unroll
                    for (int bj = 0; bj < 2; ++bj) {
                        const f32x4 o0 = bs[mq][bj][0] + gv[bj][0] * acc[ai][bj][m][0], o1 = bs[mq][bj][1] + gv[bj][1] * acc[ai][bj][m][1];
                        float* op = out + (size_t)(row0 + ai * 128 + m * 16) * DM + col0 + bj * 128;
                        *(f32x4*)op = o0; *(f32x4*)(op + 4) = o1;
                        if (gn) { const f32x4 y0 = o0 * gnv[bj][0], y1 = o1 * gnv[bj][1];
                            v4u w; w.x = cvt_pk_bf16(y0[0], y0[1]); w.y = cvt_pk_bf16(y0[2], y0[3]); w.z = cvt_pk_bf16(y1[0], y1[1]); w.w = cvt_pk_bf16(y1[2], y1[3]);
                            *(v4u*)(ap + (size_t)(arow0 + ai * 128 + m * 16) * DM + col0 + bj * 128) = w;
                            ss += ((o0[0] * o0[0] + o0[1] * o0[1]) + (o0[2] * o0[2] + o0[3] * o0[3])) + ((o1[0] * o1[0] + o1[1] * o1[1]) + (o1[2] * o1[2] + o1[3] * o1[3])); } }
                    if (gn) { ss += __shfl_xor(ss, 16); ss += __shfl_xor(ss, 32);
                        if (fq == 0) __hip_atomic_fetch_add(rs + arow0 + ai * 128 + m * 16, (u64)(ss * 16777216.0f + 0.5f), __ATOMIC_RELAXED, __HIP_MEMORY_SCOPE_AGENT); } }
            }
    }
};
struct EpiResFinal {
    static constexpr bool PERM = true, HOOKS = false; static constexpr int NST = 32;
    float* xo; const float* gate; const float* fg; u64* rs; unsigned* cnt; unsigned* tmo;
    __device__ __forceinline__ void operator()(f32x4 (&acc)[2][2][4][2], const Unit& u, int wr, int wc, int fr, int fq) const {
        asm volatile("" : "+v"(fr), "+v"(fq));
        const int grp = u.pm >> 5, row0 = u.pm * 256 + wr * 64 + fr, col0 = u.pn * 256 + wc * 32 + 8 * fq;
        f32x4 gv[2][2];
#pragma unroll
        for (int bj = 0; bj < 2; ++bj)
#pragma unroll
            for (int n = 0; n < 2; ++n) gv[bj][n] = *(const f32x4*)(gate + grp * NMOD + col0 + bj * 128 + n * 4);
#pragma unroll
        for (int ai = 0; ai < 2; ++ai)
#pragma unroll
            for (int mp = 0; mp < 2; ++mp) {
                f32x4 bs[2][2][2];
#pragma unroll
                for (int mq = 0; mq < 2; ++mq)
#pragma unroll
                    for (int bj = 0; bj < 2; ++bj)
#pragma unroll
                        for (int n = 0; n < 2; ++n) bs[mq][bj][n] = *(const f32x4*)(xo + (size_t)(row0 + ai * 128 + (2 * mp + mq) * 16) * DM + col0 + bj * 128 + n * 4);
                asm volatile("" ::: "memory");
#pragma unroll
                for (int mq = 0; mq < 2; ++mq) { const int m = 2 * mp + mq; float ss = 0.f;
#pragma unroll
                    for (int bj = 0; bj < 2; ++bj)
#pragma unroll
                        for (int n = 0; n < 2; ++n) { const f32x4 o = bs[mq][bj][n] + gv[bj][n] * acc[ai][bj][m][n]; acc[ai][bj][m][n] = o; ss += (o[0] * o[0] + o[1] * o[1]) + (o[2] * o[2] + o[3] * o[3]); }
                    ss += __shfl_xor(ss, 16); ss += __shfl_xor(ss, 32);
                    if (fq == 0) __hip_atomic_fetch_add(rs + row0 + ai * 128 + m * 16, (u64)(ss * 16777216.0f + 0.5f), __ATOMIC_RELAXED, __HIP_MEMORY_SCOPE_AGENT); }
            }
        asm volatile("s_waitcnt vmcnt(0)" ::: "memory");
        unsigned* pc = cnt + 64 * u.pm;
        if (__builtin_amdgcn_mbcnt_hi(~0u, __builtin_amdgcn_mbcnt_lo(~0u, 0u)) == 0) __hip_atomic_fetch_add(pc, 1u, __ATOMIC_RELAXED, __HIP_MEMORY_SCOPE_AGENT);
        { unsigned spins = 0;
          while ((unsigned)__builtin_amdgcn_readfirstlane(__hip_atomic_load(pc, __ATOMIC_RELAXED, __HIP_MEMORY_SCOPE_AGENT)) < 32u) {
              __builtin_amdgcn_s_sleep(2);
              if (++spins > (1u << 22)) { __hip_atomic_store(tmo, 1u, __ATOMIC_RELAXED, __HIP_MEMORY_SCOPE_AGENT); break; } } }
        f32x4 fgv[2][2];
#pragma unroll
        for (int bj = 0; bj < 2; ++bj)
#pragma unroll
            for (int n = 0; n < 2; ++n) fgv[bj][n] = *(const f32x4*)(fg + col0 + bj * 128 + n * 4);
#pragma unroll
        for (int ai = 0; ai < 2; ++ai)
#pragma unroll
            for (int m = 0; m < 4; ++m) { const int row = row0 + ai * 128 + m * 16;
                const float rstd = rs_to_rstd(__hip_atomic_load(rs + row, __ATOMIC_RELAXED, __HIP_MEMORY_SCOPE_AGENT));
#pragma unroll
                for (int bj = 0; bj < 2; ++bj)
#pragma unroll
                    for (int n = 0; n < 2; ++n) *(f32x4*)(xo + (size_t)row * DM + col0 + bj * 128 + n * 4) = acc[ai][bj][m][n] * rstd * fgv[bj][n]; }
    }
};
struct EpiAct {
    static constexpr bool PERM = true, HOOKS = false; static constexpr int NST = 16;
    bf16* a; const u64* rs; const float* cup;
    __device__ __forceinline__ void operator()(const f32x4 (&acc)[2][2][4][2], const Unit& u, int wr, int wc, int fr, int fq) const {
        asm volatile("" : "+v"(fr), "+v"(fq));
        const int grp = u.pm >= 128 ? 4 : (u.pm >> 5);
        const int row0 = u.pm * 256 + wr * 64 + fr, col0 = u.pn * 256 + wc * 32 + 8 * fq;
        const float* cp = cup + grp * FF + col0;
        f32x4 cv[2][2];
#pragma unroll
        for (int bj = 0; bj < 2; ++bj) { cv[bj][0] = *(const f32x4*)(cp + bj * 128); cv[bj][1] = *(const f32x4*)(cp + bj * 128 + 4); }
        u64 rq[2][4]; float rsv[2][4];
#pragma unroll
        for (int ai = 0; ai < 2; ++ai)
#pragma unroll
            for (int m = 0; m < 4; ++m) rq[ai][m] = rs[row0 + ai * 128 + m * 16];
        asm volatile("" ::: "memory");
#pragma unroll
        for (int ai = 0; ai < 2; ++ai)
#pragma unroll
            for (int m = 0; m < 4; ++m) rsv[ai][m] = rs_to_rstd(rq[ai][m]);
#pragma unroll
        for (int ai = 0; ai < 2; ++ai)
#pragma unroll
            for (int m = 0; m < 4; ++m) { const int row = row0 + ai * 128 + m * 16; bf16* rowp = a + (size_t)row * FF + col0; const float rstd = rsv[ai][m];
#pragma unroll
                for (int bj = 0; bj < 2; ++bj) { f32x4 v0 = acc[ai][bj][m][0] * rstd + cv[bj][0], v1 = acc[ai][bj][m][1] * rstd + cv[bj][1];
#pragma unroll
                    for (int e = 0; e < 4; ++e) { const float r0 = fmaxf(v0[e], 0.f), r1 = fmaxf(v1[e], 0.f); v0[e] = r0 * r0; v1[e] = r1 * r1; }
                    v4u w; w.x = cvt_pk_bf16(v0[0], v0[1]); w.y = cvt_pk_bf16(v0[2], v0[3]); w.z = cvt_pk_bf16(v1[0], v1[1]); w.w = cvt_pk_bf16(v1[2], v1[3]);
                    *(v4u*)(rowp + bj * 128) = w; } }
    }
};

constexpr int NS = 8;
constexpr int NSTEPS = 2 + 2 * NS;
constexpr int LARGS_OFF = LDSCTL_OFF + 1024;
enum { A_X = 0, A_C, A_CTX, A_CCTX, A_ADAW, A_ADAB, A_N1G, A_N2G, A_WIN, A_CONVW, A_RELB, A_WF, A_WC, A_WA, A_WO, A_W1, A_W2, A_FG, A_OUT, A_WS, A_NARGS };

struct Ctx { LAS unsigned char* lds; int wave, G, bx, gw, NGW, NGT;
    __device__ __forceinline__ int lane() const { int l; asm volatile("v_mbcnt_lo_u32_b32 %0, -1, 0\n\tv_mbcnt_hi_u32_b32 %0, -1, %0" : "=v"(l)); return l; }
    __device__ __forceinline__ int tid() const { return wave * 64 + lane(); }
    __device__ __forceinline__ int gt() const { return bx * NTHR + tid(); }
};
template <int I> __device__ __forceinline__ unsigned long long ldarg_t() {
    unsigned long long v; unsigned tmp;
    asm volatile("v_mov_b32 %1, %2\n\tds_read_b64 %0, %1 offset:%3\n\ts_waitcnt lgkmcnt(0)" : "=&v"(v), "=&v"(tmp) : "i"(LARGS_OFF), "i"(I * 8) : "memory");
    const unsigned lo = __builtin_amdgcn_readfirstlane((unsigned)v), hi = __builtin_amdgcn_readfirstlane((unsigned)(v >> 32));
    return ((unsigned long long)hi << 32) | lo;
}
#define ldarg(C, i) ldarg_t<(i)>()
#define ARGF(i) ((const float*)(const GAS float*)ldarg(C, (i)))
#define WSP(T, off) ((T*)(GAS T*)((GAS unsigned char*)ldarg(C, A_WS) + (off)))

__device__ __forceinline__ void ph_mod_partial(const Ctx& C) {
    const float* cvec = ARGF(A_C); const float* cctx = ARGF(A_CCTX); const float* ada_w = ARGF(A_ADAW);
    float* modp = WSP(float, WS_MODP); float2* tw = WSP(float2, WS_TW);
    LAS float* sl = (LAS float*)C.lds;
    for (int item = C.bx; item < 2 * 8 * 12; item += C.G) {
        const int l = item / 96, rem = item % 96, kc = rem / 12, jb = rem % 12;
        __syncthreads();
        for (int e = C.tid(); e < 5 * 128; e += NTHR) { const int g = e >> 7, k = kc * 128 + (e & 127); const float v = g < 4 ? cvec[g * DM + k] : cctx[k]; sl[e] = v / (1.0f + __expf(-v)); }
        __syncthreads();
        const int j = jb * 512 + C.tid(); float a0 = 0.f, a1 = 0.f, a2 = 0.f, a3 = 0.f, a4 = 0.f;
        const float* wp = ada_w + ((size_t)l * DM + kc * 128) * NMOD + j;
#pragma unroll 4
        for (int k = 0; k < 128; ++k) { const float w = wp[(size_t)k * NMOD]; a0 += sl[k] * w; a1 += sl[128 + k] * w; a2 += sl[256 + k] * w; a3 += sl[384 + k] * w; a4 += sl[512 + k] * w; }
        float* pp = modp + ((size_t)(l * 8 + kc) * 5) * NMOD + j;
        pp[0] = a0; pp[NMOD] = a1; pp[2 * NMOD] = a2; pp[3 * NMOD] = a3; pp[4 * NMOD] = a4;
    }
    for (int m = C.gt(); m < 8192; m += C.NGT) { float s, c; sincospif((float)m * (1.0f / 4096.0f), &s, &c); tw[m] = make_float2(c, s); }
}
__device__ __forceinline__ void ph_mod_reduce(const Ctx& C) {
    const float* ada_b = ARGF(A_ADAB); const float* modp = WSP(float, WS_MODP); float* mod = WSP(float, WS_MOD);
    for (int e = C.gt(); e < 2 * 5 * NMOD; e += C.NGT) { const int l = e / (5 * NMOD), r = e % (5 * NMOD), j = r % NMOD; float s = ada_b[l * NMOD + j];
#pragma unroll
        for (int kc = 0; kc < 8; ++kc) s += modp[(size_t)(l * 8 + kc) * 5 * NMOD + r];
        mod[e] = s; }
    float* gnt = WSP(float, WS_GN); const float* n1g = ARGF(A_N1G); const float* n2g = ARGF(A_N2G);
    for (int e = C.gt(); e < 2 * 2 * 5 * DM; e += C.NGT) { const int col = e & 1023, grp = (e >> 10) % 5, w = (e / (5 * DM)) & 1, l = e / (10 * DM), j = (w ? 4 : 1) * DM + col;
        float s = ada_b[l * NMOD + j];
#pragma unroll
        for (int kc = 0; kc < 8; ++kc) s += modp[((size_t)(l * 8 + kc) * 5 + grp) * NMOD + j];
        gnt[e] = (w ? n2g : n1g)[l * DM + col] * (1.0f + s); }
}
__device__ __forceinline__ void ph_ctab(const Ctx& C, int l) {
    LAS float* red = (LAS float*)(C.lds + 131072); LAS float* cu = red + 8 * 5 * 64;
    const float* modl = WSP(const float, WS_MOD) + (size_t)l * 5 * NMOD; const float2* tw = WSP(const float2, WS_TW);
    float* cin = WSP(float, WS_CIN) + (size_t)l * 5 * NIN; float* cup = WSP(float, WS_CUP) + (size_t)l * 5 * FF;
    const int lane = C.lane(), w = C.wave, tid = C.tid();
    for (int it = C.bx; it < 88 + 64; it += C.G) {
        const bool isin = it < 88; const int ldw = isin ? NIN_ORIG : FF, col0 = (isin ? it : it - 88) * 64;
        const float* W = (isin ? ARGF(A_WIN) + (size_t)l * DM * NIN_ORIG : ARGF(A_W1) + (size_t)l * DM * FF) + (size_t)(128 * w) * ldw + col0 + lane;
        const float* shp = modl + (isin ? 0 : 3 * DM) + 128 * w;
        float a0 = 0.f, a1 = 0.f, a2 = 0.f, a3 = 0.f, a4 = 0.f;
#pragma unroll 16
        for (int kk = 0; kk < 128; ++kk) { const float wv = W[(size_t)kk * ldw]; a0 += shp[kk] * wv; a1 += shp[NMOD + kk] * wv; a2 += shp[2 * NMOD + kk] * wv; a3 += shp[3 * NMOD + kk] * wv; a4 += shp[4 * NMOD + kk] * wv; }
        __syncthreads();
        red[(w * 5 + 0) * 64 + lane] = a0; red[(w * 5 + 1) * 64 + lane] = a1; red[(w * 5 + 2) * 64 + lane] = a2; red[(w * 5 + 3) * 64 + lane] = a3; red[(w * 5 + 4) * 64 + lane] = a4;
        __syncthreads();
        if (tid < 320) { const int g = tid >> 6, c = tid & 63; float v = 0.f;
#pragma unroll
            for (int ww = 0; ww < 8; ++ww) v += red[(ww * 5 + g) * 64 + c];
            if (!isin) cup[g * FF + col0 + c] = v; else if (it >= 4) cin[g * NIN + col0 + c + 256] = v; else cu[g * 64 + c] = v; }
        if (isin && it < 4) { __syncthreads();
            if (tid < 320) { const int g = tid >> 6, kc = tid & 63; float p = 0.f, q = 0.f;
                for (int c = 0; c < 64; ++c) { const float2 t = tw[((c * kc) & 63) * 128]; const float v = cu[g * 64 + c]; p += v * t.x; q += v * t.y; }
                cin[g * NIN + it * 64 + kc] = p; cin[g * NIN + 256 + it * 64 + kc] = q; } }
    }
    __syncthreads();
}
__device__ __forceinline__ void ph_weights(const Ctx& C, int l) {
    LAS float* scr = (LAS float*)(C.lds + C.wave * 16384);
    const int lane = C.lane();
    const float* Win = ARGF(A_WIN) + (size_t)l * DM * NIN_ORIG;
    bf16* win_t = WSP(bf16, WS_WIN); bf16* wm_t = WSP(bf16, WS_WM);
    constexpr int I_IN = (DM / 64) * ((NIN_ORIG - 256) / 32), I_F = (256 / 64) * (DM / 32), I_A = (512 / 64) * (DM / 32), I_O = (DM / 64) * (DM / 32), I_1 = (DM / 64) * (FF / 32), I_2 = (FF / 64) * (DM / 32);
    constexpr int NITEMS = I_IN + 2 * I_F + I_A + I_O + I_1 + I_2;
    for (int it = C.gw; it < NITEMS; it += C.NGW) {
        int r = it;
        if (r < I_IN) { transpose_item(Win + 256, NIN_ORIG, NIN_ORIG - 256, win_t, DM, 512, 0, scr, r, lane); continue; } r -= I_IN;
        if (r < I_F) { transpose_item(ARGF(A_WF) + (size_t)l * 256 * DM, DM, DM, wm_t, DM, 0, 0, scr, r, lane); continue; } r -= I_F;
        if (r < I_F) { transpose_item(ARGF(A_WC) + (size_t)l * 256 * DM, DM, DM, wm_t, DM, 0, 256, scr, r, lane); continue; } r -= I_F;
        if (r < I_A) { transpose_item(ARGF(A_WA) + (size_t)l * 512 * DM, DM, DM, wm_t, DM, 0, 512, scr, r, lane); continue; } r -= I_A;
        if (r < I_O) { transpose_item(ARGF(A_WO) + (size_t)l * DM * DM, DM, DM, WSP(bf16, WS_WO), DM, 0, 0, scr, r, lane); continue; } r -= I_O;
        if (r < I_1) { transpose_item(ARGF(A_W1) + (size_t)l * DM * FF, FF, FF, WSP(bf16, WS_W1), DM, 0, 0, scr, r, lane); continue; } r -= I_1;
        transpose_item(ARGF(A_W2) + (size_t)l * FF * DM, DM, DM, WSP(bf16, WS_W2), FF, 0, 0, scr, r, lane);
    }
    for (int it = C.gw; it < 4 * 32 * 8; it += C.NGW) {
        const int kq = it & 7, g = it >> 8, k0 = ((it >> 3) & 31) * 32, kl = lane & 31, pq = lane >> 5;
        LAS float* tile = scr;
        LAS float* ct = scr + 32 * 65;
        { float s, c; sincospif((float)lane * (1.0f / 32.0f), &s, &c); ct[lane] = c; ct[64 + lane] = s; }
#pragma unroll 8
        for (int kk = 0; kk < 32; ++kk) tile[kk * 65 + lane] = Win[(size_t)(k0 + kk) * NIN_ORIG + g * 64 + lane];
        LDS_WAIT(); asm volatile("" ::: "memory");
        float p[8];
#pragma unroll
        for (int j = 0; j < 8; ++j) p[j] = 0.f;
#pragma unroll 4
        for (int c = 0; c < 64; ++c) { const float wv = tile[kl * 65 + c];
#pragma unroll
            for (int j = 0; j < 8; ++j) p[j] += wv * ct[pq * 64 + ((c * (kq * 8 + j)) & 63)]; }
#pragma unroll
        for (int j = 0; j < 8; ++j) win_t[(size_t)(pq * 256 + g * 64 + kq * 8 + j) * DM + k0 + kl] = (bf16)f2bf(p[j]);
        LDS_WAIT(); asm volatile("" ::: "memory");
    }
}
__device__ __forceinline__ void ph_prenorm(const Ctx& C, const float* xl, const float* xc, const float* gn, bf16* dst, u64* rs, int row_begin, int row_end, const float* part, const float* pgate) {
    const int lane = C.lane();
    for (int row = row_begin + C.gw; row < row_end; row += C.NGW) {
        const bool isc = row >= ML; const int grp = isc ? 4 : (row >> 13);
        const float* xr = isc ? xc + (size_t)(row - ML) * DM : xl + (size_t)row * DM;
        f32x4 v[4]; float s2 = 0.f;
#pragma unroll
        for (int j = 0; j < 4; ++j) { v[j] = *(const f32x4*)(xr + 4 * lane + 256 * j);
            if (part != nullptr && isc) {
                const size_t po = (size_t)(row - ML) * DM + 4 * lane + 256 * j;
                const f32x4 ps = (*(const f32x4*)(part + po) + *(const f32x4*)(part + po + 1048576)) + (*(const f32x4*)(part + po + 2 * 1048576) + *(const f32x4*)(part + po + 3 * 1048576));
                v[j] = v[j] + *(const f32x4*)(pgate + 4 * lane + 256 * j) * ps; }
            s2 += (v[j].x * v[j].x + v[j].y * v[j].y) + (v[j].z * v[j].z + v[j].w * v[j].w); }
        s2 = wave_sum(s2);
        if (lane == 0) rs[row] = (u64)(s2 * 16777216.0f + 0.5f);
#pragma unroll
        for (int j = 0; j < 4; ++j) { const int c0 = 4 * lane + 256 * j; const f32x4 y = v[j] * *(const f32x4*)(gn + grp * DM + c0);
            v2u o; o.x = pk2(y.x, y.y); o.y = pk2(y.z, y.w); *(v2u*)(dst + (size_t)row * DM + c0) = o; }
    }
}
__device__ __forceinline__ void ph_mixers(const Ctx& C, int l) {
    const float2* tw = WSP(const float2, WS_TW); const bf16* pxa = WSP(const bf16, WS_PXA); bf16* mix = WSP(bf16, WS_HX);
    const int lane = C.lane();
    if (l == 0) {
        LAS float* twl = (LAS float*)(C.lds + 98304);
        { const int t = C.tid(); if (t < 256) { const float2 v = tw[t * 32]; twl[2 * t] = v.x; twl[2 * t + 1] = v.y; } }
        __syncthreads();
        for (int it = C.gw; it < NB * 4 * 128; it += C.NGW) {
            const int kp = it & 127, kcb = (it >> 7) & 3, bb = it >> 9, k0 = 2 * kp, kc = kcb * 64 + lane;
            const bf16* src = pxa + ((size_t)ML + bb * 256) * NPXA + kc; float y0 = 0.f, y1 = 0.f;
#pragma unroll 32
            for (int n = 0; n < 256; ++n) { const float p = bf2f(src[(size_t)n * NPXA + OFF_P]), q = bf2f(src[(size_t)n * NPXA + OFF_Q]);
                const int i0 = (n * k0) & 255, i1 = (n * (k0 + 1)) & 255;
                y0 += p * twl[2 * i0] - q * twl[2 * i0 + 1]; y1 += p * twl[2 * i1] - q * twl[2 * i1 + 1]; }
            mix[((size_t)ML + bb * 256 + k0) * DM + kc] = (bf16)f2bf(y0 * (1.0f / 128.0f));
            mix[((size_t)ML + bb * 256 + k0 + 1) * DM + kc] = (bf16)f2bf(y1 * (1.0f / 128.0f));
        }
    }
    const float* cw = ARGF(A_CONVW) + l * 3 * 256;
    const int nrows = l == 0 ? MT : ML;
    for (int e = C.gt(); e < nrows * 32; e += C.NGT) {
        const int row = e >> 5, ch = (e & 31) * 8;
        const int pos = row < ML ? (row & (SEQ - 1)) : ((row - ML) & 255), len = row < ML ? SEQ : 256;
        const bf16* pr = pxa + (size_t)row * NPXA;
        const v4u u1 = *(const v4u*)(pr + OFF_CU + ch), c1 = *(const v4u*)(pr + OFF_CC + ch), b1 = *(const v4u*)(pr + OFF_CB + ch);
        v4u u0 = (v4u){0, 0, 0, 0}, c0 = u0, u2 = u0, c2 = u0;
        if (pos > 0) { u0 = *(const v4u*)(pr - NPXA + OFF_CU + ch); c0 = *(const v4u*)(pr - NPXA + OFF_CC + ch); }
        if (pos < len - 1) { u2 = *(const v4u*)(pr + NPXA + OFF_CU + ch); c2 = *(const v4u*)(pr + NPXA + OFF_CC + ch); }
        float o[8]; float w0[8], w1[8], w2[8];
        { const f32x4 t0 = *(const f32x4*)(cw + ch), t1 = *(const f32x4*)(cw + ch + 4), t2 = *(const f32x4*)(cw + 256 + ch), t3 = *(const f32x4*)(cw + 256 + ch + 4), t4 = *(const f32x4*)(cw + 512 + ch), t5 = *(const f32x4*)(cw + 512 + ch + 4);
#pragma unroll
          for (int j = 0; j < 4; ++j) { w0[j] = t0[j]; w0[4 + j] = t1[j]; w1[j] = t2[j]; w1[4 + j] = t3[j]; w2[j] = t4[j]; w2[4 + j] = t5[j]; } }
#pragma unroll
        for (int j = 0; j < 4; ++j) {
            const unsigned a0 = u0[j], d0 = c0[j], a1 = u1[j], d1 = c1[j], a2 = u2[j], d2 = c2[j], bb = b1[j];
            o[2 * j] = bflo(bb) * (w0[2 * j] * bflo(a0) * bflo(d0) + w1[2 * j] * bflo(a1) * bflo(d1) + w2[2 * j] * bflo(a2) * bflo(d2));
            o[2 * j + 1] = bfhi(bb) * (w0[2 * j + 1] * bfhi(a0) * bfhi(d0) + w1[2 * j + 1] * bfhi(a1) * bfhi(d1) + w2[2 * j + 1] * bfhi(a2) * bfhi(d2));
        }
        v4u w; w.x = pk2(o[0], o[1]); w.y = pk2(o[2], o[3]); w.z = pk2(o[4], o[5]); w.w = pk2(o[6], o[7]);
        *(v4u*)(mix + (size_t)row * DM + 256 + ch) = w;
    }
}

typedef short bf16x8_t __attribute__((ext_vector_type(8)));
typedef short v4i16_t __attribute__((ext_vector_type(4)));
constexpr int AT_KW = 0, AT_VW = 73728, AT_BT = 147456;
template <bool WIN>
__device__ __forceinline__ void attn_block(LAS unsigned char* lds, const int (&ka)[2][2], const int (&va)[2][4], int rowoff0, const bf16x8_t (&qf)[2],
                                           const LAS float* brow  , const int (&dc)[2][4], unsigned vmask, f32x4 (&o)[4], float& m, float& l) {
    constexpr float SC = 0.18033688011112042f;
    constexpr int RS = WIN ? 8192 : 4096;
    f32x4 s[8][2];
#pragma unroll
    for (int j = 0; j < 8; ++j)
#pragma unroll
        for (int t = 0; t < 2; ++t) { s[j][t] = (f32x4){0.f, 0.f, 0.f, 0.f};
#pragma unroll
            for (int ks = 0; ks < 2; ++ks) { const bf16x8_t kf = *(const LAS bf16x8_t*)(lds + ka[t][ks] + rowoff0 + j * RS); s[j][t] = __builtin_amdgcn_mfma_f32_16x16x32_bf16(kf, qf[ks], s[j][t], 0, 0, 0); } }
    float tmax = -1e30f;
#pragma unroll
    for (int j = 0; j < 8; ++j)
#pragma unroll
        for (int t = 0; t < 2; ++t)
#pragma unroll
            for (int i = 0; i < 4; ++i) { float v = s[j][t][i] * SC; if (WIN) { v += brow[j * 31 + dc[t][i]]; if (!((vmask >> (t * 4 + i)) & 1u)) v = -1e30f; } s[j][t][i] = v; tmax = fmaxf(tmax, v); }
    tmax = fmaxf(tmax, __shfl_xor(tmax, 16)); tmax = fmaxf(tmax, __shfl_xor(tmax, 32));
    const float mn = fmaxf(m, tmax), alpha = __builtin_amdgcn_exp2f(m - mn); m = mn;
    float ps = 0.f;
#pragma unroll
    for (int j = 0; j < 8; ++j)
#pragma unroll
        for (int t = 0; t < 2; ++t)
#pragma unroll
            for (int i = 0; i < 4; ++i) { const float p = __builtin_amdgcn_exp2f(s[j][t][i] - mn); s[j][t][i] = p; ps += p; }
    l = l * alpha + ps;
#pragma unroll
    for (int db = 0; db < 4; ++db) o[db] = o[db] * alpha;
#pragma unroll
    for (int j = 0; j < 8; ++j) {
        v4u pw; pw.x = pg8::cvt_pk_bf16(s[j][0][0], s[j][0][1]); pw.y = pg8::cvt_pk_bf16(s[j][0][2], s[j][0][3]); pw.z = pg8::cvt_pk_bf16(s[j][1][0], s[j][1][1]); pw.w = pg8::cvt_pk_bf16(s[j][1][2], s[j][1][3]);
        const bf16x8_t pf = __builtin_bit_cast(bf16x8_t, pw);
#pragma unroll
        for (int db = 0; db < 4; ++db) {
            const v4i16_t lo = __builtin_amdgcn_ds_read_tr16_b64_v4i16((LAS v4i16_t*)(lds + va[0][db] + rowoff0 + j * RS));
            const v4i16_t hi = __builtin_amdgcn_ds_read_tr16_b64_v4i16((LAS v4i16_t*)(lds + va[1][db] + rowoff0 + j * RS));
            const bf16x8_t vf = (bf16x8_t){lo[0], lo[1], lo[2], lo[3], hi[0], hi[1], hi[2], hi[3]};
            o[db] = __builtin_amdgcn_mfma_f32_16x16x32_bf16(vf, pf, o[db], 0, 0, 0);
        }
    }
}
__device__ __forceinline__ void attn_addr(int kc0off, int li, int fq, int (&ka)[2][2], int (&va)[2][4]) {
#pragma unroll
    for (int t = 0; t < 2; ++t) {
        const int rk = kc0off + 16 * t + li;
#pragma unroll
        for (int ks = 0; ks < 2; ++ks) ka[t][ks] = AT_KW + rk * 128 + (((4 * ks + fq) ^ ((rk >> 1) & 7)) * 16);
        const int rv = kc0off + 16 * t + 4 * fq + (li >> 2), p = li & 3;
#pragma unroll
        for (int db = 0; db < 4; ++db) va[t][db] = AT_VW + rv * 128 + (((2 * db + (p >> 1)) ^ (((rv >> 1) & 3) << 1)) * 16) + (p & 1) * 8;
    }
}

__device__ __forceinline__ size_t zt_off(int b) { return b < 2 ? WS_TB + (size_t)b * 8 * MiB : (b == 2 ? (size_t)502 * MiB : WS_WIN); }
__device__ __forceinline__ void ph_t1(const Ctx& C) {
    const bf16* pxa = WSP(const bf16, WS_PXA); const int lane = C.lane();
    LAS unsigned short* tile = (LAS unsigned short*)(C.lds + C.wave * 9216);
    for (int it = C.gw; it < 4 * 2 * 128 * 4; it += C.NGW) {
        const int kcb = it & 3, n2 = (it >> 2) & 127, pq = (it >> 9) & 1, b = it >> 10;
#pragma unroll
        for (int i = 0; i < 8; ++i) { const int q = i * 64 + lane, n1 = q >> 3, cc = q & 7;
            const v4u v = *(const v4u*)(pxa + ((size_t)b * SEQ + n1 * 128 + n2) * NPXA + pq * 256 + kcb * 64 + cc * 8);
            *(LAS v4u*)(tile + n1 * 72 + cc * 8) = v; }
        LDS_WAIT(); asm volatile("" ::: "memory");
        bf16* zt = WSP(bf16, zt_off(b)) + ((size_t)(pq * 256 + kcb * 64 + lane) * SEQ + n2 * 64);
#pragma unroll
        for (int c = 0; c < 8; ++c) { v4u o;
            o.x = (unsigned)tile[(8 * c + 0) * 72 + lane] | ((unsigned)tile[(8 * c + 1) * 72 + lane] << 16); o.y = (unsigned)tile[(8 * c + 2) * 72 + lane] | ((unsigned)tile[(8 * c + 3) * 72 + lane] << 16);
            o.z = (unsigned)tile[(8 * c + 4) * 72 + lane] | ((unsigned)tile[(8 * c + 5) * 72 + lane] << 16); o.w = (unsigned)tile[(8 * c + 6) * 72 + lane] | ((unsigned)tile[(8 * c + 7) * 72 + lane] << 16);
            *(v4u*)(zt + 8 * c) = o; }
        LDS_WAIT(); asm volatile("" ::: "memory");
    }
}
typedef float f32x16 __attribute__((ext_vector_type(16)));
constexpr int FT_C64 = 0, FT_S64 = 9216, FT_C128 = 18432, FT_S128 = FT_C128 + 34816, FT_TA = FT_S128 + 34816, FT_TR = FT_TA + 4096, FT_ST = FT_TR + 8192;
static_assert(FT_ST + 32768 <= LDSCTL_OFF, "fft lds");
__device__ __forceinline__ int crow16(int r, int h) { return (r & 3) + 8 * (r >> 2) + 4 * h; }
__device__ __forceinline__ void ph_fft(const Ctx& C) {
    LAS unsigned char* lds = C.lds; const int tid = C.tid(), lane = C.lane(), w = C.wave, h = lane >> 5, c = lane & 31;
    const float2* tw = WSP(const float2, WS_TW); bf16* mix = WSP(bf16, WS_HX);
    { LAS unsigned short* c64 = (LAS unsigned short*)(lds + FT_C64); LAS unsigned short* s64 = (LAS unsigned short*)(lds + FT_S64);
#pragma unroll 4
      for (int e = tid; e < 4096; e += NTHR) { const int k1 = e >> 6, n1 = e & 63; float sn, cs; sincospif((float)((n1 * k1) & 63) * (1.0f / 32.0f), &sn, &cs); c64[k1 * 72 + n1] = (unsigned short)f2bf(cs); s64[k1 * 72 + n1] = (unsigned short)f2bf(sn); }
      LAS unsigned short* c128 = (LAS unsigned short*)(lds + FT_C128); LAS unsigned short* s128 = (LAS unsigned short*)(lds + FT_S128);
#pragma unroll 4
      for (int e = tid; e < 16384; e += NTHR) { const int k2 = e >> 7, p = e & 127, q = p & 15, n2 = (p & ~15) + (q & 3) + ((q >> 2) & 1) * 8 + ((q >> 3) & 1) * 4;
          float sn, cs; sincospif((float)((n2 * k2) & 127) * (1.0f / 64.0f), &sn, &cs); c128[k2 * 136 + p] = (unsigned short)f2bf(cs); s128[k2 * 136 + p] = (unsigned short)f2bf(sn); }
      LAS float* ta = (LAS float*)(lds + FT_TA); LAS float* trt = (LAS float*)(lds + FT_TR);
      { const int e = tid, g = e >> 6, kk = e & 63; float sn, cs; sincospif((float)((32 * (g >> 1) + 4 * (g & 1)) * kk) * (1.0f / 4096.0f), &sn, &cs); ta[2 * e] = cs; ta[2 * e + 1] = sn; }
      for (int e = tid; e < 1024; e += NTHR) { const int r = e >> 6, kk = e & 63; float sn, cs; sincospif((float)(crow16(r, 0) * kk) * (1.0f / 4096.0f), &sn, &cs); trt[2 * e] = cs; trt[2 * e + 1] = sn; }
    }
    __syncthreads();
    const int vcu = (C.G % 8 == 0) ? (C.bx % 8) * (C.G / 8) + C.bx / 8 : C.bx;
    for (int it = vcu; it < 256; it += C.G) {
        const int kb = it & 1, kcg = (it >> 1) & 31, b = it >> 6, kc = kcg * 8 + w, k1 = 32 * kb + c;
        const bf16* zp = WSP(const bf16, zt_off(b)) + (size_t)kc * SEQ; const bf16* zq = zp + (size_t)256 * SEQ;
        f32x16 acc[4];
#pragma unroll
        for (int rb2 = 0; rb2 < 4; ++rb2) acc[rb2] = (f32x16){};
#pragma unroll 1
        for (int rb = 0; rb < 4; ++rb) {
            const int n2 = 32 * rb + c;
            f32x16 xr = {}, xi = {};
#pragma unroll
            for (int ks = 0; ks < 4; ++ks) {
                const bf16x8_t cf = *(const LAS bf16x8_t*)(lds + FT_C64 + (k1 * 72 + 16 * ks + 8 * h) * 2), sf = *(const LAS bf16x8_t*)(lds + FT_S64 + (k1 * 72 + 16 * ks + 8 * h) * 2);
                const bf16x8_t pf = *(const bf16x8_t*)(zp + n2 * 64 + 16 * ks + 8 * h), qf = *(const bf16x8_t*)(zq + n2 * 64 + 16 * ks + 8 * h);
                const v4u t = __builtin_bit_cast(v4u, qf) ^ 0x80008000u; const bf16x8_t qn = __builtin_bit_cast(bf16x8_t, t);
                xr = __builtin_amdgcn_mfma_f32_32x32x16_bf16(pf, cf, xr, 0, 0, 0); xi = __builtin_amdgcn_mfma_f32_32x32x16_bf16(pf, sf, xi, 0, 0, 0);
                xi = __builtin_amdgcn_mfma_f32_32x32x16_bf16(qf, cf, xi, 0, 0, 0); xr = __builtin_amdgcn_mfma_f32_32x32x16_bf16(qn, sf, xr, 0, 0, 0); }
            bf16x8_t bre[2], bim[2];
            const LAS float* tap = (const LAS float*)(lds + FT_TA) + 2 * ((rb * 2 + h) * 64 + k1); const float ac_ = tap[0], as_ = tap[1];
            const LAS float* trp = (const LAS float*)(lds + FT_TR) + 2 * k1;
#pragma unroll
            for (int sblk = 0; sblk < 2; ++sblk) {
                float tr[8], ti[8];
#pragma unroll
                for (int r8 = 0; r8 < 8; ++r8) { const int r = 8 * sblk + r8; const float rc = trp[128 * r], rs = trp[128 * r + 1]; const float tc = ac_ * rc - as_ * rs, ts = ac_ * rs + as_ * rc;
                    tr[r8] = xr[r] * tc - xi[r] * ts; ti[r8] = -(xr[r] * ts + xi[r] * tc); }
                v4u a, bq;
                a.x = pg8::cvt_pk_bf16(tr[0], tr[1]); a.y = pg8::cvt_pk_bf16(tr[2], tr[3]); a.z = pg8::cvt_pk_bf16(tr[4], tr[5]); a.w = pg8::cvt_pk_bf16(tr[6], tr[7]);
                bq.x = pg8::cvt_pk_bf16(ti[0], ti[1]); bq.y = pg8::cvt_pk_bf16(ti[2], ti[3]); bq.z = pg8::cvt_pk_bf16(ti[4], ti[5]); bq.w = pg8::cvt_pk_bf16(ti[6], ti[7]);
                bre[sblk] = __builtin_bit_cast(bf16x8_t, a); bim[sblk] = __builtin_bit_cast(bf16x8_t, bq); }
#pragma unroll
            for (int rb2 = 0; rb2 < 4; ++rb2) {
                const int k2 = 32 * rb2 + c;
#pragma unroll
                for (int sblk = 0; sblk < 2; ++sblk) {
                    const bf16x8_t ac = *(const LAS bf16x8_t*)(lds + FT_C128 + (k2 * 136 + 32 * rb + 16 * sblk + 8 * h) * 2), as = *(const LAS bf16x8_t*)(lds + FT_S128 + (k2 * 136 + 32 * rb + 16 * sblk + 8 * h) * 2);
                    acc[rb2] = __builtin_amdgcn_mfma_f32_32x32x16_bf16(ac, bre[sblk], acc[rb2], 0, 0, 0); acc[rb2] = __builtin_amdgcn_mfma_f32_32x32x16_bf16(as, bim[sblk], acc[rb2], 0, 0, 0); }
            }
        }
#pragma unroll
        for (int rb2 = 0; rb2 < 4; ++rb2) {
            LAS unsigned short* st = (LAS unsigned short*)(lds + FT_ST + (rb2 & 1) * 16384);
#pragma unroll
            for (int r = 0; r < 16; ++r) st[((crow16(r, h) * 32 + c) * 8) + w] = (unsigned short)f2bf(acc[rb2][r] * 0.001381067932f);
            LDS_WAIT(); __syncthreads();
#pragma unroll
            for (int j = 0; j < 2; ++j) { const int idx = tid + 512 * j, k2l = idx >> 5, k1l = idx & 31;
                const v4u v = *(const LAS v4u*)(st + idx * 8);
                *(v4u*)(mix + ((size_t)b * SEQ + 32 * kb + k1l + 64 * (32 * rb2 + k2l)) * DM + kcg * 8) = v; }
        }
        __syncthreads();
    }
}
__device__ __forceinline__ void ph_attn(const Ctx& C, int l) {
    const bf16* pxa = WSP(const bf16, WS_PXA); bf16* mix = WSP(bf16, WS_HX);
    const float* rb = ARGF(A_RELB) + (size_t)l * 8 * 15 * 31;
    LAS unsigned char* lds = C.lds; LAS float* biasT = (LAS float*)(lds + AT_BT);
    const int lane = C.lane(), w = C.wave, fq = lane >> 4, li = lane & 15, tid = C.tid();
    const int nunits = 2048 + (l == 0 ? 64 : 0);
    const int vcu = (C.G % 8 == 0) ? (C.bx % 8) * (C.G / 8) + C.bx / 8 : C.bx;
    for (int u = vcu; u < nunits; u += C.G) {
        const bool isc = u >= 2048;
        int b, h, rp; if (!isc) { b = u >> 9; h = (u >> 6) & 7; rp = u & 63; } else { const int v = u - 2048; b = v >> 4; h = (v >> 1) & 7; rp = v & 1; }
        __syncthreads();
        for (int e = tid; e < 465; e += NTHR) biasT[e] = rb[h * 465 + e] * 1.4426950408889634f;
        const int R0 = min(max(2 * rp - 4, 0), 120);
        if (!isc) {
            for (int p = w; p < 72; p += 8) {
                const int tokl = p * 8 + (lane >> 3), lr = tokl >> 6, col = tokl & 63, gr = min(R0 + lr, 127), cp = lane & 7;
                const bf16* src = pxa + ((size_t)b * SEQ + gr * 64 + col) * NPXA + h * 64;
                __builtin_amdgcn_global_load_lds((const unsigned*)(src + OFF_K + ((cp ^ ((tokl >> 1) & 7)) * 8)), (LAS unsigned*)(lds + AT_KW + p * 1024), 16, 0, 0);
                __builtin_amdgcn_global_load_lds((const unsigned*)(src + OFF_V + ((cp ^ (((tokl >> 1) & 3) << 1)) * 8)), (LAS unsigned*)(lds + AT_VW + p * 1024), 16, 0, 0);
            }
        }
        int r = 0, qc = 0; size_t token;
        if (!isc) { r = 2 * rp + (w >> 2); qc = 16 * (w & 3) + li; token = (size_t)b * SEQ + r * 64 + qc; }
        else token = (size_t)ML + b * 256 + rp * 128 + 16 * w + li;
        bf16x8_t qf[2];
#pragma unroll
        for (int ks = 0; ks < 2; ++ks) qf[ks] = *(const bf16x8_t*)(pxa + token * NPXA + OFF_QQ + h * 64 + 32 * ks + 8 * fq);
        f32x4 o[4]; float m = -1e30f, lsum = 0.f;
#pragma unroll
        for (int db = 0; db < 4; ++db) o[db] = (f32x4){0.f, 0.f, 0.f, 0.f};
        int ka[2][2], va[2][4], dc[2][4];
        asm volatile("s_waitcnt vmcnt(0)" ::: "memory");
        __syncthreads();
        if (!isc) {
            const int cb = w & 3, kc0 = cb == 0 ? 0 : cb == 1 ? 8 : cb == 2 ? 24 : 32;
            attn_addr(kc0, li, fq, ka, va);
            const int csq = min(max(qc - 8, 0), 48); unsigned vmask = 0u;
#pragma unroll
            for (int t = 0; t < 2; ++t)
#pragma unroll
                for (int i = 0; i < 4; ++i) { const int kcol = kc0 + 16 * t + 4 * fq + i; if (kcol >= csq && kcol < csq + 16) vmask |= 1u << (t * 4 + i); dc[t][i] = min(max(kcol - qc + 15, 0), 30); }
            const int rsr = min(max(r - 4, 0), 120), lr0 = rsr - R0;
            attn_block<true>(lds, ka, va, lr0 * 8192, qf, biasT + (rsr - r + 7) * 31, dc, vmask, o, m, lsum);
        }
        __syncthreads();
        for (int p = w; p < 32; p += 8) {
            const int tokl = p * 8 + (lane >> 3), cp = lane & 7;
            const bf16* src = pxa + ((size_t)ML + b * 256 + tokl) * NPXA + h * 64;
            __builtin_amdgcn_global_load_lds((const unsigned*)(src + OFF_K + ((cp ^ ((tokl >> 1) & 7)) * 8)), (LAS unsigned*)(lds + AT_KW + p * 1024), 16, 0, 0);
            __builtin_amdgcn_global_load_lds((const unsigned*)(src + OFF_V + ((cp ^ (((tokl >> 1) & 3) << 1)) * 8)), (LAS unsigned*)(lds + AT_VW + p * 1024), 16, 0, 0);
        }
        attn_addr(0, li, fq, ka, va);
        asm volatile("s_waitcnt vmcnt(0)" ::: "memory");
        __syncthreads();
        attn_block<false>(lds, ka, va, 0, qf, (const LAS float*)nullptr, dc, 0xffu, o, m, lsum);
        lsum += __shfl_xor(lsum, 16); lsum += __shfl_xor(lsum, 32);
        const float inv = 1.0f / lsum;
        bf16* op = mix + token * DM + 512 + h * 64 + 4 * fq;
#pragma unroll
        for (int db = 0; db < 4; ++db) { v2u ov; ov.x = pk2(o[db][0] * inv, o[db][1] * inv); ov.y = pk2(o[db][2] * inv, o[db][3] * inv); *(v2u*)(op + 16 * db) = ov; }
    }
}
__device__ __forceinline__ void ph_final(const Ctx& C) {
    float* out = (float*)(GAS float*)ldarg(C, A_OUT); const float* fg = ARGF(A_FG); const int lane = C.lane();
    for (int row = C.gw; row < ML; row += C.NGW) {
        float* xr = out + (size_t)row * DM;
        f32x4 v[4]; float s2 = 0.f;
#pragma unroll
        for (int j = 0; j < 4; ++j) { v[j] = *(const f32x4*)(xr + 4 * lane + 256 * j); s2 += (v[j].x * v[j].x + v[j].y * v[j].y) + (v[j].z * v[j].z + v[j].w * v[j].w); }
        const float rstd = 1.0f / sqrtf(wave_sum(s2) * (1.0f / DM) + EPS);
#pragma unroll
        for (int j = 0; j < 4; ++j) { const int c0 = 4 * lane + 256 * j; const f32x4 gg = *(const f32x4*)(fg + c0); *(f32x4*)(xr + c0) = v[j] * rstd * gg; }
    }
}

struct Args { const void* p[A_NARGS]; int ph_lo, ph_hi; };

__global__ void __launch_bounds__(NTHR, 2) fwd_kernel(Args args) {
    extern __shared__ __attribute__((aligned(16))) unsigned char lds_raw[];
    LAS unsigned char* const lds0 = (LAS unsigned char*)lds_raw;
    const int wave0 = __builtin_amdgcn_readfirstlane(threadIdx.x >> 6);
    { const int t0 = threadIdx.x;
      for (int u = t0; u < (LDS_BYTES - LDSCTL_OFF) / 4; u += NTHR) ((LAS unsigned*)(lds0 + LDSCTL_OFF))[u] = 0u;
      __syncthreads();
      if (t0 < A_NARGS) ((LAS unsigned long long*)(lds0 + LARGS_OFF))[t0] = (unsigned long long)args.p[t0];
      __syncthreads(); }
    const int lo = args.ph_lo, hi = args.ph_hi;
    const unsigned xcc = xb_xcc_id();
    int vbx = blockIdx.x;
    if (!MK_MULTI) { Ctx C; C.lds = lds0; C.wave = wave0; gu32* ctl0 = (gu32*)WSP(unsigned, WS_CTL); (void)xcd_barrier_post((unsigned*)(ctl0 + CW_BAR), (volatile LAS unsigned*)(lds0 + MISC_OFF) + 8, C.tid() == 0); }
    for (int step = lo; step < hi; ++step) {
        const int ls = step - 2, l = ls >= NS ? 1 : 0, k = (step < 2) ? -1 - step : ls - l * NS;
        const int nrep = (PROBE_K != -99 && k == PROBE_K) ? PROBE_N : 1;
        for (int rep = 0; rep < nrep; ++rep) {
        Ctx C;
        C.lds = lds0; C.wave = wave0; C.G = gridDim.x; C.bx = vbx;
        asm volatile("" : "+s"(C.wave), "+s"(C.bx), "+s"(C.G));
        C.gw = C.bx * NWAVES + C.wave; C.NGW = C.G * NWAVES; C.NGT = C.G * NTHR;
        gu32* ctl = (gu32*)WSP(unsigned, WS_CTL);
        if (k == -1) { ph_mod_partial(C); __syncthreads(); ph_weights(C, 0); }
        else if (k == -2) ph_mod_reduce(C);
        else if (k == 0) {
            if (l == 1) ph_weights(C, l);
            ph_ctab(C, l);
            u64* rsb = WSP(u64, WS_RS) + (size_t)(l == 0 ? 0 : 2) * MT;
            if (l == 0) ph_prenorm(C, ARGF(A_X), ARGF(A_CTX), WSP(const float, WS_GN), WSP(bf16, WS_HX), rsb, 0, MT, (const float*)nullptr, (const float*)nullptr);
            else ph_prenorm(C, ARGF(A_OUT), WSP(const float, WS_CTXX), WSP(const float, WS_GN) + 2 * 5 * DM, WSP(bf16, WS_HX), rsb, ML, MT, WSP(const float, WS_PART), WSP(const float, WS_MOD) + 4 * NMOD + 5 * DM);
        } else if (k == 1) {
            pg8::Prob<false> P{WSP(const bf16, WS_HX), WSP(const bf16, WS_WIN), DM, DM, DM}; pg8::StaticOrder<1> S; S.init(MT, NIN, C.G, C.bx);
            EpiIn E{WSP(bf16, WS_PXA), WSP(bf16, WS_PXG), WSP(const u64, WS_RS) + (size_t)(l == 0 ? 0 : 2) * MT, WSP(const float, WS_CIN) + (size_t)l * 5 * NIN};
            pg8::gemm_phase(C.lds, P, S, E, C.tid());
        } else if (k == 2) {
            const int sub = rep == 0 ? 7 : PROBE_SUB;
            if (sub & 1) ph_t1(C);
            if (sub & 2) ph_mixers(C, l);
            if (sub & 4) ph_attn(C, l);
        } else if (k == 3) {
            ph_fft(C);
        } else if (k == 4) {
            pg8::Prob<false> P{WSP(const bf16, WS_HX), WSP(const bf16, WS_WM), DM, DM, DM}; pg8::StaticOrder<1> S; S.init(l == 0 ? MT : ML, DM, C.G, C.bx);
            EpiMerge E{WSP(bf16, WS_M), WSP(const bf16, WS_PXG)};
            pg8::gemm_phase(C.lds, P, S, E, C.tid());
        } else if (k == 5) {
            pg8::Prob<false> P{WSP(const bf16, WS_M), WSP(const bf16, WS_WO), DM, DM, DM}; pg8::StaticOrder<1> S; S.init(l == 0 ? MT : ML, DM, C.G, C.bx);
            EpiRes E{l == 0 ? ARGF(A_X) : ARGF(A_OUT), l == 0 ? ARGF(A_CTX) : WSP(const float, WS_CTXX), (float*)(GAS float*)ldarg(C, A_OUT), WSP(float, WS_CTXX),
                     rep > 0 ? WSP(const float, WS_ZERO) : WSP(const float, WS_MOD) + (size_t)l * 5 * NMOD + 2 * DM, nullptr,
                     WSP(const float, WS_GN) + (size_t)(l * 2 + 1) * 5 * DM, WSP(bf16, WS_HX), WSP(u64, WS_RS) + (size_t)(l == 0 ? 1 : 3) * MT};
            pg8::gemm_phase(C.lds, P, S, E, C.tid());
        } else if (k == 6) {
            pg8::Prob<false> P{WSP(const bf16, WS_HX), WSP(const bf16, WS_W1), DM, DM, DM}; pg8::StaticOrder<1> S; S.init(l == 0 ? MT : ML, FF, C.G, C.bx);
            EpiAct E{WSP(bf16, WS_ACT), WSP(const u64, WS_RS) + (size_t)(l == 0 ? 1 : 3) * MT, WSP(const float, WS_CUP) + (size_t)l * 5 * FF};
            pg8::gemm_phase(C.lds, P, S, E, C.tid());
        } else if (k == 7) {
            if (l == 0) {
                pg8::ProbDown P{WSP(const bf16, WS_ACT), WSP(const bf16, WS_W2), FF, FF, FF}; pg8::DownOrder S; S.init(C.G, C.bx);
                EpiRes E{ARGF(A_OUT), WSP(const float, WS_CTXX), (float*)(GAS float*)ldarg(C, A_OUT), WSP(float, WS_CTXX), WSP(const float, WS_MOD) + (size_t)l * 5 * NMOD + 5 * DM, WSP(float, WS_PART),
                         WSP(const float, WS_GN) + (size_t)2 * 5 * DM, WSP(bf16, WS_HX), WSP(u64, WS_RS) + (size_t)2 * MT};
                pg8::gemm_phase(C.lds, P, S, E, C.tid());
            } else {
                pg8::Prob<false> P{WSP(const bf16, WS_ACT), WSP(const bf16, WS_W2), FF, FF, FF}; pg8::StaticOrder<1> S; S.init(ML, DM, C.G, C.bx);
                EpiResFinal E{(float*)(GAS float*)ldarg(C, A_OUT), WSP(const float, WS_MOD) + (size_t)l * 5 * NMOD + 5 * DM, ARGF(A_FG), WSP(u64, WS_RS5), WSP(unsigned, WS_FCNT), (unsigned*)WSP(unsigned, WS_CTL) + CW_TMO};
                pg8::gemm_phase(C.lds, P, S, E, C.tid());
            }
        } else ph_final(C);
        if (step + 1 < hi || rep + 1 < nrep) { if (MK_MULTI) { if (C.tid() == 0) __hip_atomic_store(ctl + CW_TMO, 0xBADu, RLX_AGENT); } else { XcdBarrier bar; bar.bar = (unsigned*)(ctl + CW_BAR); bar.x = xcc; bar.st = (volatile LAS unsigned*)(lds0 + MISC_OFF) + 8; xcd_barrier(bar, C.tid() == 0);
                if (step == lo && rep == 0) {
                    volatile LAS unsigned* misc = (volatile LAS unsigned*)(lds0 + MISC_OFF);
                    if (C.tid() == 0) { bool ok = gridDim.x == 256;
                        for (unsigned j = 0; j < 16; ++j) { const unsigned cnt = xb_ld(bar.bar + XB_XCNT(j)); ok = ok && (cnt == (j < 8 ? 32u : 0u)); }
                        misc[11] = ok ? 1u : 0u; }
                    __syncthreads();
                    const unsigned okf = __builtin_amdgcn_readfirstlane(misc[11]), rk = __builtin_amdgcn_readfirstlane(misc[10]);
                    if (okf != 0u && rk < 32u && xcc < 8u) vbx = (int)(rk * 8u + xcc); } } }
        }
    }
}

extern "C" void kernel_launch(void* const* d_in, const int* in_sizes, int n_in, void* d_out, int out_size, void* d_ws, size_t ws_size, hipStream_t stream) {
    static int grid = 0;
    if (grid == 0) {
        if (n_in != 18 || out_size != ML * DM || ws_size < WS_END) { fprintf(stderr, "kernel_launch: unexpected shapes (n_in %d out %d ws %zu)\n", n_in, out_size, ws_size); grid = -1; return; }
        int dev = 0, cus = 0;
        if (hipGetDevice(&dev) != hipSuccess || hipDeviceGetAttribute(&cus, hipDeviceAttributeMultiprocessorCount, dev) != hipSuccess) { grid = -1; return; }
        if (hipFuncSetAttribute((const void*)fwd_kernel, hipFuncAttributeMaxDynamicSharedMemorySize, LDS_BYTES) != hipSuccess) { fprintf(stderr, "kernel_launch: hipFuncSetAttribute failed\n"); grid = -1; return; }
        int per_cu = 0;
        if (hipOccupancyMaxActiveBlocksPerMultiprocessor(&per_cu, (const void*)fwd_kernel, NTHR, LDS_BYTES) != hipSuccess || per_cu < 1) fprintf(stderr, "kernel_launch: occupancy query reports %d\n", per_cu);
        (void)hipGetLastError();
        grid = cus;
    }
    if (grid < 0) return;
    (void)hipMemsetAsync((char*)d_ws + WS_CTL, 0, CTL_ZERO_BYTES, stream);
    Args a{};
    for (int i = 0; i < 18; ++i) a.p[i] = d_in[i];
    a.p[A_OUT] = d_out; a.p[A_WS] = d_ws;
#if MK_MULTI
    for (int s = 0; s < NSTEPS; ++s) { a.ph_lo = s; a.ph_hi = s + 1; hipLaunchKernelGGL(fwd_kernel, dim3(grid), dim3(NTHR), LDS_BYTES, stream, a); }
#else
    a.ph_lo = 0; a.ph_hi = NSTEPS; hipLaunchKernelGGL(fwd_kernel, dim3(grid), dim3(NTHR), LDS_BYTES, stream, a);
#endif
}
```

```cpp
#include <hip/hip_runtime.h>
#include <cstdio>
#include <cstdint>

#ifndef PROBE_K
#define PROBE_K -99
#define PROBE_N 1
#define PROBE_SUB 7
#endif
#ifndef MK_MULTI
#define MK_MULTI 0
#endif

namespace pg8 {
#define PG8_LAS __attribute__((address_space(3)))
typedef unsigned short bf16_t;
typedef short bf16x8 __attribute__((ext_vector_type(8)));
typedef float f32x4 __attribute__((ext_vector_type(4)));
typedef unsigned u32x4 __attribute__((ext_vector_type(4)));
constexpr int BM = 256, BK = 64, HALF = 128, HTB = HALF * BK * 2, STAGE_BYTES = 8 * HTB, NXCD = 8, WGM = 8;

__host__ __device__ __forceinline__ int lds_byte(int r, int c) { const int st = (r >> 4) * 2 + (c >> 5), rr = r & 15, cc = c & 31, ob = rr * 64 + cc * 2; return st * 1024 + (ob ^ (((ob >> 9) & 1) << 5)); }
__host__ __device__ __forceinline__ void stage_rc(int b, int& R, int& C) { const int st = b / 1024, sb = b % 1024, swz = sb ^ (((sb >> 9) & 1) << 5); R = (st >> 1) * 16 + swz / 64; C = (st & 1) * 32 + (swz % 64) / 2; }
__host__ __device__ __forceinline__ int perm32(int rho) { const int n = rho >> 4, i = rho & 15; return 8 * (i >> 2) + 4 * n + (i & 3); }

struct Unit { int pm, pn, br; };

template <int REP> struct StaticOrder {
    int nM, nN, nwg, G, c;
    __device__ void init(int M, int N, int G_, int c_) { nM = M / BM; nN = N / BM; nwg = nM * nN; G = G_; c = c_; }
    __device__ __forceinline__ bool next(int i, Unit& u) const {
        const int it = i / REP; u.br = i - it * REP;
        const long L = (long)it * G + c; if (L >= nwg) return false;
        int wgid = (int)L; { const int q = nwg / NXCD, r = nwg % NXCD, xcd = wgid % NXCD, off = wgid / NXCD; wgid = (xcd < r ? xcd * (q + 1) : r * (q + 1) + (xcd - r) * q) + off; }
        const int nig = WGM * nN, gid = wgid / nig, fm = gid * WGM, gsz = (nM - fm) < WGM ? (nM - fm) : WGM;
        u.pm = fm + ((wgid % nig) % gsz); u.pn = (wgid % nig) / gsz; return true;
    }
};

struct DownOrder {
    StaticOrder<1> lat; int G, c;
    __device__ void init(int G_, int c_) { lat.init(32768, 1024, G_, c_); G = G_; c = c_; }
    __device__ __forceinline__ bool next(int i, Unit& u) const {
        const long L = (long)i * G + c;
        if (L < 512) return lat.next(i, u);
        const int j = (int)L - 512; if (j >= 64) return false;
        const int ct = j >> 2; u.pm = 128 + (ct >> 2); u.pn = ct & 3; u.br = j & 3; return true;
    }
};
struct ProbDown {
    const bf16_t* A; const bf16_t* Bt; int lda, ldb, K;
    __device__ __forceinline__ int nt(const Unit& u) const { return u.pm >= 128 ? 16 : 64; }
    __device__ __forceinline__ int koff(const Unit& u) const { return u.pm >= 128 ? u.br * 1024 : 0; }
    __device__ __forceinline__ const char* a(const Unit& u) const { return (const char*)(A + (size_t)u.pm * BM * lda + koff(u)); }
    __device__ __forceinline__ const char* b(const Unit& u) const { return (const char*)(Bt + (size_t)u.pn * BM * ldb + koff(u)); }
};
template <bool MERGE> struct Prob {
    const bf16_t* A; const bf16_t* Bt; int lda, ldb, K;
    __device__ __forceinline__ int nt(const Unit& u) const { if (MERGE) return u.br == 2 ? 8 : 4; return K / BK; }
    __device__ __forceinline__ int koff(const Unit& u) const { if (MERGE) return u.br * 256; return 0; }
    __device__ __forceinline__ const char* a(const Unit& u) const { return (const char*)(A + (size_t)u.pm * BM * lda + koff(u)); }
    __device__ __forceinline__ const char* b(const Unit& u) const { return (const char*)(Bt + (size_t)u.pn * BM * ldb + koff(u)); }
};

__device__ __forceinline__ unsigned cvt_pk_bf16(float lo, float hi) { unsigned r; asm volatile("v_cvt_pk_bf16_f32 %0, %1, %2" : "=v"(r) : "v"(lo), "v"(hi)); return r; }

template <class Epi, class Sched, class PROB>
__device__ __forceinline__ void gemm_phase(PG8_LAS unsigned char* lds, const PROB P, const Sched& S, const Epi& E, const int tid) {
    const int wid = __builtin_amdgcn_readfirstlane(tid >> 6), lane = tid & 63, wr = wid >> 2, wc = wid & 3, fr = lane & 15, fq = lane >> 4;
    unsigned voffA[2], voffB[2];
#pragma unroll
    for (int i = 0; i < 2; ++i) { int R, C; stage_rc(tid * 16 + i * 8192, R, C); const int Rb = Epi::PERM ? ((R & ~31) + perm32(R & 31)) : R;
        voffA[i] = (unsigned)(R * P.lda + C) * 2u; voffB[i] = (unsigned)(Rb * P.ldb + C) * 2u; }
    const size_t kstep = (size_t)(BK * 2);
    const size_t hstepA = (size_t)HALF * P.lda * 2, hstepB = (size_t)HALF * P.ldb * 2;
    const unsigned ldsw = (unsigned)wid * 1024u;
    const int aoff = lds_byte(wr * 64 + fr, fq * 8), boff = lds_byte(wc * 32 + fr, fq * 8);
#define PG8_SA(b, h) (((b) * 2 + (h)) * HTB)
#define PG8_SB(b, h) ((4 + (b) * 2 + (h)) * HTB)
#define PG8_STAGE(bufoff, gbase, voff) do { _Pragma("unroll") for (int _i = 0; _i < 2; ++_i) \
        __builtin_amdgcn_global_load_lds((const unsigned*)((const char*)(gbase) + (voff)[_i]), (PG8_LAS unsigned*)(lds + (bufoff) + ldsw + _i * 8192), 16, 0, 0); } while (0)
#define PG8_LDA(dst, b, h) do { _Pragma("unroll") for (int m = 0; m < 4; ++m) _Pragma("unroll") for (int k = 0; k < 2; ++k) dst[m][k] = *(const PG8_LAS bf16x8*)(lds + PG8_SA(b, h) + aoff + m * 2048 + k * 1024); } while (0)
#define PG8_LDB(dst, b, h) do { _Pragma("unroll") for (int n = 0; n < 2; ++n) _Pragma("unroll") for (int k = 0; k < 2; ++k) dst[n][k] = *(const PG8_LAS bf16x8*)(lds + PG8_SB(b, h) + boff + n * 2048 + k * 1024); } while (0)
#define PG8_MMA(ai, bj, At, Bt) do { __builtin_amdgcn_s_setprio(1); _Pragma("unroll") for (int m = 0; m < 4; ++m) _Pragma("unroll") for (int n = 0; n < 2; ++n) _Pragma("unroll") for (int k = 0; k < 2; ++k) \
        acc[ai][bj][m][n] = __builtin_amdgcn_mfma_f32_16x16x32_bf16(Bt[n][k], At[m][k], acc[ai][bj][m][n], 0, 0, 0); __builtin_amdgcn_s_setprio(0); } while (0)
#define PG8_WAIT_V(n) asm volatile("s_waitcnt vmcnt(" #n ")" ::: "memory")
#define PG8_WAIT_L(n) asm volatile("s_waitcnt lgkmcnt(" #n ")" ::: "memory")
#define PG8_BAR __builtin_amdgcn_s_barrier()
#define PG8_WAIT_SEL1(N) asm volatile("s_waitcnt vmcnt(" #N ")\n\tv_cmp_ne_u32_e32 vcc, 0, %0\n\ts_cbranch_vccnz .Lpg8w%=\n\ts_waitcnt vmcnt(8)\n.Lpg8w%=:" :: "v"(fst) : "memory", "vcc")
#define PG8_WAIT_SEL(NF16, NF32) do { if (Epi::NST == 16) PG8_WAIT_SEL1(NF16); else PG8_WAIT_SEL1(NF32); } while (0)
#define PG8_SCHED __builtin_amdgcn_sched_barrier(0)
    Unit cur, nxt; int ui = 0;
    if (!S.next(0, cur)) return;
    f32x4 acc[2][2][4][2];
#pragma unroll
    for (int a = 0; a < 2; ++a)
#pragma unroll
        for (int b = 0; b < 2; ++b)
#pragma unroll
            for (int m = 0; m < 4; ++m)
#pragma unroll
                for (int n = 0; n < 2; ++n) acc[a][b][m][n] = (f32x4){0.f, 0.f, 0.f, 0.f};
    bf16x8 At[4][2], B0[2][2], B1[2][2];
    const char* cA = P.a(cur); const char* cB = P.b(cur);
    PG8_STAGE(PG8_SB(0, 0), cB, voffB); PG8_STAGE(PG8_SB(0, 1), cB + hstepB, voffB); PG8_STAGE(PG8_SA(0, 0), cA, voffA); PG8_STAGE(PG8_SA(0, 1), cA + hstepA, voffA);
    if (wr == 1) PG8_BAR;
    PG8_WAIT_V(2); PG8_BAR;
    PG8_STAGE(PG8_SB(1, 0), cB + kstep, voffB); PG8_STAGE(PG8_SA(1, 0), cA + kstep, voffA); PG8_STAGE(PG8_SB(1, 1), cB + hstepB + kstep, voffB);
    PG8_WAIT_V(6); PG8_BAR;
    for (;;) {
        const bool has_next = S.next(ui + 1, nxt);
        const char* nA = has_next ? P.a(nxt) : cA; const char* nB = has_next ? P.b(nxt) : cB;
        const int nt = P.nt(cur);
        for (int t = 0; t < nt; t += 2) {
            const bool last = (t == nt - 2); const int fst = (t == 0 && ui > 0) ? 1 : 0;
            if constexpr (Epi::HOOKS) { if (t == 4 || t == 8) E.hook(acc, cur, t, wr, wc, fr, fq); }
            const char* a1 = cA + (size_t)(t + 1) * kstep;
            const char* a2 = last ? nA : cA + (size_t)(t + 2) * kstep; const char* b2 = last ? nB : cB + (size_t)(t + 2) * kstep;
            const char* a3 = a2 + kstep; const char* b3 = b2 + kstep;
            PG8_LDB(B0, 0, 0); PG8_LDB(B1, 0, 1); PG8_SCHED; PG8_LDA(At, 0, 0); PG8_STAGE(PG8_SA(1, 1), a1 + hstepA, voffA);
            PG8_WAIT_SEL(18, 34); PG8_WAIT_L(0); PG8_BAR; PG8_MMA(0, 0, At, B0); PG8_MMA(0, 1, At, B1); PG8_BAR; PG8_SCHED;
            PG8_LDA(At, 0, 1); PG8_STAGE(PG8_SB(0, 0), b2, voffB); PG8_STAGE(PG8_SB(0, 1), b2 + hstepB, voffB); PG8_STAGE(PG8_SA(0, 0), a2, voffA);
            PG8_WAIT_SEL(24, 40); PG8_WAIT_L(0); PG8_BAR; PG8_MMA(1, 0, At, B0); PG8_MMA(1, 1, At, B1); PG8_BAR; PG8_SCHED;
            PG8_LDB(B0, 1, 0); PG8_LDB(B1, 1, 1); PG8_SCHED; PG8_LDA(At, 1, 0); PG8_STAGE(PG8_SA(0, 1), a2 + hstepA, voffA);
            PG8_WAIT_SEL(26, 42); PG8_WAIT_L(0); PG8_BAR; PG8_MMA(0, 0, At, B0); PG8_MMA(0, 1, At, B1); PG8_BAR; PG8_SCHED;
            PG8_LDA(At, 1, 1); PG8_STAGE(PG8_SB(1, 0), b3, voffB); PG8_STAGE(PG8_SB(1, 1), b3 + hstepB, voffB); PG8_STAGE(PG8_SA(1, 0), a3, voffA);
            PG8_WAIT_V(8); PG8_WAIT_L(0); PG8_BAR; PG8_MMA(1, 0, At, B0); PG8_MMA(1, 1, At, B1); PG8_BAR; PG8_SCHED;
        }
        if (wr == 0) PG8_BAR;
        E(acc, cur, wr, wc, fr, fq);
        if (!has_next) break;
#pragma unroll
        for (int a = 0; a < 2; ++a)
#pragma unroll
            for (int b = 0; b < 2; ++b)
#pragma unroll
                for (int m = 0; m < 4; ++m)
#pragma unroll
                    for (int n = 0; n < 2; ++n) acc[a][b][m][n] = (f32x4){0.f, 0.f, 0.f, 0.f};
        cur = nxt; cA = nA; cB = nB; ++ui;
        if (wr == 1) PG8_BAR;
    }
    PG8_WAIT_V(0);
    PG8_BAR;
#undef PG8_SA
#undef PG8_SB
#undef PG8_STAGE
#undef PG8_LDA
#undef PG8_LDB
#undef PG8_MMA
#undef PG8_WAIT_V
#undef PG8_WAIT_L
#undef PG8_BAR
#undef PG8_WAIT_SEL
#undef PG8_WAIT_SEL1
#undef PG8_SCHED
}
}

constexpr int NWAVES = 8, NTHR = 512;
constexpr int DM = 1024, NB = 4, SEQ = 8192, ML = NB * SEQ, CTXL = 256, MC = NB * CTXL, MT = ML + MC;
constexpr int NIN_ORIG = 5632, NPXA = 2816, NPXG = 3072, NIN = NPXA + NPXG;
constexpr int OFF_P = 0, OFF_Q = 256, OFF_CU = 512, OFF_CB = 768, OFF_CC = 1024, OFF_QQ = 1280, OFF_K = 1792, OFF_V = 2304;
constexpr int FF = 4096, NMOD = 6 * DM, NGRP = 5;
constexpr float EPS = 1e-6f;

constexpr size_t MiB = 1u << 20;
constexpr size_t WS_CTL = 0, CTL_ZERO_BYTES = 2 * MiB;
constexpr size_t WS_RS = 262144;
constexpr size_t WS_FCNT = 1441792;
constexpr size_t WS_ZERO = 1572864;
constexpr size_t WS_RS5 = 1703936;
constexpr size_t WS_TW = 2 * MiB;
constexpr size_t WS_MOD = 2 * MiB + 65536;
constexpr size_t WS_GN = 2 * MiB + 524288;
constexpr size_t WS_CIN = 2 * MiB + 786432;
constexpr size_t WS_CUP = 3 * MiB;
constexpr size_t WS_MODP = 510 * MiB;
constexpr size_t WS_CTXX = 4 * MiB;
constexpr size_t WS_WIN = 8 * MiB, WS_WM = 20 * MiB, WS_WO = 22 * MiB, WS_W1 = 24 * MiB, WS_W2 = 32 * MiB;
constexpr size_t WS_HX = 40 * MiB;
constexpr size_t WS_PXA = 106 * MiB;
constexpr size_t WS_PXG = 288 * MiB;
constexpr size_t WS_TB = 486 * MiB;
constexpr size_t WS_M = WS_PXA;
constexpr size_t WS_ACT = WS_PXA;
constexpr size_t WS_PART = 400 * MiB;
constexpr size_t WS_END = 512 * MiB;
static_assert(WS_PXA + (size_t)MT * NPXA * 2 <= WS_PXG && WS_PXG + (size_t)MT * NPXG * 2 <= WS_TB && WS_ACT + (size_t)MT * FF * 2 <= WS_TB && WS_HX + (size_t)MT * DM * 2 <= WS_PXA, "ws map");
constexpr int CW_TMO = 0, CW_BAR = 4096;

constexpr int RING_BYTES = 131072, LDSCTL_OFF = 155648, MISC_OFF = LDSCTL_OFF + 320, LDS_BYTES = 163840;

#define GAS __attribute__((address_space(1)))
#define LAS __attribute__((address_space(3)))
typedef unsigned short bf16;
typedef unsigned v4u __attribute__((ext_vector_type(4)));
typedef unsigned v2u __attribute__((ext_vector_type(2)));
typedef float f32x4 __attribute__((ext_vector_type(4)));
typedef GAS unsigned gu32;
#define RLX_AGENT __ATOMIC_RELAXED, __HIP_MEMORY_SCOPE_AGENT
#define LDS_WAIT() asm volatile("s_waitcnt lgkmcnt(0)" ::: "memory")
__device__ __forceinline__ unsigned f2bf(float f) { unsigned u = __builtin_bit_cast(unsigned, f); return (u + 0x7fffu + ((u >> 16) & 1u)) >> 16; }
__device__ __forceinline__ unsigned pk2(float lo, float hi) { return f2bf(lo) | (f2bf(hi) << 16); }
__device__ __forceinline__ float bf2f(unsigned h) { return __uint_as_float(h << 16); }
__device__ __forceinline__ float bflo(unsigned w) { return __uint_as_float(w << 16); }
__device__ __forceinline__ float bfhi(unsigned w) { return __uint_as_float(w & 0xffff0000u); }

#define XB_TMO      128
#define XB_XCNT(j)  (256  + 64 * (j))
#define XB_XSUB(j)  (1280 + 64 * (j))
#define XB_XGEN(j)  (2304 + 64 * (j))
#define XB_TOP      3328
#define XB_TOPGEN   3392
#define XCD_BAR_WORDS 3456
#define XB_SPIN_CAP (1u << 22)
__device__ __forceinline__ unsigned xb_ld(unsigned* p)              { return __hip_atomic_load(p, __ATOMIC_RELAXED, __HIP_MEMORY_SCOPE_AGENT); }
__device__ __forceinline__ unsigned xb_add(unsigned* p, unsigned v) { return __hip_atomic_fetch_add(p, v, __ATOMIC_RELAXED, __HIP_MEMORY_SCOPE_AGENT); }
__device__ __forceinline__ unsigned xb_xcc_id() { return (unsigned)__builtin_amdgcn_s_getreg((3 << 11) | 20) & 0xFu; }
#define XB_SPIN(cond, bar) do { unsigned _sp = 0; while (cond) { __builtin_amdgcn_s_sleep(1); \
    if ((++_sp & 255u) == 0u) { if (xb_ld(&(bar)[XB_TMO])) break; if (_sp > XB_SPIN_CAP) { atomicAdd(&(bar)[XB_TMO], 1u); break; } } } } while (0)
struct XcdBarrier { unsigned* bar; unsigned x; volatile LAS unsigned* st; };
__device__ __forceinline__ XcdBarrier xcd_barrier_post(unsigned* bar, volatile LAS unsigned* st, bool leader) {
    XcdBarrier b; b.bar = bar; b.x = xb_xcc_id(); b.st = st;
    if (leader) { const unsigned rank = xb_add(&bar[XB_XCNT(b.x)], 1u); st[2] = rank; }
    return b;
}
__device__ __forceinline__ void xcd_barrier_complete(unsigned* bar, unsigned x, unsigned& nloc, unsigned& nx) {
    const unsigned G = gridDim.x * gridDim.y * gridDim.z;
    unsigned sum, cnt, mine, sp = 0u;
    for (;;) {
        sum = 0u; cnt = 0u; mine = 0u;
#pragma unroll
        for (unsigned j = 0; j < 16; ++j) { const unsigned c = xb_ld(&bar[XB_XCNT(j)]); sum += c; cnt += (c > 0u) ? 1u : 0u; mine = (j == x) ? c : mine; }
        if (sum == G) break;
        __builtin_amdgcn_s_sleep(1);
        if ((++sp & 255u) == 0u) { if (xb_ld(&bar[XB_TMO])) break; if (sp > XB_SPIN_CAP) { atomicAdd(&bar[XB_TMO], 1u); break; } }
    }
    nloc = mine > 0u ? mine : 1u; nx = cnt > 0u ? cnt : 1u;
}
__device__ __forceinline__ void xcd_barrier(const XcdBarrier& b, bool leader) {
    asm volatile("s_waitcnt vmcnt(0)" ::: "memory");
    __syncthreads();
    if (leader) {
        unsigned* bar = b.bar;
        __builtin_amdgcn_s_waitcnt(0);
        unsigned nloc = b.st[0], nx = b.st[1];
        if (nloc == 0u) { xcd_barrier_complete(bar, b.x, nloc, nx); b.st[0] = nloc; b.st[1] = nx; }
        const unsigned old = xb_add(&bar[XB_XSUB(b.x)], 1u);
        const unsigned gen = old / nloc;
        if (old + 1u == (gen + 1u) * nloc) {
            __builtin_amdgcn_fence(__ATOMIC_RELEASE, "agent");
            asm volatile("s_waitcnt vmcnt(0)" ::: "memory");
            const unsigned og = xb_add(&bar[XB_TOP], 1u);
            const unsigned tg = og / nx;
            if (og + 1u == (tg + 1u) * nx) xb_add(&bar[XB_TOPGEN], 1u);
            else XB_SPIN(xb_ld(&bar[XB_TOPGEN]) == tg, bar);
            __builtin_amdgcn_fence(__ATOMIC_ACQUIRE, "agent");
            xb_add(&bar[XB_XGEN(b.x)], 1u);
            asm volatile("s_waitcnt vmcnt(0)" ::: "memory");
        } else {
            XB_SPIN(xb_ld(&bar[XB_XGEN(b.x)]) == gen, bar);
            __builtin_amdgcn_fence(__ATOMIC_ACQUIRE, "agent");
            asm volatile("s_waitcnt vmcnt(0)" ::: "memory");
        }
    }
    __syncthreads();
}

__device__ __forceinline__ float wave_sum(float v) {
#pragma unroll
    for (int o = 1; o < 64; o <<= 1) v += __shfl_xor(v, o);
    return v;
}
__device__ __forceinline__ float wave_max(float v) {
#pragma unroll
    for (int o = 1; o < 64; o <<= 1) v = fmaxf(v, __shfl_xor(v, o));
    return v;
}

__device__ __forceinline__ void transpose_item(const float* W, int ldw, int ncols, bf16* WT, int ldwt, int row_off, int k_off, LAS float* scr, int item, int lane) {
    const int nblk = ncols / 32, kb = item / nblk, nb = item % nblk, k0 = 64 * kb, n0 = 32 * nb;
#pragma unroll 8
    for (int i = 0; i < 32; ++i) { const int kk = 2 * i + (lane >> 5); scr[kk * 33 + (lane & 31)] = W[(size_t)(k0 + kk) * ldw + n0 + (lane & 31)]; }
    LDS_WAIT(); asm volatile("" ::: "memory");
    const int c = lane & 7;
#pragma unroll
    for (int j = 0; j < 4; ++j) { const int n = (lane >> 3) + 8 * j; const LAS float* s = scr + (8 * c) * 33 + n;
        v4u o; o.x = pk2(s[0 * 33], s[1 * 33]); o.y = pk2(s[2 * 33], s[3 * 33]); o.z = pk2(s[4 * 33], s[5 * 33]); o.w = pk2(s[6 * 33], s[7 * 33]);
        *(v4u*)(WT + (size_t)(row_off + n0 + n) * ldwt + k_off + k0 + 8 * c) = o; }
    LDS_WAIT(); asm volatile("" ::: "memory");
}

using pg8::Unit; using pg8::cvt_pk_bf16;
typedef unsigned long long u64;
__device__ __forceinline__ float rs_to_rstd(u64 q) { return 1.0f / sqrtf((float)q * (1.0f / (16777216.0f * DM)) + EPS); }
struct EpiIn {
    static constexpr bool PERM = true, HOOKS = false; static constexpr int NST = 16;
    bf16* pxa; bf16* pxg; const u64* rs; const float* cin;
    __device__ __forceinline__ void operator()(const f32x4 (&acc)[2][2][4][2], const Unit& u, int wr, int wc, int fr, int fq) const {
        asm volatile("" : "+v"(fr), "+v"(fq));
        const bool gate = u.pn >= 11; bf16* base = gate ? pxg : pxa; const int ldc = gate ? NPXG : NPXA; const int colt = (gate ? u.pn - 11 : u.pn) * 256;
        const int grp = u.pm >= 128 ? 4 : (u.pm >> 5);
        const int row0 = u.pm * 256 + wr * 64 + fr, col0 = colt + wc * 32 + 8 * fq;
        const float* cp = cin + grp * NIN + u.pn * 256 + wc * 32 + 8 * fq;
        f32x4 cv[2][2];
#pragma unroll
        for (int bj = 0; bj < 2; ++bj) { cv[bj][0] = *(const f32x4*)(cp + bj * 128); cv[bj][1] = *(const f32x4*)(cp + bj * 128 + 4); }
        u64 rq[2][4]; float rsv[2][4];
#pragma unroll
        for (int ai = 0; ai < 2; ++ai)
#pragma unroll
            for (int m = 0; m < 4; ++m) rq[ai][m] = rs[row0 + ai * 128 + m * 16];
        asm volatile("" ::: "memory");
#pragma unroll
        for (int ai = 0; ai < 2; ++ai)
#pragma unroll
            for (int m = 0; m < 4; ++m) rsv[ai][m] = rs_to_rstd(rq[ai][m]);
#pragma unroll
        for (int ai = 0; ai < 2; ++ai)
#pragma unroll
            for (int m = 0; m < 4; ++m) { const int row = row0 + ai * 128 + m * 16; bf16* rowp = base + (size_t)row * ldc + col0; const float rstd = rsv[ai][m];
#pragma unroll
                for (int bj = 0; bj < 2; ++bj) { f32x4 v0 = acc[ai][bj][m][0] * rstd + cv[bj][0], v1 = acc[ai][bj][m][1] * rstd + cv[bj][1];
                    if (gate) {
#pragma unroll
                        for (int e = 0; e < 4; ++e) { v0[e] = __builtin_amdgcn_rcpf(1.0f + __builtin_amdgcn_exp2f(-1.4426950408889634f * v0[e])); v1[e] = __builtin_amdgcn_rcpf(1.0f + __builtin_amdgcn_exp2f(-1.4426950408889634f * v1[e])); } }
                    v4u w; w.x = cvt_pk_bf16(v0[0], v0[1]); w.y = cvt_pk_bf16(v0[2], v0[3]); w.z = cvt_pk_bf16(v1[0], v1[1]); w.w = cvt_pk_bf16(v1[2], v1[3]);
                    *(v4u*)(rowp + bj * 128) = w; } }
    }
};
struct EpiMerge {
    static constexpr bool PERM = true, HOOKS = true; static constexpr int NST = 16;
    bf16* m; const bf16* pxg;
    __device__ __forceinline__ void hook(f32x4 (&acc)[2][2][4][2], const Unit& u, int t, int wr, int wc, int fr, int fq) const {
        asm volatile("" : "+v"(fr), "+v"(fq));
        const int row0 = u.pm * 256 + wr * 64 + fr, col0 = u.pn * 256 + wc * 32 + 8 * fq;
        const bf16* gnum = pxg + (t == 4 ? 0 : 1024) + col0; const bf16* gden = gnum + 1024;
#pragma unroll
        for (int ai = 0; ai < 2; ++ai)
#pragma unroll
            for (int mp = 0; mp < 2; ++mp) {
                v4u gn[2][2], gd[2][2];
#pragma unroll
                for (int mq = 0; mq < 2; ++mq)
#pragma unroll
                    for (int bj = 0; bj < 2; ++bj) { const size_t ro = (size_t)(row0 + ai * 128 + (2 * mp + mq) * 16) * NPXG + bj * 128; gn[mq][bj] = *(const v4u*)(gnum + ro); gd[mq][bj] = *(const v4u*)(gden + ro); }
                asm volatile("" ::: "memory");
#pragma unroll
                for (int mq = 0; mq < 2; ++mq)
#pragma unroll
                    for (int bj = 0; bj < 2; ++bj) { const v4u a = gn[mq][bj], d = gd[mq][bj];
                        f32x4& v0 = acc[ai][bj][2 * mp + mq][0]; f32x4& v1 = acc[ai][bj][2 * mp + mq][1];
                        v0[0] *= bflo(a.x) * __builtin_amdgcn_rcpf(fmaxf(bflo(d.x), 1e-30f)); v0[1] *= bfhi(a.x) * __builtin_amdgcn_rcpf(fmaxf(bfhi(d.x), 1e-30f));
                        v0[2] *= bflo(a.y) * __builtin_amdgcn_rcpf(fmaxf(bflo(d.y), 1e-30f)); v0[3] *= bfhi(a.y) * __builtin_amdgcn_rcpf(fmaxf(bfhi(d.y), 1e-30f));
                        v1[0] *= bflo(a.z) * __builtin_amdgcn_rcpf(fmaxf(bflo(d.z), 1e-30f)); v1[1] *= bfhi(a.z) * __builtin_amdgcn_rcpf(fmaxf(bfhi(d.z), 1e-30f));
                        v1[2] *= bflo(a.w) * __builtin_amdgcn_rcpf(fmaxf(bflo(d.w), 1e-30f)); v1[3] *= bfhi(a.w) * __builtin_amdgcn_rcpf(fmaxf(bfhi(d.w), 1e-30f)); }
            }
    }
    __device__ __forceinline__ void operator()(const f32x4 (&acc)[2][2][4][2], const Unit& u, int wr, int wc, int fr, int fq) const {
        asm volatile("" : "+v"(fr), "+v"(fq));
        const int row0 = u.pm * 256 + wr * 64 + fr, col0 = u.pn * 256 + wc * 32 + 8 * fq;
#pragma unroll
        for (int ai = 0; ai < 2; ++ai) {
            v4u g[4][2];
#pragma unroll
            for (int mm = 0; mm < 4; ++mm)
#pragma unroll
                for (int bj = 0; bj < 2; ++bj) g[mm][bj] = *(const v4u*)(pxg + (size_t)(row0 + ai * 128 + mm * 16) * NPXG + 2048 + col0 + bj * 128);
            asm volatile("" ::: "memory");
#pragma unroll
            for (int mm = 0; mm < 4; ++mm)
#pragma unroll
                for (int bj = 0; bj < 2; ++bj) { const f32x4 v0 = acc[ai][bj][mm][0], v1 = acc[ai][bj][mm][1]; const v4u gg = g[mm][bj];
                    v4u w; w.x = cvt_pk_bf16(v0[0] * bflo(gg.x), v0[1] * bfhi(gg.x)); w.y = cvt_pk_bf16(v0[2] * bflo(gg.y), v0[3] * bfhi(gg.y));
                    w.z = cvt_pk_bf16(v1[0] * bflo(gg.z), v1[1] * bfhi(gg.z)); w.w = cvt_pk_bf16(v1[2] * bflo(gg.w), v1[3] * bfhi(gg.w));
                    *(v4u*)(m + (size_t)(row0 + ai * 128 + mm * 16) * DM + col0 + bj * 128) = w; }
        }
    }
};
struct EpiRes {
    static constexpr bool PERM = true, HOOKS = false; static constexpr int NST = 32;
    const float* base_l; const float* base_c; float* out_l; float* out_c; const float* gate;
    float* part;
    const float* gn; bf16* ap; u64* rs;
    __device__ __forceinline__ void operator()(const f32x4 (&acc)[2][2][4][2], const Unit& u, int wr, int wc, int fr, int fq) const {
        asm volatile("" : "+v"(fr), "+v"(fq));
        const bool isc = u.pm >= 128; const int grp = isc ? 4 : (u.pm >> 5);
        const float* base = isc ? base_c : base_l; float* out = isc ? out_c : out_l;
        const int row0 = (isc ? (u.pm - 128) : u.pm) * 256 + wr * 64 + fr, col0 = u.pn * 256 + wc * 32 + 8 * fq;
        if (part != nullptr && isc) {
            float* po = part + (size_t)u.br * 1024 * 1024;
#pragma unroll
            for (int ai = 0; ai < 2; ++ai)
#pragma unroll
                for (int m = 0; m < 4; ++m)
#pragma unroll
                    for (int bj = 0; bj < 2; ++bj)
#pragma unroll
                        for (int n = 0; n < 2; ++n) *(f32x4*)(po + (size_t)(row0 + ai * 128 + m * 16) * DM + col0 + bj * 128 + n * 4) = acc[ai][bj][m][n];
            return;
        }
        f32x4 gv[2][2], gnv[2][2];
#pragma unroll
        for (int bj = 0; bj < 2; ++bj)
#pragma unroll
            for (int n = 0; n < 2; ++n) { gv[bj][n] = *(const f32x4*)(gate + grp * NMOD + col0 + bj * 128 + n * 4);
                gnv[bj][n] = gn ? *(const f32x4*)(gn + grp * DM + col0 + bj * 128 + n * 4) : (f32x4){0.f, 0.f, 0.f, 0.f}; }
        const int arow0 = u.pm * 256 + wr * 64 + fr;
#pragma unroll
        for (int ai = 0; ai < 2; ++ai)
#pragma unroll
            for (int mp = 0; mp < 2; ++mp) {
                f32x4 bs[2][2][2];
#pragma unroll
                for (int mq = 0; mq < 2; ++mq)
#pragma unroll
                    for (int bj = 0; bj < 2; ++bj)
#pragma unroll
                        for (int n = 0; n < 2; ++n) bs[mq][bj][n] = *(const f32x4*)(base + (size_t)(row0 + ai * 128 + (2 * mp + mq) * 16) * DM + col0 + bj * 128 + n * 4);
                asm volatile("" ::: "memory");
#pragma unroll
                for (int mq = 0; mq < 2; ++mq) { const int m = 2 * mp + mq; float ss = 0.f;
#pragma unroll
                    for (int bj = 0; bj < 2; ++bj) {
                        const f32x4 o0 = bs[mq][bj][0] + gv[bj][0] * acc[ai][bj][m][0], o1 = bs[mq][bj][1] + gv[bj][1] * acc[ai][bj][m][1];
                        float* op = out + (size_t)(row0 + ai * 128 + m * 16) * DM + col0 + bj * 128;
                        *(f32x4*)op = o0; *(f32x4*)(op + 4) = o1;
                        if (gn) { const f32x4 y0 = o0 * gnv[bj][0], y1 = o1 * gnv[bj][1];
                            v4u w; w.x = cvt_pk_bf16(y0[0], y0[1]); w.y = cvt_pk_bf16(y0[2], y0[3]); w.z = cvt_pk_bf16(y1[0], y1[1]); w.w = cvt_pk_bf16(y1[2], y1[3]);
                            *(v4u*)(ap + (size_t)(arow0 + ai * 128 + m * 16) * DM + col0 + bj * 128) = w;
                            ss += ((o0[0] * o0[0] + o0[1] * o0[1]) + (o0[2] * o0[2] + o0[3] * o0[3])) + ((o1[0] * o1[0] + o1[1] * o1[1]) + (o1[2] * o1[2] + o1[3] * o1[3])); } }
                    if (gn) { ss += __shfl_xor(ss, 16); ss += __shfl_xor(ss, 32);
                        if (fq == 0) __hip_atomic_fetch_add(rs + arow0 + ai * 128 + m * 16, (u64)(ss * 16777216.0f + 0.5f), __ATOMIC_RELAXED, __HIP_MEMORY_SCOPE_AGENT); } }
            }
    }
};
struct EpiResFinal {
    static constexpr bool PERM = true, HOOKS = false; static constexpr int NST = 32;
    float* xo; const float* gate; const float* fg; u64* rs; unsigned* cnt; unsigned* tmo;
    __device__ __forceinline__ void operator()(f32x4 (&acc)[2][2][4][2], const Unit& u, int wr, int wc, int fr, int fq) const {
        asm volatile("" : "+v"(fr), "+v"(fq));
        const int grp = u.pm >> 5, row0 = u.pm * 256 + wr * 64 + fr, col0 = u.pn * 256 + wc * 32 + 8 * fq;
        f32x4 gv[2][2];
#pragma unroll
        for (int bj = 0; bj < 2; ++bj)
#pragma unroll
            for (int n = 0; n < 2; ++n) gv[bj][n] = *(const f32x4*)(gate + grp * NMOD + col0 + bj * 128 + n * 4);
#pragma unroll
        for (int ai = 0; ai < 2; ++ai)
#pragma unroll
            for (int mp = 0; mp < 2; ++mp) {
                f32x4 bs[2][2][2];
#pragma unroll
                for (int mq = 0; mq < 2; ++mq)
#pragma unroll
                    for (int bj = 0; bj < 2; ++bj)
#pragma unroll
                        for (int n = 0; n < 2; ++n) bs[mq][bj][n] = *(const f32x4*)(xo + (size_t)(row0 + ai * 128 + (2 * mp + mq) * 16) * DM + col0 + bj * 128 + n * 4);
                asm volatile("" ::: "memory");
#pragma unroll
                for (int mq = 0; mq < 2; ++mq) { const int m = 2 * mp + mq; float ss = 0.f;
#pragma unroll
                    for (int bj = 0; bj < 2; ++bj)
#pragma unroll
                        for (int n = 0; n < 2; ++n) { const f32x4 o = bs[mq][bj][n] + gv[bj][n] * acc[ai][bj][m][n]; acc[ai][bj][m][n] = o; ss += (o[0] * o[0] + o[1] * o[1]) + (o[2] * o[2] + o[3] * o[3]); }
                    ss += __shfl_xor(ss, 16); ss += __shfl_xor(ss, 32);
                    if (fq == 0) __hip_atomic_fetch_add(rs + row0 + ai * 128 + m * 16, (u64)(ss * 16777216.0f + 0.5f), __ATOMIC_RELAXED, __HIP_MEMORY_SCOPE_AGENT); }
            }
        asm volatile("s_waitcnt vmcnt(0)" ::: "memory");
        unsigned* pc = cnt + 64 * u.pm;
        if (__builtin_amdgcn_mbcnt_hi(~0u, __builtin_amdgcn_mbcnt_lo(~0u, 0u)) == 0) __hip_atomic_fetch_add(pc, 1u, __ATOMIC_RELAXED, __HIP_MEMORY_SCOPE_AGENT);
        { unsigned spins = 0;
          while ((unsigned)__builtin_amdgcn_readfirstlane(__hip_atomic_load(pc, __ATOMIC_RELAXED, __HIP_MEMORY_SCOPE_AGENT)) < 32u) {
              __builtin_amdgcn_s_sleep(2);
              if (++spins > (1u << 22)) { __hip_atomic_store(tmo, 1u, __ATOMIC_RELAXED, __HIP_MEMORY_SCOPE_AGENT); break; } } }
        f32x4 fgv[2][2];
#pragma unroll
        for (int bj = 0; bj < 2; ++bj)
#pragma unroll
            for (int n = 0; n < 2; ++n) fgv[bj][n] = *(const f32x4*)(fg + col0 + bj * 128 + n * 4);
#pragma unroll
        for (int ai = 0; ai < 2; ++ai)
#pragma unroll
            for (int m = 0; m < 4; ++m) { const int row = row0 + ai * 128 + m * 16;
                const float rstd = rs_to_rstd(__hip_atomic_load(rs + row, __ATOMIC_RELAXED, __HIP_MEMORY_SCOPE_AGENT));
#pragma unroll
                for (int bj = 0; bj < 2; ++bj)
#pragma unroll
                    for (int n = 0; n < 2; ++n) *(f32x4*)(xo + (size_t)row * DM + col0 + bj * 128 + n * 4) = acc[ai][bj][m][n] * rstd * fgv[bj][n]; }
    }
};
struct EpiAct {
    static constexpr bool PERM = true, HOOKS = false; static constexpr int NST = 16;
    bf16* a; const u64* rs; const float* cup;
    __device__ __forceinline__ void operator()(const f32x4 (&acc)[2][2][4][2], const Unit& u, int wr, int wc, int fr, int fq) const {
        asm volatile("" : "+v"(fr), "+v"(fq));
        const int grp = u.pm >= 128 ? 4 : (u.pm >> 5);
        const int row0 = u.pm * 256 + wr * 64 + fr, col0 = u.pn * 256 + wc * 32 + 8 * fq;
        const float* cp = cup + grp * FF + col0;
        f32x4 cv[2][2];
#pragma unroll
        for (int bj = 0; bj < 2; ++bj) { cv[bj][0] = *(const f32x4*)(cp + bj * 128); cv[bj][1] = *(const f32x4*)(cp + bj * 128 + 4); }
        u64 rq[2][4]; float rsv[2][4];
#pragma unroll
        for (int ai = 0; ai < 2; ++ai)
#pragma unroll
            for (int m = 0; m < 4; ++m) rq[ai][m] = rs[row0 + ai * 128 + m * 16];
        asm volatile("" ::: "memory");
#pragma unroll
        for (int ai = 0; ai < 2; ++ai)
#pragma unroll
            for (int m = 0; m < 4; ++m) rsv[ai][m] = rs_to_rstd(rq[ai][m]);
#pragma unroll
        for (int ai = 0; ai < 2; ++ai)
#pragma unroll
            for (int m = 0; m < 4; ++m) { const int row = row0 + ai * 128 + m * 16; bf16* rowp = a + (size_t)row * FF + col0; const float rstd = rsv[ai][m];
#pragma unroll
                for (int bj = 0; bj < 2; ++bj) { f32x4 v0 = acc[ai][bj][m][0] * rstd + cv[bj][0], v1 = acc[ai][bj][m][1] * rstd + cv[bj][1];
#pragma unroll
                    for (int e = 0; e < 4; ++e) { const float r0 = fmaxf(v0[e], 0.f), r1 = fmaxf(v1[e], 0.f); v0[e] = r0 * r0; v1[e] = r1 * r1; }
                    v4u w; w.x = cvt_pk_bf16(v0[0], v0[1]); w.y = cvt_pk_bf16(v0[2], v0[3]); w.z = cvt_pk_bf16(v1[0], v1[1]); w.w = cvt_pk_bf16(v1[2], v1[3]);
                    *(v4u*)(rowp + bj * 128) = w; } }
    }
};

constexpr int NS = 8;
constexpr int NSTEPS = 2 + 2 * NS;
constexpr int LARGS_OFF = LDSCTL_OFF + 1024;
enum { A_X = 0, A_C, A_CTX, A_CCTX, A_ADAW, A_ADAB, A_N1G, A_N2G, A_WIN, A_CONVW, A_RELB, A_WF, A_WC, A_WA, A_WO, A_W1, A_W2, A_FG, A_OUT, A_WS, A_NARGS };

struct Ctx { LAS unsigned char* lds; int wave, G, bx, gw, NGW, NGT;
    __device__ __forceinline__ int lane() const { int l; asm volatile("v_mbcnt_lo_u32_b32 %0, -1, 0\n\tv_mbcnt_hi_u32_b32 %0, -1, %0" : "=v"(l)); return l; }
    __device__ __forceinline__ int tid() const { return wave * 64 + lane(); }
    __device__ __forceinline__ int gt() const { return bx * NTHR + tid(); }
};
template <int I> __device__ __forceinline__ unsigned long long ldarg_t() {
    unsigned long long v; unsigned tmp;
    asm volatile("v_mov_b32 %1, %2\n\tds_read_b64 %0, %1 offset:%3\n\ts_waitcnt lgkmcnt(0)" : "=&v"(v), "=&v"(tmp) : "i"(LARGS_OFF), "i"(I * 8) : "memory");
    const unsigned lo = __builtin_amdgcn_readfirstlane((unsigned)v), hi = __builtin_amdgcn_readfirstlane((unsigned)(v >> 32));
    return ((unsigned long long)hi << 32) | lo;
}
#define ldarg(C, i) ldarg_t<(i)>()
#define ARGF(i) ((const float*)(const GAS float*)ldarg(C, (i)))
#define WSP(T, off) ((T*)(GAS T*)((GAS unsigned char*)ldarg(C, A_WS) + (off)))

__device__ __forceinline__ void ph_mod_partial(const Ctx& C) {
    const float* cvec = ARGF(A_C); const float* cctx = ARGF(A_CCTX); const float* ada_w = ARGF(A_ADAW);
    float* modp = WSP(float, WS_MODP); float2* tw = WSP(float2, WS_TW);
    LAS float* sl = (LAS float*)C.lds;
    for (int item = C.bx; item < 2 * 8 * 12; item += C.G) {
        const int l = item / 96, rem = item % 96, kc = rem / 12, jb = rem % 12;
        __syncthreads();
        for (int e = C.tid(); e < 5 * 128; e += NTHR) { const int g = e >> 7, k = kc * 128 + (e & 127); const float v = g < 4 ? cvec[g * DM + k] : cctx[k]; sl[e] = v / (1.0f + __expf(-v)); }
        __syncthreads();
        const int j = jb * 512 + C.tid(); float a0 = 0.f, a1 = 0.f, a2 = 0.f, a3 = 0.f, a4 = 0.f;
        const float* wp = ada_w + ((size_t)l * DM + kc * 128) * NMOD + j;
#pragma unroll 4
        for (int k = 0; k < 128; ++k) { const float w = wp[(size_t)k * NMOD]; a0 += sl[k] * w; a1 += sl[128 + k] * w; a2 += sl[256 + k] * w; a3 += sl[384 + k] * w; a4 += sl[512 + k] * w; }
        float* pp = modp + ((size_t)(l * 8 + kc) * 5) * NMOD + j;
        pp[0] = a0; pp[NMOD] = a1; pp[2 * NMOD] = a2; pp[3 * NMOD] = a3; pp[4 * NMOD] = a4;
    }
    for (int m = C.gt(); m < 8192; m += C.NGT) { float s, c; sincospif((float)m * (1.0f / 4096.0f), &s, &c); tw[m] = make_float2(c, s); }
}
__device__ __forceinline__ void ph_mod_reduce(const Ctx& C) {
    const float* ada_b = ARGF(A_ADAB); const float* modp = WSP(float, WS_MODP); float* mod = WSP(float, WS_MOD);
    for (int e = C.gt(); e < 2 * 5 * NMOD; e += C.NGT) { const int l = e / (5 * NMOD), r = e % (5 * NMOD), j = r % NMOD; float s = ada_b[l * NMOD + j];
#pragma unroll
        for (int kc = 0; kc < 8; ++kc) s += modp[(size_t)(l * 8 + kc) * 5 * NMOD + r];
        mod[e] = s; }
    float* gnt = WSP(float, WS_GN); const float* n1g = ARGF(A_N1G); const float* n2g = ARGF(A_N2G);
    for (int e = C.gt(); e < 2 * 2 * 5 * DM; e += C.NGT) { const int col = e & 1023, grp = (e >> 10) % 5, w = (e / (5 * DM)) & 1, l = e / (10 * DM), j = (w ? 4 : 1) * DM + col;
        float s = ada_b[l * NMOD + j];
#pragma unroll
        for (int kc = 0; kc < 8; ++kc) s += modp[((size_t)(l * 8 + kc) * 5 + grp) * NMOD + j];
        gnt[e] = (w ? n2g : n1g)[l * DM + col] * (1.0f + s); }
}
__device__ __forceinline__ void ph_ctab(const Ctx& C, int l) {
    LAS float* red = (LAS float*)(C.lds + 131072); LAS float* cu = red + 8 * 5 * 64;
    const float* modl = WSP(const float, WS_MOD) + (size_t)l * 5 * NMOD; const float2* tw = WSP(const float2, WS_TW);
    float* cin = WSP(float, WS_CIN) + (size_t)l * 5 * NIN; float* cup = WSP(float, WS_CUP) + (size_t)l * 5 * FF;
    const int lane = C.lane(), w = C.wave, tid = C.tid();
    for (int it = C.bx; it < 88 + 64; it += C.G) {
        const bool isin = it < 88; const int ldw = isin ? NIN_ORIG : FF, col0 = (isin ? it : it - 88) * 64;
        const float* W = (isin ? ARGF(A_WIN) + (size_t)l * DM * NIN_ORIG : ARGF(A_W1) + (size_t)l * DM * FF) + (size_t)(128 * w) * ldw + col0 + lane;
        const float* shp = modl + (isin ? 0 : 3 * DM) + 128 * w;
        float a0 = 0.f, a1 = 0.f, a2 = 0.f, a3 = 0.f, a4 = 0.f;
#pragma unroll 16
        for (int kk = 0; kk < 128; ++kk) { const float wv = W[(size_t)kk * ldw]; a0 += shp[kk] * wv; a1 += shp[NMOD + kk] * wv; a2 += shp[2 * NMOD + kk] * wv; a3 += shp[3 * NMOD + kk] * wv; a4 += shp[4 * NMOD + kk] * wv; }
        __syncthreads();
        red[(w * 5 + 0) * 64 + lane] = a0; red[(w * 5 + 1) * 64 + lane] = a1; red[(w * 5 + 2) * 64 + lane] = a2; red[(w * 5 + 3) * 64 + lane] = a3; red[(w * 5 + 4) * 64 + lane] = a4;
        __syncthreads();
        if (tid < 320) { const int g = tid >> 6, c = tid & 63; float v = 0.f;
#pragma unroll
            for (int ww = 0; ww < 8; ++ww) v += red[(ww * 5 + g) * 64 + c];
            if (!isin) cup[g * FF + col0 + c] = v; else if (it >= 4) cin[g * NIN + col0 + c + 256] = v; else cu[g * 64 + c] = v; }
        if (isin && it < 4) { __syncthreads();
            if (tid < 320) { const int g = tid >> 6, kc = tid & 63; float p = 0.f, q = 0.f;
                for (int c = 0; c < 64; ++c) { const float2 t = tw[((c * kc) & 63) * 128]; const float v = cu[g * 64 + c]; p += v * t.x; q += v * t.y; }
                cin[g * NIN + it * 64 + kc] = p; cin[g * NIN + 256 + it * 64 + kc] = q; } }
    }
    __syncthreads();
}
__device__ __forceinline__ void ph_weights(const Ctx& C, int l) {
    LAS float* scr = (LAS float*)(C.lds + C.wave * 16384);
    const int lane = C.lane();
    const float* Win = ARGF(A_WIN) + (size_t)l * DM * NIN_ORIG;
    bf16* win_t = WSP(bf16, WS_WIN); bf16* wm_t = WSP(bf16, WS_WM);
    constexpr int I_IN = (DM / 64) * ((NIN_ORIG - 256) / 32), I_F = (256 / 64) * (DM / 32), I_A = (512 / 64) * (DM / 32), I_O = (DM / 64) * (DM / 32), I_1 = (DM / 64) * (FF / 32), I_2 = (FF / 64) * (DM / 32);
    constexpr int NITEMS = I_IN + 2 * I_F + I_A + I_O + I_1 + I_2;
    for (int it = C.gw; it < NITEMS; it += C.NGW) {
        int r = it;
        if (r < I_IN) { transpose_item(Win + 256, NIN_ORIG, NIN_ORIG - 256, win_t, DM, 512, 0, scr, r, lane); continue; } r -= I_IN;
        if (r < I_F) { transpose_item(ARGF(A_WF) + (size_t)l * 256 * DM, DM, DM, wm_t, DM, 0, 0, scr, r, lane); continue; } r -= I_F;
        if (r < I_F) { transpose_item(ARGF(A_WC) + (size_t)l * 256 * DM, DM, DM, wm_t, DM, 0, 256, scr, r, lane); continue; } r -= I_F;
        if (r < I_A) { transpose_item(ARGF(A_WA) + (size_t)l * 512 * DM, DM, DM, wm_t, DM, 0, 512, scr, r, lane); continue; } r -= I_A;
        if (r < I_O) { transpose_item(ARGF(A_WO) + (size_t)l * DM * DM, DM, DM, WSP(bf16, WS_WO), DM, 0, 0, scr, r, lane); continue; } r -= I_O;
        if (r < I_1) { transpose_item(ARGF(A_W1) + (size_t)l * DM * FF, FF, FF, WSP(bf16, WS_W1), DM, 0, 0, scr, r, lane); continue; } r -= I_1;
        transpose_item(ARGF(A_W2) + (size_t)l * FF * DM, DM, DM, WSP(bf16, WS_W2), FF, 0, 0, scr, r, lane);
    }
    for (int it = C.gw; it < 4 * 32 * 8; it += C.NGW) {
        const int kq = it & 7, g = it >> 8, k0 = ((it >> 3) & 31) * 32, kl = lane & 31, pq = lane >> 5;
        LAS float* tile = scr;
        LAS float* ct = scr + 32 * 65;
        { float s, c; sincospif((float)lane * (1.0f / 32.0f), &s, &c); ct[lane] = c; ct[64 + lane] = s; }
#pragma unroll 8
        for (int kk = 0; kk < 32; ++kk) tile[kk * 65 + lane] = Win[(size_t)(k0 + kk) * NIN_ORIG + g * 64 + lane];
        LDS_WAIT(); asm volatile("" ::: "memory");
        float p[8];
#pragma unroll
        for (int j = 0; j < 8; ++j) p[j] = 0.f;
#pragma unroll 4
        for (int c = 0; c < 64; ++c) { const float wv = tile[kl * 65 + c];
#pragma unroll
            for (int j = 0; j < 8; ++j) p[j] += wv * ct[pq * 64 + ((c * (kq * 8 + j)) & 63)]; }
#pragma unroll
        for (int j = 0; j < 8; ++j) win_t[(size_t)(pq * 256 + g * 64 + kq * 8 + j) * DM + k0 + kl] = (bf16)f2bf(p[j]);
        LDS_WAIT(); asm volatile("" ::: "memory");
    }
}
__device__ __forceinline__ void ph_prenorm(const Ctx& C, const float* xl, const float* xc, const float* gn, bf16* dst, u64* rs, int row_begin, int row_end, const float* part, const float* pgate) {
    const int lane = C.lane();
    for (int row = row_begin + C.gw; row < row_end; row += C.NGW) {
        const bool isc = row >= ML; const int grp = isc ? 4 : (row >> 13);
        const float* xr = isc ? xc + (size_t)(row - ML) * DM : xl + (size_t)row * DM;
        f32x4 v[4]; float s2 = 0.f;
#pragma unroll
        for (int j = 0; j < 4; ++j) { v[j] = *(const f32x4*)(xr + 4 * lane + 256 * j);
            if (part != nullptr && isc) {
                const size_t po = (size_t)(row - ML) * DM + 4 * lane + 256 * j;
                const f32x4 ps = (*(const f32x4*)(part + po) + *(const f32x4*)(part + po + 1048576)) + (*(const f32x4*)(part + po + 2 * 1048576) + *(const f32x4*)(part + po + 3 * 1048576));
                v[j] = v[j] + *(const f32x4*)(pgate + 4 * lane + 256 * j) * ps; }
            s2 += (v[j].x * v[j].x + v[j].y * v[j].y) + (v[j].z * v[j].z + v[j].w * v[j].w); }
        s2 = wave_sum(s2);
        if (lane == 0) rs[row] = (u64)(s2 * 16777216.0f + 0.5f);
#pragma unroll
        for (int j = 0; j < 4; ++j) { const int c0 = 4 * lane + 256 * j; const f32x4 y = v[j] * *(const f32x4*)(gn + grp * DM + c0);
            v2u o; o.x = pk2(y.x, y.y); o.y = pk2(y.z, y.w); *(v2u*)(dst + (size_t)row * DM + c0) = o; }
    }
}
__device__ __forceinline__ void ph_mixers(const Ctx& C, int l) {
    const float2* tw = WSP(const float2, WS_TW); const bf16* pxa = WSP(const bf16, WS_PXA); bf16* mix = WSP(bf16, WS_HX);
    const int lane = C.lane();
    if (l == 0) {
        LAS float* twl = (LAS float*)(C.lds + 98304);
        { const int t = C.tid(); if (t < 256) { const float2 v = tw[t * 32]; twl[2 * t] = v.x; twl[2 * t + 1] = v.y; } }
        __syncthreads();
        for (int it = C.gw; it < NB * 4 * 128; it += C.NGW) {
            const int kp = it & 127, kcb = (it >> 7) & 3, bb = it >> 9, k0 = 2 * kp, kc = kcb * 64 + lane;
            const bf16* src = pxa + ((size_t)ML + bb * 256) * NPXA + kc; float y0 = 0.f, y1 = 0.f;
#pragma unroll 32
            for (int n = 0; n < 256; ++n) { const float p = bf2f(src[(size_t)n * NPXA + OFF_P]), q = bf2f(src[(size_t)n * NPXA + OFF_Q]);
                const int i0 = (n * k0) & 255, i1 = (n * (k0 + 1)) & 255;
                y0 += p * twl[2 * i0] - q * twl[2 * i0 + 1]; y1 += p * twl[2 * i1] - q * twl[2 * i1 + 1]; }
            mix[((size_t)ML + bb * 256 + k0) * DM + kc] = (bf16)f2bf(y0 * (1.0f / 128.0f));
            mix[((size_t)ML + bb * 256 + k0 + 1) * DM + kc] = (bf16)f2bf(y1 * (1.0f / 128.0f));
        }
    }
    const float* cw = ARGF(A_CONVW) + l * 3 * 256;
    const int nrows = l == 0 ? MT : ML;
    for (int e = C.gt(); e < nrows * 32; e += C.NGT) {
        const int row = e >> 5, ch = (e & 31) * 8;
        const int pos = row < ML ? (row & (SEQ - 1)) : ((row - ML) & 255), len = row < ML ? SEQ : 256;
        const bf16* pr = pxa + (size_t)row * NPXA;
        const v4u u1 = *(const v4u*)(pr + OFF_CU + ch), c1 = *(const v4u*)(pr + OFF_CC + ch), b1 = *(const v4u*)(pr + OFF_CB + ch);
        v4u u0 = (v4u){0, 0, 0, 0}, c0 = u0, u2 = u0, c2 = u0;
        if (pos > 0) { u0 = *(const v4u*)(pr - NPXA + OFF_CU + ch); c0 = *(const v4u*)(pr - NPXA + OFF_CC + ch); }
        if (pos < len - 1) { u2 = *(const v4u*)(pr + NPXA + OFF_CU + ch); c2 = *(const v4u*)(pr + NPXA + OFF_CC + ch); }
        float o[8]; float w0[8], w1[8], w2[8];
        { const f32x4 t0 = *(const f32x4*)(cw + ch), t1 = *(const f32x4*)(cw + ch + 4), t2 = *(const f32x4*)(cw + 256 + ch), t3 = *(const f32x4*)(cw + 256 + ch + 4), t4 = *(const f32x4*)(cw + 512 + ch), t5 = *(const f32x4*)(cw + 512 + ch + 4);
#pragma unroll
          for (int j = 0; j < 4; ++j) { w0[j] = t0[j]; w0[4 + j] = t1[j]; w1[j] = t2[j]; w1[4 + j] = t3[j]; w2[j] = t4[j]; w2[4 + j] = t5[j]; } }
#pragma unroll
        for (int j = 0; j < 4; ++j) {
            const unsigned a0 = u0[j], d0 = c0[j], a1 = u1[j], d1 = c1[j], a2 = u2[j], d2 = c2[j], bb = b1[j];
            o[2 * j] = bflo(bb) * (w0[2 * j] * bflo(a0) * bflo(d0) + w1[2 * j] * bflo(a1) * bflo(d1) + w2[2 * j] * bflo(a2) * bflo(d2));
            o[2 * j + 1] = bfhi(bb) * (w0[2 * j + 1] * bfhi(a0) * bfhi(d0) + w1[2 * j + 1] * bfhi(a1) * bfhi(d1) + w2[2 * j + 1] * bfhi(a2) * bfhi(d2));
        }
        v4u w; w.x = pk2(o[0], o[1]); w.y = pk2(o[2], o[3]); w.z = pk2(o[4], o[5]); w.w = pk2(o[6], o[7]);
        *(v4u*)(mix + (size_t)row * DM + 256 + ch) = w;
    }
}

typedef short bf16x8_t __attribute__((ext_vector_type(8)));
typedef short v4i16_t __attribute__((ext_vector_type(4)));
constexpr int AT_KW = 0, AT_VW = 73728, AT_BT = 147456;
template <bool WIN>
__device__ __forceinline__ void attn_block(LAS unsigned char* lds, const int (&ka)[2][2], const int (&va)[2][4], int rowoff0, const bf16x8_t (&qf)[2],
                                           const LAS float* brow  , const int (&dc)[2][4], unsigned vmask, f32x4 (&o)[4], float& m, float& l) {
    constexpr float SC = 0.18033688011112042f;
    constexpr int RS = WIN ? 8192 : 4096;
    f32x4 s[8][2];
#pragma unroll
    for (int j = 0; j < 8; ++j)
#pragma unroll
        for (int t = 0; t < 2; ++t) { s[j][t] = (f32x4){0.f, 0.f, 0.f, 0.f};
#pragma unroll
            for (int ks = 0; ks < 2; ++ks) { const bf16x8_t kf = *(const LAS bf16x8_t*)(lds + ka[t][ks] + rowoff0 + j * RS); s[j][t] = __builtin_amdgcn_mfma_f32_16x16x32_bf16(kf, qf[ks], s[j][t], 0, 0, 0); } }
    float tmax = -1e30f;
#pragma unroll
    for (int j = 0; j < 8; ++j)
#pragma unroll
        for (int t = 0; t < 2; ++t)
#pragma unroll
            for (int i = 0; i < 4; ++i) { float v = s[j][t][i] * SC; if (WIN) { v += brow[j * 31 + dc[t][i]]; if (!((vmask >> (t * 4 + i)) & 1u)) v = -1e30f; } s[j][t][i] = v; tmax = fmaxf(tmax, v); }
    tmax = fmaxf(tmax, __shfl_xor(tmax, 16)); tmax = fmaxf(tmax, __shfl_xor(tmax, 32));
    const float mn = fmaxf(m, tmax), alpha = __builtin_amdgcn_exp2f(m - mn); m = mn;
    float ps = 0.f;
#pragma unroll
    for (int j = 0; j < 8; ++j)
#pragma unroll
        for (int t = 0; t < 2; ++t)
#pragma unroll
            for (int i = 0; i < 4; ++i) { const float p = __builtin_amdgcn_exp2f(s[j][t][i] - mn); s[j][t][i] = p; ps += p; }
    l = l * alpha + ps;
#pragma unroll
    for (int db = 0; db < 4; ++db) o[db] = o[db] * alpha;
#pragma unroll
    for (int j = 0; j < 8; ++j) {
        v4u pw; pw.x = pg8::cvt_pk_bf16(s[j][0][0], s[j][0][1]); pw.y = pg8::cvt_pk_bf16(s[j][0][2], s[j][0][3]); pw.z = pg8::cvt_pk_bf16(s[j][1][0], s[j][1][1]); pw.w = pg8::cvt_pk_bf16(s[j][1][2], s[j][1][3]);
        const bf16x8_t pf = __builtin_bit_cast(bf16x8_t, pw);
#pragma unroll
        for (int db = 0; db < 4; ++db) {
            const v4i16_t lo = __builtin_amdgcn_ds_read_tr16_b64_v4i16((LAS v4i16_t*)(lds + va[0][db] + rowoff0 + j * RS));
            const v4i16_t hi = __builtin_amdgcn_ds_read_tr16_b64_v4i16((LAS v4i16_t*)(lds + va[1][db] + rowoff0 + j * RS));
            const bf16x8_t vf = (bf16x8_t){lo[0], lo[1], lo[2], lo[3], hi[0], hi[1], hi[2], hi[3]};
            o[db] = __builtin_amdgcn_mfma_f32_16x16x32_bf16(vf, pf, o[db], 0, 0, 0);
        }
    }
}
__device__ __forceinline__ void attn_addr(int kc0off, int li, int fq, int (&ka)[2][2], int (&va)[2][4]) {
#pragma unroll
    for (int t = 0; t < 2; ++t) {
        const int rk = kc0off + 16 * t + li;
#pragma unroll
        for (int ks = 0; ks < 2; ++ks) ka[t][ks] = AT_KW + rk * 128 + (((4 * ks + fq) ^ ((rk >> 1) & 7)) * 16);
        const int rv = kc0off + 16 * t + 4 * fq + (li >> 2), p = li & 3;
#pragma unroll
        for (int db = 0; db < 4; ++db) va[t][db] = AT_VW + rv * 128 + (((2 * db + (p >> 1)) ^ (((rv >> 1) & 3) << 1)) * 16) + (p & 1) * 8;
    }
}

__device__ __forceinline__ size_t zt_off(int b) { return b < 2 ? WS_TB + (size_t)b * 8 * MiB : (b == 2 ? (size_t)502 * MiB : WS_WIN); }
__device__ __forceinline__ void ph_t1(const Ctx& C) {
    const bf16* pxa = WSP(const bf16, WS_PXA); const int lane = C.lane();
    LAS unsigned short* tile = (LAS unsigned short*)(C.lds + C.wave * 9216);
    for (int it = C.gw; it < 4 * 2 * 128 * 4; it += C.NGW) {
        const int kcb = it & 3, n2 = (it >> 2) & 127, pq = (it >> 9) & 1, b = it >> 10;
#pragma unroll
        for (int i = 0; i < 8; ++i) { const int q = i * 64 + lane, n1 = q >> 3, cc = q & 7;
            const v4u v = *(const v4u*)(pxa + ((size_t)b * SEQ + n1 * 128 + n2) * NPXA + pq * 256 + kcb * 64 + cc * 8);
            *(LAS v4u*)(tile + n1 * 72 + cc * 8) = v; }
        LDS_WAIT(); asm volatile("" ::: "memory");
        bf16* zt = WSP(bf16, zt_off(b)) + ((size_t)(pq * 256 + kcb * 64 + lane) * SEQ + n2 * 64);
#pragma unroll
        for (int c = 0; c < 8; ++c) { v4u o;
            o.x = (unsigned)tile[(8 * c + 0) * 72 + lane] | ((unsigned)tile[(8 * c + 1) * 72 + lane] << 16); o.y = (unsigned)tile[(8 * c + 2) * 72 + lane] | ((unsigned)tile[(8 * c + 3) * 72 + lane] << 16);
            o.z = (unsigned)tile[(8 * c + 4) * 72 + lane] | ((unsigned)tile[(8 * c + 5) * 72 + lane] << 16); o.w = (unsigned)tile[(8 * c + 6) * 72 + lane] | ((unsigned)tile[(8 * c + 7) * 72 + lane] << 16);
            *(v4u*)(zt + 8 * c) = o; }
        LDS_WAIT(); asm volatile("" ::: "memory");
    }
}
typedef float f32x16 __attribute__((ext_vector_type(16)));
constexpr int FT_C64 = 0, FT_S64 = 9216, FT_C128 = 18432, FT_S128 = FT_C128 + 34816, FT_TA = FT_S128 + 34816, FT_TR = FT_TA + 4096, FT_ST = FT_TR + 8192;
static_assert(FT_ST + 32768 <= LDSCTL_OFF, "fft lds");
__device__ __forceinline__ int crow16(int r, int h) { return (r & 3) + 8 * (r >> 2) + 4 * h; }
__device__ __forceinline__ void ph_fft(const Ctx& C) {
    LAS unsigned char* lds = C.lds; const int tid = C.tid(), lane = C.lane(), w = C.wave, h = lane >> 5, c = lane & 31;
    const float2* tw = WSP(const float2, WS_TW); bf16* mix = WSP(bf16, WS_HX);
    { LAS unsigned short* c64 = (LAS unsigned short*)(lds + FT_C64); LAS unsigned short* s64 = (LAS unsigned short*)(lds + FT_S64);
#pragma unroll 4
      for (int e = tid; e < 4096; e += NTHR) { const int k1 = e >> 6, n1 = e & 63; float sn, cs; sincospif((float)((n1 * k1) & 63) * (1.0f / 32.0f), &sn, &cs); c64[k1 * 72 + n1] = (unsigned short)f2bf(cs); s64[k1 * 72 + n1] = (unsigned short)f2bf(sn); }
      LAS unsigned short* c128 = (LAS unsigned short*)(lds + FT_C128); LAS unsigned short* s128 = (LAS unsigned short*)(lds + FT_S128);
#pragma unroll 4
      for (int e = tid; e < 16384; e += NTHR) { const int k2 = e >> 7, p = e & 127, q = p & 15, n2 = (p & ~15) + (q & 3) + ((q >> 2) & 1) * 8 + ((q >> 3) & 1) * 4;
          float sn, cs; sincospif((float)((n2 * k2) & 127) * (1.0f / 64.0f), &sn, &cs); c128[k2 * 136 + p] = (unsigned short)f2bf(cs); s128[k2 * 136 + p] = (unsigned short)f2bf(sn); }
      LAS float* ta = (LAS float*)(lds + FT_TA); LAS float* trt = (LAS float*)(lds + FT_TR);
      { const int e = tid, g = e >> 6, kk = e & 63; float sn, cs; sincospif((float)((32 * (g >> 1) + 4 * (g & 1)) * kk) * (1.0f / 4096.0f), &sn, &cs); ta[2 * e] = cs; ta[2 * e + 1] = sn; }
      for (int e = tid; e < 1024; e += NTHR) { const int r = e >> 6, kk = e & 63; float sn, cs; sincospif((float)(crow16(r, 0) * kk) * (1.0f / 4096.0f), &sn, &cs); trt[2 * e] = cs; trt[2 * e + 1] = sn; }
    }
    __syncthreads();
    const int vcu = (C.G % 8 == 0) ? (C.bx % 8) * (C.G / 8) + C.bx / 8 : C.bx;
    for (int it = vcu; it < 256; it += C.G) {
        const int kb = it & 1, kcg = (it >> 1) & 31, b = it >> 6, kc = kcg * 8 + w, k1 = 32 * kb + c;
        const bf16* zp = WSP(const bf16, zt_off(b)) + (size_t)kc * SEQ; const bf16* zq = zp + (size_t)256 * SEQ;
        f32x16 acc[4];
#pragma unroll
        for (int rb2 = 0; rb2 < 4; ++rb2) acc[rb2] = (f32x16){};
#pragma unroll 1
        for (int rb = 0; rb < 4; ++rb) {
            const int n2 = 32 * rb + c;
            f32x16 xr = {}, xi = {};
#pragma unroll
            for (int ks = 0; ks < 4; ++ks) {
                const bf16x8_t cf = *(const LAS bf16x8_t*)(lds + FT_C64 + (k1 * 72 + 16 * ks + 8 * h) * 2), sf = *(const LAS bf16x8_t*)(lds + FT_S64 + (k1 * 72 + 16 * ks + 8 * h) * 2);
                const bf16x8_t pf = *(const bf16x8_t*)(zp + n2 * 64 + 16 * ks + 8 * h), qf = *(const bf16x8_t*)(zq + n2 * 64 + 16 * ks + 8 * h);
                const v4u t = __builtin_bit_cast(v4u, qf) ^ 0x80008000u; const bf16x8_t qn = __builtin_bit_cast(bf16x8_t, t);
                xr = __builtin_amdgcn_mfma_f32_32x32x16_bf16(pf, cf, xr, 0, 0, 0); xi = __builtin_amdgcn_mfma_f32_32x32x16_bf16(pf, sf, xi, 0, 0, 0);
                xi = __builtin_amdgcn_mfma_f32_32x32x16_bf16(qf, cf, xi, 0, 0, 0); xr = __builtin_amdgcn_mfma_f32_32x32x16_bf16(qn, sf, xr, 0, 0, 0); }
            bf16x8_t bre[2], bim[2];
            const LAS float* tap = (const LAS float*)(lds + FT_TA) + 2 * ((rb * 2 + h) * 64 + k1); const float ac_ = tap[0], as_ = tap[1];
            const LAS float* trp = (const LAS float*)(lds + FT_TR) + 2 * k1;
#pragma unroll
            for (int sblk = 0; sblk < 2; ++sblk) {
                float tr[8], ti[8];
#pragma unroll
                for (int r8 = 0; r8 < 8; ++r8) { const int r = 8 * sblk + r8; const float rc = trp[128 * r], rs = trp[128 * r + 1]; const float tc = ac_ * rc - as_ * rs, ts = ac_ * rs + as_ * rc;
                    tr[r8] = xr[r] * tc - xi[r] * ts; ti[r8] = -(xr[r] * ts + xi[r] * tc); }
                v4u a, bq;
                a.x = pg8::cvt_pk_bf16(tr[0], tr[1]); a.y = pg8::cvt_pk_bf16(tr[2], tr[3]); a.z = pg8::cvt_pk_bf16(tr[4], tr[5]); a.w = pg8::cvt_pk_bf16(tr[6], tr[7]);
                bq.x = pg8::cvt_pk_bf16(ti[0], ti[1]); bq.y = pg8::cvt_pk_bf16(ti[2], ti[3]); bq.z = pg8::cvt_pk_bf16(ti[4], ti[5]); bq.w = pg8::cvt_pk_bf16(ti[6], ti[7]);
                bre[sblk] = __builtin_bit_cast(bf16x8_t, a); bim[sblk] = __builtin_bit_cast(bf16x8_t, bq); }
#pragma unroll
            for (int rb2 = 0; rb2 < 4; ++rb2) {
                const int k2 = 32 * rb2 + c;
#pragma unroll
                for (int sblk = 0; sblk < 2; ++sblk) {
                    const bf16x8_t ac = *(const LAS bf16x8_t*)(lds + FT_C128 + (k2 * 136 + 32 * rb + 16 * sblk + 8 * h) * 2), as = *(const LAS bf16x8_t*)(lds + FT_S128 + (k2 * 136 + 32 * rb + 16 * sblk + 8 * h) * 2);
                    acc[rb2] = __builtin_amdgcn_mfma_f32_32x32x16_bf16(ac, bre[sblk], acc[rb2], 0, 0, 0); acc[rb2] = __builtin_amdgcn_mfma_f32_32x32x16_bf16(as, bim[sblk], acc[rb2], 0, 0, 0); }
            }
        }
#pragma unroll
        for (int rb2 = 0; rb2 < 4; ++rb2) {
            LAS unsigned short* st = (LAS unsigned short*)(lds + FT_ST + (rb2 & 1) * 16384);
#pragma unroll
            for (int r = 0; r < 16; ++r) st[((crow16(r, h) * 32 + c) * 8) + w] = (unsigned short)f2bf(acc[rb2][r] * 0.001381067932f);
            LDS_WAIT(); __syncthreads();
#pragma unroll
            for (int j = 0; j < 2; ++j) { const int idx = tid + 512 * j, k2l = idx >> 5, k1l = idx & 31;
                const v4u v = *(const LAS v4u*)(st + idx * 8);
                *(v4u*)(mix + ((size_t)b * SEQ + 32 * kb + k1l + 64 * (32 * rb2 + k2l)) * DM + kcg * 8) = v; }
        }
        __syncthreads();
    }
}
__device__ __forceinline__ void ph_attn(const Ctx& C, int l) {
    const bf16* pxa = WSP(const bf16, WS_PXA); bf16* mix = WSP(bf16, WS_HX);
    const float* rb = ARGF(A_RELB) + (size_t)l * 8 * 15 * 31;
    LAS unsigned char* lds = C.lds; LAS float* biasT = (LAS float*)(lds + AT_BT);
    const int lane = C.lane(), w = C.wave, fq = lane >> 4, li = lane & 15, tid = C.tid();
    const int nunits = 2048 + (l == 0 ? 64 : 0);
    const int vcu = (C.G % 8 == 0) ? (C.bx % 8) * (C.G / 8) + C.bx / 8 : C.bx;
    for (int u = vcu; u < nunits; u += C.G) {
        const bool isc = u >= 2048;
        int b, h, rp; if (!isc) { b = u >> 9; h = (u >> 6) & 7; rp = u & 63; } else { const int v = u - 2048; b = v >> 4; h = (v >> 1) & 7; rp = v & 1; }
        __syncthreads();
        for (int e = tid; e < 465; e += NTHR) biasT[e] = rb[h * 465 + e] * 1.4426950408889634f;
        const int R0 = min(max(2 * rp - 4, 0), 120);
        if (!isc) {
            for (int p = w; p < 72; p += 8) {
                const int tokl = p * 8 + (lane >> 3), lr = tokl >> 6, col = tokl & 63, gr = min(R0 + lr, 127), cp = lane & 7;
                const bf16* src = pxa + ((size_t)b * SEQ + gr * 64 + col) * NPXA + h * 64;
                __builtin_amdgcn_global_load_lds((const unsigned*)(src + OFF_K + ((cp ^ ((tokl >> 1) & 7)) * 8)), (LAS unsigned*)(lds + AT_KW + p * 1024), 16, 0, 0);
                __builtin_amdgcn_global_load_lds((const unsigned*)(src + OFF_V + ((cp ^ (((tokl >> 1) & 3) << 1)) * 8)), (LAS unsigned*)(lds + AT_VW + p * 1024), 16, 0, 0);
            }
        }
        int r = 0, qc = 0; size_t token;
        if (!isc) { r = 2 * rp + (w >> 2); qc = 16 * (w & 3) + li; token = (size_t)b * SEQ + r * 64 + qc; }
        else token = (size_t)ML + b * 256 + rp * 128 + 16 * w + li;
        bf16x8_t qf[2];
#pragma unroll
        for (int ks = 0; ks < 2; ++ks) qf[ks] = *(const bf16x8_t*)(pxa + token * NPXA + OFF_QQ + h * 64 + 32 * ks + 8 * fq);
        f32x4 o[4]; float m = -1e30f, lsum = 0.f;
#pragma unroll
        for (int db = 0; db < 4; ++db) o[db] = (f32x4){0.f, 0.f, 0.f, 0.f};
        int ka[2][2], va[2][4], dc[2][4];
        asm volatile("s_waitcnt vmcnt(0)" ::: "memory");
        __syncthreads();
        if (!isc) {
            const int cb = w & 3, kc0 = cb == 0 ? 0 : cb == 1 ? 8 : cb == 2 ? 24 : 32;
            attn_addr(kc0, li, fq, ka, va);
            const int csq = min(max(qc - 8, 0), 48); unsigned vmask = 0u;
#pragma unroll
            for (int t = 0; t < 2; ++t)
#pragma unroll
                for (int i = 0; i < 4; ++i) { const int kcol = kc0 + 16 * t + 4 * fq + i; if (kcol >= csq && kcol < csq + 16) vmask |= 1u << (t * 4 + i); dc[t][i] = min(max(kcol - qc + 15, 0), 30); }
            const int rsr = min(max(r - 4, 0), 120), lr0 = rsr - R0;
            attn_block<true>(lds, ka, va, lr0 * 8192, qf, biasT + (rsr - r + 7) * 31, dc, vmask, o, m, lsum);
        }
        __syncthreads();
        for (int p = w; p < 32; p += 8) {
            const int tokl = p * 8 + (lane >> 3), cp = lane & 7;
            const bf16* src = pxa + ((size_t)ML + b * 256 + tokl) * NPXA + h * 64;
            __builtin_amdgcn_global_load_lds((const unsigned*)(src + OFF_K + ((cp ^ ((tokl >> 1) & 7)) * 8)), (LAS unsigned*)(lds + AT_KW + p * 1024), 16, 0, 0);
            __builtin_amdgcn_global_load_lds((const unsigned*)(src + OFF_V + ((cp ^ (((tokl >> 1) & 3) << 1)) * 8)), (LAS unsigned*)(lds + AT_VW + p * 1024), 16, 0, 0);
        }
        attn_addr(0, li, fq, ka, va);
        asm volatile("s_waitcnt vmcnt(0)" ::: "memory");
        __syncthreads();
        attn_block<false>(lds, ka, va, 0, qf, (const LAS float*)nullptr, dc, 0xffu, o, m, lsum);
        lsum += __shfl_xor(lsum, 16); lsum += __shfl_xor(lsum, 32);
        const float inv = 1.0f / lsum;
        bf16* op = mix + token * DM + 512 + h * 64 + 4 * fq;
#pragma unroll
        for (int db = 0; db < 4; ++db) { v2u ov; ov.x = pk2(o[db][0] * inv, o[db][1] * inv); ov.y = pk2(o[db][2] * inv, o[db][3] * inv); *(v2u*)(op + 16 * db) = ov; }
    }
}

template <int KS>
__device__ __forceinline__ void wg_core(const bf16* A, const bf16* W, int li, int fq, f32x4 (&acc)[4][2]) {
    const bf16* ap = A + (size_t)li * DM + 8 * fq; const bf16* wp = W + (size_t)li * DM + 8 * fq;
    bf16x8_t af[4][4], wf[4][2];
#pragma unroll
    for (int s = 0; s < 3; ++s) {
#pragma unroll
        for (int m = 0; m < 4; ++m) af[s][m] = *(const bf16x8_t*)(ap + (size_t)(16 * m) * DM + 32 * s);
#pragma unroll
        for (int n = 0; n < 2; ++n) wf[s][n] = *(const bf16x8_t*)(wp + (size_t)(16 * n) * DM + 32 * s); }
#pragma unroll
    for (int s = 0; s < KS; ++s) {
        if (s + 3 < KS) {
#pragma unroll
            for (int m = 0; m < 4; ++m) af[(s + 3) & 3][m] = *(const bf16x8_t*)(ap + (size_t)(16 * m) * DM + 32 * (s + 3));
#pragma unroll
            for (int n = 0; n < 2; ++n) wf[(s + 3) & 3][n] = *(const bf16x8_t*)(wp + (size_t)(16 * n) * DM + 32 * (s + 3)); }
#pragma unroll
        for (int m = 0; m < 4; ++m)
#pragma unroll
            for (int n = 0; n < 2; ++n) acc[m][n] = __builtin_amdgcn_mfma_f32_16x16x32_bf16(wf[s & 3][n], af[s & 3][m], acc[m][n], 0, 0, 0);
    }
}
__device__ __forceinline__ void wg_merge_ctx(const Ctx& C) {
    if (C.wave >= 2) return;
    const bf16* mix = WSP(const bf16, WS_HX); const bf16* wm = WSP(const bf16, WS_WM); const bf16* pxg = WSP(const bf16, WS_PXG); bf16* mb = WSP(bf16, WS_M);
    const int lane = C.lane(), li = lane & 15, fq = lane >> 4;
    for (int it = C.wave * C.G + C.bx; it < 512; it += 2 * C.G) {
        const int r0 = ML + 64 * (it >> 5), c0 = 32 * (it & 31);
        f32x4 a0[4][2], a1[4][2], a2[4][2];
#pragma unroll
        for (int m = 0; m < 4; ++m)
#pragma unroll
            for (int n = 0; n < 2; ++n) { a0[m][n] = (f32x4){0.f, 0.f, 0.f, 0.f}; a1[m][n] = a0[m][n]; a2[m][n] = a0[m][n]; }
        const bf16* A = mix + (size_t)r0 * DM; const bf16* W = wm + (size_t)c0 * DM;
        wg_core<8>(A, W, li, fq, a0); wg_core<8>(A + 256, W + 256, li, fq, a1); wg_core<16>(A + 512, W + 512, li, fq, a2);
#pragma unroll
        for (int m = 0; m < 4; ++m)
#pragma unroll
            for (int n = 0; n < 2; ++n) { const size_t row = (size_t)(r0 + 16 * m + li); const int col = c0 + 16 * n + 4 * fq;
                const v2u g0 = *(const v2u*)(pxg + row * NPXG + col), g1 = *(const v2u*)(pxg + row * NPXG + 1024 + col), g2 = *(const v2u*)(pxg + row * NPXG + 2048 + col);
                const float o0 = a0[m][n][0] * bflo(g0.x) + a1[m][n][0] * bflo(g1.x) + a2[m][n][0] * bflo(g2.x), o1 = a0[m][n][1] * bfhi(g0.x) + a1[m][n][1] * bfhi(g1.x) + a2[m][n][1] * bfhi(g2.x);
                const float o2 = a0[m][n][2] * bflo(g0.y) + a1[m][n][2] * bflo(g1.y) + a2[m][n][2] * bflo(g2.y), o3 = a0[m][n][3] * bfhi(g0.y) + a1[m][n][3] * bfhi(g1.y) + a2[m][n][3] * bfhi(g2.y);
                v2u w; w.x = cvt_pk_bf16(o0, o1); w.y = cvt_pk_bf16(o2, o3); *(v2u*)(mb + row * DM + col) = w; }
    }
}
__device__ __forceinline__ void wg_wo_ctx(const Ctx& C) {
    if (C.wave >= 2) return;
    const bf16* mb = WSP(const bf16, WS_M); const bf16* wo = WSP(const bf16, WS_WO); const float* base = ARGF(A_CTX); float* out = WSP(float, WS_CTXX);
    const float* gate = WSP(const float, WS_MOD) + 4 * NMOD + 2 * DM; const float* gn = WSP(const float, WS_GN) + (size_t)(1 * 5 + 4) * DM; bf16* ap = WSP(bf16, WS_HX); u64* rs = WSP(u64, WS_RS) + (size_t)1 * MT;
    const int lane = C.lane(), li = lane & 15, fq = lane >> 4;
    for (int it = C.wave * C.G + C.bx; it < 512; it += 2 * C.G) {
        const int r0 = 64 * (it >> 5), c0 = 32 * (it & 31);
        f32x4 acc[4][2];
#pragma unroll
        for (int m = 0; m < 4; ++m)
#pragma unroll
            for (int n = 0; n < 2; ++n) acc[m][n] = (f32x4){0.f, 0.f, 0.f, 0.f};
        wg_core<32>(mb + (size_t)(ML + r0) * DM, wo + (size_t)c0 * DM, li, fq, acc);
#pragma unroll
        for (int m = 0; m < 4; ++m) { const size_t rc = (size_t)(r0 + 16 * m + li); float ss = 0.f;
#pragma unroll
            for (int n = 0; n < 2; ++n) { const int col = c0 + 16 * n + 4 * fq;
                const f32x4 o = *(const f32x4*)(base + rc * DM + col) + *(const f32x4*)(gate + col) * acc[m][n];
                *(f32x4*)(out + rc * DM + col) = o;
                const f32x4 y = o * *(const f32x4*)(gn + col); v2u w; w.x = cvt_pk_bf16(y[0], y[1]); w.y = cvt_pk_bf16(y[2], y[3]); *(v2u*)(ap + (ML + rc) * DM + col) = w;
                ss += (o[0] * o[0] + o[1] * o[1]) + (o[2] * o[2] + o[3] * o[3]); }
            ss += __shfl_xor(ss, 16); ss += __shfl_xor(ss, 32);
            if (fq == 0) __hip_atomic_fetch_add(rs + ML + rc, (u64)(ss * 16777216.0f + 0.5f), __ATOMIC_RELAXED, __HIP_MEMORY_SCOPE_AGENT); }
    }
}
__device__ __forceinline__ void ph_final(const Ctx& C) {
    float* out = (float*)(GAS float*)ldarg(C, A_OUT); const float* fg = ARGF(A_FG); const int lane = C.lane();
    for (int row = C.gw; row < ML; row += C.NGW) {
        float* xr = out + (size_t)row * DM;
        f32x4 v[4]; float s2 = 0.f;
#pragma unroll
        for (int j = 0; j < 4; ++j) { v[j] = *(const f32x4*)(xr + 4 * lane + 256 * j); s2 += (v[j].x * v[j].x + v[j].y * v[j].y) + (v[j].z * v[j].z + v[j].w * v[j].w); }
        const float rstd = 1.0f / sqrtf(wave_sum(s2) * (1.0f / DM) + EPS);
#pragma unroll
        for (int j = 0; j < 4; ++j) { const int c0 = 4 * lane + 256 * j; const f32x4 gg = *(const f32x4*)(fg + c0); *(f32x4*)(xr + c0) = v[j] * rstd * gg; }
    }
}

struct Args { const void* p[A_NARGS]; int ph_lo, ph_hi; };

__global__ void __launch_bounds__(NTHR, 2) fwd_kernel(Args args) {
    extern __shared__ __attribute__((aligned(16))) unsigned char lds_raw[];
    LAS unsigned char* const lds0 = (LAS unsigned char*)lds_raw;
    const int wave0 = __builtin_amdgcn_readfirstlane(threadIdx.x >> 6);
    { const int t0 = threadIdx.x;
      for (int u = t0; u < (LDS_BYTES - LDSCTL_OFF) / 4; u += NTHR) ((LAS unsigned*)(lds0 + LDSCTL_OFF))[u] = 0u;
      __syncthreads();
      if (t0 < A_NARGS) ((LAS unsigned long long*)(lds0 + LARGS_OFF))[t0] = (unsigned long long)args.p[t0];
      __syncthreads(); }
    const int lo = args.ph_lo, hi = args.ph_hi;
    const unsigned xcc = xb_xcc_id();
    int vbx = blockIdx.x;
    if (!MK_MULTI) { Ctx C; C.lds = lds0; C.wave = wave0; gu32* ctl0 = (gu32*)WSP(unsigned, WS_CTL); (void)xcd_barrier_post((unsigned*)(ctl0 + CW_BAR), (volatile LAS unsigned*)(lds0 + MISC_OFF) + 8, C.tid() == 0); }
    for (int step = lo; step < hi; ++step) {
        const int ls = step - 2, l = ls >= NS ? 1 : 0, k = (step < 2) ? -1 - step : ls - l * NS;
        const int nrep = (PROBE_K != -99 && k == PROBE_K) ? PROBE_N : 1;
        for (int rep = 0; rep < nrep; ++rep) {
        Ctx C;
        C.lds = lds0; C.wave = wave0; C.G = gridDim.x; C.bx = vbx;
        asm volatile("" : "+s"(C.wave), "+s"(C.bx), "+s"(C.G));
        C.gw = C.bx * NWAVES + C.wave; C.NGW = C.G * NWAVES; C.NGT = C.G * NTHR;
        gu32* ctl = (gu32*)WSP(unsigned, WS_CTL);
        if (k == -1) { ph_mod_partial(C); __syncthreads(); ph_weights(C, 0); }
        else if (k == -2) ph_mod_reduce(C);
        else if (k == 0) {
            if (l == 1) ph_weights(C, l);
            ph_ctab(C, l);
            u64* rsb = WSP(u64, WS_RS) + (size_t)(l == 0 ? 0 : 2) * MT;
            if (l == 0) ph_prenorm(C, ARGF(A_X), ARGF(A_CTX), WSP(const float, WS_GN), WSP(bf16, WS_HX), rsb, 0, MT, (const float*)nullptr, (const float*)nullptr);
            else ph_prenorm(C, ARGF(A_OUT), WSP(const float, WS_CTXX), WSP(const float, WS_GN) + 2 * 5 * DM, WSP(bf16, WS_HX), rsb, ML, MT, WSP(const float, WS_PART), WSP(const float, WS_MOD) + 4 * NMOD + 5 * DM);
        } else if (k == 1) {
            pg8::Prob<false> P{WSP(const bf16, WS_HX), WSP(const bf16, WS_WIN), DM, DM, DM}; pg8::StaticOrder<1> S; S.init(MT, NIN, C.G, C.bx);
            EpiIn E{WSP(bf16, WS_PXA), WSP(bf16, WS_PXG), WSP(const u64, WS_RS) + (size_t)(l == 0 ? 0 : 2) * MT, WSP(const float, WS_CIN) + (size_t)l * 5 * NIN};
            pg8::gemm_phase(C.lds, P, S, E, C.tid());
        } else if (k == 2) {
            const int sub = rep == 0 ? 7 : PROBE_SUB;
            if (sub & 1) ph_t1(C);
            if (sub & 2) ph_mixers(C, l);
            if (sub & 4) ph_attn(C, l);
        } else if (k == 3) {
            ph_fft(C);
        } else if (k == 4) {
            pg8::Prob<false> P{WSP(const bf16, WS_HX), WSP(const bf16, WS_WM), DM, DM, DM}; pg8::StaticOrder<1> S; S.init(ML, DM, C.G, C.bx);
            EpiMerge E{WSP(bf16, WS_M), WSP(const bf16, WS_PXG)};
            pg8::gemm_phase(C.lds, P, S, E, C.tid());
            if (l == 0) wg_merge_ctx(C);
        } else if (k == 5) {
            pg8::Prob<false> P{WSP(const bf16, WS_M), WSP(const bf16, WS_WO), DM, DM, DM}; pg8::StaticOrder<1> S; S.init(ML, DM, C.G, C.bx);
            EpiRes E{l == 0 ? ARGF(A_X) : ARGF(A_OUT), l == 0 ? ARGF(A_CTX) : WSP(const float, WS_CTXX), (float*)(GAS float*)ldarg(C, A_OUT), WSP(float, WS_CTXX),
                     rep > 0 ? WSP(const float, WS_ZERO) : WSP(const float, WS_MOD) + (size_t)l * 5 * NMOD + 2 * DM, nullptr,
                     WSP(const float, WS_GN) + (size_t)(l * 2 + 1) * 5 * DM, WSP(bf16, WS_HX), WSP(u64, WS_RS) + (size_t)(l == 0 ? 1 : 3) * MT};
            pg8::gemm_phase(C.lds, P, S, E, C.tid());
            if (l == 0 && rep == 0) wg_wo_ctx(C);
        } else if (k == 6) {
            pg8::Prob<false> P{WSP(const bf16, WS_HX), WSP(const bf16, WS_W1), DM, DM, DM}; pg8::StaticOrder<1> S; S.init(l == 0 ? MT : ML, FF, C.G, C.bx);
            EpiAct E{WSP(bf16, WS_ACT), WSP(const u64, WS_RS) + (size_t)(l == 0 ? 1 : 3) * MT, WSP(const float, WS_CUP) + (size_t)l * 5 * FF};
            pg8::gemm_phase(C.lds, P, S, E, C.tid());
        } else if (k == 7) {
            if (l == 0) {
                pg8::ProbDown P{WSP(const bf16, WS_ACT), WSP(const bf16, WS_W2), FF, FF, FF}; pg8::DownOrder S; S.init(C.G, C.bx);
                EpiRes E{ARGF(A_OUT), WSP(const float, WS_CTXX), (float*)(GAS float*)ldarg(C, A_OUT), WSP(float, WS_CTXX), WSP(const float, WS_MOD) + (size_t)l * 5 * NMOD + 5 * DM, WSP(float, WS_PART),
                         WSP(const float, WS_GN) + (size_t)2 * 5 * DM, WSP(bf16, WS_HX), WSP(u64, WS_RS) + (size_t)2 * MT};
                pg8::gemm_phase(C.lds, P, S, E, C.tid());
            } else {
                pg8::Prob<false> P{WSP(const bf16, WS_ACT), WSP(const bf16, WS_W2), FF, FF, FF}; pg8::StaticOrder<1> S; S.init(ML, DM, C.G, C.bx);
                EpiResFinal E{(float*)(GAS float*)ldarg(C, A_OUT), WSP(const float, WS_MOD) + (size_t)l * 5 * NMOD + 5 * DM, ARGF(A_FG), WSP(u64, WS_RS5), WSP(unsigned, WS_FCNT), (unsigned*)WSP(unsigned, WS_CTL) + CW_TMO};
                pg8::gemm_phase(C.lds, P, S, E, C.tid());
            }
        } else ph_final(C);
        if (step + 1 < hi || rep + 1 < nrep) { if (MK_MULTI) { if (C.tid() == 0) __hip_atomic_store(ctl + CW_TMO, 0xBADu, RLX_AGENT); } else { XcdBarrier bar; bar.bar = (unsigned*)(ctl + CW_BAR); bar.x = xcc; bar.st = (volatile LAS unsigned*)(lds0 + MISC_OFF) + 8; xcd_barrier(bar, C.tid() == 0);
                if (step == lo && rep == 0) {
                    volatile LAS unsigned* misc = (volatile LAS unsigned*)(lds0 + MISC_OFF);
                    if (C.tid() == 0) { bool ok = gridDim.x == 256;
                        for (unsigned j = 0; j < 16; ++j) { const unsigned cnt = xb_ld(bar.bar + XB_XCNT(j)); ok = ok && (cnt == (j < 8 ? 32u : 0u)); }
                        misc[11] = ok ? 1u : 0u; }
                    __syncthreads();
                    const unsigned okf = __builtin_amdgcn_readfirstlane(misc[11]), rk = __builtin_amdgcn_readfirstlane(misc[10]);
                    if (okf != 0u && rk < 32u && xcc < 8u) vbx = (int)(rk * 8u + xcc); } } }
        }
    }
}

extern "C" void kernel_launch(void* const* d_in, const int* in_sizes, int n_in, void* d_out, int out_size, void* d_ws, size_t ws_size, hipStream_t stream) {
    static int grid = 0;
    if (grid == 0) {
        if (n_in != 18 || out_size != ML * DM || ws_size < WS_END) { fprintf(stderr, "kernel_launch: unexpected shapes (n_in %d out %d ws %zu)\n", n_in, out_size, ws_size); grid = -1; return; }
        int dev = 0, cus = 0;
        if (hipGetDevice(&dev) != hipSuccess || hipDeviceGetAttribute(&cus, hipDeviceAttributeMultiprocessorCount, dev) != hipSuccess) { grid = -1; return; }
        if (hipFuncSetAttribute((const void*)fwd_kernel, hipFuncAttributeMaxDynamicSharedMemorySize, LDS_BYTES) != hipSuccess) { fprintf(stderr, "kernel_launch: hipFuncSetAttribute failed\n"); grid = -1; return; }
        int per_cu = 0;
        if (hipOccupancyMaxActiveBlocksPerMultiprocessor(&per_cu, (const void*)fwd_kernel, NTHR, LDS_BYTES) != hipSuccess || per_cu < 1) fprintf(stderr, "kernel_launch: occupancy query reports %d\n", per_cu);
        (void)hipGetLastError();
        grid = cus;
    }
    if (grid < 0) return;
    (void)hipMemsetAsync((char*)d_ws + WS_CTL, 0, CTL_ZERO_BYTES, stream);
    Args a{};
    for (int i = 0; i < 18; ++i) a.p[i] = d_in[i];
    a.p[A_OUT] = d_out; a.p[A_WS] = d_ws;
#if MK_MULTI
    for (int s = 0; s < NSTEPS; ++s) { a.ph_lo = s; a.ph_hi = s + 1; hipLaunchKernelGGL(fwd_kernel, dim3(grid), dim3(NTHR), LDS_BYTES, stream, a); }
#else
    a.ph_lo = 0; a.ph_hi = NSTEPS; hipLaunchKernelGGL(fwd_kernel, dim3(grid), dim3(NTHR), LDS_BYTES, stream, a);
#endif
}
```

```cpp
#include <hip/hip_runtime.h>
#include <cstdio>
#include <cstdint>

#ifndef PROBE_K
#define PROBE_K -99
#define PROBE_N 1
#define PROBE_SUB 7
#endif
#ifndef MK_MULTI
#define MK_MULTI 0
#endif

namespace pg8 {
#define PG8_LAS __attribute__((address_space(3)))
typedef unsigned short bf16_t;
typedef short bf16x8 __attribute__((ext_vector_type(8)));
typedef float f32x4 __attribute__((ext_vector_type(4)));
typedef unsigned u32x4 __attribute__((ext_vector_type(4)));
constexpr int BM = 256, BK = 64, HALF = 128, HTB = HALF * BK * 2, STAGE_BYTES = 8 * HTB, NXCD = 8, WGM = 8;

__host__ __device__ __forceinline__ int lds_byte(int r, int c) { const int st = (r >> 4) * 2 + (c >> 5), rr = r & 15, cc = c & 31, ob = rr * 64 + cc * 2; return st * 1024 + (ob ^ (((ob >> 9) & 1) << 5)); }
__host__ __device__ __forceinline__ void stage_rc(int b, int& R, int& C) { const int st = b / 1024, sb = b % 1024, swz = sb ^ (((sb >> 9) & 1) << 5); R = (st >> 1) * 16 + swz / 64; C = (st & 1) * 32 + (swz % 64) / 2; }
__host__ __device__ __forceinline__ int perm32(int rho) { const int n = rho >> 4, i = rho & 15; return 8 * (i >> 2) + 4 * n + (i & 3); }

struct Unit { int pm, pn, br; };

template <int NN  > struct StaticOrder {
    int nM, nwg, G, c;
    __device__ void init(int M, int  , int G_, int c_) { nM = M / BM; nwg = nM * NN; G = G_; c = c_; }
    __device__ __forceinline__ bool next(int i, Unit& u) const {
        u.br = 0;
        const long L = (long)i * G + c; if (L >= nwg) return false;
        int wgid = (int)L; { const int q = nwg >> 3, r = nwg & 7, xcd = wgid & 7, off = wgid >> 3; wgid = (xcd < r ? xcd * (q + 1) : r * (q + 1) + (xcd - r) * q) + off; }
        constexpr int nig = WGM * NN; const int gid = wgid / nig, rem = wgid - gid * nig, fm = gid * WGM, gsz = (nM - fm) < WGM ? (nM - fm) : WGM;
        if (gsz == WGM) { u.pm = fm + (rem & (WGM - 1)); u.pn = rem >> 3; } else { u.pm = fm + (rem % gsz); u.pn = rem / gsz; }
        return true;
    }
};

struct DownOrder {
    StaticOrder<4> lat; int G, c;
    __device__ void init(int G_, int c_) { lat.init(32768, 1024, G_, c_); G = G_; c = c_; }
    __device__ __forceinline__ bool next(int i, Unit& u) const {
        const long L = (long)i * G + c;
        if (L < 512) return lat.next(i, u);
        const int j = (int)L - 512; if (j >= 64) return false;
        const int ct = j >> 2; u.pm = 128 + (ct >> 2); u.pn = ct & 3; u.br = j & 3; return true;
    }
};
struct ProbDown {
    const bf16_t* A; const bf16_t* Bt; int lda, ldb, K;
    __device__ __forceinline__ int nt(const Unit& u) const { return u.pm >= 128 ? 16 : 64; }
    __device__ __forceinline__ int koff(const Unit& u) const { return u.pm >= 128 ? u.br * 1024 : 0; }
    __device__ __forceinline__ const char* a(const Unit& u) const { return (const char*)(A + (size_t)u.pm * BM * lda + koff(u)); }
    __device__ __forceinline__ const char* b(const Unit& u) const { return (const char*)(Bt + (size_t)u.pn * BM * ldb + koff(u)); }
};
template <bool MERGE> struct Prob {
    const bf16_t* A; const bf16_t* Bt; int lda, ldb, K;
    __device__ __forceinline__ int nt(const Unit& u) const { if (MERGE) return u.br == 2 ? 8 : 4; return K / BK; }
    __device__ __forceinline__ int koff(const Unit& u) const { if (MERGE) return u.br * 256; return 0; }
    __device__ __forceinline__ const char* a(const Unit& u) const { return (const char*)(A + (size_t)u.pm * BM * lda + koff(u)); }
    __device__ __forceinline__ const char* b(const Unit& u) const { return (const char*)(Bt + (size_t)u.pn * BM * ldb + koff(u)); }
};

__device__ __forceinline__ unsigned cvt_pk_bf16(float lo, float hi) { unsigned r; asm volatile("v_cvt_pk_bf16_f32 %0, %1, %2" : "=v"(r) : "v"(lo), "v"(hi)); return r; }

template <class Epi, class Sched, class PROB>
__device__ __forceinline__ void gemm_phase(PG8_LAS unsigned char* lds, const PROB P, const Sched& S, const Epi& E, const int tid) {
    const int wid = __builtin_amdgcn_readfirstlane(tid >> 6), lane = tid & 63, wr = wid >> 2, wc = wid & 3, fr = lane & 15, fq = lane >> 4;
    unsigned voffA[2], voffB[2];
#pragma unroll
    for (int i = 0; i < 2; ++i) { int R, C; stage_rc(tid * 16 + i * 8192, R, C); const int Rb = Epi::PERM ? ((R & ~31) + perm32(R & 31)) : R;
        voffA[i] = (unsigned)(R * P.lda + C) * 2u; voffB[i] = (unsigned)(Rb * P.ldb + C) * 2u; }
    const size_t kstep = (size_t)(BK * 2);
    const size_t hstepA = (size_t)HALF * P.lda * 2, hstepB = (size_t)HALF * P.ldb * 2;
    const unsigned ldsw = (unsigned)wid * 1024u;
    const int aoff = lds_byte(wr * 64 + fr, fq * 8), boff = lds_byte(wc * 32 + fr, fq * 8);
#define PG8_SA(b, h) (((b) * 2 + (h)) * HTB)
#define PG8_SB(b, h) ((4 + (b) * 2 + (h)) * HTB)
#define PG8_STAGE(bufoff, gbase, voff) do { _Pragma("unroll") for (int _i = 0; _i < 2; ++_i) \
        __builtin_amdgcn_global_load_lds((const unsigned*)((const char*)(gbase) + (voff)[_i]), (PG8_LAS unsigned*)(lds + (bufoff) + ldsw + _i * 8192), 16, 0, 0); } while (0)
#define PG8_LDA(dst, b, h) do { _Pragma("unroll") for (int m = 0; m < 4; ++m) _Pragma("unroll") for (int k = 0; k < 2; ++k) dst[m][k] = *(const PG8_LAS bf16x8*)(lds + PG8_SA(b, h) + aoff + m * 2048 + k * 1024); } while (0)
#define PG8_LDB(dst, b, h) do { _Pragma("unroll") for (int n = 0; n < 2; ++n) _Pragma("unroll") for (int k = 0; k < 2; ++k) dst[n][k] = *(const PG8_LAS bf16x8*)(lds + PG8_SB(b, h) + boff + n * 2048 + k * 1024); } while (0)
#define PG8_MMA(ai, bj, At, Bt) do { __builtin_amdgcn_s_setprio(1); _Pragma("unroll") for (int m = 0; m < 4; ++m) _Pragma("unroll") for (int n = 0; n < 2; ++n) _Pragma("unroll") for (int k = 0; k < 2; ++k) \
        acc[ai][bj][m][n] = __builtin_amdgcn_mfma_f32_16x16x32_bf16(Bt[n][k], At[m][k], acc[ai][bj][m][n], 0, 0, 0); __builtin_amdgcn_s_setprio(0); } while (0)
#define PG8_WAIT_V(n) asm volatile("s_waitcnt vmcnt(" #n ")" ::: "memory")
#define PG8_WAIT_L(n) asm volatile("s_waitcnt lgkmcnt(" #n ")" ::: "memory")
#define PG8_BAR __builtin_amdgcn_s_barrier()
#define PG8_WAIT_SEL1(N) asm volatile("s_waitcnt vmcnt(" #N ")\n\tv_cmp_ne_u32_e32 vcc, 0, %0\n\ts_cbranch_vccnz .Lpg8w%=\n\ts_waitcnt vmcnt(8)\n.Lpg8w%=:" :: "v"(fst) : "memory", "vcc")
#define PG8_WAIT_SEL(NF16, NF32) do { if (Epi::NST == 16) PG8_WAIT_SEL1(NF16); else PG8_WAIT_SEL1(NF32); } while (0)
#define PG8_SCHED __builtin_amdgcn_sched_barrier(0)
    Unit cur, nxt; int ui = 0;
    if (!S.next(0, cur)) return;
    f32x4 acc[2][2][4][2];
#pragma unroll
    for (int a = 0; a < 2; ++a)
#pragma unroll
        for (int b = 0; b < 2; ++b)
#pragma unroll
            for (int m = 0; m < 4; ++m)
#pragma unroll
                for (int n = 0; n < 2; ++n) acc[a][b][m][n] = (f32x4){0.f, 0.f, 0.f, 0.f};
    bf16x8 At[4][2], B0[2][2], B1[2][2];
    const char* cA = P.a(cur); const char* cB = P.b(cur);
    PG8_STAGE(PG8_SB(0, 0), cB, voffB); PG8_STAGE(PG8_SB(0, 1), cB + hstepB, voffB); PG8_STAGE(PG8_SA(0, 0), cA, voffA); PG8_STAGE(PG8_SA(0, 1), cA + hstepA, voffA);
    if (wr == 1) PG8_BAR;
    PG8_WAIT_V(2); PG8_BAR;
    PG8_STAGE(PG8_SB(1, 0), cB + kstep, voffB); PG8_STAGE(PG8_SA(1, 0), cA + kstep, voffA); PG8_STAGE(PG8_SB(1, 1), cB + hstepB + kstep, voffB);
    PG8_WAIT_V(6); PG8_BAR;
    for (;;) {
        const bool has_next = S.next(ui + 1, nxt);
        const char* nA = has_next ? P.a(nxt) : cA; const char* nB = has_next ? P.b(nxt) : cB;
        const int nt = P.nt(cur);
        for (int t = 0; t < nt; t += 2) {
            const bool last = (t == nt - 2); const int fst = (t == 0 && ui > 0) ? 1 : 0;
            if constexpr (Epi::HOOKS) { if (t == 4 || t == 8) E.hook(acc, cur, t, wr, wc, fr, fq); }
            const char* a1 = cA + (size_t)(t + 1) * kstep;
            const char* a2 = last ? nA : cA + (size_t)(t + 2) * kstep; const char* b2 = last ? nB : cB + (size_t)(t + 2) * kstep;
            const char* a3 = a2 + kstep; const char* b3 = b2 + kstep;
            PG8_LDB(B0, 0, 0); PG8_LDB(B1, 0, 1); PG8_SCHED; PG8_LDA(At, 0, 0); PG8_STAGE(PG8_SA(1, 1), a1 + hstepA, voffA);
            PG8_WAIT_SEL(18, 34); PG8_WAIT_L(0); PG8_BAR; PG8_MMA(0, 0, At, B0); PG8_MMA(0, 1, At, B1); PG8_BAR; PG8_SCHED;
            PG8_LDA(At, 0, 1); PG8_STAGE(PG8_SB(0, 0), b2, voffB); PG8_STAGE(PG8_SB(0, 1), b2 + hstepB, voffB); PG8_STAGE(PG8_SA(0, 0), a2, voffA);
            PG8_WAIT_SEL(24, 40); PG8_WAIT_L(0); PG8_BAR; PG8_MMA(1, 0, At, B0); PG8_MMA(1, 1, At, B1); PG8_BAR; PG8_SCHED;
            PG8_LDB(B0, 1, 0); PG8_LDB(B1, 1, 1); PG8_SCHED; PG8_LDA(At, 1, 0); PG8_STAGE(PG8_SA(0, 1), a2 + hstepA, voffA);
            PG8_WAIT_SEL(26, 42); PG8_WAIT_L(0); PG8_BAR; PG8_MMA(0, 0, At, B0); PG8_MMA(0, 1, At, B1); PG8_BAR; PG8_SCHED;
            PG8_LDA(At, 1, 1); PG8_STAGE(PG8_SB(1, 0), b3, voffB); PG8_STAGE(PG8_SB(1, 1), b3 + hstepB, voffB); PG8_STAGE(PG8_SA(1, 0), a3, voffA);
            PG8_WAIT_V(8); PG8_WAIT_L(0); PG8_BAR; PG8_MMA(1, 0, At, B0); PG8_MMA(1, 1, At, B1); PG8_BAR; PG8_SCHED;
        }
        if (wr == 0) PG8_BAR;
        E(acc, cur, wr, wc, fr, fq);
        if (!has_next) break;
#pragma unroll
        for (int a = 0; a < 2; ++a)
#pragma unroll
            for (int b = 0; b < 2; ++b)
#pragma unroll
                for (int m = 0; m < 4; ++m)
#pragma unroll
                    for (int n = 0; n < 2; ++n) acc[a][b][m][n] = (f32x4){0.f, 0.f, 0.f, 0.f};
        cur = nxt; cA = nA; cB = nB; ++ui;
        if (wr == 1) PG8_BAR;
    }
    PG8_WAIT_V(0);
    PG8_BAR;
#undef PG8_SA
#undef PG8_SB
#undef PG8_STAGE
#undef PG8_LDA
#undef PG8_LDB
#undef PG8_MMA
#undef PG8_WAIT_V
#undef PG8_WAIT_L
#undef PG8_BAR
#undef PG8_WAIT_SEL
#undef PG8_WAIT_SEL1
#undef PG8_SCHED
}
}

constexpr int NWAVES = 8, NTHR = 512;
constexpr int DM = 1024, NB = 4, SEQ = 8192, ML = NB * SEQ, CTXL = 256, MC = NB * CTXL, MT = ML + MC;
constexpr int NIN_ORIG = 5632, NPXA = 2816, NPXG = 3072, NIN = NPXA + NPXG;
constexpr int OFF_P = 0, OFF_Q = 256, OFF_CU = 512, OFF_CB = 768, OFF_CC = 1024, OFF_QQ = 1280, OFF_K = 1792, OFF_V = 2304;
constexpr int FF = 4096, NMOD = 6 * DM, NGRP = 5;
constexpr float EPS = 1e-6f;

constexpr size_t MiB = 1u << 20;
constexpr size_t WS_CTL = 0, CTL_ZERO_BYTES = 2 * MiB;
constexpr size_t WS_RS = 262144;
constexpr size_t WS_FCNT = 1441792;
constexpr size_t WS_ZERO = 1572864;
constexpr size_t WS_RS5 = 1703936;
constexpr size_t WS_TW = 2 * MiB;
constexpr size_t WS_MOD = 2 * MiB + 65536;
constexpr size_t WS_GN = 2 * MiB + 524288;
constexpr size_t WS_CIN = 2 * MiB + 786432;
constexpr size_t WS_CUP = 3 * MiB;
constexpr size_t WS_MODP = 510 * MiB;
constexpr size_t WS_CTXX = 4 * MiB;
constexpr size_t WS_WIN = 8 * MiB, WS_WM = 20 * MiB, WS_WO = 22 * MiB, WS_W1 = 24 * MiB, WS_W2 = 32 * MiB;
constexpr size_t WS_HX = 40 * MiB;
constexpr size_t WS_PXA = 106 * MiB;
constexpr size_t WS_PXG = 288 * MiB;
constexpr size_t WS_TB = 486 * MiB;
constexpr size_t WS_M = WS_PXA;
constexpr size_t WS_ACT = WS_PXA;
constexpr size_t WS_PART = 400 * MiB;
constexpr size_t WS_END = 512 * MiB;
static_assert(WS_PXA + (size_t)MT * NPXA * 2 <= WS_PXG && WS_PXG + (size_t)MT * NPXG * 2 <= WS_TB && WS_ACT + (size_t)MT * FF * 2 <= WS_TB && WS_HX + (size_t)MT * DM * 2 <= WS_PXA, "ws map");
constexpr int CW_TMO = 0, CW_BAR = 4096;

constexpr int RING_BYTES = 131072, LDSCTL_OFF = 155648, MISC_OFF = LDSCTL_OFF + 320, LDS_BYTES = 163840;

#define GAS __attribute__((address_space(1)))
#define LAS __attribute__((address_space(3)))
typedef unsigned short bf16;
typedef unsigned v4u __attribute__((ext_vector_type(4)));
typedef unsigned v2u __attribute__((ext_vector_type(2)));
typedef float f32x4 __attribute__((ext_vector_type(4)));
typedef GAS unsigned gu32;
#define RLX_AGENT __ATOMIC_RELAXED, __HIP_MEMORY_SCOPE_AGENT
#define LDS_WAIT() asm volatile("s_waitcnt lgkmcnt(0)" ::: "memory")
__device__ __forceinline__ unsigned f2bf(float f) { unsigned u = __builtin_bit_cast(unsigned, f); return (u + 0x7fffu + ((u >> 16) & 1u)) >> 16; }
__device__ __forceinline__ unsigned pk2(float lo, float hi) { return f2bf(lo) | (f2bf(hi) << 16); }
__device__ __forceinline__ float bf2f(unsigned h) { return __uint_as_float(h << 16); }
__device__ __forceinline__ float bflo(unsigned w) { return __uint_as_float(w << 16); }
__device__ __forceinline__ float bfhi(unsigned w) { return __uint_as_float(w & 0xffff0000u); }

#define XB_TMO      128
#define XB_XCNT(j)  (256  + 64 * (j))
#define XB_XSUB(j)  (1280 + 64 * (j))
#define XB_XGEN(j)  (2304 + 64 * (j))
#define XB_TOP      3328
#define XB_TOPGEN   3392
#define XCD_BAR_WORDS 3456
#define XB_SPIN_CAP (1u << 22)
__device__ __forceinline__ unsigned xb_ld(unsigned* p)              { return __hip_atomic_load(p, __ATOMIC_RELAXED, __HIP_MEMORY_SCOPE_AGENT); }
__device__ __forceinline__ unsigned xb_add(unsigned* p, unsigned v) { return __hip_atomic_fetch_add(p, v, __ATOMIC_RELAXED, __HIP_MEMORY_SCOPE_AGENT); }
__device__ __forceinline__ unsigned xb_xcc_id() { return (unsigned)__builtin_amdgcn_s_getreg((3 << 11) | 20) & 0xFu; }
#define XB_SPIN(cond, bar) do { unsigned _sp = 0; while (cond) { __builtin_amdgcn_s_sleep(1); \
    if ((++_sp & 255u) == 0u) { if (xb_ld(&(bar)[XB_TMO])) break; if (_sp > XB_SPIN_CAP) { atomicAdd(&(bar)[XB_TMO], 1u); break; } } } } while (0)
struct XcdBarrier { unsigned* bar; unsigned x; volatile LAS unsigned* st; };
__device__ __forceinline__ XcdBarrier xcd_barrier_post(unsigned* bar, volatile LAS unsigned* st, bool leader) {
    XcdBarrier b; b.bar = bar; b.x = xb_xcc_id(); b.st = st;
    if (leader) { const unsigned rank = xb_add(&bar[XB_XCNT(b.x)], 1u); st[2] = rank; }
    return b;
}
__device__ __forceinline__ void xcd_barrier_complete(unsigned* bar, unsigned x, unsigned& nloc, unsigned& nx) {
    const unsigned G = gridDim.x * gridDim.y * gridDim.z;
    unsigned sum, cnt, mine, sp = 0u;
    for (;;) {
        sum = 0u; cnt = 0u; mine = 0u;
#pragma unroll
        for (unsigned j = 0; j < 16; ++j) { const unsigned c = xb_ld(&bar[XB_XCNT(j)]); sum += c; cnt += (c > 0u) ? 1u : 0u; mine = (j == x) ? c : mine; }
        if (sum == G) break;
        __builtin_amdgcn_s_sleep(1);
        if ((++sp & 255u) == 0u) { if (xb_ld(&bar[XB_TMO])) break; if (sp > XB_SPIN_CAP) { atomicAdd(&bar[XB_TMO], 1u); break; } }
    }
    nloc = mine > 0u ? mine : 1u; nx = cnt > 0u ? cnt : 1u;
}
__device__ __forceinline__ void xcd_barrier(const XcdBarrier& b, bool leader) {
    asm volatile("s_waitcnt vmcnt(0)" ::: "memory");
    __syncthreads();
    if (leader) {
        unsigned* bar = b.bar;
        __builtin_amdgcn_s_waitcnt(0);
        unsigned nloc = b.st[0], nx = b.st[1];
        if (nloc == 0u) { xcd_barrier_complete(bar, b.x, nloc, nx); b.st[0] = nloc; b.st[1] = nx; }
        const unsigned old = xb_add(&bar[XB_XSUB(b.x)], 1u);
        const unsigned gen = old / nloc;
        if (old + 1u == (gen + 1u) * nloc) {
            __builtin_amdgcn_fence(__ATOMIC_RELEASE, "agent");
            asm volatile("s_waitcnt vmcnt(0)" ::: "memory");
            const unsigned og = xb_add(&bar[XB_TOP], 1u);
            const unsigned tg = og / nx;
            if (og + 1u == (tg + 1u) * nx) xb_add(&bar[XB_TOPGEN], 1u);
            else XB_SPIN(xb_ld(&bar[XB_TOPGEN]) == tg, bar);
            __builtin_amdgcn_fence(__ATOMIC_ACQUIRE, "agent");
            xb_add(&bar[XB_XGEN(b.x)], 1u);
            asm volatile("s_waitcnt vmcnt(0)" ::: "memory");
        } else {
            XB_SPIN(xb_ld(&bar[XB_XGEN(b.x)]) == gen, bar);
            __builtin_amdgcn_fence(__ATOMIC_ACQUIRE, "agent");
            asm volatile("s_waitcnt vmcnt(0)" ::: "memory");
        }
    }
    __syncthreads();
}

__device__ __forceinline__ float wave_sum(float v) {
#pragma unroll
    for (int o = 1; o < 64; o <<= 1) v += __shfl_xor(v, o);
    return v;
}
__device__ __forceinline__ float wave_max(float v) {
#pragma unroll
    for (int o = 1; o < 64; o <<= 1) v = fmaxf(v, __shfl_xor(v, o));
    return v;
}

__device__ __forceinline__ void transpose_item(const float* W, int ldw, int ncols, bf16* WT, int ldwt, int row_off, int k_off, LAS float* scr, int item, int lane) {
    const int nblk = ncols / 32, kb = item / nblk, nb = item % nblk, k0 = 64 * kb, n0 = 32 * nb;
#pragma unroll 8
    for (int i = 0; i < 32; ++i) { const int kk = 2 * i + (lane >> 5); scr[kk * 33 + (lane & 31)] = W[(size_t)(k0 + kk) * ldw + n0 + (lane & 31)]; }
    LDS_WAIT(); asm volatile("" ::: "memory");
    const int c = lane & 7;
#pragma unroll
    for (int j = 0; j < 4; ++j) { const int n = (lane >> 3) + 8 * j; const LAS float* s = scr + (8 * c) * 33 + n;
        v4u o; o.x = pk2(s[0 * 33], s[1 * 33]); o.y = pk2(s[2 * 33], s[3 * 33]); o.z = pk2(s[4 * 33], s[5 * 33]); o.w = pk2(s[6 * 33], s[7 * 33]);
        *(v4u*)(WT + (size_t)(row_off + n0 + n) * ldwt + k_off + k0 + 8 * c) = o; }
    LDS_WAIT(); asm volatile("" ::: "memory");
}

using pg8::Unit; using pg8::cvt_pk_bf16;
typedef unsigned long long u64;
__device__ __forceinline__ float rs_to_rstd(u64 q) { return __builtin_amdgcn_rsqf((float)q * (1.0f / (16777216.0f * DM)) + EPS); }
struct EpiIn {
    static constexpr bool PERM = true, HOOKS = false; static constexpr int NST = 16;
    bf16* pxa; bf16* pxg; const u64* rs; const float* cin;
    __device__ __forceinline__ void operator()(const f32x4 (&acc)[2][2][4][2], const Unit& u, int wr, int wc, int fr, int fq) const {
        asm volatile("" : "+v"(fr), "+v"(fq));
        const bool gate = u.pn >= 11; bf16* base = gate ? pxg : pxa; const int ldc = gate ? NPXG : NPXA; const int colt = (gate ? u.pn - 11 : u.pn) * 256;
        const int grp = u.pm >= 128 ? 4 : (u.pm >> 5);
        const int row0 = u.pm * 256 + wr * 64 + fr, col0 = colt + wc * 32 + 8 * fq;
        const float* cp = cin + grp * NIN + u.pn * 256 + wc * 32 + 8 * fq;
        const float gsc = gate ? -1.4426950408889634f : 1.0f;
        f32x4 cv[2][2];
#pragma unroll
        for (int bj = 0; bj < 2; ++bj) { cv[bj][0] = *(const f32x4*)(cp + bj * 128) * gsc; cv[bj][1] = *(const f32x4*)(cp + bj * 128 + 4) * gsc; }
        u64 rq[2][4]; float rsv[2][4];
#pragma unroll
        for (int ai = 0; ai < 2; ++ai)
#pragma unroll
            for (int m = 0; m < 4; ++m) rq[ai][m] = rs[row0 + ai * 128 + m * 16];
        asm volatile("" ::: "memory");
#pragma unroll
        for (int ai = 0; ai < 2; ++ai)
#pragma unroll
            for (int m = 0; m < 4; ++m) rsv[ai][m] = rs_to_rstd(rq[ai][m]) * gsc;
#pragma unroll
        for (int ai = 0; ai < 2; ++ai)
#pragma unroll
            for (int m = 0; m < 4; ++m) { const int row = row0 + ai * 128 + m * 16; bf16* rowp = base + (size_t)row * ldc + col0; const float rstd = rsv[ai][m];
#pragma unroll
                for (int bj = 0; bj < 2; ++bj) { f32x4 v0 = acc[ai][bj][m][0] * rstd + cv[bj][0], v1 = acc[ai][bj][m][1] * rstd + cv[bj][1];
                    if (gate) {
#pragma unroll
                        for (int e = 0; e < 4; ++e) { v0[e] = 1.0f + __builtin_amdgcn_exp2f(fminf(v0[e], 120.0f)); v1[e] = 1.0f + __builtin_amdgcn_exp2f(fminf(v1[e], 120.0f)); } }
                    v4u w; w.x = cvt_pk_bf16(v0[0], v0[1]); w.y = cvt_pk_bf16(v0[2], v0[3]); w.z = cvt_pk_bf16(v1[0], v1[1]); w.w = cvt_pk_bf16(v1[2], v1[3]);
                    *(v4u*)(rowp + bj * 128) = w; } }
    }
};
struct EpiMerge {
    static constexpr bool PERM = true, HOOKS = true; static constexpr int NST = 16;
    bf16* m; const bf16* pxg;
    __device__ __forceinline__ void hook(f32x4 (&acc)[2][2][4][2], const Unit& u, int t, int wr, int wc, int fr, int fq) const {
        asm volatile("" : "+v"(fr), "+v"(fq));
        const int row0 = u.pm * 256 + wr * 64 + fr, col0 = u.pn * 256 + wc * 32 + 8 * fq;
        const bf16* gnum = pxg + (t == 4 ? 0 : 1024) + col0; const bf16* gden = gnum + 1024;
#pragma unroll
        for (int ai = 0; ai < 2; ++ai)
#pragma unroll
            for (int mp = 0; mp < 2; ++mp) {
                v4u gn[2][2], gd[2][2];
#pragma unroll
                for (int mq = 0; mq < 2; ++mq)
#pragma unroll
                    for (int bj = 0; bj < 2; ++bj) { const size_t ro = (size_t)(row0 + ai * 128 + (2 * mp + mq) * 16) * NPXG + bj * 128; gn[mq][bj] = *(const v4u*)(gnum + ro); gd[mq][bj] = *(const v4u*)(gden + ro); }
                asm volatile("" ::: "memory");
#pragma unroll
                for (int mq = 0; mq < 2; ++mq)
#pragma unroll
                    for (int bj = 0; bj < 2; ++bj) { const v4u a = gn[mq][bj], d = gd[mq][bj];
                        f32x4& v0 = acc[ai][bj][2 * mp + mq][0]; f32x4& v1 = acc[ai][bj][2 * mp + mq][1];
                        v0[0] *= bflo(d.x) * __builtin_amdgcn_rcpf(bflo(a.x)); v0[1] *= bfhi(d.x) * __builtin_amdgcn_rcpf(bfhi(a.x));
                        v0[2] *= bflo(d.y) * __builtin_amdgcn_rcpf(bflo(a.y)); v0[3] *= bfhi(d.y) * __builtin_amdgcn_rcpf(bfhi(a.y));
                        v1[0] *= bflo(d.z) * __builtin_amdgcn_rcpf(bflo(a.z)); v1[1] *= bfhi(d.z) * __builtin_amdgcn_rcpf(bfhi(a.z));
                        v1[2] *= bflo(d.w) * __builtin_amdgcn_rcpf(bflo(a.w)); v1[3] *= bfhi(d.w) * __builtin_amdgcn_rcpf(bfhi(a.w)); }
            }
    }
    __device__ __forceinline__ void operator()(const f32x4 (&acc)[2][2][4][2], const Unit& u, int wr, int wc, int fr, int fq) const {
        asm volatile("" : "+v"(fr), "+v"(fq));
        const int row0 = u.pm * 256 + wr * 64 + fr, col0 = u.pn * 256 + wc * 32 + 8 * fq;
#pragma unroll
        for (int ai = 0; ai < 2; ++ai) {
            v4u g[4][2];
#pragma unroll
            for (int mm = 0; mm < 4; ++mm)
#pragma unroll
                for (int bj = 0; bj < 2; ++bj) g[mm][bj] = *(const v4u*)(pxg + (size_t)(row0 + ai * 128 + mm * 16) * NPXG + 2048 + col0 + bj * 128);
            asm volatile("" ::: "memory");
#pragma unroll
            for (int mm = 0; mm < 4; ++mm)
#pragma unroll
                for (int bj = 0; bj < 2; ++bj) { const f32x4 v0 = acc[ai][bj][mm][0], v1 = acc[ai][bj][mm][1]; const v4u gg = g[mm][bj];
#define RC(x) __builtin_amdgcn_rcpf(x)
                    v4u w; w.x = cvt_pk_bf16(v0[0] * RC(bflo(gg.x)), v0[1] * RC(bfhi(gg.x))); w.y = cvt_pk_bf16(v0[2] * RC(bflo(gg.y)), v0[3] * RC(bfhi(gg.y)));
                    w.z = cvt_pk_bf16(v1[0] * RC(bflo(gg.z)), v1[1] * RC(bfhi(gg.z))); w.w = cvt_pk_bf16(v1[2] * RC(bflo(gg.w)), v1[3] * RC(bfhi(gg.w)));
#undef RC
                    *(v4u*)(m + (size_t)(row0 + ai * 128 + mm * 16) * DM + col0 + bj * 128) = w; }
        }
    }
};
struct EpiRes {
    static constexpr bool PERM = true, HOOKS = false; static constexpr int NST = 32;
    const float* base_l; const float* base_c; float* out_l; float* out_c; const float* gate;
    float* part;
    const float* gn; bf16* ap; u64* rs;
    __device__ __forceinline__ void operator()(const f32x4 (&acc)[2][2][4][2], const Unit& u, int wr, int wc, int fr, int fq) const {
        asm volatile("" : "+v"(fr), "+v"(fq));
        const bool isc = u.pm >= 128; const int grp = isc ? 4 : (u.pm >> 5);
        const float* base = isc ? base_c : base_l; float* out = isc ? out_c : out_l;
        const int row0 = (isc ? (u.pm - 128) : u.pm) * 256 + wr * 64 + fr, col0 = u.pn * 256 + wc * 32 + 8 * fq;
        if (part != nullptr && isc) {
            float* po = part + (size_t)u.br * 1024 * 1024;
#pragma unroll
            for (int ai = 0; ai < 2; ++ai)
#pragma unroll
                for (int m = 0; m < 4; ++m)
#pragma unroll
                    for (int bj = 0; bj < 2; ++bj)
#pragma unroll
                        for (int n = 0; n < 2; ++n) *(f32x4*)(po + (size_t)(row0 + ai * 128 + m * 16) * DM + col0 + bj * 128 + n * 4) = acc[ai][bj][m][n];
            return;
        }
        f32x4 gv[2][2], gnv[2][2];
#pragma unroll
        for (int bj = 0; bj < 2; ++bj)
#pragma unroll
            for (int n = 0; n < 2; ++n) { gv[bj][n] = *(const f32x4*)(gate + grp * NMOD + col0 + bj * 128 + n * 4);
                gnv[bj][n] = gn ? *(const f32x4*)(gn + grp * DM + col0 + bj * 128 + n * 4) : (f32x4){0.f, 0.f, 0.f, 0.f}; }
        const int arow0 = u.pm * 256 + wr * 64 + fr;
#pragma unroll
        for (int ai = 0; ai < 2; ++ai)
#pragma unroll
            for (int mp = 0; mp < 2; ++mp) {
                f32x4 bs[2][2][2];
#pragma unroll
                for (int mq = 0; mq < 2; ++mq)
#pragma unroll
                    for (int bj = 0; bj < 2; ++bj)
#pragma unroll
                        for (int n = 0; n < 2; ++n) bs[mq][bj][n] = *(const f32x4*)(base + (size_t)(row0 + ai * 128 + (2 * mp + mq) * 16) * DM + col0 + bj * 128 + n * 4);
                asm volatile("" ::: "memory");
#pragma unroll
                for (int mq = 0; mq < 2; ++mq) { const int m = 2 * mp + mq; float ss = 0.f;
#pragma unroll
                    for (int bj = 0; bj < 2; ++bj) {
                        const f32x4 o0 = bs[mq][bj][0] + gv[bj][0] * acc[ai][bj][m][0], o1 = bs[mq][bj][1] + gv[bj][1] * acc[ai][bj][m][1];
                        float* op = out + (size_t)(row0 + ai * 128 + m * 16) * DM + col0 + bj * 128;
                        *(f32x4*)op = o0; *(f32x4*)(op + 4) = o1;
                        if (gn) { const f32x4 y0 = o0 * gnv[bj][0], y1 = o1 * gnv[bj][1];
                            v4u w; w.x = cvt_pk_bf16(y0[0], y0[1]); w.y = cvt_pk_bf16(y0[2], y0[3]); w.z = cvt_pk_bf16(y1[0], y1[1]); w.w = cvt_pk_bf16(y1[2], y1[3]);
                            *(v4u*)(ap + (size_t)(arow0 + ai * 128 + m * 16) * DM + col0 + bj * 128) = w;
                            ss += ((o0[0] * o0[0] + o0[1] * o0[1]) + (o0[2] * o0[2] + o0[3] * o0[3])) + ((o1[0] * o1[0] + o1[1] * o1[1]) + (o1[2] * o1[2] + o1[3] * o1[3])); } }
                    if (gn) { ss += __shfl_xor(ss, 16); ss += __shfl_xor(ss, 32);
                        if (fq == 0) __hip_atomic_fetch_add(rs + arow0 + ai * 128 + m * 16, (u64)(ss * 16777216.0f + 0.5f), __ATOMIC_RELAXED, __HIP_MEMORY_SCOPE_AGENT); } }
            }
    }
};
struct EpiResFinal {
    static constexpr bool PERM = true, HOOKS = false; static constexpr int NST = 32;
    float* xo; const float* gate; const float* fg; u64* rs; unsigned* cnt; unsigned* tmo;
    __device__ __forceinline__ void operator()(f32x4 (&acc)[2][2][4][2], const Unit& u, int wr, int wc, int fr, int fq) const {
        asm volatile("" : "+v"(fr), "+v"(fq));
        const int grp = u.pm >> 5, row0 = u.pm * 256 + wr * 64 + fr, col0 = u.pn * 256 + wc * 32 + 8 * fq;
        f32x4 gv[2][2];
#pragma unroll
        for (int bj = 0; bj < 2; ++bj)
#pragma unroll
            for (int n = 0; n < 2; ++n) gv[bj][n] = *(const f32x4*)(gate + grp * NMOD + col0 + bj * 128 + n * 4);
#pragma unroll
        for (int ai = 0; ai < 2; ++ai)
#pragma unroll
            for (int mp = 0; mp < 2; ++mp) {
                f32x4 bs[2][2][2];
#pragma unroll
                for (int mq = 0; mq < 2; ++mq)
#pragma unroll
                    for (int bj = 0; bj < 2; ++bj)
#pragma unroll
                        for (int n = 0; n < 2; ++n) bs[mq][bj][n] = *(const f32x4*)(xo + (size_t)(row0 + ai * 128 + (2 * mp + mq) * 16) * DM + col0 + bj * 128 + n * 4);
                asm volatile("" ::: "memory");
#pragma unroll
                for (int mq = 0; mq < 2; ++mq) { const int m = 2 * mp + mq; float ss = 0.f;
#pragma unroll
                    for (int bj = 0; bj < 2; ++bj)
#pragma unroll
                        for (int n = 0; n < 2; ++n) { const f32x4 o = bs[mq][bj][n] + gv[bj][n] * acc[ai][bj][m][n]; acc[ai][bj][m][n] = o; ss += (o[0] * o[0] + o[1] * o[1]) + (o[2] * o[2] + o[3] * o[3]); }
                    ss += __shfl_xor(ss, 16); ss += __shfl_xor(ss, 32);
                    if (fq == 0) __hip_atomic_fetch_add(rs + row0 + ai * 128 + m * 16, (u64)(ss * 16777216.0f + 0.5f), __ATOMIC_RELAXED, __HIP_MEMORY_SCOPE_AGENT); }
            }
        asm volatile("s_waitcnt vmcnt(0)" ::: "memory");
        unsigned* pc = cnt + 64 * u.pm;
        if (__builtin_amdgcn_mbcnt_hi(~0u, __builtin_amdgcn_mbcnt_lo(~0u, 0u)) == 0) __hip_atomic_fetch_add(pc, 1u, __ATOMIC_RELAXED, __HIP_MEMORY_SCOPE_AGENT);
        { unsigned spins = 0;
          while ((unsigned)__builtin_amdgcn_readfirstlane(__hip_atomic_load(pc, __ATOMIC_RELAXED, __HIP_MEMORY_SCOPE_AGENT)) < 32u) {
              __builtin_amdgcn_s_sleep(2);
              if (++spins > (1u << 22)) { __hip_atomic_store(tmo, 1u, __ATOMIC_RELAXED, __HIP_MEMORY_SCOPE_AGENT); break; } } }
        f32x4 fgv[2][2];
#pragma unroll
        for (int bj = 0; bj < 2; ++bj)
#pragma unroll
            for (int n = 0; n < 2; ++n) fgv[bj][n] = *(const f32x4*)(fg + col0 + bj * 128 + n * 4);
#pragma unroll
        for (int ai = 0; ai < 2; ++ai)
#pragma unroll
            for (int m = 0; m < 4; ++m) { const int row = row0 + ai * 128 + m * 16;
                const float rstd = rs_to_rstd(__hip_atomic_load(rs + row, __ATOMIC_RELAXED, __HIP_MEMORY_SCOPE_AGENT));
#pragma unroll
                for (int bj = 0; bj < 2; ++bj)
#pragma unroll
                    for (int n = 0; n < 2; ++n) *(f32x4*)(xo + (size_t)row * DM + col0 + bj * 128 + n * 4) = acc[ai][bj][m][n] * rstd * fgv[bj][n]; }
    }
};
struct EpiAct {
    static constexpr bool PERM = true, HOOKS = false; static constexpr int NST = 16;
    bf16* a; const u64* rs; const float* cup;
    __device__ __forceinline__ void operator()(const f32x4 (&acc)[2][2][4][2], const Unit& u, int wr, int wc, int fr, int fq) const {
        asm volatile("" : "+v"(fr), "+v"(fq));
        const int grp = u.pm >= 128 ? 4 : (u.pm >> 5);
        const int row0 = u.pm * 256 + wr * 64 + fr, col0 = u.pn * 256 + wc * 32 + 8 * fq;
        const float* cp = cup + grp * FF + col0;
        f32x4 cv[2][2];
#pragma unroll
        for (int bj = 0; bj < 2; ++bj) { cv[bj][0] = *(const f32x4*)(cp + bj * 128); cv[bj][1] = *(const f32x4*)(cp + bj * 128 + 4); }
        u64 rq[2][4]; float rsv[2][4];
#pragma unroll
        for (int ai = 0; ai < 2; ++ai)
#pragma unroll
            for (int m = 0; m < 4; ++m) rq[ai][m] = rs[row0 + ai * 128 + m * 16];
        asm volatile("" ::: "memory");
#pragma unroll
        for (int ai = 0; ai < 2; ++ai)
#pragma unroll
            for (int m = 0; m < 4; ++m) rsv[ai][m] = rs_to_rstd(rq[ai][m]);
#pragma unroll
        for (int ai = 0; ai < 2; ++ai)
#pragma unroll
            for (int m = 0; m < 4; ++m) { const int row = row0 + ai * 128 + m * 16; bf16* rowp = a + (size_t)row * FF + col0; const float rstd = rsv[ai][m];
#pragma unroll
                for (int bj = 0; bj < 2; ++bj) { f32x4 v0 = acc[ai][bj][m][0] * rstd + cv[bj][0], v1 = acc[ai][bj][m][1] * rstd + cv[bj][1];
#pragma unroll
                    for (int e = 0; e < 4; ++e) { const float r0 = fmaxf(v0[e], 0.f), r1 = fmaxf(v1[e], 0.f); v0[e] = r0 * r0; v1[e] = r1 * r1; }
                    v4u w; w.x = cvt_pk_bf16(v0[0], v0[1]); w.y = cvt_pk_bf16(v0[2], v0[3]); w.z = cvt_pk_bf16(v1[0], v1[1]); w.w = cvt_pk_bf16(v1[2], v1[3]);
                    *(v4u*)(rowp + bj * 128) = w; } }
    }
};

constexpr int NS = 8;
constexpr int NSTEPS = 2 + 2 * NS;
constexpr int LARGS_OFF = LDSCTL_OFF + 1024;
enum { A_X = 0, A_C, A_CTX, A_CCTX, A_ADAW, A_ADAB, A_N1G, A_N2G, A_WIN, A_CONVW, A_RELB, A_WF, A_WC, A_WA, A_WO, A_W1, A_W2, A_FG, A_OUT, A_WS, A_NARGS };

struct Ctx { LAS unsigned char* lds; int wave, G, bx, gw, NGW, NGT;
    __device__ __forceinline__ int lane() const { int l; asm volatile("v_mbcnt_lo_u32_b32 %0, -1, 0\n\tv_mbcnt_hi_u32_b32 %0, -1, %0" : "=v"(l)); return l; }
    __device__ __forceinline__ int tid() const { return wave * 64 + lane(); }
    __device__ __forceinline__ int gt() const { return bx * NTHR + tid(); }
};
template <int I> __device__ __forceinline__ unsigned long long ldarg_t() {
    unsigned long long v; unsigned tmp;
    asm volatile("v_mov_b32 %1, %2\n\tds_read_b64 %0, %1 offset:%3\n\ts_waitcnt lgkmcnt(0)" : "=&v"(v), "=&v"(tmp) : "i"(LARGS_OFF), "i"(I * 8) : "memory");
    const unsigned lo = __builtin_amdgcn_readfirstlane((unsigned)v), hi = __builtin_amdgcn_readfirstlane((unsigned)(v >> 32));
    return ((unsigned long long)hi << 32) | lo;
}
#define ldarg(C, i) ldarg_t<(i)>()
#define ARGF(i) ((const float*)(const GAS float*)ldarg(C, (i)))
#define WSP(T, off) ((T*)(GAS T*)((GAS unsigned char*)ldarg(C, A_WS) + (off)))

__device__ __forceinline__ void ph_mod_partial(const Ctx& C) {
    const float* cvec = ARGF(A_C); const float* cctx = ARGF(A_CCTX); const float* ada_w = ARGF(A_ADAW);
    float* modp = WSP(float, WS_MODP); float2* tw = WSP(float2, WS_TW);
    LAS float* sl = (LAS float*)C.lds;
    for (int item = C.bx; item < 2 * 8 * 12; item += C.G) {
        const int l = item / 96, rem = item % 96, kc = rem / 12, jb = rem % 12;
        __syncthreads();
        for (int e = C.tid(); e < 5 * 128; e += NTHR) { const int g = e >> 7, k = kc * 128 + (e & 127); const float v = g < 4 ? cvec[g * DM + k] : cctx[k]; sl[e] = v / (1.0f + __expf(-v)); }
        __syncthreads();
        const int j = jb * 512 + C.tid(); float a0 = 0.f, a1 = 0.f, a2 = 0.f, a3 = 0.f, a4 = 0.f;
        const float* wp = ada_w + ((size_t)l * DM + kc * 128) * NMOD + j;
#pragma unroll 4
        for (int k = 0; k < 128; ++k) { const float w = wp[(size_t)k * NMOD]; a0 += sl[k] * w; a1 += sl[128 + k] * w; a2 += sl[256 + k] * w; a3 += sl[384 + k] * w; a4 += sl[512 + k] * w; }
        float* pp = modp + ((size_t)(l * 8 + kc) * 5) * NMOD + j;
        pp[0] = a0; pp[NMOD] = a1; pp[2 * NMOD] = a2; pp[3 * NMOD] = a3; pp[4 * NMOD] = a4;
    }
    for (int m = C.gt(); m < 8192; m += C.NGT) { float s, c; sincospif((float)m * (1.0f / 4096.0f), &s, &c); tw[m] = make_float2(c, s); }
}
__device__ __forceinline__ void ph_mod_reduce(const Ctx& C) {
    const float* ada_b = ARGF(A_ADAB); const float* modp = WSP(float, WS_MODP); float* mod = WSP(float, WS_MOD);
    for (int e = C.gt(); e < 2 * 5 * NMOD; e += C.NGT) { const int l = e / (5 * NMOD), r = e % (5 * NMOD), j = r % NMOD; float s = ada_b[l * NMOD + j];
#pragma unroll
        for (int kc = 0; kc < 8; ++kc) s += modp[(size_t)(l * 8 + kc) * 5 * NMOD + r];
        mod[e] = s; }
    float* gnt = WSP(float, WS_GN); const float* n1g = ARGF(A_N1G); const float* n2g = ARGF(A_N2G);
    for (int e = C.gt(); e < 2 * 2 * 5 * DM; e += C.NGT) { const int col = e & 1023, grp = (e >> 10) % 5, w = (e / (5 * DM)) & 1, l = e / (10 * DM), j = (w ? 4 : 1) * DM + col;
        float s = ada_b[l * NMOD + j];
#pragma unroll
        for (int kc = 0; kc < 8; ++kc) s += modp[((size_t)(l * 8 + kc) * 5 + grp) * NMOD + j];
        gnt[e] = (w ? n2g : n1g)[l * DM + col] * (1.0f + s); }
}
__device__ __forceinline__ void ph_ctab(const Ctx& C, int l) {
    LAS float* red = (LAS float*)(C.lds + 131072); LAS float* cu = red + 8 * 5 * 64;
    const float* modl = WSP(const float, WS_MOD) + (size_t)l * 5 * NMOD; const float2* tw = WSP(const float2, WS_TW);
    float* cin = WSP(float, WS_CIN) + (size_t)l * 5 * NIN; float* cup = WSP(float, WS_CUP) + (size_t)l * 5 * FF;
    const int lane = C.lane(), w = C.wave, tid = C.tid();
    for (int it = C.bx; it < 88 + 64; it += C.G) {
        const bool isin = it < 88; const int ldw = isin ? NIN_ORIG : FF, col0 = (isin ? it : it - 88) * 64;
        const float* W = (isin ? ARGF(A_WIN) + (size_t)l * DM * NIN_ORIG : ARGF(A_W1) + (size_t)l * DM * FF) + (size_t)(128 * w) * ldw + col0 + lane;
        const float* shp = modl + (isin ? 0 : 3 * DM) + 128 * w;
        float a0 = 0.f, a1 = 0.f, a2 = 0.f, a3 = 0.f, a4 = 0.f;
#pragma unroll 16
        for (int kk = 0; kk < 128; ++kk) { const float wv = W[(size_t)kk * ldw]; a0 += shp[kk] * wv; a1 += shp[NMOD + kk] * wv; a2 += shp[2 * NMOD + kk] * wv; a3 += shp[3 * NMOD + kk] * wv; a4 += shp[4 * NMOD + kk] * wv; }
        __syncthreads();
        red[(w * 5 + 0) * 64 + lane] = a0; red[(w * 5 + 1) * 64 + lane] = a1; red[(w * 5 + 2) * 64 + lane] = a2; red[(w * 5 + 3) * 64 + lane] = a3; red[(w * 5 + 4) * 64 + lane] = a4;
        __syncthreads();
        if (tid < 320) { const int g = tid >> 6, c = tid & 63; float v = 0.f;
#pragma unroll
            for (int ww = 0; ww < 8; ++ww) v += red[(ww * 5 + g) * 64 + c];
            if (!isin) cup[g * FF + col0 + c] = v; else if (it >= 4) cin[g * NIN + col0 + c + 256] = v; else cu[g * 64 + c] = v; }
        if (isin && it < 4) { __syncthreads();
            if (tid < 320) { const int g = tid >> 6, kc = tid & 63; float p = 0.f, q = 0.f;
                for (int c = 0; c < 64; ++c) { const float2 t = tw[((c * kc) & 63) * 128]; const float v = cu[g * 64 + c]; p += v * t.x; q += v * t.y; }
                cin[g * NIN + it * 64 + kc] = p; cin[g * NIN + 256 + it * 64 + kc] = q; } }
    }
    __syncthreads();
}
__device__ __forceinline__ void ph_weights(const Ctx& C, int l) {
    LAS float* scr = (LAS float*)(C.lds + C.wave * 16384);
    const int lane = C.lane();
    const float* Win = ARGF(A_WIN) + (size_t)l * DM * NIN_ORIG;
    bf16* win_t = WSP(bf16, WS_WIN); bf16* wm_t = WSP(bf16, WS_WM);
    constexpr int I_IN = (DM / 64) * ((NIN_ORIG - 256) / 32), I_F = (256 / 64) * (DM / 32), I_A = (512 / 64) * (DM / 32), I_O = (DM / 64) * (DM / 32), I_1 = (DM / 64) * (FF / 32), I_2 = (FF / 64) * (DM / 32);
    constexpr int NITEMS = I_IN + 2 * I_F + I_A + I_O + I_1 + I_2;
    for (int it = C.gw; it < NITEMS; it += C.NGW) {
        int r = it;
        if (r < I_IN) { transpose_item(Win + 256, NIN_ORIG, NIN_ORIG - 256, win_t, DM, 512, 0, scr, r, lane); continue; } r -= I_IN;
        if (r < I_F) { transpose_item(ARGF(A_WF) + (size_t)l * 256 * DM, DM, DM, wm_t, DM, 0, 0, scr, r, lane); continue; } r -= I_F;
        if (r < I_F) { transpose_item(ARGF(A_WC) + (size_t)l * 256 * DM, DM, DM, wm_t, DM, 0, 256, scr, r, lane); continue; } r -= I_F;
        if (r < I_A) { transpose_item(ARGF(A_WA) + (size_t)l * 512 * DM, DM, DM, wm_t, DM, 0, 512, scr, r, lane); continue; } r -= I_A;
        if (r < I_O) { transpose_item(ARGF(A_WO) + (size_t)l * DM * DM, DM, DM, WSP(bf16, WS_WO), DM, 0, 0, scr, r, lane); continue; } r -= I_O;
        if (r < I_1) { transpose_item(ARGF(A_W1) + (size_t)l * DM * FF, FF, FF, WSP(bf16, WS_W1), DM, 0, 0, scr, r, lane); continue; } r -= I_1;
        transpose_item(ARGF(A_W2) + (size_t)l * FF * DM, DM, DM, WSP(bf16, WS_W2), FF, 0, 0, scr, r, lane);
    }
    for (int it = C.gw; it < 4 * 32 * 8; it += C.NGW) {
        const int kq = it & 7, g = it >> 8, k0 = ((it >> 3) & 31) * 32, kl = lane & 31, pq = lane >> 5;
        LAS float* tile = scr;
        LAS float* ct = scr + 32 * 65;
        { float s, c; sincospif((float)lane * (1.0f / 32.0f), &s, &c); ct[lane] = c; ct[64 + lane] = s; }
#pragma unroll 8
        for (int kk = 0; kk < 32; ++kk) tile[kk * 65 + lane] = Win[(size_t)(k0 + kk) * NIN_ORIG + g * 64 + lane];
        LDS_WAIT(); asm volatile("" ::: "memory");
        float p[8];
#pragma unroll
        for (int j = 0; j < 8; ++j) p[j] = 0.f;
#pragma unroll 4
        for (int c = 0; c < 64; ++c) { const float wv = tile[kl * 65 + c];
#pragma unroll
            for (int j = 0; j < 8; ++j) p[j] += wv * ct[pq * 64 + ((c * (kq * 8 + j)) & 63)]; }
#pragma unroll
        for (int j = 0; j < 8; ++j) win_t[(size_t)(pq * 256 + g * 64 + kq * 8 + j) * DM + k0 + kl] = (bf16)f2bf(p[j]);
        LDS_WAIT(); asm volatile("" ::: "memory");
    }
}
__device__ __forceinline__ void ph_prenorm(const Ctx& C, const float* xl, const float* xc, const float* gn, bf16* dst, u64* rs, int row_begin, int row_end, const float* part, const float* pgate) {
    const int lane = C.lane();
    for (int row = row_begin + C.gw; row < row_end; row += C.NGW) {
        const bool isc = row >= ML; const int grp = isc ? 4 : (row >> 13);
        const float* xr = isc ? xc + (size_t)(row - ML) * DM : xl + (size_t)row * DM;
        f32x4 v[4]; float s2 = 0.f;
#pragma unroll
        for (int j = 0; j < 4; ++j) { v[j] = *(const f32x4*)(xr + 4 * lane + 256 * j);
            if (part != nullptr && isc) {
                const size_t po = (size_t)(row - ML) * DM + 4 * lane + 256 * j;
                const f32x4 ps = (*(const f32x4*)(part + po) + *(const f32x4*)(part + po + 1048576)) + (*(const f32x4*)(part + po + 2 * 1048576) + *(const f32x4*)(part + po + 3 * 1048576));
                v[j] = v[j] + *(const f32x4*)(pgate + 4 * lane + 256 * j) * ps; }
            s2 += (v[j].x * v[j].x + v[j].y * v[j].y) + (v[j].z * v[j].z + v[j].w * v[j].w); }
        s2 = wave_sum(s2);
        if (lane == 0) rs[row] = (u64)(s2 * 16777216.0f + 0.5f);
#pragma unroll
        for (int j = 0; j < 4; ++j) { const int c0 = 4 * lane + 256 * j; const f32x4 y = v[j] * *(const f32x4*)(gn + grp * DM + c0);
            v2u o; o.x = pk2(y.x, y.y); o.y = pk2(y.z, y.w); *(v2u*)(dst + (size_t)row * DM + c0) = o; }
    }
}
__device__ __forceinline__ void ph_mixers(const Ctx& C, int l) {
    const float2* tw = WSP(const float2, WS_TW); const bf16* pxa = WSP(const bf16, WS_PXA); bf16* mix = WSP(bf16, WS_HX);
    const int lane = C.lane();
    if (l == 0) {
        LAS float* twl = (LAS float*)(C.lds + 98304);
        { const int t = C.tid(); if (t < 256) { const float2 v = tw[t * 32]; twl[2 * t] = v.x; twl[2 * t + 1] = v.y; } }
        __syncthreads();
        for (int it = C.gw; it < NB * 4 * 128; it += C.NGW) {
            const int kp = it & 127, kcb = (it >> 7) & 3, bb = it >> 9, k0 = 2 * kp, kc = kcb * 64 + lane;
            const bf16* src = pxa + ((size_t)ML + bb * 256) * NPXA + kc; float y0 = 0.f, y1 = 0.f;
#pragma unroll 32
            for (int n = 0; n < 256; ++n) { const float p = bf2f(src[(size_t)n * NPXA + OFF_P]), q = bf2f(src[(size_t)n * NPXA + OFF_Q]);
                const int i0 = (n * k0) & 255, i1 = (n * (k0 + 1)) & 255;
                y0 += p * twl[2 * i0] - q * twl[2 * i0 + 1]; y1 += p * twl[2 * i1] - q * twl[2 * i1 + 1]; }
            mix[((size_t)ML + bb * 256 + k0) * DM + kc] = (bf16)f2bf(y0 * (1.0f / 128.0f));
            mix[((size_t)ML + bb * 256 + k0 + 1) * DM + kc] = (bf16)f2bf(y1 * (1.0f / 128.0f));
        }
    }
    const float* cw = ARGF(A_CONVW) + l * 3 * 256;
    const int nrows = l == 0 ? MT : ML;
    for (int e = C.gt(); e < nrows * 32; e += C.NGT) {
        const int row = e >> 5, ch = (e & 31) * 8;
        const int pos = row < ML ? (row & (SEQ - 1)) : ((row - ML) & 255), len = row < ML ? SEQ : 256;
        const bf16* pr = pxa + (size_t)row * NPXA;
        const v4u u1 = *(const v4u*)(pr + OFF_CU + ch), c1 = *(const v4u*)(pr + OFF_CC + ch), b1 = *(const v4u*)(pr + OFF_CB + ch);
        v4u u0 = (v4u){0, 0, 0, 0}, c0 = u0, u2 = u0, c2 = u0;
        if (pos > 0) { u0 = *(const v4u*)(pr - NPXA + OFF_CU + ch); c0 = *(const v4u*)(pr - NPXA + OFF_CC + ch); }
        if (pos < len - 1) { u2 = *(const v4u*)(pr + NPXA + OFF_CU + ch); c2 = *(const v4u*)(pr + NPXA + OFF_CC + ch); }
        float o[8]; float w0[8], w1[8], w2[8];
        { const f32x4 t0 = *(const f32x4*)(cw + ch), t1 = *(const f32x4*)(cw + ch + 4), t2 = *(const f32x4*)(cw + 256 + ch), t3 = *(const f32x4*)(cw + 256 + ch + 4), t4 = *(const f32x4*)(cw + 512 + ch), t5 = *(const f32x4*)(cw + 512 + ch + 4);
#pragma unroll
          for (int j = 0; j < 4; ++j) { w0[j] = t0[j]; w0[4 + j] = t1[j]; w1[j] = t2[j]; w1[4 + j] = t3[j]; w2[j] = t4[j]; w2[4 + j] = t5[j]; } }
#pragma unroll
        for (int j = 0; j < 4; ++j) {
            const unsigned a0 = u0[j], d0 = c0[j], a1 = u1[j], d1 = c1[j], a2 = u2[j], d2 = c2[j], bb = b1[j];
            o[2 * j] = bflo(bb) * (w0[2 * j] * bflo(a0) * bflo(d0) + w1[2 * j] * bflo(a1) * bflo(d1) + w2[2 * j] * bflo(a2) * bflo(d2));
            o[2 * j + 1] = bfhi(bb) * (w0[2 * j + 1] * bfhi(a0) * bfhi(d0) + w1[2 * j + 1] * bfhi(a1) * bfhi(d1) + w2[2 * j + 1] * bfhi(a2) * bfhi(d2));
        }
        v4u w; w.x = pk2(o[0], o[1]); w.y = pk2(o[2], o[3]); w.z = pk2(o[4], o[5]); w.w = pk2(o[6], o[7]);
        *(v4u*)(mix + (size_t)row * DM + 256 + ch) = w;
    }
}

typedef short bf16x8_t __attribute__((ext_vector_type(8)));
typedef short v4i16_t __attribute__((ext_vector_type(4)));
constexpr int AT_KW = 0, AT_VW = 73728, AT_BT = 147456;
template <bool WIN>
__device__ __forceinline__ void attn_block(LAS unsigned char* lds, const int (&ka)[2][2], const int (&va)[2][4], int rowoff0, const bf16x8_t (&qf)[2],
                                           const LAS float* brow  , const int (&dc)[2][4], unsigned vmask, f32x4 (&o)[4], float& m, float& l) {
    constexpr float SC = 0.18033688011112042f;
    constexpr int RS = WIN ? 8192 : 4096;
    f32x4 s[8][2];
#pragma unroll
    for (int j = 0; j < 8; ++j)
#pragma unroll
        for (int t = 0; t < 2; ++t) { s[j][t] = (f32x4){0.f, 0.f, 0.f, 0.f};
#pragma unroll
            for (int ks = 0; ks < 2; ++ks) { const bf16x8_t kf = *(const LAS bf16x8_t*)(lds + ka[t][ks] + rowoff0 + j * RS); s[j][t] = __builtin_amdgcn_mfma_f32_16x16x32_bf16(kf, qf[ks], s[j][t], 0, 0, 0); } }
    float tmax = -1e30f;
#pragma unroll
    for (int j = 0; j < 8; ++j)
#pragma unroll
        for (int t = 0; t < 2; ++t)
#pragma unroll
            for (int i = 0; i < 4; ++i) { float v = s[j][t][i] * SC; if (WIN) { v += brow[j * 31 + dc[t][i]]; if (!((vmask >> (t * 4 + i)) & 1u)) v = -1e30f; } s[j][t][i] = v; tmax = fmaxf(tmax, v); }
    tmax = fmaxf(tmax, __shfl_xor(tmax, 16)); tmax = fmaxf(tmax, __shfl_xor(tmax, 32));
    const float mn = fmaxf(m, tmax), alpha = __builtin_amdgcn_exp2f(m - mn); m = mn;
    float ps = 0.f;
#pragma unroll
    for (int j = 0; j < 8; ++j)
#pragma unroll
        for (int t = 0; t < 2; ++t)
#pragma unroll
            for (int i = 0; i < 4; ++i) { const float p = __builtin_amdgcn_exp2f(s[j][t][i] - mn); s[j][t][i] = p; ps += p; }
    l = l * alpha + ps;
#pragma unroll
    for (int db = 0; db < 4; ++db) o[db] = o[db] * alpha;
#pragma unroll
    for (int j = 0; j < 8; ++j) {
        v4u pw; pw.x = pg8::cvt_pk_bf16(s[j][0][0], s[j][0][1]); pw.y = pg8::cvt_pk_bf16(s[j][0][2], s[j][0][3]); pw.z = pg8::cvt_pk_bf16(s[j][1][0], s[j][1][1]); pw.w = pg8::cvt_pk_bf16(s[j][1][2], s[j][1][3]);
        const bf16x8_t pf = __builtin_bit_cast(bf16x8_t, pw);
#pragma unroll
        for (int db = 0; db < 4; ++db) {
            const v4i16_t lo = __builtin_amdgcn_ds_read_tr16_b64_v4i16((LAS v4i16_t*)(lds + va[0][db] + rowoff0 + j * RS));
            const v4i16_t hi = __builtin_amdgcn_ds_read_tr16_b64_v4i16((LAS v4i16_t*)(lds + va[1][db] + rowoff0 + j * RS));
            const bf16x8_t vf = (bf16x8_t){lo[0], lo[1], lo[2], lo[3], hi[0], hi[1], hi[2], hi[3]};
            o[db] = __builtin_amdgcn_mfma_f32_16x16x32_bf16(vf, pf, o[db], 0, 0, 0);
        }
    }
}
__device__ __forceinline__ void attn_addr(int kc0off, int li, int fq, int (&ka)[2][2], int (&va)[2][4]) {
#pragma unroll
    for (int t = 0; t < 2; ++t) {
        const int rk = kc0off + 16 * t + li;
#pragma unroll
        for (int ks = 0; ks < 2; ++ks) ka[t][ks] = AT_KW + rk * 128 + (((4 * ks + fq) ^ ((rk >> 1) & 7)) * 16);
        const int rv = kc0off + 16 * t + 4 * fq + (li >> 2), p = li & 3;
#pragma unroll
        for (int db = 0; db < 4; ++db) va[t][db] = AT_VW + rv * 128 + (((2 * db + (p >> 1)) ^ (((rv >> 1) & 3) << 1)) * 16) + (p & 1) * 8;
    }
}

__device__ __forceinline__ size_t zt_off(int b) { return b < 2 ? WS_TB + (size_t)b * 8 * MiB : (b == 2 ? (size_t)502 * MiB : WS_WIN); }
__device__ __forceinline__ void ph_t1(const Ctx& C) {
    const bf16* pxa = WSP(const bf16, WS_PXA); const int lane = C.lane();
    LAS unsigned short* tile = (LAS unsigned short*)(C.lds + C.wave * 9216);
    for (int it = C.gw; it < 4 * 2 * 128 * 4; it += C.NGW) {
        const int kcb = it & 3, n2 = (it >> 2) & 127, pq = (it >> 9) & 1, b = it >> 10;
#pragma unroll
        for (int i = 0; i < 8; ++i) { const int q = i * 64 + lane, n1 = q >> 3, cc = q & 7;
            const v4u v = *(const v4u*)(pxa + ((size_t)b * SEQ + n1 * 128 + n2) * NPXA + pq * 256 + kcb * 64 + cc * 8);
            *(LAS v4u*)(tile + n1 * 72 + cc * 8) = v; }
        LDS_WAIT(); asm volatile("" ::: "memory");
        bf16* zt = WSP(bf16, zt_off(b)) + ((size_t)(pq * 256 + kcb * 64 + lane) * SEQ + n2 * 64);
#pragma unroll
        for (int c = 0; c < 8; ++c) { v4u o;
            o.x = (unsigned)tile[(8 * c + 0) * 72 + lane] | ((unsigned)tile[(8 * c + 1) * 72 + lane] << 16); o.y = (unsigned)tile[(8 * c + 2) * 72 + lane] | ((unsigned)tile[(8 * c + 3) * 72 + lane] << 16);
            o.z = (unsigned)tile[(8 * c + 4) * 72 + lane] | ((unsigned)tile[(8 * c + 5) * 72 + lane] << 16); o.w = (unsigned)tile[(8 * c + 6) * 72 + lane] | ((unsigned)tile[(8 * c + 7) * 72 + lane] << 16);
            *(v4u*)(zt + 8 * c) = o; }
        LDS_WAIT(); asm volatile("" ::: "memory");
    }
}
typedef float f32x16 __attribute__((ext_vector_type(16)));
constexpr int FT_C64 = 0, FT_S64 = 9216, FT_C128 = 18432, FT_S128 = FT_C128 + 34816, FT_TA = FT_S128 + 34816, FT_TR = FT_TA + 4096, FT_ST = FT_TR + 8192;
static_assert(FT_ST + 32768 <= LDSCTL_OFF, "fft lds");
__device__ __forceinline__ int crow16(int r, int h) { return (r & 3) + 8 * (r >> 2) + 4 * h; }
__device__ __forceinline__ void ph_fft(const Ctx& C) {
    LAS unsigned char* lds = C.lds; const int tid = C.tid(), lane = C.lane(), w = C.wave, h = lane >> 5, c = lane & 31;
    const float2* tw = WSP(const float2, WS_TW); bf16* mix = WSP(bf16, WS_HX);
    { LAS unsigned short* c64 = (LAS unsigned short*)(lds + FT_C64); LAS unsigned short* s64 = (LAS unsigned short*)(lds + FT_S64);
#pragma unroll 4
      for (int e = tid; e < 4096; e += NTHR) { const int k1 = e >> 6, n1 = e & 63; float sn, cs; sincospif((float)((n1 * k1) & 63) * (1.0f / 32.0f), &sn, &cs); c64[k1 * 72 + n1] = (unsigned short)f2bf(cs); s64[k1 * 72 + n1] = (unsigned short)f2bf(sn); }
      LAS unsigned short* c128 = (LAS unsigned short*)(lds + FT_C128); LAS unsigned short* s128 = (LAS unsigned short*)(lds + FT_S128);
#pragma unroll 4
      for (int e = tid; e < 16384; e += NTHR) { const int k2 = e >> 7, p = e & 127, q = p & 15, n2 = (p & ~15) + (q & 3) + ((q >> 2) & 1) * 8 + ((q >> 3) & 1) * 4;
          float sn, cs; sincospif((float)((n2 * k2) & 127) * (1.0f / 64.0f), &sn, &cs); c128[k2 * 136 + p] = (unsigned short)f2bf(cs); s128[k2 * 136 + p] = (unsigned short)f2bf(sn); }
      LAS float* ta = (LAS float*)(lds + FT_TA); LAS float* trt = (LAS float*)(lds + FT_TR);
      { const int e = tid, g = e >> 6, kk = e & 63; float sn, cs; sincospif((float)((32 * (g >> 1) + 4 * (g & 1)) * kk) * (1.0f / 4096.0f), &sn, &cs); ta[2 * e] = cs; ta[2 * e + 1] = sn; }
      for (int e = tid; e < 1024; e += NTHR) { const int r = e >> 6, kk = e & 63; float sn, cs; sincospif((float)(crow16(r, 0) * kk) * (1.0f / 4096.0f), &sn, &cs); trt[2 * e] = cs; trt[2 * e + 1] = sn; }
    }
    __syncthreads();
    const int vcu = (C.G % 8 == 0) ? (C.bx % 8) * (C.G / 8) + C.bx / 8 : C.bx;
    for (int it = vcu; it < 256; it += C.G) {
        const int kb = it & 1, kcg = (it >> 1) & 31, b = it >> 6, kc = kcg * 8 + w, k1 = 32 * kb + c;
        const bf16* zp = WSP(const bf16, zt_off(b)) + (size_t)kc * SEQ; const bf16* zq = zp + (size_t)256 * SEQ;
        f32x16 acc[4];
#pragma unroll
        for (int rb2 = 0; rb2 < 4; ++rb2) acc[rb2] = (f32x16){};
#pragma unroll 1
        for (int rb = 0; rb < 4; ++rb) {
            const int n2 = 32 * rb + c;
            f32x16 xr = {}, xi = {};
#pragma unroll
            for (int ks = 0; ks < 4; ++ks) {
                const bf16x8_t cf = *(const LAS bf16x8_t*)(lds + FT_C64 + (k1 * 72 + 16 * ks + 8 * h) * 2), sf = *(const LAS bf16x8_t*)(lds + FT_S64 + (k1 * 72 + 16 * ks + 8 * h) * 2);
                const bf16x8_t pf = *(const bf16x8_t*)(zp + n2 * 64 + 16 * ks + 8 * h), qf = *(const bf16x8_t*)(zq + n2 * 64 + 16 * ks + 8 * h);
                const v4u t = __builtin_bit_cast(v4u, qf) ^ 0x80008000u; const bf16x8_t qn = __builtin_bit_cast(bf16x8_t, t);
                xr = __builtin_amdgcn_mfma_f32_32x32x16_bf16(pf, cf, xr, 0, 0, 0); xi = __builtin_amdgcn_mfma_f32_32x32x16_bf16(pf, sf, xi, 0, 0, 0);
                xi = __builtin_amdgcn_mfma_f32_32x32x16_bf16(qf, cf, xi, 0, 0, 0); xr = __builtin_amdgcn_mfma_f32_32x32x16_bf16(qn, sf, xr, 0, 0, 0); }
            bf16x8_t bre[2], bim[2];
            const LAS float* tap = (const LAS float*)(lds + FT_TA) + 2 * ((rb * 2 + h) * 64 + k1); const float ac_ = tap[0], as_ = tap[1];
            const LAS float* trp = (const LAS float*)(lds + FT_TR) + 2 * k1;
#pragma unroll
            for (int sblk = 0; sblk < 2; ++sblk) {
                float tr[8], ti[8];
#pragma unroll
                for (int r8 = 0; r8 < 8; ++r8) { const int r = 8 * sblk + r8; const float rc = trp[128 * r], rs = trp[128 * r + 1]; const float tc = ac_ * rc - as_ * rs, ts = ac_ * rs + as_ * rc;
                    tr[r8] = xr[r] * tc - xi[r] * ts; ti[r8] = -(xr[r] * ts + xi[r] * tc); }
                v4u a, bq;
                a.x = pg8::cvt_pk_bf16(tr[0], tr[1]); a.y = pg8::cvt_pk_bf16(tr[2], tr[3]); a.z = pg8::cvt_pk_bf16(tr[4], tr[5]); a.w = pg8::cvt_pk_bf16(tr[6], tr[7]);
                bq.x = pg8::cvt_pk_bf16(ti[0], ti[1]); bq.y = pg8::cvt_pk_bf16(ti[2], ti[3]); bq.z = pg8::cvt_pk_bf16(ti[4], ti[5]); bq.w = pg8::cvt_pk_bf16(ti[6], ti[7]);
                bre[sblk] = __builtin_bit_cast(bf16x8_t, a); bim[sblk] = __builtin_bit_cast(bf16x8_t, bq); }
#pragma unroll
            for (int rb2 = 0; rb2 < 4; ++rb2) {
                const int k2 = 32 * rb2 + c;
#pragma unroll
                for (int sblk = 0; sblk < 2; ++sblk) {
                    const bf16x8_t ac = *(const LAS bf16x8_t*)(lds + FT_C128 + (k2 * 136 + 32 * rb + 16 * sblk + 8 * h) * 2), as = *(const LAS bf16x8_t*)(lds + FT_S128 + (k2 * 136 + 32 * rb + 16 * sblk + 8 * h) * 2);
                    acc[rb2] = __builtin_amdgcn_mfma_f32_32x32x16_bf16(ac, bre[sblk], acc[rb2], 0, 0, 0); acc[rb2] = __builtin_amdgcn_mfma_f32_32x32x16_bf16(as, bim[sblk], acc[rb2], 0, 0, 0); }
            }
        }
#pragma unroll
        for (int rb2 = 0; rb2 < 4; ++rb2) {
            LAS unsigned short* st = (LAS unsigned short*)(lds + FT_ST + (rb2 & 1) * 16384);
#pragma unroll
            for (int r = 0; r < 16; ++r) st[((crow16(r, h) * 32 + c) * 8) + w] = (unsigned short)f2bf(acc[rb2][r] * 0.001381067932f);
            LDS_WAIT(); __syncthreads();
#pragma unroll
            for (int j = 0; j < 2; ++j) { const int idx = tid + 512 * j, k2l = idx >> 5, k1l = idx & 31;
                const v4u v = *(const LAS v4u*)(st + idx * 8);
                *(v4u*)(mix + ((size_t)b * SEQ + 32 * kb + k1l + 64 * (32 * rb2 + k2l)) * DM + kcg * 8) = v; }
        }
        __syncthreads();
    }
}
__device__ __forceinline__ void ph_attn(const Ctx& C, int l) {
    const bf16* pxa = WSP(const bf16, WS_PXA); bf16* mix = WSP(bf16, WS_HX);
    const float* rb = ARGF(A_RELB) + (size_t)l * 8 * 15 * 31;
    LAS unsigned char* lds = C.lds; LAS float* biasT = (LAS float*)(lds + AT_BT);
    const int lane = C.lane(), w = C.wave, fq = lane >> 4, li = lane & 15, tid = C.tid();
    const int nunits = 2048 + (l == 0 ? 64 : 0);
    const int vcu = (C.G % 8 == 0) ? (C.bx % 8) * (C.G / 8) + C.bx / 8 : C.bx;
    for (int u = vcu; u < nunits; u += C.G) {
        const bool isc = u >= 2048;
        int b, h, rp; if (!isc) { b = u >> 9; h = (u >> 6) & 7; rp = u & 63; } else { const int v = u - 2048; b = v >> 4; h = (v >> 1) & 7; rp = v & 1; }
        __syncthreads();
        for (int e = tid; e < 465; e += NTHR) biasT[e] = rb[h * 465 + e] * 1.4426950408889634f;
        const int R0 = min(max(2 * rp - 4, 0), 120);
        if (!isc) {
            for (int p = w; p < 72; p += 8) {
                const int tokl = p * 8 + (lane >> 3), lr = tokl >> 6, col = tokl & 63, gr = min(R0 + lr, 127), cp = lane & 7;
                const bf16* src = pxa + ((size_t)b * SEQ + gr * 64 + col) * NPXA + h * 64;
                __builtin_amdgcn_global_load_lds((const unsigned*)(src + OFF_K + ((cp ^ ((tokl >> 1) & 7)) * 8)), (LAS unsigned*)(lds + AT_KW + p * 1024), 16, 0, 0);
                __builtin_amdgcn_global_load_lds((const unsigned*)(src + OFF_V + ((cp ^ (((tokl >> 1) & 3) << 1)) * 8)), (LAS unsigned*)(lds + AT_VW + p * 1024), 16, 0, 0);
            }
        }
        int r = 0, qc = 0; size_t token;
        if (!isc) { r = 2 * rp + (w >> 2); qc = 16 * (w & 3) + li; token = (size_t)b * SEQ + r * 64 + qc; }
        else token = (size_t)ML + b * 256 + rp * 128 + 16 * w + li;
        bf16x8_t qf[2];
#pragma unroll
        for (int ks = 0; ks < 2; ++ks) qf[ks] = *(const bf16x8_t*)(pxa + token * NPXA + OFF_QQ + h * 64 + 32 * ks + 8 * fq);
        f32x4 o[4]; float m = -1e30f, lsum = 0.f;
#pragma unroll
        for (int db = 0; db < 4; ++db) o[db] = (f32x4){0.f, 0.f, 0.f, 0.f};
        int ka[2][2], va[2][4], dc[2][4];
        asm volatile("s_waitcnt vmcnt(0)" ::: "memory");
        __syncthreads();
        if (!isc) {
            const int cb = w & 3, kc0 = cb == 0 ? 0 : cb == 1 ? 8 : cb == 2 ? 24 : 32;
            attn_addr(kc0, li, fq, ka, va);
            const int csq = min(max(qc - 8, 0), 48); unsigned vmask = 0u;
#pragma unroll
            for (int t = 0; t < 2; ++t)
#pragma unroll
                for (int i = 0; i < 4; ++i) { const int kcol = kc0 + 16 * t + 4 * fq + i; if (kcol >= csq && kcol < csq + 16) vmask |= 1u << (t * 4 + i); dc[t][i] = min(max(kcol - qc + 15, 0), 30); }
            const int rsr = min(max(r - 4, 0), 120), lr0 = rsr - R0;
            attn_block<true>(lds, ka, va, lr0 * 8192, qf, biasT + (rsr - r + 7) * 31, dc, vmask, o, m, lsum);
        }
        __syncthreads();
        for (int p = w; p < 32; p += 8) {
            const int tokl = p * 8 + (lane >> 3), cp = lane & 7;
            const bf16* src = pxa + ((size_t)ML + b * 256 + tokl) * NPXA + h * 64;
            __builtin_amdgcn_global_load_lds((const unsigned*)(src + OFF_K + ((cp ^ ((tokl >> 1) & 7)) * 8)), (LAS unsigned*)(lds + AT_KW + p * 1024), 16, 0, 0);
            __builtin_amdgcn_global_load_lds((const unsigned*)(src + OFF_V + ((cp ^ (((tokl >> 1) & 3) << 1)) * 8)), (LAS unsigned*)(lds + AT_VW + p * 1024), 16, 0, 0);
        }
        attn_addr(0, li, fq, ka, va);
        asm volatile("s_waitcnt vmcnt(0)" ::: "memory");
        __syncthreads();
        attn_block<false>(lds, ka, va, 0, qf, (const LAS float*)nullptr, dc, 0xffu, o, m, lsum);
        lsum += __shfl_xor(lsum, 16); lsum += __shfl_xor(lsum, 32);
        const float inv = __builtin_amdgcn_rcpf(lsum);
        bf16* op = mix + token * DM + 512 + h * 64 + 4 * fq;
#pragma unroll
        for (int db = 0; db < 4; ++db) { v2u ov; ov.x = pk2(o[db][0] * inv, o[db][1] * inv); ov.y = pk2(o[db][2] * inv, o[db][3] * inv); *(v2u*)(op + 16 * db) = ov; }
    }
}

template <int KS>
__device__ __forceinline__ void wg_core(const bf16* A, const bf16* W, int li, int fq, f32x4 (&acc)[4][2]) {
    const bf16* ap = A + (size_t)li * DM + 8 * fq; const bf16* wp = W + (size_t)li * DM + 8 * fq;
    bf16x8_t af[4][4], wf[4][2];
#pragma unroll
    for (int s = 0; s < 3; ++s) {
#pragma unroll
        for (int m = 0; m < 4; ++m) af[s][m] = *(const bf16x8_t*)(ap + (size_t)(16 * m) * DM + 32 * s);
#pragma unroll
        for (int n = 0; n < 2; ++n) wf[s][n] = *(const bf16x8_t*)(wp + (size_t)(16 * n) * DM + 32 * s); }
#pragma unroll
    for (int s = 0; s < KS; ++s) {
        if (s + 3 < KS) {
#pragma unroll
            for (int m = 0; m < 4; ++m) af[(s + 3) & 3][m] = *(const bf16x8_t*)(ap + (size_t)(16 * m) * DM + 32 * (s + 3));
#pragma unroll
            for (int n = 0; n < 2; ++n) wf[(s + 3) & 3][n] = *(const bf16x8_t*)(wp + (size_t)(16 * n) * DM + 32 * (s + 3)); }
#pragma unroll
        for (int m = 0; m < 4; ++m)
#pragma unroll
            for (int n = 0; n < 2; ++n) acc[m][n] = __builtin_amdgcn_mfma_f32_16x16x32_bf16(wf[s & 3][n], af[s & 3][m], acc[m][n], 0, 0, 0);
    }
}
__device__ __forceinline__ void wg_merge_ctx(const Ctx& C) {
    if (C.wave >= 2) return;
    const bf16* mix = WSP(const bf16, WS_HX); const bf16* wm = WSP(const bf16, WS_WM); const bf16* pxg = WSP(const bf16, WS_PXG); bf16* mb = WSP(bf16, WS_M);
    const int lane = C.lane(), li = lane & 15, fq = lane >> 4;
    for (int it = C.wave * C.G + C.bx; it < 512; it += 2 * C.G) {
        const int r0 = ML + 64 * (it >> 5), c0 = 32 * (it & 31);
        f32x4 a0[4][2], a1[4][2], a2[4][2];
#pragma unroll
        for (int m = 0; m < 4; ++m)
#pragma unroll
            for (int n = 0; n < 2; ++n) { a0[m][n] = (f32x4){0.f, 0.f, 0.f, 0.f}; a1[m][n] = a0[m][n]; a2[m][n] = a0[m][n]; }
        const bf16* A = mix + (size_t)r0 * DM; const bf16* W = wm + (size_t)c0 * DM;
        wg_core<8>(A, W, li, fq, a0); wg_core<8>(A + 256, W + 256, li, fq, a1); wg_core<16>(A + 512, W + 512, li, fq, a2);
#pragma unroll
        for (int m = 0; m < 4; ++m)
#pragma unroll
            for (int n = 0; n < 2; ++n) { const size_t row = (size_t)(r0 + 16 * m + li); const int col = c0 + 16 * n + 4 * fq;
                const v2u g0 = *(const v2u*)(pxg + row * NPXG + col), g1 = *(const v2u*)(pxg + row * NPXG + 1024 + col), g2 = *(const v2u*)(pxg + row * NPXG + 2048 + col);
#define RL(x) __builtin_amdgcn_rcpf(bflo(x))
#define RH(x) __builtin_amdgcn_rcpf(bfhi(x))
                const float o0 = a0[m][n][0] * RL(g0.x) + a1[m][n][0] * RL(g1.x) + a2[m][n][0] * RL(g2.x), o1 = a0[m][n][1] * RH(g0.x) + a1[m][n][1] * RH(g1.x) + a2[m][n][1] * RH(g2.x);
                const float o2 = a0[m][n][2] * RL(g0.y) + a1[m][n][2] * RL(g1.y) + a2[m][n][2] * RL(g2.y), o3 = a0[m][n][3] * RH(g0.y) + a1[m][n][3] * RH(g1.y) + a2[m][n][3] * RH(g2.y);
#undef RL
#undef RH
                v2u w; w.x = cvt_pk_bf16(o0, o1); w.y = cvt_pk_bf16(o2, o3); *(v2u*)(mb + row * DM + col) = w; }
    }
}
__device__ __forceinline__ void wg_wo_ctx(const Ctx& C) {
    if (C.wave >= 2) return;
    const bf16* mb = WSP(const bf16, WS_M); const bf16* wo = WSP(const bf16, WS_WO); const float* base = ARGF(A_CTX); float* out = WSP(float, WS_CTXX);
    const float* gate = WSP(const float, WS_MOD) + 4 * NMOD + 2 * DM; const float* gn = WSP(const float, WS_GN) + (size_t)(1 * 5 + 4) * DM; bf16* ap = WSP(bf16, WS_HX); u64* rs = WSP(u64, WS_RS) + (size_t)1 * MT;
    const int lane = C.lane(), li = lane & 15, fq = lane >> 4;
    for (int it = C.wave * C.G + C.bx; it < 512; it += 2 * C.G) {
        const int r0 = 64 * (it >> 5), c0 = 32 * (it & 31);
        f32x4 acc[4][2];
#pragma unroll
        for (int m = 0; m < 4; ++m)
#pragma unroll
            for (int n = 0; n < 2; ++n) acc[m][n] = (f32x4){0.f, 0.f, 0.f, 0.f};
        wg_core<32>(mb + (size_t)(ML + r0) * DM, wo + (size_t)c0 * DM, li, fq, acc);
#pragma unroll
        for (int m = 0; m < 4; ++m) { const size_t rc = (size_t)(r0 + 16 * m + li); float ss = 0.f;
#pragma unroll
            for (int n = 0; n < 2; ++n) { const int col = c0 + 16 * n + 4 * fq;
                const f32x4 o = *(const f32x4*)(base + rc * DM + col) + *(const f32x4*)(gate + col) * acc[m][n];
                *(f32x4*)(out + rc * DM + col) = o;
                const f32x4 y = o * *(const f32x4*)(gn + col); v2u w; w.x = cvt_pk_bf16(y[0], y[1]); w.y = cvt_pk_bf16(y[2], y[3]); *(v2u*)(ap + (ML + rc) * DM + col) = w;
                ss += (o[0] * o[0] + o[1] * o[1]) + (o[2] * o[2] + o[3] * o[3]); }
            ss += __shfl_xor(ss, 16); ss += __shfl_xor(ss, 32);
            if (fq == 0) __hip_atomic_fetch_add(rs + ML + rc, (u64)(ss * 16777216.0f + 0.5f), __ATOMIC_RELAXED, __HIP_MEMORY_SCOPE_AGENT); }
    }
}
__device__ __forceinline__ void ph_final(const Ctx& C) {
    float* out = (float*)(GAS float*)ldarg(C, A_OUT); const float* fg = ARGF(A_FG); const int lane = C.lane();
    for (int row = C.gw; row < ML; row += C.NGW) {
        float* xr = out + (size_t)row * DM;
        f32x4 v[4]; float s2 = 0.f;
#pragma unroll
        for (int j = 0; j < 4; ++j) { v[j] = *(const f32x4*)(xr + 4 * lane + 256 * j); s2 += (v[j].x * v[j].x + v[j].y * v[j].y) + (v[j].z * v[j].z + v[j].w * v[j].w); }
        const float rstd = 1.0f / sqrtf(wave_sum(s2) * (1.0f / DM) + EPS);
#pragma unroll
        for (int j = 0; j < 4; ++j) { const int c0 = 4 * lane + 256 * j; const f32x4 gg = *(const f32x4*)(fg + c0); *(f32x4*)(xr + c0) = v[j] * rstd * gg; }
    }
}

struct Args { const void* p[A_NARGS]; int ph_lo, ph_hi; };

__global__ void __launch_bounds__(NTHR, 2) fwd_kernel(Args args) {
    extern __shared__ __attribute__((aligned(16))) unsigned char lds_raw[];
    LAS unsigned char* const lds0 = (LAS unsigned char*)lds_raw;
    const int wave0 = __builtin_amdgcn_readfirstlane(threadIdx.x >> 6);
    { const int t0 = threadIdx.x;
      for (int u = t0; u < (LDS_BYTES - LDSCTL_OFF) / 4; u += NTHR) ((LAS unsigned*)(lds0 + LDSCTL_OFF))[u] = 0u;
      __syncthreads();
      if (t0 < A_NARGS) ((LAS unsigned long long*)(lds0 + LARGS_OFF))[t0] = (unsigned long long)args.p[t0];
      __syncthreads(); }
    const int lo = args.ph_lo, hi = args.ph_hi;
    const unsigned xcc = xb_xcc_id();
    int vbx = blockIdx.x;
    if (!MK_MULTI) { Ctx C; C.lds = lds0; C.wave = wave0; gu32* ctl0 = (gu32*)WSP(unsigned, WS_CTL); (void)xcd_barrier_post((unsigned*)(ctl0 + CW_BAR), (volatile LAS unsigned*)(lds0 + MISC_OFF) + 8, C.tid() == 0); }
    for (int step = lo; step < hi; ++step) {
        const int ls = step - 2, l = ls >= NS ? 1 : 0, k = (step < 2) ? -1 - step : ls - l * NS;
        const int nrep = (PROBE_K != -99 && k == PROBE_K) ? PROBE_N : 1;
        for (int rep = 0; rep < nrep; ++rep) {
        Ctx C;
        C.lds = lds0; C.wave = wave0; C.G = gridDim.x; C.bx = vbx;
        asm volatile("" : "+s"(C.wave), "+s"(C.bx), "+s"(C.G));
        C.gw = C.bx * NWAVES + C.wave; C.NGW = C.G * NWAVES; C.NGT = C.G * NTHR;
        gu32* ctl = (gu32*)WSP(unsigned, WS_CTL);
        if (k == -1) { ph_mod_partial(C); __syncthreads(); ph_weights(C, 0); }
        else if (k == -2) ph_mod_reduce(C);
        else if (k == 0) {
            if (l == 1) ph_weights(C, l);
            ph_ctab(C, l);
            u64* rsb = WSP(u64, WS_RS) + (size_t)(l == 0 ? 0 : 2) * MT;
            if (l == 0) ph_prenorm(C, ARGF(A_X), ARGF(A_CTX), WSP(const float, WS_GN), WSP(bf16, WS_HX), rsb, 0, MT, (const float*)nullptr, (const float*)nullptr);
            else ph_prenorm(C, ARGF(A_OUT), WSP(const float, WS_CTXX), WSP(const float, WS_GN) + 2 * 5 * DM, WSP(bf16, WS_HX), rsb, ML, MT, WSP(const float, WS_PART), WSP(const float, WS_MOD) + 4 * NMOD + 5 * DM);
        } else if (k == 1) {
            pg8::Prob<false> P{WSP(const bf16, WS_HX), WSP(const bf16, WS_WIN), DM, DM, DM}; pg8::StaticOrder<NIN / 256> S; S.init(MT, NIN, C.G, C.bx);
            EpiIn E{WSP(bf16, WS_PXA), WSP(bf16, WS_PXG), WSP(const u64, WS_RS) + (size_t)(l == 0 ? 0 : 2) * MT, WSP(const float, WS_CIN) + (size_t)l * 5 * NIN};
            pg8::gemm_phase(C.lds, P, S, E, C.tid());
        } else if (k == 2) {
            const int sub = rep == 0 ? 7 : PROBE_SUB;
            if (sub & 1) ph_t1(C);
            if (sub & 2) ph_mixers(C, l);
            if (sub & 4) ph_attn(C, l);
        } else if (k == 3) {
            ph_fft(C);
        } else if (k == 4) {
            pg8::Prob<false> P{WSP(const bf16, WS_HX), WSP(const bf16, WS_WM), DM, DM, DM}; pg8::StaticOrder<DM / 256> S; S.init(ML, DM, C.G, C.bx);
            EpiMerge E{WSP(bf16, WS_M), WSP(const bf16, WS_PXG)};
            pg8::gemm_phase(C.lds, P, S, E, C.tid());
            if (l == 0) wg_merge_ctx(C);
        } else if (k == 5) {
            pg8::Prob<false> P{WSP(const bf16, WS_M), WSP(const bf16, WS_WO), DM, DM, DM}; pg8::StaticOrder<DM / 256> S; S.init(ML, DM, C.G, C.bx);
            EpiRes E{l == 0 ? ARGF(A_X) : ARGF(A_OUT), l == 0 ? ARGF(A_CTX) : WSP(const float, WS_CTXX), (float*)(GAS float*)ldarg(C, A_OUT), WSP(float, WS_CTXX),
                     rep > 0 ? WSP(const float, WS_ZERO) : WSP(const float, WS_MOD) + (size_t)l * 5 * NMOD + 2 * DM, nullptr,
                     WSP(const float, WS_GN) + (size_t)(l * 2 + 1) * 5 * DM, WSP(bf16, WS_HX), WSP(u64, WS_RS) + (size_t)(l == 0 ? 1 : 3) * MT};
            pg8::gemm_phase(C.lds, P, S, E, C.tid());
            if (l == 0 && rep == 0) wg_wo_ctx(C);
        } else if (k == 6) {
            pg8::Prob<false> P{WSP(const bf16, WS_HX), WSP(const bf16, WS_W1), DM, DM, DM}; pg8::StaticOrder<FF / 256> S; S.init(l == 0 ? MT : ML, FF, C.G, C.bx);
            EpiAct E{WSP(bf16, WS_ACT), WSP(const u64, WS_RS) + (size_t)(l == 0 ? 1 : 3) * MT, WSP(const float, WS_CUP) + (size_t)l * 5 * FF};
            pg8::gemm_phase(C.lds, P, S, E, C.tid());
        } else if (k == 7) {
            if (l == 0) {
                pg8::ProbDown P{WSP(const bf16, WS_ACT), WSP(const bf16, WS_W2), FF, FF, FF}; pg8::DownOrder S; S.init(C.G, C.bx);
                EpiRes E{ARGF(A_OUT), WSP(const float, WS_CTXX), (float*)(GAS float*)ldarg(C, A_OUT), WSP(float, WS_CTXX), WSP(const float, WS_MOD) + (size_t)l * 5 * NMOD + 5 * DM, WSP(float, WS_PART),
                         WSP(const float, WS_GN) + (size_t)2 * 5 * DM, WSP(bf16, WS_HX), WSP(u64, WS_RS) + (size_t)2 * MT};
                pg8::gemm_phase(C.lds, P, S, E, C.tid());
            } else {
                pg8::Prob<false> P{WSP(const bf16, WS_ACT), WSP(const bf16, WS_W2), FF, FF, FF}; pg8::StaticOrder<DM / 256> S; S.init(ML, DM, C.G, C.bx);
                EpiResFinal E{(float*)(GAS float*)ldarg(C, A_OUT), WSP(const float, WS_MOD) + (size_t)l * 5 * NMOD + 5 * DM, ARGF(A_FG), WSP(u64, WS_RS5), WSP(unsigned, WS_FCNT), (unsigned*)WSP(unsigned, WS_CTL) + CW_TMO};
                pg8::gemm_phase(C.lds, P, S, E, C.tid());
            }
        } else ph_final(C);
        if (step + 1 < hi || rep + 1 < nrep) { if (MK_MULTI) { if (C.tid() == 0) __hip_atomic_store(ctl + CW_TMO, 0xBADu, RLX_AGENT); } else { XcdBarrier bar; bar.bar = (unsigned*)(ctl + CW_BAR); bar.x = xcc; bar.st = (volatile LAS unsigned*)(lds0 + MISC_OFF) + 8; xcd_barrier(bar, C.tid() == 0);
                if (step == lo && rep == 0) {
                    volatile LAS unsigned* misc = (volatile LAS unsigned*)(lds0 + MISC_OFF);
                    if (C.tid() == 0) { bool ok = gridDim.x == 256;
                        for (unsigned j = 0; j < 16; ++j) { const unsigned cnt = xb_ld(bar.bar + XB_XCNT(j)); ok = ok && (cnt == (j < 8 ? 32u : 0u)); }
                        misc[11] = ok ? 1u : 0u; }
                    __syncthreads();
                    const unsigned okf = __builtin_amdgcn_readfirstlane(misc[11]), rk = __builtin_amdgcn_readfirstlane(misc[10]);
                    if (okf != 0u && rk < 32u && xcc < 8u) vbx = (int)(rk * 8u + xcc); } } }
        }
    }
}

extern "C" void kernel_launch(void* const* d_in, const int* in_sizes, int n_in, void* d_out, int out_size, void* d_ws, size_t ws_size, hipStream_t stream) {
    static int grid = 0;
    if (grid == 0) {
        if (n_in != 18 || out_size != ML * DM || ws_size < WS_END) { fprintf(stderr, "kernel_launch: unexpected shapes (n_in %d out %d ws %zu)\n", n_in, out_size, ws_size); grid = -1; return; }
        int dev = 0, cus = 0;
        if (hipGetDevice(&dev) != hipSuccess || hipDeviceGetAttribute(&cus, hipDeviceAttributeMultiprocessorCount, dev) != hipSuccess) { grid = -1; return; }
        if (hipFuncSetAttribute((const void*)fwd_kernel, hipFuncAttributeMaxDynamicSharedMemorySize, LDS_BYTES) != hipSuccess) { fprintf(stderr, "kernel_launch: hipFuncSetAttribute failed\n"); grid = -1; return; }
        int per_cu = 0;
        if (hipOccupancyMaxActiveBlocksPerMultiprocessor(&per_cu, (const void*)fwd_kernel, NTHR, LDS_BYTES) != hipSuccess || per_cu < 1) fprintf(stderr, "kernel_launch: occupancy query reports %d\n", per_cu);
        (void)hipGetLastError();
        grid = cus;
    }
    if (grid < 0) return;
    (void)hipMemsetAsync((char*)d_ws + WS_CTL, 0, CTL_ZERO_BYTES, stream);
    Args a{};
    for (int i = 0; i < 18; ++i) a.p[i] = d_in[i];
    a.p[A_OUT] = d_out; a.p[A_WS] = d_ws;
#if MK_MULTI
    for (int s = 0; s < NSTEPS; ++s) { a.ph_lo = s; a.ph_hi = s + 1; hipLaunchKernelGGL(fwd_kernel, dim3(grid), dim3(NTHR), LDS_BYTES, stream, a); }
#else
    a.ph_lo = 0; a.ph_hi = NSTEPS; hipLaunchKernelGGL(fwd_kernel, dim3(grid), dim3(NTHR), LDS_BYTES, stream, a);
#endif
}
```

```cpp
#include <hip/hip_runtime.h>
#include <cstdio>
#include <cstdint>

#ifndef PROBE_K
#define PROBE_K -99
#define PROBE_N 1
#define PROBE_SUB 7
#endif
#ifndef MK_MULTI
#define MK_MULTI 0
#endif

namespace pg8 {
#define PG8_LAS __attribute__((address_space(3)))
typedef unsigned short bf16_t;
typedef short bf16x8 __attribute__((ext_vector_type(8)));
typedef float f32x4 __attribute__((ext_vector_type(4)));
typedef unsigned u32x4 __attribute__((ext_vector_type(4)));
constexpr int BM = 256, BK = 64, HALF = 128, HTB = HALF * BK * 2, STAGE_BYTES = 8 * HTB, NXCD = 8, WGM = 8;

__host__ __device__ __forceinline__ int lds_byte(int r, int c) { const int st = (r >> 4) * 2 + (c >> 5), rr = r & 15, cc = c & 31, ob = rr * 64 + cc * 2; return st * 1024 + (ob ^ (((ob >> 9) & 1) << 5)); }
__host__ __device__ __forceinline__ void stage_rc(int b, int& R, int& C) { const int st = b / 1024, sb = b % 1024, swz = sb ^ (((sb >> 9) & 1) << 5); R = (st >> 1) * 16 + swz / 64; C = (st & 1) * 32 + (swz % 64) / 2; }
__host__ __device__ __forceinline__ int perm32(int rho) { const int n = rho >> 4, i = rho & 15; return 8 * (i >> 2) + 4 * n + (i & 3); }

struct Unit { int pm, pn, br; };

template <int NN  > struct StaticOrder {
    int nM, nwg, G, c;
    __device__ void init(int M, int  , int G_, int c_) { nM = M / BM; nwg = nM * NN; G = G_; c = c_; }
    __device__ __forceinline__ bool next(int i, Unit& u) const {
        u.br = 0;
        const long L = (long)i * G + c; if (L >= nwg) return false;
        int wgid = (int)L; { const int q = nwg >> 3, r = nwg & 7, xcd = wgid & 7, off = wgid >> 3; wgid = (xcd < r ? xcd * (q + 1) : r * (q + 1) + (xcd - r) * q) + off; }
        constexpr int nig = WGM * NN; const int gid = wgid / nig, rem = wgid - gid * nig, fm = gid * WGM, gsz = (nM - fm) < WGM ? (nM - fm) : WGM;
        if (gsz == WGM) { u.pm = fm + (rem & (WGM - 1)); u.pn = rem >> 3; } else { u.pm = fm + (rem % gsz); u.pn = rem / gsz; }
        return true;
    }
};

struct DownOrder {
    StaticOrder<4> lat; int G, c;
    __device__ void init(int G_, int c_) { lat.init(32768, 1024, G_, c_); G = G_; c = c_; }
    __device__ __forceinline__ bool next(int i, Unit& u) const {
        const long L = (long)i * G + c;
        if (L < 512) return lat.next(i, u);
        const int j = (int)L - 512; if (j >= 64) return false;
        const int ct = j >> 2; u.pm = 128 + (ct >> 2); u.pn = ct & 3; u.br = j & 3; return true;
    }
};
struct ProbDown {
    const bf16_t* A; const bf16_t* Bt; int lda, ldb, K;
    __device__ __forceinline__ int nt(const Unit& u) const { return u.pm >= 128 ? 16 : 64; }
    __device__ __forceinline__ int koff(const Unit& u) const { return u.pm >= 128 ? u.br * 1024 : 0; }
    __device__ __forceinline__ const char* a(const Unit& u) const { return (const char*)(A + (size_t)u.pm * BM * lda + koff(u)); }
    __device__ __forceinline__ const char* b(const Unit& u) const { return (const char*)(Bt + (size_t)u.pn * BM * ldb + koff(u)); }
};
template <bool MERGE> struct Prob {
    const bf16_t* A; const bf16_t* Bt; int lda, ldb, K;
    __device__ __forceinline__ int nt(const Unit& u) const { if (MERGE) return u.br == 2 ? 8 : 4; return K / BK; }
    __device__ __forceinline__ int koff(const Unit& u) const { if (MERGE) return u.br * 256; return 0; }
    __device__ __forceinline__ const char* a(const Unit& u) const { return (const char*)(A + (size_t)u.pm * BM * lda + koff(u)); }
    __device__ __forceinline__ const char* b(const Unit& u) const { return (const char*)(Bt + (size_t)u.pn * BM * ldb + koff(u)); }
};

__device__ __forceinline__ unsigned cvt_pk_bf16(float lo, float hi) { unsigned r; asm volatile("v_cvt_pk_bf16_f32 %0, %1, %2" : "=v"(r) : "v"(lo), "v"(hi)); return r; }

template <class Epi, class Sched, class PROB>
__device__ __forceinline__ void gemm_phase(PG8_LAS unsigned char* lds, const PROB P, const Sched& S, const Epi& E, const int tid) {
    const int wid = __builtin_amdgcn_readfirstlane(tid >> 6), lane = tid & 63, wr = wid >> 2, wc = wid & 3, fr = lane & 15, fq = lane >> 4;
    unsigned voffA[2], voffB[2];
#pragma unroll
    for (int i = 0; i < 2; ++i) { int R, C; stage_rc(tid * 16 + i * 8192, R, C); const int Rb = Epi::PERM ? ((R & ~31) + perm32(R & 31)) : R;
        voffA[i] = (unsigned)(R * P.lda + C) * 2u; voffB[i] = (unsigned)(Rb * P.ldb + C) * 2u; }
    const size_t kstep = (size_t)(BK * 2);
    const size_t hstepA = (size_t)HALF * P.lda * 2, hstepB = (size_t)HALF * P.ldb * 2;
    const unsigned ldsw = (unsigned)wid * 1024u;
    const int aoff = lds_byte(wr * 64 + fr, fq * 8), boff = lds_byte(wc * 32 + fr, fq * 8);
#define PG8_SA(b, h) (((b) * 2 + (h)) * HTB)
#define PG8_SB(b, h) ((4 + (b) * 2 + (h)) * HTB)
#define PG8_STAGE(bufoff, gbase, voff) do { _Pragma("unroll") for (int _i = 0; _i < 2; ++_i) \
        __builtin_amdgcn_global_load_lds((const unsigned*)((const char*)(gbase) + (voff)[_i]), (PG8_LAS unsigned*)(lds + (bufoff) + ldsw + _i * 8192), 16, 0, 0); } while (0)
#define PG8_LDA(dst, b, h) do { _Pragma("unroll") for (int m = 0; m < 4; ++m) _Pragma("unroll") for (int k = 0; k < 2; ++k) dst[m][k] = *(const PG8_LAS bf16x8*)(lds + PG8_SA(b, h) + aoff + m * 2048 + k * 1024); } while (0)
#define PG8_LDB(dst, b, h) do { _Pragma("unroll") for (int n = 0; n < 2; ++n) _Pragma("unroll") for (int k = 0; k < 2; ++k) dst[n][k] = *(const PG8_LAS bf16x8*)(lds + PG8_SB(b, h) + boff + n * 2048 + k * 1024); } while (0)
#define PG8_MMA(ai, bj, At, Bt) do { __builtin_amdgcn_s_setprio(1); _Pragma("unroll") for (int m = 0; m < 4; ++m) _Pragma("unroll") for (int n = 0; n < 2; ++n) _Pragma("unroll") for (int k = 0; k < 2; ++k) \
        acc[ai][bj][m][n] = __builtin_amdgcn_mfma_f32_16x16x32_bf16(Bt[n][k], At[m][k], acc[ai][bj][m][n], 0, 0, 0); __builtin_amdgcn_s_setprio(0); } while (0)
#define PG8_WAIT_V(n) asm volatile("s_waitcnt vmcnt(" #n ")" ::: "memory")
#define PG8_WAIT_L(n) asm volatile("s_waitcnt lgkmcnt(" #n ")" ::: "memory")
#define PG8_BAR __builtin_amdgcn_s_barrier()
#define PG8_WAIT_SEL1(N) asm volatile("s_waitcnt vmcnt(" #N ")\n\tv_cmp_ne_u32_e32 vcc, 0, %0\n\ts_cbranch_vccnz .Lpg8w%=\n\ts_waitcnt vmcnt(8)\n.Lpg8w%=:" :: "v"(fst) : "memory", "vcc")
#define PG8_WAIT_SEL(NF16, NF32) do { if (Epi::NST == 16) PG8_WAIT_SEL1(NF16); else PG8_WAIT_SEL1(NF32); } while (0)
#define PG8_SCHED __builtin_amdgcn_sched_barrier(0)
    Unit cur, nxt; int ui = 0;
    if (!S.next(0, cur)) return;
    f32x4 acc[2][2][4][2];
#pragma unroll
    for (int a = 0; a < 2; ++a)
#pragma unroll
        for (int b = 0; b < 2; ++b)
#pragma unroll
            for (int m = 0; m < 4; ++m)
#pragma unroll
                for (int n = 0; n < 2; ++n) acc[a][b][m][n] = (f32x4){0.f, 0.f, 0.f, 0.f};
    bf16x8 At[4][2], B0[2][2], B1[2][2];
    const char* cA = P.a(cur); const char* cB = P.b(cur);
    PG8_STAGE(PG8_SB(0, 0), cB, voffB); PG8_STAGE(PG8_SB(0, 1), cB + hstepB, voffB); PG8_STAGE(PG8_SA(0, 0), cA, voffA); PG8_STAGE(PG8_SA(0, 1), cA + hstepA, voffA);
    if (wr == 1) PG8_BAR;
    PG8_WAIT_V(2); PG8_BAR;
    PG8_STAGE(PG8_SB(1, 0), cB + kstep, voffB); PG8_STAGE(PG8_SA(1, 0), cA + kstep, voffA); PG8_STAGE(PG8_SB(1, 1), cB + hstepB + kstep, voffB);
    PG8_WAIT_V(6); PG8_BAR;
    for (;;) {
        const bool has_next = S.next(ui + 1, nxt);
        const char* nA = has_next ? P.a(nxt) : cA; const char* nB = has_next ? P.b(nxt) : cB;
        const int nt = P.nt(cur);
        for (int t = 0; t < nt; t += 2) {
            const bool last = (t == nt - 2); const int fst = (t == 0 && ui > 0) ? 1 : 0;
            if constexpr (Epi::HOOKS) { if (t == 4 || t == 8) E.hook(acc, cur, t, wr, wc, fr, fq); }
            const char* a1 = cA + (size_t)(t + 1) * kstep;
            const char* a2 = last ? nA : cA + (size_t)(t + 2) * kstep; const char* b2 = last ? nB : cB + (size_t)(t + 2) * kstep;
            const char* a3 = a2 + kstep; const char* b3 = b2 + kstep;
            PG8_LDB(B0, 0, 0); PG8_LDB(B1, 0, 1); PG8_SCHED; PG8_LDA(At, 0, 0); PG8_STAGE(PG8_SA(1, 1), a1 + hstepA, voffA);
            PG8_WAIT_SEL(18, 34); PG8_WAIT_L(0); PG8_BAR; PG8_MMA(0, 0, At, B0); PG8_MMA(0, 1, At, B1); PG8_BAR; PG8_SCHED;
            PG8_LDA(At, 0, 1); PG8_STAGE(PG8_SB(0, 0), b2, voffB); PG8_STAGE(PG8_SB(0, 1), b2 + hstepB, voffB); PG8_STAGE(PG8_SA(0, 0), a2, voffA);
            PG8_WAIT_SEL(24, 40); PG8_WAIT_L(0); PG8_BAR; PG8_MMA(1, 0, At, B0); PG8_MMA(1, 1, At, B1); PG8_BAR; PG8_SCHED;
            PG8_LDB(B0, 1, 0); PG8_LDB(B1, 1, 1); PG8_SCHED; PG8_LDA(At, 1, 0); PG8_STAGE(PG8_SA(0, 1), a2 + hstepA, voffA);
            PG8_WAIT_SEL(26, 42); PG8_WAIT_L(0); PG8_BAR; PG8_MMA(0, 0, At, B0); PG8_MMA(0, 1, At, B1); PG8_BAR; PG8_SCHED;
            PG8_LDA(At, 1, 1); PG8_STAGE(PG8_SB(1, 0), b3, voffB); PG8_STAGE(PG8_SB(1, 1), b3 + hstepB, voffB); PG8_STAGE(PG8_SA(1, 0), a3, voffA);
            PG8_WAIT_V(8); PG8_WAIT_L(0); PG8_BAR; PG8_MMA(1, 0, At, B0); PG8_MMA(1, 1, At, B1); PG8_BAR; PG8_SCHED;
        }
        if (wr == 0) PG8_BAR;
        E(acc, cur, wr, wc, fr, fq);
        if (!has_next) break;
#pragma unroll
        for (int a = 0; a < 2; ++a)
#pragma unroll
            for (int b = 0; b < 2; ++b)
#pragma unroll
                for (int m = 0; m < 4; ++m)
#pragma unroll
                    for (int n = 0; n < 2; ++n) acc[a][b][m][n] = (f32x4){0.f, 0.f, 0.f, 0.f};
        cur = nxt; cA = nA; cB = nB; ++ui;
        if (wr == 1) PG8_BAR;
    }
    PG8_WAIT_V(0);
    PG8_BAR;
#undef PG8_SA
#undef PG8_SB
#undef PG8_STAGE
#undef PG8_LDA
#undef PG8_LDB
#undef PG8_MMA
#undef PG8_WAIT_V
#undef PG8_WAIT_L
#undef PG8_BAR
#undef PG8_WAIT_SEL
#undef PG8_WAIT_SEL1
#undef PG8_SCHED
}
}

constexpr int NWAVES = 8, NTHR = 512;
constexpr int DM = 1024, NB = 4, SEQ = 8192, ML = NB * SEQ, CTXL = 256, MC = NB * CTXL, MT = ML + MC;
constexpr int NIN_ORIG = 5632, NPXA = 2816, NPXG = 3072, NIN = NPXA + NPXG;
constexpr int OFF_P = 0, OFF_Q = 256, OFF_CU = 512, OFF_CB = 768, OFF_CC = 1024, OFF_QQ = 1280, OFF_K = 1792, OFF_V = 2304;
constexpr int FF = 4096, NMOD = 6 * DM, NGRP = 5;
constexpr float EPS = 1e-6f;

constexpr size_t MiB = 1u << 20;
constexpr size_t WS_CTL = 0, CTL_ZERO_BYTES = 2 * MiB;
constexpr size_t WS_RS = 262144;
constexpr size_t WS_FCNT = 1441792;
constexpr size_t WS_ZERO = 1572864;
constexpr size_t WS_RS5 = 1703936;
constexpr size_t WS_TW = 2 * MiB;
constexpr size_t WS_MOD = 2 * MiB + 65536;
constexpr size_t WS_GN = 2 * MiB + 524288;
constexpr size_t WS_CIN = 2 * MiB + 786432;
constexpr size_t WS_CUP = 3 * MiB;
constexpr size_t WS_MODP = 510 * MiB;
constexpr size_t WS_CTXX = 4 * MiB;
constexpr size_t WS_WIN = 8 * MiB, WS_WM = 20 * MiB, WS_WO = 22 * MiB, WS_W1 = 24 * MiB, WS_W2 = 32 * MiB;
constexpr size_t WS_HX = 40 * MiB;
constexpr size_t WS_PXA = 106 * MiB;
constexpr size_t WS_PXG = 288 * MiB;
constexpr size_t WS_TB = 486 * MiB;
constexpr size_t WS_M = WS_PXA;
constexpr size_t WS_ACT = WS_PXA;
constexpr size_t WS_PART = 400 * MiB;
constexpr size_t WS_END = 512 * MiB;
static_assert(WS_PXA + (size_t)MT * NPXA * 2 <= WS_PXG && WS_PXG + (size_t)MT * NPXG * 2 <= WS_TB && WS_ACT + (size_t)MT * FF * 2 <= WS_TB && WS_HX + (size_t)MT * DM * 2 <= WS_PXA, "ws map");
constexpr int CW_TMO = 0, CW_BAR = 4096;

constexpr int RING_BYTES = 131072, LDSCTL_OFF = 155648, MISC_OFF = LDSCTL_OFF + 320, LDS_BYTES = 163840;

#define GAS __attribute__((address_space(1)))
#define LAS __attribute__((address_space(3)))
typedef unsigned short bf16;
typedef unsigned v4u __attribute__((ext_vector_type(4)));
typedef unsigned v2u __attribute__((ext_vector_type(2)));
typedef float f32x4 __attribute__((ext_vector_type(4)));
typedef GAS unsigned gu32;
#define RLX_AGENT __ATOMIC_RELAXED, __HIP_MEMORY_SCOPE_AGENT
#define LDS_WAIT() asm volatile("s_waitcnt lgkmcnt(0)" ::: "memory")
__device__ __forceinline__ unsigned f2bf(float f) { unsigned u = __builtin_bit_cast(unsigned, f); return (u + 0x7fffu + ((u >> 16) & 1u)) >> 16; }
__device__ __forceinline__ unsigned pk2(float lo, float hi) { return f2bf(lo) | (f2bf(hi) << 16); }
__device__ __forceinline__ float bf2f(unsigned h) { return __uint_as_float(h << 16); }
__device__ __forceinline__ float bflo(unsigned w) { return __uint_as_float(w << 16); }
__device__ __forceinline__ float bfhi(unsigned w) { return __uint_as_float(w & 0xffff0000u); }

#define XB_TMO      128
#define XB_XCNT(j)  (256  + 64 * (j))
#define XB_XSUB(j)  (1280 + 64 * (j))
#define XB_XGEN(j)  (2304 + 64 * (j))
#define XB_TOP      3328
#define XB_TOPGEN   3392
#define XCD_BAR_WORDS 3456
#define XB_SPIN_CAP (1u << 22)
__device__ __forceinline__ unsigned xb_ld(unsigned* p)              { return __hip_atomic_load(p, __ATOMIC_RELAXED, __HIP_MEMORY_SCOPE_AGENT); }
__device__ __forceinline__ unsigned xb_add(unsigned* p, unsigned v) { return __hip_atomic_fetch_add(p, v, __ATOMIC_RELAXED, __HIP_MEMORY_SCOPE_AGENT); }
__device__ __forceinline__ unsigned xb_xcc_id() { return (unsigned)__builtin_amdgcn_s_getreg((3 << 11) | 20) & 0xFu; }
#define XB_SPIN(cond, bar) do { unsigned _sp = 0; while (cond) { __builtin_amdgcn_s_sleep(1); \
    if ((++_sp & 255u) == 0u) { if (xb_ld(&(bar)[XB_TMO])) break; if (_sp > XB_SPIN_CAP) { atomicAdd(&(bar)[XB_TMO], 1u); break; } } } } while (0)
struct XcdBarrier { unsigned* bar; unsigned x; volatile LAS unsigned* st; };
__device__ __forceinline__ XcdBarrier xcd_barrier_post(unsigned* bar, volatile LAS unsigned* st, bool leader) {
    XcdBarrier b; b.bar = bar; b.x = xb_xcc_id(); b.st = st;
    if (leader) { const unsigned rank = xb_add(&bar[XB_XCNT(b.x)], 1u); st[2] = rank; }
    return b;
}
__device__ __forceinline__ void xcd_barrier_complete(unsigned* bar, unsigned x, unsigned& nloc, unsigned& nx) {
    const unsigned G = gridDim.x * gridDim.y * gridDim.z;
    unsigned sum, cnt, mine, sp = 0u;
    for (;;) {
        sum = 0u; cnt = 0u; mine = 0u;
#pragma unroll
        for (unsigned j = 0; j < 16; ++j) { const unsigned c = xb_ld(&bar[XB_XCNT(j)]); sum += c; cnt += (c > 0u) ? 1u : 0u; mine = (j == x) ? c : mine; }
        if (sum == G) break;
        __builtin_amdgcn_s_sleep(1);
        if ((++sp & 255u) == 0u) { if (xb_ld(&bar[XB_TMO])) break; if (sp > XB_SPIN_CAP) { atomicAdd(&bar[XB_TMO], 1u); break; } }
    }
    nloc = mine > 0u ? mine : 1u; nx = cnt > 0u ? cnt : 1u;
}
__device__ __forceinline__ void xcd_barrier(const XcdBarrier& b, bool leader) {
    asm volatile("s_waitcnt vmcnt(0)" ::: "memory");
    __syncthreads();
    if (leader) {
        unsigned* bar = b.bar;
        __builtin_amdgcn_s_waitcnt(0);
        unsigned nloc = b.st[0], nx = b.st[1];
        if (nloc == 0u) { xcd_barrier_complete(bar, b.x, nloc, nx); b.st[0] = nloc; b.st[1] = nx; }
        const unsigned old = xb_add(&bar[XB_XSUB(b.x)], 1u);
        const unsigned gen = old / nloc;
        if (old + 1u == (gen + 1u) * nloc) {
            __builtin_amdgcn_fence(__ATOMIC_RELEASE, "agent");
            asm volatile("s_waitcnt vmcnt(0)" ::: "memory");
            const unsigned og = xb_add(&bar[XB_TOP], 1u);
            const unsigned tg = og / nx;
            if (og + 1u == (tg + 1u) * nx) xb_add(&bar[XB_TOPGEN], 1u);
            else XB_SPIN(xb_ld(&bar[XB_TOPGEN]) == tg, bar);
            __builtin_amdgcn_fence(__ATOMIC_ACQUIRE, "agent");
            xb_add(&bar[XB_XGEN(b.x)], 1u);
            asm volatile("s_waitcnt vmcnt(0)" ::: "memory");
        } else {
            XB_SPIN(xb_ld(&bar[XB_XGEN(b.x)]) == gen, bar);
            __builtin_amdgcn_fence(__ATOMIC_ACQUIRE, "agent");
            asm volatile("s_waitcnt vmcnt(0)" ::: "memory");
        }
    }
    __syncthreads();
}

__device__ __forceinline__ float wave_sum(float v) {
#pragma unroll
    for (int o = 1; o < 64; o <<= 1) v += __shfl_xor(v, o);
    return v;
}
__device__ __forceinline__ float wave_max(float v) {
#pragma unroll
    for (int o = 1; o < 64; o <<= 1) v = fmaxf(v, __shfl_xor(v, o));
    return v;
}

__device__ __forceinline__ void transpose_item(const float* W, int ldw, int ncols, bf16* WT, int ldwt, int row_off, int k_off, LAS float* scr, int item, int lane) {
    const int nblk = ncols / 32, kb = item / nblk, nb = item % nblk, k0 = 64 * kb, n0 = 32 * nb;
#pragma unroll 8
    for (int i = 0; i < 32; ++i) { const int kk = 2 * i + (lane >> 5); scr[kk * 33 + (lane & 31)] = W[(size_t)(k0 + kk) * ldw + n0 + (lane & 31)]; }
    LDS_WAIT(); asm volatile("" ::: "memory");
    const int c = lane & 7;
#pragma unroll
    for (int j = 0; j < 4; ++j) { const int n = (lane >> 3) + 8 * j; const LAS float* s = scr + (8 * c) * 33 + n;
        v4u o; o.x = pk2(s[0 * 33], s[1 * 33]); o.y = pk2(s[2 * 33], s[3 * 33]); o.z = pk2(s[4 * 33], s[5 * 33]); o.w = pk2(s[6 * 33], s[7 * 33]);
        *(v4u*)(WT + (size_t)(row_off + n0 + n) * ldwt + k_off + k0 + 8 * c) = o; }
    LDS_WAIT(); asm volatile("" ::: "memory");
}

using pg8::Unit; using pg8::cvt_pk_bf16;
typedef unsigned long long u64;
__device__ __forceinline__ float rs_to_rstd(u64 q) { return __builtin_amdgcn_rsqf((float)q * (1.0f / (16777216.0f * DM)) + EPS); }
struct EpiIn {
    static constexpr bool PERM = true, HOOKS = false; static constexpr int NST = 16;
    bf16* pxa; bf16* pxg; const u64* rs; const float* cin;
    __device__ __forceinline__ void operator()(const f32x4 (&acc)[2][2][4][2], const Unit& u, int wr, int wc, int fr, int fq) const {
        asm volatile("" : "+v"(fr), "+v"(fq));
        const bool gate = u.pn >= 11; bf16* base = gate ? pxg : pxa; const int ldc = gate ? NPXG : NPXA; const int colt = (gate ? u.pn - 11 : u.pn) * 256;
        const int grp = u.pm >= 128 ? 4 : (u.pm >> 5);
        const int row0 = u.pm * 256 + wr * 64 + fr, col0 = colt + wc * 32 + 8 * fq;
        const float* cp = cin + grp * NIN + u.pn * 256 + wc * 32 + 8 * fq;
        const float gsc = gate ? -1.4426950408889634f : 1.0f;
        f32x4 cv[2][2];
#pragma unroll
        for (int bj = 0; bj < 2; ++bj) { cv[bj][0] = *(const f32x4*)(cp + bj * 128) * gsc; cv[bj][1] = *(const f32x4*)(cp + bj * 128 + 4) * gsc; }
        u64 rq[2][4]; float rsv[2][4];
#pragma unroll
        for (int ai = 0; ai < 2; ++ai)
#pragma unroll
            for (int m = 0; m < 4; ++m) rq[ai][m] = rs[row0 + ai * 128 + m * 16];
        asm volatile("" ::: "memory");
#pragma unroll
        for (int ai = 0; ai < 2; ++ai)
#pragma unroll
            for (int m = 0; m < 4; ++m) rsv[ai][m] = rs_to_rstd(rq[ai][m]) * gsc;
#pragma unroll
        for (int ai = 0; ai < 2; ++ai)
#pragma unroll
            for (int m = 0; m < 4; ++m) { const int row = row0 + ai * 128 + m * 16; bf16* rowp = base + (size_t)row * ldc + col0; const float rstd = rsv[ai][m];
#pragma unroll
                for (int bj = 0; bj < 2; ++bj) { f32x4 v0 = acc[ai][bj][m][0] * rstd + cv[bj][0], v1 = acc[ai][bj][m][1] * rstd + cv[bj][1];
                    if (gate) {
#pragma unroll
                        for (int e = 0; e < 4; ++e) { v0[e] = 1.0f + __builtin_amdgcn_exp2f(__builtin_amdgcn_fmed3f(v0[e], -120.0f, 120.0f)); v1[e] = 1.0f + __builtin_amdgcn_exp2f(__builtin_amdgcn_fmed3f(v1[e], -120.0f, 120.0f)); } }
                    v4u w; w.x = cvt_pk_bf16(v0[0], v0[1]); w.y = cvt_pk_bf16(v0[2], v0[3]); w.z = cvt_pk_bf16(v1[0], v1[1]); w.w = cvt_pk_bf16(v1[2], v1[3]);
                    *(v4u*)(rowp + bj * 128) = w; } }
    }
};
struct EpiMerge {
    static constexpr bool PERM = true, HOOKS = true; static constexpr int NST = 16;
    bf16* m; const bf16* pxg;
    __device__ __forceinline__ void hook(f32x4 (&acc)[2][2][4][2], const Unit& u, int t, int wr, int wc, int fr, int fq) const {
        asm volatile("" : "+v"(fr), "+v"(fq));
        const int row0 = u.pm * 256 + wr * 64 + fr, col0 = u.pn * 256 + wc * 32 + 8 * fq;
        const bf16* gnum = pxg + (t == 4 ? 0 : 1024) + col0; const bf16* gden = gnum + 1024;
#pragma unroll
        for (int ai = 0; ai < 2; ++ai)
#pragma unroll
            for (int mp = 0; mp < 2; ++mp) {
                v4u gn[2][2], gd[2][2];
#pragma unroll
                for (int mq = 0; mq < 2; ++mq)
#pragma unroll
                    for (int bj = 0; bj < 2; ++bj) { const size_t ro = (size_t)(row0 + ai * 128 + (2 * mp + mq) * 16) * NPXG + bj * 128; gn[mq][bj] = *(const v4u*)(gnum + ro); gd[mq][bj] = *(const v4u*)(gden + ro); }
                asm volatile("" ::: "memory");
#pragma unroll
                for (int mq = 0; mq < 2; ++mq)
#pragma unroll
                    for (int bj = 0; bj < 2; ++bj) { const v4u a = gn[mq][bj], d = gd[mq][bj];
                        f32x4& v0 = acc[ai][bj][2 * mp + mq][0]; f32x4& v1 = acc[ai][bj][2 * mp + mq][1];
                        v0[0] *= bflo(d.x) * __builtin_amdgcn_rcpf(bflo(a.x)); v0[1] *= bfhi(d.x) * __builtin_amdgcn_rcpf(bfhi(a.x));
                        v0[2] *= bflo(d.y) * __builtin_amdgcn_rcpf(bflo(a.y)); v0[3] *= bfhi(d.y) * __builtin_amdgcn_rcpf(bfhi(a.y));
                        v1[0] *= bflo(d.z) * __builtin_amdgcn_rcpf(bflo(a.z)); v1[1] *= bfhi(d.z) * __builtin_amdgcn_rcpf(bfhi(a.z));
                        v1[2] *= bflo(d.w) * __builtin_amdgcn_rcpf(bflo(a.w)); v1[3] *= bfhi(d.w) * __builtin_amdgcn_rcpf(bfhi(a.w)); }
            }
    }
    __device__ __forceinline__ void operator()(const f32x4 (&acc)[2][2][4][2], const Unit& u, int wr, int wc, int fr, int fq) const {
        asm volatile("" : "+v"(fr), "+v"(fq));
        const int row0 = u.pm * 256 + wr * 64 + fr, col0 = u.pn * 256 + wc * 32 + 8 * fq;
#pragma unroll
        for (int ai = 0; ai < 2; ++ai) {
            v4u g[4][2];
#pragma unroll
            for (int mm = 0; mm < 4; ++mm)
#pragma unroll
                for (int bj = 0; bj < 2; ++bj) g[mm][bj] = *(const v4u*)(pxg + (size_t)(row0 + ai * 128 + mm * 16) * NPXG + 2048 + col0 + bj * 128);
            asm volatile("" ::: "memory");
#pragma unroll
            for (int mm = 0; mm < 4; ++mm)
#pragma unroll
                for (int bj = 0; bj < 2; ++bj) { const f32x4 v0 = acc[ai][bj][mm][0], v1 = acc[ai][bj][mm][1]; const v4u gg = g[mm][bj];
#define RC(x) __builtin_amdgcn_rcpf(x)
                    v4u w; w.x = cvt_pk_bf16(v0[0] * RC(bflo(gg.x)), v0[1] * RC(bfhi(gg.x))); w.y = cvt_pk_bf16(v0[2] * RC(bflo(gg.y)), v0[3] * RC(bfhi(gg.y)));
                    w.z = cvt_pk_bf16(v1[0] * RC(bflo(gg.z)), v1[1] * RC(bfhi(gg.z))); w.w = cvt_pk_bf16(v1[2] * RC(bflo(gg.w)), v1[3] * RC(bfhi(gg.w)));
#undef RC
                    *(v4u*)(m + (size_t)(row0 + ai * 128 + mm * 16) * DM + col0 + bj * 128) = w; }
        }
    }
};
struct EpiRes {
    static constexpr bool PERM = true, HOOKS = false; static constexpr int NST = 32;
    const float* base_l; const float* base_c; float* out_l; float* out_c; const float* gate;
    float* part;
    const float* gn; bf16* ap; u64* rs;
    __device__ __forceinline__ void operator()(const f32x4 (&acc)[2][2][4][2], const Unit& u, int wr, int wc, int fr, int fq) const {
        asm volatile("" : "+v"(fr), "+v"(fq));
        const bool isc = u.pm >= 128; const int grp = isc ? 4 : (u.pm >> 5);
        const float* base = isc ? base_c : base_l; float* out = isc ? out_c : out_l;
        const int row0 = (isc ? (u.pm - 128) : u.pm) * 256 + wr * 64 + fr, col0 = u.pn * 256 + wc * 32 + 8 * fq;
        if (part != nullptr && isc) {
            float* po = part + (size_t)u.br * 1024 * 1024;
#pragma unroll
            for (int ai = 0; ai < 2; ++ai)
#pragma unroll
                for (int m = 0; m < 4; ++m)
#pragma unroll
                    for (int bj = 0; bj < 2; ++bj)
#pragma unroll
                        for (int n = 0; n < 2; ++n) *(f32x4*)(po + (size_t)(row0 + ai * 128 + m * 16) * DM + col0 + bj * 128 + n * 4) = acc[ai][bj][m][n];
            return;
        }
        f32x4 gv[2][2], gnv[2][2];
#pragma unroll
        for (int bj = 0; bj < 2; ++bj)
#pragma unroll
            for (int n = 0; n < 2; ++n) { gv[bj][n] = *(const f32x4*)(gate + grp * NMOD + col0 + bj * 128 + n * 4);
                gnv[bj][n] = gn ? *(const f32x4*)(gn + grp * DM + col0 + bj * 128 + n * 4) : (f32x4){0.f, 0.f, 0.f, 0.f}; }
        const int arow0 = u.pm * 256 + wr * 64 + fr;
#pragma unroll
        for (int ai = 0; ai < 2; ++ai)
#pragma unroll
            for (int mp = 0; mp < 2; ++mp) {
                f32x4 bs[2][2][2];
#pragma unroll
                for (int mq = 0; mq < 2; ++mq)
#pragma unroll
                    for (int bj = 0; bj < 2; ++bj)
#pragma unroll
                        for (int n = 0; n < 2; ++n) bs[mq][bj][n] = *(const f32x4*)(base + (size_t)(row0 + ai * 128 + (2 * mp + mq) * 16) * DM + col0 + bj * 128 + n * 4);
                asm volatile("" ::: "memory");
#pragma unroll
                for (int mq = 0; mq < 2; ++mq) { const int m = 2 * mp + mq; float ss = 0.f;
#pragma unroll
                    for (int bj = 0; bj < 2; ++bj) {
                        const f32x4 o0 = bs[mq][bj][0] + gv[bj][0] * acc[ai][bj][m][0], o1 = bs[mq][bj][1] + gv[bj][1] * acc[ai][bj][m][1];
                        float* op = out + (size_t)(row0 + ai * 128 + m * 16) * DM + col0 + bj * 128;
                        *(f32x4*)op = o0; *(f32x4*)(op + 4) = o1;
                        if (gn) { const f32x4 y0 = o0 * gnv[bj][0], y1 = o1 * gnv[bj][1];
                            v4u w; w.x = cvt_pk_bf16(y0[0], y0[1]); w.y = cvt_pk_bf16(y0[2], y0[3]); w.z = cvt_pk_bf16(y1[0], y1[1]); w.w = cvt_pk_bf16(y1[2], y1[3]);
                            *(v4u*)(ap + (size_t)(arow0 + ai * 128 + m * 16) * DM + col0 + bj * 128) = w;
                            ss += ((o0[0] * o0[0] + o0[1] * o0[1]) + (o0[2] * o0[2] + o0[3] * o0[3])) + ((o1[0] * o1[0] + o1[1] * o1[1]) + (o1[2] * o1[2] + o1[3] * o1[3])); } }
                    if (gn) { ss += __shfl_xor(ss, 16); ss += __shfl_xor(ss, 32);
                        if (fq == 0) __hip_atomic_fetch_add(rs + arow0 + ai * 128 + m * 16, (u64)(ss * 16777216.0f + 0.5f), __ATOMIC_RELAXED, __HIP_MEMORY_SCOPE_AGENT); } }
            }
    }
};
struct EpiResFinal {
    static constexpr bool PERM = true, HOOKS = false; static constexpr int NST = 32;
    float* xo; const float* gate; const float* fg; u64* rs; unsigned* cnt; unsigned* tmo;
    __device__ __forceinline__ void operator()(f32x4 (&acc)[2][2][4][2], const Unit& u, int wr, int wc, int fr, int fq) const {
        asm volatile("" : "+v"(fr), "+v"(fq));
        const int grp = u.pm >> 5, row0 = u.pm * 256 + wr * 64 + fr, col0 = u.pn * 256 + wc * 32 + 8 * fq;
        f32x4 gv[2][2];
#pragma unroll
        for (int bj = 0; bj < 2; ++bj)
#pragma unroll
            for (int n = 0; n < 2; ++n) gv[bj][n] = *(const f32x4*)(gate + grp * NMOD + col0 + bj * 128 + n * 4);
#pragma unroll
        for (int ai = 0; ai < 2; ++ai)
#pragma unroll
            for (int mp = 0; mp < 2; ++mp) {
                f32x4 bs[2][2][2];
#pragma unroll
                for (int mq = 0; mq < 2; ++mq)
#pragma unroll
                    for (int bj = 0; bj < 2; ++bj)
#pragma unroll
                        for (int n = 0; n < 2; ++n) bs[mq][bj][n] = *(const f32x4*)(xo + (size_t)(row0 + ai * 128 + (2 * mp + mq) * 16) * DM + col0 + bj * 128 + n * 4);
                asm volatile("" ::: "memory");
#pragma unroll
                for (int mq = 0; mq < 2; ++mq) { const int m = 2 * mp + mq; float ss = 0.f;
#pragma unroll
                    for (int bj = 0; bj < 2; ++bj)
#pragma unroll
                        for (int n = 0; n < 2; ++n) { const f32x4 o = bs[mq][bj][n] + gv[bj][n] * acc[ai][bj][m][n]; acc[ai][bj][m][n] = o; ss += (o[0] * o[0] + o[1] * o[1]) + (o[2] * o[2] + o[3] * o[3]); }
                    ss += __shfl_xor(ss, 16); ss += __shfl_xor(ss, 32);
                    if (fq == 0) __hip_atomic_fetch_add(rs + row0 + ai * 128 + m * 16, (u64)(ss * 16777216.0f + 0.5f), __ATOMIC_RELAXED, __HIP_MEMORY_SCOPE_AGENT); }
            }
        asm volatile("s_waitcnt vmcnt(0)" ::: "memory");
        unsigned* pc = cnt + 64 * u.pm;
        if (__builtin_amdgcn_mbcnt_hi(~0u, __builtin_amdgcn_mbcnt_lo(~0u, 0u)) == 0) __hip_atomic_fetch_add(pc, 1u, __ATOMIC_RELAXED, __HIP_MEMORY_SCOPE_AGENT);
        { unsigned spins = 0;
          while ((unsigned)__builtin_amdgcn_readfirstlane(__hip_atomic_load(pc, __ATOMIC_RELAXED, __HIP_MEMORY_SCOPE_AGENT)) < 32u) {
              __builtin_amdgcn_s_sleep(2);
              if (++spins > (1u << 22)) { __hip_atomic_store(tmo, 1u, __ATOMIC_RELAXED, __HIP_MEMORY_SCOPE_AGENT); break; } } }
        f32x4 fgv[2][2];
#pragma unroll
        for (int bj = 0; bj < 2; ++bj)
#pragma unroll
            for (int n = 0; n < 2; ++n) fgv[bj][n] = *(const f32x4*)(fg + col0 + bj * 128 + n * 4);
#pragma unroll
        for (int ai = 0; ai < 2; ++ai)
#pragma unroll
            for (int m = 0; m < 4; ++m) { const int row = row0 + ai * 128 + m * 16;
                const float rstd = rs_to_rstd(__hip_atomic_load(rs + row, __ATOMIC_RELAXED, __HIP_MEMORY_SCOPE_AGENT));
#pragma unroll
                for (int bj = 0; bj < 2; ++bj)
#pragma unroll
                    for (int n = 0; n < 2; ++n) *(f32x4*)(xo + (size_t)row * DM + col0 + bj * 128 + n * 4) = acc[ai][bj][m][n] * rstd * fgv[bj][n]; }
    }
};
struct EpiAct {
    static constexpr bool PERM = true, HOOKS = false; static constexpr int NST = 16;
    bf16* a; const u64* rs; const float* cup;
    __device__ __forceinline__ void operator()(const f32x4 (&acc)[2][2][4][2], const Unit& u, int wr, int wc, int fr, int fq) const {
        asm volatile("" : "+v"(fr), "+v"(fq));
        const int grp = u.pm >= 128 ? 4 : (u.pm >> 5);
        const int row0 = u.pm * 256 + wr * 64 + fr, col0 = u.pn * 256 + wc * 32 + 8 * fq;
        const float* cp = cup + grp * FF + col0;
        f32x4 cv[2][2];
#pragma unroll
        for (int bj = 0; bj < 2; ++bj) { cv[bj][0] = *(const f32x4*)(cp + bj * 128); cv[bj][1] = *(const f32x4*)(cp + bj * 128 + 4); }
        u64 rq[2][4]; float rsv[2][4];
#pragma unroll
        for (int ai = 0; ai < 2; ++ai)
#pragma unroll
            for (int m = 0; m < 4; ++m) rq[ai][m] = rs[row0 + ai * 128 + m * 16];
        asm volatile("" ::: "memory");
#pragma unroll
        for (int ai = 0; ai < 2; ++ai)
#pragma unroll
            for (int m = 0; m < 4; ++m) rsv[ai][m] = rs_to_rstd(rq[ai][m]);
#pragma unroll
        for (int ai = 0; ai < 2; ++ai)
#pragma unroll
            for (int m = 0; m < 4; ++m) { const int row = row0 + ai * 128 + m * 16; bf16* rowp = a + (size_t)row * FF + col0; const float rstd = rsv[ai][m];
#pragma unroll
                for (int bj = 0; bj < 2; ++bj) { f32x4 v0 = acc[ai][bj][m][0] * rstd + cv[bj][0], v1 = acc[ai][bj][m][1] * rstd + cv[bj][1];
#pragma unroll
                    for (int e = 0; e < 4; ++e) { const float r0 = fmaxf(v0[e], 0.f), r1 = fmaxf(v1[e], 0.f); v0[e] = r0 * r0; v1[e] = r1 * r1; }
                    v4u w; w.x = cvt_pk_bf16(v0[0], v0[1]); w.y = cvt_pk_bf16(v0[2], v0[3]); w.z = cvt_pk_bf16(v1[0], v1[1]); w.w = cvt_pk_bf16(v1[2], v1[3]);
                    *(v4u*)(rowp + bj * 128) = w; } }
    }
};

constexpr int NS = 8;
constexpr int NSTEPS = 2 + 2 * NS;
constexpr int LARGS_OFF = LDSCTL_OFF + 1024;
enum { A_X = 0, A_C, A_CTX, A_CCTX, A_ADAW, A_ADAB, A_N1G, A_N2G, A_WIN, A_CONVW, A_RELB, A_WF, A_WC, A_WA, A_WO, A_W1, A_W2, A_FG, A_OUT, A_WS, A_NARGS };

struct Ctx { LAS unsigned char* lds; int wave, G, bx, gw, NGW, NGT;
    __device__ __forceinline__ int lane() const { int l; asm volatile("v_mbcnt_lo_u32_b32 %0, -1, 0\n\tv_mbcnt_hi_u32_b32 %0, -1, %0" : "=v"(l)); return l; }
    __device__ __forceinline__ int tid() const { return wave * 64 + lane(); }
    __device__ __forceinline__ int gt() const { return bx * NTHR + tid(); }
};
template <int I> __device__ __forceinline__ unsigned long long ldarg_t() {
    unsigned long long v; unsigned tmp;
    asm volatile("v_mov_b32 %1, %2\n\tds_read_b64 %0, %1 offset:%3\n\ts_waitcnt lgkmcnt(0)" : "=&v"(v), "=&v"(tmp) : "i"(LARGS_OFF), "i"(I * 8) : "memory");
    const unsigned lo = __builtin_amdgcn_readfirstlane((unsigned)v), hi = __builtin_amdgcn_readfirstlane((unsigned)(v >> 32));
    return ((unsigned long long)hi << 32) | lo;
}
#define ldarg(C, i) ldarg_t<(i)>()
#define ARGF(i) ((const float*)(const GAS float*)ldarg(C, (i)))
#define WSP(T, off) ((T*)(GAS T*)((GAS unsigned char*)ldarg(C, A_WS) + (off)))

__device__ __forceinline__ void ph_mod_partial(const Ctx& C) {
    const float* cvec = ARGF(A_C); const float* cctx = ARGF(A_CCTX); const float* ada_w = ARGF(A_ADAW);
    float* modp = WSP(float, WS_MODP); float2* tw = WSP(float2, WS_TW);
    LAS float* sl = (LAS float*)C.lds;
    for (int item = C.bx; item < 2 * 8 * 12; item += C.G) {
        const int l = item / 96, rem = item % 96, kc = rem / 12, jb = rem % 12;
        __syncthreads();
        for (int e = C.tid(); e < 5 * 128; e += NTHR) { const int g = e >> 7, k = kc * 128 + (e & 127); const float v = g < 4 ? cvec[g * DM + k] : cctx[k]; sl[e] = v / (1.0f + __expf(-v)); }
        __syncthreads();
        const int j = jb * 512 + C.tid(); float a0 = 0.f, a1 = 0.f, a2 = 0.f, a3 = 0.f, a4 = 0.f;
        const float* wp = ada_w + ((size_t)l * DM + kc * 128) * NMOD + j;
#pragma unroll 4
        for (int k = 0; k < 128; ++k) { const float w = wp[(size_t)k * NMOD]; a0 += sl[k] * w; a1 += sl[128 + k] * w; a2 += sl[256 + k] * w; a3 += sl[384 + k] * w; a4 += sl[512 + k] * w; }
        float* pp = modp + ((size_t)(l * 8 + kc) * 5) * NMOD + j;
        pp[0] = a0; pp[NMOD] = a1; pp[2 * NMOD] = a2; pp[3 * NMOD] = a3; pp[4 * NMOD] = a4;
    }
    for (int m = C.gt(); m < 8192; m += C.NGT) { float s, c; sincospif((float)m * (1.0f / 4096.0f), &s, &c); tw[m] = make_float2(c, s); }
}
__device__ __forceinline__ void ph_mod_reduce(const Ctx& C) {
    const float* ada_b = ARGF(A_ADAB); const float* modp = WSP(float, WS_MODP); float* mod = WSP(float, WS_MOD);
    for (int e = C.gt(); e < 2 * 5 * NMOD; e += C.NGT) { const int l = e / (5 * NMOD), r = e % (5 * NMOD), j = r % NMOD; float s = ada_b[l * NMOD + j];
#pragma unroll
        for (int kc = 0; kc < 8; ++kc) s += modp[(size_t)(l * 8 + kc) * 5 * NMOD + r];
        mod[e] = s; }
    float* gnt = WSP(float, WS_GN); const float* n1g = ARGF(A_N1G); const float* n2g = ARGF(A_N2G);
    for (int e = C.gt(); e < 2 * 2 * 5 * DM; e += C.NGT) { const int col = e & 1023, grp = (e >> 10) % 5, w = (e / (5 * DM)) & 1, l = e / (10 * DM), j = (w ? 4 : 1) * DM + col;
        float s = ada_b[l * NMOD + j];
#pragma unroll
        for (int kc = 0; kc < 8; ++kc) s += modp[((size_t)(l * 8 + kc) * 5 + grp) * NMOD + j];
        gnt[e] = (w ? n2g : n1g)[l * DM + col] * (1.0f + s); }
}
__device__ __forceinline__ void ph_ctab(const Ctx& C, int l) {
    LAS float* red = (LAS float*)(C.lds + 131072); LAS float* cu = red + 8 * 5 * 64;
    const float* modl = WSP(const float, WS_MOD) + (size_t)l * 5 * NMOD; const float2* tw = WSP(const float2, WS_TW);
    float* cin = WSP(float, WS_CIN) + (size_t)l * 5 * NIN; float* cup = WSP(float, WS_CUP) + (size_t)l * 5 * FF;
    const int lane = C.lane(), w = C.wave, tid = C.tid();
    for (int it = C.bx; it < 88 + 64; it += C.G) {
        const bool isin = it < 88; const int ldw = isin ? NIN_ORIG : FF, col0 = (isin ? it : it - 88) * 64;
        const float* W = (isin ? ARGF(A_WIN) + (size_t)l * DM * NIN_ORIG : ARGF(A_W1) + (size_t)l * DM * FF) + (size_t)(128 * w) * ldw + col0 + lane;
        const float* shp = modl + (isin ? 0 : 3 * DM) + 128 * w;
        float a0 = 0.f, a1 = 0.f, a2 = 0.f, a3 = 0.f, a4 = 0.f;
#pragma unroll 16
        for (int kk = 0; kk < 128; ++kk) { const float wv = W[(size_t)kk * ldw]; a0 += shp[kk] * wv; a1 += shp[NMOD + kk] * wv; a2 += shp[2 * NMOD + kk] * wv; a3 += shp[3 * NMOD + kk] * wv; a4 += shp[4 * NMOD + kk] * wv; }
        __syncthreads();
        red[(w * 5 + 0) * 64 + lane] = a0; red[(w * 5 + 1) * 64 + lane] = a1; red[(w * 5 + 2) * 64 + lane] = a2; red[(w * 5 + 3) * 64 + lane] = a3; red[(w * 5 + 4) * 64 + lane] = a4;
        __syncthreads();
        if (tid < 320) { const int g = tid >> 6, c = tid & 63; float v = 0.f;
#pragma unroll
            for (int ww = 0; ww < 8; ++ww) v += red[(ww * 5 + g) * 64 + c];
            if (!isin) cup[g * FF + col0 + c] = v; else if (it >= 4) cin[g * NIN + col0 + c + 256] = v; else cu[g * 64 + c] = v; }
        if (isin && it < 4) { __syncthreads();
            if (tid < 320) { const int g = tid >> 6, kc = tid & 63; float p = 0.f, q = 0.f;
                for (int c = 0; c < 64; ++c) { const float2 t = tw[((c * kc) & 63) * 128]; const float v = cu[g * 64 + c]; p += v * t.x; q += v * t.y; }
                cin[g * NIN + it * 64 + kc] = p; cin[g * NIN + 256 + it * 64 + kc] = q; } }
    }
    __syncthreads();
}
__device__ __forceinline__ void ph_weights(const Ctx& C, int l) {
    LAS float* scr = (LAS float*)(C.lds + C.wave * 16384);
    const int lane = C.lane();
    const float* Win = ARGF(A_WIN) + (size_t)l * DM * NIN_ORIG;
    bf16* win_t = WSP(bf16, WS_WIN); bf16* wm_t = WSP(bf16, WS_WM);
    constexpr int I_IN = (DM / 64) * ((NIN_ORIG - 256) / 32), I_F = (256 / 64) * (DM / 32), I_A = (512 / 64) * (DM / 32), I_O = (DM / 64) * (DM / 32), I_1 = (DM / 64) * (FF / 32), I_2 = (FF / 64) * (DM / 32);
    constexpr int NITEMS = I_IN + 2 * I_F + I_A + I_O + I_1 + I_2;
    for (int it = C.gw; it < NITEMS; it += C.NGW) {
        int r = it;
        if (r < I_IN) { transpose_item(Win + 256, NIN_ORIG, NIN_ORIG - 256, win_t, DM, 512, 0, scr, r, lane); continue; } r -= I_IN;
        if (r < I_F) { transpose_item(ARGF(A_WF) + (size_t)l * 256 * DM, DM, DM, wm_t, DM, 0, 0, scr, r, lane); continue; } r -= I_F;
        if (r < I_F) { transpose_item(ARGF(A_WC) + (size_t)l * 256 * DM, DM, DM, wm_t, DM, 0, 256, scr, r, lane); continue; } r -= I_F;
        if (r < I_A) { transpose_item(ARGF(A_WA) + (size_t)l * 512 * DM, DM, DM, wm_t, DM, 0, 512, scr, r, lane); continue; } r -= I_A;
        if (r < I_O) { transpose_item(ARGF(A_WO) + (size_t)l * DM * DM, DM, DM, WSP(bf16, WS_WO), DM, 0, 0, scr, r, lane); continue; } r -= I_O;
        if (r < I_1) { transpose_item(ARGF(A_W1) + (size_t)l * DM * FF, FF, FF, WSP(bf16, WS_W1), DM, 0, 0, scr, r, lane); continue; } r -= I_1;
        transpose_item(ARGF(A_W2) + (size_t)l * FF * DM, DM, DM, WSP(bf16, WS_W2), FF, 0, 0, scr, r, lane);
    }
    for (int it = C.gw; it < 4 * 32 * 8; it += C.NGW) {
        const int kq = it & 7, g = it >> 8, k0 = ((it >> 3) & 31) * 32, kl = lane & 31, pq = lane >> 5;
        LAS float* tile = scr;
        LAS float* ct = scr + 32 * 65;
        { float s, c; sincospif((float)lane * (1.0f / 32.0f), &s, &c); ct[lane] = c; ct[64 + lane] = s; }
#pragma unroll 8
        for (int kk = 0; kk < 32; ++kk) tile[kk * 65 + lane] = Win[(size_t)(k0 + kk) * NIN_ORIG + g * 64 + lane];
        LDS_WAIT(); asm volatile("" ::: "memory");
        float p[8];
#pragma unroll
        for (int j = 0; j < 8; ++j) p[j] = 0.f;
#pragma unroll 4
        for (int c = 0; c < 64; ++c) { const float wv = tile[kl * 65 + c];
#pragma unroll
            for (int j = 0; j < 8; ++j) p[j] += wv * ct[pq * 64 + ((c * (kq * 8 + j)) & 63)]; }
#pragma unroll
        for (int j = 0; j < 8; ++j) win_t[(size_t)(pq * 256 + g * 64 + kq * 8 + j) * DM + k0 + kl] = (bf16)f2bf(p[j]);
        LDS_WAIT(); asm volatile("" ::: "memory");
    }
}
__device__ __forceinline__ void ph_prenorm(const Ctx& C, const float* xl, const float* xc, const float* gn, bf16* dst, u64* rs, int row_begin, int row_end, const float* part, const float* pgate) {
    const int lane = C.lane();
    for (int row = row_begin + C.gw; row < row_end; row += C.NGW) {
        const bool isc = row >= ML; const int grp = isc ? 4 : (row >> 13);
        const float* xr = isc ? xc + (size_t)(row - ML) * DM : xl + (size_t)row * DM;
        f32x4 v[4]; float s2 = 0.f;
#pragma unroll
        for (int j = 0; j < 4; ++j) { v[j] = *(const f32x4*)(xr + 4 * lane + 256 * j);
            if (part != nullptr && isc) {
                const size_t po = (size_t)(row - ML) * DM + 4 * lane + 256 * j;
                const f32x4 ps = (*(const f32x4*)(part + po) + *(const f32x4*)(part + po + 1048576)) + (*(const f32x4*)(part + po + 2 * 1048576) + *(const f32x4*)(part + po + 3 * 1048576));
                v[j] = v[j] + *(const f32x4*)(pgate + 4 * lane + 256 * j) * ps; }
            s2 += (v[j].x * v[j].x + v[j].y * v[j].y) + (v[j].z * v[j].z + v[j].w * v[j].w); }
        s2 = wave_sum(s2);
        if (lane == 0) rs[row] = (u64)(s2 * 16777216.0f + 0.5f);
#pragma unroll
        for (int j = 0; j < 4; ++j) { const int c0 = 4 * lane + 256 * j; const f32x4 y = v[j] * *(const f32x4*)(gn + grp * DM + c0);
            v2u o; o.x = pk2(y.x, y.y); o.y = pk2(y.z, y.w); *(v2u*)(dst + (size_t)row * DM + c0) = o; }
    }
}
__device__ __forceinline__ void ph_mixers(const Ctx& C, int l) {
    const bf16* pxa = WSP(const bf16, WS_PXA); bf16* mix = WSP(bf16, WS_HX);
    const float* cw = ARGF(A_CONVW) + l * 3 * 256;
    const int nrows = l == 0 ? MT : ML;
    for (int e = C.gt(); e < nrows * 32; e += C.NGT) {
        const int row = e >> 5, ch = (e & 31) * 8;
        const int pos = row < ML ? (row & (SEQ - 1)) : ((row - ML) & 255), len = row < ML ? SEQ : 256;
        const bf16* pr = pxa + (size_t)row * NPXA;
        const v4u u1 = *(const v4u*)(pr + OFF_CU + ch), c1 = *(const v4u*)(pr + OFF_CC + ch), b1 = *(const v4u*)(pr + OFF_CB + ch);
        v4u u0 = (v4u){0, 0, 0, 0}, c0 = u0, u2 = u0, c2 = u0;
        if (pos > 0) { u0 = *(const v4u*)(pr - NPXA + OFF_CU + ch); c0 = *(const v4u*)(pr - NPXA + OFF_CC + ch); }
        if (pos < len - 1) { u2 = *(const v4u*)(pr + NPXA + OFF_CU + ch); c2 = *(const v4u*)(pr + NPXA + OFF_CC + ch); }
        float o[8]; float w0[8], w1[8], w2[8];
        { const f32x4 t0 = *(const f32x4*)(cw + ch), t1 = *(const f32x4*)(cw + ch + 4), t2 = *(const f32x4*)(cw + 256 + ch), t3 = *(const f32x4*)(cw + 256 + ch + 4), t4 = *(const f32x4*)(cw + 512 + ch), t5 = *(const f32x4*)(cw + 512 + ch + 4);
#pragma unroll
          for (int j = 0; j < 4; ++j) { w0[j] = t0[j]; w0[4 + j] = t1[j]; w1[j] = t2[j]; w1[4 + j] = t3[j]; w2[j] = t4[j]; w2[4 + j] = t5[j]; } }
#pragma unroll
        for (int j = 0; j < 4; ++j) {
            const unsigned a0 = u0[j], d0 = c0[j], a1 = u1[j], d1 = c1[j], a2 = u2[j], d2 = c2[j], bb = b1[j];
            o[2 * j] = bflo(bb) * (w0[2 * j] * bflo(a0) * bflo(d0) + w1[2 * j] * bflo(a1) * bflo(d1) + w2[2 * j] * bflo(a2) * bflo(d2));
            o[2 * j + 1] = bfhi(bb) * (w0[2 * j + 1] * bfhi(a0) * bfhi(d0) + w1[2 * j + 1] * bfhi(a1) * bfhi(d1) + w2[2 * j + 1] * bfhi(a2) * bfhi(d2));
        }
        v4u w; w.x = pk2(o[0], o[1]); w.y = pk2(o[2], o[3]); w.z = pk2(o[4], o[5]); w.w = pk2(o[6], o[7]);
        *(v4u*)(mix + (size_t)row * DM + 256 + ch) = w;
    }
}

typedef short bf16x8_t __attribute__((ext_vector_type(8)));
typedef short v4i16_t __attribute__((ext_vector_type(4)));
constexpr int AT_KW = 0, AT_VW = 73728, AT_BT = 147456;
template <bool WIN>
__device__ __forceinline__ void attn_block(LAS unsigned char* lds, const int (&ka)[2][2], const int (&va)[2][4], int rowoff0, const bf16x8_t (&qf)[2],
                                           const LAS float* brow  , const int (&dc)[2][4], unsigned vmask, f32x4 (&o)[4], float& m, float& l) {
    constexpr float SC = 0.18033688011112042f;
    constexpr int RS = WIN ? 8192 : 4096;
    f32x4 s[8][2];
#pragma unroll
    for (int j = 0; j < 8; ++j)
#pragma unroll
        for (int t = 0; t < 2; ++t) { s[j][t] = (f32x4){0.f, 0.f, 0.f, 0.f};
#pragma unroll
            for (int ks = 0; ks < 2; ++ks) { const bf16x8_t kf = *(const LAS bf16x8_t*)(lds + ka[t][ks] + rowoff0 + j * RS); s[j][t] = __builtin_amdgcn_mfma_f32_16x16x32_bf16(kf, qf[ks], s[j][t], 0, 0, 0); } }
    float tmax = -1e30f;
#pragma unroll
    for (int j = 0; j < 8; ++j)
#pragma unroll
        for (int t = 0; t < 2; ++t)
#pragma unroll
            for (int i = 0; i < 4; ++i) { float v = s[j][t][i] * SC; if (WIN) { v += brow[j * 31 + dc[t][i]]; if (!((vmask >> (t * 4 + i)) & 1u)) v = -1e30f; } s[j][t][i] = v; tmax = fmaxf(tmax, v); }
    tmax = fmaxf(tmax, __shfl_xor(tmax, 16)); tmax = fmaxf(tmax, __shfl_xor(tmax, 32));
    const float mn = fmaxf(m, tmax), alpha = __builtin_amdgcn_exp2f(m - mn); m = mn;
    float ps = 0.f;
#pragma unroll
    for (int j = 0; j < 8; ++j)
#pragma unroll
        for (int t = 0; t < 2; ++t)
#pragma unroll
            for (int i = 0; i < 4; ++i) { const float p = __builtin_amdgcn_exp2f(s[j][t][i] - mn); s[j][t][i] = p; ps += p; }
    l = l * alpha + ps;
#pragma unroll
    for (int db = 0; db < 4; ++db) o[db] = o[db] * alpha;
#pragma unroll
    for (int j = 0; j < 8; ++j) {
        v4u pw; pw.x = pg8::cvt_pk_bf16(s[j][0][0], s[j][0][1]); pw.y = pg8::cvt_pk_bf16(s[j][0][2], s[j][0][3]); pw.z = pg8::cvt_pk_bf16(s[j][1][0], s[j][1][1]); pw.w = pg8::cvt_pk_bf16(s[j][1][2], s[j][1][3]);
        const bf16x8_t pf = __builtin_bit_cast(bf16x8_t, pw);
#pragma unroll
        for (int db = 0; db < 4; ++db) {
            const v4i16_t lo = __builtin_amdgcn_ds_read_tr16_b64_v4i16((LAS v4i16_t*)(lds + va[0][db] + rowoff0 + j * RS));
            const v4i16_t hi = __builtin_amdgcn_ds_read_tr16_b64_v4i16((LAS v4i16_t*)(lds + va[1][db] + rowoff0 + j * RS));
            const bf16x8_t vf = (bf16x8_t){lo[0], lo[1], lo[2], lo[3], hi[0], hi[1], hi[2], hi[3]};
            o[db] = __builtin_amdgcn_mfma_f32_16x16x32_bf16(vf, pf, o[db], 0, 0, 0);
        }
    }
}
__device__ __forceinline__ void attn_addr(int kc0off, int li, int fq, int (&ka)[2][2], int (&va)[2][4]) {
#pragma unroll
    for (int t = 0; t < 2; ++t) {
        const int rk = kc0off + 16 * t + li;
#pragma unroll
        for (int ks = 0; ks < 2; ++ks) ka[t][ks] = AT_KW + rk * 128 + (((4 * ks + fq) ^ ((rk >> 1) & 7)) * 16);
        const int rv = kc0off + 16 * t + 4 * fq + (li >> 2), p = li & 3;
#pragma unroll
        for (int db = 0; db < 4; ++db) va[t][db] = AT_VW + rv * 128 + (((2 * db + (p >> 1)) ^ (((rv >> 1) & 3) << 1)) * 16) + (p & 1) * 8;
    }
}

__device__ __forceinline__ void ph_ctx_dft(const Ctx& C) {
    if (C.bx >= 32) return;
    constexpr int DF_Q = 32768, DF_TW = AT_VW + 65536;
    static_assert(DF_TW + 2048 <= AT_BT, "ctx dft lds");
    const float2* tw = WSP(const float2, WS_TW); const bf16* pxa = WSP(const bf16, WS_PXA); bf16* mix = WSP(bf16, WS_HX);
    LAS unsigned char* lds = C.lds; LAS float* twl = (LAS float*)(lds + DF_TW);
    const int lane = C.lane(), w = C.wave, li = lane & 15, fq = lane >> 4, tid = C.tid();
    const int b = C.bx >> 3, kcb = (C.bx >> 1) & 3, kh = C.bx & 1;
    if (tid < 256) { const float2 v = tw[tid * 32]; twl[2 * tid] = v.x; twl[2 * tid + 1] = v.y; }
    for (int p = w; p < 32; p += 8) {
        const int tokl = p * 8 + (lane >> 3), cp = lane & 7;
        const bf16* src = pxa + ((size_t)ML + b * 256 + tokl) * NPXA + kcb * 64 + ((cp ^ (((tokl >> 1) & 3) << 1)) * 8);
        __builtin_amdgcn_global_load_lds((const unsigned*)(src + OFF_P), (LAS unsigned*)(lds + AT_VW + p * 1024), 16, 0, 0);
        __builtin_amdgcn_global_load_lds((const unsigned*)(src + OFF_Q), (LAS unsigned*)(lds + AT_VW + DF_Q + p * 1024), 16, 0, 0);
    }
    int ka[2][2], va[2][4]; attn_addr(0, li, fq, ka, va);
    asm volatile("s_waitcnt vmcnt(0) lgkmcnt(0)" ::: "memory");
    __syncthreads();
    const int k = 128 * kh + 16 * w + li;
    f32x4 o[4];
#pragma unroll
    for (int db = 0; db < 4; ++db) o[db] = (f32x4){0.f, 0.f, 0.f, 0.f};
#pragma unroll 2
    for (int j = 0; j < 8; ++j) {
        float cs[8], sn[8];
#pragma unroll
        for (int t = 0; t < 2; ++t)
#pragma unroll
            for (int i = 0; i < 4; ++i) { const int n = 32 * j + 16 * t + 4 * fq + i, idx = (n * k) & 255; cs[4 * t + i] = twl[2 * idx]; sn[4 * t + i] = -twl[2 * idx + 1]; }
        v4u cw, sw;
        cw.x = pg8::cvt_pk_bf16(cs[0], cs[1]); cw.y = pg8::cvt_pk_bf16(cs[2], cs[3]); cw.z = pg8::cvt_pk_bf16(cs[4], cs[5]); cw.w = pg8::cvt_pk_bf16(cs[6], cs[7]);
        sw.x = pg8::cvt_pk_bf16(sn[0], sn[1]); sw.y = pg8::cvt_pk_bf16(sn[2], sn[3]); sw.z = pg8::cvt_pk_bf16(sn[4], sn[5]); sw.w = pg8::cvt_pk_bf16(sn[6], sn[7]);
        const bf16x8_t cf = __builtin_bit_cast(bf16x8_t, cw), sf = __builtin_bit_cast(bf16x8_t, sw);
#pragma unroll
        for (int db = 0; db < 4; ++db) {
            const v4i16_t plo = __builtin_amdgcn_ds_read_tr16_b64_v4i16((LAS v4i16_t*)(lds + va[0][db] + j * 4096)), phi = __builtin_amdgcn_ds_read_tr16_b64_v4i16((LAS v4i16_t*)(lds + va[1][db] + j * 4096));
            const v4i16_t qlo = __builtin_amdgcn_ds_read_tr16_b64_v4i16((LAS v4i16_t*)(lds + va[0][db] + DF_Q + j * 4096)), qhi = __builtin_amdgcn_ds_read_tr16_b64_v4i16((LAS v4i16_t*)(lds + va[1][db] + DF_Q + j * 4096));
            const bf16x8_t pf = (bf16x8_t){plo[0], plo[1], plo[2], plo[3], phi[0], phi[1], phi[2], phi[3]}, qf = (bf16x8_t){qlo[0], qlo[1], qlo[2], qlo[3], qhi[0], qhi[1], qhi[2], qhi[3]};
            o[db] = __builtin_amdgcn_mfma_f32_16x16x32_bf16(pf, cf, o[db], 0, 0, 0);
            o[db] = __builtin_amdgcn_mfma_f32_16x16x32_bf16(qf, sf, o[db], 0, 0, 0);
        }
    }
    bf16* op = mix + ((size_t)ML + b * 256 + k) * DM + kcb * 64 + 4 * fq;
#pragma unroll
    for (int db = 0; db < 4; ++db) { v2u ov; ov.x = pk2(o[db][0] * (1.0f / 128.0f), o[db][1] * (1.0f / 128.0f)); ov.y = pk2(o[db][2] * (1.0f / 128.0f), o[db][3] * (1.0f / 128.0f)); *(v2u*)(op + 16 * db) = ov; }
}

__device__ __forceinline__ size_t zt_off(int b) { return b < 2 ? WS_TB + (size_t)b * 8 * MiB : (b == 2 ? (size_t)502 * MiB : WS_WIN); }
__device__ __forceinline__ void ph_t1(const Ctx& C) {
    const bf16* pxa = WSP(const bf16, WS_PXA); const int lane = C.lane();
    LAS unsigned short* tile = (LAS unsigned short*)(C.lds + C.wave * 9216);
    for (int it = C.gw; it < 4 * 2 * 128 * 4; it += C.NGW) {
        const int kcb = it & 3, n2 = (it >> 2) & 127, pq = (it >> 9) & 1, b = it >> 10;
#pragma unroll
        for (int i = 0; i < 8; ++i) { const int q = i * 64 + lane, n1 = q >> 3, cc = q & 7;
            const v4u v = *(const v4u*)(pxa + ((size_t)b * SEQ + n1 * 128 + n2) * NPXA + pq * 256 + kcb * 64 + cc * 8);
            *(LAS v4u*)(tile + n1 * 72 + cc * 8) = v; }
        LDS_WAIT(); asm volatile("" ::: "memory");
        bf16* zt = WSP(bf16, zt_off(b)) + ((size_t)(pq * 256 + kcb * 64 + lane) * SEQ + n2 * 64);
#pragma unroll
        for (int c = 0; c < 8; ++c) { v4u o;
            o.x = (unsigned)tile[(8 * c + 0) * 72 + lane] | ((unsigned)tile[(8 * c + 1) * 72 + lane] << 16); o.y = (unsigned)tile[(8 * c + 2) * 72 + lane] | ((unsigned)tile[(8 * c + 3) * 72 + lane] << 16);
            o.z = (unsigned)tile[(8 * c + 4) * 72 + lane] | ((unsigned)tile[(8 * c + 5) * 72 + lane] << 16); o.w = (unsigned)tile[(8 * c + 6) * 72 + lane] | ((unsigned)tile[(8 * c + 7) * 72 + lane] << 16);
            *(v4u*)(zt + 8 * c) = o; }
        LDS_WAIT(); asm volatile("" ::: "memory");
    }
}
typedef float f32x16 __attribute__((ext_vector_type(16)));
constexpr int FT_C64 = 0, FT_S64 = 9216, FT_C128 = 18432, FT_S128 = FT_C128 + 34816, FT_TA = FT_S128 + 34816, FT_TR = FT_TA + 4096, FT_ST = FT_TR + 8192;
static_assert(FT_ST + 32768 <= LDSCTL_OFF, "fft lds");
__device__ __forceinline__ void hw_sincos_rev(float rev, float& sn, float& cs) { sn = __builtin_amdgcn_sinf(rev); cs = __builtin_amdgcn_cosf(rev); }
__device__ __forceinline__ int crow16(int r, int h) { return (r & 3) + 8 * (r >> 2) + 4 * h; }
__device__ __forceinline__ void ph_fft(const Ctx& C) {
    LAS unsigned char* lds = C.lds; const int tid = C.tid(), lane = C.lane(), w = C.wave, h = lane >> 5, c = lane & 31;
    const float2* tw = WSP(const float2, WS_TW); bf16* mix = WSP(bf16, WS_HX);
    { LAS unsigned short* c64 = (LAS unsigned short*)(lds + FT_C64); LAS unsigned short* s64 = (LAS unsigned short*)(lds + FT_S64);
#pragma unroll 4
      for (int e = tid; e < 4096; e += NTHR) { const int k1 = e >> 6, n1 = e & 63; float sn, cs; hw_sincos_rev(0.5f * ((float)((n1 * k1) & 63) * (1.0f / 32.0f)), sn, cs); c64[k1 * 72 + n1] = (unsigned short)f2bf(cs); s64[k1 * 72 + n1] = (unsigned short)f2bf(sn); }
      LAS unsigned short* c128 = (LAS unsigned short*)(lds + FT_C128); LAS unsigned short* s128 = (LAS unsigned short*)(lds + FT_S128);
#pragma unroll 4
      for (int e = tid; e < 16384; e += NTHR) { const int k2 = e >> 7, p = e & 127, q = p & 15, n2 = (p & ~15) + (q & 3) + ((q >> 2) & 1) * 8 + ((q >> 3) & 1) * 4;
          float sn, cs; hw_sincos_rev(0.5f * ((float)((n2 * k2) & 127) * (1.0f / 64.0f)), sn, cs); c128[k2 * 136 + p] = (unsigned short)f2bf(cs); s128[k2 * 136 + p] = (unsigned short)f2bf(sn); }
      LAS float* ta = (LAS float*)(lds + FT_TA); LAS float* trt = (LAS float*)(lds + FT_TR);
      { const int e = tid, g = e >> 6, kk = e & 63; float sn, cs; hw_sincos_rev(0.5f * ((float)((32 * (g >> 1) + 4 * (g & 1)) * kk) * (1.0f / 4096.0f)), sn, cs); ta[2 * e] = cs; ta[2 * e + 1] = sn; }
      for (int e = tid; e < 1024; e += NTHR) { const int r = e >> 6, kk = e & 63; float sn, cs; hw_sincos_rev(0.5f * ((float)(crow16(r, 0) * kk) * (1.0f / 4096.0f)), sn, cs); trt[2 * e] = cs; trt[2 * e + 1] = sn; }
    }
    __syncthreads();
    const int vcu = (C.G % 8 == 0) ? (C.bx % 8) * (C.G / 8) + C.bx / 8 : C.bx;
    for (int it = vcu; it < 256; it += C.G) {
        const int kb = it & 1, kcg = (it >> 1) & 31, b = it >> 6, kc = kcg * 8 + w, k1 = 32 * kb + c;
        const bf16* zp = WSP(const bf16, zt_off(b)) + (size_t)kc * SEQ; const bf16* zq = zp + (size_t)256 * SEQ;
        f32x16 acc[4];
#pragma unroll
        for (int rb2 = 0; rb2 < 4; ++rb2) acc[rb2] = (f32x16){};
#pragma unroll 1
        for (int rb = 0; rb < 4; ++rb) {
            const int n2 = 32 * rb + c;
            f32x16 xr = {}, xi = {};
#pragma unroll
            for (int ks = 0; ks < 4; ++ks) {
                const bf16x8_t cf = *(const LAS bf16x8_t*)(lds + FT_C64 + (k1 * 72 + 16 * ks + 8 * h) * 2), sf = *(const LAS bf16x8_t*)(lds + FT_S64 + (k1 * 72 + 16 * ks + 8 * h) * 2);
                const bf16x8_t pf = *(const bf16x8_t*)(zp + n2 * 64 + 16 * ks + 8 * h), qf = *(const bf16x8_t*)(zq + n2 * 64 + 16 * ks + 8 * h);
                const v4u t = __builtin_bit_cast(v4u, qf) ^ 0x80008000u; const bf16x8_t qn = __builtin_bit_cast(bf16x8_t, t);
                xr = __builtin_amdgcn_mfma_f32_32x32x16_bf16(pf, cf, xr, 0, 0, 0); xi = __builtin_amdgcn_mfma_f32_32x32x16_bf16(pf, sf, xi, 0, 0, 0);
                xi = __builtin_amdgcn_mfma_f32_32x32x16_bf16(qf, cf, xi, 0, 0, 0); xr = __builtin_amdgcn_mfma_f32_32x32x16_bf16(qn, sf, xr, 0, 0, 0); }
            bf16x8_t bre[2], bim[2];
            const LAS float* tap = (const LAS float*)(lds + FT_TA) + 2 * ((rb * 2 + h) * 64 + k1); const float ac_ = tap[0], as_ = tap[1];
            const LAS float* trp = (const LAS float*)(lds + FT_TR) + 2 * k1;
#pragma unroll
            for (int sblk = 0; sblk < 2; ++sblk) {
                float tr[8], ti[8];
#pragma unroll
                for (int r8 = 0; r8 < 8; ++r8) { const int r = 8 * sblk + r8; const float rc = trp[128 * r], rs = trp[128 * r + 1]; const float tc = ac_ * rc - as_ * rs, ts = ac_ * rs + as_ * rc;
                    tr[r8] = xr[r] * tc - xi[r] * ts; ti[r8] = -(xr[r] * ts + xi[r] * tc); }
                v4u a, bq;
                a.x = pg8::cvt_pk_bf16(tr[0], tr[1]); a.y = pg8::cvt_pk_bf16(tr[2], tr[3]); a.z = pg8::cvt_pk_bf16(tr[4], tr[5]); a.w = pg8::cvt_pk_bf16(tr[6], tr[7]);
                bq.x = pg8::cvt_pk_bf16(ti[0], ti[1]); bq.y = pg8::cvt_pk_bf16(ti[2], ti[3]); bq.z = pg8::cvt_pk_bf16(ti[4], ti[5]); bq.w = pg8::cvt_pk_bf16(ti[6], ti[7]);
                bre[sblk] = __builtin_bit_cast(bf16x8_t, a); bim[sblk] = __builtin_bit_cast(bf16x8_t, bq); }
#pragma unroll
            for (int rb2 = 0; rb2 < 4; ++rb2) {
                const int k2 = 32 * rb2 + c;
#pragma unroll
                for (int sblk = 0; sblk < 2; ++sblk) {
                    const bf16x8_t ac = *(const LAS bf16x8_t*)(lds + FT_C128 + (k2 * 136 + 32 * rb + 16 * sblk + 8 * h) * 2), as = *(const LAS bf16x8_t*)(lds + FT_S128 + (k2 * 136 + 32 * rb + 16 * sblk + 8 * h) * 2);
                    acc[rb2] = __builtin_amdgcn_mfma_f32_32x32x16_bf16(ac, bre[sblk], acc[rb2], 0, 0, 0); acc[rb2] = __builtin_amdgcn_mfma_f32_32x32x16_bf16(as, bim[sblk], acc[rb2], 0, 0, 0); }
            }
        }
#pragma unroll
        for (int rb2 = 0; rb2 < 4; ++rb2) {
            LAS unsigned short* st = (LAS unsigned short*)(lds + FT_ST + (rb2 & 1) * 16384);
#pragma unroll
            for (int r = 0; r < 16; ++r) st[((crow16(r, h) * 32 + c) * 8) + w] = (unsigned short)f2bf(acc[rb2][r] * 0.001381067932f);
            LDS_WAIT(); __syncthreads();
#pragma unroll
            for (int j = 0; j < 2; ++j) { const int idx = tid + 512 * j, k2l = idx >> 5, k1l = idx & 31;
                const v4u v = *(const LAS v4u*)(st + idx * 8);
                *(v4u*)(mix + ((size_t)b * SEQ + 32 * kb + k1l + 64 * (32 * rb2 + k2l)) * DM + kcg * 8) = v; }
        }
        __syncthreads();
    }
}
__device__ __forceinline__ void ph_attn(const Ctx& C, int l) {
    const bf16* pxa = WSP(const bf16, WS_PXA); bf16* mix = WSP(bf16, WS_HX);
    const float* rb = ARGF(A_RELB) + (size_t)l * 8 * 15 * 31;
    LAS unsigned char* lds = C.lds; LAS float* biasT = (LAS float*)(lds + AT_BT);
    const int lane = C.lane(), w = C.wave, fq = lane >> 4, li = lane & 15, tid = C.tid();
    const int nunits = 2048 + (l == 0 ? 64 : 0);
    const int vcu = (C.G % 8 == 0) ? (C.bx % 8) * (C.G / 8) + C.bx / 8 : C.bx;
    for (int u = vcu; u < nunits; u += C.G) {
        const bool isc = u >= 2048;
        int b, h, rp; if (!isc) { b = u >> 9; h = (u >> 6) & 7; rp = u & 63; } else { const int v = u - 2048; b = v >> 4; h = (v >> 1) & 7; rp = v & 1; }
        __syncthreads();
        for (int e = tid; e < 465; e += NTHR) biasT[e] = rb[h * 465 + e] * 1.4426950408889634f;
        const int R0 = min(max(2 * rp - 4, 0), 120);
        if (!isc) {
            for (int p = w; p < 72; p += 8) {
                const int tokl = p * 8 + (lane >> 3), lr = tokl >> 6, col = tokl & 63, gr = min(R0 + lr, 127), cp = lane & 7;
                const bf16* src = pxa + ((size_t)b * SEQ + gr * 64 + col) * NPXA + h * 64;
                __builtin_amdgcn_global_load_lds((const unsigned*)(src + OFF_K + ((cp ^ ((tokl >> 1) & 7)) * 8)), (LAS unsigned*)(lds + AT_KW + p * 1024), 16, 0, 0);
                __builtin_amdgcn_global_load_lds((const unsigned*)(src + OFF_V + ((cp ^ (((tokl >> 1) & 3) << 1)) * 8)), (LAS unsigned*)(lds + AT_VW + p * 1024), 16, 0, 0);
            }
        }
        int r = 0, qc = 0; size_t token;
        if (!isc) { r = 2 * rp + (w >> 2); qc = 16 * (w & 3) + li; token = (size_t)b * SEQ + r * 64 + qc; }
        else token = (size_t)ML + b * 256 + rp * 128 + 16 * w + li;
        bf16x8_t qf[2];
#pragma unroll
        for (int ks = 0; ks < 2; ++ks) qf[ks] = *(const bf16x8_t*)(pxa + token * NPXA + OFF_QQ + h * 64 + 32 * ks + 8 * fq);
        f32x4 o[4]; float m = -1e30f, lsum = 0.f;
#pragma unroll
        for (int db = 0; db < 4; ++db) o[db] = (f32x4){0.f, 0.f, 0.f, 0.f};
        int ka[2][2], va[2][4], dc[2][4];
        asm volatile("s_waitcnt vmcnt(0)" ::: "memory");
        __syncthreads();
        if (!isc) {
            const int cb = w & 3, kc0 = cb == 0 ? 0 : cb == 1 ? 8 : cb == 2 ? 24 : 32;
            attn_addr(kc0, li, fq, ka, va);
            const int csq = min(max(qc - 8, 0), 48); unsigned vmask = 0u;
#pragma unroll
            for (int t = 0; t < 2; ++t)
#pragma unroll
                for (int i = 0; i < 4; ++i) { const int kcol = kc0 + 16 * t + 4 * fq + i; if (kcol >= csq && kcol < csq + 16) vmask |= 1u << (t * 4 + i); dc[t][i] = min(max(kcol - qc + 15, 0), 30); }
            const int rsr = min(max(r - 4, 0), 120), lr0 = rsr - R0;
            attn_block<true>(lds, ka, va, lr0 * 8192, qf, biasT + (rsr - r + 7) * 31, dc, vmask, o, m, lsum);
        }
        __syncthreads();
        for (int p = w; p < 32; p += 8) {
            const int tokl = p * 8 + (lane >> 3), cp = lane & 7;
            const bf16* src = pxa + ((size_t)ML + b * 256 + tokl) * NPXA + h * 64;
            __builtin_amdgcn_global_load_lds((const unsigned*)(src + OFF_K + ((cp ^ ((tokl >> 1) & 7)) * 8)), (LAS unsigned*)(lds + AT_KW + p * 1024), 16, 0, 0);
            __builtin_amdgcn_global_load_lds((const unsigned*)(src + OFF_V + ((cp ^ (((tokl >> 1) & 3) << 1)) * 8)), (LAS unsigned*)(lds + AT_VW + p * 1024), 16, 0, 0);
        }
        attn_addr(0, li, fq, ka, va);
        asm volatile("s_waitcnt vmcnt(0)" ::: "memory");
        __syncthreads();
        attn_block<false>(lds, ka, va, 0, qf, (const LAS float*)nullptr, dc, 0xffu, o, m, lsum);
        lsum += __shfl_xor(lsum, 16); lsum += __shfl_xor(lsum, 32);
        const float inv = __builtin_amdgcn_rcpf(lsum);
        bf16* op = mix + token * DM + 512 + h * 64 + 4 * fq;
#pragma unroll
        for (int db = 0; db < 4; ++db) { v2u ov; ov.x = pk2(o[db][0] * inv, o[db][1] * inv); ov.y = pk2(o[db][2] * inv, o[db][3] * inv); *(v2u*)(op + 16 * db) = ov; }
    }
}

template <int KS>
__device__ __forceinline__ void wg_core(const bf16* A, const bf16* W, int li, int fq, f32x4 (&acc)[4][2]) {
    const bf16* ap = A + (size_t)li * DM + 8 * fq; const bf16* wp = W + (size_t)li * DM + 8 * fq;
    bf16x8_t af[4][4], wf[4][2];
#pragma unroll
    for (int s = 0; s < 3; ++s) {
#pragma unroll
        for (int m = 0; m < 4; ++m) af[s][m] = *(const bf16x8_t*)(ap + (size_t)(16 * m) * DM + 32 * s);
#pragma unroll
        for (int n = 0; n < 2; ++n) wf[s][n] = *(const bf16x8_t*)(wp + (size_t)(16 * n) * DM + 32 * s); }
#pragma unroll
    for (int s = 0; s < KS; ++s) {
        if (s + 3 < KS) {
#pragma unroll
            for (int m = 0; m < 4; ++m) af[(s + 3) & 3][m] = *(const bf16x8_t*)(ap + (size_t)(16 * m) * DM + 32 * (s + 3));
#pragma unroll
            for (int n = 0; n < 2; ++n) wf[(s + 3) & 3][n] = *(const bf16x8_t*)(wp + (size_t)(16 * n) * DM + 32 * (s + 3)); }
#pragma unroll
        for (int m = 0; m < 4; ++m)
#pragma unroll
            for (int n = 0; n < 2; ++n) acc[m][n] = __builtin_amdgcn_mfma_f32_16x16x32_bf16(wf[s & 3][n], af[s & 3][m], acc[m][n], 0, 0, 0);
    }
}
__device__ __forceinline__ void wg_merge_ctx(const Ctx& C) {
    if (C.wave >= 2) return;
    const bf16* mix = WSP(const bf16, WS_HX); const bf16* wm = WSP(const bf16, WS_WM); const bf16* pxg = WSP(const bf16, WS_PXG); bf16* mb = WSP(bf16, WS_M);
    const int lane = C.lane(), li = lane & 15, fq = lane >> 4;
    for (int it = C.wave * C.G + C.bx; it < 512; it += 2 * C.G) {
        const int r0 = ML + 64 * (it >> 5), c0 = 32 * (it & 31);
        f32x4 a0[4][2], a1[4][2], a2[4][2];
#pragma unroll
        for (int m = 0; m < 4; ++m)
#pragma unroll
            for (int n = 0; n < 2; ++n) { a0[m][n] = (f32x4){0.f, 0.f, 0.f, 0.f}; a1[m][n] = a0[m][n]; a2[m][n] = a0[m][n]; }
        const bf16* A = mix + (size_t)r0 * DM; const bf16* W = wm + (size_t)c0 * DM;
        wg_core<8>(A, W, li, fq, a0); wg_core<8>(A + 256, W + 256, li, fq, a1); wg_core<16>(A + 512, W + 512, li, fq, a2);
#pragma unroll
        for (int m = 0; m < 4; ++m)
#pragma unroll
            for (int n = 0; n < 2; ++n) { const size_t row = (size_t)(r0 + 16 * m + li); const int col = c0 + 16 * n + 4 * fq;
                const v2u g0 = *(const v2u*)(pxg + row * NPXG + col), g1 = *(const v2u*)(pxg + row * NPXG + 1024 + col), g2 = *(const v2u*)(pxg + row * NPXG + 2048 + col);
#define RL(x) __builtin_amdgcn_rcpf(bflo(x))
#define RH(x) __builtin_amdgcn_rcpf(bfhi(x))
                const float o0 = a0[m][n][0] * RL(g0.x) + a1[m][n][0] * RL(g1.x) + a2[m][n][0] * RL(g2.x), o1 = a0[m][n][1] * RH(g0.x) + a1[m][n][1] * RH(g1.x) + a2[m][n][1] * RH(g2.x);
                const float o2 = a0[m][n][2] * RL(g0.y) + a1[m][n][2] * RL(g1.y) + a2[m][n][2] * RL(g2.y), o3 = a0[m][n][3] * RH(g0.y) + a1[m][n][3] * RH(g1.y) + a2[m][n][3] * RH(g2.y);
#undef RL
#undef RH
                v2u w; w.x = cvt_pk_bf16(o0, o1); w.y = cvt_pk_bf16(o2, o3); *(v2u*)(mb + row * DM + col) = w; }
    }
}
__device__ __forceinline__ void wg_wo_ctx(const Ctx& C) {
    if (C.wave >= 2) return;
    const bf16* mb = WSP(const bf16, WS_M); const bf16* wo = WSP(const bf16, WS_WO); const float* base = ARGF(A_CTX); float* out = WSP(float, WS_CTXX);
    const float* gate = WSP(const float, WS_MOD) + 4 * NMOD + 2 * DM; const float* gn = WSP(const float, WS_GN) + (size_t)(1 * 5 + 4) * DM; bf16* ap = WSP(bf16, WS_HX); u64* rs = WSP(u64, WS_RS) + (size_t)1 * MT;
    const int lane = C.lane(), li = lane & 15, fq = lane >> 4;
    for (int it = C.wave * C.G + C.bx; it < 512; it += 2 * C.G) {
        const int r0 = 64 * (it >> 5), c0 = 32 * (it & 31);
        f32x4 acc[4][2];
#pragma unroll
        for (int m = 0; m < 4; ++m)
#pragma unroll
            for (int n = 0; n < 2; ++n) acc[m][n] = (f32x4){0.f, 0.f, 0.f, 0.f};
        wg_core<32>(mb + (size_t)(ML + r0) * DM, wo + (size_t)c0 * DM, li, fq, acc);
#pragma unroll
        for (int m = 0; m < 4; ++m) { const size_t rc = (size_t)(r0 + 16 * m + li); float ss = 0.f;
#pragma unroll
            for (int n = 0; n < 2; ++n) { const int col = c0 + 16 * n + 4 * fq;
                const f32x4 o = *(const f32x4*)(base + rc * DM + col) + *(const f32x4*)(gate + col) * acc[m][n];
                *(f32x4*)(out + rc * DM + col) = o;
                const f32x4 y = o * *(const f32x4*)(gn + col); v2u w; w.x = cvt_pk_bf16(y[0], y[1]); w.y = cvt_pk_bf16(y[2], y[3]); *(v2u*)(ap + (ML + rc) * DM + col) = w;
                ss += (o[0] * o[0] + o[1] * o[1]) + (o[2] * o[2] + o[3] * o[3]); }
            ss += __shfl_xor(ss, 16); ss += __shfl_xor(ss, 32);
            if (fq == 0) __hip_atomic_fetch_add(rs + ML + rc, (u64)(ss * 16777216.0f + 0.5f), __ATOMIC_RELAXED, __HIP_MEMORY_SCOPE_AGENT); }
    }
}
__device__ __forceinline__ void ph_final(const Ctx& C) {
    float* out = (float*)(GAS float*)ldarg(C, A_OUT); const float* fg = ARGF(A_FG); const int lane = C.lane();
    for (int row = C.gw; row < ML; row += C.NGW) {
        float* xr = out + (size_t)row * DM;
        f32x4 v[4]; float s2 = 0.f;
#pragma unroll
        for (int j = 0; j < 4; ++j) { v[j] = *(const f32x4*)(xr + 4 * lane + 256 * j); s2 += (v[j].x * v[j].x + v[j].y * v[j].y) + (v[j].z * v[j].z + v[j].w * v[j].w); }
        const float rstd = 1.0f / sqrtf(wave_sum(s2) * (1.0f / DM) + EPS);
#pragma unroll
        for (int j = 0; j < 4; ++j) { const int c0 = 4 * lane + 256 * j; const f32x4 gg = *(const f32x4*)(fg + c0); *(f32x4*)(xr + c0) = v[j] * rstd * gg; }
    }
}

struct Args { const void* p[A_NARGS]; int ph_lo, ph_hi; };

__global__ void __launch_bounds__(NTHR, 2) fwd_kernel(Args args) {
    extern __shared__ __attribute__((aligned(16))) unsigned char lds_raw[];
    LAS unsigned char* const lds0 = (LAS unsigned char*)lds_raw;
    const int wave0 = __builtin_amdgcn_readfirstlane(threadIdx.x >> 6);
    { const int t0 = threadIdx.x;
      for (int u = t0; u < (LDS_BYTES - LDSCTL_OFF) / 4; u += NTHR) ((LAS unsigned*)(lds0 + LDSCTL_OFF))[u] = 0u;
      __syncthreads();
      if (t0 < A_NARGS) ((LAS unsigned long long*)(lds0 + LARGS_OFF))[t0] = (unsigned long long)args.p[t0];
      __syncthreads(); }
    const int lo = args.ph_lo, hi = args.ph_hi;
    const unsigned xcc = xb_xcc_id();
    int vbx = blockIdx.x;
    if (!MK_MULTI) { Ctx C; C.lds = lds0; C.wave = wave0; gu32* ctl0 = (gu32*)WSP(unsigned, WS_CTL); (void)xcd_barrier_post((unsigned*)(ctl0 + CW_BAR), (volatile LAS unsigned*)(lds0 + MISC_OFF) + 8, C.tid() == 0); }
    for (int step = lo; step < hi; ++step) {
        const int ls = step - 2, l = ls >= NS ? 1 : 0, k = (step < 2) ? -1 - step : ls - l * NS;
        const int nrep = (PROBE_K != -99 && k == PROBE_K) ? PROBE_N : 1;
        for (int rep = 0; rep < nrep; ++rep) {
        Ctx C;
        C.lds = lds0; C.wave = wave0; C.G = gridDim.x; C.bx = vbx;
        asm volatile("" : "+s"(C.wave), "+s"(C.bx), "+s"(C.G));
        C.gw = C.bx * NWAVES + C.wave; C.NGW = C.G * NWAVES; C.NGT = C.G * NTHR;
        gu32* ctl = (gu32*)WSP(unsigned, WS_CTL);
        if (k == -1) { ph_mod_partial(C); __syncthreads(); ph_weights(C, 0); }
        else if (k == -2) ph_mod_reduce(C);
        else if (k == 0) {
            if (l == 1) ph_weights(C, l);
            ph_ctab(C, l);
            u64* rsb = WSP(u64, WS_RS) + (size_t)(l == 0 ? 0 : 2) * MT;
            if (l == 0) ph_prenorm(C, ARGF(A_X), ARGF(A_CTX), WSP(const float, WS_GN), WSP(bf16, WS_HX), rsb, 0, MT, (const float*)nullptr, (const float*)nullptr);
            else ph_prenorm(C, ARGF(A_OUT), WSP(const float, WS_CTXX), WSP(const float, WS_GN) + 2 * 5 * DM, WSP(bf16, WS_HX), rsb, ML, MT, WSP(const float, WS_PART), WSP(const float, WS_MOD) + 4 * NMOD + 5 * DM);
        } else if (k == 1) {
            pg8::Prob<false> P{WSP(const bf16, WS_HX), WSP(const bf16, WS_WIN), DM, DM, DM}; pg8::StaticOrder<NIN / 256> S; S.init(MT, NIN, C.G, C.bx);
            EpiIn E{WSP(bf16, WS_PXA), WSP(bf16, WS_PXG), WSP(const u64, WS_RS) + (size_t)(l == 0 ? 0 : 2) * MT, WSP(const float, WS_CIN) + (size_t)l * 5 * NIN};
            pg8::gemm_phase(C.lds, P, S, E, C.tid());
        } else if (k == 2) {
            const int sub = rep == 0 ? 7 : PROBE_SUB;
            if (sub & 1) ph_t1(C);
            if (sub & 2) { if (l == 0) ph_ctx_dft(C); ph_mixers(C, l); }
            if (sub & 4) ph_attn(C, l);
        } else if (k == 3) {
            ph_fft(C);
        } else if (k == 4) {
            pg8::Prob<false> P{WSP(const bf16, WS_HX), WSP(const bf16, WS_WM), DM, DM, DM}; pg8::StaticOrder<DM / 256> S; S.init(ML, DM, C.G, C.bx);
            EpiMerge E{WSP(bf16, WS_M), WSP(const bf16, WS_PXG)};
            pg8::gemm_phase(C.lds, P, S, E, C.tid());
            if (l == 0) wg_merge_ctx(C);
        } else if (k == 5) {
            pg8::Prob<false> P{WSP(const bf16, WS_M), WSP(const bf16, WS_WO), DM, DM, DM}; pg8::StaticOrder<DM / 256> S; S.init(ML, DM, C.G, C.bx);
            EpiRes E{l == 0 ? ARGF(A_X) : ARGF(A_OUT), l == 0 ? ARGF(A_CTX) : WSP(const float, WS_CTXX), (float*)(GAS float*)ldarg(C, A_OUT), WSP(float, WS_CTXX),
                     rep > 0 ? WSP(const float, WS_ZERO) : WSP(const float, WS_MOD) + (size_t)l * 5 * NMOD + 2 * DM, nullptr,
                     WSP(const float, WS_GN) + (size_t)(l * 2 + 1) * 5 * DM, WSP(bf16, WS_HX), WSP(u64, WS_RS) + (size_t)(l == 0 ? 1 : 3) * MT};
            pg8::gemm_phase(C.lds, P, S, E, C.tid());
            if (l == 0 && rep == 0) wg_wo_ctx(C);
        } else if (k == 6) {
            pg8::Prob<false> P{WSP(const bf16, WS_HX), WSP(const bf16, WS_W1), DM, DM, DM}; pg8::StaticOrder<FF / 256> S; S.init(l == 0 ? MT : ML, FF, C.G, C.bx);
            EpiAct E{WSP(bf16, WS_ACT), WSP(const u64, WS_RS) + (size_t)(l == 0 ? 1 : 3) * MT, WSP(const float, WS_CUP) + (size_t)l * 5 * FF};
            pg8::gemm_phase(C.lds, P, S, E, C.tid());
        } else if (k == 7) {
            if (l == 0) {
                pg8::ProbDown P{WSP(const bf16, WS_ACT), WSP(const bf16, WS_W2), FF, FF, FF}; pg8::DownOrder S; S.init(C.G, C.bx);
                EpiRes E{ARGF(A_OUT), WSP(const float, WS_CTXX), (float*)(GAS float*)ldarg(C, A_OUT), WSP(float, WS_CTXX), WSP(const float, WS_MOD) + (size_t)l * 5 * NMOD + 5 * DM, WSP(float, WS_PART),
                         WSP(const float, WS_GN) + (size_t)2 * 5 * DM, WSP(bf16, WS_HX), WSP(u64, WS_RS) + (size_t)2 * MT};
                pg8::gemm_phase(C.lds, P, S, E, C.tid());
            } else {
                pg8::Prob<false> P{WSP(const bf16, WS_ACT), WSP(const bf16, WS_W2), FF, FF, FF}; pg8::StaticOrder<DM / 256> S; S.init(ML, DM, C.G, C.bx);
                EpiResFinal E{(float*)(GAS float*)ldarg(C, A_OUT), WSP(const float, WS_MOD) + (size_t)l * 5 * NMOD + 5 * DM, ARGF(A_FG), WSP(u64, WS_RS5), WSP(unsigned, WS_FCNT), (unsigned*)WSP(unsigned, WS_CTL) + CW_TMO};
                pg8::gemm_phase(C.lds, P, S, E, C.tid());
            }
        } else ph_final(C);
        if (step + 1 < hi || rep + 1 < nrep) { if (MK_MULTI) { if (C.tid() == 0) __hip_atomic_store(ctl + CW_TMO, 0xBADu, RLX_AGENT); } else { XcdBarrier bar; bar.bar = (unsigned*)(ctl + CW_BAR); bar.x = xcc; bar.st = (volatile LAS unsigned*)(lds0 + MISC_OFF) + 8; xcd_barrier(bar, C.tid() == 0);
                if (step == lo && rep == 0) {
                    volatile LAS unsigned* misc = (volatile LAS unsigned*)(lds0 + MISC_OFF);
                    if (C.tid() == 0) { bool ok = gridDim.x == 256;
                        for (unsigned j = 0; j < 16; ++j) { const unsigned cnt = xb_ld(bar.bar + XB_XCNT(j)); ok = ok && (cnt == (j < 8 ? 32u : 0u)); }
                        misc[11] = ok ? 1u : 0u; }
                    __syncthreads();
                    const unsigned okf = __builtin_amdgcn_readfirstlane(misc[11]), rk = __builtin_amdgcn_readfirstlane(misc[10]);
                    if (okf != 0u && rk < 32u && xcc < 8u) vbx = (int)(rk * 8u + xcc); } } }
        }
    }
}

extern "C" void kernel_launch(void* const* d_in, const int* in_sizes, int n_in, void* d_out, int out_size, void* d_ws, size_t ws_size, hipStream_t stream) {
    static int grid = 0;
    if (grid == 0) {
        if (n_in != 18 || out_size != ML * DM || ws_size < WS_END) { fprintf(stderr, "kernel_launch: unexpected shapes (n_in %d out %d ws %zu)\n", n_in, out_size, ws_size); grid = -1; return; }
        int dev = 0, cus = 0;
        if (hipGetDevice(&dev) != hipSuccess || hipDeviceGetAttribute(&cus, hipDeviceAttributeMultiprocessorCount, dev) != hipSuccess) { grid = -1; return; }
        if (hipFuncSetAttribute((const void*)fwd_kernel, hipFuncAttributeMaxDynamicSharedMemorySize, LDS_BYTES) != hipSuccess) { fprintf(stderr, "kernel_launch: hipFuncSetAttribute failed\n"); grid = -1; return; }
        int per_cu = 0;
        if (hipOccupancyMaxActiveBlocksPerMultiprocessor(&per_cu, (const void*)fwd_kernel, NTHR, LDS_BYTES) != hipSuccess || per_cu < 1) fprintf(stderr, "kernel_launch: occupancy query reports %d\n", per_cu);
        (void)hipGetLastError();
        grid = cus;
    }
    if (grid < 0) return;
    (void)hipMemsetAsync((char*)d_ws + WS_CTL, 0, CTL_ZERO_BYTES, stream);
    Args a{};
    for (int i = 0; i < 18; ++i) a.p[i] = d_in[i];
    a.p[A_OUT] = d_out; a.p[A_WS] = d_ws;
#if MK_MULTI
    for (int s = 0; s < NSTEPS; ++s) { a.ph_lo = s; a.ph_hi = s + 1; hipLaunchKernelGGL(fwd_kernel, dim3(grid), dim3(NTHR), LDS_BYTES, stream, a); }
#else
    a.ph_lo = 0; a.ph_hi = NSTEPS; hipLaunchKernelGGL(fwd_kernel, dim3(grid), dim3(NTHR), LDS_BYTES, stream, a);
#endif
}
```

```cpp
#include <hip/hip_runtime.h>
#include <cstdio>
#include <cstdint>

#ifndef PROBE_K
#define PROBE_K -99
#define PROBE_N 1
#define PROBE_SUB 7
#endif
#ifndef MK_MULTI
#define MK_MULTI 0
#endif

namespace pg8 {
#define PG8_LAS __attribute__((address_space(3)))
typedef unsigned short bf16_t;
typedef short bf16x8 __attribute__((ext_vector_type(8)));
typedef float f32x4 __attribute__((ext_vector_type(4)));
typedef unsigned u32x4 __attribute__((ext_vector_type(4)));
constexpr int BM = 256, BK = 64, HALF = 128, HTB = HALF * BK * 2, STAGE_BYTES = 8 * HTB, NXCD = 8, WGM = 8;

__host__ __device__ __forceinline__ int lds_byte(int r, int c) { const int st = (r >> 4) * 2 + (c >> 5), rr = r & 15, cc = c & 31, ob = rr * 64 + cc * 2; return st * 1024 + (ob ^ (((ob >> 9) & 1) << 5)); }
__host__ __device__ __forceinline__ void stage_rc(int b, int& R, int& C) { const int st = b / 1024, sb = b % 1024, swz = sb ^ (((sb >> 9) & 1) << 5); R = (st >> 1) * 16 + swz / 64; C = (st & 1) * 32 + (swz % 64) / 2; }
__host__ __device__ __forceinline__ int perm32(int rho) { const int n = rho >> 4, i = rho & 15; return 8 * (i >> 2) + 4 * n + (i & 3); }

struct Unit { int pm, pn, br; };

template <int NN  > struct StaticOrder {
    int nM, nwg, G, c;
    __device__ void init(int M, int  , int G_, int c_) { nM = M / BM; nwg = nM * NN; G = G_; c = c_; }
    __device__ __forceinline__ bool next(int i, Unit& u) const {
        u.br = 0;
        const long L = (long)i * G + c; if (L >= nwg) return false;
        int wgid = (int)L; { const int q = nwg >> 3, r = nwg & 7, xcd = wgid & 7, off = wgid >> 3; wgid = (xcd < r ? xcd * (q + 1) : r * (q + 1) + (xcd - r) * q) + off; }
        constexpr int nig = WGM * NN; const int gid = wgid / nig, rem = wgid - gid * nig, fm = gid * WGM, gsz = (nM - fm) < WGM ? (nM - fm) : WGM;
        if (gsz == WGM) { u.pm = fm + (rem & (WGM - 1)); u.pn = rem >> 3; } else { u.pm = fm + (rem % gsz); u.pn = rem / gsz; }
        return true;
    }
};

struct DownOrder {
    StaticOrder<4> lat; int G, c;
    __device__ void init(int G_, int c_) { lat.init(32768, 1024, G_, c_); G = G_; c = c_; }
    __device__ __forceinline__ bool next(int i, Unit& u) const {
        const long L = (long)i * G + c;
        if (L < 512) return lat.next(i, u);
        const int j = (int)L - 512; if (j >= 64) return false;
        const int ct = j >> 2; u.pm = 128 + (ct >> 2); u.pn = ct & 3; u.br = j & 3; return true;
    }
};
struct ProbDown {
    const bf16_t* A; const bf16_t* Bt; int lda, ldb, K;
    __device__ __forceinline__ int nt(const Unit& u) const { return u.pm >= 128 ? 16 : 64; }
    __device__ __forceinline__ int koff(const Unit& u) const { return u.pm >= 128 ? u.br * 1024 : 0; }
    __device__ __forceinline__ const char* a(const Unit& u) const { return (const char*)(A + (size_t)u.pm * BM * lda + koff(u)); }
    __device__ __forceinline__ const char* b(const Unit& u) const { return (const char*)(Bt + (size_t)u.pn * BM * ldb + koff(u)); }
};
template <bool MERGE> struct Prob {
    const bf16_t* A; const bf16_t* Bt; int lda, ldb, K;
    __device__ __forceinline__ int nt(const Unit& u) const { if (MERGE) return u.br == 2 ? 8 : 4; return K / BK; }
    __device__ __forceinline__ int koff(const Unit& u) const { if (MERGE) return u.br * 256; return 0; }
    __device__ __forceinline__ const char* a(const Unit& u) const { return (const char*)(A + (size_t)u.pm * BM * lda + koff(u)); }
    __device__ __forceinline__ const char* b(const Unit& u) const { return (const char*)(Bt + (size_t)u.pn * BM * ldb + koff(u)); }
};

__device__ __forceinline__ unsigned cvt_pk_bf16(float lo, float hi) { unsigned r; asm volatile("v_cvt_pk_bf16_f32 %0, %1, %2" : "=v"(r) : "v"(lo), "v"(hi)); return r; }

template <class Epi, class Sched, class PROB>
__device__ __forceinline__ void gemm_phase(PG8_LAS unsigned char* lds, const PROB P, const Sched& S, const Epi& E, const int tid) {
    const int wid = __builtin_amdgcn_readfirstlane(tid >> 6), lane = tid & 63, wr = wid >> 2, wc = wid & 3, fr = lane & 15, fq = lane >> 4;
    unsigned voffA[2], voffB[2];
#pragma unroll
    for (int i = 0; i < 2; ++i) { int R, C; stage_rc(tid * 16 + i * 8192, R, C); const int Rb = Epi::PERM ? ((R & ~31) + perm32(R & 31)) : R;
        voffA[i] = (unsigned)(R * P.lda + C) * 2u; voffB[i] = (unsigned)(Rb * P.ldb + C) * 2u; }
    const size_t kstep = (size_t)(BK * 2);
    const size_t hstepA = (size_t)HALF * P.lda * 2, hstepB = (size_t)HALF * P.ldb * 2;
    const unsigned ldsw = (unsigned)wid * 1024u;
    const int aoff = lds_byte(wr * 64 + fr, fq * 8), boff = lds_byte(wc * 32 + fr, fq * 8);
#define PG8_SA(b, h) (((b) * 2 + (h)) * HTB)
#define PG8_SB(b, h) ((4 + (b) * 2 + (h)) * HTB)
#define PG8_STAGE(bufoff, gbase, voff) do { _Pragma("unroll") for (int _i = 0; _i < 2; ++_i) \
        __builtin_amdgcn_global_load_lds((const unsigned*)((const char*)(gbase) + (voff)[_i]), (PG8_LAS unsigned*)(lds + (bufoff) + ldsw + _i * 8192), 16, 0, 0); } while (0)
#define PG8_LDA(dst, b, h) do { _Pragma("unroll") for (int m = 0; m < 4; ++m) _Pragma("unroll") for (int k = 0; k < 2; ++k) dst[m][k] = *(const PG8_LAS bf16x8*)(lds + PG8_SA(b, h) + aoff + m * 2048 + k * 1024); } while (0)
#define PG8_LDB(dst, b, h) do { _Pragma("unroll") for (int n = 0; n < 2; ++n) _Pragma("unroll") for (int k = 0; k < 2; ++k) dst[n][k] = *(const PG8_LAS bf16x8*)(lds + PG8_SB(b, h) + boff + n * 2048 + k * 1024); } while (0)
#define PG8_MMA(ai, bj, At, Bt) do { __builtin_amdgcn_s_setprio(1); _Pragma("unroll") for (int m = 0; m < 4; ++m) _Pragma("unroll") for (int n = 0; n < 2; ++n) _Pragma("unroll") for (int k = 0; k < 2; ++k) \
        acc[ai][bj][m][n] = __builtin_amdgcn_mfma_f32_16x16x32_bf16(Bt[n][k], At[m][k], acc[ai][bj][m][n], 0, 0, 0); __builtin_amdgcn_s_setprio(0); } while (0)
#define PG8_WAIT_V(n) asm volatile("s_waitcnt vmcnt(" #n ")" ::: "memory")
#define PG8_WAIT_L(n) asm volatile("s_waitcnt lgkmcnt(" #n ")" ::: "memory")
#define PG8_BAR __builtin_amdgcn_s_barrier()
#define PG8_WAIT_SEL1(N) asm volatile("s_waitcnt vmcnt(" #N ")\n\tv_cmp_ne_u32_e32 vcc, 0, %0\n\ts_cbranch_vccnz .Lpg8w%=\n\ts_waitcnt vmcnt(8)\n.Lpg8w%=:" :: "v"(fst) : "memory", "vcc")
#define PG8_WAIT_SEL(NF16, NF32) do { if (Epi::NST == 16) PG8_WAIT_SEL1(NF16); else PG8_WAIT_SEL1(NF32); } while (0)
#define PG8_SCHED __builtin_amdgcn_sched_barrier(0)
    Unit cur, nxt; int ui = 0;
    if (!S.next(0, cur)) return;
    f32x4 acc[2][2][4][2];
#pragma unroll
    for (int a = 0; a < 2; ++a)
#pragma unroll
        for (int b = 0; b < 2; ++b)
#pragma unroll
            for (int m = 0; m < 4; ++m)
#pragma unroll
                for (int n = 0; n < 2; ++n) acc[a][b][m][n] = (f32x4){0.f, 0.f, 0.f, 0.f};
    bf16x8 At[4][2], B0[2][2], B1[2][2];
    const char* cA = P.a(cur); const char* cB = P.b(cur);
    PG8_STAGE(PG8_SB(0, 0), cB, voffB); PG8_STAGE(PG8_SB(0, 1), cB + hstepB, voffB); PG8_STAGE(PG8_SA(0, 0), cA, voffA); PG8_STAGE(PG8_SA(0, 1), cA + hstepA, voffA);
    if (wr == 1) PG8_BAR;
    PG8_WAIT_V(2); PG8_BAR;
    PG8_STAGE(PG8_SB(1, 0), cB + kstep, voffB); PG8_STAGE(PG8_SA(1, 0), cA + kstep, voffA); PG8_STAGE(PG8_SB(1, 1), cB + hstepB + kstep, voffB);
    PG8_WAIT_V(6); PG8_BAR;
    for (;;) {
        const bool has_next = S.next(ui + 1, nxt);
        const char* nA = has_next ? P.a(nxt) : cA; const char* nB = has_next ? P.b(nxt) : cB;
        const int nt = P.nt(cur);
        for (int t = 0; t < nt; t += 2) {
            const bool last = (t == nt - 2); const int fst = (t == 0 && ui > 0) ? 1 : 0;
            if constexpr (Epi::HOOKS) { if (t == 4 || t == 8) E.hook(acc, cur, t, wr, wc, fr, fq); }
            const char* a1 = cA + (size_t)(t + 1) * kstep;
            const char* a2 = last ? nA : cA + (size_t)(t + 2) * kstep; const char* b2 = last ? nB : cB + (size_t)(t + 2) * kstep;
            const char* a3 = a2 + kstep; const char* b3 = b2 + kstep;
            PG8_LDB(B0, 0, 0); PG8_LDB(B1, 0, 1); PG8_SCHED; PG8_LDA(At, 0, 0); PG8_STAGE(PG8_SA(1, 1), a1 + hstepA, voffA);
            PG8_WAIT_SEL(18, 34); PG8_WAIT_L(0); PG8_BAR; PG8_MMA(0, 0, At, B0); PG8_MMA(0, 1, At, B1); PG8_BAR; PG8_SCHED;
            PG8_LDA(At, 0, 1); PG8_STAGE(PG8_SB(0, 0), b2, voffB); PG8_STAGE(PG8_SB(0, 1), b2 + hstepB, voffB); PG8_STAGE(PG8_SA(0, 0), a2, voffA);
            PG8_WAIT_SEL(24, 40); PG8_WAIT_L(0); PG8_BAR; PG8_MMA(1, 0, At, B0); PG8_MMA(1, 1, At, B1); PG8_BAR; PG8_SCHED;
            PG8_LDB(B0, 1, 0); PG8_LDB(B1, 1, 1); PG8_SCHED; PG8_LDA(At, 1, 0); PG8_STAGE(PG8_SA(0, 1), a2 + hstepA, voffA);
            PG8_WAIT_SEL(26, 42); PG8_WAIT_L(0); PG8_BAR; PG8_MMA(0, 0, At, B0); PG8_MMA(0, 1, At, B1); PG8_BAR; PG8_SCHED;
            PG8_LDA(At, 1, 1); PG8_STAGE(PG8_SB(1, 0), b3, voffB); PG8_STAGE(PG8_SB(1, 1), b3 + hstepB, voffB); PG8_STAGE(PG8_SA(1, 0), a3, voffA);
            PG8_WAIT_V(8); PG8_WAIT_L(0); PG8_BAR; PG8_MMA(1, 0, At, B0); PG8_MMA(1, 1, At, B1); PG8_BAR; PG8_SCHED;
        }
        if (wr == 0) PG8_BAR;
        E(acc, cur, wr, wc, fr, fq);
        if (!has_next) break;
#pragma unroll
        for (int a = 0; a < 2; ++a)
#pragma unroll
            for (int b = 0; b < 2; ++b)
#pragma unroll
                for (int m = 0; m < 4; ++m)
#pragma unroll
                    for (int n = 0; n < 2; ++n) acc[a][b][m][n] = (f32x4){0.f, 0.f, 0.f, 0.f};
        cur = nxt; cA = nA; cB = nB; ++ui;
        if (wr == 1) PG8_BAR;
    }
    PG8_WAIT_V(0);
    PG8_BAR;
#undef PG8_SA
#undef PG8_SB
#undef PG8_STAGE
#undef PG8_LDA
#undef PG8_LDB
#undef PG8_MMA
#undef PG8_WAIT_V
#undef PG8_WAIT_L
#undef PG8_BAR
#undef PG8_WAIT_SEL
#undef PG8_WAIT_SEL1
#undef PG8_SCHED
}
}

constexpr int NWAVES = 8, NTHR = 512;
constexpr int DM = 1024, NB = 4, SEQ = 8192, ML = NB * SEQ, CTXL = 256, MC = NB * CTXL, MT = ML + MC;
constexpr int NIN_ORIG = 5632, NPXA = 2816, NPXG = 3072, NIN = NPXA + NPXG;
constexpr int OFF_P = 0, OFF_Q = 256, OFF_CU = 512, OFF_CB = 768, OFF_CC = 1024, OFF_QQ = 1280, OFF_K = 1792, OFF_V = 2304;
constexpr int FF = 4096, NMOD = 6 * DM, NGRP = 5;
constexpr float EPS = 1e-6f;

constexpr size_t MiB = 1u << 20;
constexpr size_t WS_CTL = 0, CTL_ZERO_BYTES = 2 * MiB;
constexpr size_t WS_RS = 262144;
constexpr size_t WS_FCNT = 1441792;
constexpr size_t WS_ZERO = 1572864;
constexpr size_t WS_RS5 = 1703936;
constexpr size_t WS_TW = 2 * MiB;
constexpr size_t WS_MOD = 2 * MiB + 65536;
constexpr size_t WS_GN = 2 * MiB + 524288;
constexpr size_t WS_CIN = 2 * MiB + 786432;
constexpr size_t WS_CUP = 3 * MiB;
constexpr size_t WS_MODP = 510 * MiB;
constexpr size_t WS_CTXX = 4 * MiB;
constexpr size_t WS_WIN = 8 * MiB, WS_WM = 20 * MiB, WS_WO = 22 * MiB, WS_W1 = 24 * MiB, WS_W2 = 32 * MiB;
constexpr size_t WS_HX = 40 * MiB;
constexpr size_t WS_PXA = 106 * MiB;
constexpr size_t WS_PXG = 288 * MiB;
constexpr size_t WS_TB = 486 * MiB;
constexpr size_t WS_M = WS_PXA;
constexpr size_t WS_ACT = WS_PXA;
constexpr size_t WS_PART = 400 * MiB;
constexpr size_t WS_STREAM1 = 416 * MiB;
constexpr size_t WS_END = 512 * MiB;
static_assert(WS_PXA + (size_t)MT * NPXA * 2 <= WS_PXG && WS_PXG + (size_t)MT * NPXG * 2 <= WS_TB && WS_ACT + (size_t)MT * FF * 2 <= WS_TB && WS_HX + (size_t)MT * DM * 2 <= WS_PXA, "ws map");
constexpr int CW_TMO = 0, CW_BAR = 4096;

constexpr int RING_BYTES = 131072, LDSCTL_OFF = 155648, MISC_OFF = LDSCTL_OFF + 320, LDS_BYTES = 163840;

#define GAS __attribute__((address_space(1)))
#define LAS __attribute__((address_space(3)))
typedef unsigned short bf16;
typedef unsigned v4u __attribute__((ext_vector_type(4)));
typedef unsigned v2u __attribute__((ext_vector_type(2)));
typedef float f32x4 __attribute__((ext_vector_type(4)));
typedef GAS unsigned gu32;
#define RLX_AGENT __ATOMIC_RELAXED, __HIP_MEMORY_SCOPE_AGENT
#define LDS_WAIT() asm volatile("s_waitcnt lgkmcnt(0)" ::: "memory")
__device__ __forceinline__ unsigned f2bf(float f) { unsigned u = __builtin_bit_cast(unsigned, f); return (u + 0x7fffu + ((u >> 16) & 1u)) >> 16; }
__device__ __forceinline__ unsigned pk2(float lo, float hi) { return f2bf(lo) | (f2bf(hi) << 16); }
__device__ __forceinline__ float bf2f(unsigned h) { return __uint_as_float(h << 16); }
__device__ __forceinline__ float bflo(unsigned w) { return __uint_as_float(w << 16); }
__device__ __forceinline__ float bfhi(unsigned w) { return __uint_as_float(w & 0xffff0000u); }

#define XB_TMO      128
#define XB_XCNT(j)  (256  + 64 * (j))
#define XB_XSUB(j)  (1280 + 64 * (j))
#define XB_XGEN(j)  (2304 + 64 * (j))
#define XB_TOP      3328
#define XB_TOPGEN   3392
#define XCD_BAR_WORDS 3456
#define XB_SPIN_CAP (1u << 22)
__device__ __forceinline__ unsigned xb_ld(unsigned* p)              { return __hip_atomic_load(p, __ATOMIC_RELAXED, __HIP_MEMORY_SCOPE_AGENT); }
__device__ __forceinline__ unsigned xb_add(unsigned* p, unsigned v) { return __hip_atomic_fetch_add(p, v, __ATOMIC_RELAXED, __HIP_MEMORY_SCOPE_AGENT); }
__device__ __forceinline__ unsigned xb_xcc_id() { return (unsigned)__builtin_amdgcn_s_getreg((3 << 11) | 20) & 0xFu; }
#define XB_SPIN(cond, bar) do { unsigned _sp = 0; while (cond) { __builtin_amdgcn_s_sleep(1); \
    if ((++_sp & 255u) == 0u) { if (xb_ld(&(bar)[XB_TMO])) break; if (_sp > XB_SPIN_CAP) { atomicAdd(&(bar)[XB_TMO], 1u); break; } } } } while (0)
struct XcdBarrier { unsigned* bar; unsigned x; volatile LAS unsigned* st; };
__device__ __forceinline__ XcdBarrier xcd_barrier_post(unsigned* bar, volatile LAS unsigned* st, bool leader) {
    XcdBarrier b; b.bar = bar; b.x = xb_xcc_id(); b.st = st;
    if (leader) { const unsigned rank = xb_add(&bar[XB_XCNT(b.x)], 1u); st[2] = rank; }
    return b;
}
__device__ __forceinline__ void xcd_barrier_complete(unsigned* bar, unsigned x, unsigned& nloc, unsigned& nx) {
    const unsigned G = gridDim.x * gridDim.y * gridDim.z;
    unsigned sum, cnt, mine, sp = 0u;
    for (;;) {
        sum = 0u; cnt = 0u; mine = 0u;
#pragma unroll
        for (unsigned j = 0; j < 16; ++j) { const unsigned c = xb_ld(&bar[XB_XCNT(j)]); sum += c; cnt += (c > 0u) ? 1u : 0u; mine = (j == x) ? c : mine; }
        if (sum == G) break;
        __builtin_amdgcn_s_sleep(1);
        if ((++sp & 255u) == 0u) { if (xb_ld(&bar[XB_TMO])) break; if (sp > XB_SPIN_CAP) { atomicAdd(&bar[XB_TMO], 1u); break; } }
    }
    nloc = mine > 0u ? mine : 1u; nx = cnt > 0u ? cnt : 1u;
}
__device__ __forceinline__ void xcd_barrier(const XcdBarrier& b, bool leader) {
    asm volatile("s_waitcnt vmcnt(0)" ::: "memory");
    __syncthreads();
    if (leader) {
        unsigned* bar = b.bar;
        __builtin_amdgcn_s_waitcnt(0);
        unsigned nloc = b.st[0], nx = b.st[1];
        if (nloc == 0u) { xcd_barrier_complete(bar, b.x, nloc, nx); b.st[0] = nloc; b.st[1] = nx; }
        const unsigned old = xb_add(&bar[XB_XSUB(b.x)], 1u);
        const unsigned gen = old / nloc;
        if (old + 1u == (gen + 1u) * nloc) {
            __builtin_amdgcn_fence(__ATOMIC_RELEASE, "agent");
            asm volatile("s_waitcnt vmcnt(0)" ::: "memory");
            const unsigned og = xb_add(&bar[XB_TOP], 1u);
            const unsigned tg = og / nx;
            if (og + 1u == (tg + 1u) * nx) xb_add(&bar[XB_TOPGEN], 1u);
            else XB_SPIN(xb_ld(&bar[XB_TOPGEN]) == tg, bar);
            __builtin_amdgcn_fence(__ATOMIC_ACQUIRE, "agent");
            xb_add(&bar[XB_XGEN(b.x)], 1u);
            asm volatile("s_waitcnt vmcnt(0)" ::: "memory");
        } else {
            XB_SPIN(xb_ld(&bar[XB_XGEN(b.x)]) == gen, bar);
            __builtin_amdgcn_fence(__ATOMIC_ACQUIRE, "agent");
            asm volatile("s_waitcnt vmcnt(0)" ::: "memory");
        }
    }
    __syncthreads();
}

__device__ __forceinline__ float wave_sum(float v) {
#pragma unroll
    for (int o = 1; o < 64; o <<= 1) v += __shfl_xor(v, o);
    return v;
}
__device__ __forceinline__ float wave_max(float v) {
#pragma unroll
    for (int o = 1; o < 64; o <<= 1) v = fmaxf(v, __shfl_xor(v, o));
    return v;
}

__device__ __forceinline__ void transpose_item(const float* W, int ldw, int ncols, bf16* WT, int ldwt, int row_off, int k_off, LAS float* scr, int item, int lane) {
    const int nblk = ncols / 32, kb = item / nblk, nb = item % nblk, k0 = 64 * kb, n0 = 32 * nb;
#pragma unroll 8
    for (int i = 0; i < 32; ++i) { const int kk = 2 * i + (lane >> 5); scr[kk * 33 + (lane & 31)] = W[(size_t)(k0 + kk) * ldw + n0 + (lane & 31)]; }
    LDS_WAIT(); asm volatile("" ::: "memory");
    const int c = lane & 7;
#pragma unroll
    for (int j = 0; j < 4; ++j) { const int n = (lane >> 3) + 8 * j; const LAS float* s = scr + (8 * c) * 33 + n;
        v4u o; o.x = pk2(s[0 * 33], s[1 * 33]); o.y = pk2(s[2 * 33], s[3 * 33]); o.z = pk2(s[4 * 33], s[5 * 33]); o.w = pk2(s[6 * 33], s[7 * 33]);
        *(v4u*)(WT + (size_t)(row_off + n0 + n) * ldwt + k_off + k0 + 8 * c) = o; }
    LDS_WAIT(); asm volatile("" ::: "memory");
}

using pg8::Unit; using pg8::cvt_pk_bf16;
typedef unsigned long long u64;
constexpr int NTM = MT / 256;
__device__ __forceinline__ size_t gate_tile(int g, int pm, int pn) { return (size_t)((g * NTM + pm) * 4 + pn) * 65536; }
__device__ __forceinline__ int gate_piece(int ai, int m, int bj, int wave, int lane) { return ((((ai * 4 + m) * 2 + bj) * 8 + wave) * 64 + lane) * 8; }
__device__ __forceinline__ size_t gate_elem(int g, int row, int col) {
    const int r = row & 255, c = col & 255;
    return gate_tile(g, row >> 8, col >> 8) + gate_piece(r >> 7, (r >> 4) & 3, c >> 7, ((r >> 6) & 1) * 4 + ((c >> 5) & 3), ((c >> 3) & 3) * 16 + (r & 15)) + (c & 7);
}
__device__ __forceinline__ float rs_to_rstd(u64 q) { return __builtin_amdgcn_rsqf((float)q * (1.0f / (16777216.0f * DM)) + EPS); }
struct EpiIn {
    static constexpr bool PERM = true, HOOKS = false; static constexpr int NST = 16;
    bf16* pxa; bf16* pxg; const u64* rs; const float* cin;
    __device__ __forceinline__ void operator()(const f32x4 (&acc)[2][2][4][2], const Unit& u, int wr, int wc, int fr, int fq) const {
        asm volatile("" : "+v"(fr), "+v"(fq));
        const bool gate = u.pn >= 11; bf16* base = gate ? pxg : pxa; const int ldc = gate ? NPXG : NPXA; const int colt = (gate ? u.pn - 11 : u.pn) * 256;
        const int grp = u.pm >= 128 ? 4 : (u.pm >> 5);
        const int row0 = u.pm * 256 + wr * 64 + fr, col0 = colt + wc * 32 + 8 * fq;
        const float* cp = cin + grp * NIN + u.pn * 256 + wc * 32 + 8 * fq;
        bf16* gbase = pxg + (gate ? gate_tile((u.pn - 11) >> 2, u.pm, (u.pn - 11) & 3) : 0);
        const float gsc = gate ? -1.4426950408889634f : 1.0f;
        f32x4 cv[2][2];
#pragma unroll
        for (int bj = 0; bj < 2; ++bj) { cv[bj][0] = *(const f32x4*)(cp + bj * 128) * gsc; cv[bj][1] = *(const f32x4*)(cp + bj * 128 + 4) * gsc; }
        u64 rq[2][4]; float rsv[2][4];
#pragma unroll
        for (int ai = 0; ai < 2; ++ai)
#pragma unroll
            for (int m = 0; m < 4; ++m) rq[ai][m] = rs[row0 + ai * 128 + m * 16];
        asm volatile("" ::: "memory");
#pragma unroll
        for (int ai = 0; ai < 2; ++ai)
#pragma unroll
            for (int m = 0; m < 4; ++m) rsv[ai][m] = rs_to_rstd(rq[ai][m]) * gsc;
#pragma unroll
        for (int ai = 0; ai < 2; ++ai)
#pragma unroll
            for (int m = 0; m < 4; ++m) { const int row = row0 + ai * 128 + m * 16; bf16* rowp = base + (size_t)row * ldc + col0; const float rstd = rsv[ai][m];
#pragma unroll
                for (int bj = 0; bj < 2; ++bj) { f32x4 v0 = acc[ai][bj][m][0] * rstd + cv[bj][0], v1 = acc[ai][bj][m][1] * rstd + cv[bj][1];
                    if (gate) {
#pragma unroll
                        for (int e = 0; e < 4; ++e) { v0[e] = 1.0f + __builtin_amdgcn_exp2f(__builtin_amdgcn_fmed3f(v0[e], -120.0f, 120.0f)); v1[e] = 1.0f + __builtin_amdgcn_exp2f(__builtin_amdgcn_fmed3f(v1[e], -120.0f, 120.0f)); } }
                    v4u w; w.x = cvt_pk_bf16(v0[0], v0[1]); w.y = cvt_pk_bf16(v0[2], v0[3]); w.z = cvt_pk_bf16(v1[0], v1[1]); w.w = cvt_pk_bf16(v1[2], v1[3]);
                    if (gate) *(v4u*)(gbase + gate_piece(ai, m, bj, wr * 4 + wc, fq * 16 + fr)) = w;
                    else *(v4u*)(rowp + bj * 128) = w; } }
    }
};
struct EpiMerge {
    static constexpr bool PERM = true, HOOKS = true; static constexpr int NST = 16;
    bf16* m; const bf16* pxg;
    __device__ __forceinline__ void hook(f32x4 (&acc)[2][2][4][2], const Unit& u, int t, int wr, int wc, int fr, int fq) const {
        asm volatile("" : "+v"(fr), "+v"(fq));
        const int wv = wr * 4 + wc, ln = fq * 16 + fr;
        const bf16* gnum = pxg + gate_tile(t == 4 ? 0 : 1, u.pm, u.pn); const bf16* gden = pxg + gate_tile(t == 4 ? 1 : 2, u.pm, u.pn);
#pragma unroll
        for (int ai = 0; ai < 2; ++ai)
#pragma unroll
            for (int mp = 0; mp < 2; ++mp) {
                v4u gn[2][2], gd[2][2];
#pragma unroll
                for (int mq = 0; mq < 2; ++mq)
#pragma unroll
                    for (int bj = 0; bj < 2; ++bj) { const int ro = gate_piece(ai, 2 * mp + mq, bj, wv, ln); gn[mq][bj] = *(const v4u*)(gnum + ro); gd[mq][bj] = *(const v4u*)(gden + ro); }
                asm volatile("" ::: "memory");
#pragma unroll
                for (int mq = 0; mq < 2; ++mq)
#pragma unroll
                    for (int bj = 0; bj < 2; ++bj) { const v4u a = gn[mq][bj], d = gd[mq][bj];
                        f32x4& v0 = acc[ai][bj][2 * mp + mq][0]; f32x4& v1 = acc[ai][bj][2 * mp + mq][1];
                        v0[0] *= bflo(d.x) * __builtin_amdgcn_rcpf(bflo(a.x)); v0[1] *= bfhi(d.x) * __builtin_amdgcn_rcpf(bfhi(a.x));
                        v0[2] *= bflo(d.y) * __builtin_amdgcn_rcpf(bflo(a.y)); v0[3] *= bfhi(d.y) * __builtin_amdgcn_rcpf(bfhi(a.y));
                        v1[0] *= bflo(d.z) * __builtin_amdgcn_rcpf(bflo(a.z)); v1[1] *= bfhi(d.z) * __builtin_amdgcn_rcpf(bfhi(a.z));
                        v1[2] *= bflo(d.w) * __builtin_amdgcn_rcpf(bflo(a.w)); v1[3] *= bfhi(d.w) * __builtin_amdgcn_rcpf(bfhi(a.w)); }
            }
    }
    __device__ __forceinline__ void operator()(const f32x4 (&acc)[2][2][4][2], const Unit& u, int wr, int wc, int fr, int fq) const {
        asm volatile("" : "+v"(fr), "+v"(fq));
        const int row0 = u.pm * 256 + wr * 64 + fr, col0 = u.pn * 256 + wc * 32 + 8 * fq;
        const bf16* ga = pxg + gate_tile(2, u.pm, u.pn);
#pragma unroll
        for (int ai = 0; ai < 2; ++ai) {
            v4u g[4][2];
#pragma unroll
            for (int mm = 0; mm < 4; ++mm)
#pragma unroll
                for (int bj = 0; bj < 2; ++bj) g[mm][bj] = *(const v4u*)(ga + gate_piece(ai, mm, bj, wr * 4 + wc, fq * 16 + fr));
            asm volatile("" ::: "memory");
#pragma unroll
            for (int mm = 0; mm < 4; ++mm)
#pragma unroll
                for (int bj = 0; bj < 2; ++bj) { const f32x4 v0 = acc[ai][bj][mm][0], v1 = acc[ai][bj][mm][1]; const v4u gg = g[mm][bj];
#define RC(x) __builtin_amdgcn_rcpf(x)
                    v4u w; w.x = cvt_pk_bf16(v0[0] * RC(bflo(gg.x)), v0[1] * RC(bfhi(gg.x))); w.y = cvt_pk_bf16(v0[2] * RC(bflo(gg.y)), v0[3] * RC(bfhi(gg.y)));
                    w.z = cvt_pk_bf16(v1[0] * RC(bflo(gg.z)), v1[1] * RC(bfhi(gg.z))); w.w = cvt_pk_bf16(v1[2] * RC(bflo(gg.w)), v1[3] * RC(bfhi(gg.w)));
#undef RC
                    *(v4u*)(m + (size_t)(row0 + ai * 128 + mm * 16) * DM + col0 + bj * 128) = w; }
        }
    }
};
template <bool BF  >
struct EpiRes {
    static constexpr bool PERM = true, HOOKS = false; static constexpr int NST = 32;
    const void* base_l; bf16* out; const float* gate;
    float* part;
    const float* gn; bf16* ap; u64* rs;
    __device__ __forceinline__ void operator()(const f32x4 (&acc)[2][2][4][2], const Unit& u, int wr, int wc, int fr, int fq) const {
        asm volatile("" : "+v"(fr), "+v"(fq));
        const bool isc = u.pm >= 128; const int grp = isc ? 4 : (u.pm >> 5);
        const int row0 = (isc ? (u.pm - 128) : u.pm) * 256 + wr * 64 + fr, col0 = u.pn * 256 + wc * 32 + 8 * fq;
        if (isc) {
            if (part == nullptr) return;
            float* po = part + (size_t)u.br * 1024 * 1024;
#pragma unroll
            for (int ai = 0; ai < 2; ++ai)
#pragma unroll
                for (int m = 0; m < 4; ++m)
#pragma unroll
                    for (int bj = 0; bj < 2; ++bj)
#pragma unroll
                        for (int n = 0; n < 2; ++n) *(f32x4*)(po + (size_t)(row0 + ai * 128 + m * 16) * DM + col0 + bj * 128 + n * 4) = acc[ai][bj][m][n];
            return;
        }
        f32x4 gv[2][2], gnv[2][2];
#pragma unroll
        for (int bj = 0; bj < 2; ++bj)
#pragma unroll
            for (int n = 0; n < 2; ++n) { gv[bj][n] = *(const f32x4*)(gate + grp * NMOD + col0 + bj * 128 + n * 4); gnv[bj][n] = *(const f32x4*)(gn + grp * DM + col0 + bj * 128 + n * 4); }
#pragma unroll
        for (int ai = 0; ai < 2; ++ai)
#pragma unroll
            for (int mp = 0; mp < 2; ++mp) {
                f32x4 bs[2][2][2];
                if constexpr (BF) {
                    v4u bb[2][2];
#pragma unroll
                    for (int mq = 0; mq < 2; ++mq)
#pragma unroll
                        for (int bj = 0; bj < 2; ++bj) bb[mq][bj] = *(const v4u*)((const bf16*)base_l + (size_t)(row0 + ai * 128 + (2 * mp + mq) * 16) * DM + col0 + bj * 128);
                    asm volatile("" ::: "memory");
#pragma unroll
                    for (int mq = 0; mq < 2; ++mq)
#pragma unroll
                        for (int bj = 0; bj < 2; ++bj) { const v4u b = bb[mq][bj]; bs[mq][bj][0] = (f32x4){bflo(b.x), bfhi(b.x), bflo(b.y), bfhi(b.y)}; bs[mq][bj][1] = (f32x4){bflo(b.z), bfhi(b.z), bflo(b.w), bfhi(b.w)}; }
                } else {
#pragma unroll
                    for (int mq = 0; mq < 2; ++mq)
#pragma unroll
                        for (int bj = 0; bj < 2; ++bj)
#pragma unroll
                            for (int n = 0; n < 2; ++n) bs[mq][bj][n] = *(const f32x4*)((const float*)base_l + (size_t)(row0 + ai * 128 + (2 * mp + mq) * 16) * DM + col0 + bj * 128 + n * 4);
                    asm volatile("" ::: "memory");
                }
#pragma unroll
                for (int mq = 0; mq < 2; ++mq) { const int m = 2 * mp + mq; float ss = 0.f; const size_t ro = (size_t)(row0 + ai * 128 + m * 16) * DM + col0;
#pragma unroll
                    for (int bj = 0; bj < 2; ++bj) {
                        const f32x4 o0 = bs[mq][bj][0] + gv[bj][0] * acc[ai][bj][m][0], o1 = bs[mq][bj][1] + gv[bj][1] * acc[ai][bj][m][1];
                        v4u ow; ow.x = cvt_pk_bf16(o0[0], o0[1]); ow.y = cvt_pk_bf16(o0[2], o0[3]); ow.z = cvt_pk_bf16(o1[0], o1[1]); ow.w = cvt_pk_bf16(o1[2], o1[3]);
                        *(v4u*)(out + ro + bj * 128) = ow;
                        const f32x4 y0 = o0 * gnv[bj][0], y1 = o1 * gnv[bj][1];
                        v4u w; w.x = cvt_pk_bf16(y0[0], y0[1]); w.y = cvt_pk_bf16(y0[2], y0[3]); w.z = cvt_pk_bf16(y1[0], y1[1]); w.w = cvt_pk_bf16(y1[2], y1[3]);
                        *(v4u*)(ap + ro + bj * 128) = w;
                        ss += ((o0[0] * o0[0] + o0[1] * o0[1]) + (o0[2] * o0[2] + o0[3] * o0[3])) + ((o1[0] * o1[0] + o1[1] * o1[1]) + (o1[2] * o1[2] + o1[3] * o1[3])); }
                    ss += __shfl_xor(ss, 16); ss += __shfl_xor(ss, 32);
                    if (fq == 0) __hip_atomic_fetch_add(rs + row0 + ai * 128 + m * 16, (u64)(ss * 16777216.0f + 0.5f), __ATOMIC_RELAXED, __HIP_MEMORY_SCOPE_AGENT); }
            }
    }
};
struct EpiResFinal {
    static constexpr bool PERM = true, HOOKS = false; static constexpr int NST = 32;
    const bf16* xs; float* xo; const float* gate; const float* fg; u64* rs; unsigned* cnt; unsigned* tmo;
    __device__ __forceinline__ void operator()(f32x4 (&acc)[2][2][4][2], const Unit& u, int wr, int wc, int fr, int fq) const {
        asm volatile("" : "+v"(fr), "+v"(fq));
        const int grp = u.pm >> 5, row0 = u.pm * 256 + wr * 64 + fr, col0 = u.pn * 256 + wc * 32 + 8 * fq;
        f32x4 gv[2][2];
#pragma unroll
        for (int bj = 0; bj < 2; ++bj)
#pragma unroll
            for (int n = 0; n < 2; ++n) gv[bj][n] = *(const f32x4*)(gate + grp * NMOD + col0 + bj * 128 + n * 4);
#pragma unroll
        for (int ai = 0; ai < 2; ++ai)
#pragma unroll
            for (int mp = 0; mp < 2; ++mp) {
                f32x4 bs[2][2][2];
                { v4u bb[2][2];
#pragma unroll
                  for (int mq = 0; mq < 2; ++mq)
#pragma unroll
                      for (int bj = 0; bj < 2; ++bj) bb[mq][bj] = *(const v4u*)(xs + (size_t)(row0 + ai * 128 + (2 * mp + mq) * 16) * DM + col0 + bj * 128);
                  asm volatile("" ::: "memory");
#pragma unroll
                  for (int mq = 0; mq < 2; ++mq)
#pragma unroll
                      for (int bj = 0; bj < 2; ++bj) { const v4u b = bb[mq][bj]; bs[mq][bj][0] = (f32x4){bflo(b.x), bfhi(b.x), bflo(b.y), bfhi(b.y)}; bs[mq][bj][1] = (f32x4){bflo(b.z), bfhi(b.z), bflo(b.w), bfhi(b.w)}; } }
#pragma unroll
                for (int mq = 0; mq < 2; ++mq) { const int m = 2 * mp + mq; float ss = 0.f;
#pragma unroll
                    for (int bj = 0; bj < 2; ++bj)
#pragma unroll
                        for (int n = 0; n < 2; ++n) { const f32x4 o = bs[mq][bj][n] + gv[bj][n] * acc[ai][bj][m][n]; acc[ai][bj][m][n] = o; ss += (o[0] * o[0] + o[1] * o[1]) + (o[2] * o[2] + o[3] * o[3]); }
                    ss += __shfl_xor(ss, 16); ss += __shfl_xor(ss, 32);
                    if (fq == 0) __hip_atomic_fetch_add(rs + row0 + ai * 128 + m * 16, (u64)(ss * 16777216.0f + 0.5f), __ATOMIC_RELAXED, __HIP_MEMORY_SCOPE_AGENT); }
            }
        asm volatile("s_waitcnt vmcnt(0)" ::: "memory");
        unsigned* pc = cnt + 64 * u.pm;
        if (__builtin_amdgcn_mbcnt_hi(~0u, __builtin_amdgcn_mbcnt_lo(~0u, 0u)) == 0) __hip_atomic_fetch_add(pc, 1u, __ATOMIC_RELAXED, __HIP_MEMORY_SCOPE_AGENT);
        { unsigned spins = 0;
          while ((unsigned)__builtin_amdgcn_readfirstlane(__hip_atomic_load(pc, __ATOMIC_RELAXED, __HIP_MEMORY_SCOPE_AGENT)) < 32u) {
              __builtin_amdgcn_s_sleep(2);
              if (++spins > (1u << 22)) { __hip_atomic_store(tmo, 1u, __ATOMIC_RELAXED, __HIP_MEMORY_SCOPE_AGENT); break; } } }
        f32x4 fgv[2][2];
#pragma unroll
        for (int bj = 0; bj < 2; ++bj)
#pragma unroll
            for (int n = 0; n < 2; ++n) fgv[bj][n] = *(const f32x4*)(fg + col0 + bj * 128 + n * 4);
#pragma unroll
        for (int ai = 0; ai < 2; ++ai)
#pragma unroll
            for (int m = 0; m < 4; ++m) { const int row = row0 + ai * 128 + m * 16;
                const float rstd = rs_to_rstd(__hip_atomic_load(rs + row, __ATOMIC_RELAXED, __HIP_MEMORY_SCOPE_AGENT));
#pragma unroll
                for (int bj = 0; bj < 2; ++bj)
#pragma unroll
                    for (int n = 0; n < 2; ++n) *(f32x4*)(xo + (size_t)row * DM + col0 + bj * 128 + n * 4) = acc[ai][bj][m][n] * rstd * fgv[bj][n]; }
    }
};
struct EpiAct {
    static constexpr bool PERM = true, HOOKS = false; static constexpr int NST = 16;
    bf16* a; const u64* rs; const float* cup;
    __device__ __forceinline__ void operator()(const f32x4 (&acc)[2][2][4][2], const Unit& u, int wr, int wc, int fr, int fq) const {
        asm volatile("" : "+v"(fr), "+v"(fq));
        const int grp = u.pm >= 128 ? 4 : (u.pm >> 5);
        const int row0 = u.pm * 256 + wr * 64 + fr, col0 = u.pn * 256 + wc * 32 + 8 * fq;
        const float* cp = cup + grp * FF + col0;
        f32x4 cv[2][2];
#pragma unroll
        for (int bj = 0; bj < 2; ++bj) { cv[bj][0] = *(const f32x4*)(cp + bj * 128); cv[bj][1] = *(const f32x4*)(cp + bj * 128 + 4); }
        u64 rq[2][4]; float rsv[2][4];
#pragma unroll
        for (int ai = 0; ai < 2; ++ai)
#pragma unroll
            for (int m = 0; m < 4; ++m) rq[ai][m] = rs[row0 + ai * 128 + m * 16];
        asm volatile("" ::: "memory");
#pragma unroll
        for (int ai = 0; ai < 2; ++ai)
#pragma unroll
            for (int m = 0; m < 4; ++m) rsv[ai][m] = rs_to_rstd(rq[ai][m]);
#pragma unroll
        for (int ai = 0; ai < 2; ++ai)
#pragma unroll
            for (int m = 0; m < 4; ++m) { const int row = row0 + ai * 128 + m * 16; bf16* rowp = a + (size_t)row * FF + col0; const float rstd = rsv[ai][m];
#pragma unroll
                for (int bj = 0; bj < 2; ++bj) { f32x4 v0 = acc[ai][bj][m][0] * rstd + cv[bj][0], v1 = acc[ai][bj][m][1] * rstd + cv[bj][1];
#pragma unroll
                    for (int e = 0; e < 4; ++e) { const float r0 = fmaxf(v0[e], 0.f), r1 = fmaxf(v1[e], 0.f); v0[e] = r0 * r0; v1[e] = r1 * r1; }
                    v4u w; w.x = cvt_pk_bf16(v0[0], v0[1]); w.y = cvt_pk_bf16(v0[2], v0[3]); w.z = cvt_pk_bf16(v1[0], v1[1]); w.w = cvt_pk_bf16(v1[2], v1[3]);
                    *(v4u*)(rowp + bj * 128) = w; } }
    }
};

constexpr int NS = 8;
constexpr int NSTEPS = 2 + 2 * NS;
constexpr int LARGS_OFF = LDSCTL_OFF + 1024;
enum { A_X = 0, A_C, A_CTX, A_CCTX, A_ADAW, A_ADAB, A_N1G, A_N2G, A_WIN, A_CONVW, A_RELB, A_WF, A_WC, A_WA, A_WO, A_W1, A_W2, A_FG, A_OUT, A_WS, A_NARGS };

struct Ctx { LAS unsigned char* lds; int wave, G, bx, gw, NGW, NGT;
    __device__ __forceinline__ int lane() const { int l; asm volatile("v_mbcnt_lo_u32_b32 %0, -1, 0\n\tv_mbcnt_hi_u32_b32 %0, -1, %0" : "=v"(l)); return l; }
    __device__ __forceinline__ int tid() const { return wave * 64 + lane(); }
    __device__ __forceinline__ int gt() const { return bx * NTHR + tid(); }
};
template <int I> __device__ __forceinline__ unsigned long long ldarg_t() {
    unsigned long long v; unsigned tmp;
    asm volatile("v_mov_b32 %1, %2\n\tds_read_b64 %0, %1 offset:%3\n\ts_waitcnt lgkmcnt(0)" : "=&v"(v), "=&v"(tmp) : "i"(LARGS_OFF), "i"(I * 8) : "memory");
    const unsigned lo = __builtin_amdgcn_readfirstlane((unsigned)v), hi = __builtin_amdgcn_readfirstlane((unsigned)(v >> 32));
    return ((unsigned long long)hi << 32) | lo;
}
#define ldarg(C, i) ldarg_t<(i)>()
#define ARGF(i) ((const float*)(const GAS float*)ldarg(C, (i)))
#define WSP(T, off) ((T*)(GAS T*)((GAS unsigned char*)ldarg(C, A_WS) + (off)))

__device__ __forceinline__ void ph_mod_partial(const Ctx& C) {
    const float* cvec = ARGF(A_C); const float* cctx = ARGF(A_CCTX); const float* ada_w = ARGF(A_ADAW);
    float* modp = WSP(float, WS_MODP); float2* tw = WSP(float2, WS_TW);
    LAS float* sl = (LAS float*)C.lds;
    for (int item = C.bx; item < 2 * 8 * 12; item += C.G) {
        const int l = item / 96, rem = item % 96, kc = rem / 12, jb = rem % 12;
        __syncthreads();
        for (int e = C.tid(); e < 5 * 128; e += NTHR) { const int g = e >> 7, k = kc * 128 + (e & 127); const float v = g < 4 ? cvec[g * DM + k] : cctx[k]; sl[e] = v / (1.0f + __expf(-v)); }
        __syncthreads();
        const int j = jb * 512 + C.tid(); float a0 = 0.f, a1 = 0.f, a2 = 0.f, a3 = 0.f, a4 = 0.f;
        const float* wp = ada_w + ((size_t)l * DM + kc * 128) * NMOD + j;
#pragma unroll 4
        for (int k = 0; k < 128; ++k) { const float w = wp[(size_t)k * NMOD]; a0 += sl[k] * w; a1 += sl[128 + k] * w; a2 += sl[256 + k] * w; a3 += sl[384 + k] * w; a4 += sl[512 + k] * w; }
        float* pp = modp + ((size_t)(l * 8 + kc) * 5) * NMOD + j;
        pp[0] = a0; pp[NMOD] = a1; pp[2 * NMOD] = a2; pp[3 * NMOD] = a3; pp[4 * NMOD] = a4;
    }
    for (int m = C.gt(); m < 8192; m += C.NGT) { float s, c; sincospif((float)m * (1.0f / 4096.0f), &s, &c); tw[m] = make_float2(c, s); }
}
__device__ __forceinline__ void ph_mod_reduce(const Ctx& C) {
    const float* ada_b = ARGF(A_ADAB); const float* modp = WSP(float, WS_MODP); float* mod = WSP(float, WS_MOD);
    for (int e = C.gt(); e < 2 * 5 * NMOD; e += C.NGT) { const int l = e / (5 * NMOD), r = e % (5 * NMOD), j = r % NMOD; float s = ada_b[l * NMOD + j];
#pragma unroll
        for (int kc = 0; kc < 8; ++kc) s += modp[(size_t)(l * 8 + kc) * 5 * NMOD + r];
        mod[e] = s; }
    float* gnt = WSP(float, WS_GN); const float* n1g = ARGF(A_N1G); const float* n2g = ARGF(A_N2G);
    for (int e = C.gt(); e < 2 * 2 * 5 * DM; e += C.NGT) { const int col = e & 1023, grp = (e >> 10) % 5, w = (e / (5 * DM)) & 1, l = e / (10 * DM), j = (w ? 4 : 1) * DM + col;
        float s = ada_b[l * NMOD + j];
#pragma unroll
        for (int kc = 0; kc < 8; ++kc) s += modp[((size_t)(l * 8 + kc) * 5 + grp) * NMOD + j];
        gnt[e] = (w ? n2g : n1g)[l * DM + col] * (1.0f + s); }
}
__device__ __forceinline__ void ph_ctab(const Ctx& C, int l) {
    LAS float* red = (LAS float*)(C.lds + 131072); LAS float* cu = red + 8 * 5 * 64;
    const float* modl = WSP(const float, WS_MOD) + (size_t)l * 5 * NMOD; const float2* tw = WSP(const float2, WS_TW);
    float* cin = WSP(float, WS_CIN) + (size_t)l * 5 * NIN; float* cup = WSP(float, WS_CUP) + (size_t)l * 5 * FF;
    const int lane = C.lane(), w = C.wave, tid = C.tid();
    for (int it = C.bx; it < 88 + 64; it += C.G) {
        const bool isin = it < 88; const int ldw = isin ? NIN_ORIG : FF, col0 = (isin ? it : it - 88) * 64;
        const float* W = (isin ? ARGF(A_WIN) + (size_t)l * DM * NIN_ORIG : ARGF(A_W1) + (size_t)l * DM * FF) + (size_t)(128 * w) * ldw + col0 + lane;
        const float* shp = modl + (isin ? 0 : 3 * DM) + 128 * w;
        float a0 = 0.f, a1 = 0.f, a2 = 0.f, a3 = 0.f, a4 = 0.f;
#pragma unroll 16
        for (int kk = 0; kk < 128; ++kk) { const float wv = W[(size_t)kk * ldw]; a0 += shp[kk] * wv; a1 += shp[NMOD + kk] * wv; a2 += shp[2 * NMOD + kk] * wv; a3 += shp[3 * NMOD + kk] * wv; a4 += shp[4 * NMOD + kk] * wv; }
        __syncthreads();
        red[(w * 5 + 0) * 64 + lane] = a0; red[(w * 5 + 1) * 64 + lane] = a1; red[(w * 5 + 2) * 64 + lane] = a2; red[(w * 5 + 3) * 64 + lane] = a3; red[(w * 5 + 4) * 64 + lane] = a4;
        __syncthreads();
        if (tid < 320) { const int g = tid >> 6, c = tid & 63; float v = 0.f;
#pragma unroll
            for (int ww = 0; ww < 8; ++ww) v += red[(ww * 5 + g) * 64 + c];
            if (!isin) cup[g * FF + col0 + c] = v; else if (it >= 4) cin[g * NIN + col0 + c + 256] = v; else cu[g * 64 + c] = v; }
        if (isin && it < 4) { __syncthreads();
            if (tid < 320) { const int g = tid >> 6, kc = tid & 63; float p = 0.f, q = 0.f;
                for (int c = 0; c < 64; ++c) { const float2 t = tw[((c * kc) & 63) * 128]; const float v = cu[g * 64 + c]; p += v * t.x; q += v * t.y; }
                cin[g * NIN + it * 64 + kc] = p; cin[g * NIN + 256 + it * 64 + kc] = q; } }
    }
    __syncthreads();
}
__device__ __forceinline__ void ph_weights(const Ctx& C, int l) {
    LAS float* scr = (LAS float*)(C.lds + C.wave * 16384);
    const int lane = C.lane();
    const float* Win = ARGF(A_WIN) + (size_t)l * DM * NIN_ORIG;
    bf16* win_t = WSP(bf16, WS_WIN); bf16* wm_t = WSP(bf16, WS_WM);
    constexpr int I_IN = (DM / 64) * ((NIN_ORIG - 256) / 32), I_F = (256 / 64) * (DM / 32), I_A = (512 / 64) * (DM / 32), I_O = (DM / 64) * (DM / 32), I_1 = (DM / 64) * (FF / 32), I_2 = (FF / 64) * (DM / 32);
    constexpr int NITEMS = I_IN + 2 * I_F + I_A + I_O + I_1 + I_2;
    for (int it = C.gw; it < NITEMS; it += C.NGW) {
        int r = it;
        if (r < I_IN) { transpose_item(Win + 256, NIN_ORIG, NIN_ORIG - 256, win_t, DM, 512, 0, scr, r, lane); continue; } r -= I_IN;
        if (r < I_F) { transpose_item(ARGF(A_WF) + (size_t)l * 256 * DM, DM, DM, wm_t, DM, 0, 0, scr, r, lane); continue; } r -= I_F;
        if (r < I_F) { transpose_item(ARGF(A_WC) + (size_t)l * 256 * DM, DM, DM, wm_t, DM, 0, 256, scr, r, lane); continue; } r -= I_F;
        if (r < I_A) { transpose_item(ARGF(A_WA) + (size_t)l * 512 * DM, DM, DM, wm_t, DM, 0, 512, scr, r, lane); continue; } r -= I_A;
        if (r < I_O) { transpose_item(ARGF(A_WO) + (size_t)l * DM * DM, DM, DM, WSP(bf16, WS_WO), DM, 0, 0, scr, r, lane); continue; } r -= I_O;
        if (r < I_1) { transpose_item(ARGF(A_W1) + (size_t)l * DM * FF, FF, FF, WSP(bf16, WS_W1), DM, 0, 0, scr, r, lane); continue; } r -= I_1;
        transpose_item(ARGF(A_W2) + (size_t)l * FF * DM, DM, DM, WSP(bf16, WS_W2), FF, 0, 0, scr, r, lane);
    }
    for (int it = C.gw; it < 4 * 32 * 8; it += C.NGW) {
        const int kq = it & 7, g = it >> 8, k0 = ((it >> 3) & 31) * 32, kl = lane & 31, pq = lane >> 5;
        LAS float* tile = scr;
        LAS float* ct = scr + 32 * 65;
        { float s, c; sincospif((float)lane * (1.0f / 32.0f), &s, &c); ct[lane] = c; ct[64 + lane] = s; }
#pragma unroll 8
        for (int kk = 0; kk < 32; ++kk) tile[kk * 65 + lane] = Win[(size_t)(k0 + kk) * NIN_ORIG + g * 64 + lane];
        LDS_WAIT(); asm volatile("" ::: "memory");
        float p[8];
#pragma unroll
        for (int j = 0; j < 8; ++j) p[j] = 0.f;
#pragma unroll 4
        for (int c = 0; c < 64; ++c) { const float wv = tile[kl * 65 + c];
#pragma unroll
            for (int j = 0; j < 8; ++j) p[j] += wv * ct[pq * 64 + ((c * (kq * 8 + j)) & 63)]; }
#pragma unroll
        for (int j = 0; j < 8; ++j) win_t[(size_t)(pq * 256 + g * 64 + kq * 8 + j) * DM + k0 + kl] = (bf16)f2bf(p[j]);
        LDS_WAIT(); asm volatile("" ::: "memory");
    }
}
__device__ __forceinline__ void ph_prenorm(const Ctx& C, const float* xl, const float* xc, const float* gn, bf16* dst, u64* rs, int row_begin, int row_end, const float* part, const float* pgate) {
    const int lane = C.lane();
    for (int row = row_begin + C.gw; row < row_end; row += C.NGW) {
        const bool isc = row >= ML; const int grp = isc ? 4 : (row >> 13);
        const float* xr = isc ? xc + (size_t)(row - ML) * DM : xl + (size_t)row * DM;
        f32x4 v[4]; float s2 = 0.f;
#pragma unroll
        for (int j = 0; j < 4; ++j) { v[j] = *(const f32x4*)(xr + 4 * lane + 256 * j);
            if (part != nullptr && isc) {
                const size_t po = (size_t)(row - ML) * DM + 4 * lane + 256 * j;
                const f32x4 ps = (*(const f32x4*)(part + po) + *(const f32x4*)(part + po + 1048576)) + (*(const f32x4*)(part + po + 2 * 1048576) + *(const f32x4*)(part + po + 3 * 1048576));
                v[j] = v[j] + *(const f32x4*)(pgate + 4 * lane + 256 * j) * ps; }
            s2 += (v[j].x * v[j].x + v[j].y * v[j].y) + (v[j].z * v[j].z + v[j].w * v[j].w); }
        s2 = wave_sum(s2);
        if (lane == 0) rs[row] = (u64)(s2 * 16777216.0f + 0.5f);
#pragma unroll
        for (int j = 0; j < 4; ++j) { const int c0 = 4 * lane + 256 * j; const f32x4 y = v[j] * *(const f32x4*)(gn + grp * DM + c0);
            v2u o; o.x = pk2(y.x, y.y); o.y = pk2(y.z, y.w); *(v2u*)(dst + (size_t)row * DM + c0) = o; }
    }
}
__device__ __forceinline__ void ph_mixers(const Ctx& C, int l) {
    const bf16* pxa = WSP(const bf16, WS_PXA); bf16* mix = WSP(bf16, WS_HX);
    const float* cw = ARGF(A_CONVW) + l * 3 * 256;
    const int nrows = l == 0 ? MT : ML;
    for (int e = C.gt(); e < nrows * 32; e += C.NGT) {
        const int row = e >> 5, ch = (e & 31) * 8;
        const int pos = row < ML ? (row & (SEQ - 1)) : ((row - ML) & 255), len = row < ML ? SEQ : 256;
        const bf16* pr = pxa + (size_t)row * NPXA;
        const v4u u1 = *(const v4u*)(pr + OFF_CU + ch), c1 = *(const v4u*)(pr + OFF_CC + ch), b1 = *(const v4u*)(pr + OFF_CB + ch);
        v4u u0 = (v4u){0, 0, 0, 0}, c0 = u0, u2 = u0, c2 = u0;
        if (pos > 0) { u0 = *(const v4u*)(pr - NPXA + OFF_CU + ch); c0 = *(const v4u*)(pr - NPXA + OFF_CC + ch); }
        if (pos < len - 1) { u2 = *(const v4u*)(pr + NPXA + OFF_CU + ch); c2 = *(const v4u*)(pr + NPXA + OFF_CC + ch); }
        float o[8]; float w0[8], w1[8], w2[8];
        { const f32x4 t0 = *(const f32x4*)(cw + ch), t1 = *(const f32x4*)(cw + ch + 4), t2 = *(const f32x4*)(cw + 256 + ch), t3 = *(const f32x4*)(cw + 256 + ch + 4), t4 = *(const f32x4*)(cw + 512 + ch), t5 = *(const f32x4*)(cw + 512 + ch + 4);
#pragma unroll
          for (int j = 0; j < 4; ++j) { w0[j] = t0[j]; w0[4 + j] = t1[j]; w1[j] = t2[j]; w1[4 + j] = t3[j]; w2[j] = t4[j]; w2[4 + j] = t5[j]; } }
#pragma unroll
        for (int j = 0; j < 4; ++j) {
            const unsigned a0 = u0[j], d0 = c0[j], a1 = u1[j], d1 = c1[j], a2 = u2[j], d2 = c2[j], bb = b1[j];
            o[2 * j] = bflo(bb) * (w0[2 * j] * bflo(a0) * bflo(d0) + w1[2 * j] * bflo(a1) * bflo(d1) + w2[2 * j] * bflo(a2) * bflo(d2));
            o[2 * j + 1] = bfhi(bb) * (w0[2 * j + 1] * bfhi(a0) * bfhi(d0) + w1[2 * j + 1] * bfhi(a1) * bfhi(d1) + w2[2 * j + 1] * bfhi(a2) * bfhi(d2));
        }
        v4u w; w.x = pk2(o[0], o[1]); w.y = pk2(o[2], o[3]); w.z = pk2(o[4], o[5]); w.w = pk2(o[6], o[7]);
        *(v4u*)(mix + (size_t)row * DM + 256 + ch) = w;
    }
}

typedef short bf16x8_t __attribute__((ext_vector_type(8)));
typedef short v4i16_t __attribute__((ext_vector_type(4)));
constexpr int AT_KW = 0, AT_VW = 73728, AT_BT = 147456;
template <bool WIN>
__device__ __forceinline__ void attn_block(LAS unsigned char* lds, const int (&ka)[2][2], const int (&va)[2][4], int rowoff0, const bf16x8_t (&qf)[2],
                                           const LAS float* brow  , const int (&dc)[2][4], unsigned vmask, f32x4 (&o)[4], float& m, float& l) {
    constexpr float SC = 0.18033688011112042f;
    constexpr int RS = WIN ? 8192 : 4096;
    f32x4 s[8][2];
#pragma unroll
    for (int j = 0; j < 8; ++j)
#pragma unroll
        for (int t = 0; t < 2; ++t) { s[j][t] = (f32x4){0.f, 0.f, 0.f, 0.f};
#pragma unroll
            for (int ks = 0; ks < 2; ++ks) { const bf16x8_t kf = *(const LAS bf16x8_t*)(lds + ka[t][ks] + rowoff0 + j * RS); s[j][t] = __builtin_amdgcn_mfma_f32_16x16x32_bf16(kf, qf[ks], s[j][t], 0, 0, 0); } }
    float tmax = -1e30f;
#pragma unroll
    for (int j = 0; j < 8; ++j)
#pragma unroll
        for (int t = 0; t < 2; ++t)
#pragma unroll
            for (int i = 0; i < 4; ++i) { float v = s[j][t][i] * SC; if (WIN) { v += brow[j * 31 + dc[t][i]]; if (!((vmask >> (t * 4 + i)) & 1u)) v = -1e30f; } s[j][t][i] = v; tmax = fmaxf(tmax, v); }
    tmax = fmaxf(tmax, __shfl_xor(tmax, 16)); tmax = fmaxf(tmax, __shfl_xor(tmax, 32));
    const float mn = fmaxf(m, tmax), alpha = __builtin_amdgcn_exp2f(m - mn); m = mn;
    float ps = 0.f;
#pragma unroll
    for (int j = 0; j < 8; ++j)
#pragma unroll
        for (int t = 0; t < 2; ++t)
#pragma unroll
            for (int i = 0; i < 4; ++i) { const float p = __builtin_amdgcn_exp2f(s[j][t][i] - mn); s[j][t][i] = p; ps += p; }
    l = l * alpha + ps;
#pragma unroll
    for (int db = 0; db < 4; ++db) o[db] = o[db] * alpha;
#pragma unroll
    for (int j = 0; j < 8; ++j) {
        v4u pw; pw.x = pg8::cvt_pk_bf16(s[j][0][0], s[j][0][1]); pw.y = pg8::cvt_pk_bf16(s[j][0][2], s[j][0][3]); pw.z = pg8::cvt_pk_bf16(s[j][1][0], s[j][1][1]); pw.w = pg8::cvt_pk_bf16(s[j][1][2], s[j][1][3]);
        const bf16x8_t pf = __builtin_bit_cast(bf16x8_t, pw);
#pragma unroll
        for (int db = 0; db < 4; ++db) {
            const v4i16_t lo = __builtin_amdgcn_ds_read_tr16_b64_v4i16((LAS v4i16_t*)(lds + va[0][db] + rowoff0 + j * RS));
            const v4i16_t hi = __builtin_amdgcn_ds_read_tr16_b64_v4i16((LAS v4i16_t*)(lds + va[1][db] + rowoff0 + j * RS));
            const bf16x8_t vf = (bf16x8_t){lo[0], lo[1], lo[2], lo[3], hi[0], hi[1], hi[2], hi[3]};
            o[db] = __builtin_amdgcn_mfma_f32_16x16x32_bf16(vf, pf, o[db], 0, 0, 0);
        }
    }
}
__device__ __forceinline__ void attn_addr(int kc0off, int li, int fq, int (&ka)[2][2], int (&va)[2][4]) {
#pragma unroll
    for (int t = 0; t < 2; ++t) {
        const int rk = kc0off + 16 * t + li;
#pragma unroll
        for (int ks = 0; ks < 2; ++ks) ka[t][ks] = AT_KW + rk * 128 + (((4 * ks + fq) ^ ((rk >> 1) & 7)) * 16);
        const int rv = kc0off + 16 * t + 4 * fq + (li >> 2), p = li & 3;
#pragma unroll
        for (int db = 0; db < 4; ++db) va[t][db] = AT_VW + rv * 128 + (((2 * db + (p >> 1)) ^ (((rv >> 1) & 3) << 1)) * 16) + (p & 1) * 8;
    }
}

__device__ __forceinline__ void ph_ctx_dft(const Ctx& C) {
    if (C.bx >= 32) return;
    constexpr int DF_Q = 32768, DF_TW = AT_VW + 65536;
    static_assert(DF_TW + 2048 <= AT_BT, "ctx dft lds");
    const float2* tw = WSP(const float2, WS_TW); const bf16* pxa = WSP(const bf16, WS_PXA); bf16* mix = WSP(bf16, WS_HX);
    LAS unsigned char* lds = C.lds; LAS float* twl = (LAS float*)(lds + DF_TW);
    const int lane = C.lane(), w = C.wave, li = lane & 15, fq = lane >> 4, tid = C.tid();
    const int b = C.bx >> 3, kcb = (C.bx >> 1) & 3, kh = C.bx & 1;
    if (tid < 256) { const float2 v = tw[tid * 32]; twl[2 * tid] = v.x; twl[2 * tid + 1] = v.y; }
    for (int p = w; p < 32; p += 8) {
        const int tokl = p * 8 + (lane >> 3), cp = lane & 7;
        const bf16* src = pxa + ((size_t)ML + b * 256 + tokl) * NPXA + kcb * 64 + ((cp ^ (((tokl >> 1) & 3) << 1)) * 8);
        __builtin_amdgcn_global_load_lds((const unsigned*)(src + OFF_P), (LAS unsigned*)(lds + AT_VW + p * 1024), 16, 0, 0);
        __builtin_amdgcn_global_load_lds((const unsigned*)(src + OFF_Q), (LAS unsigned*)(lds + AT_VW + DF_Q + p * 1024), 16, 0, 0);
    }
    int ka[2][2], va[2][4]; attn_addr(0, li, fq, ka, va);
    asm volatile("s_waitcnt vmcnt(0) lgkmcnt(0)" ::: "memory");
    __syncthreads();
    const int k = 128 * kh + 16 * w + li;
    f32x4 o[4];
#pragma unroll
    for (int db = 0; db < 4; ++db) o[db] = (f32x4){0.f, 0.f, 0.f, 0.f};
#pragma unroll 2
    for (int j = 0; j < 8; ++j) {
        float cs[8], sn[8];
#pragma unroll
        for (int t = 0; t < 2; ++t)
#pragma unroll
            for (int i = 0; i < 4; ++i) { const int n = 32 * j + 16 * t + 4 * fq + i, idx = (n * k) & 255; cs[4 * t + i] = twl[2 * idx]; sn[4 * t + i] = -twl[2 * idx + 1]; }
        v4u cw, sw;
        cw.x = pg8::cvt_pk_bf16(cs[0], cs[1]); cw.y = pg8::cvt_pk_bf16(cs[2], cs[3]); cw.z = pg8::cvt_pk_bf16(cs[4], cs[5]); cw.w = pg8::cvt_pk_bf16(cs[6], cs[7]);
        sw.x = pg8::cvt_pk_bf16(sn[0], sn[1]); sw.y = pg8::cvt_pk_bf16(sn[2], sn[3]); sw.z = pg8::cvt_pk_bf16(sn[4], sn[5]); sw.w = pg8::cvt_pk_bf16(sn[6], sn[7]);
        const bf16x8_t cf = __builtin_bit_cast(bf16x8_t, cw), sf = __builtin_bit_cast(bf16x8_t, sw);
#pragma unroll
        for (int db = 0; db < 4; ++db) {
            const v4i16_t plo = __builtin_amdgcn_ds_read_tr16_b64_v4i16((LAS v4i16_t*)(lds + va[0][db] + j * 4096)), phi = __builtin_amdgcn_ds_read_tr16_b64_v4i16((LAS v4i16_t*)(lds + va[1][db] + j * 4096));
            const v4i16_t qlo = __builtin_amdgcn_ds_read_tr16_b64_v4i16((LAS v4i16_t*)(lds + va[0][db] + DF_Q + j * 4096)), qhi = __builtin_amdgcn_ds_read_tr16_b64_v4i16((LAS v4i16_t*)(lds + va[1][db] + DF_Q + j * 4096));
            const bf16x8_t pf = (bf16x8_t){plo[0], plo[1], plo[2], plo[3], phi[0], phi[1], phi[2], phi[3]}, qf = (bf16x8_t){qlo[0], qlo[1], qlo[2], qlo[3], qhi[0], qhi[1], qhi[2], qhi[3]};
            o[db] = __builtin_amdgcn_mfma_f32_16x16x32_bf16(pf, cf, o[db], 0, 0, 0);
            o[db] = __builtin_amdgcn_mfma_f32_16x16x32_bf16(qf, sf, o[db], 0, 0, 0);
        }
    }
    bf16* op = mix + ((size_t)ML + b * 256 + k) * DM + kcb * 64 + 4 * fq;
#pragma unroll
    for (int db = 0; db < 4; ++db) { v2u ov; ov.x = pk2(o[db][0] * (1.0f / 128.0f), o[db][1] * (1.0f / 128.0f)); ov.y = pk2(o[db][2] * (1.0f / 128.0f), o[db][3] * (1.0f / 128.0f)); *(v2u*)(op + 16 * db) = ov; }
}

__device__ __forceinline__ size_t zt_off(int b) { return b < 2 ? WS_TB + (size_t)b * 8 * MiB : (b == 2 ? (size_t)502 * MiB : WS_WIN); }
__device__ __forceinline__ void ph_t1(const Ctx& C) {
    const bf16* pxa = WSP(const bf16, WS_PXA); const int lane = C.lane();
    LAS unsigned short* tile = (LAS unsigned short*)(C.lds + C.wave * 9216);
    for (int it = C.gw; it < 4 * 2 * 128 * 4; it += C.NGW) {
        const int kcb = it & 3, n2 = (it >> 2) & 127, pq = (it >> 9) & 1, b = it >> 10;
#pragma unroll
        for (int i = 0; i < 8; ++i) { const int q = i * 64 + lane, n1 = q >> 3, cc = q & 7;
            const v4u v = *(const v4u*)(pxa + ((size_t)b * SEQ + n1 * 128 + n2) * NPXA + pq * 256 + kcb * 64 + cc * 8);
            *(LAS v4u*)(tile + n1 * 72 + cc * 8) = v; }
        LDS_WAIT(); asm volatile("" ::: "memory");
        bf16* zt = WSP(bf16, zt_off(b)) + ((size_t)(pq * 256 + kcb * 64 + lane) * SEQ + n2 * 64);
#pragma unroll
        for (int c = 0; c < 8; ++c) { v4u o;
            o.x = (unsigned)tile[(8 * c + 0) * 72 + lane] | ((unsigned)tile[(8 * c + 1) * 72 + lane] << 16); o.y = (unsigned)tile[(8 * c + 2) * 72 + lane] | ((unsigned)tile[(8 * c + 3) * 72 + lane] << 16);
            o.z = (unsigned)tile[(8 * c + 4) * 72 + lane] | ((unsigned)tile[(8 * c + 5) * 72 + lane] << 16); o.w = (unsigned)tile[(8 * c + 6) * 72 + lane] | ((unsigned)tile[(8 * c + 7) * 72 + lane] << 16);
            *(v4u*)(zt + 8 * c) = o; }
        LDS_WAIT(); asm volatile("" ::: "memory");
    }
}
typedef float f32x16 __attribute__((ext_vector_type(16)));
constexpr int FT_C64 = 0, FT_S64 = 9216, FT_C128 = 18432, FT_S128 = FT_C128 + 34816, FT_TA = FT_S128 + 34816, FT_TR = FT_TA + 4096, FT_ST = FT_TR + 8192;
static_assert(FT_ST + 32768 <= LDSCTL_OFF, "fft lds");
__device__ __forceinline__ void hw_sincos_rev(float rev, float& sn, float& cs) { sn = __builtin_amdgcn_sinf(rev); cs = __builtin_amdgcn_cosf(rev); }
__device__ __forceinline__ int crow16(int r, int h) { return (r & 3) + 8 * (r >> 2) + 4 * h; }
__device__ __forceinline__ void ph_fft(const Ctx& C) {
    LAS unsigned char* lds = C.lds; const int tid = C.tid(), lane = C.lane(), w = C.wave, h = lane >> 5, c = lane & 31;
    const float2* tw = WSP(const float2, WS_TW); bf16* mix = WSP(bf16, WS_HX);
    { LAS unsigned short* c64 = (LAS unsigned short*)(lds + FT_C64); LAS unsigned short* s64 = (LAS unsigned short*)(lds + FT_S64);
#pragma unroll 4
      for (int e = tid; e < 4096; e += NTHR) { const int k1 = e >> 6, n1 = e & 63; float sn, cs; hw_sincos_rev(0.5f * ((float)((n1 * k1) & 63) * (1.0f / 32.0f)), sn, cs); c64[k1 * 72 + n1] = (unsigned short)f2bf(cs); s64[k1 * 72 + n1] = (unsigned short)f2bf(sn); }
      LAS unsigned short* c128 = (LAS unsigned short*)(lds + FT_C128); LAS unsigned short* s128 = (LAS unsigned short*)(lds + FT_S128);
#pragma unroll 4
      for (int e = tid; e < 16384; e += NTHR) { const int k2 = e >> 7, p = e & 127, q = p & 15, n2 = (p & ~15) + (q & 3) + ((q >> 2) & 1) * 8 + ((q >> 3) & 1) * 4;
          float sn, cs; hw_sincos_rev(0.5f * ((float)((n2 * k2) & 127) * (1.0f / 64.0f)), sn, cs); c128[k2 * 136 + p] = (unsigned short)f2bf(cs); s128[k2 * 136 + p] = (unsigned short)f2bf(sn); }
      LAS float* ta = (LAS float*)(lds + FT_TA); LAS float* trt = (LAS float*)(lds + FT_TR);
      { const int e = tid, g = e >> 6, kk = e & 63; float sn, cs; hw_sincos_rev(0.5f * ((float)((32 * (g >> 1) + 4 * (g & 1)) * kk) * (1.0f / 4096.0f)), sn, cs); ta[2 * e] = cs; ta[2 * e + 1] = sn; }
      for (int e = tid; e < 1024; e += NTHR) { const int r = e >> 6, kk = e & 63; float sn, cs; hw_sincos_rev(0.5f * ((float)(crow16(r, 0) * kk) * (1.0f / 4096.0f)), sn, cs); trt[2 * e] = cs; trt[2 * e + 1] = sn; }
    }
    __syncthreads();
    const int vcu = (C.G % 8 == 0) ? (C.bx % 8) * (C.G / 8) + C.bx / 8 : C.bx;
    for (int it = vcu; it < 256; it += C.G) {
        const int kb = it & 1, kcg = (it >> 1) & 31, b = it >> 6, kc = kcg * 8 + w, k1 = 32 * kb + c;
        const bf16* zp = WSP(const bf16, zt_off(b)) + (size_t)kc * SEQ; const bf16* zq = zp + (size_t)256 * SEQ;
        f32x16 acc[4];
#pragma unroll
        for (int rb2 = 0; rb2 < 4; ++rb2) acc[rb2] = (f32x16){};
#pragma unroll 1
        for (int rb = 0; rb < 4; ++rb) {
            const int n2 = 32 * rb + c;
            f32x16 xr = {}, xi = {};
#pragma unroll
            for (int ks = 0; ks < 4; ++ks) {
                const bf16x8_t cf = *(const LAS bf16x8_t*)(lds + FT_C64 + (k1 * 72 + 16 * ks + 8 * h) * 2), sf = *(const LAS bf16x8_t*)(lds + FT_S64 + (k1 * 72 + 16 * ks + 8 * h) * 2);
                const bf16x8_t pf = *(const bf16x8_t*)(zp + n2 * 64 + 16 * ks + 8 * h), qf = *(const bf16x8_t*)(zq + n2 * 64 + 16 * ks + 8 * h);
                const v4u t = __builtin_bit_cast(v4u, qf) ^ 0x80008000u; const bf16x8_t qn = __builtin_bit_cast(bf16x8_t, t);
                xr = __builtin_amdgcn_mfma_f32_32x32x16_bf16(pf, cf, xr, 0, 0, 0); xi = __builtin_amdgcn_mfma_f32_32x32x16_bf16(pf, sf, xi, 0, 0, 0);
                xi = __builtin_amdgcn_mfma_f32_32x32x16_bf16(qf, cf, xi, 0, 0, 0); xr = __builtin_amdgcn_mfma_f32_32x32x16_bf16(qn, sf, xr, 0, 0, 0); }
            bf16x8_t bre[2], bim[2];
            const LAS float* tap = (const LAS float*)(lds + FT_TA) + 2 * ((rb * 2 + h) * 64 + k1); const float ac_ = tap[0], as_ = tap[1];
            const LAS float* trp = (const LAS float*)(lds + FT_TR) + 2 * k1;
#pragma unroll
            for (int sblk = 0; sblk < 2; ++sblk) {
                float tr[8], ti[8];
#pragma unroll
                for (int r8 = 0; r8 < 8; ++r8) { const int r = 8 * sblk + r8; const float rc = trp[128 * r], rs = trp[128 * r + 1]; const float tc = ac_ * rc - as_ * rs, ts = ac_ * rs + as_ * rc;
                    tr[r8] = xr[r] * tc - xi[r] * ts; ti[r8] = -(xr[r] * ts + xi[r] * tc); }
                v4u a, bq;
                a.x = pg8::cvt_pk_bf16(tr[0], tr[1]); a.y = pg8::cvt_pk_bf16(tr[2], tr[3]); a.z = pg8::cvt_pk_bf16(tr[4], tr[5]); a.w = pg8::cvt_pk_bf16(tr[6], tr[7]);
                bq.x = pg8::cvt_pk_bf16(ti[0], ti[1]); bq.y = pg8::cvt_pk_bf16(ti[2], ti[3]); bq.z = pg8::cvt_pk_bf16(ti[4], ti[5]); bq.w = pg8::cvt_pk_bf16(ti[6], ti[7]);
                bre[sblk] = __builtin_bit_cast(bf16x8_t, a); bim[sblk] = __builtin_bit_cast(bf16x8_t, bq); }
#pragma unroll
            for (int rb2 = 0; rb2 < 4; ++rb2) {
                const int k2 = 32 * rb2 + c;
#pragma unroll
                for (int sblk = 0; sblk < 2; ++sblk) {
                    const bf16x8_t ac = *(const LAS bf16x8_t*)(lds + FT_C128 + (k2 * 136 + 32 * rb + 16 * sblk + 8 * h) * 2), as = *(const LAS bf16x8_t*)(lds + FT_S128 + (k2 * 136 + 32 * rb + 16 * sblk + 8 * h) * 2);
                    acc[rb2] = __builtin_amdgcn_mfma_f32_32x32x16_bf16(ac, bre[sblk], acc[rb2], 0, 0, 0); acc[rb2] = __builtin_amdgcn_mfma_f32_32x32x16_bf16(as, bim[sblk], acc[rb2], 0, 0, 0); }
            }
        }
#pragma unroll
        for (int rb2 = 0; rb2 < 4; ++rb2) {
            LAS unsigned short* st = (LAS unsigned short*)(lds + FT_ST + (rb2 & 1) * 16384);
#pragma unroll
            for (int r = 0; r < 16; ++r) st[((crow16(r, h) * 32 + c) * 8) + w] = (unsigned short)f2bf(acc[rb2][r] * 0.001381067932f);
            LDS_WAIT(); __syncthreads();
#pragma unroll
            for (int j = 0; j < 2; ++j) { const int idx = tid + 512 * j, k2l = idx >> 5, k1l = idx & 31;
                const v4u v = *(const LAS v4u*)(st + idx * 8);
                *(v4u*)(mix + ((size_t)b * SEQ + 32 * kb + k1l + 64 * (32 * rb2 + k2l)) * DM + kcg * 8) = v; }
        }
        __syncthreads();
    }
}
__device__ __forceinline__ void ph_attn(const Ctx& C, int l) {
    const bf16* pxa = WSP(const bf16, WS_PXA); bf16* mix = WSP(bf16, WS_HX);
    const float* rb = ARGF(A_RELB) + (size_t)l * 8 * 15 * 31;
    LAS unsigned char* lds = C.lds; LAS float* biasT = (LAS float*)(lds + AT_BT);
    const int lane = C.lane(), w = C.wave, fq = lane >> 4, li = lane & 15, tid = C.tid();
    const int nunits = 2048 + (l == 0 ? 64 : 0);
    const int vcu = (C.G % 8 == 0) ? (C.bx % 8) * (C.G / 8) + C.bx / 8 : C.bx;
    for (int u = vcu; u < nunits; u += C.G) {
        const bool isc = u >= 2048;
        int b, h, rp; if (!isc) { b = u >> 9; h = (u >> 6) & 7; rp = u & 63; } else { const int v = u - 2048; b = v >> 4; h = (v >> 1) & 7; rp = v & 1; }
        __syncthreads();
        for (int e = tid; e < 465; e += NTHR) biasT[e] = rb[h * 465 + e] * 1.4426950408889634f;
        const int R0 = min(max(2 * rp - 4, 0), 120);
        if (!isc) {
            for (int p = w; p < 72; p += 8) {
                const int tokl = p * 8 + (lane >> 3), lr = tokl >> 6, col = tokl & 63, gr = min(R0 + lr, 127), cp = lane & 7;
                const bf16* src = pxa + ((size_t)b * SEQ + gr * 64 + col) * NPXA + h * 64;
                __builtin_amdgcn_global_load_lds((const unsigned*)(src + OFF_K + ((cp ^ ((tokl >> 1) & 7)) * 8)), (LAS unsigned*)(lds + AT_KW + p * 1024), 16, 0, 0);
                __builtin_amdgcn_global_load_lds((const unsigned*)(src + OFF_V + ((cp ^ (((tokl >> 1) & 3) << 1)) * 8)), (LAS unsigned*)(lds + AT_VW + p * 1024), 16, 0, 0);
            }
        }
        int r = 0, qc = 0; size_t token;
        if (!isc) { r = 2 * rp + (w >> 2); qc = 16 * (w & 3) + li; token = (size_t)b * SEQ + r * 64 + qc; }
        else token = (size_t)ML + b * 256 + rp * 128 + 16 * w + li;
        bf16x8_t qf[2];
#pragma unroll
        for (int ks = 0; ks < 2; ++ks) qf[ks] = *(const bf16x8_t*)(pxa + token * NPXA + OFF_QQ + h * 64 + 32 * ks + 8 * fq);
        f32x4 o[4]; float m = -1e30f, lsum = 0.f;
#pragma unroll
        for (int db = 0; db < 4; ++db) o[db] = (f32x4){0.f, 0.f, 0.f, 0.f};
        int ka[2][2], va[2][4], dc[2][4];
        asm volatile("s_waitcnt vmcnt(0)" ::: "memory");
        __syncthreads();
        if (!isc) {
            const int cb = w & 3, kc0 = cb == 0 ? 0 : cb == 1 ? 8 : cb == 2 ? 24 : 32;
            attn_addr(kc0, li, fq, ka, va);
            const int csq = min(max(qc - 8, 0), 48); unsigned vmask = 0u;
#pragma unroll
            for (int t = 0; t < 2; ++t)
#pragma unroll
                for (int i = 0; i < 4; ++i) { const int kcol = kc0 + 16 * t + 4 * fq + i; if (kcol >= csq && kcol < csq + 16) vmask |= 1u << (t * 4 + i); dc[t][i] = min(max(kcol - qc + 15, 0), 30); }
            const int rsr = min(max(r - 4, 0), 120), lr0 = rsr - R0;
            attn_block<true>(lds, ka, va, lr0 * 8192, qf, biasT + (rsr - r + 7) * 31, dc, vmask, o, m, lsum);
        }
        __syncthreads();
        for (int p = w; p < 32; p += 8) {
            const int tokl = p * 8 + (lane >> 3), cp = lane & 7;
            const bf16* src = pxa + ((size_t)ML + b * 256 + tokl) * NPXA + h * 64;
            __builtin_amdgcn_global_load_lds((const unsigned*)(src + OFF_K + ((cp ^ ((tokl >> 1) & 7)) * 8)), (LAS unsigned*)(lds + AT_KW + p * 1024), 16, 0, 0);
            __builtin_amdgcn_global_load_lds((const unsigned*)(src + OFF_V + ((cp ^ (((tokl >> 1) & 3) << 1)) * 8)), (LAS unsigned*)(lds + AT_VW + p * 1024), 16, 0, 0);
        }
        attn_addr(0, li, fq, ka, va);
        asm volatile("s_waitcnt vmcnt(0)" ::: "memory");
        __syncthreads();
        attn_block<false>(lds, ka, va, 0, qf, (const LAS float*)nullptr, dc, 0xffu, o, m, lsum);
        lsum += __shfl_xor(lsum, 16); lsum += __shfl_xor(lsum, 32);
        const float inv = __builtin_amdgcn_rcpf(lsum);
        bf16* op = mix + token * DM + 512 + h * 64 + 4 * fq;
#pragma unroll
        for (int db = 0; db < 4; ++db) { v2u ov; ov.x = pk2(o[db][0] * inv, o[db][1] * inv); ov.y = pk2(o[db][2] * inv, o[db][3] * inv); *(v2u*)(op + 16 * db) = ov; }
    }
}

template <int KS>
__device__ __forceinline__ void wg_core(const bf16* A, const bf16* W, int li, int fq, f32x4 (&acc)[4][2]) {
    const bf16* ap = A + (size_t)li * DM + 8 * fq; const bf16* wp = W + (size_t)li * DM + 8 * fq;
    bf16x8_t af[4][4], wf[4][2];
#pragma unroll
    for (int s = 0; s < 3; ++s) {
#pragma unroll
        for (int m = 0; m < 4; ++m) af[s][m] = *(const bf16x8_t*)(ap + (size_t)(16 * m) * DM + 32 * s);
#pragma unroll
        for (int n = 0; n < 2; ++n) wf[s][n] = *(const bf16x8_t*)(wp + (size_t)(16 * n) * DM + 32 * s); }
#pragma unroll
    for (int s = 0; s < KS; ++s) {
        if (s + 3 < KS) {
#pragma unroll
            for (int m = 0; m < 4; ++m) af[(s + 3) & 3][m] = *(const bf16x8_t*)(ap + (size_t)(16 * m) * DM + 32 * (s + 3));
#pragma unroll
            for (int n = 0; n < 2; ++n) wf[(s + 3) & 3][n] = *(const bf16x8_t*)(wp + (size_t)(16 * n) * DM + 32 * (s + 3)); }
#pragma unroll
        for (int m = 0; m < 4; ++m)
#pragma unroll
            for (int n = 0; n < 2; ++n) acc[m][n] = __builtin_amdgcn_mfma_f32_16x16x32_bf16(wf[s & 3][n], af[s & 3][m], acc[m][n], 0, 0, 0);
    }
}
__device__ __forceinline__ void wg_merge_ctx(const Ctx& C) {
    if (C.wave >= 2) return;
    const bf16* mix = WSP(const bf16, WS_HX); const bf16* wm = WSP(const bf16, WS_WM); const bf16* pxg = WSP(const bf16, WS_PXG); bf16* mb = WSP(bf16, WS_M);
    const int lane = C.lane(), li = lane & 15, fq = lane >> 4;
    for (int it = C.wave * C.G + C.bx; it < 512; it += 2 * C.G) {
        const int r0 = ML + 64 * (it >> 5), c0 = 32 * (it & 31);
        f32x4 a0[4][2], a1[4][2], a2[4][2];
#pragma unroll
        for (int m = 0; m < 4; ++m)
#pragma unroll
            for (int n = 0; n < 2; ++n) { a0[m][n] = (f32x4){0.f, 0.f, 0.f, 0.f}; a1[m][n] = a0[m][n]; a2[m][n] = a0[m][n]; }
        const bf16* A = mix + (size_t)r0 * DM; const bf16* W = wm + (size_t)c0 * DM;
        wg_core<8>(A, W, li, fq, a0); wg_core<8>(A + 256, W + 256, li, fq, a1); wg_core<16>(A + 512, W + 512, li, fq, a2);
#pragma unroll
        for (int m = 0; m < 4; ++m)
#pragma unroll
            for (int n = 0; n < 2; ++n) { const size_t row = (size_t)(r0 + 16 * m + li); const int col = c0 + 16 * n + 4 * fq;
                const v2u g0 = *(const v2u*)(pxg + gate_elem(0, (int)row, col)), g1 = *(const v2u*)(pxg + gate_elem(1, (int)row, col)), g2 = *(const v2u*)(pxg + gate_elem(2, (int)row, col));
#define RL(x) __builtin_amdgcn_rcpf(bflo(x))
#define RH(x) __builtin_amdgcn_rcpf(bfhi(x))
                const float o0 = a0[m][n][0] * RL(g0.x) + a1[m][n][0] * RL(g1.x) + a2[m][n][0] * RL(g2.x), o1 = a0[m][n][1] * RH(g0.x) + a1[m][n][1] * RH(g1.x) + a2[m][n][1] * RH(g2.x);
                const float o2 = a0[m][n][2] * RL(g0.y) + a1[m][n][2] * RL(g1.y) + a2[m][n][2] * RL(g2.y), o3 = a0[m][n][3] * RH(g0.y) + a1[m][n][3] * RH(g1.y) + a2[m][n][3] * RH(g2.y);
#undef RL
#undef RH
                v2u w; w.x = cvt_pk_bf16(o0, o1); w.y = cvt_pk_bf16(o2, o3); *(v2u*)(mb + row * DM + col) = w; }
    }
}
__device__ __forceinline__ void wg_wo_ctx(const Ctx& C) {
    if (C.wave >= 2) return;
    const bf16* mb = WSP(const bf16, WS_M); const bf16* wo = WSP(const bf16, WS_WO); const float* base = ARGF(A_CTX); float* out = WSP(float, WS_CTXX);
    const float* gate = WSP(const float, WS_MOD) + 4 * NMOD + 2 * DM; const float* gn = WSP(const float, WS_GN) + (size_t)(1 * 5 + 4) * DM; bf16* ap = WSP(bf16, WS_HX); u64* rs = WSP(u64, WS_RS) + (size_t)1 * MT;
    const int lane = C.lane(), li = lane & 15, fq = lane >> 4;
    for (int it = C.wave * C.G + C.bx; it < 512; it += 2 * C.G) {
        const int r0 = 64 * (it >> 5), c0 = 32 * (it & 31);
        f32x4 acc[4][2];
#pragma unroll
        for (int m = 0; m < 4; ++m)
#pragma unroll
            for (int n = 0; n < 2; ++n) acc[m][n] = (f32x4){0.f, 0.f, 0.f, 0.f};
        wg_core<32>(mb + (size_t)(ML + r0) * DM, wo + (size_t)c0 * DM, li, fq, acc);
#pragma unroll
        for (int m = 0; m < 4; ++m) { const size_t rc = (size_t)(r0 + 16 * m + li); float ss = 0.f;
#pragma unroll
            for (int n = 0; n < 2; ++n) { const int col = c0 + 16 * n + 4 * fq;
                const f32x4 o = *(const f32x4*)(base + rc * DM + col) + *(const f32x4*)(gate + col) * acc[m][n];
                *(f32x4*)(out + rc * DM + col) = o;
                const f32x4 y = o * *(const f32x4*)(gn + col); v2u w; w.x = cvt_pk_bf16(y[0], y[1]); w.y = cvt_pk_bf16(y[2], y[3]); *(v2u*)(ap + (ML + rc) * DM + col) = w;
                ss += (o[0] * o[0] + o[1] * o[1]) + (o[2] * o[2] + o[3] * o[3]); }
            ss += __shfl_xor(ss, 16); ss += __shfl_xor(ss, 32);
            if (fq == 0) __hip_atomic_fetch_add(rs + ML + rc, (u64)(ss * 16777216.0f + 0.5f), __ATOMIC_RELAXED, __HIP_MEMORY_SCOPE_AGENT); }
    }
}
__device__ __forceinline__ void ph_final(const Ctx& C) {
    float* out = (float*)(GAS float*)ldarg(C, A_OUT); const float* fg = ARGF(A_FG); const int lane = C.lane();
    for (int row = C.gw; row < ML; row += C.NGW) {
        float* xr = out + (size_t)row * DM;
        f32x4 v[4]; float s2 = 0.f;
#pragma unroll
        for (int j = 0; j < 4; ++j) { v[j] = *(const f32x4*)(xr + 4 * lane + 256 * j); s2 += (v[j].x * v[j].x + v[j].y * v[j].y) + (v[j].z * v[j].z + v[j].w * v[j].w); }
        const float rstd = 1.0f / sqrtf(wave_sum(s2) * (1.0f / DM) + EPS);
#pragma unroll
        for (int j = 0; j < 4; ++j) { const int c0 = 4 * lane + 256 * j; const f32x4 gg = *(const f32x4*)(fg + c0); *(f32x4*)(xr + c0) = v[j] * rstd * gg; }
    }
}

struct Args { const void* p[A_NARGS]; int ph_lo, ph_hi; };

__global__ void __launch_bounds__(NTHR, 2) fwd_kernel(Args args) {
    extern __shared__ __attribute__((aligned(16))) unsigned char lds_raw[];
    LAS unsigned char* const lds0 = (LAS unsigned char*)lds_raw;
    const int wave0 = __builtin_amdgcn_readfirstlane(threadIdx.x >> 6);
    { const int t0 = threadIdx.x;
      for (int u = t0; u < (LDS_BYTES - LDSCTL_OFF) / 4; u += NTHR) ((LAS unsigned*)(lds0 + LDSCTL_OFF))[u] = 0u;
      __syncthreads();
      if (t0 < A_NARGS) ((LAS unsigned long long*)(lds0 + LARGS_OFF))[t0] = (unsigned long long)args.p[t0];
      __syncthreads(); }
    const int lo = args.ph_lo, hi = args.ph_hi;
    const unsigned xcc = xb_xcc_id();
    int vbx = blockIdx.x;
    if (!MK_MULTI) { Ctx C; C.lds = lds0; C.wave = wave0; gu32* ctl0 = (gu32*)WSP(unsigned, WS_CTL); (void)xcd_barrier_post((unsigned*)(ctl0 + CW_BAR), (volatile LAS unsigned*)(lds0 + MISC_OFF) + 8, C.tid() == 0); }
    for (int step = lo; step < hi; ++step) {
        const int ls = step - 2, l = ls >= NS ? 1 : 0, k = (step < 2) ? -1 - step : ls - l * NS;
        const int nrep = (PROBE_K != -99 && k == PROBE_K) ? PROBE_N : 1;
        for (int rep = 0; rep < nrep; ++rep) {
        Ctx C;
        C.lds = lds0; C.wave = wave0; C.G = gridDim.x; C.bx = vbx;
        asm volatile("" : "+s"(C.wave), "+s"(C.bx), "+s"(C.G));
        C.gw = C.bx * NWAVES + C.wave; C.NGW = C.G * NWAVES; C.NGT = C.G * NTHR;
        gu32* ctl = (gu32*)WSP(unsigned, WS_CTL);
        if (k == -1) { ph_mod_partial(C); __syncthreads(); ph_weights(C, 0); }
        else if (k == -2) ph_mod_reduce(C);
        else if (k == 0) {
            if (l == 1) ph_weights(C, l);
            ph_ctab(C, l);
            u64* rsb = WSP(u64, WS_RS) + (size_t)(l == 0 ? 0 : 2) * MT;
            if (l == 0) ph_prenorm(C, ARGF(A_X), ARGF(A_CTX), WSP(const float, WS_GN), WSP(bf16, WS_HX), rsb, 0, MT, (const float*)nullptr, (const float*)nullptr);
            else ph_prenorm(C, ARGF(A_OUT), WSP(const float, WS_CTXX), WSP(const float, WS_GN) + 2 * 5 * DM, WSP(bf16, WS_HX), rsb, ML, MT, WSP(const float, WS_PART), WSP(const float, WS_MOD) + 4 * NMOD + 5 * DM);
        } else if (k == 1) {
            pg8::Prob<false> P{WSP(const bf16, WS_HX), WSP(const bf16, WS_WIN), DM, DM, DM}; pg8::StaticOrder<NIN / 256> S; S.init(MT, NIN, C.G, C.bx);
            EpiIn E{WSP(bf16, WS_PXA), WSP(bf16, WS_PXG), WSP(const u64, WS_RS) + (size_t)(l == 0 ? 0 : 2) * MT, WSP(const float, WS_CIN) + (size_t)l * 5 * NIN};
            pg8::gemm_phase(C.lds, P, S, E, C.tid());
        } else if (k == 2) {
            const int sub = rep == 0 ? 7 : PROBE_SUB;
            if (sub & 1) ph_t1(C);
            if (sub & 2) { if (l == 0) ph_ctx_dft(C); ph_mixers(C, l); }
            if (sub & 4) ph_attn(C, l);
        } else if (k == 3) {
            ph_fft(C);
        } else if (k == 4) {
            pg8::Prob<false> P{WSP(const bf16, WS_HX), WSP(const bf16, WS_WM), DM, DM, DM}; pg8::StaticOrder<DM / 256> S; S.init(ML, DM, C.G, C.bx);
            EpiMerge E{WSP(bf16, WS_M), WSP(const bf16, WS_PXG)};
            pg8::gemm_phase(C.lds, P, S, E, C.tid());
            if (l == 0) wg_merge_ctx(C);
        } else if (k == 5) {
            pg8::Prob<false> P{WSP(const bf16, WS_M), WSP(const bf16, WS_WO), DM, DM, DM}; pg8::StaticOrder<DM / 256> S; S.init(ML, DM, C.G, C.bx);
            const float* gatev = rep > 0 ? WSP(const float, WS_ZERO) : WSP(const float, WS_MOD) + (size_t)l * 5 * NMOD + 2 * DM;
            const float* gnp = WSP(const float, WS_GN) + (size_t)(l * 2 + 1) * 5 * DM; u64* rsp = WSP(u64, WS_RS) + (size_t)(l == 0 ? 1 : 3) * MT;
            if (l == 0) { EpiRes<false> E{(const void*)ARGF(A_X), (bf16*)(GAS bf16*)ldarg(C, A_OUT), gatev, nullptr, gnp, WSP(bf16, WS_HX), rsp}; pg8::gemm_phase(C.lds, P, S, E, C.tid()); }
            else { EpiRes<true> E{(const void*)(const bf16*)(GAS bf16*)ldarg(C, A_OUT), WSP(bf16, WS_STREAM1), gatev, nullptr, gnp, WSP(bf16, WS_HX), rsp}; pg8::gemm_phase(C.lds, P, S, E, C.tid()); }
            if (l == 0 && rep == 0) wg_wo_ctx(C);
        } else if (k == 6) {
            pg8::Prob<false> P{WSP(const bf16, WS_HX), WSP(const bf16, WS_W1), DM, DM, DM}; pg8::StaticOrder<FF / 256> S; S.init(l == 0 ? MT : ML, FF, C.G, C.bx);
            EpiAct E{WSP(bf16, WS_ACT), WSP(const u64, WS_RS) + (size_t)(l == 0 ? 1 : 3) * MT, WSP(const float, WS_CUP) + (size_t)l * 5 * FF};
            pg8::gemm_phase(C.lds, P, S, E, C.tid());
        } else if (k == 7) {
            if (l == 0) {
                pg8::ProbDown P{WSP(const bf16, WS_ACT), WSP(const bf16, WS_W2), FF, FF, FF}; pg8::DownOrder S; S.init(C.G, C.bx);
                EpiRes<true> E{(const void*)(const bf16*)(GAS bf16*)ldarg(C, A_OUT), (bf16*)(GAS bf16*)ldarg(C, A_OUT), WSP(const float, WS_MOD) + (size_t)l * 5 * NMOD + 5 * DM, WSP(float, WS_PART),
                         WSP(const float, WS_GN) + (size_t)2 * 5 * DM, WSP(bf16, WS_HX), WSP(u64, WS_RS) + (size_t)2 * MT};
                pg8::gemm_phase(C.lds, P, S, E, C.tid());
            } else {
                pg8::Prob<false> P{WSP(const bf16, WS_ACT), WSP(const bf16, WS_W2), FF, FF, FF}; pg8::StaticOrder<DM / 256> S; S.init(ML, DM, C.G, C.bx);
                EpiResFinal E{WSP(const bf16, WS_STREAM1), (float*)(GAS float*)ldarg(C, A_OUT), WSP(const float, WS_MOD) + (size_t)l * 5 * NMOD + 5 * DM, ARGF(A_FG), WSP(u64, WS_RS5), WSP(unsigned, WS_FCNT), (unsigned*)WSP(unsigned, WS_CTL) + CW_TMO};
                pg8::gemm_phase(C.lds, P, S, E, C.tid());
            }
        } else ph_final(C);
        if (step + 1 < hi || rep + 1 < nrep) { if (MK_MULTI) { if (C.tid() == 0) __hip_atomic_store(ctl + CW_TMO, 0xBADu, RLX_AGENT); } else { XcdBarrier bar; bar.bar = (unsigned*)(ctl + CW_BAR); bar.x = xcc; bar.st = (volatile LAS unsigned*)(lds0 + MISC_OFF) + 8; xcd_barrier(bar, C.tid() == 0);
                if (step == lo && rep == 0) {
                    volatile LAS unsigned* misc = (volatile LAS unsigned*)(lds0 + MISC_OFF);
                    if (C.tid() == 0) { bool ok = gridDim.x == 256;
                        for (unsigned j = 0; j < 16; ++j) { const unsigned cnt = xb_ld(bar.bar + XB_XCNT(j)); ok = ok && (cnt == (j < 8 ? 32u : 0u)); }
                        misc[11] = ok ? 1u : 0u; }
                    __syncthreads();
                    const unsigned okf = __builtin_amdgcn_readfirstlane(misc[11]), rk = __builtin_amdgcn_readfirstlane(misc[10]);
                    if (okf != 0u && rk < 32u && xcc < 8u) vbx = (int)(rk * 8u + xcc); } } }
        }
    }
}

extern "C" void kernel_launch(void* const* d_in, const int* in_sizes, int n_in, void* d_out, int out_size, void* d_ws, size_t ws_size, hipStream_t stream) {
    static int grid = 0;
    if (grid == 0) {
        if (n_in != 18 || out_size != ML * DM || ws_size < WS_END) { fprintf(stderr, "kernel_launch: unexpected shapes (n_in %d out %d ws %zu)\n", n_in, out_size, ws_size); grid = -1; return; }
        int dev = 0, cus = 0;
        if (hipGetDevice(&dev) != hipSuccess || hipDeviceGetAttribute(&cus, hipDeviceAttributeMultiprocessorCount, dev) != hipSuccess) { grid = -1; return; }
        if (hipFuncSetAttribute((const void*)fwd_kernel, hipFuncAttributeMaxDynamicSharedMemorySize, LDS_BYTES) != hipSuccess) { fprintf(stderr, "kernel_launch: hipFuncSetAttribute failed\n"); grid = -1; return; }
        int per_cu = 0;
        if (hipOccupancyMaxActiveBlocksPerMultiprocessor(&per_cu, (const void*)fwd_kernel, NTHR, LDS_BYTES) != hipSuccess || per_cu < 1) fprintf(stderr, "kernel_launch: occupancy query reports %d\n", per_cu);
        (void)hipGetLastError();
        grid = cus;
    }
    if (grid < 0) return;
    (void)hipMemsetAsync((char*)d_ws + WS_CTL, 0, CTL_ZERO_BYTES, stream);
    Args a{};
    for (int i = 0; i < 18; ++i) a.p[i] = d_in[i];
    a.p[A_OUT] = d_out; a.p[A_WS] = d_ws;
#if MK_MULTI
    for (int s = 0; s < NSTEPS; ++s) { a.ph_lo = s; a.ph_hi = s + 1; hipLaunchKernelGGL(fwd_kernel, dim3(grid), dim3(NTHR), LDS_BYTES, stream, a); }
#else
    a.ph_lo = 0; a.ph_hi = NSTEPS; hipLaunchKernelGGL(fwd_kernel, dim3(grid), dim3(NTHR), LDS_BYTES, stream, a);
#endif
}
```

```cpp
#include <hip/hip_runtime.h>
#include <cstdio>
#include <cstdint>

#ifndef PROBE_K
#define PROBE_K -99
#define PROBE_N 1
#define PROBE_SUB 7
#endif
#ifndef MK_MULTI
#define MK_MULTI 0
#endif

namespace pg8 {
#define PG8_LAS __attribute__((address_space(3)))
typedef unsigned short bf16_t;
typedef short bf16x8 __attribute__((ext_vector_type(8)));
typedef float f32x4 __attribute__((ext_vector_type(4)));
typedef unsigned u32x4 __attribute__((ext_vector_type(4)));
constexpr int BM = 256, BK = 64, HALF = 128, HTB = HALF * BK * 2, STAGE_BYTES = 8 * HTB, NXCD = 8, WGM = 8;

__host__ __device__ __forceinline__ int lds_byte(int r, int c) { const int st = (r >> 4) * 2 + (c >> 5), rr = r & 15, cc = c & 31, ob = rr * 64 + cc * 2; return st * 1024 + (ob ^ (((ob >> 9) & 1) << 5)); }
__host__ __device__ __forceinline__ void stage_rc(int b, int& R, int& C) { const int st = b / 1024, sb = b % 1024, swz = sb ^ (((sb >> 9) & 1) << 5); R = (st >> 1) * 16 + swz / 64; C = (st & 1) * 32 + (swz % 64) / 2; }
__host__ __device__ __forceinline__ int perm32(int rho) { const int n = rho >> 4, i = rho & 15; return 8 * (i >> 2) + 4 * n + (i & 3); }

struct Unit { int pm, pn, br; };

template <int NN  > struct StaticOrder {
    int nM, nwg, G, c;
    __device__ void init(int M, int  , int G_, int c_) { nM = M / BM; nwg = nM * NN; G = G_; c = c_; }
    __device__ __forceinline__ bool next(int i, Unit& u) const {
        u.br = 0;
        const long L = (long)i * G + c; if (L >= nwg) return false;
        int wgid = (int)L; { const int q = nwg >> 3, r = nwg & 7, xcd = wgid & 7, off = wgid >> 3; wgid = (xcd < r ? xcd * (q + 1) : r * (q + 1) + (xcd - r) * q) + off; }
        constexpr int nig = WGM * NN; const int gid = wgid / nig, rem = wgid - gid * nig, fm = gid * WGM, gsz = (nM - fm) < WGM ? (nM - fm) : WGM;
        if (gsz == WGM) { u.pm = fm + (rem & (WGM - 1)); u.pn = rem >> 3; } else { u.pm = fm + (rem % gsz); u.pn = rem / gsz; }
        return true;
    }
};

struct DownOrder {
    StaticOrder<4> lat; int G, c;
    __device__ void init(int G_, int c_) { lat.init(32768, 1024, G_, c_); G = G_; c = c_; }
    __device__ __forceinline__ bool next(int i, Unit& u) const {
        const long L = (long)i * G + c;
        if (L < 512) return lat.next(i, u);
        const int j = (int)L - 512; if (j >= 64) return false;
        const int ct = j >> 2; u.pm = 128 + (ct >> 2); u.pn = ct & 3; u.br = j & 3; return true;
    }
};
struct ProbDown {
    const bf16_t* A; const bf16_t* Bt; int lda, ldb, K;
    __device__ __forceinline__ int nt(const Unit& u) const { return u.pm >= 128 ? 16 : 64; }
    __device__ __forceinline__ int koff(const Unit& u) const { return u.pm >= 128 ? u.br * 1024 : 0; }
    __device__ __forceinline__ const char* a(const Unit& u) const { return (const char*)(A + (size_t)u.pm * BM * lda + koff(u)); }
    __device__ __forceinline__ const char* b(const Unit& u) const { return (const char*)(Bt + (size_t)u.pn * BM * ldb + koff(u)); }
};
template <bool MERGE> struct Prob {
    const bf16_t* A; const bf16_t* Bt; int lda, ldb, K;
    __device__ __forceinline__ int nt(const Unit& u) const { if (MERGE) return u.br == 2 ? 8 : 4; return K / BK; }
    __device__ __forceinline__ int koff(const Unit& u) const { if (MERGE) return u.br * 256; return 0; }
    __device__ __forceinline__ const char* a(const Unit& u) const { return (const char*)(A + (size_t)u.pm * BM * lda + koff(u)); }
    __device__ __forceinline__ const char* b(const Unit& u) const { return (const char*)(Bt + (size_t)u.pn * BM * ldb + koff(u)); }
};

typedef __bf16 bf16x2_cv __attribute__((ext_vector_type(2)));
typedef float f32x2_cv __attribute__((ext_vector_type(2)));
__device__ __forceinline__ unsigned cvt_pk_bf16(float lo, float hi) { const f32x2_cv v = {lo, hi}; const bf16x2_cv r = __builtin_convertvector(v, bf16x2_cv); return __builtin_bit_cast(unsigned, r); }

template <class Epi, class Sched, class PROB>
__device__ __forceinline__ void gemm_phase(PG8_LAS unsigned char* lds, const PROB P, const Sched& S, const Epi& E, const int tid) {
    const int wid = __builtin_amdgcn_readfirstlane(tid >> 6), lane = tid & 63, wr = wid >> 2, wc = wid & 3, fr = lane & 15, fq = lane >> 4;
    unsigned voffA[2], voffB[2];
#pragma unroll
    for (int i = 0; i < 2; ++i) { int R, C; stage_rc(tid * 16 + i * 8192, R, C); const int Rb = Epi::PERM ? ((R & ~31) + perm32(R & 31)) : R;
        voffA[i] = (unsigned)(R * P.lda + C) * 2u; voffB[i] = (unsigned)(Rb * P.ldb + C) * 2u; }
    const size_t kstep = (size_t)(BK * 2);
    const size_t hstepA = (size_t)HALF * P.lda * 2, hstepB = (size_t)HALF * P.ldb * 2;
    const unsigned ldsw = (unsigned)wid * 1024u;
    const int aoff = lds_byte(wr * 64 + fr, fq * 8), boff = lds_byte(wc * 32 + fr, fq * 8);
#define PG8_SA(b, h) (((b) * 2 + (h)) * HTB)
#define PG8_SB(b, h) ((4 + (b) * 2 + (h)) * HTB)
#define PG8_STAGE(bufoff, gbase, voff) do { _Pragma("unroll") for (int _i = 0; _i < 2; ++_i) \
        __builtin_amdgcn_global_load_lds((const unsigned*)((const char*)(gbase) + (voff)[_i]), (PG8_LAS unsigned*)(lds + (bufoff) + ldsw + _i * 8192), 16, 0, 0); } while (0)
#define PG8_LDA(dst, b, h) do { _Pragma("unroll") for (int m = 0; m < 4; ++m) _Pragma("unroll") for (int k = 0; k < 2; ++k) dst[m][k] = *(const PG8_LAS bf16x8*)(lds + PG8_SA(b, h) + aoff + m * 2048 + k * 1024); } while (0)
#define PG8_LDB(dst, b, h) do { _Pragma("unroll") for (int n = 0; n < 2; ++n) _Pragma("unroll") for (int k = 0; k < 2; ++k) dst[n][k] = *(const PG8_LAS bf16x8*)(lds + PG8_SB(b, h) + boff + n * 2048 + k * 1024); } while (0)
#define PG8_MMA(ai, bj, At, Bt) do { __builtin_amdgcn_s_setprio(1); _Pragma("unroll") for (int m = 0; m < 4; ++m) _Pragma("unroll") for (int n = 0; n < 2; ++n) _Pragma("unroll") for (int k = 0; k < 2; ++k) \
        acc[ai][bj][m][n] = __builtin_amdgcn_mfma_f32_16x16x32_bf16(Bt[n][k], At[m][k], acc[ai][bj][m][n], 0, 0, 0); __builtin_amdgcn_s_setprio(0); } while (0)
#define PG8_WAIT_V(n) asm volatile("s_waitcnt vmcnt(" #n ")" ::: "memory")
#define PG8_WAIT_L(n) asm volatile("s_waitcnt lgkmcnt(" #n ")" ::: "memory")
#define PG8_BAR __builtin_amdgcn_s_barrier()
#define PG8_WAIT_SEL1(N) asm volatile("s_waitcnt vmcnt(" #N ")\n\tv_cmp_ne_u32_e32 vcc, 0, %0\n\ts_cbranch_vccnz .Lpg8w%=\n\ts_waitcnt vmcnt(8)\n.Lpg8w%=:" :: "v"(fst) : "memory", "vcc")
#define PG8_WAIT_SEL(NF16, NF32) do { if (Epi::NST == 16) PG8_WAIT_SEL1(NF16); else PG8_WAIT_SEL1(NF32); } while (0)
#define PG8_SCHED __builtin_amdgcn_sched_barrier(0)
    Unit cur, nxt; int ui = 0;
    if (!S.next(0, cur)) return;
    f32x4 acc[2][2][4][2];
#pragma unroll
    for (int a = 0; a < 2; ++a)
#pragma unroll
        for (int b = 0; b < 2; ++b)
#pragma unroll
            for (int m = 0; m < 4; ++m)
#pragma unroll
                for (int n = 0; n < 2; ++n) acc[a][b][m][n] = (f32x4){0.f, 0.f, 0.f, 0.f};
    bf16x8 At[4][2], B0[2][2], B1[2][2];
    const char* cA = P.a(cur); const char* cB = P.b(cur);
    PG8_STAGE(PG8_SB(0, 0), cB, voffB); PG8_STAGE(PG8_SB(0, 1), cB + hstepB, voffB); PG8_STAGE(PG8_SA(0, 0), cA, voffA); PG8_STAGE(PG8_SA(0, 1), cA + hstepA, voffA);
    if (wr == 1) PG8_BAR;
    PG8_WAIT_V(2); PG8_BAR;
    PG8_STAGE(PG8_SB(1, 0), cB + kstep, voffB); PG8_STAGE(PG8_SA(1, 0), cA + kstep, voffA); PG8_STAGE(PG8_SB(1, 1), cB + hstepB + kstep, voffB);
    PG8_WAIT_V(6); PG8_BAR;
    for (;;) {
        const bool has_next = S.next(ui + 1, nxt);
        const char* nA = has_next ? P.a(nxt) : cA; const char* nB = has_next ? P.b(nxt) : cB;
        const int nt = P.nt(cur);
        for (int t = 0; t < nt; t += 2) {
            const bool last = (t == nt - 2); const int fst = (t == 0 && ui > 0) ? 1 : 0;
            if constexpr (Epi::HOOKS) { if (t == 4 || t == 8) E.hook(acc, cur, t, wr, wc, fr, fq); }
            const char* a1 = cA + (size_t)(t + 1) * kstep;
            const char* a2 = last ? nA : cA + (size_t)(t + 2) * kstep; const char* b2 = last ? nB : cB + (size_t)(t + 2) * kstep;
            const char* a3 = a2 + kstep; const char* b3 = b2 + kstep;
            PG8_LDB(B0, 0, 0); PG8_LDB(B1, 0, 1); PG8_SCHED; PG8_LDA(At, 0, 0); PG8_STAGE(PG8_SA(1, 1), a1 + hstepA, voffA);
            PG8_WAIT_SEL(18, 34); PG8_WAIT_L(0); PG8_BAR; PG8_MMA(0, 0, At, B0); PG8_MMA(0, 1, At, B1); PG8_BAR; PG8_SCHED;
            PG8_LDA(At, 0, 1); PG8_STAGE(PG8_SB(0, 0), b2, voffB); PG8_STAGE(PG8_SB(0, 1), b2 + hstepB, voffB); PG8_STAGE(PG8_SA(0, 0), a2, voffA);
            PG8_WAIT_SEL(24, 40); PG8_WAIT_L(0); PG8_BAR; PG8_MMA(1, 0, At, B0); PG8_MMA(1, 1, At, B1); PG8_BAR; PG8_SCHED;
            PG8_LDB(B0, 1, 0); PG8_LDB(B1, 1, 1); PG8_SCHED; PG8_LDA(At, 1, 0); PG8_STAGE(PG8_SA(0, 1), a2 + hstepA, voffA);
            PG8_WAIT_SEL(26, 42); PG8_WAIT_L(0); PG8_BAR; PG8_MMA(0, 0, At, B0); PG8_MMA(0, 1, At, B1); PG8_BAR; PG8_SCHED;
            PG8_LDA(At, 1, 1); PG8_STAGE(PG8_SB(1, 0), b3, voffB); PG8_STAGE(PG8_SB(1, 1), b3 + hstepB, voffB); PG8_STAGE(PG8_SA(1, 0), a3, voffA);
            PG8_WAIT_V(8); PG8_WAIT_L(0); PG8_BAR; PG8_MMA(1, 0, At, B0); PG8_MMA(1, 1, At, B1); PG8_BAR; PG8_SCHED;
        }
        if (wr == 0) PG8_BAR;
        E(acc, cur, wr, wc, fr, fq);
        if (!has_next) break;
#pragma unroll
        for (int a = 0; a < 2; ++a)
#pragma unroll
            for (int b = 0; b < 2; ++b)
#pragma unroll
                for (int m = 0; m < 4; ++m)
#pragma unroll
                    for (int n = 0; n < 2; ++n) acc[a][b][m][n] = (f32x4){0.f, 0.f, 0.f, 0.f};
        cur = nxt; cA = nA; cB = nB; ++ui;
        if (wr == 1) PG8_BAR;
    }
    PG8_WAIT_V(0);
    PG8_BAR;
#undef PG8_SA
#undef PG8_SB
#undef PG8_STAGE
#undef PG8_LDA
#undef PG8_LDB
#undef PG8_MMA
#undef PG8_WAIT_V
#undef PG8_WAIT_L
#undef PG8_BAR
#undef PG8_WAIT_SEL
#undef PG8_WAIT_SEL1
#undef PG8_SCHED
}
}

constexpr int NWAVES = 8, NTHR = 512;
constexpr int DM = 1024, NB = 4, SEQ = 8192, ML = NB * SEQ, CTXL = 256, MC = NB * CTXL, MT = ML + MC;
constexpr int NIN_ORIG = 5632, NPXA = 2816, NPXG = 3072, NIN = NPXA + NPXG;
constexpr int OFF_P = 0, OFF_Q = 256, OFF_CU = 512, OFF_CB = 768, OFF_CC = 1024, OFF_QQ = 1280, OFF_K = 1792, OFF_V = 2304;
constexpr int FF = 4096, NMOD = 6 * DM, NGRP = 5;
constexpr float EPS = 1e-6f;

constexpr size_t MiB = 1u << 20;
constexpr size_t WS_CTL = 0, CTL_ZERO_BYTES = 2 * MiB;
constexpr size_t WS_RS = 262144;
constexpr size_t WS_FCNT = 1441792;
constexpr size_t WS_ZERO = 1572864;
constexpr size_t WS_RS5 = 1703936;
constexpr size_t WS_TW = 2 * MiB;
constexpr size_t WS_MOD = 2 * MiB + 65536;
constexpr size_t WS_GN = 2 * MiB + 524288;
constexpr size_t WS_CIN = 2 * MiB + 786432;
constexpr size_t WS_CUP = 3 * MiB;
constexpr size_t WS_MODP = 510 * MiB;
constexpr size_t WS_CTXX = 4 * MiB;
constexpr size_t WS_WIN = 8 * MiB, WS_WM = 20 * MiB, WS_WO = 22 * MiB, WS_W1 = 24 * MiB, WS_W2 = 32 * MiB;
constexpr size_t WS_HX = 40 * MiB;
constexpr size_t WS_PXA = 106 * MiB;
constexpr size_t WS_PXG = 288 * MiB;
constexpr size_t WS_TB = 486 * MiB;
constexpr size_t WS_M = WS_PXA;
constexpr size_t WS_ACT = WS_PXA;
constexpr size_t WS_PART = 400 * MiB;
constexpr size_t WS_STREAM1 = 416 * MiB;
constexpr size_t WS_END = 512 * MiB;
static_assert(WS_PXA + (size_t)MT * NPXA * 2 <= WS_PXG && WS_PXG + (size_t)MT * NPXG * 2 <= WS_TB && WS_ACT + (size_t)MT * FF * 2 <= WS_TB && WS_HX + (size_t)MT * DM * 2 <= WS_PXA, "ws map");
constexpr int CW_TMO = 0, CW_BAR = 4096;

constexpr int RING_BYTES = 131072, LDSCTL_OFF = 155648, MISC_OFF = LDSCTL_OFF + 320, LDS_BYTES = 163840;

#define GAS __attribute__((address_space(1)))
#define LAS __attribute__((address_space(3)))
typedef unsigned short bf16;
typedef unsigned v4u __attribute__((ext_vector_type(4)));
typedef unsigned v2u __attribute__((ext_vector_type(2)));
typedef float f32x4 __attribute__((ext_vector_type(4)));
typedef GAS unsigned gu32;
#define RLX_AGENT __ATOMIC_RELAXED, __HIP_MEMORY_SCOPE_AGENT
#define LDS_WAIT() asm volatile("s_waitcnt lgkmcnt(0)" ::: "memory")
__device__ __forceinline__ unsigned pk2(float lo, float hi) { return pg8::cvt_pk_bf16(lo, hi); }
__device__ __forceinline__ unsigned f2bf(float f) { return pg8::cvt_pk_bf16(f, 0.0f) & 0xffffu; }
__device__ __forceinline__ float bf2f(unsigned h) { return __uint_as_float(h << 16); }
__device__ __forceinline__ float bflo(unsigned w) { return __uint_as_float(w << 16); }
__device__ __forceinline__ float bfhi(unsigned w) { return __uint_as_float(w & 0xffff0000u); }

#define XB_TMO      128
#define XB_XCNT(j)  (256  + 64 * (j))
#define XB_XSUB(j)  (1280 + 64 * (j))
#define XB_XGEN(j)  (2304 + 64 * (j))
#define XB_TOP      3328
#define XB_TOPGEN   3392
#define XCD_BAR_WORDS 3456
#define XB_SPIN_CAP (1u << 22)
__device__ __forceinline__ unsigned xb_ld(unsigned* p)              { return __hip_atomic_load(p, __ATOMIC_RELAXED, __HIP_MEMORY_SCOPE_AGENT); }
__device__ __forceinline__ unsigned xb_add(unsigned* p, unsigned v) { return __hip_atomic_fetch_add(p, v, __ATOMIC_RELAXED, __HIP_MEMORY_SCOPE_AGENT); }
__device__ __forceinline__ unsigned xb_xcc_id() { return (unsigned)__builtin_amdgcn_s_getreg((3 << 11) | 20) & 0xFu; }
#define XB_SPIN(cond, bar) do { unsigned _sp = 0; while (cond) { __builtin_amdgcn_s_sleep(1); \
    if ((++_sp & 255u) == 0u) { if (xb_ld(&(bar)[XB_TMO])) break; if (_sp > XB_SPIN_CAP) { atomicAdd(&(bar)[XB_TMO], 1u); break; } } } } while (0)
struct XcdBarrier { unsigned* bar; unsigned x; volatile LAS unsigned* st; };
__device__ __forceinline__ XcdBarrier xcd_barrier_post(unsigned* bar, volatile LAS unsigned* st, bool leader) {
    XcdBarrier b; b.bar = bar; b.x = xb_xcc_id(); b.st = st;
    if (leader) { const unsigned rank = xb_add(&bar[XB_XCNT(b.x)], 1u); st[2] = rank; }
    return b;
}
__device__ __forceinline__ void xcd_barrier_complete(unsigned* bar, unsigned x, unsigned& nloc, unsigned& nx) {
    const unsigned G = gridDim.x * gridDim.y * gridDim.z;
    unsigned sum, cnt, mine, sp = 0u;
    for (;;) {
        sum = 0u; cnt = 0u; mine = 0u;
#pragma unroll
        for (unsigned j = 0; j < 16; ++j) { const unsigned c = xb_ld(&bar[XB_XCNT(j)]); sum += c; cnt += (c > 0u) ? 1u : 0u; mine = (j == x) ? c : mine; }
        if (sum == G) break;
        __builtin_amdgcn_s_sleep(1);
        if ((++sp & 255u) == 0u) { if (xb_ld(&bar[XB_TMO])) break; if (sp > XB_SPIN_CAP) { atomicAdd(&bar[XB_TMO], 1u); break; } }
    }
    nloc = mine > 0u ? mine : 1u; nx = cnt > 0u ? cnt : 1u;
}
__device__ __forceinline__ void xcd_barrier(const XcdBarrier& b, bool leader) {
    asm volatile("s_waitcnt vmcnt(0)" ::: "memory");
    __syncthreads();
    if (leader) {
        unsigned* bar = b.bar;
        __builtin_amdgcn_s_waitcnt(0);
        unsigned nloc = b.st[0], nx = b.st[1];
        if (nloc == 0u) { xcd_barrier_complete(bar, b.x, nloc, nx); b.st[0] = nloc; b.st[1] = nx; }
        const unsigned old = xb_add(&bar[XB_XSUB(b.x)], 1u);
        const unsigned gen = old / nloc;
        if (old + 1u == (gen + 1u) * nloc) {
            __builtin_amdgcn_fence(__ATOMIC_RELEASE, "agent");
            asm volatile("s_waitcnt vmcnt(0)" ::: "memory");
            const unsigned og = xb_add(&bar[XB_TOP], 1u);
            const unsigned tg = og / nx;
            if (og + 1u == (tg + 1u) * nx) xb_add(&bar[XB_TOPGEN], 1u);
            else XB_SPIN(xb_ld(&bar[XB_TOPGEN]) == tg, bar);
            __builtin_amdgcn_fence(__ATOMIC_ACQUIRE, "agent");
            xb_add(&bar[XB_XGEN(b.x)], 1u);
            asm volatile("s_waitcnt vmcnt(0)" ::: "memory");
        } else {
            XB_SPIN(xb_ld(&bar[XB_XGEN(b.x)]) == gen, bar);
            __builtin_amdgcn_fence(__ATOMIC_ACQUIRE, "agent");
            asm volatile("s_waitcnt vmcnt(0)" ::: "memory");
        }
    }
    __syncthreads();
}

__device__ __forceinline__ float wave_sum(float v) {
#pragma unroll
    for (int o = 1; o < 64; o <<= 1) v += __shfl_xor(v, o);
    return v;
}
__device__ __forceinline__ float wave_max(float v) {
#pragma unroll
    for (int o = 1; o < 64; o <<= 1) v = fmaxf(v, __shfl_xor(v, o));
    return v;
}

__device__ __forceinline__ void transpose_item(const float* W, int ldw, int ncols, bf16* WT, int ldwt, int row_off, int k_off, LAS float* scr, int item, int lane) {
    const int nblk = ncols / 32, kb = item / nblk, nb = item % nblk, k0 = 64 * kb, n0 = 32 * nb;
#pragma unroll 8
    for (int i = 0; i < 32; ++i) { const int kk = 2 * i + (lane >> 5); scr[kk * 33 + (lane & 31)] = W[(size_t)(k0 + kk) * ldw + n0 + (lane & 31)]; }
    LDS_WAIT(); asm volatile("" ::: "memory");
    const int c = lane & 7;
#pragma unroll
    for (int j = 0; j < 4; ++j) { const int n = (lane >> 3) + 8 * j; const LAS float* s = scr + (8 * c) * 33 + n;
        v4u o; o.x = pk2(s[0 * 33], s[1 * 33]); o.y = pk2(s[2 * 33], s[3 * 33]); o.z = pk2(s[4 * 33], s[5 * 33]); o.w = pk2(s[6 * 33], s[7 * 33]);
        *(v4u*)(WT + (size_t)(row_off + n0 + n) * ldwt + k_off + k0 + 8 * c) = o; }
    LDS_WAIT(); asm volatile("" ::: "memory");
}

using pg8::Unit; using pg8::cvt_pk_bf16;
typedef unsigned long long u64;
constexpr int NTM = MT / 256;
__device__ __forceinline__ size_t gate_tile(int g, int pm, int pn) { return (size_t)((g * NTM + pm) * 4 + pn) * 65536; }
__device__ __forceinline__ int gate_piece(int ai, int m, int bj, int wave, int lane) { return ((((ai * 4 + m) * 2 + bj) * 8 + wave) * 64 + lane) * 8; }
__device__ __forceinline__ size_t gate_elem(int g, int row, int col) {
    const int r = row & 255, c = col & 255;
    return gate_tile(g, row >> 8, col >> 8) + gate_piece(r >> 7, (r >> 4) & 3, c >> 7, ((r >> 6) & 1) * 4 + ((c >> 5) & 3), ((c >> 3) & 3) * 16 + (r & 15)) + (c & 7);
}
__device__ __forceinline__ float rs_to_rstd(u64 q) { return __builtin_amdgcn_rsqf((float)q * (1.0f / (16777216.0f * DM)) + EPS); }
struct EpiIn {
    static constexpr bool PERM = true, HOOKS = false; static constexpr int NST = 16;
    bf16* pxa; bf16* pxg; const u64* rs; const float* cin;
    __device__ __forceinline__ void operator()(const f32x4 (&acc)[2][2][4][2], const Unit& u, int wr, int wc, int fr, int fq) const {
        asm volatile("" : "+v"(fr), "+v"(fq));
        const bool gate = u.pn >= 11; bf16* base = gate ? pxg : pxa; const int ldc = gate ? NPXG : NPXA; const int colt = (gate ? u.pn - 11 : u.pn) * 256;
        const int grp = u.pm >= 128 ? 4 : (u.pm >> 5);
        const int row0 = u.pm * 256 + wr * 64 + fr, col0 = colt + wc * 32 + 8 * fq;
        const float* cp = cin + grp * NIN + u.pn * 256 + wc * 32 + 8 * fq;
        bf16* gbase = pxg + (gate ? gate_tile((u.pn - 11) >> 2, u.pm, (u.pn - 11) & 3) : 0);
        const float gsc = gate ? -1.4426950408889634f : 1.0f;
        f32x4 cv[2][2];
#pragma unroll
        for (int bj = 0; bj < 2; ++bj) { cv[bj][0] = *(const f32x4*)(cp + bj * 128) * gsc; cv[bj][1] = *(const f32x4*)(cp + bj * 128 + 4) * gsc; }
        u64 rq[2][4]; float rsv[2][4];
#pragma unroll
        for (int ai = 0; ai < 2; ++ai)
#pragma unroll
            for (int m = 0; m < 4; ++m) rq[ai][m] = rs[row0 + ai * 128 + m * 16];
        asm volatile("" ::: "memory");
#pragma unroll
        for (int ai = 0; ai < 2; ++ai)
#pragma unroll
            for (int m = 0; m < 4; ++m) rsv[ai][m] = rs_to_rstd(rq[ai][m]) * gsc;
#pragma unroll
        for (int ai = 0; ai < 2; ++ai)
#pragma unroll
            for (int m = 0; m < 4; ++m) { const int row = row0 + ai * 128 + m * 16; bf16* rowp = base + (size_t)row * ldc + col0; const float rstd = rsv[ai][m];
#pragma unroll
                for (int bj = 0; bj < 2; ++bj) { f32x4 v0 = acc[ai][bj][m][0] * rstd + cv[bj][0], v1 = acc[ai][bj][m][1] * rstd + cv[bj][1];
                    if (gate) {
#pragma unroll
                        for (int e = 0; e < 4; ++e) { v0[e] = 1.0f + __builtin_amdgcn_exp2f(__builtin_amdgcn_fmed3f(v0[e], -120.0f, 120.0f)); v1[e] = 1.0f + __builtin_amdgcn_exp2f(__builtin_amdgcn_fmed3f(v1[e], -120.0f, 120.0f)); } }
                    v4u w; w.x = cvt_pk_bf16(v0[0], v0[1]); w.y = cvt_pk_bf16(v0[2], v0[3]); w.z = cvt_pk_bf16(v1[0], v1[1]); w.w = cvt_pk_bf16(v1[2], v1[3]);
                    if (gate) *(v4u*)(gbase + gate_piece(ai, m, bj, wr * 4 + wc, fq * 16 + fr)) = w;
                    else *(v4u*)(rowp + bj * 128) = w; } }
    }
};
struct EpiMerge {
    static constexpr bool PERM = true, HOOKS = true; static constexpr int NST = 16;
    bf16* m; const bf16* pxg;
    __device__ __forceinline__ void hook(f32x4 (&acc)[2][2][4][2], const Unit& u, int t, int wr, int wc, int fr, int fq) const {
        asm volatile("" : "+v"(fr), "+v"(fq));
        const int wv = wr * 4 + wc, ln = fq * 16 + fr;
        const bf16* gnum = pxg + gate_tile(t == 4 ? 0 : 1, u.pm, u.pn); const bf16* gden = pxg + gate_tile(t == 4 ? 1 : 2, u.pm, u.pn);
#pragma unroll
        for (int ai = 0; ai < 2; ++ai)
#pragma unroll
            for (int mp = 0; mp < 2; ++mp) {
                v4u gn[2][2], gd[2][2];
#pragma unroll
                for (int mq = 0; mq < 2; ++mq)
#pragma unroll
                    for (int bj = 0; bj < 2; ++bj) { const int ro = gate_piece(ai, 2 * mp + mq, bj, wv, ln); gn[mq][bj] = *(const v4u*)(gnum + ro); gd[mq][bj] = *(const v4u*)(gden + ro); }
                asm volatile("" ::: "memory");
#pragma unroll
                for (int mq = 0; mq < 2; ++mq)
#pragma unroll
                    for (int bj = 0; bj < 2; ++bj) { const v4u a = gn[mq][bj], d = gd[mq][bj];
                        f32x4& v0 = acc[ai][bj][2 * mp + mq][0]; f32x4& v1 = acc[ai][bj][2 * mp + mq][1];
                        v0[0] *= bflo(d.x) * __builtin_amdgcn_rcpf(bflo(a.x)); v0[1] *= bfhi(d.x) * __builtin_amdgcn_rcpf(bfhi(a.x));
                        v0[2] *= bflo(d.y) * __builtin_amdgcn_rcpf(bflo(a.y)); v0[3] *= bfhi(d.y) * __builtin_amdgcn_rcpf(bfhi(a.y));
                        v1[0] *= bflo(d.z) * __builtin_amdgcn_rcpf(bflo(a.z)); v1[1] *= bfhi(d.z) * __builtin_amdgcn_rcpf(bfhi(a.z));
                        v1[2] *= bflo(d.w) * __builtin_amdgcn_rcpf(bflo(a.w)); v1[3] *= bfhi(d.w) * __builtin_amdgcn_rcpf(bfhi(a.w)); }
            }
    }
    __device__ __forceinline__ void operator()(const f32x4 (&acc)[2][2][4][2], const Unit& u, int wr, int wc, int fr, int fq) const {
        asm volatile("" : "+v"(fr), "+v"(fq));
        const int row0 = u.pm * 256 + wr * 64 + fr, col0 = u.pn * 256 + wc * 32 + 8 * fq;
        const bf16* ga = pxg + gate_tile(2, u.pm, u.pn);
#pragma unroll
        for (int ai = 0; ai < 2; ++ai) {
            v4u g[4][2];
#pragma unroll
            for (int mm = 0; mm < 4; ++mm)
#pragma unroll
                for (int bj = 0; bj < 2; ++bj) g[mm][bj] = *(const v4u*)(ga + gate_piece(ai, mm, bj, wr * 4 + wc, fq * 16 + fr));
            asm volatile("" ::: "memory");
#pragma unroll
            for (int mm = 0; mm < 4; ++mm)
#pragma unroll
                for (int bj = 0; bj < 2; ++bj) { const f32x4 v0 = acc[ai][bj][mm][0], v1 = acc[ai][bj][mm][1]; const v4u gg = g[mm][bj];
#define RC(x) __builtin_amdgcn_rcpf(x)
                    v4u w; w.x = cvt_pk_bf16(v0[0] * RC(bflo(gg.x)), v0[1] * RC(bfhi(gg.x))); w.y = cvt_pk_bf16(v0[2] * RC(bflo(gg.y)), v0[3] * RC(bfhi(gg.y)));
                    w.z = cvt_pk_bf16(v1[0] * RC(bflo(gg.z)), v1[1] * RC(bfhi(gg.z))); w.w = cvt_pk_bf16(v1[2] * RC(bflo(gg.w)), v1[3] * RC(bfhi(gg.w)));
#undef RC
                    *(v4u*)(m + (size_t)(row0 + ai * 128 + mm * 16) * DM + col0 + bj * 128) = w; }
        }
    }
};
template <bool BF  >
struct EpiRes {
    static constexpr bool PERM = true, HOOKS = false; static constexpr int NST = 32;
    const void* base_l; bf16* out; const float* gate;
    float* part;
    const float* gn; bf16* ap; u64* rs;
    __device__ __forceinline__ void operator()(const f32x4 (&acc)[2][2][4][2], const Unit& u, int wr, int wc, int fr, int fq) const {
        asm volatile("" : "+v"(fr), "+v"(fq));
        const bool isc = u.pm >= 128; const int grp = isc ? 4 : (u.pm >> 5);
        const int row0 = (isc ? (u.pm - 128) : u.pm) * 256 + wr * 64 + fr, col0 = u.pn * 256 + wc * 32 + 8 * fq;
        if (isc) {
            if (part == nullptr) return;
            float* po = part + (size_t)u.br * 1024 * 1024;
#pragma unroll
            for (int ai = 0; ai < 2; ++ai)
#pragma unroll
                for (int m = 0; m < 4; ++m)
#pragma unroll
                    for (int bj = 0; bj < 2; ++bj)
#pragma unroll
                        for (int n = 0; n < 2; ++n) *(f32x4*)(po + (size_t)(row0 + ai * 128 + m * 16) * DM + col0 + bj * 128 + n * 4) = acc[ai][bj][m][n];
            return;
        }
        f32x4 gv[2][2], gnv[2][2];
#pragma unroll
        for (int bj = 0; bj < 2; ++bj)
#pragma unroll
            for (int n = 0; n < 2; ++n) { gv[bj][n] = *(const f32x4*)(gate + grp * NMOD + col0 + bj * 128 + n * 4); gnv[bj][n] = *(const f32x4*)(gn + grp * DM + col0 + bj * 128 + n * 4); }
#pragma unroll
        for (int ai = 0; ai < 2; ++ai)
#pragma unroll
            for (int mp = 0; mp < 2; ++mp) {
                f32x4 bs[2][2][2];
                if constexpr (BF) {
                    v4u bb[2][2];
#pragma unroll
                    for (int mq = 0; mq < 2; ++mq)
#pragma unroll
                        for (int bj = 0; bj < 2; ++bj) bb[mq][bj] = *(const v4u*)((const bf16*)base_l + (size_t)(row0 + ai * 128 + (2 * mp + mq) * 16) * DM + col0 + bj * 128);
                    asm volatile("" ::: "memory");
#pragma unroll
                    for (int mq = 0; mq < 2; ++mq)
#pragma unroll
                        for (int bj = 0; bj < 2; ++bj) { const v4u b = bb[mq][bj]; bs[mq][bj][0] = (f32x4){bflo(b.x), bfhi(b.x), bflo(b.y), bfhi(b.y)}; bs[mq][bj][1] = (f32x4){bflo(b.z), bfhi(b.z), bflo(b.w), bfhi(b.w)}; }
                } else {
#pragma unroll
                    for (int mq = 0; mq < 2; ++mq)
#pragma unroll
                        for (int bj = 0; bj < 2; ++bj)
#pragma unroll
                            for (int n = 0; n < 2; ++n) bs[mq][bj][n] = *(const f32x4*)((const float*)base_l + (size_t)(row0 + ai * 128 + (2 * mp + mq) * 16) * DM + col0 + bj * 128 + n * 4);
                    asm volatile("" ::: "memory");
                }
#pragma unroll
                for (int mq = 0; mq < 2; ++mq) { const int m = 2 * mp + mq; float ss = 0.f; const size_t ro = (size_t)(row0 + ai * 128 + m * 16) * DM + col0;
#pragma unroll
                    for (int bj = 0; bj < 2; ++bj) {
                        const f32x4 o0 = bs[mq][bj][0] + gv[bj][0] * acc[ai][bj][m][0], o1 = bs[mq][bj][1] + gv[bj][1] * acc[ai][bj][m][1];
                        v4u ow; ow.x = cvt_pk_bf16(o0[0], o0[1]); ow.y = cvt_pk_bf16(o0[2], o0[3]); ow.z = cvt_pk_bf16(o1[0], o1[1]); ow.w = cvt_pk_bf16(o1[2], o1[3]);
                        *(v4u*)(out + ro + bj * 128) = ow;
                        const f32x4 y0 = o0 * gnv[bj][0], y1 = o1 * gnv[bj][1];
                        v4u w; w.x = cvt_pk_bf16(y0[0], y0[1]); w.y = cvt_pk_bf16(y0[2], y0[3]); w.z = cvt_pk_bf16(y1[0], y1[1]); w.w = cvt_pk_bf16(y1[2], y1[3]);
                        *(v4u*)(ap + ro + bj * 128) = w;
                        ss += ((o0[0] * o0[0] + o0[1] * o0[1]) + (o0[2] * o0[2] + o0[3] * o0[3])) + ((o1[0] * o1[0] + o1[1] * o1[1]) + (o1[2] * o1[2] + o1[3] * o1[3])); }
                    ss += __shfl_xor(ss, 16); ss += __shfl_xor(ss, 32);
                    if (fq == 0) __hip_atomic_fetch_add(rs + row0 + ai * 128 + m * 16, (u64)(ss * 16777216.0f + 0.5f), __ATOMIC_RELAXED, __HIP_MEMORY_SCOPE_AGENT); }
            }
    }
};
struct EpiResFinal {
    static constexpr bool PERM = true, HOOKS = false; static constexpr int NST = 32;
    const bf16* xs; float* xo; const float* gate; const float* fg; u64* rs; unsigned* cnt; unsigned* tmo;
    __device__ __forceinline__ void operator()(f32x4 (&acc)[2][2][4][2], const Unit& u, int wr, int wc, int fr, int fq) const {
        asm volatile("" : "+v"(fr), "+v"(fq));
        const int grp = u.pm >> 5, row0 = u.pm * 256 + wr * 64 + fr, col0 = u.pn * 256 + wc * 32 + 8 * fq;
        f32x4 gv[2][2];
#pragma unroll
        for (int bj = 0; bj < 2; ++bj)
#pragma unroll
            for (int n = 0; n < 2; ++n) gv[bj][n] = *(const f32x4*)(gate + grp * NMOD + col0 + bj * 128 + n * 4);
#pragma unroll
        for (int ai = 0; ai < 2; ++ai)
#pragma unroll
            for (int mp = 0; mp < 2; ++mp) {
                f32x4 bs[2][2][2];
                { v4u bb[2][2];
#pragma unroll
                  for (int mq = 0; mq < 2; ++mq)
#pragma unroll
                      for (int bj = 0; bj < 2; ++bj) bb[mq][bj] = *(const v4u*)(xs + (size_t)(row0 + ai * 128 + (2 * mp + mq) * 16) * DM + col0 + bj * 128);
                  asm volatile("" ::: "memory");
#pragma unroll
                  for (int mq = 0; mq < 2; ++mq)
#pragma unroll
                      for (int bj = 0; bj < 2; ++bj) { const v4u b = bb[mq][bj]; bs[mq][bj][0] = (f32x4){bflo(b.x), bfhi(b.x), bflo(b.y), bfhi(b.y)}; bs[mq][bj][1] = (f32x4){bflo(b.z), bfhi(b.z), bflo(b.w), bfhi(b.w)}; } }
#pragma unroll
                for (int mq = 0; mq < 2; ++mq) { const int m = 2 * mp + mq; float ss = 0.f;
#pragma unroll
                    for (int bj = 0; bj < 2; ++bj)
#pragma unroll
                        for (int n = 0; n < 2; ++n) { const f32x4 o = bs[mq][bj][n] + gv[bj][n] * acc[ai][bj][m][n]; acc[ai][bj][m][n] = o; ss += (o[0] * o[0] + o[1] * o[1]) + (o[2] * o[2] + o[3] * o[3]); }
                    ss += __shfl_xor(ss, 16); ss += __shfl_xor(ss, 32);
                    if (fq == 0) __hip_atomic_fetch_add(rs + row0 + ai * 128 + m * 16, (u64)(ss * 16777216.0f + 0.5f), __ATOMIC_RELAXED, __HIP_MEMORY_SCOPE_AGENT); }
            }
        asm volatile("s_waitcnt vmcnt(0)" ::: "memory");
        unsigned* pc = cnt + 64 * u.pm;
        if (__builtin_amdgcn_mbcnt_hi(~0u, __builtin_amdgcn_mbcnt_lo(~0u, 0u)) == 0) __hip_atomic_fetch_add(pc, 1u, __ATOMIC_RELAXED, __HIP_MEMORY_SCOPE_AGENT);
        { unsigned spins = 0;
          while ((unsigned)__builtin_amdgcn_readfirstlane(__hip_atomic_load(pc, __ATOMIC_RELAXED, __HIP_MEMORY_SCOPE_AGENT)) < 32u) {
              __builtin_amdgcn_s_sleep(2);
              if (++spins > (1u << 22)) { __hip_atomic_store(tmo, 1u, __ATOMIC_RELAXED, __HIP_MEMORY_SCOPE_AGENT); break; } } }
        f32x4 fgv[2][2];
#pragma unroll
        for (int bj = 0; bj < 2; ++bj)
#pragma unroll
            for (int n = 0; n < 2; ++n) fgv[bj][n] = *(const f32x4*)(fg + col0 + bj * 128 + n * 4);
#pragma unroll
        for (int ai = 0; ai < 2; ++ai)
#pragma unroll
            for (int m = 0; m < 4; ++m) { const int row = row0 + ai * 128 + m * 16;
                const float rstd = rs_to_rstd(__hip_atomic_load(rs + row, __ATOMIC_RELAXED, __HIP_MEMORY_SCOPE_AGENT));
#pragma unroll
                for (int bj = 0; bj < 2; ++bj)
#pragma unroll
                    for (int n = 0; n < 2; ++n) *(f32x4*)(xo + (size_t)row * DM + col0 + bj * 128 + n * 4) = acc[ai][bj][m][n] * rstd * fgv[bj][n]; }
    }
};
struct EpiAct {
    static constexpr bool PERM = true, HOOKS = false; static constexpr int NST = 16;
    bf16* a; const u64* rs; const float* cup;
    __device__ __forceinline__ void operator()(const f32x4 (&acc)[2][2][4][2], const Unit& u, int wr, int wc, int fr, int fq) const {
        asm volatile("" : "+v"(fr), "+v"(fq));
        const int grp = u.pm >= 128 ? 4 : (u.pm >> 5);
        const int row0 = u.pm * 256 + wr * 64 + fr, col0 = u.pn * 256 + wc * 32 + 8 * fq;
        const float* cp = cup + grp * FF + col0;
        f32x4 cv[2][2];
#pragma unroll
        for (int bj = 0; bj < 2; ++bj) { cv[bj][0] = *(const f32x4*)(cp + bj * 128); cv[bj][1] = *(const f32x4*)(cp + bj * 128 + 4); }
        u64 rq[2][4]; float rsv[2][4];
#pragma unroll
        for (int ai = 0; ai < 2; ++ai)
#pragma unroll
            for (int m = 0; m < 4; ++m) rq[ai][m] = rs[row0 + ai * 128 + m * 16];
        asm volatile("" ::: "memory");
#pragma unroll
        for (int ai = 0; ai < 2; ++ai)
#pragma unroll
            for (int m = 0; m < 4; ++m) rsv[ai][m] = rs_to_rstd(rq[ai][m]);
#pragma unroll
        for (int ai = 0; ai < 2; ++ai)
#pragma unroll
            for (int m = 0; m < 4; ++m) { const int row = row0 + ai * 128 + m * 16; bf16* rowp = a + (size_t)row * FF + col0; const float rstd = rsv[ai][m];
#pragma unroll
                for (int bj = 0; bj < 2; ++bj) { f32x4 v0 = acc[ai][bj][m][0] * rstd + cv[bj][0], v1 = acc[ai][bj][m][1] * rstd + cv[bj][1];
#pragma unroll
                    for (int e = 0; e < 4; ++e) { const float r0 = fmaxf(v0[e], 0.f), r1 = fmaxf(v1[e], 0.f); v0[e] = r0 * r0; v1[e] = r1 * r1; }
                    v4u w; w.x = cvt_pk_bf16(v0[0], v0[1]); w.y = cvt_pk_bf16(v0[2], v0[3]); w.z = cvt_pk_bf16(v1[0], v1[1]); w.w = cvt_pk_bf16(v1[2], v1[3]);
                    *(v4u*)(rowp + bj * 128) = w; } }
    }
};

constexpr int NS = 8;
constexpr int NSTEPS = 2 + 2 * NS;
constexpr int LARGS_OFF = LDSCTL_OFF + 1024;
enum { A_X = 0, A_C, A_CTX, A_CCTX, A_ADAW, A_ADAB, A_N1G, A_N2G, A_WIN, A_CONVW, A_RELB, A_WF, A_WC, A_WA, A_WO, A_W1, A_W2, A_FG, A_OUT, A_WS, A_NARGS };

struct Ctx { LAS unsigned char* lds; int wave, G, bx, gw, NGW, NGT;
    __device__ __forceinline__ int lane() const { int l; asm volatile("v_mbcnt_lo_u32_b32 %0, -1, 0\n\tv_mbcnt_hi_u32_b32 %0, -1, %0" : "=v"(l)); return l; }
    __device__ __forceinline__ int tid() const { return wave * 64 + lane(); }
    __device__ __forceinline__ int gt() const { return bx * NTHR + tid(); }
};
template <int I> __device__ __forceinline__ unsigned long long ldarg_t() {
    unsigned long long v; unsigned tmp;
    asm volatile("v_mov_b32 %1, %2\n\tds_read_b64 %0, %1 offset:%3\n\ts_waitcnt lgkmcnt(0)" : "=&v"(v), "=&v"(tmp) : "i"(LARGS_OFF), "i"(I * 8) : "memory");
    const unsigned lo = __builtin_amdgcn_readfirstlane((unsigned)v), hi = __builtin_amdgcn_readfirstlane((unsigned)(v >> 32));
    return ((unsigned long long)hi << 32) | lo;
}
#define ldarg(C, i) ldarg_t<(i)>()
#define ARGF(i) ((const float*)(const GAS float*)ldarg(C, (i)))
#define WSP(T, off) ((T*)(GAS T*)((GAS unsigned char*)ldarg(C, A_WS) + (off)))

__device__ __forceinline__ void ph_mod_partial(const Ctx& C) {
    const float* cvec = ARGF(A_C); const float* cctx = ARGF(A_CCTX); const float* ada_w = ARGF(A_ADAW);
    float* modp = WSP(float, WS_MODP); float2* tw = WSP(float2, WS_TW);
    LAS float* sl = (LAS float*)C.lds;
    for (int item = C.bx; item < 2 * 8 * 12; item += C.G) {
        const int l = item / 96, rem = item % 96, kc = rem / 12, jb = rem % 12;
        __syncthreads();
        for (int e = C.tid(); e < 5 * 128; e += NTHR) { const int g = e >> 7, k = kc * 128 + (e & 127); const float v = g < 4 ? cvec[g * DM + k] : cctx[k]; sl[e] = v / (1.0f + __expf(-v)); }
        __syncthreads();
        const int j = jb * 512 + C.tid(); float a0 = 0.f, a1 = 0.f, a2 = 0.f, a3 = 0.f, a4 = 0.f;
        const float* wp = ada_w + ((size_t)l * DM + kc * 128) * NMOD + j;
#pragma unroll 4
        for (int k = 0; k < 128; ++k) { const float w = wp[(size_t)k * NMOD]; a0 += sl[k] * w; a1 += sl[128 + k] * w; a2 += sl[256 + k] * w; a3 += sl[384 + k] * w; a4 += sl[512 + k] * w; }
        float* pp = modp + ((size_t)(l * 8 + kc) * 5) * NMOD + j;
        pp[0] = a0; pp[NMOD] = a1; pp[2 * NMOD] = a2; pp[3 * NMOD] = a3; pp[4 * NMOD] = a4;
    }
    for (int m = C.gt(); m < 8192; m += C.NGT) { float s, c; sincospif((float)m * (1.0f / 4096.0f), &s, &c); tw[m] = make_float2(c, s); }
}
__device__ __forceinline__ void ph_mod_reduce(const Ctx& C) {
    const float* ada_b = ARGF(A_ADAB); const float* modp = WSP(float, WS_MODP); float* mod = WSP(float, WS_MOD);
    for (int e = C.gt(); e < 2 * 5 * NMOD; e += C.NGT) { const int l = e / (5 * NMOD), r = e % (5 * NMOD), j = r % NMOD; float s = ada_b[l * NMOD + j];
#pragma unroll
        for (int kc = 0; kc < 8; ++kc) s += modp[(size_t)(l * 8 + kc) * 5 * NMOD + r];
        mod[e] = s; }
    float* gnt = WSP(float, WS_GN); const float* n1g = ARGF(A_N1G); const float* n2g = ARGF(A_N2G);
    for (int e = C.gt(); e < 2 * 2 * 5 * DM; e += C.NGT) { const int col = e & 1023, grp = (e >> 10) % 5, w = (e / (5 * DM)) & 1, l = e / (10 * DM), j = (w ? 4 : 1) * DM + col;
        float s = ada_b[l * NMOD + j];
#pragma unroll
        for (int kc = 0; kc < 8; ++kc) s += modp[((size_t)(l * 8 + kc) * 5 + grp) * NMOD + j];
        gnt[e] = (w ? n2g : n1g)[l * DM + col] * (1.0f + s); }
}
__device__ __forceinline__ void ph_ctab(const Ctx& C, int l) {
    LAS float* red = (LAS float*)(C.lds + 131072); LAS float* cu = red + 8 * 5 * 64;
    const float* modl = WSP(const float, WS_MOD) + (size_t)l * 5 * NMOD; const float2* tw = WSP(const float2, WS_TW);
    float* cin = WSP(float, WS_CIN) + (size_t)l * 5 * NIN; float* cup = WSP(float, WS_CUP) + (size_t)l * 5 * FF;
    const int lane = C.lane(), w = C.wave, tid = C.tid();
    LAS float* sl = (LAS float*)C.lds;
    for (int it = C.bx; it < 88 + 64; it += C.G) {
        const bool isin = it < 88; const int ldw = isin ? NIN_ORIG : FF, col0 = (isin ? it : it - 88) * 64;
        __syncthreads();
        for (int e = tid; e < 5 * 1024; e += NTHR) sl[e] = modl[(e >> 10) * NMOD + (isin ? 0 : 3 * DM) + (e & 1023)];
        __syncthreads();
        const int rq = lane >> 4, c4 = lane & 15;
        const float* W = (isin ? ARGF(A_WIN) + (size_t)l * DM * NIN_ORIG : ARGF(A_W1) + (size_t)l * DM * FF) + (size_t)(128 * w + rq) * ldw + col0 + 4 * c4;
        f32x4 a[5];
#pragma unroll
        for (int g = 0; g < 5; ++g) a[g] = (f32x4){0.f, 0.f, 0.f, 0.f};
#pragma unroll 8
        for (int i = 0; i < 32; ++i) { const f32x4 wv = *(const f32x4*)(W + (size_t)(4 * i) * ldw); const int kr = 128 * w + 4 * i + rq;
#pragma unroll
            for (int g = 0; g < 5; ++g) a[g] += sl[g * 1024 + kr] * wv; }
#pragma unroll
        for (int g = 0; g < 5; ++g)
#pragma unroll
            for (int e = 0; e < 4; ++e) { float v = a[g][e]; v += __shfl_xor(v, 16); v += __shfl_xor(v, 32); a[g][e] = v; }
        if (lane < 16) {
#pragma unroll
            for (int g = 0; g < 5; ++g) { red[(w * 5 + g) * 64 + 4 * c4] = a[g][0]; red[(w * 5 + g) * 64 + 4 * c4 + 1] = a[g][1]; red[(w * 5 + g) * 64 + 4 * c4 + 2] = a[g][2]; red[(w * 5 + g) * 64 + 4 * c4 + 3] = a[g][3]; } }
        __syncthreads();
        if (tid < 320) { const int g = tid >> 6, c = tid & 63; float v = 0.f;
#pragma unroll
            for (int ww = 0; ww < 8; ++ww) v += red[(ww * 5 + g) * 64 + c];
            if (!isin) cup[g * FF + col0 + c] = v; else if (it >= 4) cin[g * NIN + col0 + c + 256] = v; else cu[g * 64 + c] = v; }
        if (isin && it < 4) { __syncthreads();
            if (tid < 320) { const int g = tid >> 6, kc = tid & 63; float p = 0.f, q = 0.f;
                for (int c = 0; c < 64; ++c) { const float2 t = tw[((c * kc) & 63) * 128]; const float v = cu[g * 64 + c]; p += v * t.x; q += v * t.y; }
                cin[g * NIN + it * 64 + kc] = p; cin[g * NIN + 256 + it * 64 + kc] = q; } }
    }
    __syncthreads();
}
__device__ __forceinline__ void ph_weights(const Ctx& C, int l) {
    LAS float* scr = (LAS float*)(C.lds + C.wave * 16384);
    const int lane = C.lane();
    const float* Win = ARGF(A_WIN) + (size_t)l * DM * NIN_ORIG;
    bf16* win_t = WSP(bf16, WS_WIN); bf16* wm_t = WSP(bf16, WS_WM);
    constexpr int I_IN = (DM / 64) * ((NIN_ORIG - 256) / 32), I_F = (256 / 64) * (DM / 32), I_A = (512 / 64) * (DM / 32), I_O = (DM / 64) * (DM / 32), I_1 = (DM / 64) * (FF / 32), I_2 = (FF / 64) * (DM / 32);
    constexpr int NITEMS = I_IN + 2 * I_F + I_A + I_O + I_1 + I_2;
    for (int it = C.gw; it < NITEMS; it += C.NGW) {
        int r = it;
        if (r < I_IN) { transpose_item(Win + 256, NIN_ORIG, NIN_ORIG - 256, win_t, DM, 512, 0, scr, r, lane); continue; } r -= I_IN;
        if (r < I_F) { transpose_item(ARGF(A_WF) + (size_t)l * 256 * DM, DM, DM, wm_t, DM, 0, 0, scr, r, lane); continue; } r -= I_F;
        if (r < I_F) { transpose_item(ARGF(A_WC) + (size_t)l * 256 * DM, DM, DM, wm_t, DM, 0, 256, scr, r, lane); continue; } r -= I_F;
        if (r < I_A) { transpose_item(ARGF(A_WA) + (size_t)l * 512 * DM, DM, DM, wm_t, DM, 0, 512, scr, r, lane); continue; } r -= I_A;
        if (r < I_O) { transpose_item(ARGF(A_WO) + (size_t)l * DM * DM, DM, DM, WSP(bf16, WS_WO), DM, 0, 0, scr, r, lane); continue; } r -= I_O;
        if (r < I_1) { transpose_item(ARGF(A_W1) + (size_t)l * DM * FF, FF, FF, WSP(bf16, WS_W1), DM, 0, 0, scr, r, lane); continue; } r -= I_1;
        transpose_item(ARGF(A_W2) + (size_t)l * FF * DM, DM, DM, WSP(bf16, WS_W2), FF, 0, 0, scr, r, lane);
    }
    for (int it = C.gw; it < 4 * 32 * 8; it += C.NGW) {
        const int kq = it & 7, g = it >> 8, k0 = ((it >> 3) & 31) * 32, kl = lane & 31, pq = lane >> 5;
        LAS float* tile = scr;
        LAS float* ct = scr + 32 * 65;
        { float s, c; sincospif((float)lane * (1.0f / 32.0f), &s, &c); ct[lane] = c; ct[64 + lane] = s; }
#pragma unroll 8
        for (int kk = 0; kk < 32; ++kk) tile[kk * 65 + lane] = Win[(size_t)(k0 + kk) * NIN_ORIG + g * 64 + lane];
        LDS_WAIT(); asm volatile("" ::: "memory");
        float p[8];
#pragma unroll
        for (int j = 0; j < 8; ++j) p[j] = 0.f;
#pragma unroll 4
        for (int c = 0; c < 64; ++c) { const float wv = tile[kl * 65 + c];
#pragma unroll
            for (int j = 0; j < 8; ++j) p[j] += wv * ct[pq * 64 + ((c * (kq * 8 + j)) & 63)]; }
#pragma unroll
        for (int j = 0; j < 8; ++j) win_t[(size_t)(pq * 256 + g * 64 + kq * 8 + j) * DM + k0 + kl] = (bf16)f2bf(p[j]);
        LDS_WAIT(); asm volatile("" ::: "memory");
    }
}
__device__ __forceinline__ void ph_prenorm(const Ctx& C, const float* xl, const float* xc, const float* gn, bf16* dst, u64* rs, int row_begin, int row_end, const float* part, const float* pgate) {
    const int lane = C.lane();
    for (int row = row_begin + C.gw; row < row_end; row += C.NGW) {
        const bool isc = row >= ML; const int grp = isc ? 4 : (row >> 13);
        const float* xr = isc ? xc + (size_t)(row - ML) * DM : xl + (size_t)row * DM;
        f32x4 v[4]; float s2 = 0.f;
#pragma unroll
        for (int j = 0; j < 4; ++j) { v[j] = *(const f32x4*)(xr + 4 * lane + 256 * j);
            if (part != nullptr && isc) {
                const size_t po = (size_t)(row - ML) * DM + 4 * lane + 256 * j;
                const f32x4 ps = (*(const f32x4*)(part + po) + *(const f32x4*)(part + po + 1048576)) + (*(const f32x4*)(part + po + 2 * 1048576) + *(const f32x4*)(part + po + 3 * 1048576));
                v[j] = v[j] + *(const f32x4*)(pgate + 4 * lane + 256 * j) * ps; }
            s2 += (v[j].x * v[j].x + v[j].y * v[j].y) + (v[j].z * v[j].z + v[j].w * v[j].w); }
        s2 = wave_sum(s2);
        if (lane == 0) rs[row] = (u64)(s2 * 16777216.0f + 0.5f);
#pragma unroll
        for (int j = 0; j < 4; ++j) { const int c0 = 4 * lane + 256 * j; const f32x4 y = v[j] * *(const f32x4*)(gn + grp * DM + c0);
            v2u o; o.x = pk2(y.x, y.y); o.y = pk2(y.z, y.w); *(v2u*)(dst + (size_t)row * DM + c0) = o; }
    }
}
__device__ __forceinline__ void ph_mixers(const Ctx& C, int l) {
    const bf16* pxa = WSP(const bf16, WS_PXA); bf16* mix = WSP(bf16, WS_HX);
    const float* cw = ARGF(A_CONVW) + l * 3 * 256;
    const int nrows = l == 0 ? MT : ML;
    for (int e = C.gt(); e < nrows * 32; e += C.NGT) {
        const int row = e >> 5, ch = (e & 31) * 8;
        const int pos = row < ML ? (row & (SEQ - 1)) : ((row - ML) & 255), len = row < ML ? SEQ : 256;
        const bf16* pr = pxa + (size_t)row * NPXA;
        const v4u u1 = *(const v4u*)(pr + OFF_CU + ch), c1 = *(const v4u*)(pr + OFF_CC + ch), b1 = *(const v4u*)(pr + OFF_CB + ch);
        v4u u0 = (v4u){0, 0, 0, 0}, c0 = u0, u2 = u0, c2 = u0;
        if (pos > 0) { u0 = *(const v4u*)(pr - NPXA + OFF_CU + ch); c0 = *(const v4u*)(pr - NPXA + OFF_CC + ch); }
        if (pos < len - 1) { u2 = *(const v4u*)(pr + NPXA + OFF_CU + ch); c2 = *(const v4u*)(pr + NPXA + OFF_CC + ch); }
        float o[8]; float w0[8], w1[8], w2[8];
        { const f32x4 t0 = *(const f32x4*)(cw + ch), t1 = *(const f32x4*)(cw + ch + 4), t2 = *(const f32x4*)(cw + 256 + ch), t3 = *(const f32x4*)(cw + 256 + ch + 4), t4 = *(const f32x4*)(cw + 512 + ch), t5 = *(const f32x4*)(cw + 512 + ch + 4);
#pragma unroll
          for (int j = 0; j < 4; ++j) { w0[j] = t0[j]; w0[4 + j] = t1[j]; w1[j] = t2[j]; w1[4 + j] = t3[j]; w2[j] = t4[j]; w2[4 + j] = t5[j]; } }
#pragma unroll
        for (int j = 0; j < 4; ++j) {
            const unsigned a0 = u0[j], d0 = c0[j], a1 = u1[j], d1 = c1[j], a2 = u2[j], d2 = c2[j], bb = b1[j];
            o[2 * j] = bflo(bb) * (w0[2 * j] * bflo(a0) * bflo(d0) + w1[2 * j] * bflo(a1) * bflo(d1) + w2[2 * j] * bflo(a2) * bflo(d2));
            o[2 * j + 1] = bfhi(bb) * (w0[2 * j + 1] * bfhi(a0) * bfhi(d0) + w1[2 * j + 1] * bfhi(a1) * bfhi(d1) + w2[2 * j + 1] * bfhi(a2) * bfhi(d2));
        }
        v4u w; w.x = pk2(o[0], o[1]); w.y = pk2(o[2], o[3]); w.z = pk2(o[4], o[5]); w.w = pk2(o[6], o[7]);
        *(v4u*)(mix + (size_t)row * DM + 256 + ch) = w;
    }
}

typedef short bf16x8_t __attribute__((ext_vector_type(8)));
typedef short v4i16_t __attribute__((ext_vector_type(4)));
constexpr int AT_KW = 0, AT_VW = 73728, AT_BT = 147456;
template <bool WIN>
__device__ __forceinline__ void attn_block(LAS unsigned char* lds, const int (&ka)[2][2], const int (&va)[2][4], int rowoff0, const bf16x8_t (&qf)[2],
                                           const LAS float* brow  , const int (&dcs)[4]  , unsigned vmask  ,
                                           f32x4 (&o)[4], f32x4& osum, float& m) {
    constexpr float SC = 0.18033688011112042f;
    constexpr int RS = WIN ? 8192 : 4096;
    f32x4 s[8][2];
#pragma unroll
    for (int j = 0; j < 8; ++j)
#pragma unroll
        for (int t = 0; t < 2; ++t) { s[j][t] = (f32x4){0.f, 0.f, 0.f, 0.f};
#pragma unroll
            for (int ks = 0; ks < 2; ++ks) { const bf16x8_t kf = *(const LAS bf16x8_t*)(lds + ka[t][ks] + rowoff0 + j * RS); s[j][t] = __builtin_amdgcn_mfma_f32_16x16x32_bf16(kf, qf[ks], s[j][t], 0, 0, 0); } }
    const v4u onesw = (v4u){0x3F803F80u, 0x3F803F80u, 0x3F803F80u, 0x3F803F80u}; const bf16x8_t ones = __builtin_bit_cast(bf16x8_t, onesw);
    if constexpr (WIN) {
        const bool v0 = vmask & 1u, v1 = vmask & 2u, v2 = vmask & 4u, v3 = vmask & 8u;
        const unsigned hm01 = (v0 ? 0xFFFFu : 0u) | (v1 ? 0xFFFF0000u : 0u), hm23 = (v2 ? 0xFFFFu : 0u) | (v3 ? 0xFFFF0000u : 0u);
        float tmax = -1e30f;
#pragma unroll
        for (int j = 0; j < 8; ++j) {
            f32x4 v;
            v[0] = (v0 ? s[j][0][0] : s[j][1][0]) * SC + brow[j * 31 + dcs[0]]; v[1] = (v1 ? s[j][0][1] : s[j][1][1]) * SC + brow[j * 31 + dcs[1]];
            v[2] = (v2 ? s[j][0][2] : s[j][1][2]) * SC + brow[j * 31 + dcs[2]]; v[3] = (v3 ? s[j][0][3] : s[j][1][3]) * SC + brow[j * 31 + dcs[3]];
            s[j][0] = v; tmax = fmaxf(tmax, fmaxf(fmaxf(v[0], v[1]), fmaxf(v[2], v[3]))); }
        tmax = fmaxf(tmax, __shfl_xor(tmax, 16)); tmax = fmaxf(tmax, __shfl_xor(tmax, 32));
        const float mn = fmaxf(m, tmax), alpha = __builtin_amdgcn_exp2f(m - mn); m = mn;
#pragma unroll
        for (int db = 0; db < 4; ++db) o[db] = o[db] * alpha;
        osum = osum * alpha;
#pragma unroll
        for (int j = 0; j < 8; ++j) {
            const unsigned p01 = pg8::cvt_pk_bf16(__builtin_amdgcn_exp2f(s[j][0][0] - mn), __builtin_amdgcn_exp2f(s[j][0][1] - mn)), p23 = pg8::cvt_pk_bf16(__builtin_amdgcn_exp2f(s[j][0][2] - mn), __builtin_amdgcn_exp2f(s[j][0][3] - mn));
            v4u pw; pw.x = p01 & hm01; pw.y = p23 & hm23; pw.z = p01 & ~hm01; pw.w = p23 & ~hm23;
            const bf16x8_t pf = __builtin_bit_cast(bf16x8_t, pw);
            osum = __builtin_amdgcn_mfma_f32_16x16x32_bf16(ones, pf, osum, 0, 0, 0);
#pragma unroll
            for (int db = 0; db < 4; ++db) {
                const v4i16_t lo = __builtin_amdgcn_ds_read_tr16_b64_v4i16((LAS v4i16_t*)(lds + va[0][db] + rowoff0 + j * RS));
                const v4i16_t hi = __builtin_amdgcn_ds_read_tr16_b64_v4i16((LAS v4i16_t*)(lds + va[1][db] + rowoff0 + j * RS));
                const bf16x8_t vf = (bf16x8_t){lo[0], lo[1], lo[2], lo[3], hi[0], hi[1], hi[2], hi[3]};
                o[db] = __builtin_amdgcn_mfma_f32_16x16x32_bf16(vf, pf, o[db], 0, 0, 0);
            }
        }
    } else {
        float tmax = -1e30f;
#pragma unroll
        for (int j = 0; j < 8; ++j)
#pragma unroll
            for (int t = 0; t < 2; ++t) tmax = fmaxf(tmax, fmaxf(fmaxf(s[j][t][0], s[j][t][1]), fmaxf(s[j][t][2], s[j][t][3])));
        tmax = fmaxf(tmax, __shfl_xor(tmax, 16)); tmax = fmaxf(tmax, __shfl_xor(tmax, 32));
        const float mn = fmaxf(m, tmax * SC), alpha = __builtin_amdgcn_exp2f(m - mn); m = mn;
#pragma unroll
        for (int db = 0; db < 4; ++db) o[db] = o[db] * alpha;
        osum = osum * alpha;
#pragma unroll
        for (int j = 0; j < 8; ++j) {
            v4u pw;
            pw.x = pg8::cvt_pk_bf16(__builtin_amdgcn_exp2f(s[j][0][0] * SC - mn), __builtin_amdgcn_exp2f(s[j][0][1] * SC - mn)); pw.y = pg8::cvt_pk_bf16(__builtin_amdgcn_exp2f(s[j][0][2] * SC - mn), __builtin_amdgcn_exp2f(s[j][0][3] * SC - mn));
            pw.z = pg8::cvt_pk_bf16(__builtin_amdgcn_exp2f(s[j][1][0] * SC - mn), __builtin_amdgcn_exp2f(s[j][1][1] * SC - mn)); pw.w = pg8::cvt_pk_bf16(__builtin_amdgcn_exp2f(s[j][1][2] * SC - mn), __builtin_amdgcn_exp2f(s[j][1][3] * SC - mn));
            const bf16x8_t pf = __builtin_bit_cast(bf16x8_t, pw);
            osum = __builtin_amdgcn_mfma_f32_16x16x32_bf16(ones, pf, osum, 0, 0, 0);
#pragma unroll
            for (int db = 0; db < 4; ++db) {
                const v4i16_t lo = __builtin_amdgcn_ds_read_tr16_b64_v4i16((LAS v4i16_t*)(lds + va[0][db] + rowoff0 + j * RS));
                const v4i16_t hi = __builtin_amdgcn_ds_read_tr16_b64_v4i16((LAS v4i16_t*)(lds + va[1][db] + rowoff0 + j * RS));
                const bf16x8_t vf = (bf16x8_t){lo[0], lo[1], lo[2], lo[3], hi[0], hi[1], hi[2], hi[3]};
                o[db] = __builtin_amdgcn_mfma_f32_16x16x32_bf16(vf, pf, o[db], 0, 0, 0);
            }
        }
    }
}
__device__ __forceinline__ void attn_addr(int kc0off, int li, int fq, int (&ka)[2][2], int (&va)[2][4]) {
#pragma unroll
    for (int t = 0; t < 2; ++t) {
        const int rk = kc0off + 16 * t + li;
#pragma unroll
        for (int ks = 0; ks < 2; ++ks) ka[t][ks] = AT_KW + rk * 128 + (((4 * ks + fq) ^ ((rk >> 1) & 7)) * 16);
        const int rv = kc0off + 16 * t + 4 * fq + (li >> 2), p = li & 3;
#pragma unroll
        for (int db = 0; db < 4; ++db) va[t][db] = AT_VW + rv * 128 + (((2 * db + (p >> 1)) ^ (((rv >> 1) & 3) << 1)) * 16) + (p & 1) * 8;
    }
}

__device__ __forceinline__ void ph_ctx_dft(const Ctx& C) {
    if (C.bx >= 32) return;
    constexpr int DF_Q = 32768, DF_TW = AT_VW + 65536;
    static_assert(DF_TW + 2048 <= AT_BT, "ctx dft lds");
    const float2* tw = WSP(const float2, WS_TW); const bf16* pxa = WSP(const bf16, WS_PXA); bf16* mix = WSP(bf16, WS_HX);
    LAS unsigned char* lds = C.lds; LAS float* twl = (LAS float*)(lds + DF_TW);
    const int lane = C.lane(), w = C.wave, li = lane & 15, fq = lane >> 4, tid = C.tid();
    const int b = C.bx >> 3, kcb = (C.bx >> 1) & 3, kh = C.bx & 1;
    if (tid < 256) { const float2 v = tw[tid * 32]; twl[2 * tid] = v.x; twl[2 * tid + 1] = v.y; }
    for (int p = w; p < 32; p += 8) {
        const int tokl = p * 8 + (lane >> 3), cp = lane & 7;
        const bf16* src = pxa + ((size_t)ML + b * 256 + tokl) * NPXA + kcb * 64 + ((cp ^ (((tokl >> 1) & 3) << 1)) * 8);
        __builtin_amdgcn_global_load_lds((const unsigned*)(src + OFF_P), (LAS unsigned*)(lds + AT_VW + p * 1024), 16, 0, 0);
        __builtin_amdgcn_global_load_lds((const unsigned*)(src + OFF_Q), (LAS unsigned*)(lds + AT_VW + DF_Q + p * 1024), 16, 0, 0);
    }
    int ka[2][2], va[2][4]; attn_addr(0, li, fq, ka, va);
    asm volatile("s_waitcnt vmcnt(0) lgkmcnt(0)" ::: "memory");
    __syncthreads();
    const int k = 128 * kh + 16 * w + li;
    f32x4 o[4];
#pragma unroll
    for (int db = 0; db < 4; ++db) o[db] = (f32x4){0.f, 0.f, 0.f, 0.f};
#pragma unroll 2
    for (int j = 0; j < 8; ++j) {
        float cs[8], sn[8];
#pragma unroll
        for (int t = 0; t < 2; ++t)
#pragma unroll
            for (int i = 0; i < 4; ++i) { const int n = 32 * j + 16 * t + 4 * fq + i, idx = (n * k) & 255; cs[4 * t + i] = twl[2 * idx]; sn[4 * t + i] = -twl[2 * idx + 1]; }
        v4u cw, sw;
        cw.x = pg8::cvt_pk_bf16(cs[0], cs[1]); cw.y = pg8::cvt_pk_bf16(cs[2], cs[3]); cw.z = pg8::cvt_pk_bf16(cs[4], cs[5]); cw.w = pg8::cvt_pk_bf16(cs[6], cs[7]);
        sw.x = pg8::cvt_pk_bf16(sn[0], sn[1]); sw.y = pg8::cvt_pk_bf16(sn[2], sn[3]); sw.z = pg8::cvt_pk_bf16(sn[4], sn[5]); sw.w = pg8::cvt_pk_bf16(sn[6], sn[7]);
        const bf16x8_t cf = __builtin_bit_cast(bf16x8_t, cw), sf = __builtin_bit_cast(bf16x8_t, sw);
#pragma unroll
        for (int db = 0; db < 4; ++db) {
            const v4i16_t plo = __builtin_amdgcn_ds_read_tr16_b64_v4i16((LAS v4i16_t*)(lds + va[0][db] + j * 4096)), phi = __builtin_amdgcn_ds_read_tr16_b64_v4i16((LAS v4i16_t*)(lds + va[1][db] + j * 4096));
            const v4i16_t qlo = __builtin_amdgcn_ds_read_tr16_b64_v4i16((LAS v4i16_t*)(lds + va[0][db] + DF_Q + j * 4096)), qhi = __builtin_amdgcn_ds_read_tr16_b64_v4i16((LAS v4i16_t*)(lds + va[1][db] + DF_Q + j * 4096));
            const bf16x8_t pf = (bf16x8_t){plo[0], plo[1], plo[2], plo[3], phi[0], phi[1], phi[2], phi[3]}, qf = (bf16x8_t){qlo[0], qlo[1], qlo[2], qlo[3], qhi[0], qhi[1], qhi[2], qhi[3]};
            o[db] = __builtin_amdgcn_mfma_f32_16x16x32_bf16(pf, cf, o[db], 0, 0, 0);
            o[db] = __builtin_amdgcn_mfma_f32_16x16x32_bf16(qf, sf, o[db], 0, 0, 0);
        }
    }
    bf16* op = mix + ((size_t)ML + b * 256 + k) * DM + kcb * 64 + 4 * fq;
#pragma unroll
    for (int db = 0; db < 4; ++db) { v2u ov; ov.x = pk2(o[db][0] * (1.0f / 128.0f), o[db][1] * (1.0f / 128.0f)); ov.y = pk2(o[db][2] * (1.0f / 128.0f), o[db][3] * (1.0f / 128.0f)); *(v2u*)(op + 16 * db) = ov; }
}

__device__ __forceinline__ size_t zt_off(int b) { return b < 2 ? WS_TB + (size_t)b * 8 * MiB : (b == 2 ? (size_t)502 * MiB : WS_WIN); }
__device__ __forceinline__ void ph_t1(const Ctx& C) {
    const bf16* pxa = WSP(const bf16, WS_PXA); const int lane = C.lane();
    LAS unsigned short* tile = (LAS unsigned short*)(C.lds + C.wave * 9216);
    for (int it = C.gw; it < 4 * 2 * 128 * 4; it += C.NGW) {
        const int kcb = it & 3, n2 = (it >> 2) & 127, pq = (it >> 9) & 1, b = it >> 10;
#pragma unroll
        for (int i = 0; i < 8; ++i) { const int q = i * 64 + lane, n1 = q >> 3, cc = q & 7;
            const v4u v = *(const v4u*)(pxa + ((size_t)b * SEQ + n1 * 128 + n2) * NPXA + pq * 256 + kcb * 64 + cc * 8);
            *(LAS v4u*)(tile + n1 * 72 + cc * 8) = v; }
        LDS_WAIT(); asm volatile("" ::: "memory");
        bf16* zt = WSP(bf16, zt_off(b)) + ((size_t)(pq * 256 + kcb * 64 + lane) * SEQ + n2 * 64);
#pragma unroll
        for (int c = 0; c < 8; ++c) { v4u o;
            o.x = (unsigned)tile[(8 * c + 0) * 72 + lane] | ((unsigned)tile[(8 * c + 1) * 72 + lane] << 16); o.y = (unsigned)tile[(8 * c + 2) * 72 + lane] | ((unsigned)tile[(8 * c + 3) * 72 + lane] << 16);
            o.z = (unsigned)tile[(8 * c + 4) * 72 + lane] | ((unsigned)tile[(8 * c + 5) * 72 + lane] << 16); o.w = (unsigned)tile[(8 * c + 6) * 72 + lane] | ((unsigned)tile[(8 * c + 7) * 72 + lane] << 16);
            *(v4u*)(zt + 8 * c) = o; }
        LDS_WAIT(); asm volatile("" ::: "memory");
    }
}
typedef float f32x16 __attribute__((ext_vector_type(16)));
constexpr int FT_C64 = 0, FT_S64 = 9216, FT_C128 = 18432, FT_S128 = FT_C128 + 34816, FT_TA = FT_S128 + 34816, FT_TR = FT_TA + 4096, FT_ST = FT_TR + 8192;
static_assert(FT_ST + 32768 <= LDSCTL_OFF, "fft lds");
__device__ __forceinline__ void hw_sincos_rev(float rev, float& sn, float& cs) { sn = __builtin_amdgcn_sinf(rev); cs = __builtin_amdgcn_cosf(rev); }
__device__ __forceinline__ int crow16(int r, int h) { return (r & 3) + 8 * (r >> 2) + 4 * h; }
__device__ __forceinline__ void ph_fft(const Ctx& C) {
    LAS unsigned char* lds = C.lds; const int tid = C.tid(), lane = C.lane(), w = C.wave, h = lane >> 5, c = lane & 31;
    const float2* tw = WSP(const float2, WS_TW); bf16* mix = WSP(bf16, WS_HX);
    { LAS unsigned short* c64 = (LAS unsigned short*)(lds + FT_C64); LAS unsigned short* s64 = (LAS unsigned short*)(lds + FT_S64);
#pragma unroll 4
      for (int e = tid; e < 4096; e += NTHR) { const int k1 = e >> 6, n1 = e & 63; float sn, cs; hw_sincos_rev(0.5f * ((float)((n1 * k1) & 63) * (1.0f / 32.0f)), sn, cs); c64[k1 * 72 + n1] = (unsigned short)f2bf(cs); s64[k1 * 72 + n1] = (unsigned short)f2bf(sn); }
      LAS unsigned short* c128 = (LAS unsigned short*)(lds + FT_C128); LAS unsigned short* s128 = (LAS unsigned short*)(lds + FT_S128);
#pragma unroll 4
      for (int e = tid; e < 16384; e += NTHR) { const int k2 = e >> 7, p = e & 127, q = p & 15, n2 = (p & ~15) + (q & 3) + ((q >> 2) & 1) * 8 + ((q >> 3) & 1) * 4;
          float sn, cs; hw_sincos_rev(0.5f * ((float)((n2 * k2) & 127) * (1.0f / 64.0f)), sn, cs); c128[k2 * 136 + p] = (unsigned short)f2bf(cs); s128[k2 * 136 + p] = (unsigned short)f2bf(sn); }
      LAS float* ta = (LAS float*)(lds + FT_TA); LAS float* trt = (LAS float*)(lds + FT_TR);
      { const int e = tid, g = e >> 6, kk = e & 63; float sn, cs; hw_sincos_rev(0.5f * ((float)((32 * (g >> 1) + 4 * (g & 1)) * kk) * (1.0f / 4096.0f)), sn, cs); ta[2 * e] = cs; ta[2 * e + 1] = sn; }
      for (int e = tid; e < 1024; e += NTHR) { const int r = e >> 6, kk = e & 63; float sn, cs; hw_sincos_rev(0.5f * ((float)(crow16(r, 0) * kk) * (1.0f / 4096.0f)), sn, cs); trt[2 * e] = cs; trt[2 * e + 1] = sn; }
    }
    __syncthreads();
    const int vcu = (C.G % 8 == 0) ? (C.bx % 8) * (C.G / 8) + C.bx / 8 : C.bx;
    for (int it = vcu; it < 256; it += C.G) {
        const int kb = it & 1, kcg = (it >> 1) & 31, b = it >> 6, kc = kcg * 8 + w, k1 = 32 * kb + c;
        const bf16* zp = WSP(const bf16, zt_off(b)) + (size_t)kc * SEQ; const bf16* zq = zp + (size_t)256 * SEQ;
        f32x16 acc[4];
#pragma unroll
        for (int rb2 = 0; rb2 < 4; ++rb2) acc[rb2] = (f32x16){};
#pragma unroll 1
        for (int rb = 0; rb < 4; ++rb) {
            const int n2 = 32 * rb + c;
            f32x16 xr = {}, xi = {};
#pragma unroll
            for (int ks = 0; ks < 4; ++ks) {
                const bf16x8_t cf = *(const LAS bf16x8_t*)(lds + FT_C64 + (k1 * 72 + 16 * ks + 8 * h) * 2), sf = *(const LAS bf16x8_t*)(lds + FT_S64 + (k1 * 72 + 16 * ks + 8 * h) * 2);
                const bf16x8_t pf = *(const bf16x8_t*)(zp + n2 * 64 + 16 * ks + 8 * h), qf = *(const bf16x8_t*)(zq + n2 * 64 + 16 * ks + 8 * h);
                const v4u t = __builtin_bit_cast(v4u, qf) ^ 0x80008000u; const bf16x8_t qn = __builtin_bit_cast(bf16x8_t, t);
                xr = __builtin_amdgcn_mfma_f32_32x32x16_bf16(pf, cf, xr, 0, 0, 0); xi = __builtin_amdgcn_mfma_f32_32x32x16_bf16(pf, sf, xi, 0, 0, 0);
                xi = __builtin_amdgcn_mfma_f32_32x32x16_bf16(qf, cf, xi, 0, 0, 0); xr = __builtin_amdgcn_mfma_f32_32x32x16_bf16(qn, sf, xr, 0, 0, 0); }
            bf16x8_t bre[2], bim[2];
            const LAS float* tap = (const LAS float*)(lds + FT_TA) + 2 * ((rb * 2 + h) * 64 + k1); const float ac_ = tap[0], as_ = tap[1];
            const LAS float* trp = (const LAS float*)(lds + FT_TR) + 2 * k1;
#pragma unroll
            for (int sblk = 0; sblk < 2; ++sblk) {
                float tr[8], ti[8];
#pragma unroll
                for (int r8 = 0; r8 < 8; ++r8) { const int r = 8 * sblk + r8; const float rc = trp[128 * r], rs = trp[128 * r + 1]; const float tc = ac_ * rc - as_ * rs, ts = ac_ * rs + as_ * rc;
                    tr[r8] = xr[r] * tc - xi[r] * ts; ti[r8] = -(xr[r] * ts + xi[r] * tc); }
                v4u a, bq;
                a.x = pg8::cvt_pk_bf16(tr[0], tr[1]); a.y = pg8::cvt_pk_bf16(tr[2], tr[3]); a.z = pg8::cvt_pk_bf16(tr[4], tr[5]); a.w = pg8::cvt_pk_bf16(tr[6], tr[7]);
                bq.x = pg8::cvt_pk_bf16(ti[0], ti[1]); bq.y = pg8::cvt_pk_bf16(ti[2], ti[3]); bq.z = pg8::cvt_pk_bf16(ti[4], ti[5]); bq.w = pg8::cvt_pk_bf16(ti[6], ti[7]);
                bre[sblk] = __builtin_bit_cast(bf16x8_t, a); bim[sblk] = __builtin_bit_cast(bf16x8_t, bq); }
#pragma unroll
            for (int rb2 = 0; rb2 < 4; ++rb2) {
                const int k2 = 32 * rb2 + c;
#pragma unroll
                for (int sblk = 0; sblk < 2; ++sblk) {
                    const bf16x8_t ac = *(const LAS bf16x8_t*)(lds + FT_C128 + (k2 * 136 + 32 * rb + 16 * sblk + 8 * h) * 2), as = *(const LAS bf16x8_t*)(lds + FT_S128 + (k2 * 136 + 32 * rb + 16 * sblk + 8 * h) * 2);
                    acc[rb2] = __builtin_amdgcn_mfma_f32_32x32x16_bf16(ac, bre[sblk], acc[rb2], 0, 0, 0); acc[rb2] = __builtin_amdgcn_mfma_f32_32x32x16_bf16(as, bim[sblk], acc[rb2], 0, 0, 0); }
            }
        }
#pragma unroll
        for (int rb2 = 0; rb2 < 4; ++rb2) {
            LAS unsigned short* st = (LAS unsigned short*)(lds + FT_ST + (rb2 & 1) * 16384);
#pragma unroll
            for (int r = 0; r < 16; ++r) st[((crow16(r, h) * 32 + c) * 8) + w] = (unsigned short)f2bf(acc[rb2][r] * 0.001381067932f);
            LDS_WAIT(); __syncthreads();
#pragma unroll
            for (int j = 0; j < 2; ++j) { const int idx = tid + 512 * j, k2l = idx >> 5, k1l = idx & 31;
                const v4u v = *(const LAS v4u*)(st + idx * 8);
                *(v4u*)(mix + ((size_t)b * SEQ + 32 * kb + k1l + 64 * (32 * rb2 + k2l)) * DM + kcg * 8) = v; }
        }
        __syncthreads();
    }
}
__device__ __forceinline__ void ph_attn(const Ctx& C, int l) {
    const bf16* pxa = WSP(const bf16, WS_PXA); bf16* mix = WSP(bf16, WS_HX);
    const float* rb = ARGF(A_RELB) + (size_t)l * 8 * 15 * 31;
    LAS unsigned char* lds = C.lds; LAS float* biasT = (LAS float*)(lds + AT_BT);
    const int lane = C.lane(), w = C.wave, fq = lane >> 4, li = lane & 15, tid = C.tid();
    const int nunits = 2048 + (l == 0 ? 64 : 0);
    const int vcu = (C.G % 8 == 0) ? (C.bx % 8) * (C.G / 8) + C.bx / 8 : C.bx;
    for (int u = vcu; u < nunits; u += C.G) {
        const bool isc = u >= 2048;
        int b, h, rp; if (!isc) { b = u >> 9; h = (u >> 6) & 7; rp = u & 63; } else { const int v = u - 2048; b = v >> 4; h = (v >> 1) & 7; rp = v & 1; }
        __syncthreads();
        for (int e = tid; e < 465; e += NTHR) biasT[e] = rb[h * 465 + e] * 1.4426950408889634f;
        const int R0 = min(max(2 * rp - 4, 0), 120);
        if (!isc) {
            for (int p = w; p < 72; p += 8) {
                const int tokl = p * 8 + (lane >> 3), lr = tokl >> 6, col = tokl & 63, gr = min(R0 + lr, 127), cp = lane & 7;
                const bf16* src = pxa + ((size_t)b * SEQ + gr * 64 + col) * NPXA + h * 64;
                __builtin_amdgcn_global_load_lds((const unsigned*)(src + OFF_K + ((cp ^ ((tokl >> 1) & 7)) * 8)), (LAS unsigned*)(lds + AT_KW + p * 1024), 16, 0, 0);
                __builtin_amdgcn_global_load_lds((const unsigned*)(src + OFF_V + ((cp ^ (((tokl >> 1) & 3) << 1)) * 8)), (LAS unsigned*)(lds + AT_VW + p * 1024), 16, 0, 0);
            }
        }
        int r = 0, qc = 0; size_t token;
        if (!isc) { r = 2 * rp + (w >> 2); qc = 16 * (w & 3) + li; token = (size_t)b * SEQ + r * 64 + qc; }
        else token = (size_t)ML + b * 256 + rp * 128 + 16 * w + li;
        bf16x8_t qf[2];
#pragma unroll
        for (int ks = 0; ks < 2; ++ks) qf[ks] = *(const bf16x8_t*)(pxa + token * NPXA + OFF_QQ + h * 64 + 32 * ks + 8 * fq);
        f32x4 o[4], osum = (f32x4){0.f, 0.f, 0.f, 0.f}; float m = -1e30f;
#pragma unroll
        for (int db = 0; db < 4; ++db) o[db] = (f32x4){0.f, 0.f, 0.f, 0.f};
        int ka[2][2], va[2][4], dcs[4] = {0, 0, 0, 0};
        asm volatile("s_waitcnt vmcnt(0)" ::: "memory");
        __syncthreads();
        if (!isc) {
            const int cb = w & 3, kc0 = cb == 0 ? 0 : cb == 1 ? 8 : cb == 2 ? 24 : 32;
            attn_addr(kc0, li, fq, ka, va);
            const int csq = min(max(qc - 8, 0), 48); unsigned vmask = 0u;
#pragma unroll
            for (int i = 0; i < 4; ++i) { const int kc_ = kc0 + 4 * fq + i; const bool in0 = kc_ >= csq && kc_ < csq + 16; if (in0) vmask |= 1u << i; dcs[i] = min(max((in0 ? kc_ : kc_ + 16) - qc + 15, 0), 30); }
            const int rsr = min(max(r - 4, 0), 120), lr0 = rsr - R0;
            attn_block<true>(lds, ka, va, lr0 * 8192, qf, biasT + (rsr - r + 7) * 31, dcs, vmask, o, osum, m);
        }
        __syncthreads();
        for (int p = w; p < 32; p += 8) {
            const int tokl = p * 8 + (lane >> 3), cp = lane & 7;
            const bf16* src = pxa + ((size_t)ML + b * 256 + tokl) * NPXA + h * 64;
            __builtin_amdgcn_global_load_lds((const unsigned*)(src + OFF_K + ((cp ^ ((tokl >> 1) & 7)) * 8)), (LAS unsigned*)(lds + AT_KW + p * 1024), 16, 0, 0);
            __builtin_amdgcn_global_load_lds((const unsigned*)(src + OFF_V + ((cp ^ (((tokl >> 1) & 3) << 1)) * 8)), (LAS unsigned*)(lds + AT_VW + p * 1024), 16, 0, 0);
        }
        attn_addr(0, li, fq, ka, va);
        asm volatile("s_waitcnt vmcnt(0)" ::: "memory");
        __syncthreads();
        attn_block<false>(lds, ka, va, 0, qf, (const LAS float*)nullptr, dcs, 0xfu, o, osum, m);
        const float inv = __builtin_amdgcn_rcpf(osum[0]);
        bf16* op = mix + token * DM + 512 + h * 64 + 4 * fq;
#pragma unroll
        for (int db = 0; db < 4; ++db) { v2u ov; ov.x = pk2(o[db][0] * inv, o[db][1] * inv); ov.y = pk2(o[db][2] * inv, o[db][3] * inv); *(v2u*)(op + 16 * db) = ov; }
    }
}

template <int KS>
__device__ __forceinline__ void wg_core(const bf16* A, const bf16* W, int li, int fq, f32x4 (&acc)[4][2]) {
    const bf16* ap = A + (size_t)li * DM + 8 * fq; const bf16* wp = W + (size_t)li * DM + 8 * fq;
    bf16x8_t af[4][4], wf[4][2];
#pragma unroll
    for (int s = 0; s < 3; ++s) {
#pragma unroll
        for (int m = 0; m < 4; ++m) af[s][m] = *(const bf16x8_t*)(ap + (size_t)(16 * m) * DM + 32 * s);
#pragma unroll
        for (int n = 0; n < 2; ++n) wf[s][n] = *(const bf16x8_t*)(wp + (size_t)(16 * n) * DM + 32 * s); }
#pragma unroll
    for (int s = 0; s < KS; ++s) {
        if (s + 3 < KS) {
#pragma unroll
            for (int m = 0; m < 4; ++m) af[(s + 3) & 3][m] = *(const bf16x8_t*)(ap + (size_t)(16 * m) * DM + 32 * (s + 3));
#pragma unroll
            for (int n = 0; n < 2; ++n) wf[(s + 3) & 3][n] = *(const bf16x8_t*)(wp + (size_t)(16 * n) * DM + 32 * (s + 3)); }
#pragma unroll
        for (int m = 0; m < 4; ++m)
#pragma unroll
            for (int n = 0; n < 2; ++n) acc[m][n] = __builtin_amdgcn_mfma_f32_16x16x32_bf16(wf[s & 3][n], af[s & 3][m], acc[m][n], 0, 0, 0);
    }
}
__device__ __forceinline__ void wg_merge_ctx(const Ctx& C) {
    if (C.wave >= 2) return;
    const bf16* mix = WSP(const bf16, WS_HX); const bf16* wm = WSP(const bf16, WS_WM); const bf16* pxg = WSP(const bf16, WS_PXG); bf16* mb = WSP(bf16, WS_M);
    const int lane = C.lane(), li = lane & 15, fq = lane >> 4;
    for (int it = C.wave * C.G + C.bx; it < 512; it += 2 * C.G) {
        const int r0 = ML + 64 * (it >> 5), c0 = 32 * (it & 31);
        f32x4 a0[4][2], a1[4][2], a2[4][2];
#pragma unroll
        for (int m = 0; m < 4; ++m)
#pragma unroll
            for (int n = 0; n < 2; ++n) { a0[m][n] = (f32x4){0.f, 0.f, 0.f, 0.f}; a1[m][n] = a0[m][n]; a2[m][n] = a0[m][n]; }
        const bf16* A = mix + (size_t)r0 * DM; const bf16* W = wm + (size_t)c0 * DM;
        wg_core<8>(A, W, li, fq, a0); wg_core<8>(A + 256, W + 256, li, fq, a1); wg_core<16>(A + 512, W + 512, li, fq, a2);
#pragma unroll
        for (int m = 0; m < 4; ++m)
#pragma unroll
            for (int n = 0; n < 2; ++n) { const size_t row = (size_t)(r0 + 16 * m + li); const int col = c0 + 16 * n + 4 * fq;
                const v2u g0 = *(const v2u*)(pxg + gate_elem(0, (int)row, col)), g1 = *(const v2u*)(pxg + gate_elem(1, (int)row, col)), g2 = *(const v2u*)(pxg + gate_elem(2, (int)row, col));
#define RL(x) __builtin_amdgcn_rcpf(bflo(x))
#define RH(x) __builtin_amdgcn_rcpf(bfhi(x))
                const float o0 = a0[m][n][0] * RL(g0.x) + a1[m][n][0] * RL(g1.x) + a2[m][n][0] * RL(g2.x), o1 = a0[m][n][1] * RH(g0.x) + a1[m][n][1] * RH(g1.x) + a2[m][n][1] * RH(g2.x);
                const float o2 = a0[m][n][2] * RL(g0.y) + a1[m][n][2] * RL(g1.y) + a2[m][n][2] * RL(g2.y), o3 = a0[m][n][3] * RH(g0.y) + a1[m][n][3] * RH(g1.y) + a2[m][n][3] * RH(g2.y);
#undef RL
#undef RH
                v2u w; w.x = cvt_pk_bf16(o0, o1); w.y = cvt_pk_bf16(o2, o3); *(v2u*)(mb + row * DM + col) = w; }
    }
}
__device__ __forceinline__ void wg_wo_ctx(const Ctx& C) {
    if (C.wave >= 2) return;
    const bf16* mb = WSP(const bf16, WS_M); const bf16* wo = WSP(const bf16, WS_WO); const float* base = ARGF(A_CTX); float* out = WSP(float, WS_CTXX);
    const float* gate = WSP(const float, WS_MOD) + 4 * NMOD + 2 * DM; const float* gn = WSP(const float, WS_GN) + (size_t)(1 * 5 + 4) * DM; bf16* ap = WSP(bf16, WS_HX); u64* rs = WSP(u64, WS_RS) + (size_t)1 * MT;
    const int lane = C.lane(), li = lane & 15, fq = lane >> 4;
    for (int it = C.wave * C.G + C.bx; it < 512; it += 2 * C.G) {
        const int r0 = 64 * (it >> 5), c0 = 32 * (it & 31);
        f32x4 acc[4][2];
#pragma unroll
        for (int m = 0; m < 4; ++m)
#pragma unroll
            for (int n = 0; n < 2; ++n) acc[m][n] = (f32x4){0.f, 0.f, 0.f, 0.f};
        wg_core<32>(mb + (size_t)(ML + r0) * DM, wo + (size_t)c0 * DM, li, fq, acc);
#pragma unroll
        for (int m = 0; m < 4; ++m) { const size_t rc = (size_t)(r0 + 16 * m + li); float ss = 0.f;
#pragma unroll
            for (int n = 0; n < 2; ++n) { const int col = c0 + 16 * n + 4 * fq;
                const f32x4 o = *(const f32x4*)(base + rc * DM + col) + *(const f32x4*)(gate + col) * acc[m][n];
                *(f32x4*)(out + rc * DM + col) = o;
                const f32x4 y = o * *(const f32x4*)(gn + col); v2u w; w.x = cvt_pk_bf16(y[0], y[1]); w.y = cvt_pk_bf16(y[2], y[3]); *(v2u*)(ap + (ML + rc) * DM + col) = w;
                ss += (o[0] * o[0] + o[1] * o[1]) + (o[2] * o[2] + o[3] * o[3]); }
            ss += __shfl_xor(ss, 16); ss += __shfl_xor(ss, 32);
            if (fq == 0) __hip_atomic_fetch_add(rs + ML + rc, (u64)(ss * 16777216.0f + 0.5f), __ATOMIC_RELAXED, __HIP_MEMORY_SCOPE_AGENT); }
    }
}
__device__ __forceinline__ void ph_final(const Ctx& C) {
    float* out = (float*)(GAS float*)ldarg(C, A_OUT); const float* fg = ARGF(A_FG); const int lane = C.lane();
    for (int row = C.gw; row < ML; row += C.NGW) {
        float* xr = out + (size_t)row * DM;
        f32x4 v[4]; float s2 = 0.f;
#pragma unroll
        for (int j = 0; j < 4; ++j) { v[j] = *(const f32x4*)(xr + 4 * lane + 256 * j); s2 += (v[j].x * v[j].x + v[j].y * v[j].y) + (v[j].z * v[j].z + v[j].w * v[j].w); }
        const float rstd = 1.0f / sqrtf(wave_sum(s2) * (1.0f / DM) + EPS);
#pragma unroll
        for (int j = 0; j < 4; ++j) { const int c0 = 4 * lane + 256 * j; const f32x4 gg = *(const f32x4*)(fg + c0); *(f32x4*)(xr + c0) = v[j] * rstd * gg; }
    }
}

struct Args { const void* p[A_NARGS]; int ph_lo, ph_hi; };

__global__ void __launch_bounds__(NTHR, 2) fwd_kernel(Args args) {
    extern __shared__ __attribute__((aligned(16))) unsigned char lds_raw[];
    LAS unsigned char* const lds0 = (LAS unsigned char*)lds_raw;
    const int wave0 = __builtin_amdgcn_readfirstlane(threadIdx.x >> 6);
    { const int t0 = threadIdx.x;
      for (int u = t0; u < (LDS_BYTES - LDSCTL_OFF) / 4; u += NTHR) ((LAS unsigned*)(lds0 + LDSCTL_OFF))[u] = 0u;
      __syncthreads();
      if (t0 < A_NARGS) ((LAS unsigned long long*)(lds0 + LARGS_OFF))[t0] = (unsigned long long)args.p[t0];
      __syncthreads(); }
    const int lo = args.ph_lo, hi = args.ph_hi;
    const unsigned xcc = xb_xcc_id();
    int vbx = blockIdx.x;
    if (!MK_MULTI) { Ctx C; C.lds = lds0; C.wave = wave0; gu32* ctl0 = (gu32*)WSP(unsigned, WS_CTL); (void)xcd_barrier_post((unsigned*)(ctl0 + CW_BAR), (volatile LAS unsigned*)(lds0 + MISC_OFF) + 8, C.tid() == 0); }
    for (int step = lo; step < hi; ++step) {
        const int ls = step - 2, l = ls >= NS ? 1 : 0, k = (step < 2) ? -1 - step : ls - l * NS;
        const int nrep = (PROBE_K != -99 && k == PROBE_K) ? PROBE_N : 1;
        for (int rep = 0; rep < nrep; ++rep) {
        Ctx C;
        C.lds = lds0; C.wave = wave0; C.G = gridDim.x; C.bx = vbx;
        asm volatile("" : "+s"(C.wave), "+s"(C.bx), "+s"(C.G));
        C.gw = C.bx * NWAVES + C.wave; C.NGW = C.G * NWAVES; C.NGT = C.G * NTHR;
        gu32* ctl = (gu32*)WSP(unsigned, WS_CTL);
        if (k == -1) { ph_mod_partial(C); __syncthreads(); ph_weights(C, 0); }
        else if (k == -2) ph_mod_reduce(C);
        else if (k == 0) {
            if (l == 1) ph_weights(C, l);
            ph_ctab(C, l);
            u64* rsb = WSP(u64, WS_RS) + (size_t)(l == 0 ? 0 : 2) * MT;
            if (l == 0) ph_prenorm(C, ARGF(A_X), ARGF(A_CTX), WSP(const float, WS_GN), WSP(bf16, WS_HX), rsb, 0, MT, (const float*)nullptr, (const float*)nullptr);
            else ph_prenorm(C, ARGF(A_OUT), WSP(const float, WS_CTXX), WSP(const float, WS_GN) + 2 * 5 * DM, WSP(bf16, WS_HX), rsb, ML, MT, WSP(const float, WS_PART), WSP(const float, WS_MOD) + 4 * NMOD + 5 * DM);
        } else if (k == 1) {
            pg8::Prob<false> P{WSP(const bf16, WS_HX), WSP(const bf16, WS_WIN), DM, DM, DM}; pg8::StaticOrder<NIN / 256> S; S.init(MT, NIN, C.G, C.bx);
            EpiIn E{WSP(bf16, WS_PXA), WSP(bf16, WS_PXG), WSP(const u64, WS_RS) + (size_t)(l == 0 ? 0 : 2) * MT, WSP(const float, WS_CIN) + (size_t)l * 5 * NIN};
            pg8::gemm_phase(C.lds, P, S, E, C.tid());
        } else if (k == 2) {
            const int sub = rep == 0 ? 7 : PROBE_SUB;
            if (sub & 1) ph_t1(C);
            if (sub & 2) { if (l == 0) ph_ctx_dft(C); ph_mixers(C, l); }
            if (sub & 4) ph_attn(C, l);
        } else if (k == 3) {
            ph_fft(C);
        } else if (k == 4) {
            pg8::Prob<false> P{WSP(const bf16, WS_HX), WSP(const bf16, WS_WM), DM, DM, DM}; pg8::StaticOrder<DM / 256> S; S.init(ML, DM, C.G, C.bx);
            EpiMerge E{WSP(bf16, WS_M), WSP(const bf16, WS_PXG)};
            pg8::gemm_phase(C.lds, P, S, E, C.tid());
            if (l == 0) wg_merge_ctx(C);
        } else if (k == 5) {
            pg8::Prob<false> P{WSP(const bf16, WS_M), WSP(const bf16, WS_WO), DM, DM, DM}; pg8::StaticOrder<DM / 256> S; S.init(ML, DM, C.G, C.bx);
            const float* gatev = rep > 0 ? WSP(const float, WS_ZERO) : WSP(const float, WS_MOD) + (size_t)l * 5 * NMOD + 2 * DM;
            const float* gnp = WSP(const float, WS_GN) + (size_t)(l * 2 + 1) * 5 * DM; u64* rsp = WSP(u64, WS_RS) + (size_t)(l == 0 ? 1 : 3) * MT;
            if (l == 0) { EpiRes<false> E{(const void*)ARGF(A_X), (bf16*)(GAS bf16*)ldarg(C, A_OUT), gatev, nullptr, gnp, WSP(bf16, WS_HX), rsp}; pg8::gemm_phase(C.lds, P, S, E, C.tid()); }
            else { EpiRes<true> E{(const void*)(const bf16*)(GAS bf16*)ldarg(C, A_OUT), WSP(bf16, WS_STREAM1), gatev, nullptr, gnp, WSP(bf16, WS_HX), rsp}; pg8::gemm_phase(C.lds, P, S, E, C.tid()); }
            if (l == 0 && rep == 0) wg_wo_ctx(C);
        } else if (k == 6) {
            pg8::Prob<false> P{WSP(const bf16, WS_HX), WSP(const bf16, WS_W1), DM, DM, DM}; pg8::StaticOrder<FF / 256> S; S.init(l == 0 ? MT : ML, FF, C.G, C.bx);
            EpiAct E{WSP(bf16, WS_ACT), WSP(const u64, WS_RS) + (size_t)(l == 0 ? 1 : 3) * MT, WSP(const float, WS_CUP) + (size_t)l * 5 * FF};
            pg8::gemm_phase(C.lds, P, S, E, C.tid());
        } else if (k == 7) {
            if (l == 0) {
                pg8::ProbDown P{WSP(const bf16, WS_ACT), WSP(const bf16, WS_W2), FF, FF, FF}; pg8::DownOrder S; S.init(C.G, C.bx);
                EpiRes<true> E{(const void*)(const bf16*)(GAS bf16*)ldarg(C, A_OUT), (bf16*)(GAS bf16*)ldarg(C, A_OUT), WSP(const float, WS_MOD) + (size_t)l * 5 * NMOD + 5 * DM, WSP(float, WS_PART),
                         WSP(const float, WS_GN) + (size_t)2 * 5 * DM, WSP(bf16, WS_HX), WSP(u64, WS_RS) + (size_t)2 * MT};
                pg8::gemm_phase(C.lds, P, S, E, C.tid());
            } else {
                pg8::Prob<false> P{WSP(const bf16, WS_ACT), WSP(const bf16, WS_W2), FF, FF, FF}; pg8::StaticOrder<DM / 256> S; S.init(ML, DM, C.G, C.bx);
                EpiResFinal E{WSP(const bf16, WS_STREAM1), (float*)(GAS float*)ldarg(C, A_OUT), WSP(const float, WS_MOD) + (size_t)l * 5 * NMOD + 5 * DM, ARGF(A_FG), WSP(u64, WS_RS5), WSP(unsigned, WS_FCNT), (unsigned*)WSP(unsigned, WS_CTL) + CW_TMO};
                pg8::gemm_phase(C.lds, P, S, E, C.tid());
            }
        } else ph_final(C);
        if (step + 1 < hi || rep + 1 < nrep) { if (MK_MULTI) { if (C.tid() == 0) __hip_atomic_store(ctl + CW_TMO, 0xBADu, RLX_AGENT); } else { XcdBarrier bar; bar.bar = (unsigned*)(ctl + CW_BAR); bar.x = xcc; bar.st = (volatile LAS unsigned*)(lds0 + MISC_OFF) + 8; xcd_barrier(bar, C.tid() == 0);
                if (step == lo && rep == 0) {
                    volatile LAS unsigned* misc = (volatile LAS unsigned*)(lds0 + MISC_OFF);
                    if (C.tid() == 0) { bool ok = gridDim.x == 256;
                        for (unsigned j = 0; j < 16; ++j) { const unsigned cnt = xb_ld(bar.bar + XB_XCNT(j)); ok = ok && (cnt == (j < 8 ? 32u : 0u)); }
                        misc[11] = ok ? 1u : 0u; }
                    __syncthreads();
                    const unsigned okf = __builtin_amdgcn_readfirstlane(misc[11]), rk = __builtin_amdgcn_readfirstlane(misc[10]);
                    if (okf != 0u && rk < 32u && xcc < 8u) vbx = (int)(rk * 8u + xcc); } } }
        }
    }
}

extern "C" void kernel_launch(void* const* d_in, const int* in_sizes, int n_in, void* d_out, int out_size, void* d_ws, size_t ws_size, hipStream_t stream) {
    static int grid = 0;
    if (grid == 0) {
        if (n_in != 18 || out_size != ML * DM || ws_size < WS_END) { fprintf(stderr, "kernel_launch: unexpected shapes (n_in %d out %d ws %zu)\n", n_in, out_size, ws_size); grid = -1; return; }
        int dev = 0, cus = 0;
        if (hipGetDevice(&dev) != hipSuccess || hipDeviceGetAttribute(&cus, hipDeviceAttributeMultiprocessorCount, dev) != hipSuccess) { grid = -1; return; }
        if (hipFuncSetAttribute((const void*)fwd_kernel, hipFuncAttributeMaxDynamicSharedMemorySize, LDS_BYTES) != hipSuccess) { fprintf(stderr, "kernel_launch: hipFuncSetAttribute failed\n"); grid = -1; return; }
        int per_cu = 0;
        if (hipOccupancyMaxActiveBlocksPerMultiprocessor(&per_cu, (const void*)fwd_kernel, NTHR, LDS_BYTES) != hipSuccess || per_cu < 1) fprintf(stderr, "kernel_launch: occupancy query reports %d\n", per_cu);
        (void)hipGetLastError();
        grid = cus;
    }
    if (grid < 0) return;
    (void)hipMemsetAsync((char*)d_ws + WS_CTL, 0, CTL_ZERO_BYTES, stream);
    Args a{};
    for (int i = 0; i < 18; ++i) a.p[i] = d_in[i];
    a.p[A_OUT] = d_out; a.p[A_WS] = d_ws;
#if MK_MULTI
    for (int s = 0; s < NSTEPS; ++s) { a.ph_lo = s; a.ph_hi = s + 1; hipLaunchKernelGGL(fwd_kernel, dim3(grid), dim3(NTHR), LDS_BYTES, stream, a); }
#else
    a.ph_lo = 0; a.ph_hi = NSTEPS; hipLaunchKernelGGL(fwd_kernel, dim3(grid), dim3(NTHR), LDS_BYTES, stream, a);
#endif
}
```

```cpp
#include <hip/hip_runtime.h>
#include <cstdio>
#include <cstdint>

#ifndef PROBE_K
#define PROBE_K -99
#define PROBE_N 1
#define PROBE_SUB 7
#endif
#ifndef MK_MULTI
#define MK_MULTI 0
#endif

namespace pg8 {
#define PG8_LAS __attribute__((address_space(3)))
typedef unsigned short bf16_t;
typedef short bf16x8 __attribute__((ext_vector_type(8)));
typedef float f32x4 __attribute__((ext_vector_type(4)));
typedef unsigned u32x4 __attribute__((ext_vector_type(4)));
constexpr int BM = 256, BK = 64, HALF = 128, HTB = HALF * BK * 2, STAGE_BYTES = 8 * HTB, NXCD = 8, WGM = 8;

__host__ __device__ __forceinline__ int lds_byte(int r, int c) { const int st = (r >> 4) * 2 + (c >> 5), rr = r & 15, cc = c & 31, ob = rr * 64 + cc * 2; return st * 1024 + (ob ^ (((ob >> 9) & 1) << 5)); }
__host__ __device__ __forceinline__ void stage_rc(int b, int& R, int& C) { const int st = b / 1024, sb = b % 1024, swz = sb ^ (((sb >> 9) & 1) << 5); R = (st >> 1) * 16 + swz / 64; C = (st & 1) * 32 + (swz % 64) / 2; }
__host__ __device__ __forceinline__ int perm32(int rho) { const int n = rho >> 4, i = rho & 15; return 8 * (i >> 2) + 4 * n + (i & 3); }

struct Unit { int pm, pn, br; };

template <int NN  > struct StaticOrder {
    int nM, nwg, G, c;
    __device__ void init(int M, int  , int G_, int c_) { nM = M / BM; nwg = nM * NN; G = G_; c = c_; }
    __device__ __forceinline__ bool next(int i, Unit& u) const {
        u.br = 0;
        const long L = (long)i * G + c; if (L >= nwg) return false;
        int wgid = (int)L; { const int q = nwg >> 3, r = nwg & 7, xcd = wgid & 7, off = wgid >> 3; wgid = (xcd < r ? xcd * (q + 1) : r * (q + 1) + (xcd - r) * q) + off; }
        constexpr int nig = WGM * NN; const int gid = wgid / nig, rem = wgid - gid * nig, fm = gid * WGM, gsz = (nM - fm) < WGM ? (nM - fm) : WGM;
        if (gsz == WGM) { u.pm = fm + (rem & (WGM - 1)); u.pn = rem >> 3; } else { u.pm = fm + (rem % gsz); u.pn = rem / gsz; }
        return true;
    }
};

struct DownOrder {
    StaticOrder<4> lat; int G, c;
    __device__ void init(int G_, int c_) { lat.init(32768, 1024, G_, c_); G = G_; c = c_; }
    __device__ __forceinline__ bool next(int i, Unit& u) const {
        const long L = (long)i * G + c;
        if (L < 512) return lat.next(i, u);
        const int j = (int)L - 512; if (j >= 64) return false;
        const int ct = j >> 2; u.pm = 128 + (ct >> 2); u.pn = ct & 3; u.br = j & 3; return true;
    }
};
struct ProbDown {
    const bf16_t* A; const bf16_t* Bt; int lda, ldb, K;
    __device__ __forceinline__ int nt(const Unit& u) const { return u.pm >= 128 ? 16 : 64; }
    __device__ __forceinline__ int koff(const Unit& u) const { return u.pm >= 128 ? u.br * 1024 : 0; }
    __device__ __forceinline__ const char* a(const Unit& u) const { return (const char*)(A + (size_t)u.pm * BM * lda + koff(u)); }
    __device__ __forceinline__ const char* b(const Unit& u) const { return (const char*)(Bt + (size_t)u.pn * BM * ldb + koff(u)); }
};
template <bool MERGE> struct Prob {
    const bf16_t* A; const bf16_t* Bt; int lda, ldb, K;
    __device__ __forceinline__ int nt(const Unit& u) const { if (MERGE) return u.br == 2 ? 8 : 4; return K / BK; }
    __device__ __forceinline__ int koff(const Unit& u) const { if (MERGE) return u.br * 256; return 0; }
    __device__ __forceinline__ const char* a(const Unit& u) const { return (const char*)(A + (size_t)u.pm * BM * lda + koff(u)); }
    __device__ __forceinline__ const char* b(const Unit& u) const { return (const char*)(Bt + (size_t)u.pn * BM * ldb + koff(u)); }
};

typedef __bf16 bf16x2_cv __attribute__((ext_vector_type(2)));
typedef float f32x2_cv __attribute__((ext_vector_type(2)));
__device__ __forceinline__ unsigned cvt_pk_bf16(float lo, float hi) { const f32x2_cv v = {lo, hi}; const bf16x2_cv r = __builtin_convertvector(v, bf16x2_cv); return __builtin_bit_cast(unsigned, r); }

template <class Epi, class Sched, class PROB>
__device__ __forceinline__ void gemm_phase(PG8_LAS unsigned char* lds, const PROB P, const Sched& S, const Epi& E, const int tid) {
    const int wid = __builtin_amdgcn_readfirstlane(tid >> 6), lane = tid & 63, wr = wid >> 2, wc = wid & 3, fr = lane & 15, fq = lane >> 4;
    unsigned voffA[2], voffB[2];
#pragma unroll
    for (int i = 0; i < 2; ++i) { int R, C; stage_rc(tid * 16 + i * 8192, R, C); const int Rb = Epi::PERM ? ((R & ~31) + perm32(R & 31)) : R;
        voffA[i] = (unsigned)(R * P.lda + C) * 2u; voffB[i] = (unsigned)(Rb * P.ldb + C) * 2u; }
    const size_t kstep = (size_t)(BK * 2);
    const size_t hstepA = (size_t)HALF * P.lda * 2, hstepB = (size_t)HALF * P.ldb * 2;
    const unsigned ldsw = (unsigned)wid * 1024u;
    const int aoff = lds_byte(wr * 64 + fr, fq * 8), boff = lds_byte(wc * 32 + fr, fq * 8);
#define PG8_SA(b, h) (((b) * 2 + (h)) * HTB)
#define PG8_SB(b, h) ((4 + (b) * 2 + (h)) * HTB)
#define PG8_STAGE(bufoff, gbase, voff) do { _Pragma("unroll") for (int _i = 0; _i < 2; ++_i) \
        __builtin_amdgcn_global_load_lds((const unsigned*)((const char*)(gbase) + (voff)[_i]), (PG8_LAS unsigned*)(lds + (bufoff) + ldsw + _i * 8192), 16, 0, 0); } while (0)
#define PG8_LDA(dst, b, h) do { _Pragma("unroll") for (int m = 0; m < 4; ++m) _Pragma("unroll") for (int k = 0; k < 2; ++k) dst[m][k] = *(const PG8_LAS bf16x8*)(lds + PG8_SA(b, h) + aoff + m * 2048 + k * 1024); } while (0)
#define PG8_LDB(dst, b, h) do { _Pragma("unroll") for (int n = 0; n < 2; ++n) _Pragma("unroll") for (int k = 0; k < 2; ++k) dst[n][k] = *(const PG8_LAS bf16x8*)(lds + PG8_SB(b, h) + boff + n * 2048 + k * 1024); } while (0)
#define PG8_MMA(ai, bj, At, Bt) do { __builtin_amdgcn_s_setprio(1); _Pragma("unroll") for (int m = 0; m < 4; ++m) _Pragma("unroll") for (int n = 0; n < 2; ++n) _Pragma("unroll") for (int k = 0; k < 2; ++k) \
        acc[ai][bj][m][n] = __builtin_amdgcn_mfma_f32_16x16x32_bf16(Bt[n][k], At[m][k], acc[ai][bj][m][n], 0, 0, 0); __builtin_amdgcn_s_setprio(0); } while (0)
#define PG8_WAIT_V(n) asm volatile("s_waitcnt vmcnt(" #n ")" ::: "memory")
#define PG8_WAIT_L(n) asm volatile("s_waitcnt lgkmcnt(" #n ")" ::: "memory")
#define PG8_BAR __builtin_amdgcn_s_barrier()
#define PG8_WAIT_SEL1(N) asm volatile("s_waitcnt vmcnt(" #N ")\n\tv_cmp_ne_u32_e32 vcc, 0, %0\n\ts_cbranch_vccnz .Lpg8w%=\n\ts_waitcnt vmcnt(8)\n.Lpg8w%=:" :: "v"(fst) : "memory", "vcc")
#define PG8_WAIT_SEL(NF16, NF32) do { if (Epi::NST == 16) PG8_WAIT_SEL1(NF16); else PG8_WAIT_SEL1(NF32); } while (0)
#define PG8_SCHED __builtin_amdgcn_sched_barrier(0)
    Unit cur, nxt; int ui = 0;
    if (!S.next(0, cur)) return;
    f32x4 acc[2][2][4][2];
#pragma unroll
    for (int a = 0; a < 2; ++a)
#pragma unroll
        for (int b = 0; b < 2; ++b)
#pragma unroll
            for (int m = 0; m < 4; ++m)
#pragma unroll
                for (int n = 0; n < 2; ++n) acc[a][b][m][n] = (f32x4){0.f, 0.f, 0.f, 0.f};
    bf16x8 At[4][2], B0[2][2], B1[2][2];
    const char* cA = P.a(cur); const char* cB = P.b(cur);
    PG8_STAGE(PG8_SB(0, 0), cB, voffB); PG8_STAGE(PG8_SB(0, 1), cB + hstepB, voffB); PG8_STAGE(PG8_SA(0, 0), cA, voffA); PG8_STAGE(PG8_SA(0, 1), cA + hstepA, voffA);
    if (wr == 1) PG8_BAR;
    PG8_WAIT_V(2); PG8_BAR;
    PG8_STAGE(PG8_SB(1, 0), cB + kstep, voffB); PG8_STAGE(PG8_SA(1, 0), cA + kstep, voffA); PG8_STAGE(PG8_SB(1, 1), cB + hstepB + kstep, voffB);
    PG8_WAIT_V(6); PG8_BAR;
    for (;;) {
        const bool has_next = S.next(ui + 1, nxt);
        const char* nA = has_next ? P.a(nxt) : cA; const char* nB = has_next ? P.b(nxt) : cB;
        const int nt = P.nt(cur);
        for (int t = 0; t < nt; t += 2) {
            const bool last = (t == nt - 2); const int fst = (t == 0 && ui > 0) ? 1 : 0;
            if constexpr (Epi::HOOKS) { if (t == 4 || t == 8) E.hook(acc, cur, t, wr, wc, fr, fq); }
            const char* a1 = cA + (size_t)(t + 1) * kstep;
            const char* a2 = last ? nA : cA + (size_t)(t + 2) * kstep; const char* b2 = last ? nB : cB + (size_t)(t + 2) * kstep;
            const char* a3 = a2 + kstep; const char* b3 = b2 + kstep;
            PG8_LDB(B0, 0, 0); PG8_LDB(B1, 0, 1); PG8_SCHED; PG8_LDA(At, 0, 0); PG8_STAGE(PG8_SA(1, 1), a1 + hstepA, voffA);
            PG8_WAIT_SEL(18, 34); PG8_WAIT_L(0); PG8_BAR; PG8_MMA(0, 0, At, B0); PG8_MMA(0, 1, At, B1); PG8_BAR; PG8_SCHED;
            PG8_LDA(At, 0, 1); PG8_STAGE(PG8_SB(0, 0), b2, voffB); PG8_STAGE(PG8_SB(0, 1), b2 + hstepB, voffB); PG8_STAGE(PG8_SA(0, 0), a2, voffA);
            PG8_WAIT_SEL(24, 40); PG8_WAIT_L(0); PG8_BAR; PG8_MMA(1, 0, At, B0); PG8_MMA(1, 1, At, B1); PG8_BAR; PG8_SCHED;
            PG8_LDB(B0, 1, 0); PG8_LDB(B1, 1, 1); PG8_SCHED; PG8_LDA(At, 1, 0); PG8_STAGE(PG8_SA(0, 1), a2 + hstepA, voffA);
            PG8_WAIT_SEL(26, 42); PG8_WAIT_L(0); PG8_BAR; PG8_MMA(0, 0, At, B0); PG8_MMA(0, 1, At, B1); PG8_BAR; PG8_SCHED;
            PG8_LDA(At, 1, 1); PG8_STAGE(PG8_SB(1, 0), b3, voffB); PG8_STAGE(PG8_SB(1, 1), b3 + hstepB, voffB); PG8_STAGE(PG8_SA(1, 0), a3, voffA);
            PG8_WAIT_V(8); PG8_WAIT_L(0); PG8_BAR; PG8_MMA(1, 0, At, B0); PG8_MMA(1, 1, At, B1); PG8_BAR; PG8_SCHED;
        }
        if (wr == 0) PG8_BAR;
        E(acc, cur, wr, wc, fr, fq);
        if (!has_next) break;
#pragma unroll
        for (int a = 0; a < 2; ++a)
#pragma unroll
            for (int b = 0; b < 2; ++b)
#pragma unroll
                for (int m = 0; m < 4; ++m)
#pragma unroll
                    for (int n = 0; n < 2; ++n) acc[a][b][m][n] = (f32x4){0.f, 0.f, 0.f, 0.f};
        cur = nxt; cA = nA; cB = nB; ++ui;
        if (wr == 1) PG8_BAR;
    }
    PG8_WAIT_V(0);
    PG8_BAR;
#undef PG8_SA
#undef PG8_SB
#undef PG8_STAGE
#undef PG8_LDA
#undef PG8_LDB
#undef PG8_MMA
#undef PG8_WAIT_V
#undef PG8_WAIT_L
#undef PG8_BAR
#undef PG8_WAIT_SEL
#undef PG8_WAIT_SEL1
#undef PG8_SCHED
}
}

constexpr int NWAVES = 8, NTHR = 512;
constexpr int DM = 1024, NB = 4, SEQ = 8192, ML = NB * SEQ, CTXL = 256, MC = NB * CTXL, MT = ML + MC;
constexpr int NIN_ORIG = 5632, NPXA = 2816, NPXG = 3072, NIN = NPXA + NPXG;
constexpr int OFF_P = 0, OFF_Q = 256, OFF_CU = 512, OFF_CB = 768, OFF_CC = 1024, OFF_QQ = 1280, OFF_K = 1792, OFF_V = 2304;
constexpr int FF = 4096, NMOD = 6 * DM, NGRP = 5;
constexpr float EPS = 1e-6f;

constexpr size_t MiB = 1u << 20;
constexpr size_t WS_CTL = 0, CTL_ZERO_BYTES = 2 * MiB;
constexpr size_t WS_RS = 262144;
constexpr size_t WS_FCNT = 1441792;
constexpr size_t WS_ZERO = 1572864;
constexpr size_t WS_RS5 = 1703936;
constexpr size_t WS_TW = 2 * MiB;
constexpr size_t WS_MOD = 2 * MiB + 65536;
constexpr size_t WS_GN = 2 * MiB + 524288;
constexpr size_t WS_CIN = 2 * MiB + 786432;
constexpr size_t WS_CUP = 3 * MiB;
constexpr size_t WS_MODP = 510 * MiB;
constexpr size_t WS_CTXX = 4 * MiB;
constexpr size_t WS_WIN = 8 * MiB, WS_WM = 20 * MiB, WS_WO = 22 * MiB, WS_W1 = 24 * MiB, WS_W2 = 32 * MiB;
constexpr size_t WS_HX = 40 * MiB;
constexpr size_t WS_PXA = 106 * MiB;
constexpr size_t WS_PXG = 288 * MiB;
constexpr size_t WS_TB = 486 * MiB;
constexpr size_t WS_M = WS_PXA;
constexpr size_t WS_ACT = WS_PXA;
constexpr size_t WS_PART = 400 * MiB;
constexpr size_t WS_STREAM1 = 416 * MiB;
constexpr size_t WS_END = 512 * MiB;
static_assert(WS_PXA + (size_t)MT * NPXA * 2 <= WS_PXG && WS_PXG + (size_t)MT * NPXG * 2 <= WS_TB && WS_ACT + (size_t)MT * FF * 2 <= WS_TB && WS_HX + (size_t)MT * DM * 2 <= WS_PXA, "ws map");
constexpr int CW_TMO = 0, CW_BAR = 4096;

constexpr int RING_BYTES = 131072, LDSCTL_OFF = 155648, MISC_OFF = LDSCTL_OFF + 320, LDS_BYTES = 163840;

#define GAS __attribute__((address_space(1)))
#define LAS __attribute__((address_space(3)))
typedef unsigned short bf16;
typedef unsigned v4u __attribute__((ext_vector_type(4)));
typedef unsigned v2u __attribute__((ext_vector_type(2)));
typedef float f32x4 __attribute__((ext_vector_type(4)));
typedef GAS unsigned gu32;
#define RLX_AGENT __ATOMIC_RELAXED, __HIP_MEMORY_SCOPE_AGENT
#define LDS_WAIT() asm volatile("s_waitcnt lgkmcnt(0)" ::: "memory")
__device__ __forceinline__ unsigned pk2(float lo, float hi) { return pg8::cvt_pk_bf16(lo, hi); }
__device__ __forceinline__ unsigned f2bf(float f) { return pg8::cvt_pk_bf16(f, 0.0f) & 0xffffu; }
__device__ __forceinline__ float bf2f(unsigned h) { return __uint_as_float(h << 16); }
__device__ __forceinline__ float bflo(unsigned w) { return __uint_as_float(w << 16); }
__device__ __forceinline__ float bfhi(unsigned w) { return __uint_as_float(w & 0xffff0000u); }

#define XB_TMO      128
#define XB_XCNT(j)  (256  + 64 * (j))
#define XB_XSUB(j)  (1280 + 64 * (j))
#define XB_XGEN(j)  (2304 + 64 * (j))
#define XB_TOP      3328
#define XB_TOPGEN   3392
#define XCD_BAR_WORDS 3456
#define XB_SPIN_CAP (1u << 22)
__device__ __forceinline__ unsigned xb_ld(unsigned* p)              { return __hip_atomic_load(p, __ATOMIC_RELAXED, __HIP_MEMORY_SCOPE_AGENT); }
__device__ __forceinline__ unsigned xb_add(unsigned* p, unsigned v) { return __hip_atomic_fetch_add(p, v, __ATOMIC_RELAXED, __HIP_MEMORY_SCOPE_AGENT); }
__device__ __forceinline__ unsigned xb_xcc_id() { return (unsigned)__builtin_amdgcn_s_getreg((3 << 11) | 20) & 0xFu; }
#define XB_SPIN(cond, bar) do { unsigned _sp = 0; while (cond) { __builtin_amdgcn_s_sleep(1); \
    if ((++_sp & 255u) == 0u) { if (xb_ld(&(bar)[XB_TMO])) break; if (_sp > XB_SPIN_CAP) { atomicAdd(&(bar)[XB_TMO], 1u); break; } } } } while (0)
struct XcdBarrier { unsigned* bar; unsigned x; volatile LAS unsigned* st; };
__device__ __forceinline__ XcdBarrier xcd_barrier_post(unsigned* bar, volatile LAS unsigned* st, bool leader) {
    XcdBarrier b; b.bar = bar; b.x = xb_xcc_id(); b.st = st;
    if (leader) { const unsigned rank = xb_add(&bar[XB_XCNT(b.x)], 1u); st[2] = rank; }
    return b;
}
__device__ __forceinline__ void xcd_barrier_complete(unsigned* bar, unsigned x, unsigned& nloc, unsigned& nx) {
    const unsigned G = gridDim.x * gridDim.y * gridDim.z;
    unsigned sum, cnt, mine, sp = 0u;
    for (;;) {
        sum = 0u; cnt = 0u; mine = 0u;
#pragma unroll
        for (unsigned j = 0; j < 16; ++j) { const unsigned c = xb_ld(&bar[XB_XCNT(j)]); sum += c; cnt += (c > 0u) ? 1u : 0u; mine = (j == x) ? c : mine; }
        if (sum == G) break;
        __builtin_amdgcn_s_sleep(1);
        if ((++sp & 255u) == 0u) { if (xb_ld(&bar[XB_TMO])) break; if (sp > XB_SPIN_CAP) { atomicAdd(&bar[XB_TMO], 1u); break; } }
    }
    nloc = mine > 0u ? mine : 1u; nx = cnt > 0u ? cnt : 1u;
}
__device__ __forceinline__ void xcd_barrier(const XcdBarrier& b, bool leader) {
    asm volatile("s_waitcnt vmcnt(0)" ::: "memory");
    __syncthreads();
    if (leader) {
        unsigned* bar = b.bar;
        __builtin_amdgcn_s_waitcnt(0);
        unsigned nloc = b.st[0], nx = b.st[1];
        if (nloc == 0u) { xcd_barrier_complete(bar, b.x, nloc, nx); b.st[0] = nloc; b.st[1] = nx; }
        const unsigned old = xb_add(&bar[XB_XSUB(b.x)], 1u);
        const unsigned gen = old / nloc;
        if (old + 1u == (gen + 1u) * nloc) {
            __builtin_amdgcn_fence(__ATOMIC_RELEASE, "agent");
            asm volatile("s_waitcnt vmcnt(0)" ::: "memory");
            const unsigned og = xb_add(&bar[XB_TOP], 1u);
            const unsigned tg = og / nx;
            if (og + 1u == (tg + 1u) * nx) xb_add(&bar[XB_TOPGEN], 1u);
            else XB_SPIN(xb_ld(&bar[XB_TOPGEN]) == tg, bar);
            __builtin_amdgcn_fence(__ATOMIC_ACQUIRE, "agent");
            xb_add(&bar[XB_XGEN(b.x)], 1u);
            asm volatile("s_waitcnt vmcnt(0)" ::: "memory");
        } else {
            XB_SPIN(xb_ld(&bar[XB_XGEN(b.x)]) == gen, bar);
            __builtin_amdgcn_fence(__ATOMIC_ACQUIRE, "agent");
            asm volatile("s_waitcnt vmcnt(0)" ::: "memory");
        }
    }
    __syncthreads();
}

__device__ __forceinline__ float wave_sum(float v) {
#pragma unroll
    for (int o = 1; o < 64; o <<= 1) v += __shfl_xor(v, o);
    return v;
}
__device__ __forceinline__ float wave_max(float v) {
#pragma unroll
    for (int o = 1; o < 64; o <<= 1) v = fmaxf(v, __shfl_xor(v, o));
    return v;
}

__device__ __forceinline__ void transpose_item(const float* W, int ldw, int ncols, bf16* WT, int ldwt, int row_off, int k_off, LAS float* scr, int item, int lane) {
    const int nblk = ncols / 32, kb = item / nblk, nb = item % nblk, k0 = 64 * kb, n0 = 32 * nb;
#pragma unroll 8
    for (int i = 0; i < 32; ++i) { const int kk = 2 * i + (lane >> 5); scr[kk * 33 + (lane & 31)] = W[(size_t)(k0 + kk) * ldw + n0 + (lane & 31)]; }
    LDS_WAIT(); asm volatile("" ::: "memory");
    const int c = lane & 7;
#pragma unroll
    for (int j = 0; j < 4; ++j) { const int n = (lane >> 3) + 8 * j; const LAS float* s = scr + (8 * c) * 33 + n;
        v4u o; o.x = pk2(s[0 * 33], s[1 * 33]); o.y = pk2(s[2 * 33], s[3 * 33]); o.z = pk2(s[4 * 33], s[5 * 33]); o.w = pk2(s[6 * 33], s[7 * 33]);
        *(v4u*)(WT + (size_t)(row_off + n0 + n) * ldwt + k_off + k0 + 8 * c) = o; }
    LDS_WAIT(); asm volatile("" ::: "memory");
}

using pg8::Unit; using pg8::cvt_pk_bf16;
typedef unsigned long long u64;
constexpr int NTM = MT / 256;
__device__ __forceinline__ size_t gate_tile(int g, int pm, int pn) { return (size_t)((g * NTM + pm) * 4 + pn) * 65536; }
__device__ __forceinline__ int gate_piece(int ai, int m, int bj, int wave, int lane) { return ((((ai * 4 + m) * 2 + bj) * 8 + wave) * 64 + lane) * 8; }
__device__ __forceinline__ size_t gate_elem(int g, int row, int col) {
    const int r = row & 255, c = col & 255;
    return gate_tile(g, row >> 8, col >> 8) + gate_piece(r >> 7, (r >> 4) & 3, c >> 7, ((r >> 6) & 1) * 4 + ((c >> 5) & 3), ((c >> 3) & 3) * 16 + (r & 15)) + (c & 7);
}
__device__ __forceinline__ float rs_to_rstd(u64 q) { return __builtin_amdgcn_rsqf((float)q * (1.0f / (16777216.0f * DM)) + EPS); }
struct EpiIn {
    static constexpr bool PERM = true, HOOKS = false; static constexpr int NST = 16;
    bf16* pxa; bf16* pxg; const u64* rs; const float* cin;
    __device__ __forceinline__ void operator()(const f32x4 (&acc)[2][2][4][2], const Unit& u, int wr, int wc, int fr, int fq) const {
        asm volatile("" : "+v"(fr), "+v"(fq));
        const bool gate = u.pn >= 11; bf16* base = gate ? pxg : pxa; const int ldc = gate ? NPXG : NPXA; const int colt = (gate ? u.pn - 11 : u.pn) * 256;
        const int grp = u.pm >= 128 ? 4 : (u.pm >> 5);
        const int row0 = u.pm * 256 + wr * 64 + fr, col0 = colt + wc * 32 + 8 * fq;
        const float* cp = cin + grp * NIN + u.pn * 256 + wc * 32 + 8 * fq;
        bf16* gbase = pxg + (gate ? gate_tile((u.pn - 11) >> 2, u.pm, (u.pn - 11) & 3) : 0);
        const float gsc = gate ? -1.4426950408889634f : 1.0f;
        f32x4 cv[2][2];
#pragma unroll
        for (int bj = 0; bj < 2; ++bj) { cv[bj][0] = *(const f32x4*)(cp + bj * 128) * gsc; cv[bj][1] = *(const f32x4*)(cp + bj * 128 + 4) * gsc; }
        u64 rq[2][4]; float rsv[2][4];
#pragma unroll
        for (int ai = 0; ai < 2; ++ai)
#pragma unroll
            for (int m = 0; m < 4; ++m) rq[ai][m] = rs[row0 + ai * 128 + m * 16];
        asm volatile("" ::: "memory");
#pragma unroll
        for (int ai = 0; ai < 2; ++ai)
#pragma unroll
            for (int m = 0; m < 4; ++m) rsv[ai][m] = rs_to_rstd(rq[ai][m]) * gsc;
#pragma unroll
        for (int ai = 0; ai < 2; ++ai)
#pragma unroll
            for (int m = 0; m < 4; ++m) { const int row = row0 + ai * 128 + m * 16; bf16* rowp = base + (size_t)row * ldc + col0; const float rstd = rsv[ai][m];
#pragma unroll
                for (int bj = 0; bj < 2; ++bj) { f32x4 v0 = acc[ai][bj][m][0] * rstd + cv[bj][0], v1 = acc[ai][bj][m][1] * rstd + cv[bj][1];
                    if (gate) {
#pragma unroll
                        for (int e = 0; e < 4; ++e) { v0[e] = 1.0f + __builtin_amdgcn_exp2f(__builtin_amdgcn_fmed3f(v0[e], -120.0f, 120.0f)); v1[e] = 1.0f + __builtin_amdgcn_exp2f(__builtin_amdgcn_fmed3f(v1[e], -120.0f, 120.0f)); } }
                    v4u w; w.x = cvt_pk_bf16(v0[0], v0[1]); w.y = cvt_pk_bf16(v0[2], v0[3]); w.z = cvt_pk_bf16(v1[0], v1[1]); w.w = cvt_pk_bf16(v1[2], v1[3]);
                    if (gate) *(v4u*)(gbase + gate_piece(ai, m, bj, wr * 4 + wc, fq * 16 + fr)) = w;
                    else *(v4u*)(rowp + bj * 128) = w; } }
    }
};
struct EpiMerge {
    static constexpr bool PERM = true, HOOKS = true; static constexpr int NST = 16;
    bf16* m; const bf16* pxg;
    __device__ __forceinline__ void hook(f32x4 (&acc)[2][2][4][2], const Unit& u, int t, int wr, int wc, int fr, int fq) const {
        asm volatile("" : "+v"(fr), "+v"(fq));
        const int wv = wr * 4 + wc, ln = fq * 16 + fr;
        const bf16* gnum = pxg + gate_tile(t == 4 ? 0 : 1, u.pm, u.pn); const bf16* gden = pxg + gate_tile(t == 4 ? 1 : 2, u.pm, u.pn);
#pragma unroll
        for (int ai = 0; ai < 2; ++ai)
#pragma unroll
            for (int mp = 0; mp < 2; ++mp) {
                v4u gn[2][2], gd[2][2];
#pragma unroll
                for (int mq = 0; mq < 2; ++mq)
#pragma unroll
                    for (int bj = 0; bj < 2; ++bj) { const int ro = gate_piece(ai, 2 * mp + mq, bj, wv, ln); gn[mq][bj] = *(const v4u*)(gnum + ro); gd[mq][bj] = *(const v4u*)(gden + ro); }
                asm volatile("" ::: "memory");
#pragma unroll
                for (int mq = 0; mq < 2; ++mq)
#pragma unroll
                    for (int bj = 0; bj < 2; ++bj) { const v4u a = gn[mq][bj], d = gd[mq][bj];
                        f32x4& v0 = acc[ai][bj][2 * mp + mq][0]; f32x4& v1 = acc[ai][bj][2 * mp + mq][1];
                        v0[0] *= bflo(d.x) * __builtin_amdgcn_rcpf(bflo(a.x)); v0[1] *= bfhi(d.x) * __builtin_amdgcn_rcpf(bfhi(a.x));
                        v0[2] *= bflo(d.y) * __builtin_amdgcn_rcpf(bflo(a.y)); v0[3] *= bfhi(d.y) * __builtin_amdgcn_rcpf(bfhi(a.y));
                        v1[0] *= bflo(d.z) * __builtin_amdgcn_rcpf(bflo(a.z)); v1[1] *= bfhi(d.z) * __builtin_amdgcn_rcpf(bfhi(a.z));
                        v1[2] *= bflo(d.w) * __builtin_amdgcn_rcpf(bflo(a.w)); v1[3] *= bfhi(d.w) * __builtin_amdgcn_rcpf(bfhi(a.w)); }
            }
    }
    __device__ __forceinline__ void operator()(const f32x4 (&acc)[2][2][4][2], const Unit& u, int wr, int wc, int fr, int fq) const {
        asm volatile("" : "+v"(fr), "+v"(fq));
        const int row0 = u.pm * 256 + wr * 64 + fr, col0 = u.pn * 256 + wc * 32 + 8 * fq;
        const bf16* ga = pxg + gate_tile(2, u.pm, u.pn);
#pragma unroll
        for (int ai = 0; ai < 2; ++ai) {
            v4u g[4][2];
#pragma unroll
            for (int mm = 0; mm < 4; ++mm)
#pragma unroll
                for (int bj = 0; bj < 2; ++bj) g[mm][bj] = *(const v4u*)(ga + gate_piece(ai, mm, bj, wr * 4 + wc, fq * 16 + fr));
            asm volatile("" ::: "memory");
#pragma unroll
            for (int mm = 0; mm < 4; ++mm)
#pragma unroll
                for (int bj = 0; bj < 2; ++bj) { const f32x4 v0 = acc[ai][bj][mm][0], v1 = acc[ai][bj][mm][1]; const v4u gg = g[mm][bj];
#define RC(x) __builtin_amdgcn_rcpf(x)
                    v4u w; w.x = cvt_pk_bf16(v0[0] * RC(bflo(gg.x)), v0[1] * RC(bfhi(gg.x))); w.y = cvt_pk_bf16(v0[2] * RC(bflo(gg.y)), v0[3] * RC(bfhi(gg.y)));
                    w.z = cvt_pk_bf16(v1[0] * RC(bflo(gg.z)), v1[1] * RC(bfhi(gg.z))); w.w = cvt_pk_bf16(v1[2] * RC(bflo(gg.w)), v1[3] * RC(bfhi(gg.w)));
#undef RC
                    *(v4u*)(m + (size_t)(row0 + ai * 128 + mm * 16) * DM + col0 + bj * 128) = w; }
        }
    }
};
template <bool BF  >
struct EpiRes {
    static constexpr bool PERM = true, HOOKS = false; static constexpr int NST = 32;
    const void* base_l; bf16* out; const float* gate;
    float* part;
    const float* gn; bf16* ap; u64* rs;
    __device__ __forceinline__ void operator()(const f32x4 (&acc)[2][2][4][2], const Unit& u, int wr, int wc, int fr, int fq) const {
        asm volatile("" : "+v"(fr), "+v"(fq));
        const bool isc = u.pm >= 128; const int grp = isc ? 4 : (u.pm >> 5);
        const int row0 = (isc ? (u.pm - 128) : u.pm) * 256 + wr * 64 + fr, col0 = u.pn * 256 + wc * 32 + 8 * fq;
        if (isc) {
            if (part == nullptr) return;
            float* po = part + (size_t)u.br * 1024 * 1024;
#pragma unroll
            for (int ai = 0; ai < 2; ++ai)
#pragma unroll
                for (int m = 0; m < 4; ++m)
#pragma unroll
                    for (int bj = 0; bj < 2; ++bj)
#pragma unroll
                        for (int n = 0; n < 2; ++n) *(f32x4*)(po + (size_t)(row0 + ai * 128 + m * 16) * DM + col0 + bj * 128 + n * 4) = acc[ai][bj][m][n];
            return;
        }
        const size_t stile = (size_t)(u.pm * 4 + u.pn) * 65536;
        f32x4 gv[2][2], gnv[2][2];
#pragma unroll
        for (int bj = 0; bj < 2; ++bj)
#pragma unroll
            for (int n = 0; n < 2; ++n) { gv[bj][n] = *(const f32x4*)(gate + grp * NMOD + col0 + bj * 128 + n * 4); gnv[bj][n] = *(const f32x4*)(gn + grp * DM + col0 + bj * 128 + n * 4); }
#pragma unroll
        for (int ai = 0; ai < 2; ++ai)
#pragma unroll
            for (int mp = 0; mp < 2; ++mp) {
                f32x4 bs[2][2][2];
                if constexpr (BF) {
                    v4u bb[2][2];
#pragma unroll
                    for (int mq = 0; mq < 2; ++mq)
#pragma unroll
                        for (int bj = 0; bj < 2; ++bj) bb[mq][bj] = *(const v4u*)((const bf16*)base_l + stile + gate_piece(ai, 2 * mp + mq, bj, wr * 4 + wc, fq * 16 + fr));
                    asm volatile("" ::: "memory");
#pragma unroll
                    for (int mq = 0; mq < 2; ++mq)
#pragma unroll
                        for (int bj = 0; bj < 2; ++bj) { const v4u b = bb[mq][bj]; bs[mq][bj][0] = (f32x4){bflo(b.x), bfhi(b.x), bflo(b.y), bfhi(b.y)}; bs[mq][bj][1] = (f32x4){bflo(b.z), bfhi(b.z), bflo(b.w), bfhi(b.w)}; }
                } else {
#pragma unroll
                    for (int mq = 0; mq < 2; ++mq)
#pragma unroll
                        for (int bj = 0; bj < 2; ++bj)
#pragma unroll
                            for (int n = 0; n < 2; ++n) bs[mq][bj][n] = *(const f32x4*)((const float*)base_l + (size_t)(row0 + ai * 128 + (2 * mp + mq) * 16) * DM + col0 + bj * 128 + n * 4);
                    asm volatile("" ::: "memory");
                }
#pragma unroll
                for (int mq = 0; mq < 2; ++mq) { const int m = 2 * mp + mq; float ss = 0.f; const size_t ro = (size_t)(row0 + ai * 128 + m * 16) * DM + col0;
#pragma unroll
                    for (int bj = 0; bj < 2; ++bj) {
                        const f32x4 o0 = bs[mq][bj][0] + gv[bj][0] * acc[ai][bj][m][0], o1 = bs[mq][bj][1] + gv[bj][1] * acc[ai][bj][m][1];
                        v4u ow; ow.x = cvt_pk_bf16(o0[0], o0[1]); ow.y = cvt_pk_bf16(o0[2], o0[3]); ow.z = cvt_pk_bf16(o1[0], o1[1]); ow.w = cvt_pk_bf16(o1[2], o1[3]);
                        *(v4u*)(out + stile + gate_piece(ai, m, bj, wr * 4 + wc, fq * 16 + fr)) = ow;
                        const f32x4 y0 = o0 * gnv[bj][0], y1 = o1 * gnv[bj][1];
                        v4u w; w.x = cvt_pk_bf16(y0[0], y0[1]); w.y = cvt_pk_bf16(y0[2], y0[3]); w.z = cvt_pk_bf16(y1[0], y1[1]); w.w = cvt_pk_bf16(y1[2], y1[3]);
                        *(v4u*)(ap + ro + bj * 128) = w;
                        ss += ((o0[0] * o0[0] + o0[1] * o0[1]) + (o0[2] * o0[2] + o0[3] * o0[3])) + ((o1[0] * o1[0] + o1[1] * o1[1]) + (o1[2] * o1[2] + o1[3] * o1[3])); }
                    ss += __shfl_xor(ss, 16); ss += __shfl_xor(ss, 32);
                    if (fq == 0) __hip_atomic_fetch_add(rs + row0 + ai * 128 + m * 16, (u64)(ss * 16777216.0f + 0.5f), __ATOMIC_RELAXED, __HIP_MEMORY_SCOPE_AGENT); }
            }
    }
};
struct EpiResFinal {
    static constexpr bool PERM = true, HOOKS = false; static constexpr int NST = 32;
    const bf16* xs; float* xo; const float* gate; const float* fg; u64* rs; unsigned* cnt; unsigned* tmo;
    __device__ __forceinline__ void operator()(f32x4 (&acc)[2][2][4][2], const Unit& u, int wr, int wc, int fr, int fq) const {
        asm volatile("" : "+v"(fr), "+v"(fq));
        const int grp = u.pm >> 5, row0 = u.pm * 256 + wr * 64 + fr, col0 = u.pn * 256 + wc * 32 + 8 * fq;
        f32x4 gv[2][2];
#pragma unroll
        for (int bj = 0; bj < 2; ++bj)
#pragma unroll
            for (int n = 0; n < 2; ++n) gv[bj][n] = *(const f32x4*)(gate + grp * NMOD + col0 + bj * 128 + n * 4);
#pragma unroll
        for (int ai = 0; ai < 2; ++ai)
#pragma unroll
            for (int mp = 0; mp < 2; ++mp) {
                f32x4 bs[2][2][2];
                { v4u bb[2][2];
#pragma unroll
                  for (int mq = 0; mq < 2; ++mq)
#pragma unroll
                      for (int bj = 0; bj < 2; ++bj) bb[mq][bj] = *(const v4u*)(xs + (size_t)(u.pm * 4 + u.pn) * 65536 + gate_piece(ai, 2 * mp + mq, bj, wr * 4 + wc, fq * 16 + fr));
                  asm volatile("" ::: "memory");
#pragma unroll
                  for (int mq = 0; mq < 2; ++mq)
#pragma unroll
                      for (int bj = 0; bj < 2; ++bj) { const v4u b = bb[mq][bj]; bs[mq][bj][0] = (f32x4){bflo(b.x), bfhi(b.x), bflo(b.y), bfhi(b.y)}; bs[mq][bj][1] = (f32x4){bflo(b.z), bfhi(b.z), bflo(b.w), bfhi(b.w)}; } }
#pragma unroll
                for (int mq = 0; mq < 2; ++mq) { const int m = 2 * mp + mq; float ss = 0.f;
#pragma unroll
                    for (int bj = 0; bj < 2; ++bj)
#pragma unroll
                        for (int n = 0; n < 2; ++n) { const f32x4 o = bs[mq][bj][n] + gv[bj][n] * acc[ai][bj][m][n]; acc[ai][bj][m][n] = o; ss += (o[0] * o[0] + o[1] * o[1]) + (o[2] * o[2] + o[3] * o[3]); }
                    ss += __shfl_xor(ss, 16); ss += __shfl_xor(ss, 32);
                    if (fq == 0) __hip_atomic_fetch_add(rs + row0 + ai * 128 + m * 16, (u64)(ss * 16777216.0f + 0.5f), __ATOMIC_RELAXED, __HIP_MEMORY_SCOPE_AGENT); }
            }
        asm volatile("s_waitcnt vmcnt(0)" ::: "memory");
        unsigned* pc = cnt + 64 * u.pm;
        if (__builtin_amdgcn_mbcnt_hi(~0u, __builtin_amdgcn_mbcnt_lo(~0u, 0u)) == 0) __hip_atomic_fetch_add(pc, 1u, __ATOMIC_RELAXED, __HIP_MEMORY_SCOPE_AGENT);
        { unsigned spins = 0;
          while ((unsigned)__builtin_amdgcn_readfirstlane(__hip_atomic_load(pc, __ATOMIC_RELAXED, __HIP_MEMORY_SCOPE_AGENT)) < 32u) {
              __builtin_amdgcn_s_sleep(2);
              if (++spins > (1u << 22)) { __hip_atomic_store(tmo, 1u, __ATOMIC_RELAXED, __HIP_MEMORY_SCOPE_AGENT); break; } } }
        f32x4 fgv[2][2];
#pragma unroll
        for (int bj = 0; bj < 2; ++bj)
#pragma unroll
            for (int n = 0; n < 2; ++n) fgv[bj][n] = *(const f32x4*)(fg + col0 + bj * 128 + n * 4);
#pragma unroll
        for (int ai = 0; ai < 2; ++ai)
#pragma unroll
            for (int m = 0; m < 4; ++m) { const int row = row0 + ai * 128 + m * 16;
                const float rstd = rs_to_rstd(__hip_atomic_load(rs + row, __ATOMIC_RELAXED, __HIP_MEMORY_SCOPE_AGENT));
#pragma unroll
                for (int bj = 0; bj < 2; ++bj)
#pragma unroll
                    for (int n = 0; n < 2; ++n) *(f32x4*)(xo + (size_t)row * DM + col0 + bj * 128 + n * 4) = acc[ai][bj][m][n] * rstd * fgv[bj][n]; }
    }
};
struct EpiAct {
    static constexpr bool PERM = true, HOOKS = false; static constexpr int NST = 16;
    bf16* a; const u64* rs; const float* cup;
    __device__ __forceinline__ void operator()(const f32x4 (&acc)[2][2][4][2], const Unit& u, int wr, int wc, int fr, int fq) const {
        asm volatile("" : "+v"(fr), "+v"(fq));
        const int grp = u.pm >= 128 ? 4 : (u.pm >> 5);
        const int row0 = u.pm * 256 + wr * 64 + fr, col0 = u.pn * 256 + wc * 32 + 8 * fq;
        const float* cp = cup + grp * FF + col0;
        f32x4 cv[2][2];
#pragma unroll
        for (int bj = 0; bj < 2; ++bj) { cv[bj][0] = *(const f32x4*)(cp + bj * 128); cv[bj][1] = *(const f32x4*)(cp + bj * 128 + 4); }
        u64 rq[2][4]; float rsv[2][4];
#pragma unroll
        for (int ai = 0; ai < 2; ++ai)
#pragma unroll
            for (int m = 0; m < 4; ++m) rq[ai][m] = rs[row0 + ai * 128 + m * 16];
        asm volatile("" ::: "memory");
#pragma unroll
        for (int ai = 0; ai < 2; ++ai)
#pragma unroll
            for (int m = 0; m < 4; ++m) rsv[ai][m] = rs_to_rstd(rq[ai][m]);
#pragma unroll
        for (int ai = 0; ai < 2; ++ai)
#pragma unroll
            for (int m = 0; m < 4; ++m) { const int row = row0 + ai * 128 + m * 16; bf16* rowp = a + (size_t)row * FF + col0; const float rstd = rsv[ai][m];
#pragma unroll
                for (int bj = 0; bj < 2; ++bj) { f32x4 v0 = acc[ai][bj][m][0] * rstd + cv[bj][0], v1 = acc[ai][bj][m][1] * rstd + cv[bj][1];
#pragma unroll
                    for (int e = 0; e < 4; ++e) { const float r0 = fmaxf(v0[e], 0.f), r1 = fmaxf(v1[e], 0.f); v0[e] = r0 * r0; v1[e] = r1 * r1; }
                    v4u w; w.x = cvt_pk_bf16(v0[0], v0[1]); w.y = cvt_pk_bf16(v0[2], v0[3]); w.z = cvt_pk_bf16(v1[0], v1[1]); w.w = cvt_pk_bf16(v1[2], v1[3]);
                    *(v4u*)(rowp + bj * 128) = w; } }
    }
};

constexpr int NS = 8;
constexpr int NSTEPS = 2 + 2 * NS;
constexpr int LARGS_OFF = LDSCTL_OFF + 1024;
enum { A_X = 0, A_C, A_CTX, A_CCTX, A_ADAW, A_ADAB, A_N1G, A_N2G, A_WIN, A_CONVW, A_RELB, A_WF, A_WC, A_WA, A_WO, A_W1, A_W2, A_FG, A_OUT, A_WS, A_NARGS };

struct Ctx { LAS unsigned char* lds; int wave, G, bx, gw, NGW, NGT;
    __device__ __forceinline__ int lane() const { int l; asm volatile("v_mbcnt_lo_u32_b32 %0, -1, 0\n\tv_mbcnt_hi_u32_b32 %0, -1, %0" : "=v"(l)); return l; }
    __device__ __forceinline__ int tid() const { return wave * 64 + lane(); }
    __device__ __forceinline__ int gt() const { return bx * NTHR + tid(); }
};
template <int I> __device__ __forceinline__ unsigned long long ldarg_t() {
    unsigned long long v; unsigned tmp;
    asm volatile("v_mov_b32 %1, %2\n\tds_read_b64 %0, %1 offset:%3\n\ts_waitcnt lgkmcnt(0)" : "=&v"(v), "=&v"(tmp) : "i"(LARGS_OFF), "i"(I * 8) : "memory");
    const unsigned lo = __builtin_amdgcn_readfirstlane((unsigned)v), hi = __builtin_amdgcn_readfirstlane((unsigned)(v >> 32));
    return ((unsigned long long)hi << 32) | lo;
}
#define ldarg(C, i) ldarg_t<(i)>()
#define ARGF(i) ((const float*)(const GAS float*)ldarg(C, (i)))
#define WSP(T, off) ((T*)(GAS T*)((GAS unsigned char*)ldarg(C, A_WS) + (off)))

__device__ __forceinline__ void ph_mod_partial(const Ctx& C) {
    const float* cvec = ARGF(A_C); const float* cctx = ARGF(A_CCTX); const float* ada_w = ARGF(A_ADAW);
    float* modp = WSP(float, WS_MODP); float2* tw = WSP(float2, WS_TW);
    LAS float* sl = (LAS float*)C.lds;
    for (int item = C.bx; item < 2 * 8 * 12; item += C.G) {
        const int l = item / 96, rem = item % 96, kc = rem / 12, jb = rem % 12;
        __syncthreads();
        for (int e = C.tid(); e < 5 * 128; e += NTHR) { const int g = e >> 7, k = kc * 128 + (e & 127); const float v = g < 4 ? cvec[g * DM + k] : cctx[k]; sl[e] = v / (1.0f + __expf(-v)); }
        __syncthreads();
        const int j = jb * 512 + C.tid(); float a0 = 0.f, a1 = 0.f, a2 = 0.f, a3 = 0.f, a4 = 0.f;
        const float* wp = ada_w + ((size_t)l * DM + kc * 128) * NMOD + j;
#pragma unroll 4
        for (int k = 0; k < 128; ++k) { const float w = wp[(size_t)k * NMOD]; a0 += sl[k] * w; a1 += sl[128 + k] * w; a2 += sl[256 + k] * w; a3 += sl[384 + k] * w; a4 += sl[512 + k] * w; }
        float* pp = modp + ((size_t)(l * 8 + kc) * 5) * NMOD + j;
        pp[0] = a0; pp[NMOD] = a1; pp[2 * NMOD] = a2; pp[3 * NMOD] = a3; pp[4 * NMOD] = a4;
    }
    for (int m = C.gt(); m < 8192; m += C.NGT) { float s, c; sincospif((float)m * (1.0f / 4096.0f), &s, &c); tw[m] = make_float2(c, s); }
}
__device__ __forceinline__ void ph_mod_reduce(const Ctx& C) {
    const float* ada_b = ARGF(A_ADAB); const float* modp = WSP(float, WS_MODP); float* mod = WSP(float, WS_MOD);
    for (int e = C.gt(); e < 2 * 5 * NMOD; e += C.NGT) { const int l = e / (5 * NMOD), r = e % (5 * NMOD), j = r % NMOD; float s = ada_b[l * NMOD + j];
#pragma unroll
        for (int kc = 0; kc < 8; ++kc) s += modp[(size_t)(l * 8 + kc) * 5 * NMOD + r];
        mod[e] = s; }
    float* gnt = WSP(float, WS_GN); const float* n1g = ARGF(A_N1G); const float* n2g = ARGF(A_N2G);
    for (int e = C.gt(); e < 2 * 2 * 5 * DM; e += C.NGT) { const int col = e & 1023, grp = (e >> 10) % 5, w = (e / (5 * DM)) & 1, l = e / (10 * DM), j = (w ? 4 : 1) * DM + col;
        float s = ada_b[l * NMOD + j];
#pragma unroll
        for (int kc = 0; kc < 8; ++kc) s += modp[((size_t)(l * 8 + kc) * 5 + grp) * NMOD + j];
        gnt[e] = (w ? n2g : n1g)[l * DM + col] * (1.0f + s); }
}
__device__ __forceinline__ void ph_ctab(const Ctx& C, int l) {
    LAS float* red = (LAS float*)(C.lds + 131072); LAS float* cu = red + 8 * 5 * 64;
    const float* modl = WSP(const float, WS_MOD) + (size_t)l * 5 * NMOD; const float2* tw = WSP(const float2, WS_TW);
    float* cin = WSP(float, WS_CIN) + (size_t)l * 5 * NIN; float* cup = WSP(float, WS_CUP) + (size_t)l * 5 * FF;
    const int lane = C.lane(), w = C.wave, tid = C.tid();
    LAS float* sl = (LAS float*)C.lds;
    for (int it = C.bx; it < 88 + 64; it += C.G) {
        const bool isin = it < 88; const int ldw = isin ? NIN_ORIG : FF, col0 = (isin ? it : it - 88) * 64;
        __syncthreads();
        for (int e = tid; e < 5 * 1024; e += NTHR) sl[e] = modl[(e >> 10) * NMOD + (isin ? 0 : 3 * DM) + (e & 1023)];
        __syncthreads();
        const int rq = lane >> 4, c4 = lane & 15;
        const float* W = (isin ? ARGF(A_WIN) + (size_t)l * DM * NIN_ORIG : ARGF(A_W1) + (size_t)l * DM * FF) + (size_t)(128 * w + rq) * ldw + col0 + 4 * c4;
        f32x4 a[5];
#pragma unroll
        for (int g = 0; g < 5; ++g) a[g] = (f32x4){0.f, 0.f, 0.f, 0.f};
#pragma unroll 8
        for (int i = 0; i < 32; ++i) { const f32x4 wv = *(const f32x4*)(W + (size_t)(4 * i) * ldw); const int kr = 128 * w + 4 * i + rq;
#pragma unroll
            for (int g = 0; g < 5; ++g) a[g] += sl[g * 1024 + kr] * wv; }
#pragma unroll
        for (int g = 0; g < 5; ++g)
#pragma unroll
            for (int e = 0; e < 4; ++e) { float v = a[g][e]; v += __shfl_xor(v, 16); v += __shfl_xor(v, 32); a[g][e] = v; }
        if (lane < 16) {
#pragma unroll
            for (int g = 0; g < 5; ++g) { red[(w * 5 + g) * 64 + 4 * c4] = a[g][0]; red[(w * 5 + g) * 64 + 4 * c4 + 1] = a[g][1]; red[(w * 5 + g) * 64 + 4 * c4 + 2] = a[g][2]; red[(w * 5 + g) * 64 + 4 * c4 + 3] = a[g][3]; } }
        __syncthreads();
        if (tid < 320) { const int g = tid >> 6, c = tid & 63; float v = 0.f;
#pragma unroll
            for (int ww = 0; ww < 8; ++ww) v += red[(ww * 5 + g) * 64 + c];
            if (!isin) cup[g * FF + col0 + c] = v; else if (it >= 4) cin[g * NIN + col0 + c + 256] = v; else cu[g * 64 + c] = v; }
        if (isin && it < 4) { __syncthreads();
            if (tid < 320) { const int g = tid >> 6, kc = tid & 63; float p = 0.f, q = 0.f;
                for (int c = 0; c < 64; ++c) { const float2 t = tw[((c * kc) & 63) * 128]; const float v = cu[g * 64 + c]; p += v * t.x; q += v * t.y; }
                cin[g * NIN + it * 64 + kc] = p; cin[g * NIN + 256 + it * 64 + kc] = q; } }
    }
    __syncthreads();
}
__device__ __forceinline__ void ph_weights(const Ctx& C, int l) {
    LAS float* scr = (LAS float*)(C.lds + C.wave * 16384);
    const int lane = C.lane();
    const float* Win = ARGF(A_WIN) + (size_t)l * DM * NIN_ORIG;
    bf16* win_t = WSP(bf16, WS_WIN); bf16* wm_t = WSP(bf16, WS_WM);
    constexpr int I_IN = (DM / 64) * ((NIN_ORIG - 256) / 32), I_F = (256 / 64) * (DM / 32), I_A = (512 / 64) * (DM / 32), I_O = (DM / 64) * (DM / 32), I_1 = (DM / 64) * (FF / 32), I_2 = (FF / 64) * (DM / 32);
    constexpr int NITEMS = I_IN + 2 * I_F + I_A + I_O + I_1 + I_2;
    for (int it = C.gw; it < NITEMS; it += C.NGW) {
        int r = it;
        if (r < I_IN) { transpose_item(Win + 256, NIN_ORIG, NIN_ORIG - 256, win_t, DM, 512, 0, scr, r, lane); continue; } r -= I_IN;
        if (r < I_F) { transpose_item(ARGF(A_WF) + (size_t)l * 256 * DM, DM, DM, wm_t, DM, 0, 0, scr, r, lane); continue; } r -= I_F;
        if (r < I_F) { transpose_item(ARGF(A_WC) + (size_t)l * 256 * DM, DM, DM, wm_t, DM, 0, 256, scr, r, lane); continue; } r -= I_F;
        if (r < I_A) { transpose_item(ARGF(A_WA) + (size_t)l * 512 * DM, DM, DM, wm_t, DM, 0, 512, scr, r, lane); continue; } r -= I_A;
        if (r < I_O) { transpose_item(ARGF(A_WO) + (size_t)l * DM * DM, DM, DM, WSP(bf16, WS_WO), DM, 0, 0, scr, r, lane); continue; } r -= I_O;
        if (r < I_1) { transpose_item(ARGF(A_W1) + (size_t)l * DM * FF, FF, FF, WSP(bf16, WS_W1), DM, 0, 0, scr, r, lane); continue; } r -= I_1;
        transpose_item(ARGF(A_W2) + (size_t)l * FF * DM, DM, DM, WSP(bf16, WS_W2), FF, 0, 0, scr, r, lane);
    }
    for (int it = C.gw; it < 4 * 32 * 8; it += C.NGW) {
        const int kq = it & 7, g = it >> 8, k0 = ((it >> 3) & 31) * 32, kl = lane & 31, pq = lane >> 5;
        LAS float* tile = scr;
        LAS float* ct = scr + 32 * 65;
        { float s, c; sincospif((float)lane * (1.0f / 32.0f), &s, &c); ct[lane] = c; ct[64 + lane] = s; }
#pragma unroll 8
        for (int kk = 0; kk < 32; ++kk) tile[kk * 65 + lane] = Win[(size_t)(k0 + kk) * NIN_ORIG + g * 64 + lane];
        LDS_WAIT(); asm volatile("" ::: "memory");
        float p[8];
#pragma unroll
        for (int j = 0; j < 8; ++j) p[j] = 0.f;
#pragma unroll 4
        for (int c = 0; c < 64; ++c) { const float wv = tile[kl * 65 + c];
#pragma unroll
            for (int j = 0; j < 8; ++j) p[j] += wv * ct[pq * 64 + ((c * (kq * 8 + j)) & 63)]; }
#pragma unroll
        for (int j = 0; j < 8; ++j) win_t[(size_t)(pq * 256 + g * 64 + kq * 8 + j) * DM + k0 + kl] = (bf16)f2bf(p[j]);
        LDS_WAIT(); asm volatile("" ::: "memory");
    }
}
__device__ __forceinline__ void ph_prenorm(const Ctx& C, const float* xl, const float* xc, const float* gn, bf16* dst, u64* rs, int row_begin, int row_end, const float* part, const float* pgate) {
    const int lane = C.lane();
    for (int row = row_begin + C.gw; row < row_end; row += C.NGW) {
        const bool isc = row >= ML; const int grp = isc ? 4 : (row >> 13);
        const float* xr = isc ? xc + (size_t)(row - ML) * DM : xl + (size_t)row * DM;
        f32x4 v[4]; float s2 = 0.f;
#pragma unroll
        for (int j = 0; j < 4; ++j) { v[j] = *(const f32x4*)(xr + 4 * lane + 256 * j);
            if (part != nullptr && isc) {
                const size_t po = (size_t)(row - ML) * DM + 4 * lane + 256 * j;
                const f32x4 ps = (*(const f32x4*)(part + po) + *(const f32x4*)(part + po + 1048576)) + (*(const f32x4*)(part + po + 2 * 1048576) + *(const f32x4*)(part + po + 3 * 1048576));
                v[j] = v[j] + *(const f32x4*)(pgate + 4 * lane + 256 * j) * ps; }
            s2 += (v[j].x * v[j].x + v[j].y * v[j].y) + (v[j].z * v[j].z + v[j].w * v[j].w); }
        s2 = wave_sum(s2);
        if (lane == 0) rs[row] = (u64)(s2 * 16777216.0f + 0.5f);
#pragma unroll
        for (int j = 0; j < 4; ++j) { const int c0 = 4 * lane + 256 * j; const f32x4 y = v[j] * *(const f32x4*)(gn + grp * DM + c0);
            v2u o; o.x = pk2(y.x, y.y); o.y = pk2(y.z, y.w); *(v2u*)(dst + (size_t)row * DM + c0) = o; }
    }
}
__device__ __forceinline__ void ph_mixers(const Ctx& C, int l) {
    const bf16* pxa = WSP(const bf16, WS_PXA); bf16* mix = WSP(bf16, WS_HX);
    const float* cw = ARGF(A_CONVW) + l * 3 * 256;
    const int nrows = l == 0 ? MT : ML;
    for (int e = C.gt(); e < nrows * 32; e += C.NGT) {
        const int row = e >> 5, ch = (e & 31) * 8;
        const int pos = row < ML ? (row & (SEQ - 1)) : ((row - ML) & 255), len = row < ML ? SEQ : 256;
        const bf16* pr = pxa + (size_t)row * NPXA;
        const v4u u1 = *(const v4u*)(pr + OFF_CU + ch), c1 = *(const v4u*)(pr + OFF_CC + ch), b1 = *(const v4u*)(pr + OFF_CB + ch);
        v4u u0 = (v4u){0, 0, 0, 0}, c0 = u0, u2 = u0, c2 = u0;
        if (pos > 0) { u0 = *(const v4u*)(pr - NPXA + OFF_CU + ch); c0 = *(const v4u*)(pr - NPXA + OFF_CC + ch); }
        if (pos < len - 1) { u2 = *(const v4u*)(pr + NPXA + OFF_CU + ch); c2 = *(const v4u*)(pr + NPXA + OFF_CC + ch); }
        float o[8]; float w0[8], w1[8], w2[8];
        { const f32x4 t0 = *(const f32x4*)(cw + ch), t1 = *(const f32x4*)(cw + ch + 4), t2 = *(const f32x4*)(cw + 256 + ch), t3 = *(const f32x4*)(cw + 256 + ch + 4), t4 = *(const f32x4*)(cw + 512 + ch), t5 = *(const f32x4*)(cw + 512 + ch + 4);
#pragma unroll
          for (int j = 0; j < 4; ++j) { w0[j] = t0[j]; w0[4 + j] = t1[j]; w1[j] = t2[j]; w1[4 + j] = t3[j]; w2[j] = t4[j]; w2[4 + j] = t5[j]; } }
#pragma unroll
        for (int j = 0; j < 4; ++j) {
            const unsigned a0 = u0[j], d0 = c0[j], a1 = u1[j], d1 = c1[j], a2 = u2[j], d2 = c2[j], bb = b1[j];
            o[2 * j] = bflo(bb) * (w0[2 * j] * bflo(a0) * bflo(d0) + w1[2 * j] * bflo(a1) * bflo(d1) + w2[2 * j] * bflo(a2) * bflo(d2));
            o[2 * j + 1] = bfhi(bb) * (w0[2 * j + 1] * bfhi(a0) * bfhi(d0) + w1[2 * j + 1] * bfhi(a1) * bfhi(d1) + w2[2 * j + 1] * bfhi(a2) * bfhi(d2));
        }
        v4u w; w.x = pk2(o[0], o[1]); w.y = pk2(o[2], o[3]); w.z = pk2(o[4], o[5]); w.w = pk2(o[6], o[7]);
        *(v4u*)(mix + (size_t)row * DM + 256 + ch) = w;
    }
}

typedef short bf16x8_t __attribute__((ext_vector_type(8)));
typedef short v4i16_t __attribute__((ext_vector_type(4)));
constexpr int AT_KW = 0, AT_VW = 73728, AT_BT = 147456;
template <bool WIN>
__device__ __forceinline__ void attn_qk(LAS unsigned char* lds, const int (&ka)[2][2], int rowoff0, const bf16x8_t (&qf)[2], f32x4 (&s)[8][2]) {
    constexpr int RS = WIN ? 8192 : 4096;
#pragma unroll
    for (int j = 0; j < 8; ++j)
#pragma unroll
        for (int t = 0; t < 2; ++t) { s[j][t] = (f32x4){0.f, 0.f, 0.f, 0.f};
#pragma unroll
            for (int ks = 0; ks < 2; ++ks) { const bf16x8_t kf = *(const LAS bf16x8_t*)(lds + ka[t][ks] + rowoff0 + j * RS); s[j][t] = __builtin_amdgcn_mfma_f32_16x16x32_bf16(kf, qf[ks], s[j][t], 0, 0, 0); } }
}
template <bool WIN>
__device__ __forceinline__ void attn_sm_pv(LAS unsigned char* lds, f32x4 (&s)[8][2], const int (&va)[2][4], int rowoff0,
                                           const LAS float* brow  , const int (&dcs)[4]  , unsigned vmask  ,
                                           f32x4 (&o)[4], f32x4& osum, float& m) {
    constexpr float SC = 0.18033688011112042f;
    constexpr int RS = WIN ? 8192 : 4096;
    const v4u onesw = (v4u){0x3F803F80u, 0x3F803F80u, 0x3F803F80u, 0x3F803F80u}; const bf16x8_t ones = __builtin_bit_cast(bf16x8_t, onesw);
    if constexpr (WIN) {
        const bool v0 = vmask & 1u, v1 = vmask & 2u, v2 = vmask & 4u, v3 = vmask & 8u;
        const unsigned hm01 = (v0 ? 0xFFFFu : 0u) | (v1 ? 0xFFFF0000u : 0u), hm23 = (v2 ? 0xFFFFu : 0u) | (v3 ? 0xFFFF0000u : 0u);
        float tmax = -1e30f;
#pragma unroll
        for (int j = 0; j < 8; ++j) {
            f32x4 v;
            v[0] = (v0 ? s[j][0][0] : s[j][1][0]) * SC + brow[j * 31 + dcs[0]]; v[1] = (v1 ? s[j][0][1] : s[j][1][1]) * SC + brow[j * 31 + dcs[1]];
            v[2] = (v2 ? s[j][0][2] : s[j][1][2]) * SC + brow[j * 31 + dcs[2]]; v[3] = (v3 ? s[j][0][3] : s[j][1][3]) * SC + brow[j * 31 + dcs[3]];
            s[j][0] = v; tmax = fmaxf(tmax, fmaxf(fmaxf(v[0], v[1]), fmaxf(v[2], v[3]))); }
        tmax = fmaxf(tmax, __shfl_xor(tmax, 16)); tmax = fmaxf(tmax, __shfl_xor(tmax, 32));
        const float mn = fmaxf(m, tmax), alpha = __builtin_amdgcn_exp2f(m - mn); m = mn;
#pragma unroll
        for (int db = 0; db < 4; ++db) o[db] = o[db] * alpha;
        osum = osum * alpha;
#pragma unroll
        for (int j = 0; j < 8; ++j) {
            const unsigned p01 = pg8::cvt_pk_bf16(__builtin_amdgcn_exp2f(s[j][0][0] - mn), __builtin_amdgcn_exp2f(s[j][0][1] - mn)), p23 = pg8::cvt_pk_bf16(__builtin_amdgcn_exp2f(s[j][0][2] - mn), __builtin_amdgcn_exp2f(s[j][0][3] - mn));
            v4u pw; pw.x = p01 & hm01; pw.y = p23 & hm23; pw.z = p01 & ~hm01; pw.w = p23 & ~hm23;
            const bf16x8_t pf = __builtin_bit_cast(bf16x8_t, pw);
            osum = __builtin_amdgcn_mfma_f32_16x16x32_bf16(ones, pf, osum, 0, 0, 0);
#pragma unroll
            for (int db = 0; db < 4; ++db) {
                const v4i16_t lo = __builtin_amdgcn_ds_read_tr16_b64_v4i16((LAS v4i16_t*)(lds + va[0][db] + rowoff0 + j * RS));
                const v4i16_t hi = __builtin_amdgcn_ds_read_tr16_b64_v4i16((LAS v4i16_t*)(lds + va[1][db] + rowoff0 + j * RS));
                const bf16x8_t vf = (bf16x8_t){lo[0], lo[1], lo[2], lo[3], hi[0], hi[1], hi[2], hi[3]};
                o[db] = __builtin_amdgcn_mfma_f32_16x16x32_bf16(vf, pf, o[db], 0, 0, 0);
            }
        }
    } else {
        float tmax = -1e30f;
#pragma unroll
        for (int j = 0; j < 8; ++j)
#pragma unroll
            for (int t = 0; t < 2; ++t) tmax = fmaxf(tmax, fmaxf(fmaxf(s[j][t][0], s[j][t][1]), fmaxf(s[j][t][2], s[j][t][3])));
        tmax = fmaxf(tmax, __shfl_xor(tmax, 16)); tmax = fmaxf(tmax, __shfl_xor(tmax, 32));
        const float mn = fmaxf(m, tmax * SC), alpha = __builtin_amdgcn_exp2f(m - mn); m = mn;
#pragma unroll
        for (int db = 0; db < 4; ++db) o[db] = o[db] * alpha;
        osum = osum * alpha;
#pragma unroll
        for (int j = 0; j < 8; ++j) {
            v4u pw;
            pw.x = pg8::cvt_pk_bf16(__builtin_amdgcn_exp2f(s[j][0][0] * SC - mn), __builtin_amdgcn_exp2f(s[j][0][1] * SC - mn)); pw.y = pg8::cvt_pk_bf16(__builtin_amdgcn_exp2f(s[j][0][2] * SC - mn), __builtin_amdgcn_exp2f(s[j][0][3] * SC - mn));
            pw.z = pg8::cvt_pk_bf16(__builtin_amdgcn_exp2f(s[j][1][0] * SC - mn), __builtin_amdgcn_exp2f(s[j][1][1] * SC - mn)); pw.w = pg8::cvt_pk_bf16(__builtin_amdgcn_exp2f(s[j][1][2] * SC - mn), __builtin_amdgcn_exp2f(s[j][1][3] * SC - mn));
            const bf16x8_t pf = __builtin_bit_cast(bf16x8_t, pw);
            osum = __builtin_amdgcn_mfma_f32_16x16x32_bf16(ones, pf, osum, 0, 0, 0);
#pragma unroll
            for (int db = 0; db < 4; ++db) {
                const v4i16_t lo = __builtin_amdgcn_ds_read_tr16_b64_v4i16((LAS v4i16_t*)(lds + va[0][db] + rowoff0 + j * RS));
                const v4i16_t hi = __builtin_amdgcn_ds_read_tr16_b64_v4i16((LAS v4i16_t*)(lds + va[1][db] + rowoff0 + j * RS));
                const bf16x8_t vf = (bf16x8_t){lo[0], lo[1], lo[2], lo[3], hi[0], hi[1], hi[2], hi[3]};
                o[db] = __builtin_amdgcn_mfma_f32_16x16x32_bf16(vf, pf, o[db], 0, 0, 0);
            }
        }
    }
}
template <bool WIN>
__device__ __forceinline__ void attn_block(LAS unsigned char* lds, const int (&ka)[2][2], const int (&va)[2][4], int rowoff0, const bf16x8_t (&qf)[2],
                                           const LAS float* brow, const int (&dcs)[4], unsigned vmask, f32x4 (&o)[4], f32x4& osum, float& m) {
    f32x4 s[8][2];
    attn_qk<WIN>(lds, ka, rowoff0, qf, s);
    attn_sm_pv<WIN>(lds, s, va, rowoff0, brow, dcs, vmask, o, osum, m);
}
__device__ __forceinline__ void attn_addr(int kc0off, int li, int fq, int (&ka)[2][2], int (&va)[2][4]) {
#pragma unroll
    for (int t = 0; t < 2; ++t) {
        const int rk = kc0off + 16 * t + li;
#pragma unroll
        for (int ks = 0; ks < 2; ++ks) ka[t][ks] = AT_KW + rk * 128 + (((4 * ks + fq) ^ ((rk >> 1) & 7)) * 16);
        const int rv = kc0off + 16 * t + 4 * fq + (li >> 2), p = li & 3;
#pragma unroll
        for (int db = 0; db < 4; ++db) va[t][db] = AT_VW + rv * 128 + (((2 * db + (p >> 1)) ^ (((rv >> 1) & 3) << 1)) * 16) + (p & 1) * 8;
    }
}

__device__ __forceinline__ void ph_ctx_dft(const Ctx& C) {
    if (C.bx >= 32) return;
    constexpr int DF_Q = 32768, DF_TW = AT_VW + 65536;
    static_assert(DF_TW + 2048 <= AT_BT, "ctx dft lds");
    const float2* tw = WSP(const float2, WS_TW); const bf16* pxa = WSP(const bf16, WS_PXA); bf16* mix = WSP(bf16, WS_HX);
    LAS unsigned char* lds = C.lds; LAS float* twl = (LAS float*)(lds + DF_TW);
    const int lane = C.lane(), w = C.wave, li = lane & 15, fq = lane >> 4, tid = C.tid();
    const int b = C.bx >> 3, kcb = (C.bx >> 1) & 3, kh = C.bx & 1;
    if (tid < 256) { const float2 v = tw[tid * 32]; twl[2 * tid] = v.x; twl[2 * tid + 1] = v.y; }
    for (int p = w; p < 32; p += 8) {
        const int tokl = p * 8 + (lane >> 3), cp = lane & 7;
        const bf16* src = pxa + ((size_t)ML + b * 256 + tokl) * NPXA + kcb * 64 + ((cp ^ (((tokl >> 1) & 3) << 1)) * 8);
        __builtin_amdgcn_global_load_lds((const unsigned*)(src + OFF_P), (LAS unsigned*)(lds + AT_VW + p * 1024), 16, 0, 0);
        __builtin_amdgcn_global_load_lds((const unsigned*)(src + OFF_Q), (LAS unsigned*)(lds + AT_VW + DF_Q + p * 1024), 16, 0, 0);
    }
    int ka[2][2], va[2][4]; attn_addr(0, li, fq, ka, va);
    asm volatile("s_waitcnt vmcnt(0) lgkmcnt(0)" ::: "memory");
    __syncthreads();
    const int k = 128 * kh + 16 * w + li;
    f32x4 o[4];
#pragma unroll
    for (int db = 0; db < 4; ++db) o[db] = (f32x4){0.f, 0.f, 0.f, 0.f};
#pragma unroll 2
    for (int j = 0; j < 8; ++j) {
        float cs[8], sn[8];
#pragma unroll
        for (int t = 0; t < 2; ++t)
#pragma unroll
            for (int i = 0; i < 4; ++i) { const int n = 32 * j + 16 * t + 4 * fq + i, idx = (n * k) & 255; cs[4 * t + i] = twl[2 * idx]; sn[4 * t + i] = -twl[2 * idx + 1]; }
        v4u cw, sw;
        cw.x = pg8::cvt_pk_bf16(cs[0], cs[1]); cw.y = pg8::cvt_pk_bf16(cs[2], cs[3]); cw.z = pg8::cvt_pk_bf16(cs[4], cs[5]); cw.w = pg8::cvt_pk_bf16(cs[6], cs[7]);
        sw.x = pg8::cvt_pk_bf16(sn[0], sn[1]); sw.y = pg8::cvt_pk_bf16(sn[2], sn[3]); sw.z = pg8::cvt_pk_bf16(sn[4], sn[5]); sw.w = pg8::cvt_pk_bf16(sn[6], sn[7]);
        const bf16x8_t cf = __builtin_bit_cast(bf16x8_t, cw), sf = __builtin_bit_cast(bf16x8_t, sw);
#pragma unroll
        for (int db = 0; db < 4; ++db) {
            const v4i16_t plo = __builtin_amdgcn_ds_read_tr16_b64_v4i16((LAS v4i16_t*)(lds + va[0][db] + j * 4096)), phi = __builtin_amdgcn_ds_read_tr16_b64_v4i16((LAS v4i16_t*)(lds + va[1][db] + j * 4096));
            const v4i16_t qlo = __builtin_amdgcn_ds_read_tr16_b64_v4i16((LAS v4i16_t*)(lds + va[0][db] + DF_Q + j * 4096)), qhi = __builtin_amdgcn_ds_read_tr16_b64_v4i16((LAS v4i16_t*)(lds + va[1][db] + DF_Q + j * 4096));
            const bf16x8_t pf = (bf16x8_t){plo[0], plo[1], plo[2], plo[3], phi[0], phi[1], phi[2], phi[3]}, qf = (bf16x8_t){qlo[0], qlo[1], qlo[2], qlo[3], qhi[0], qhi[1], qhi[2], qhi[3]};
            o[db] = __builtin_amdgcn_mfma_f32_16x16x32_bf16(pf, cf, o[db], 0, 0, 0);
            o[db] = __builtin_amdgcn_mfma_f32_16x16x32_bf16(qf, sf, o[db], 0, 0, 0);
        }
    }
    bf16* op = mix + ((size_t)ML + b * 256 + k) * DM + kcb * 64 + 4 * fq;
#pragma unroll
    for (int db = 0; db < 4; ++db) { v2u ov; ov.x = pk2(o[db][0] * (1.0f / 128.0f), o[db][1] * (1.0f / 128.0f)); ov.y = pk2(o[db][2] * (1.0f / 128.0f), o[db][3] * (1.0f / 128.0f)); *(v2u*)(op + 16 * db) = ov; }
}

__device__ __forceinline__ size_t zt_off(int b) { return b < 2 ? WS_TB + (size_t)b * 8 * MiB : (b == 2 ? (size_t)502 * MiB : WS_WIN); }
__device__ __forceinline__ void ph_t1(const Ctx& C) {
    const bf16* pxa = WSP(const bf16, WS_PXA); const int lane = C.lane();
    LAS unsigned short* tile = (LAS unsigned short*)(C.lds + C.wave * 9216);
    for (int it = C.gw; it < 4 * 2 * 128 * 4; it += C.NGW) {
        const int kcb = it & 3, n2 = (it >> 2) & 127, pq = (it >> 9) & 1, b = it >> 10;
#pragma unroll
        for (int i = 0; i < 8; ++i) { const int q = i * 64 + lane, n1 = q >> 3, cc = q & 7;
            const v4u v = *(const v4u*)(pxa + ((size_t)b * SEQ + n1 * 128 + n2) * NPXA + pq * 256 + kcb * 64 + cc * 8);
            *(LAS v4u*)(tile + n1 * 72 + cc * 8) = v; }
        LDS_WAIT(); asm volatile("" ::: "memory");
        bf16* zt = WSP(bf16, zt_off(b)) + ((size_t)(pq * 256 + kcb * 64 + lane) * SEQ + n2 * 64);
#pragma unroll
        for (int c = 0; c < 8; ++c) { v4u o;
            o.x = (unsigned)tile[(8 * c + 0) * 72 + lane] | ((unsigned)tile[(8 * c + 1) * 72 + lane] << 16); o.y = (unsigned)tile[(8 * c + 2) * 72 + lane] | ((unsigned)tile[(8 * c + 3) * 72 + lane] << 16);
            o.z = (unsigned)tile[(8 * c + 4) * 72 + lane] | ((unsigned)tile[(8 * c + 5) * 72 + lane] << 16); o.w = (unsigned)tile[(8 * c + 6) * 72 + lane] | ((unsigned)tile[(8 * c + 7) * 72 + lane] << 16);
            *(v4u*)(zt + 8 * c) = o; }
        LDS_WAIT(); asm volatile("" ::: "memory");
    }
}
typedef float f32x16 __attribute__((ext_vector_type(16)));
constexpr int FT_C64 = 0, FT_S64 = 9216, FT_C128 = 18432, FT_S128 = FT_C128 + 34816, FT_TA = FT_S128 + 34816, FT_TR = FT_TA + 4096, FT_ST = FT_TR + 8192;
static_assert(FT_ST + 32768 <= LDSCTL_OFF, "fft lds");
__device__ __forceinline__ void hw_sincos_rev(float rev, float& sn, float& cs) { sn = __builtin_amdgcn_sinf(rev); cs = __builtin_amdgcn_cosf(rev); }
__device__ __forceinline__ int crow16(int r, int h) { return (r & 3) + 8 * (r >> 2) + 4 * h; }
__device__ __forceinline__ void ph_fft(const Ctx& C) {
    LAS unsigned char* lds = C.lds; const int tid = C.tid(), lane = C.lane(), w = C.wave, h = lane >> 5, c = lane & 31;
    const float2* tw = WSP(const float2, WS_TW); bf16* mix = WSP(bf16, WS_HX);
    { LAS unsigned short* c64 = (LAS unsigned short*)(lds + FT_C64); LAS unsigned short* s64 = (LAS unsigned short*)(lds + FT_S64);
#pragma unroll 4
      for (int e = tid; e < 4096; e += NTHR) { const int k1 = e >> 6, n1 = e & 63; float sn, cs; hw_sincos_rev(0.5f * ((float)((n1 * k1) & 63) * (1.0f / 32.0f)), sn, cs); c64[k1 * 72 + n1] = (unsigned short)f2bf(cs); s64[k1 * 72 + n1] = (unsigned short)f2bf(sn); }
      LAS unsigned short* c128 = (LAS unsigned short*)(lds + FT_C128); LAS unsigned short* s128 = (LAS unsigned short*)(lds + FT_S128);
#pragma unroll 4
      for (int e = tid; e < 16384; e += NTHR) { const int k2 = e >> 7, p = e & 127, q = p & 15, n2 = (p & ~15) + (q & 3) + ((q >> 2) & 1) * 8 + ((q >> 3) & 1) * 4;
          float sn, cs; hw_sincos_rev(0.5f * ((float)((n2 * k2) & 127) * (1.0f / 64.0f)), sn, cs); c128[k2 * 136 + p] = (unsigned short)f2bf(cs); s128[k2 * 136 + p] = (unsigned short)f2bf(sn); }
      LAS float* ta = (LAS float*)(lds + FT_TA); LAS float* trt = (LAS float*)(lds + FT_TR);
      { const int e = tid, g = e >> 6, kk = e & 63; float sn, cs; hw_sincos_rev(0.5f * ((float)((32 * (g >> 1) + 4 * (g & 1)) * kk) * (1.0f / 4096.0f)), sn, cs); ta[2 * e] = cs; ta[2 * e + 1] = sn; }
      for (int e = tid; e < 1024; e += NTHR) { const int r = e >> 6, kk = e & 63; float sn, cs; hw_sincos_rev(0.5f * ((float)(crow16(r, 0) * kk) * (1.0f / 4096.0f)), sn, cs); trt[2 * e] = cs; trt[2 * e + 1] = sn; }
    }
    __syncthreads();
    const int vcu = (C.G % 8 == 0) ? (C.bx % 8) * (C.G / 8) + C.bx / 8 : C.bx;
    for (int it = vcu; it < 256; it += C.G) {
        const int kb = it & 1, kcg = (it >> 1) & 31, b = it >> 6, kc = kcg * 8 + w, k1 = 32 * kb + c;
        const bf16* zp = WSP(const bf16, zt_off(b)) + (size_t)kc * SEQ; const bf16* zq = zp + (size_t)256 * SEQ;
        f32x16 acc[4];
#pragma unroll
        for (int rb2 = 0; rb2 < 4; ++rb2) acc[rb2] = (f32x16){};
#pragma unroll 1
        for (int rb = 0; rb < 4; ++rb) {
            const int n2 = 32 * rb + c;
            f32x16 xr = {}, xi = {};
#pragma unroll
            for (int ks = 0; ks < 4; ++ks) {
                const bf16x8_t cf = *(const LAS bf16x8_t*)(lds + FT_C64 + (k1 * 72 + 16 * ks + 8 * h) * 2), sf = *(const LAS bf16x8_t*)(lds + FT_S64 + (k1 * 72 + 16 * ks + 8 * h) * 2);
                const bf16x8_t pf = *(const bf16x8_t*)(zp + n2 * 64 + 16 * ks + 8 * h), qf = *(const bf16x8_t*)(zq + n2 * 64 + 16 * ks + 8 * h);
                const v4u t = __builtin_bit_cast(v4u, qf) ^ 0x80008000u; const bf16x8_t qn = __builtin_bit_cast(bf16x8_t, t);
                xr = __builtin_amdgcn_mfma_f32_32x32x16_bf16(pf, cf, xr, 0, 0, 0); xi = __builtin_amdgcn_mfma_f32_32x32x16_bf16(pf, sf, xi, 0, 0, 0);
                xi = __builtin_amdgcn_mfma_f32_32x32x16_bf16(qf, cf, xi, 0, 0, 0); xr = __builtin_amdgcn_mfma_f32_32x32x16_bf16(qn, sf, xr, 0, 0, 0); }
            bf16x8_t bre[2], bim[2];
            const LAS float* tap = (const LAS float*)(lds + FT_TA) + 2 * ((rb * 2 + h) * 64 + k1); const float ac_ = tap[0], as_ = tap[1];
            const LAS float* trp = (const LAS float*)(lds + FT_TR) + 2 * k1;
#pragma unroll
            for (int sblk = 0; sblk < 2; ++sblk) {
                float tr[8], ti[8];
#pragma unroll
                for (int r8 = 0; r8 < 8; ++r8) { const int r = 8 * sblk + r8; const float rc = trp[128 * r], rs = trp[128 * r + 1]; const float tc = ac_ * rc - as_ * rs, ts = ac_ * rs + as_ * rc;
                    tr[r8] = xr[r] * tc - xi[r] * ts; ti[r8] = -(xr[r] * ts + xi[r] * tc); }
                v4u a, bq;
                a.x = pg8::cvt_pk_bf16(tr[0], tr[1]); a.y = pg8::cvt_pk_bf16(tr[2], tr[3]); a.z = pg8::cvt_pk_bf16(tr[4], tr[5]); a.w = pg8::cvt_pk_bf16(tr[6], tr[7]);
                bq.x = pg8::cvt_pk_bf16(ti[0], ti[1]); bq.y = pg8::cvt_pk_bf16(ti[2], ti[3]); bq.z = pg8::cvt_pk_bf16(ti[4], ti[5]); bq.w = pg8::cvt_pk_bf16(ti[6], ti[7]);
                bre[sblk] = __builtin_bit_cast(bf16x8_t, a); bim[sblk] = __builtin_bit_cast(bf16x8_t, bq); }
#pragma unroll
            for (int rb2 = 0; rb2 < 4; ++rb2) {
                const int k2 = 32 * rb2 + c;
#pragma unroll
                for (int sblk = 0; sblk < 2; ++sblk) {
                    const bf16x8_t ac = *(const LAS bf16x8_t*)(lds + FT_C128 + (k2 * 136 + 32 * rb + 16 * sblk + 8 * h) * 2), as = *(const LAS bf16x8_t*)(lds + FT_S128 + (k2 * 136 + 32 * rb + 16 * sblk + 8 * h) * 2);
                    acc[rb2] = __builtin_amdgcn_mfma_f32_32x32x16_bf16(ac, bre[sblk], acc[rb2], 0, 0, 0); acc[rb2] = __builtin_amdgcn_mfma_f32_32x32x16_bf16(as, bim[sblk], acc[rb2], 0, 0, 0); }
            }
        }
#pragma unroll
        for (int rb2 = 0; rb2 < 4; ++rb2) {
            LAS unsigned short* st = (LAS unsigned short*)(lds + FT_ST + (rb2 & 1) * 16384);
#pragma unroll
            for (int r = 0; r < 16; ++r) st[((crow16(r, h) * 32 + c) * 8) + w] = (unsigned short)f2bf(acc[rb2][r] * 0.001381067932f);
            LDS_WAIT(); __syncthreads();
#pragma unroll
            for (int j = 0; j < 2; ++j) { const int idx = tid + 512 * j, k2l = idx >> 5, k1l = idx & 31;
                const v4u v = *(const LAS v4u*)(st + idx * 8);
                *(v4u*)(mix + ((size_t)b * SEQ + 32 * kb + k1l + 64 * (32 * rb2 + k2l)) * DM + kcg * 8) = v; }
        }
        __syncthreads();
    }
}
__device__ __forceinline__ void attn_stage_win(LAS unsigned char* lds, const bf16* pxa, int b, int h, int R0, int w, int lane, bool isV) {
    for (int p = w; p < 72; p += 8) {
        const int tokl = p * 8 + (lane >> 3), lr = tokl >> 6, col = tokl & 63, gr = min(R0 + lr, 127), cp = lane & 7;
        const bf16* src = pxa + ((size_t)b * SEQ + gr * 64 + col) * NPXA + h * 64;
        if (!isV) __builtin_amdgcn_global_load_lds((const unsigned*)(src + OFF_K + ((cp ^ ((tokl >> 1) & 7)) * 8)), (LAS unsigned*)(lds + AT_KW + p * 1024), 16, 0, 0);
        else __builtin_amdgcn_global_load_lds((const unsigned*)(src + OFF_V + ((cp ^ (((tokl >> 1) & 3) << 1)) * 8)), (LAS unsigned*)(lds + AT_VW + p * 1024), 16, 0, 0);
    }
}
__device__ __forceinline__ void attn_stage_ctx(LAS unsigned char* lds, const bf16* pxa, int b, int h, int w, int lane, bool isV) {
    for (int p = w; p < 32; p += 8) {
        const int tokl = p * 8 + (lane >> 3), cp = lane & 7;
        const bf16* src = pxa + ((size_t)ML + b * 256 + tokl) * NPXA + h * 64;
        if (!isV) __builtin_amdgcn_global_load_lds((const unsigned*)(src + OFF_K + ((cp ^ ((tokl >> 1) & 7)) * 8)), (LAS unsigned*)(lds + AT_KW + p * 1024), 16, 0, 0);
        else __builtin_amdgcn_global_load_lds((const unsigned*)(src + OFF_V + ((cp ^ (((tokl >> 1) & 3) << 1)) * 8)), (LAS unsigned*)(lds + AT_VW + p * 1024), 16, 0, 0);
    }
}
#define AT_BAR() do { asm volatile("s_waitcnt lgkmcnt(0)" ::: "memory"); __builtin_amdgcn_s_barrier(); asm volatile("" ::: "memory"); } while (0)
__device__ __forceinline__ void ph_attn(const Ctx& C, int l) {
    const bf16* pxa = WSP(const bf16, WS_PXA); bf16* mix = WSP(bf16, WS_HX);
    const float* rb = ARGF(A_RELB) + (size_t)l * 8 * 15 * 31;
    LAS unsigned char* lds = C.lds; LAS float* biasT = (LAS float*)(lds + AT_BT);
    const int lane = C.lane(), w = C.wave, fq = lane >> 4, li = lane & 15, tid = C.tid(), tb = min(tid, 464);
    const int vcu = (C.G % 8 == 0) ? (C.bx % 8) * (C.G / 8) + C.bx / 8 : C.bx;
    __syncthreads();
    int u = vcu;
    if (u < 2048) {
        int b = u >> 9, h = (u >> 6) & 7, rp = u & 63, R0 = min(max(2 * rp - 4, 0), 120);
        attn_stage_win(lds, pxa, b, h, R0, w, lane, false); attn_stage_win(lds, pxa, b, h, R0, w, lane, true);
        bf16x8_t qf[2];
        { const size_t token = (size_t)b * SEQ + (2 * rp + (w >> 2)) * 64 + 16 * (w & 3) + li;
#pragma unroll
          for (int ks = 0; ks < 2; ++ks) qf[ks] = *(const bf16x8_t*)(pxa + token * NPXA + OFF_QQ + h * 64 + 32 * ks + 8 * fq); }
        { const float bv = rb[h * 465 + tb] * 1.4426950408889634f; asm volatile("s_waitcnt vmcnt(0)" ::: "memory"); if (tid < 465) biasT[tid] = bv; }
        AT_BAR();
        for (;;) {
            const int un = u + C.G; const bool has_next = un < 2048;
            const int bn_ = un >> 9, hn = (un >> 6) & 7, rpn = un & 63, R0n = min(max(2 * rpn - 4, 0), 120);
            const int r = 2 * rp + (w >> 2), qc = 16 * (w & 3) + li; const size_t token = (size_t)b * SEQ + r * 64 + qc;
            f32x4 o[4], osum = (f32x4){0.f, 0.f, 0.f, 0.f}; float m = -1e30f;
#pragma unroll
            for (int db = 0; db < 4; ++db) o[db] = (f32x4){0.f, 0.f, 0.f, 0.f};
            int ka[2][2], va[2][4], dcs[4];
            const int cb = w & 3, kc0 = cb == 0 ? 0 : cb == 1 ? 8 : cb == 2 ? 24 : 32;
            attn_addr(kc0, li, fq, ka, va);
            const int csq = min(max(qc - 8, 0), 48); unsigned vmask = 0u;
#pragma unroll
            for (int i = 0; i < 4; ++i) { const int kc_ = kc0 + 4 * fq + i; const bool in0 = kc_ >= csq && kc_ < csq + 16; if (in0) vmask |= 1u << i; dcs[i] = min(max((in0 ? kc_ : kc_ + 16) - qc + 15, 0), 30); }
            const int rsr = min(max(r - 4, 0), 120), lr0 = rsr - R0;
            f32x4 s[8][2];
            attn_qk<true>(lds, ka, lr0 * 8192, qf, s);
            asm volatile("s_waitcnt vmcnt(0)" ::: "memory");
            AT_BAR();
            attn_stage_ctx(lds, pxa, b, h, w, lane, false);
            asm volatile("" ::: "memory");
            bf16x8_t qn[2] = {qf[0], qf[1]}; float bnv = 0.f;
            if (has_next) { const size_t tokn = (size_t)bn_ * SEQ + (2 * rpn + (w >> 2)) * 64 + 16 * (w & 3) + li;
#pragma unroll
                for (int ks = 0; ks < 2; ++ks) qn[ks] = *(const bf16x8_t*)(pxa + tokn * NPXA + OFF_QQ + hn * 64 + 32 * ks + 8 * fq);
                bnv = rb[hn * 465 + tb]; }
            asm volatile("" ::: "memory");
            attn_sm_pv<true>(lds, s, va, lr0 * 8192, biasT + (rsr - r + 7) * 31, dcs, vmask, o, osum, m);
            if (has_next) asm volatile("s_waitcnt vmcnt(3)" ::: "memory"); else asm volatile("s_waitcnt vmcnt(0)" ::: "memory");
            AT_BAR();
            attn_stage_ctx(lds, pxa, b, h, w, lane, true);
            attn_addr(0, li, fq, ka, va);
            attn_qk<false>(lds, ka, 0, qf, s);
            AT_BAR();
            if (has_next) attn_stage_win(lds, pxa, bn_, hn, R0n, w, lane, false);
            asm volatile("" ::: "memory");
            if (has_next) asm volatile("s_waitcnt vmcnt(9)" ::: "memory"); else asm volatile("s_waitcnt vmcnt(0)" ::: "memory");
            AT_BAR();
            attn_sm_pv<false>(lds, s, va, 0, (const LAS float*)nullptr, dcs, 0xfu, o, osum, m);
            asm volatile("s_waitcnt vmcnt(0)" ::: "memory");
            asm volatile("" : "+v"(qn[0]), "+v"(qn[1]), "+v"(bnv));
            if (has_next && tid < 465) biasT[tid] = bnv * 1.4426950408889634f;
            AT_BAR();
            { const float inv = __builtin_amdgcn_rcpf(osum[0]);
              bf16* op = mix + token * DM + 512 + h * 64 + 4 * fq;
#pragma unroll
              for (int db = 0; db < 4; ++db) { v2u ov; ov.x = pk2(o[db][0] * inv, o[db][1] * inv); ov.y = pk2(o[db][2] * inv, o[db][3] * inv); *(v2u*)(op + 16 * db) = ov; } }
            if (!has_next) break;
            attn_stage_win(lds, pxa, bn_, hn, R0n, w, lane, true);
            u = un; b = bn_; h = hn; rp = rpn; R0 = R0n; qf[0] = qn[0]; qf[1] = qn[1];
        }
    }
    if (l == 0 && vcu < 64) {
        const int v = vcu, b = v >> 4, h = (v >> 1) & 7, rp = v & 1;
        asm volatile("s_waitcnt vmcnt(0)" ::: "memory");
        __syncthreads();
        attn_stage_ctx(lds, pxa, b, h, w, lane, false); attn_stage_ctx(lds, pxa, b, h, w, lane, true);
        const size_t token = (size_t)ML + b * 256 + rp * 128 + 16 * w + li;
        bf16x8_t qf[2];
#pragma unroll
        for (int ks = 0; ks < 2; ++ks) qf[ks] = *(const bf16x8_t*)(pxa + token * NPXA + OFF_QQ + h * 64 + 32 * ks + 8 * fq);
        f32x4 o[4], osum = (f32x4){0.f, 0.f, 0.f, 0.f}; float m = -1e30f;
#pragma unroll
        for (int db = 0; db < 4; ++db) o[db] = (f32x4){0.f, 0.f, 0.f, 0.f};
        int ka[2][2], va[2][4], dcs[4] = {0, 0, 0, 0};
        attn_addr(0, li, fq, ka, va);
        asm volatile("s_waitcnt vmcnt(0)" ::: "memory");
        __syncthreads();
        attn_block<false>(lds, ka, va, 0, qf, (const LAS float*)nullptr, dcs, 0xfu, o, osum, m);
        const float inv = __builtin_amdgcn_rcpf(osum[0]);
        bf16* op = mix + token * DM + 512 + h * 64 + 4 * fq;
#pragma unroll
        for (int db = 0; db < 4; ++db) { v2u ov; ov.x = pk2(o[db][0] * inv, o[db][1] * inv); ov.y = pk2(o[db][2] * inv, o[db][3] * inv); *(v2u*)(op + 16 * db) = ov; }
    }
}

template <int KS>
__device__ __forceinline__ void wg_core(const bf16* A, const bf16* W, int li, int fq, f32x4 (&acc)[4][2]) {
    const bf16* ap = A + (size_t)li * DM + 8 * fq; const bf16* wp = W + (size_t)li * DM + 8 * fq;
    bf16x8_t af[4][4], wf[4][2];
#pragma unroll
    for (int s = 0; s < 3; ++s) {
#pragma unroll
        for (int m = 0; m < 4; ++m) af[s][m] = *(const bf16x8_t*)(ap + (size_t)(16 * m) * DM + 32 * s);
#pragma unroll
        for (int n = 0; n < 2; ++n) wf[s][n] = *(const bf16x8_t*)(wp + (size_t)(16 * n) * DM + 32 * s); }
#pragma unroll
    for (int s = 0; s < KS; ++s) {
        if (s + 3 < KS) {
#pragma unroll
            for (int m = 0; m < 4; ++m) af[(s + 3) & 3][m] = *(const bf16x8_t*)(ap + (size_t)(16 * m) * DM + 32 * (s + 3));
#pragma unroll
            for (int n = 0; n < 2; ++n) wf[(s + 3) & 3][n] = *(const bf16x8_t*)(wp + (size_t)(16 * n) * DM + 32 * (s + 3)); }
#pragma unroll
        for (int m = 0; m < 4; ++m)
#pragma unroll
            for (int n = 0; n < 2; ++n) acc[m][n] = __builtin_amdgcn_mfma_f32_16x16x32_bf16(wf[s & 3][n], af[s & 3][m], acc[m][n], 0, 0, 0);
    }
}
__device__ __forceinline__ void wg_merge_ctx(const Ctx& C) {
    if (C.wave >= 2) return;
    const bf16* mix = WSP(const bf16, WS_HX); const bf16* wm = WSP(const bf16, WS_WM); const bf16* pxg = WSP(const bf16, WS_PXG); bf16* mb = WSP(bf16, WS_M);
    const int lane = C.lane(), li = lane & 15, fq = lane >> 4;
    for (int it = C.wave * C.G + C.bx; it < 512; it += 2 * C.G) {
        const int r0 = ML + 64 * (it >> 5), c0 = 32 * (it & 31);
        f32x4 a0[4][2], a1[4][2], a2[4][2];
#pragma unroll
        for (int m = 0; m < 4; ++m)
#pragma unroll
            for (int n = 0; n < 2; ++n) { a0[m][n] = (f32x4){0.f, 0.f, 0.f, 0.f}; a1[m][n] = a0[m][n]; a2[m][n] = a0[m][n]; }
        const bf16* A = mix + (size_t)r0 * DM; const bf16* W = wm + (size_t)c0 * DM;
        wg_core<8>(A, W, li, fq, a0); wg_core<8>(A + 256, W + 256, li, fq, a1); wg_core<16>(A + 512, W + 512, li, fq, a2);
#pragma unroll
        for (int m = 0; m < 4; ++m)
#pragma unroll
            for (int n = 0; n < 2; ++n) { const size_t row = (size_t)(r0 + 16 * m + li); const int col = c0 + 16 * n + 4 * fq;
                const v2u g0 = *(const v2u*)(pxg + gate_elem(0, (int)row, col)), g1 = *(const v2u*)(pxg + gate_elem(1, (int)row, col)), g2 = *(const v2u*)(pxg + gate_elem(2, (int)row, col));
#define RL(x) __builtin_amdgcn_rcpf(bflo(x))
#define RH(x) __builtin_amdgcn_rcpf(bfhi(x))
                const float o0 = a0[m][n][0] * RL(g0.x) + a1[m][n][0] * RL(g1.x) + a2[m][n][0] * RL(g2.x), o1 = a0[m][n][1] * RH(g0.x) + a1[m][n][1] * RH(g1.x) + a2[m][n][1] * RH(g2.x);
                const float o2 = a0[m][n][2] * RL(g0.y) + a1[m][n][2] * RL(g1.y) + a2[m][n][2] * RL(g2.y), o3 = a0[m][n][3] * RH(g0.y) + a1[m][n][3] * RH(g1.y) + a2[m][n][3] * RH(g2.y);
#undef RL
#undef RH
                v2u w; w.x = cvt_pk_bf16(o0, o1); w.y = cvt_pk_bf16(o2, o3); *(v2u*)(mb + row * DM + col) = w; }
    }
}
__device__ __forceinline__ void wg_wo_ctx(const Ctx& C) {
    if (C.wave >= 2) return;
    const bf16* mb = WSP(const bf16, WS_M); const bf16* wo = WSP(const bf16, WS_WO); const float* base = ARGF(A_CTX); float* out = WSP(float, WS_CTXX);
    const float* gate = WSP(const float, WS_MOD) + 4 * NMOD + 2 * DM; const float* gn = WSP(const float, WS_GN) + (size_t)(1 * 5 + 4) * DM; bf16* ap = WSP(bf16, WS_HX); u64* rs = WSP(u64, WS_RS) + (size_t)1 * MT;
    const int lane = C.lane(), li = lane & 15, fq = lane >> 4;
    for (int it = C.wave * C.G + C.bx; it < 512; it += 2 * C.G) {
        const int r0 = 64 * (it >> 5), c0 = 32 * (it & 31);
        f32x4 acc[4][2];
#pragma unroll
        for (int m = 0; m < 4; ++m)
#pragma unroll
            for (int n = 0; n < 2; ++n) acc[m][n] = (f32x4){0.f, 0.f, 0.f, 0.f};
        wg_core<32>(mb + (size_t)(ML + r0) * DM, wo + (size_t)c0 * DM, li, fq, acc);
#pragma unroll
        for (int m = 0; m < 4; ++m) { const size_t rc = (size_t)(r0 + 16 * m + li); float ss = 0.f;
#pragma unroll
            for (int n = 0; n < 2; ++n) { const int col = c0 + 16 * n + 4 * fq;
                const f32x4 o = *(const f32x4*)(base + rc * DM + col) + *(const f32x4*)(gate + col) * acc[m][n];
                *(f32x4*)(out + rc * DM + col) = o;
                const f32x4 y = o * *(const f32x4*)(gn + col); v2u w; w.x = cvt_pk_bf16(y[0], y[1]); w.y = cvt_pk_bf16(y[2], y[3]); *(v2u*)(ap + (ML + rc) * DM + col) = w;
                ss += (o[0] * o[0] + o[1] * o[1]) + (o[2] * o[2] + o[3] * o[3]); }
            ss += __shfl_xor(ss, 16); ss += __shfl_xor(ss, 32);
            if (fq == 0) __hip_atomic_fetch_add(rs + ML + rc, (u64)(ss * 16777216.0f + 0.5f), __ATOMIC_RELAXED, __HIP_MEMORY_SCOPE_AGENT); }
    }
}
__device__ __forceinline__ void ph_final(const Ctx& C) {
    float* out = (float*)(GAS float*)ldarg(C, A_OUT); const float* fg = ARGF(A_FG); const int lane = C.lane();
    for (int row = C.gw; row < ML; row += C.NGW) {
        float* xr = out + (size_t)row * DM;
        f32x4 v[4]; float s2 = 0.f;
#pragma unroll
        for (int j = 0; j < 4; ++j) { v[j] = *(const f32x4*)(xr + 4 * lane + 256 * j); s2 += (v[j].x * v[j].x + v[j].y * v[j].y) + (v[j].z * v[j].z + v[j].w * v[j].w); }
        const float rstd = 1.0f / sqrtf(wave_sum(s2) * (1.0f / DM) + EPS);
#pragma unroll
        for (int j = 0; j < 4; ++j) { const int c0 = 4 * lane + 256 * j; const f32x4 gg = *(const f32x4*)(fg + c0); *(f32x4*)(xr + c0) = v[j] * rstd * gg; }
    }
}

struct Args { const void* p[A_NARGS]; int ph_lo, ph_hi; };

__global__ void __launch_bounds__(NTHR, 2) fwd_kernel(Args args) {
    extern __shared__ __attribute__((aligned(16))) unsigned char lds_raw[];
    LAS unsigned char* const lds0 = (LAS unsigned char*)lds_raw;
    const int wave0 = __builtin_amdgcn_readfirstlane(threadIdx.x >> 6);
    { const int t0 = threadIdx.x;
      for (int u = t0; u < (LDS_BYTES - LDSCTL_OFF) / 4; u += NTHR) ((LAS unsigned*)(lds0 + LDSCTL_OFF))[u] = 0u;
      __syncthreads();
      if (t0 < A_NARGS) ((LAS unsigned long long*)(lds0 + LARGS_OFF))[t0] = (unsigned long long)args.p[t0];
      __syncthreads(); }
    const int lo = args.ph_lo, hi = args.ph_hi;
    const unsigned xcc = xb_xcc_id();
    int vbx = blockIdx.x;
    if (!MK_MULTI) { Ctx C; C.lds = lds0; C.wave = wave0; gu32* ctl0 = (gu32*)WSP(unsigned, WS_CTL); (void)xcd_barrier_post((unsigned*)(ctl0 + CW_BAR), (volatile LAS unsigned*)(lds0 + MISC_OFF) + 8, C.tid() == 0); }
    for (int step = lo; step < hi; ++step) {
        const int ls = step - 2, l = ls >= NS ? 1 : 0, k = (step < 2) ? -1 - step : ls - l * NS;
        const int nrep = (PROBE_K != -99 && k == PROBE_K) ? PROBE_N : 1;
        for (int rep = 0; rep < nrep; ++rep) {
        Ctx C;
        C.lds = lds0; C.wave = wave0; C.G = gridDim.x; C.bx = vbx;
        asm volatile("" : "+s"(C.wave), "+s"(C.bx), "+s"(C.G));
        C.gw = C.bx * NWAVES + C.wave; C.NGW = C.G * NWAVES; C.NGT = C.G * NTHR;
        gu32* ctl = (gu32*)WSP(unsigned, WS_CTL);
        if (k == -1) { ph_mod_partial(C); __syncthreads(); ph_weights(C, 0); }
        else if (k == -2) ph_mod_reduce(C);
        else if (k == 0) {
            if (l == 1) ph_weights(C, l);
            ph_ctab(C, l);
            u64* rsb = WSP(u64, WS_RS) + (size_t)(l == 0 ? 0 : 2) * MT;
            if (l == 0) ph_prenorm(C, ARGF(A_X), ARGF(A_CTX), WSP(const float, WS_GN), WSP(bf16, WS_HX), rsb, 0, MT, (const float*)nullptr, (const float*)nullptr);
            else ph_prenorm(C, ARGF(A_OUT), WSP(const float, WS_CTXX), WSP(const float, WS_GN) + 2 * 5 * DM, WSP(bf16, WS_HX), rsb, ML, MT, WSP(const float, WS_PART), WSP(const float, WS_MOD) + 4 * NMOD + 5 * DM);
        } else if (k == 1) {
            pg8::Prob<false> P{WSP(const bf16, WS_HX), WSP(const bf16, WS_WIN), DM, DM, DM}; pg8::StaticOrder<NIN / 256> S; S.init(MT, NIN, C.G, C.bx);
            EpiIn E{WSP(bf16, WS_PXA), WSP(bf16, WS_PXG), WSP(const u64, WS_RS) + (size_t)(l == 0 ? 0 : 2) * MT, WSP(const float, WS_CIN) + (size_t)l * 5 * NIN};
            pg8::gemm_phase(C.lds, P, S, E, C.tid());
        } else if (k == 2) {
            const int sub = rep == 0 ? 7 : PROBE_SUB;
            if (sub & 1) ph_t1(C);
            if (sub & 2) { if (l == 0) ph_ctx_dft(C); ph_mixers(C, l); }
            if (sub & 4) ph_attn(C, l);
        } else if (k == 3) {
            ph_fft(C);
        } else if (k == 4) {
            pg8::Prob<false> P{WSP(const bf16, WS_HX), WSP(const bf16, WS_WM), DM, DM, DM}; pg8::StaticOrder<DM / 256> S; S.init(ML, DM, C.G, C.bx);
            EpiMerge E{WSP(bf16, WS_M), WSP(const bf16, WS_PXG)};
            pg8::gemm_phase(C.lds, P, S, E, C.tid());
            if (l == 0) wg_merge_ctx(C);
        } else if (k == 5) {
            pg8::Prob<false> P{WSP(const bf16, WS_M), WSP(const bf16, WS_WO), DM, DM, DM}; pg8::StaticOrder<DM / 256> S; S.init(ML, DM, C.G, C.bx);
            const float* gatev = rep > 0 ? WSP(const float, WS_ZERO) : WSP(const float, WS_MOD) + (size_t)l * 5 * NMOD + 2 * DM;
            const float* gnp = WSP(const float, WS_GN) + (size_t)(l * 2 + 1) * 5 * DM; u64* rsp = WSP(u64, WS_RS) + (size_t)(l == 0 ? 1 : 3) * MT;
            if (l == 0) { EpiRes<false> E{(const void*)ARGF(A_X), (bf16*)(GAS bf16*)ldarg(C, A_OUT), gatev, nullptr, gnp, WSP(bf16, WS_HX), rsp}; pg8::gemm_phase(C.lds, P, S, E, C.tid()); }
            else { EpiRes<true> E{(const void*)(const bf16*)(GAS bf16*)ldarg(C, A_OUT), WSP(bf16, WS_STREAM1), gatev, nullptr, gnp, WSP(bf16, WS_HX), rsp}; pg8::gemm_phase(C.lds, P, S, E, C.tid()); }
            if (l == 0 && rep == 0) wg_wo_ctx(C);
        } else if (k == 6) {
            pg8::Prob<false> P{WSP(const bf16, WS_HX), WSP(const bf16, WS_W1), DM, DM, DM}; pg8::StaticOrder<FF / 256> S; S.init(l == 0 ? MT : ML, FF, C.G, C.bx);
            EpiAct E{WSP(bf16, WS_ACT), WSP(const u64, WS_RS) + (size_t)(l == 0 ? 1 : 3) * MT, WSP(const float, WS_CUP) + (size_t)l * 5 * FF};
            pg8::gemm_phase(C.lds, P, S, E, C.tid());
        } else if (k == 7) {
            if (l == 0) {
                pg8::ProbDown P{WSP(const bf16, WS_ACT), WSP(const bf16, WS_W2), FF, FF, FF}; pg8::DownOrder S; S.init(C.G, C.bx);
                EpiRes<true> E{(const void*)(const bf16*)(GAS bf16*)ldarg(C, A_OUT), (bf16*)(GAS bf16*)ldarg(C, A_OUT), WSP(const float, WS_MOD) + (size_t)l * 5 * NMOD + 5 * DM, WSP(float, WS_PART),
                         WSP(const float, WS_GN) + (size_t)2 * 5 * DM, WSP(bf16, WS_HX), WSP(u64, WS_RS) + (size_t)2 * MT};
                pg8::gemm_phase(C.lds, P, S, E, C.tid());
            } else {
                pg8::Prob<false> P{WSP(const bf16, WS_ACT), WSP(const bf16, WS_W2), FF, FF, FF}; pg8::StaticOrder<DM / 256> S; S.init(ML, DM, C.G, C.bx);
                EpiResFinal E{WSP(const bf16, WS_STREAM1), (float*)(GAS float*)ldarg(C, A_OUT), WSP(const float, WS_MOD) + (size_t)l * 5 * NMOD + 5 * DM, ARGF(A_FG), WSP(u64, WS_RS5), WSP(unsigned, WS_FCNT), (unsigned*)WSP(unsigned, WS_CTL) + CW_TMO};
                pg8::gemm_phase(C.lds, P, S, E, C.tid());
            }
        } else ph_final(C);
        if (step + 1 < hi || rep + 1 < nrep) { if (MK_MULTI) { if (C.tid() == 0) __hip_atomic_store(ctl + CW_TMO, 0xBADu, RLX_AGENT); } else { XcdBarrier bar; bar.bar = (unsigned*)(ctl + CW_BAR); bar.x = xcc; bar.st = (volatile LAS unsigned*)(lds0 + MISC_OFF) + 8; xcd_barrier(bar, C.tid() == 0);
                if (step == lo && rep == 0) {
                    volatile LAS unsigned* misc = (volatile LAS unsigned*)(lds0 + MISC_OFF);
                    if (C.tid() == 0) { bool ok = gridDim.x == 256;
                        for (unsigned j = 0; j < 16; ++j) { const unsigned cnt = xb_ld(bar.bar + XB_XCNT(j)); ok = ok && (cnt == (j < 8 ? 32u : 0u)); }
                        misc[11] = ok ? 1u : 0u; }
                    __syncthreads();
                    const unsigned okf = __builtin_amdgcn_readfirstlane(misc[11]), rk = __builtin_amdgcn_readfirstlane(misc[10]);
                    if (okf != 0u && rk < 32u && xcc < 8u) vbx = (int)(rk * 8u + xcc); } } }
        }
    }
}

extern "C" void kernel_launch(void* const* d_in, const int* in_sizes, int n_in, void* d_out, int out_size, void* d_ws, size_t ws_size, hipStream_t stream) {
    static int grid = 0;
    if (grid == 0) {
        if (n_in != 18 || out_size != ML * DM || ws_size < WS_END) { fprintf(stderr, "kernel_launch: unexpected shapes (n_in %d out %d ws %zu)\n", n_in, out_size, ws_size); grid = -1; return; }
        int dev = 0, cus = 0;
        if (hipGetDevice(&dev) != hipSuccess || hipDeviceGetAttribute(&cus, hipDeviceAttributeMultiprocessorCount, dev) != hipSuccess) { grid = -1; return; }
        if (hipFuncSetAttribute((const void*)fwd_kernel, hipFuncAttributeMaxDynamicSharedMemorySize, LDS_BYTES) != hipSuccess) { fprintf(stderr, "kernel_launch: hipFuncSetAttribute failed\n"); grid = -1; return; }
        int per_cu = 0;
        if (hipOccupancyMaxActiveBlocksPerMultiprocessor(&per_cu, (const void*)fwd_kernel, NTHR, LDS_BYTES) != hipSuccess || per_cu < 1) fprintf(stderr, "kernel_launch: occupancy query reports %d\n", per_cu);
        (void)hipGetLastError();
        grid = cus;
    }
    if (grid < 0) return;
    (void)hipMemsetAsync((char*)d_ws + WS_CTL, 0, CTL_ZERO_BYTES, stream);
    Args a{};
    for (int i = 0; i < 18; ++i) a.p[i] = d_in[i];
    a.p[A_OUT] = d_out; a.p[A_WS] = d_ws;
#if MK_MULTI
    for (int s = 0; s < NSTEPS; ++s) { a.ph_lo = s; a.ph_hi = s + 1; hipLaunchKernelGGL(fwd_kernel, dim3(grid), dim3(NTHR), LDS_BYTES, stream, a); }
#else
    a.ph_lo = 0; a.ph_hi = NSTEPS; hipLaunchKernelGGL(fwd_kernel, dim3(grid), dim3(NTHR), LDS_BYTES, stream, a);
#endif
}
```

```cpp
#include <hip/hip_runtime.h>
#include <cstdio>
#include <cstdint>

#ifndef PROBE_K
#define PROBE_K -99
#define PROBE_N 1
#define PROBE_SUB 7
#endif
#ifndef MK_MULTI
#define MK_MULTI 0
#endif

namespace pg8 {
#define PG8_LAS __attribute__((address_space(3)))
typedef unsigned short bf16_t;
typedef short bf16x8 __attribute__((ext_vector_type(8)));
typedef float f32x4 __attribute__((ext_vector_type(4)));
typedef unsigned u32x4 __attribute__((ext_vector_type(4)));
constexpr int BM = 256, BK = 64, HALF = 128, HTB = HALF * BK * 2, STAGE_BYTES = 8 * HTB, NXCD = 8, WGM = 8;

__host__ __device__ __forceinline__ int lds_byte(int r, int c) { const int st = (r >> 4) * 2 + (c >> 5), rr = r & 15, cc = c & 31, ob = rr * 64 + cc * 2; return st * 1024 + (ob ^ (((ob >> 9) & 1) << 5)); }
__host__ __device__ __forceinline__ void stage_rc(int b, int& R, int& C) { const int st = b / 1024, sb = b % 1024, swz = sb ^ (((sb >> 9) & 1) << 5); R = (st >> 1) * 16 + swz / 64; C = (st & 1) * 32 + (swz % 64) / 2; }
__host__ __device__ __forceinline__ int perm32(int rho) { const int n = rho >> 4, i = rho & 15; return 8 * (i >> 2) + 4 * n + (i & 3); }

struct Unit { int pm, pn, br; };

template <int NN  > struct StaticOrder {
    int nM, nwg, G, c;
    __device__ void init(int M, int  , int G_, int c_) { nM = M / BM; nwg = nM * NN; G = G_; c = c_; }
    __device__ __forceinline__ bool next(int i, Unit& u) const {
        u.br = 0;
        const long L = (long)i * G + c; if (L >= nwg) return false;
        int wgid = (int)L; { const int q = nwg >> 3, r = nwg & 7, xcd = wgid & 7, off = wgid >> 3; wgid = (xcd < r ? xcd * (q + 1) : r * (q + 1) + (xcd - r) * q) + off; }
        constexpr int nig = WGM * NN; const int gid = wgid / nig, rem = wgid - gid * nig, fm = gid * WGM, gsz = (nM - fm) < WGM ? (nM - fm) : WGM;
        if (gsz == WGM) { u.pm = fm + (rem & (WGM - 1)); u.pn = rem >> 3; } else { u.pm = fm + (rem % gsz); u.pn = rem / gsz; }
        return true;
    }
};

struct DownOrder {
    StaticOrder<4> lat; int G, c;
    __device__ void init(int G_, int c_) { lat.init(32768, 1024, G_, c_); G = G_; c = c_; }
    __device__ __forceinline__ bool next(int i, Unit& u) const {
        const long L = (long)i * G + c;
        if (L < 512) return lat.next(i, u);
        const int j = (int)L - 512; if (j >= 64) return false;
        const int ct = j >> 2; u.pm = 128 + (ct >> 2); u.pn = ct & 3; u.br = j & 3; return true;
    }
};
struct ProbDown {
    const bf16_t* A; const bf16_t* Bt; int lda, ldb, K;
    __device__ __forceinline__ int nt(const Unit& u) const { return u.pm >= 128 ? 16 : 64; }
    __device__ __forceinline__ int koff(const Unit& u) const { return u.pm >= 128 ? u.br * 1024 : 0; }
    __device__ __forceinline__ const char* a(const Unit& u) const { return (const char*)(A + (size_t)u.pm * BM * lda + koff(u)); }
    __device__ __forceinline__ const char* b(const Unit& u) const { return (const char*)(Bt + (size_t)u.pn * BM * ldb + koff(u)); }
};
template <bool MERGE> struct Prob {
    const bf16_t* A; const bf16_t* Bt; int lda, ldb, K;
    __device__ __forceinline__ int nt(const Unit& u) const { if (MERGE) return u.br == 2 ? 8 : 4; return K / BK; }
    __device__ __forceinline__ int koff(const Unit& u) const { if (MERGE) return u.br * 256; return 0; }
    __device__ __forceinline__ const char* a(const Unit& u) const { return (const char*)(A + (size_t)u.pm * BM * lda + koff(u)); }
    __device__ __forceinline__ const char* b(const Unit& u) const { return (const char*)(Bt + (size_t)u.pn * BM * ldb + koff(u)); }
};

typedef __bf16 bf16x2_cv __attribute__((ext_vector_type(2)));
typedef float f32x2_cv __attribute__((ext_vector_type(2)));
__device__ __forceinline__ unsigned cvt_pk_bf16(float lo, float hi) { const f32x2_cv v = {lo, hi}; const bf16x2_cv r = __builtin_convertvector(v, bf16x2_cv); return __builtin_bit_cast(unsigned, r); }

template <class Epi, class Sched, class PROB>
__device__ __forceinline__ void gemm_phase(PG8_LAS unsigned char* lds, const PROB P, const Sched& S, const Epi& E, const int tid) {
    const int wid = __builtin_amdgcn_readfirstlane(tid >> 6), lane = tid & 63, wr = wid >> 2, wc = wid & 3, fr = lane & 15, fq = lane >> 4;
    unsigned voffA[2], voffB[2];
#pragma unroll
    for (int i = 0; i < 2; ++i) { int R, C; stage_rc(tid * 16 + i * 8192, R, C); const int Rb = Epi::PERM ? ((R & ~31) + perm32(R & 31)) : R;
        voffA[i] = (unsigned)(R * P.lda + C) * 2u; voffB[i] = (unsigned)(Rb * P.ldb + C) * 2u; }
    const size_t kstep = (size_t)(BK * 2);
    const size_t hstepA = (size_t)HALF * P.lda * 2, hstepB = (size_t)HALF * P.ldb * 2;
    const unsigned ldsw = (unsigned)wid * 1024u;
    const int aoff = lds_byte(wr * 64 + fr, fq * 8), boff = lds_byte(wc * 32 + fr, fq * 8);
#define PG8_SA(b, h) (((b) * 2 + (h)) * HTB)
#define PG8_SB(b, h) ((4 + (b) * 2 + (h)) * HTB)
#define PG8_STAGE(bufoff, gbase, voff) do { _Pragma("unroll") for (int _i = 0; _i < 2; ++_i) \
        __builtin_amdgcn_global_load_lds((const unsigned*)((const char*)(gbase) + (voff)[_i]), (PG8_LAS unsigned*)(lds + (bufoff) + ldsw + _i * 8192), 16, 0, 0); } while (0)
#define PG8_LDA(dst, b, h) do { _Pragma("unroll") for (int m = 0; m < 4; ++m) _Pragma("unroll") for (int k = 0; k < 2; ++k) dst[m][k] = *(const PG8_LAS bf16x8*)(lds + PG8_SA(b, h) + aoff + m * 2048 + k * 1024); } while (0)
#define PG8_LDB(dst, b, h) do { _Pragma("unroll") for (int n = 0; n < 2; ++n) _Pragma("unroll") for (int k = 0; k < 2; ++k) dst[n][k] = *(const PG8_LAS bf16x8*)(lds + PG8_SB(b, h) + boff + n * 2048 + k * 1024); } while (0)
#define PG8_MMA(ai, bj, At, Bt) do { __builtin_amdgcn_s_setprio(1); _Pragma("unroll") for (int m = 0; m < 4; ++m) _Pragma("unroll") for (int n = 0; n < 2; ++n) _Pragma("unroll") for (int k = 0; k < 2; ++k) \
        acc[ai][bj][m][n] = __builtin_amdgcn_mfma_f32_16x16x32_bf16(Bt[n][k], At[m][k], acc[ai][bj][m][n], 0, 0, 0); __builtin_amdgcn_s_setprio(0); } while (0)
#define PG8_WAIT_V(n) asm volatile("s_waitcnt vmcnt(" #n ")" ::: "memory")
#define PG8_WAIT_L(n) asm volatile("s_waitcnt lgkmcnt(" #n ")" ::: "memory")
#define PG8_BAR __builtin_amdgcn_s_barrier()
#define PG8_WAIT_SEL1(N, H) asm volatile("s_waitcnt vmcnt(" #N ")\n\tv_cmp_eq_u32_e32 vcc, 1, %0\n\ts_cbranch_vccnz .Lpg8w%=\n\ts_waitcnt vmcnt(" #H ")\n\tv_cmp_eq_u32_e32 vcc, 2, %0\n\ts_cbranch_vccnz .Lpg8w%=\n\ts_waitcnt vmcnt(8)\n.Lpg8w%=:" :: "v"(fst) : "memory", "vcc")
#define PG8_WAIT_SEL(NF16, NH16, NF32) do { if (Epi::NST == 16) PG8_WAIT_SEL1(NF16, NH16); else PG8_WAIT_SEL1(NF32, NF32); } while (0)
#define PG8_SCHED __builtin_amdgcn_sched_barrier(0)
    Unit cur, nxt; int ui = 0, pcls = 1;
    if (!S.next(0, cur)) return;
    f32x4 acc[2][2][4][2];
#pragma unroll
    for (int a = 0; a < 2; ++a)
#pragma unroll
        for (int b = 0; b < 2; ++b)
#pragma unroll
            for (int m = 0; m < 4; ++m)
#pragma unroll
                for (int n = 0; n < 2; ++n) acc[a][b][m][n] = (f32x4){0.f, 0.f, 0.f, 0.f};
    bf16x8 At[4][2], B0[2][2], B1[2][2];
    const char* cA = P.a(cur); const char* cB = P.b(cur);
    PG8_STAGE(PG8_SB(0, 0), cB, voffB); PG8_STAGE(PG8_SB(0, 1), cB + hstepB, voffB); PG8_STAGE(PG8_SA(0, 0), cA, voffA); PG8_STAGE(PG8_SA(0, 1), cA + hstepA, voffA);
    if (wr == 1) PG8_BAR;
    PG8_WAIT_V(2); PG8_BAR;
    PG8_STAGE(PG8_SB(1, 0), cB + kstep, voffB); PG8_STAGE(PG8_SA(1, 0), cA + kstep, voffA); PG8_STAGE(PG8_SB(1, 1), cB + hstepB + kstep, voffB);
    PG8_WAIT_V(6); PG8_BAR;
    for (;;) {
        const bool has_next = S.next(ui + 1, nxt);
        const char* nA = has_next ? P.a(nxt) : cA; const char* nB = has_next ? P.b(nxt) : cB;
        const int nt = P.nt(cur);
        for (int t = 0; t < nt; t += 2) {
            const bool last = (t == nt - 2); const int fst = (t == 0 && ui > 0) ? pcls : 0;
            if constexpr (Epi::HOOKS) { if (t == 4 || t == 8) E.hook(acc, cur, t, wr, wc, fr, fq); }
            const char* a1 = cA + (size_t)(t + 1) * kstep;
            const char* a2 = last ? nA : cA + (size_t)(t + 2) * kstep; const char* b2 = last ? nB : cB + (size_t)(t + 2) * kstep;
            const char* a3 = a2 + kstep; const char* b3 = b2 + kstep;
            PG8_LDB(B0, 0, 0); PG8_LDB(B1, 0, 1); PG8_SCHED; PG8_LDA(At, 0, 0); PG8_STAGE(PG8_SA(1, 1), a1 + hstepA, voffA);
            PG8_WAIT_SEL(18, 10, 34); PG8_WAIT_L(0); PG8_BAR; PG8_MMA(0, 0, At, B0); PG8_MMA(0, 1, At, B1); PG8_BAR; PG8_SCHED;
            PG8_LDA(At, 0, 1); PG8_STAGE(PG8_SB(0, 0), b2, voffB); PG8_STAGE(PG8_SB(0, 1), b2 + hstepB, voffB); PG8_STAGE(PG8_SA(0, 0), a2, voffA);
            PG8_WAIT_SEL(24, 16, 40); PG8_WAIT_L(0); PG8_BAR; PG8_MMA(1, 0, At, B0); PG8_MMA(1, 1, At, B1); PG8_BAR; PG8_SCHED;
            PG8_LDB(B0, 1, 0); PG8_LDB(B1, 1, 1); PG8_SCHED; PG8_LDA(At, 1, 0); PG8_STAGE(PG8_SA(0, 1), a2 + hstepA, voffA);
            PG8_WAIT_SEL(26, 18, 42); PG8_WAIT_L(0); PG8_BAR; PG8_MMA(0, 0, At, B0); PG8_MMA(0, 1, At, B1); PG8_BAR; PG8_SCHED;
            PG8_LDA(At, 1, 1); PG8_STAGE(PG8_SB(1, 0), b3, voffB); PG8_STAGE(PG8_SB(1, 1), b3 + hstepB, voffB); PG8_STAGE(PG8_SA(1, 0), a3, voffA);
            PG8_WAIT_V(8); PG8_WAIT_L(0); PG8_BAR; PG8_MMA(1, 0, At, B0); PG8_MMA(1, 1, At, B1); PG8_BAR; PG8_SCHED;
        }
        if (wr == 0) PG8_BAR;
        E(acc, cur, wr, wc, fr, fq); pcls = E.cls(cur);
        if (!has_next) break;
#pragma unroll
        for (int a = 0; a < 2; ++a)
#pragma unroll
            for (int b = 0; b < 2; ++b)
#pragma unroll
                for (int m = 0; m < 4; ++m)
#pragma unroll
                    for (int n = 0; n < 2; ++n) acc[a][b][m][n] = (f32x4){0.f, 0.f, 0.f, 0.f};
        cur = nxt; cA = nA; cB = nB; ++ui;
        if (wr == 1) PG8_BAR;
    }
    PG8_WAIT_V(0);
    PG8_BAR;
#undef PG8_SA
#undef PG8_SB
#undef PG8_STAGE
#undef PG8_LDA
#undef PG8_LDB
#undef PG8_MMA
#undef PG8_WAIT_V
#undef PG8_WAIT_L
#undef PG8_BAR
#undef PG8_WAIT_SEL
#undef PG8_WAIT_SEL1
#undef PG8_SCHED
}
}

constexpr int NWAVES = 8, NTHR = 512;
constexpr int DM = 1024, NB = 4, SEQ = 8192, ML = NB * SEQ, CTXL = 256, MC = NB * CTXL, MT = ML + MC;
constexpr int NIN_ORIG = 5632, NPXA = 2816, NPXG = 3072, NIN = NPXA + NPXG;
constexpr int OFF_P = 0, OFF_Q = 256, OFF_CU = 512, OFF_CB = 768, OFF_CC = 1024, OFF_QQ = 1280, OFF_K = 1792, OFF_V = 2304;
constexpr int FF = 4096, NMOD = 6 * DM, NGRP = 5;
constexpr float EPS = 1e-6f;

constexpr size_t MiB = 1u << 20;
constexpr size_t WS_CTL = 0, CTL_ZERO_BYTES = 2 * MiB;
constexpr size_t WS_RS = 262144;
constexpr size_t WS_FCNT = 1441792;
constexpr size_t WS_ZERO = 1572864;
constexpr size_t WS_RS5 = 1703936;
constexpr size_t WS_TW = 2 * MiB;
constexpr size_t WS_MOD = 2 * MiB + 65536;
constexpr size_t WS_GN = 2 * MiB + 524288;
constexpr size_t WS_CIN = 2 * MiB + 786432;
constexpr size_t WS_CUP = 3 * MiB;
constexpr size_t WS_MODP = 510 * MiB;
constexpr size_t WS_CTXX = 4 * MiB;
constexpr size_t WS_WIN = 8 * MiB, WS_WM = 20 * MiB, WS_WO = 22 * MiB, WS_W1 = 24 * MiB, WS_W2 = 32 * MiB;
constexpr size_t WS_HX = 40 * MiB;
constexpr size_t WS_PXA = 106 * MiB;
constexpr size_t WS_PXG = 288 * MiB;
constexpr size_t WS_TB = 486 * MiB;
constexpr size_t WS_M = WS_PXA;
constexpr size_t WS_ACT = WS_PXA;
constexpr size_t WS_PART = 400 * MiB;
constexpr size_t WS_STREAM1 = 416 * MiB;
constexpr size_t WS_END = 512 * MiB;
static_assert(WS_PXA + (size_t)MT * NPXA * 2 <= WS_PXG && WS_PXG + (size_t)MT * NPXG * 2 <= WS_TB && WS_ACT + (size_t)MT * FF * 2 <= WS_TB && WS_HX + (size_t)MT * DM * 2 <= WS_PXA, "ws map");
constexpr int CW_TMO = 0, CW_BAR = 4096;

constexpr int RING_BYTES = 131072, LDSCTL_OFF = 155648, MISC_OFF = LDSCTL_OFF + 320, LDS_BYTES = 163840;

#define GAS __attribute__((address_space(1)))
#define LAS __attribute__((address_space(3)))
typedef unsigned short bf16;
typedef unsigned v4u __attribute__((ext_vector_type(4)));
typedef unsigned v2u __attribute__((ext_vector_type(2)));
typedef float f32x4 __attribute__((ext_vector_type(4)));
typedef GAS unsigned gu32;
#define RLX_AGENT __ATOMIC_RELAXED, __HIP_MEMORY_SCOPE_AGENT
#define LDS_WAIT() asm volatile("s_waitcnt lgkmcnt(0)" ::: "memory")
__device__ __forceinline__ unsigned pk2(float lo, float hi) { return pg8::cvt_pk_bf16(lo, hi); }
__device__ __forceinline__ unsigned f2bf(float f) { return pg8::cvt_pk_bf16(f, 0.0f) & 0xffffu; }
__device__ __forceinline__ float bf2f(unsigned h) { return __uint_as_float(h << 16); }
__device__ __forceinline__ float bflo(unsigned w) { return __uint_as_float(w << 16); }
__device__ __forceinline__ float bfhi(unsigned w) { return __uint_as_float(w & 0xffff0000u); }

#define XB_TMO      128
#define XB_XCNT(j)  (256  + 64 * (j))
#define XB_XSUB(j)  (1280 + 64 * (j))
#define XB_XGEN(j)  (2304 + 64 * (j))
#define XB_TOP      3328
#define XB_TOPGEN   3392
#define XCD_BAR_WORDS 3456
#define XB_SPIN_CAP (1u << 22)
__device__ __forceinline__ unsigned xb_ld(unsigned* p)              { return __hip_atomic_load(p, __ATOMIC_RELAXED, __HIP_MEMORY_SCOPE_AGENT); }
__device__ __forceinline__ unsigned xb_add(unsigned* p, unsigned v) { return __hip_atomic_fetch_add(p, v, __ATOMIC_RELAXED, __HIP_MEMORY_SCOPE_AGENT); }
__device__ __forceinline__ unsigned xb_xcc_id() { return (unsigned)__builtin_amdgcn_s_getreg((3 << 11) | 20) & 0xFu; }
#define XB_SPIN(cond, bar) do { unsigned _sp = 0; while (cond) { __builtin_amdgcn_s_sleep(1); \
    if ((++_sp & 255u) == 0u) { if (xb_ld(&(bar)[XB_TMO])) break; if (_sp > XB_SPIN_CAP) { atomicAdd(&(bar)[XB_TMO], 1u); break; } } } } while (0)
struct XcdBarrier { unsigned* bar; unsigned x; volatile LAS unsigned* st; };
__device__ __forceinline__ XcdBarrier xcd_barrier_post(unsigned* bar, volatile LAS unsigned* st, bool leader) {
    XcdBarrier b; b.bar = bar; b.x = xb_xcc_id(); b.st = st;
    if (leader) { const unsigned rank = xb_add(&bar[XB_XCNT(b.x)], 1u); st[2] = rank; }
    return b;
}
__device__ __forceinline__ void xcd_barrier_complete(unsigned* bar, unsigned x, unsigned& nloc, unsigned& nx) {
    const unsigned G = gridDim.x * gridDim.y * gridDim.z;
    unsigned sum, cnt, mine, sp = 0u;
    for (;;) {
        sum = 0u; cnt = 0u; mine = 0u;
#pragma unroll
        for (unsigned j = 0; j < 16; ++j) { const unsigned c = xb_ld(&bar[XB_XCNT(j)]); sum += c; cnt += (c > 0u) ? 1u : 0u; mine = (j == x) ? c : mine; }
        if (sum == G) break;
        __builtin_amdgcn_s_sleep(1);
        if ((++sp & 255u) == 0u) { if (xb_ld(&bar[XB_TMO])) break; if (sp > XB_SPIN_CAP) { atomicAdd(&bar[XB_TMO], 1u); break; } }
    }
    nloc = mine > 0u ? mine : 1u; nx = cnt > 0u ? cnt : 1u;
}
__device__ __forceinline__ void xcd_barrier(const XcdBarrier& b, bool leader) {
    asm volatile("s_waitcnt vmcnt(0)" ::: "memory");
    __syncthreads();
    if (leader) {
        unsigned* bar = b.bar;
        __builtin_amdgcn_s_waitcnt(0);
        unsigned nloc = b.st[0], nx = b.st[1];
        if (nloc == 0u) { xcd_barrier_complete(bar, b.x, nloc, nx); b.st[0] = nloc; b.st[1] = nx; }
        const unsigned old = xb_add(&bar[XB_XSUB(b.x)], 1u);
        const unsigned gen = old / nloc;
        if (old + 1u == (gen + 1u) * nloc) {
            __builtin_amdgcn_fence(__ATOMIC_RELEASE, "agent");
            asm volatile("s_waitcnt vmcnt(0)" ::: "memory");
            const unsigned og = xb_add(&bar[XB_TOP], 1u);
            const unsigned tg = og / nx;
            if (og + 1u == (tg + 1u) * nx) xb_add(&bar[XB_TOPGEN], 1u);
            else XB_SPIN(xb_ld(&bar[XB_TOPGEN]) == tg, bar);
            __builtin_amdgcn_fence(__ATOMIC_ACQUIRE, "agent");
            xb_add(&bar[XB_XGEN(b.x)], 1u);
            asm volatile("s_waitcnt vmcnt(0)" ::: "memory");
        } else {
            XB_SPIN(xb_ld(&bar[XB_XGEN(b.x)]) == gen, bar);
            __builtin_amdgcn_fence(__ATOMIC_ACQUIRE, "agent");
            asm volatile("s_waitcnt vmcnt(0)" ::: "memory");
        }
    }
    __syncthreads();
}

__device__ __forceinline__ float wave_sum(float v) {
#pragma unroll
    for (int o = 1; o < 64; o <<= 1) v += __shfl_xor(v, o);
    return v;
}
__device__ __forceinline__ float wave_max(float v) {
#pragma unroll
    for (int o = 1; o < 64; o <<= 1) v = fmaxf(v, __shfl_xor(v, o));
    return v;
}

__device__ __forceinline__ void transpose_item(const float* W, int ldw, int ncols, bf16* WT, int ldwt, int row_off, int k_off, LAS float* scr, int item, int lane) {
    const int nblk = ncols / 32, kb = item / nblk, nb = item % nblk, k0 = 64 * kb, n0 = 32 * nb;
#pragma unroll 8
    for (int i = 0; i < 32; ++i) { const int kk = 2 * i + (lane >> 5); scr[kk * 33 + (lane & 31)] = W[(size_t)(k0 + kk) * ldw + n0 + (lane & 31)]; }
    LDS_WAIT(); asm volatile("" ::: "memory");
    const int c = lane & 7;
#pragma unroll
    for (int j = 0; j < 4; ++j) { const int n = (lane >> 3) + 8 * j; const LAS float* s = scr + (8 * c) * 33 + n;
        v4u o; o.x = pk2(s[0 * 33], s[1 * 33]); o.y = pk2(s[2 * 33], s[3 * 33]); o.z = pk2(s[4 * 33], s[5 * 33]); o.w = pk2(s[6 * 33], s[7 * 33]);
        *(v4u*)(WT + (size_t)(row_off + n0 + n) * ldwt + k_off + k0 + 8 * c) = o; }
    LDS_WAIT(); asm volatile("" ::: "memory");
}

using pg8::Unit; using pg8::cvt_pk_bf16;
typedef unsigned long long u64;
constexpr int NTM = MT / 256;
__device__ __forceinline__ size_t gate_tile(int g, int pm, int pn) { return (size_t)((g * NTM + pm) * 4 + pn) * 65536; }
__device__ __forceinline__ int gate_piece(int ai, int m, int bj, int wave, int lane) { return ((((ai * 4 + m) * 2 + bj) * 8 + wave) * 64 + lane) * 8; }
__device__ __forceinline__ size_t gq_tile(int g, int pm, int pn) { return (size_t)((g * NTM + pm) * 4 + pn) * 65536; }
__device__ __forceinline__ int gq_piece(int ai, int m, int wave, int lane) { return (((ai * 4 + m) * 8 + wave) * 64 + lane) * 16; }
__device__ __forceinline__ size_t gq_elem(int g, int row, int col) { const int r = row & 255, c = col & 255;
    return gq_tile(g, row >> 8, col >> 8) + gq_piece(r >> 7, (r >> 4) & 3, ((r >> 6) & 1) * 4 + ((c >> 5) & 3), ((c >> 3) & 3) * 16 + (r & 15)) + (c >> 7) * 8 + (c & 7); }
__device__ __forceinline__ unsigned pk4q(float a, float b, float c, float d) {
    const unsigned lo = __builtin_amdgcn_perm(__builtin_bit_cast(unsigned, b), __builtin_bit_cast(unsigned, a), 0x0c0c0400u), hi = __builtin_amdgcn_perm(__builtin_bit_cast(unsigned, d), __builtin_bit_cast(unsigned, c), 0x0c0c0400u);
    return lo | (hi << 16); }
__device__ __forceinline__ float ub0(unsigned v) { return (float)(v & 0xffu); }
__device__ __forceinline__ float ub1(unsigned v) { return (float)((v >> 8) & 0xffu); }
__device__ __forceinline__ float ub2(unsigned v) { return (float)((v >> 16) & 0xffu); }
__device__ __forceinline__ float ub3(unsigned v) { return (float)(v >> 24); }
__device__ __forceinline__ size_t gate_elem(int g, int row, int col) {
    const int r = row & 255, c = col & 255;
    return gate_tile(g, row >> 8, col >> 8) + gate_piece(r >> 7, (r >> 4) & 3, c >> 7, ((r >> 6) & 1) * 4 + ((c >> 5) & 3), ((c >> 3) & 3) * 16 + (r & 15)) + (c & 7);
}
__device__ __forceinline__ float rs_to_rstd(u64 q) { return __builtin_amdgcn_rsqf((float)q * (1.0f / (16777216.0f * DM)) + EPS); }
struct EpiIn {
    static constexpr bool PERM = true, HOOKS = false; static constexpr int NST = 16;
    __device__ __forceinline__ int cls(const Unit&) const { return 1; }
    bf16* pxa; bf16* pxg; const u64* rs; const float* cin;
    __device__ __forceinline__ void operator()(const f32x4 (&acc)[2][2][4][2], const Unit& u, int wr, int wc, int fr, int fq) const {
        { int l_; asm volatile("v_mbcnt_lo_u32_b32 %0, -1, 0\n\tv_mbcnt_hi_u32_b32 %0, -1, %0" : "=v"(l_)); fr = l_ & 15; fq = l_ >> 4; }
        const bool gate = u.pn >= 11; bf16* base = gate ? pxg : pxa; const int ldc = gate ? NPXG : NPXA; const int colt = (gate ? u.pn - 11 : u.pn) * 256;
        const int grp = u.pm >= 128 ? 4 : (u.pm >> 5);
        const int row0 = u.pm * 256 + wr * 64 + fr, col0 = colt + wc * 32 + 8 * fq;
        const float* cp = cin + grp * NIN + u.pn * 256 + wc * 32 + 8 * fq;
        unsigned char* gbase = (unsigned char*)pxg + (gate ? gq_tile((u.pn - 11) >> 2, u.pm, (u.pn - 11) & 3) : 0);
        const float gsc = gate ? -1.4426950408889634f : 1.0f;
        f32x4 cv[2][2];
#pragma unroll
        for (int bj = 0; bj < 2; ++bj) { cv[bj][0] = *(const f32x4*)(cp + bj * 128) * gsc; cv[bj][1] = *(const f32x4*)(cp + bj * 128 + 4) * gsc; }
        u64 rq[2][4]; float rsv[2][4];
#pragma unroll
        for (int ai = 0; ai < 2; ++ai)
#pragma unroll
            for (int m = 0; m < 4; ++m) rq[ai][m] = rs[row0 + ai * 128 + m * 16];
        asm volatile("" ::: "memory");
#pragma unroll
        for (int ai = 0; ai < 2; ++ai)
#pragma unroll
            for (int m = 0; m < 4; ++m) rsv[ai][m] = rs_to_rstd(rq[ai][m]) * gsc;
#pragma unroll
        for (int ai = 0; ai < 2; ++ai)
#pragma unroll
            for (int m = 0; m < 4; ++m) { const int row = row0 + ai * 128 + m * 16; bf16* rowp = base + (size_t)row * ldc + col0; const float rstd = rsv[ai][m];
#pragma unroll
                for (int bj = 0; bj < 2; ++bj) { f32x4 v0 = acc[ai][bj][m][0] * rstd + cv[bj][0], v1 = acc[ai][bj][m][1] * rstd + cv[bj][1];
                    if (gate) {
#pragma unroll
                        for (int e = 0; e < 4; ++e) { v0[e] = __builtin_fmaf(fmaxf(__builtin_amdgcn_rcpf(1.0f + __builtin_amdgcn_exp2f(v0[e])), 1.0f / 255.0f), 255.0f, 8388608.0f);
                                                      v1[e] = __builtin_fmaf(fmaxf(__builtin_amdgcn_rcpf(1.0f + __builtin_amdgcn_exp2f(v1[e])), 1.0f / 255.0f), 255.0f, 8388608.0f); }
                        v2u gq; gq.x = pk4q(v0[0], v0[1], v0[2], v0[3]); gq.y = pk4q(v1[0], v1[1], v1[2], v1[3]);
                        *(v2u*)(gbase + gq_piece(ai, m, wr * 4 + wc, fq * 16 + fr) + bj * 8) = gq;
                    } else {
                        v4u w; w.x = cvt_pk_bf16(v0[0], v0[1]); w.y = cvt_pk_bf16(v0[2], v0[3]); w.z = cvt_pk_bf16(v1[0], v1[1]); w.w = cvt_pk_bf16(v1[2], v1[3]);
                        *(v4u*)(rowp + bj * 128) = w; } }
            }
    }
};
struct EpiMerge {
    static constexpr bool PERM = true, HOOKS = true; static constexpr int NST = 16;
    __device__ __forceinline__ int cls(const Unit&) const { return 1; }
    bf16* m; const bf16* pxg;
    __device__ __forceinline__ void hook(f32x4 (&acc)[2][2][4][2], const Unit& u, int t, int wr, int wc, int fr, int fq) const {
        asm volatile("" : "+v"(fr), "+v"(fq));
        const int wv = wr * 4 + wc, ln = fq * 16 + fr;
        const unsigned char* gnum = (const unsigned char*)pxg + gq_tile(t == 4 ? 0 : 1, u.pm, u.pn); const unsigned char* gden = (const unsigned char*)pxg + gq_tile(t == 4 ? 1 : 2, u.pm, u.pn);
#pragma unroll
        for (int ai = 0; ai < 2; ++ai) {
            v4u gn[4], gd[4];
#pragma unroll
            for (int mm = 0; mm < 4; ++mm) { const int ro = gq_piece(ai, mm, wv, ln); gn[mm] = *(const v4u*)(gnum + ro); gd[mm] = *(const v4u*)(gden + ro); }
            asm volatile("" ::: "memory");
#pragma unroll
            for (int mm = 0; mm < 4; ++mm)
#pragma unroll
                for (int bj = 0; bj < 2; ++bj) {
                    const unsigned a0 = bj ? gn[mm].z : gn[mm].x, a1 = bj ? gn[mm].w : gn[mm].y, d0 = bj ? gd[mm].z : gd[mm].x, d1 = bj ? gd[mm].w : gd[mm].y;
                    f32x4& v0 = acc[ai][bj][mm][0]; f32x4& v1 = acc[ai][bj][mm][1];
                    v0[0] *= ub0(a0) * __builtin_amdgcn_rcpf(ub0(d0)); v0[1] *= ub1(a0) * __builtin_amdgcn_rcpf(ub1(d0)); v0[2] *= ub2(a0) * __builtin_amdgcn_rcpf(ub2(d0)); v0[3] *= ub3(a0) * __builtin_amdgcn_rcpf(ub3(d0));
                    v1[0] *= ub0(a1) * __builtin_amdgcn_rcpf(ub0(d1)); v1[1] *= ub1(a1) * __builtin_amdgcn_rcpf(ub1(d1)); v1[2] *= ub2(a1) * __builtin_amdgcn_rcpf(ub2(d1)); v1[3] *= ub3(a1) * __builtin_amdgcn_rcpf(ub3(d1)); }
        }
    }
    __device__ __forceinline__ void operator()(const f32x4 (&acc)[2][2][4][2], const Unit& u, int wr, int wc, int fr, int fq) const {
        asm volatile("" : "+v"(fr), "+v"(fq));
        const int row0 = u.pm * 256 + wr * 64 + fr, col0 = u.pn * 256 + wc * 32 + 8 * fq;
        const unsigned char* ga = (const unsigned char*)pxg + gq_tile(2, u.pm, u.pn);
        constexpr float S = 1.0f / 255.0f;
#pragma unroll
        for (int ai = 0; ai < 2; ++ai) {
            v4u g[4];
#pragma unroll
            for (int mm = 0; mm < 4; ++mm) g[mm] = *(const v4u*)(ga + gq_piece(ai, mm, wr * 4 + wc, fq * 16 + fr));
            asm volatile("" ::: "memory");
#pragma unroll
            for (int mm = 0; mm < 4; ++mm)
#pragma unroll
                for (int bj = 0; bj < 2; ++bj) { const f32x4 v0 = acc[ai][bj][mm][0], v1 = acc[ai][bj][mm][1]; const unsigned q0 = bj ? g[mm].z : g[mm].x, q1 = bj ? g[mm].w : g[mm].y;
                    v4u w; w.x = cvt_pk_bf16(v0[0] * (ub0(q0) * S), v0[1] * (ub1(q0) * S)); w.y = cvt_pk_bf16(v0[2] * (ub2(q0) * S), v0[3] * (ub3(q0) * S));
                    w.z = cvt_pk_bf16(v1[0] * (ub0(q1) * S), v1[1] * (ub1(q1) * S)); w.w = cvt_pk_bf16(v1[2] * (ub2(q1) * S), v1[3] * (ub3(q1) * S));
                    *(v4u*)(m + (size_t)(row0 + ai * 128 + mm * 16) * DM + col0 + bj * 128) = w; }
        }
    }
};
template <bool BF  >
struct EpiRes {
    static constexpr bool PERM = true, HOOKS = false; static constexpr int NST = 32;
    __device__ __forceinline__ int cls(const Unit&) const { return 1; }
    const void* base_l; bf16* out; const float* gate;
    float* part;
    const float* gn; bf16* ap; u64* rs;
    __device__ __forceinline__ void operator()(const f32x4 (&acc)[2][2][4][2], const Unit& u, int wr, int wc, int fr, int fq) const {
        asm volatile("" : "+v"(fr), "+v"(fq));
        const bool isc = u.pm >= 128; const int grp = isc ? 4 : (u.pm >> 5);
        const int row0 = (isc ? (u.pm - 128) : u.pm) * 256 + wr * 64 + fr, col0 = u.pn * 256 + wc * 32 + 8 * fq;
        if (isc) {
            if (part == nullptr) return;
            float* po = part + (size_t)u.br * 1024 * 1024;
#pragma unroll
            for (int ai = 0; ai < 2; ++ai)
#pragma unroll
                for (int m = 0; m < 4; ++m)
#pragma unroll
                    for (int bj = 0; bj < 2; ++bj)
#pragma unroll
                        for (int n = 0; n < 2; ++n) *(f32x4*)(po + (size_t)(row0 + ai * 128 + m * 16) * DM + col0 + bj * 128 + n * 4) = acc[ai][bj][m][n];
            return;
        }
        const size_t stile = (size_t)(u.pm * 4 + u.pn) * 65536;
        f32x4 gv[2][2], gnv[2][2];
#pragma unroll
        for (int bj = 0; bj < 2; ++bj)
#pragma unroll
            for (int n = 0; n < 2; ++n) { gv[bj][n] = *(const f32x4*)(gate + grp * NMOD + col0 + bj * 128 + n * 4); gnv[bj][n] = *(const f32x4*)(gn + grp * DM + col0 + bj * 128 + n * 4); }
#pragma unroll
        for (int ai = 0; ai < 2; ++ai)
#pragma unroll
            for (int mp = 0; mp < 2; ++mp) {
                f32x4 bs[2][2][2];
                if constexpr (BF) {
                    v4u bb[2][2];
#pragma unroll
                    for (int mq = 0; mq < 2; ++mq)
#pragma unroll
                        for (int bj = 0; bj < 2; ++bj) bb[mq][bj] = *(const v4u*)((const bf16*)base_l + stile + gate_piece(ai, 2 * mp + mq, bj, wr * 4 + wc, fq * 16 + fr));
                    asm volatile("" ::: "memory");
#pragma unroll
                    for (int mq = 0; mq < 2; ++mq)
#pragma unroll
                        for (int bj = 0; bj < 2; ++bj) { const v4u b = bb[mq][bj]; bs[mq][bj][0] = (f32x4){bflo(b.x), bfhi(b.x), bflo(b.y), bfhi(b.y)}; bs[mq][bj][1] = (f32x4){bflo(b.z), bfhi(b.z), bflo(b.w), bfhi(b.w)}; }
                } else {
#pragma unroll
                    for (int mq = 0; mq < 2; ++mq)
#pragma unroll
                        for (int bj = 0; bj < 2; ++bj)
#pragma unroll
                            for (int n = 0; n < 2; ++n) bs[mq][bj][n] = *(const f32x4*)((const float*)base_l + (size_t)(row0 + ai * 128 + (2 * mp + mq) * 16) * DM + col0 + bj * 128 + n * 4);
                    asm volatile("" ::: "memory");
                }
#pragma unroll
                for (int mq = 0; mq < 2; ++mq) { const int m = 2 * mp + mq; float ss = 0.f; const size_t ro = (size_t)(row0 + ai * 128 + m * 16) * DM + col0;
#pragma unroll
                    for (int bj = 0; bj < 2; ++bj) {
                        const f32x4 o0 = bs[mq][bj][0] + gv[bj][0] * acc[ai][bj][m][0], o1 = bs[mq][bj][1] + gv[bj][1] * acc[ai][bj][m][1];
                        v4u ow; ow.x = cvt_pk_bf16(o0[0], o0[1]); ow.y = cvt_pk_bf16(o0[2], o0[3]); ow.z = cvt_pk_bf16(o1[0], o1[1]); ow.w = cvt_pk_bf16(o1[2], o1[3]);
                        *(v4u*)(out + stile + gate_piece(ai, m, bj, wr * 4 + wc, fq * 16 + fr)) = ow;
                        const f32x4 y0 = o0 * gnv[bj][0], y1 = o1 * gnv[bj][1];
                        v4u w; w.x = cvt_pk_bf16(y0[0], y0[1]); w.y = cvt_pk_bf16(y0[2], y0[3]); w.z = cvt_pk_bf16(y1[0], y1[1]); w.w = cvt_pk_bf16(y1[2], y1[3]);
                        *(v4u*)(ap + ro + bj * 128) = w;
                        ss += ((o0[0] * o0[0] + o0[1] * o0[1]) + (o0[2] * o0[2] + o0[3] * o0[3])) + ((o1[0] * o1[0] + o1[1] * o1[1]) + (o1[2] * o1[2] + o1[3] * o1[3])); }
                    ss += __shfl_xor(ss, 16); ss += __shfl_xor(ss, 32);
                    if (fq == 0) __hip_atomic_fetch_add(rs + row0 + ai * 128 + m * 16, (u64)(ss * 16777216.0f + 0.5f), __ATOMIC_RELAXED, __HIP_MEMORY_SCOPE_AGENT); }
            }
    }
};
struct EpiResFinal {
    static constexpr bool PERM = true, HOOKS = false; static constexpr int NST = 32;
    __device__ __forceinline__ int cls(const Unit&) const { return 1; }
    const bf16* xs; float* xo; const float* gate; const float* fg; u64* rs; unsigned* cnt; unsigned* tmo;
    __device__ __forceinline__ void operator()(f32x4 (&acc)[2][2][4][2], const Unit& u, int wr, int wc, int fr, int fq) const {
        asm volatile("" : "+v"(fr), "+v"(fq));
        const int grp = u.pm >> 5, row0 = u.pm * 256 + wr * 64 + fr, col0 = u.pn * 256 + wc * 32 + 8 * fq;
        f32x4 gv[2][2];
#pragma unroll
        for (int bj = 0; bj < 2; ++bj)
#pragma unroll
            for (int n = 0; n < 2; ++n) gv[bj][n] = *(const f32x4*)(gate + grp * NMOD + col0 + bj * 128 + n * 4);
#pragma unroll
        for (int ai = 0; ai < 2; ++ai)
#pragma unroll
            for (int mp = 0; mp < 2; ++mp) {
                f32x4 bs[2][2][2];
                { v4u bb[2][2];
#pragma unroll
                  for (int mq = 0; mq < 2; ++mq)
#pragma unroll
                      for (int bj = 0; bj < 2; ++bj) bb[mq][bj] = *(const v4u*)(xs + (size_t)(u.pm * 4 + u.pn) * 65536 + gate_piece(ai, 2 * mp + mq, bj, wr * 4 + wc, fq * 16 + fr));
                  asm volatile("" ::: "memory");
#pragma unroll
                  for (int mq = 0; mq < 2; ++mq)
#pragma unroll
                      for (int bj = 0; bj < 2; ++bj) { const v4u b = bb[mq][bj]; bs[mq][bj][0] = (f32x4){bflo(b.x), bfhi(b.x), bflo(b.y), bfhi(b.y)}; bs[mq][bj][1] = (f32x4){bflo(b.z), bfhi(b.z), bflo(b.w), bfhi(b.w)}; } }
#pragma unroll
                for (int mq = 0; mq < 2; ++mq) { const int m = 2 * mp + mq; float ss = 0.f;
#pragma unroll
                    for (int bj = 0; bj < 2; ++bj)
#pragma unroll
                        for (int n = 0; n < 2; ++n) { const f32x4 o = bs[mq][bj][n] + gv[bj][n] * acc[ai][bj][m][n]; acc[ai][bj][m][n] = o; ss += (o[0] * o[0] + o[1] * o[1]) + (o[2] * o[2] + o[3] * o[3]); }
                    ss += __shfl_xor(ss, 16); ss += __shfl_xor(ss, 32);
                    if (fq == 0) __hip_atomic_fetch_add(rs + row0 + ai * 128 + m * 16, (u64)(ss * 16777216.0f + 0.5f), __ATOMIC_RELAXED, __HIP_MEMORY_SCOPE_AGENT); }
            }
        asm volatile("s_waitcnt vmcnt(0)" ::: "memory");
        unsigned* pc = cnt + 64 * u.pm;
        if (__builtin_amdgcn_mbcnt_hi(~0u, __builtin_amdgcn_mbcnt_lo(~0u, 0u)) == 0) __hip_atomic_fetch_add(pc, 1u, __ATOMIC_RELAXED, __HIP_MEMORY_SCOPE_AGENT);
        { unsigned spins = 0;
          while ((unsigned)__builtin_amdgcn_readfirstlane(__hip_atomic_load(pc, __ATOMIC_RELAXED, __HIP_MEMORY_SCOPE_AGENT)) < 32u) {
              __builtin_amdgcn_s_sleep(2);
              if (++spins > (1u << 22)) { __hip_atomic_store(tmo, 1u, __ATOMIC_RELAXED, __HIP_MEMORY_SCOPE_AGENT); break; } } }
        f32x4 fgv[2][2];
#pragma unroll
        for (int bj = 0; bj < 2; ++bj)
#pragma unroll
            for (int n = 0; n < 2; ++n) fgv[bj][n] = *(const f32x4*)(fg + col0 + bj * 128 + n * 4);
#pragma unroll
        for (int ai = 0; ai < 2; ++ai)
#pragma unroll
            for (int m = 0; m < 4; ++m) { const int row = row0 + ai * 128 + m * 16;
                const float rstd = rs_to_rstd(__hip_atomic_load(rs + row, __ATOMIC_RELAXED, __HIP_MEMORY_SCOPE_AGENT));
#pragma unroll
                for (int bj = 0; bj < 2; ++bj)
#pragma unroll
                    for (int n = 0; n < 2; ++n) *(f32x4*)(xo + (size_t)row * DM + col0 + bj * 128 + n * 4) = acc[ai][bj][m][n] * rstd * fgv[bj][n]; }
    }
};
struct EpiAct {
    static constexpr bool PERM = true, HOOKS = false; static constexpr int NST = 16;
    __device__ __forceinline__ int cls(const Unit&) const { return 1; }
    bf16* a; const u64* rs; const float* cup;
    __device__ __forceinline__ void operator()(const f32x4 (&acc)[2][2][4][2], const Unit& u, int wr, int wc, int fr, int fq) const {
        asm volatile("" : "+v"(fr), "+v"(fq));
        const int grp = u.pm >= 128 ? 4 : (u.pm >> 5);
        const int row0 = u.pm * 256 + wr * 64 + fr, col0 = u.pn * 256 + wc * 32 + 8 * fq;
        const float* cp = cup + grp * FF + col0;
        f32x4 cv[2][2];
#pragma unroll
        for (int bj = 0; bj < 2; ++bj) { cv[bj][0] = *(const f32x4*)(cp + bj * 128); cv[bj][1] = *(const f32x4*)(cp + bj * 128 + 4); }
        u64 rq[2][4]; float rsv[2][4];
#pragma unroll
        for (int ai = 0; ai < 2; ++ai)
#pragma unroll
            for (int m = 0; m < 4; ++m) rq[ai][m] = rs[row0 + ai * 128 + m * 16];
        asm volatile("" ::: "memory");
#pragma unroll
        for (int ai = 0; ai < 2; ++ai)
#pragma unroll
            for (int m = 0; m < 4; ++m) rsv[ai][m] = rs_to_rstd(rq[ai][m]);
#pragma unroll
        for (int ai = 0; ai < 2; ++ai)
#pragma unroll
            for (int m = 0; m < 4; ++m) { const int row = row0 + ai * 128 + m * 16; bf16* rowp = a + (size_t)row * FF + col0; const float rstd = rsv[ai][m];
#pragma unroll
                for (int bj = 0; bj < 2; ++bj) { f32x4 v0 = acc[ai][bj][m][0] * rstd + cv[bj][0], v1 = acc[ai][bj][m][1] * rstd + cv[bj][1];
#pragma unroll
                    for (int e = 0; e < 4; ++e) { const float r0 = fmaxf(v0[e], 0.f), r1 = fmaxf(v1[e], 0.f); v0[e] = r0 * r0; v1[e] = r1 * r1; }
                    v4u w; w.x = cvt_pk_bf16(v0[0], v0[1]); w.y = cvt_pk_bf16(v0[2], v0[3]); w.z = cvt_pk_bf16(v1[0], v1[1]); w.w = cvt_pk_bf16(v1[2], v1[3]);
                    *(v4u*)(rowp + bj * 128) = w; } }
    }
};

constexpr int NS = 8;
constexpr int NSTEPS = 2 + 2 * NS;
constexpr int LARGS_OFF = LDSCTL_OFF + 1024;
enum { A_X = 0, A_C, A_CTX, A_CCTX, A_ADAW, A_ADAB, A_N1G, A_N2G, A_WIN, A_CONVW, A_RELB, A_WF, A_WC, A_WA, A_WO, A_W1, A_W2, A_FG, A_OUT, A_WS, A_NARGS };

struct Ctx { LAS unsigned char* lds; int wave, G, bx, gw, NGW, NGT;
    __device__ __forceinline__ int lane() const { int l; asm volatile("v_mbcnt_lo_u32_b32 %0, -1, 0\n\tv_mbcnt_hi_u32_b32 %0, -1, %0" : "=v"(l)); return l; }
    __device__ __forceinline__ int tid() const { return wave * 64 + lane(); }
    __device__ __forceinline__ int gt() const { return bx * NTHR + tid(); }
};
template <int I> __device__ __forceinline__ unsigned long long ldarg_t() {
    unsigned long long v; unsigned tmp;
    asm volatile("v_mov_b32 %1, %2\n\tds_read_b64 %0, %1 offset:%3\n\ts_waitcnt lgkmcnt(0)" : "=&v"(v), "=&v"(tmp) : "i"(LARGS_OFF), "i"(I * 8) : "memory");
    const unsigned lo = __builtin_amdgcn_readfirstlane((unsigned)v), hi = __builtin_amdgcn_readfirstlane((unsigned)(v >> 32));
    return ((unsigned long long)hi << 32) | lo;
}
#define ldarg(C, i) ldarg_t<(i)>()
#define ARGF(i) ((const float*)(const GAS float*)ldarg(C, (i)))
#define WSP(T, off) ((T*)(GAS T*)((GAS unsigned char*)ldarg(C, A_WS) + (off)))

__device__ __forceinline__ void ph_mod_partial(const Ctx& C) {
    const float* cvec = ARGF(A_C); const float* cctx = ARGF(A_CCTX); const float* ada_w = ARGF(A_ADAW);
    float* modp = WSP(float, WS_MODP); float2* tw = WSP(float2, WS_TW);
    LAS float* sl = (LAS float*)C.lds;
    for (int item = C.bx; item < 2 * 8 * 12; item += C.G) {
        const int l = item / 96, rem = item % 96, kc = rem / 12, jb = rem % 12;
        __syncthreads();
        for (int e = C.tid(); e < 5 * 128; e += NTHR) { const int g = e >> 7, k = kc * 128 + (e & 127); const float v = g < 4 ? cvec[g * DM + k] : cctx[k]; sl[e] = v / (1.0f + __expf(-v)); }
        __syncthreads();
        const int tid = C.tid(), jq = tid & 127, kq = tid >> 7;
        const float* wp = ada_w + ((size_t)l * DM + kc * 128 + kq * 32) * NMOD + jb * 512 + 4 * jq;
        f32x4 a[5];
#pragma unroll
        for (int g = 0; g < 5; ++g) a[g] = (f32x4){0.f, 0.f, 0.f, 0.f};
#pragma unroll 16
        for (int k = 0; k < 32; ++k) { const f32x4 wv = *(const f32x4*)(wp + (size_t)k * NMOD);
#pragma unroll
            for (int g = 0; g < 5; ++g) a[g] += sl[g * 128 + kq * 32 + k] * wv; }
        LAS float* red = sl + 1024;
#pragma unroll
        for (int g = 0; g < 5; ++g) { LAS float* rp = red + (kq * 5 + g) * 512 + 4 * jq; rp[0] = a[g][0]; rp[1] = a[g][1]; rp[2] = a[g][2]; rp[3] = a[g][3]; }
        __syncthreads();
        for (int e = tid; e < 5 * 512; e += NTHR) { const int g = e >> 9, c = e & 511;
            modp[((size_t)(l * 8 + kc) * 5 + g) * NMOD + jb * 512 + c] = (red[(0 * 5 + g) * 512 + c] + red[(1 * 5 + g) * 512 + c]) + (red[(2 * 5 + g) * 512 + c] + red[(3 * 5 + g) * 512 + c]); }
    }
    for (int m = C.gt(); m < 8192; m += C.NGT) { float s, c; sincospif((float)m * (1.0f / 4096.0f), &s, &c); tw[m] = make_float2(c, s); }
}
__device__ __forceinline__ void ph_mod_reduce(const Ctx& C) {
    const float* ada_b = ARGF(A_ADAB); const float* modp = WSP(float, WS_MODP); float* mod = WSP(float, WS_MOD);
    for (int e = C.gt(); e < 2 * 5 * NMOD; e += C.NGT) { const int l = e / (5 * NMOD), r = e % (5 * NMOD), j = r % NMOD; float s = ada_b[l * NMOD + j];
#pragma unroll
        for (int kc = 0; kc < 8; ++kc) s += modp[(size_t)(l * 8 + kc) * 5 * NMOD + r];
        mod[e] = s; }
    float* gnt = WSP(float, WS_GN); const float* n1g = ARGF(A_N1G); const float* n2g = ARGF(A_N2G);
    for (int e = C.gt(); e < 2 * 2 * 5 * DM; e += C.NGT) { const int col = e & 1023, grp = (e >> 10) % 5, w = (e / (5 * DM)) & 1, l = e / (10 * DM), j = (w ? 4 : 1) * DM + col;
        float s = ada_b[l * NMOD + j];
#pragma unroll
        for (int kc = 0; kc < 8; ++kc) s += modp[((size_t)(l * 8 + kc) * 5 + grp) * NMOD + j];
        gnt[e] = (w ? n2g : n1g)[l * DM + col] * (1.0f + s); }
}
__device__ __forceinline__ void ph_ctab(const Ctx& C, int l) {
    LAS float* red = (LAS float*)(C.lds + 131072); LAS float* cu = red + 8 * 5 * 64;
    const float* modl = WSP(const float, WS_MOD) + (size_t)l * 5 * NMOD; const float2* tw = WSP(const float2, WS_TW);
    float* cin = WSP(float, WS_CIN) + (size_t)l * 5 * NIN; float* cup = WSP(float, WS_CUP) + (size_t)l * 5 * FF;
    const int lane = C.lane(), w = C.wave, tid = C.tid();
    LAS float* sl = (LAS float*)C.lds;
    for (int it = C.bx; it < 88 + 64; it += C.G) {
        const bool isin = it < 88; const int ldw = isin ? NIN_ORIG : FF, col0 = (isin ? it : it - 88) * 64;
        __syncthreads();
        for (int e = tid; e < 5 * 1024; e += NTHR) sl[e] = modl[(e >> 10) * NMOD + (isin ? 0 : 3 * DM) + (e & 1023)];
        __syncthreads();
        const int rq = lane >> 4, c4 = lane & 15;
        const float* W = (isin ? ARGF(A_WIN) + (size_t)l * DM * NIN_ORIG : ARGF(A_W1) + (size_t)l * DM * FF) + (size_t)(128 * w + rq) * ldw + col0 + 4 * c4;
        f32x4 a[5];
#pragma unroll
        for (int g = 0; g < 5; ++g) a[g] = (f32x4){0.f, 0.f, 0.f, 0.f};
#pragma unroll 8
        for (int i = 0; i < 32; ++i) { const f32x4 wv = *(const f32x4*)(W + (size_t)(4 * i) * ldw); const int kr = 128 * w + 4 * i + rq;
#pragma unroll
            for (int g = 0; g < 5; ++g) a[g] += sl[g * 1024 + kr] * wv; }
#pragma unroll
        for (int g = 0; g < 5; ++g)
#pragma unroll
            for (int e = 0; e < 4; ++e) { float v = a[g][e]; v += __shfl_xor(v, 16); v += __shfl_xor(v, 32); a[g][e] = v; }
        if (lane < 16) {
#pragma unroll
            for (int g = 0; g < 5; ++g) { red[(w * 5 + g) * 64 + 4 * c4] = a[g][0]; red[(w * 5 + g) * 64 + 4 * c4 + 1] = a[g][1]; red[(w * 5 + g) * 64 + 4 * c4 + 2] = a[g][2]; red[(w * 5 + g) * 64 + 4 * c4 + 3] = a[g][3]; } }
        __syncthreads();
        if (tid < 320) { const int g = tid >> 6, c = tid & 63; float v = 0.f;
#pragma unroll
            for (int ww = 0; ww < 8; ++ww) v += red[(ww * 5 + g) * 64 + c];
            if (!isin) cup[g * FF + col0 + c] = v; else if (it >= 4) cin[g * NIN + col0 + c + 256] = v; else cu[g * 64 + c] = v; }
        if (isin && it < 4) { __syncthreads();
            if (tid < 320) { const int g = tid >> 6, kc = tid & 63; float p = 0.f, q = 0.f;
                for (int c = 0; c < 64; ++c) { const float2 t = tw[((c * kc) & 63) * 128]; const float v = cu[g * 64 + c]; p += v * t.x; q += v * t.y; }
                cin[g * NIN + it * 64 + kc] = p; cin[g * NIN + 256 + it * 64 + kc] = q; } }
    }
    __syncthreads();
}
__device__ __forceinline__ void ph_weights(const Ctx& C, int l) {
    LAS float* scr = (LAS float*)(C.lds + C.wave * 16384);
    const int lane = C.lane();
    const float* Win = ARGF(A_WIN) + (size_t)l * DM * NIN_ORIG;
    bf16* win_t = WSP(bf16, WS_WIN); bf16* wm_t = WSP(bf16, WS_WM);
    constexpr int I_IN = (DM / 64) * ((NIN_ORIG - 256) / 32), I_F = (256 / 64) * (DM / 32), I_A = (512 / 64) * (DM / 32), I_O = (DM / 64) * (DM / 32), I_1 = (DM / 64) * (FF / 32), I_2 = (FF / 64) * (DM / 32);
    constexpr int NITEMS = I_IN + 2 * I_F + I_A + I_O + I_1 + I_2;
    for (int it = C.gw; it < NITEMS; it += C.NGW) {
        int r = it;
        if (r < I_IN) { transpose_item(Win + 256, NIN_ORIG, NIN_ORIG - 256, win_t, DM, 512, 0, scr, r, lane); continue; } r -= I_IN;
        if (r < I_F) { transpose_item(ARGF(A_WF) + (size_t)l * 256 * DM, DM, DM, wm_t, DM, 0, 0, scr, r, lane); continue; } r -= I_F;
        if (r < I_F) { transpose_item(ARGF(A_WC) + (size_t)l * 256 * DM, DM, DM, wm_t, DM, 0, 256, scr, r, lane); continue; } r -= I_F;
        if (r < I_A) { transpose_item(ARGF(A_WA) + (size_t)l * 512 * DM, DM, DM, wm_t, DM, 0, 512, scr, r, lane); continue; } r -= I_A;
        if (r < I_O) { transpose_item(ARGF(A_WO) + (size_t)l * DM * DM, DM, DM, WSP(bf16, WS_WO), DM, 0, 0, scr, r, lane); continue; } r -= I_O;
        if (r < I_1) { transpose_item(ARGF(A_W1) + (size_t)l * DM * FF, FF, FF, WSP(bf16, WS_W1), DM, 0, 0, scr, r, lane); continue; } r -= I_1;
        transpose_item(ARGF(A_W2) + (size_t)l * FF * DM, DM, DM, WSP(bf16, WS_W2), FF, 0, 0, scr, r, lane);
    }
    for (int it = C.gw; it < 4 * 32 * 8; it += C.NGW) {
        const int kq = it & 7, g = it >> 8, k0 = ((it >> 3) & 31) * 32, kl = lane & 31, pq = lane >> 5;
        LAS float* tile = scr;
        LAS float* ct = scr + 32 * 65;
        { float s, c; sincospif((float)lane * (1.0f / 32.0f), &s, &c); ct[lane] = c; ct[64 + lane] = s; }
#pragma unroll 8
        for (int kk = 0; kk < 32; ++kk) tile[kk * 65 + lane] = Win[(size_t)(k0 + kk) * NIN_ORIG + g * 64 + lane];
        LDS_WAIT(); asm volatile("" ::: "memory");
        float p[8];
#pragma unroll
        for (int j = 0; j < 8; ++j) p[j] = 0.f;
#pragma unroll 4
        for (int c = 0; c < 64; ++c) { const float wv = tile[kl * 65 + c];
#pragma unroll
            for (int j = 0; j < 8; ++j) p[j] += wv * ct[pq * 64 + ((c * (kq * 8 + j)) & 63)]; }
#pragma unroll
        for (int j = 0; j < 8; ++j) win_t[(size_t)(pq * 256 + g * 64 + kq * 8 + j) * DM + k0 + kl] = (bf16)f2bf(p[j]);
        LDS_WAIT(); asm volatile("" ::: "memory");
    }
}
__device__ __forceinline__ void ph_prenorm(const Ctx& C, const float* xl, const float* xc, const float* gn, bf16* dst, u64* rs, int row_begin, int row_end, const float* part, const float* pgate) {
    const int lane = C.lane();
    for (int row = row_begin + C.gw; row < row_end; row += C.NGW) {
        const bool isc = row >= ML; const int grp = isc ? 4 : (row >> 13);
        const float* xr = isc ? xc + (size_t)(row - ML) * DM : xl + (size_t)row * DM;
        f32x4 v[4]; float s2 = 0.f;
#pragma unroll
        for (int j = 0; j < 4; ++j) { v[j] = *(const f32x4*)(xr + 4 * lane + 256 * j);
            if (part != nullptr && isc) {
                const size_t po = (size_t)(row - ML) * DM + 4 * lane + 256 * j;
                const f32x4 ps = (*(const f32x4*)(part + po) + *(const f32x4*)(part + po + 1048576)) + (*(const f32x4*)(part + po + 2 * 1048576) + *(const f32x4*)(part + po + 3 * 1048576));
                v[j] = v[j] + *(const f32x4*)(pgate + 4 * lane + 256 * j) * ps; }
            s2 += (v[j].x * v[j].x + v[j].y * v[j].y) + (v[j].z * v[j].z + v[j].w * v[j].w); }
        s2 = wave_sum(s2);
        if (lane == 0) rs[row] = (u64)(s2 * 16777216.0f + 0.5f);
#pragma unroll
        for (int j = 0; j < 4; ++j) { const int c0 = 4 * lane + 256 * j; const f32x4 y = v[j] * *(const f32x4*)(gn + grp * DM + c0);
            v2u o; o.x = pk2(y.x, y.y); o.y = pk2(y.z, y.w); *(v2u*)(dst + (size_t)row * DM + c0) = o; }
    }
}
__device__ __forceinline__ void ph_mixers(const Ctx& C, int l) {
    const bf16* pxa = WSP(const bf16, WS_PXA); bf16* mix = WSP(bf16, WS_HX);
    const float* cw = ARGF(A_CONVW) + l * 3 * 256;
    const int nrows = l == 0 ? MT : ML;
    for (int e = C.gt(); e < nrows * 32; e += C.NGT) {
        const int row = e >> 5, ch = (e & 31) * 8;
        const int pos = row < ML ? (row & (SEQ - 1)) : ((row - ML) & 255), len = row < ML ? SEQ : 256;
        const bf16* pr = pxa + (size_t)row * NPXA;
        const v4u u1 = *(const v4u*)(pr + OFF_CU + ch), c1 = *(const v4u*)(pr + OFF_CC + ch), b1 = *(const v4u*)(pr + OFF_CB + ch);
        v4u u0 = (v4u){0, 0, 0, 0}, c0 = u0, u2 = u0, c2 = u0;
        if (pos > 0) { u0 = *(const v4u*)(pr - NPXA + OFF_CU + ch); c0 = *(const v4u*)(pr - NPXA + OFF_CC + ch); }
        if (pos < len - 1) { u2 = *(const v4u*)(pr + NPXA + OFF_CU + ch); c2 = *(const v4u*)(pr + NPXA + OFF_CC + ch); }
        float o[8]; float w0[8], w1[8], w2[8];
        { const f32x4 t0 = *(const f32x4*)(cw + ch), t1 = *(const f32x4*)(cw + ch + 4), t2 = *(const f32x4*)(cw + 256 + ch), t3 = *(const f32x4*)(cw + 256 + ch + 4), t4 = *(const f32x4*)(cw + 512 + ch), t5 = *(const f32x4*)(cw + 512 + ch + 4);
#pragma unroll
          for (int j = 0; j < 4; ++j) { w0[j] = t0[j]; w0[4 + j] = t1[j]; w1[j] = t2[j]; w1[4 + j] = t3[j]; w2[j] = t4[j]; w2[4 + j] = t5[j]; } }
#pragma unroll
        for (int j = 0; j < 4; ++j) {
            const unsigned a0 = u0[j], d0 = c0[j], a1 = u1[j], d1 = c1[j], a2 = u2[j], d2 = c2[j], bb = b1[j];
            o[2 * j] = bflo(bb) * (w0[2 * j] * bflo(a0) * bflo(d0) + w1[2 * j] * bflo(a1) * bflo(d1) + w2[2 * j] * bflo(a2) * bflo(d2));
            o[2 * j + 1] = bfhi(bb) * (w0[2 * j + 1] * bfhi(a0) * bfhi(d0) + w1[2 * j + 1] * bfhi(a1) * bfhi(d1) + w2[2 * j + 1] * bfhi(a2) * bfhi(d2));
        }
        v4u w; w.x = pk2(o[0], o[1]); w.y = pk2(o[2], o[3]); w.z = pk2(o[4], o[5]); w.w = pk2(o[6], o[7]);
        *(v4u*)(mix + (size_t)row * DM + 256 + ch) = w;
    }
}

typedef short bf16x8_t __attribute__((ext_vector_type(8)));
typedef short v4i16_t __attribute__((ext_vector_type(4)));
constexpr int AT_KW = 0, AT_VW = 73728, AT_BT = 147456;
template <bool WIN>
__device__ __forceinline__ void attn_qk(LAS unsigned char* lds, const int (&ka)[2][2], int rowoff0, const bf16x8_t (&qf)[2], f32x4 (&s)[8][2]) {
    constexpr int RS = WIN ? 8192 : 4096;
#pragma unroll
    for (int j = 0; j < 8; ++j)
#pragma unroll
        for (int t = 0; t < 2; ++t) { s[j][t] = (f32x4){0.f, 0.f, 0.f, 0.f};
#pragma unroll
            for (int ks = 0; ks < 2; ++ks) { const bf16x8_t kf = *(const LAS bf16x8_t*)(lds + ka[t][ks] + rowoff0 + j * RS); s[j][t] = __builtin_amdgcn_mfma_f32_16x16x32_bf16(kf, qf[ks], s[j][t], 0, 0, 0); } }
}
template <bool WIN>
__device__ __forceinline__ void attn_sm_pv(LAS unsigned char* lds, f32x4 (&s)[8][2], const int (&va)[2][4], int rowoff0,
                                           const LAS float* brow  , const int (&dcs)[4]  , unsigned vmask  ,
                                           f32x4 (&o)[4], f32x4& osum, float& m) {
    constexpr float SC = 0.18033688011112042f;
    constexpr int RS = WIN ? 8192 : 4096;
    const v4u onesw = (v4u){0x3F803F80u, 0x3F803F80u, 0x3F803F80u, 0x3F803F80u}; const bf16x8_t ones = __builtin_bit_cast(bf16x8_t, onesw);
    if constexpr (WIN) {
        const bool v0 = vmask & 1u, v1 = vmask & 2u, v2 = vmask & 4u, v3 = vmask & 8u;
        const unsigned hm01 = (v0 ? 0xFFFFu : 0u) | (v1 ? 0xFFFF0000u : 0u), hm23 = (v2 ? 0xFFFFu : 0u) | (v3 ? 0xFFFF0000u : 0u);
        float tmax = -1e30f;
#pragma unroll
        for (int j = 0; j < 8; ++j) {
            f32x4 v;
            v[0] = (v0 ? s[j][0][0] : s[j][1][0]) * SC + brow[j * 31 + dcs[0]]; v[1] = (v1 ? s[j][0][1] : s[j][1][1]) * SC + brow[j * 31 + dcs[1]];
            v[2] = (v2 ? s[j][0][2] : s[j][1][2]) * SC + brow[j * 31 + dcs[2]]; v[3] = (v3 ? s[j][0][3] : s[j][1][3]) * SC + brow[j * 31 + dcs[3]];
            s[j][0] = v; tmax = fmaxf(tmax, fmaxf(fmaxf(v[0], v[1]), fmaxf(v[2], v[3]))); }
        tmax = fmaxf(tmax, __shfl_xor(tmax, 16)); tmax = fmaxf(tmax, __shfl_xor(tmax, 32));
        const float mn = fmaxf(m, tmax), alpha = __builtin_amdgcn_exp2f(m - mn); m = mn;
#pragma unroll
        for (int db = 0; db < 4; ++db) o[db] = o[db] * alpha;
        osum = osum * alpha;
#pragma unroll
        for (int j = 0; j < 8; ++j) {
            const unsigned p01 = pg8::cvt_pk_bf16(__builtin_amdgcn_exp2f(s[j][0][0] - mn), __builtin_amdgcn_exp2f(s[j][0][1] - mn)), p23 = pg8::cvt_pk_bf16(__builtin_amdgcn_exp2f(s[j][0][2] - mn), __builtin_amdgcn_exp2f(s[j][0][3] - mn));
            v4u pw; pw.x = p01 & hm01; pw.y = p23 & hm23; pw.z = p01 & ~hm01; pw.w = p23 & ~hm23;
            const bf16x8_t pf = __builtin_bit_cast(bf16x8_t, pw);
            osum = __builtin_amdgcn_mfma_f32_16x16x32_bf16(ones, pf, osum, 0, 0, 0);
#pragma unroll
            for (int db = 0; db < 4; ++db) {
                const v4i16_t lo = __builtin_amdgcn_ds_read_tr16_b64_v4i16((LAS v4i16_t*)(lds + va[0][db] + rowoff0 + j * RS));
                const v4i16_t hi = __builtin_amdgcn_ds_read_tr16_b64_v4i16((LAS v4i16_t*)(lds + va[1][db] + rowoff0 + j * RS));
                const bf16x8_t vf = (bf16x8_t){lo[0], lo[1], lo[2], lo[3], hi[0], hi[1], hi[2], hi[3]};
                o[db] = __builtin_amdgcn_mfma_f32_16x16x32_bf16(vf, pf, o[db], 0, 0, 0);
            }
        }
    } else {
        float tmax = -1e30f;
#pragma unroll
        for (int j = 0; j < 8; ++j)
#pragma unroll
            for (int t = 0; t < 2; ++t) tmax = fmaxf(tmax, fmaxf(fmaxf(s[j][t][0], s[j][t][1]), fmaxf(s[j][t][2], s[j][t][3])));
        tmax = fmaxf(tmax, __shfl_xor(tmax, 16)); tmax = fmaxf(tmax, __shfl_xor(tmax, 32));
        const float mn = fmaxf(m, tmax * SC), alpha = __builtin_amdgcn_exp2f(m - mn); m = mn;
#pragma unroll
        for (int db = 0; db < 4; ++db) o[db] = o[db] * alpha;
        osum = osum * alpha;
#pragma unroll
        for (int j = 0; j < 8; ++j) {
            v4u pw;
            pw.x = pg8::cvt_pk_bf16(__builtin_amdgcn_exp2f(s[j][0][0] * SC - mn), __builtin_amdgcn_exp2f(s[j][0][1] * SC - mn)); pw.y = pg8::cvt_pk_bf16(__builtin_amdgcn_exp2f(s[j][0][2] * SC - mn), __builtin_amdgcn_exp2f(s[j][0][3] * SC - mn));
            pw.z = pg8::cvt_pk_bf16(__builtin_amdgcn_exp2f(s[j][1][0] * SC - mn), __builtin_amdgcn_exp2f(s[j][1][1] * SC - mn)); pw.w = pg8::cvt_pk_bf16(__builtin_amdgcn_exp2f(s[j][1][2] * SC - mn), __builtin_amdgcn_exp2f(s[j][1][3] * SC - mn));
            const bf16x8_t pf = __builtin_bit_cast(bf16x8_t, pw);
            osum = __builtin_amdgcn_mfma_f32_16x16x32_bf16(ones, pf, osum, 0, 0, 0);
#pragma unroll
            for (int db = 0; db < 4; ++db) {
                const v4i16_t lo = __builtin_amdgcn_ds_read_tr16_b64_v4i16((LAS v4i16_t*)(lds + va[0][db] + rowoff0 + j * RS));
                const v4i16_t hi = __builtin_amdgcn_ds_read_tr16_b64_v4i16((LAS v4i16_t*)(lds + va[1][db] + rowoff0 + j * RS));
                const bf16x8_t vf = (bf16x8_t){lo[0], lo[1], lo[2], lo[3], hi[0], hi[1], hi[2], hi[3]};
                o[db] = __builtin_amdgcn_mfma_f32_16x16x32_bf16(vf, pf, o[db], 0, 0, 0);
            }
        }
    }
}
template <bool WIN>
__device__ __forceinline__ void attn_block(LAS unsigned char* lds, const int (&ka)[2][2], const int (&va)[2][4], int rowoff0, const bf16x8_t (&qf)[2],
                                           const LAS float* brow, const int (&dcs)[4], unsigned vmask, f32x4 (&o)[4], f32x4& osum, float& m) {
    f32x4 s[8][2];
    attn_qk<WIN>(lds, ka, rowoff0, qf, s);
    attn_sm_pv<WIN>(lds, s, va, rowoff0, brow, dcs, vmask, o, osum, m);
}
__device__ __forceinline__ void attn_addr(int kc0off, int li, int fq, int (&ka)[2][2], int (&va)[2][4]) {
#pragma unroll
    for (int t = 0; t < 2; ++t) {
        const int rk = kc0off + 16 * t + li;
#pragma unroll
        for (int ks = 0; ks < 2; ++ks) ka[t][ks] = AT_KW + rk * 128 + (((4 * ks + fq) ^ ((rk >> 1) & 7)) * 16);
        const int rv = kc0off + 16 * t + 4 * fq + (li >> 2), p = li & 3;
#pragma unroll
        for (int db = 0; db < 4; ++db) va[t][db] = AT_VW + rv * 128 + (((2 * db + (p >> 1)) ^ (((rv >> 1) & 3) << 1)) * 16) + (p & 1) * 8;
    }
}

__device__ __forceinline__ void ph_ctx_dft(const Ctx& C) {
    if (C.bx >= 32) return;
    constexpr int DF_Q = 32768, DF_TW = AT_VW + 65536;
    static_assert(DF_TW + 2048 <= AT_BT, "ctx dft lds");
    const float2* tw = WSP(const float2, WS_TW); const bf16* pxa = WSP(const bf16, WS_PXA); bf16* mix = WSP(bf16, WS_HX);
    LAS unsigned char* lds = C.lds; LAS float* twl = (LAS float*)(lds + DF_TW);
    const int lane = C.lane(), w = C.wave, li = lane & 15, fq = lane >> 4, tid = C.tid();
    const int b = C.bx >> 3, kcb = (C.bx >> 1) & 3, kh = C.bx & 1;
    if (tid < 256) { const float2 v = tw[tid * 32]; twl[2 * tid] = v.x; twl[2 * tid + 1] = v.y; }
    for (int p = w; p < 32; p += 8) {
        const int tokl = p * 8 + (lane >> 3), cp = lane & 7;
        const bf16* src = pxa + ((size_t)ML + b * 256 + tokl) * NPXA + kcb * 64 + ((cp ^ (((tokl >> 1) & 3) << 1)) * 8);
        __builtin_amdgcn_global_load_lds((const unsigned*)(src + OFF_P), (LAS unsigned*)(lds + AT_VW + p * 1024), 16, 0, 0);
        __builtin_amdgcn_global_load_lds((const unsigned*)(src + OFF_Q), (LAS unsigned*)(lds + AT_VW + DF_Q + p * 1024), 16, 0, 0);
    }
    int ka[2][2], va[2][4]; attn_addr(0, li, fq, ka, va);
    asm volatile("s_waitcnt vmcnt(0) lgkmcnt(0)" ::: "memory");
    __syncthreads();
    const int k = 128 * kh + 16 * w + li;
    f32x4 o[4];
#pragma unroll
    for (int db = 0; db < 4; ++db) o[db] = (f32x4){0.f, 0.f, 0.f, 0.f};
#pragma unroll 2
    for (int j = 0; j < 8; ++j) {
        float cs[8], sn[8];
#pragma unroll
        for (int t = 0; t < 2; ++t)
#pragma unroll
            for (int i = 0; i < 4; ++i) { const int n = 32 * j + 16 * t + 4 * fq + i, idx = (n * k) & 255; cs[4 * t + i] = twl[2 * idx]; sn[4 * t + i] = -twl[2 * idx + 1]; }
        v4u cw, sw;
        cw.x = pg8::cvt_pk_bf16(cs[0], cs[1]); cw.y = pg8::cvt_pk_bf16(cs[2], cs[3]); cw.z = pg8::cvt_pk_bf16(cs[4], cs[5]); cw.w = pg8::cvt_pk_bf16(cs[6], cs[7]);
        sw.x = pg8::cvt_pk_bf16(sn[0], sn[1]); sw.y = pg8::cvt_pk_bf16(sn[2], sn[3]); sw.z = pg8::cvt_pk_bf16(sn[4], sn[5]); sw.w = pg8::cvt_pk_bf16(sn[6], sn[7]);
        const bf16x8_t cf = __builtin_bit_cast(bf16x8_t, cw), sf = __builtin_bit_cast(bf16x8_t, sw);
#pragma unroll
        for (int db = 0; db < 4; ++db) {
            const v4i16_t plo = __builtin_amdgcn_ds_read_tr16_b64_v4i16((LAS v4i16_t*)(lds + va[0][db] + j * 4096)), phi = __builtin_amdgcn_ds_read_tr16_b64_v4i16((LAS v4i16_t*)(lds + va[1][db] + j * 4096));
            const v4i16_t qlo = __builtin_amdgcn_ds_read_tr16_b64_v4i16((LAS v4i16_t*)(lds + va[0][db] + DF_Q + j * 4096)), qhi = __builtin_amdgcn_ds_read_tr16_b64_v4i16((LAS v4i16_t*)(lds + va[1][db] + DF_Q + j * 4096));
            const bf16x8_t pf = (bf16x8_t){plo[0], plo[1], plo[2], plo[3], phi[0], phi[1], phi[2], phi[3]}, qf = (bf16x8_t){qlo[0], qlo[1], qlo[2], qlo[3], qhi[0], qhi[1], qhi[2], qhi[3]};
            o[db] = __builtin_amdgcn_mfma_f32_16x16x32_bf16(pf, cf, o[db], 0, 0, 0);
            o[db] = __builtin_amdgcn_mfma_f32_16x16x32_bf16(qf, sf, o[db], 0, 0, 0);
        }
    }
    bf16* op = mix + ((size_t)ML + b * 256 + k) * DM + kcb * 64 + 4 * fq;
#pragma unroll
    for (int db = 0; db < 4; ++db) { v2u ov; ov.x = pk2(o[db][0] * (1.0f / 128.0f), o[db][1] * (1.0f / 128.0f)); ov.y = pk2(o[db][2] * (1.0f / 128.0f), o[db][3] * (1.0f / 128.0f)); *(v2u*)(op + 16 * db) = ov; }
}

__device__ __forceinline__ size_t zt_off(int b) { return b < 2 ? WS_TB + (size_t)b * 8 * MiB : (b == 2 ? (size_t)502 * MiB : WS_WIN); }
__device__ __forceinline__ void ph_t1(const Ctx& C) {
    const bf16* pxa = WSP(const bf16, WS_PXA); const int lane = C.lane();
    LAS unsigned short* tile = (LAS unsigned short*)(C.lds + C.wave * 9216);
    for (int it = C.gw; it < 4 * 2 * 128 * 4; it += C.NGW) {
        const int kcb = it & 3, n2 = (it >> 2) & 127, pq = (it >> 9) & 1, b = it >> 10;
#pragma unroll
        for (int i = 0; i < 8; ++i) { const int q = i * 64 + lane, n1 = q >> 3, cc = q & 7;
            const v4u v = *(const v4u*)(pxa + ((size_t)b * SEQ + n1 * 128 + n2) * NPXA + pq * 256 + kcb * 64 + cc * 8);
            *(LAS v4u*)(tile + n1 * 72 + cc * 8) = v; }
        LDS_WAIT(); asm volatile("" ::: "memory");
        bf16* zt = WSP(bf16, zt_off(b)) + ((size_t)(pq * 256 + kcb * 64 + lane) * SEQ + n2 * 64);
#pragma unroll
        for (int c = 0; c < 8; ++c) { v4u o;
            o.x = (unsigned)tile[(8 * c + 0) * 72 + lane] | ((unsigned)tile[(8 * c + 1) * 72 + lane] << 16); o.y = (unsigned)tile[(8 * c + 2) * 72 + lane] | ((unsigned)tile[(8 * c + 3) * 72 + lane] << 16);
            o.z = (unsigned)tile[(8 * c + 4) * 72 + lane] | ((unsigned)tile[(8 * c + 5) * 72 + lane] << 16); o.w = (unsigned)tile[(8 * c + 6) * 72 + lane] | ((unsigned)tile[(8 * c + 7) * 72 + lane] << 16);
            *(v4u*)(zt + 8 * c) = o; }
        LDS_WAIT(); asm volatile("" ::: "memory");
    }
}
typedef float f32x16 __attribute__((ext_vector_type(16)));
constexpr int FT_C64 = 0, FT_S64 = 9216, FT_C128 = 18432, FT_S128 = FT_C128 + 34816, FT_TA = FT_S128 + 34816, FT_TR = FT_TA + 4096, FT_ST = FT_TR + 8192;
static_assert(FT_ST + 32768 <= LDSCTL_OFF, "fft lds");
__device__ __forceinline__ void hw_sincos_rev(float rev, float& sn, float& cs) { sn = __builtin_amdgcn_sinf(rev); cs = __builtin_amdgcn_cosf(rev); }
__device__ __forceinline__ int crow16(int r, int h) { return (r & 3) + 8 * (r >> 2) + 4 * h; }
__device__ __forceinline__ void ph_fft(const Ctx& C) {
    LAS unsigned char* lds = C.lds; const int tid = C.tid(), lane = C.lane(), w = C.wave, h = lane >> 5, c = lane & 31;
    const float2* tw = WSP(const float2, WS_TW); bf16* mix = WSP(bf16, WS_HX);
    { LAS unsigned short* c64 = (LAS unsigned short*)(lds + FT_C64); LAS unsigned short* s64 = (LAS unsigned short*)(lds + FT_S64);
#pragma unroll 4
      for (int e = tid; e < 4096; e += NTHR) { const int k1 = e >> 6, n1 = e & 63; float sn, cs; hw_sincos_rev(0.5f * ((float)((n1 * k1) & 63) * (1.0f / 32.0f)), sn, cs); c64[k1 * 72 + n1] = (unsigned short)f2bf(cs); s64[k1 * 72 + n1] = (unsigned short)f2bf(sn); }
      LAS unsigned short* c128 = (LAS unsigned short*)(lds + FT_C128); LAS unsigned short* s128 = (LAS unsigned short*)(lds + FT_S128);
#pragma unroll 4
      for (int e = tid; e < 16384; e += NTHR) { const int k2 = e >> 7, p = e & 127, q = p & 15, n2 = (p & ~15) + (q & 3) + ((q >> 2) & 1) * 8 + ((q >> 3) & 1) * 4;
          float sn, cs; hw_sincos_rev(0.5f * ((float)((n2 * k2) & 127) * (1.0f / 64.0f)), sn, cs); c128[k2 * 136 + p] = (unsigned short)f2bf(cs); s128[k2 * 136 + p] = (unsigned short)f2bf(sn); }
      LAS float* ta = (LAS float*)(lds + FT_TA); LAS float* trt = (LAS float*)(lds + FT_TR);
      { const int e = tid, g = e >> 6, kk = e & 63; float sn, cs; hw_sincos_rev(0.5f * ((float)((32 * (g >> 1) + 4 * (g & 1)) * kk) * (1.0f / 4096.0f)), sn, cs); ta[2 * e] = cs; ta[2 * e + 1] = sn; }
      for (int e = tid; e < 1024; e += NTHR) { const int r = e >> 6, kk = e & 63; float sn, cs; hw_sincos_rev(0.5f * ((float)(crow16(r, 0) * kk) * (1.0f / 4096.0f)), sn, cs); trt[2 * e] = cs; trt[2 * e + 1] = sn; }
    }
    __syncthreads();
    const int vcu = (C.G % 8 == 0) ? (C.bx % 8) * (C.G / 8) + C.bx / 8 : C.bx;
    for (int it = vcu; it < 256; it += C.G) {
        const int kb = it & 1, kcg = (it >> 1) & 31, b = it >> 6, kc = kcg * 8 + w, k1 = 32 * kb + c;
        const bf16* zp = WSP(const bf16, zt_off(b)) + (size_t)kc * SEQ; const bf16* zq = zp + (size_t)256 * SEQ;
        f32x16 acc[4];
#pragma unroll
        for (int rb2 = 0; rb2 < 4; ++rb2) acc[rb2] = (f32x16){};
#pragma unroll 1
        for (int rb = 0; rb < 4; ++rb) {
            const int n2 = 32 * rb + c;
            f32x16 xr = {}, xi = {};
#pragma unroll
            for (int ks = 0; ks < 4; ++ks) {
                const bf16x8_t cf = *(const LAS bf16x8_t*)(lds + FT_C64 + (k1 * 72 + 16 * ks + 8 * h) * 2), sf = *(const LAS bf16x8_t*)(lds + FT_S64 + (k1 * 72 + 16 * ks + 8 * h) * 2);
                const bf16x8_t pf = *(const bf16x8_t*)(zp + n2 * 64 + 16 * ks + 8 * h), qf = *(const bf16x8_t*)(zq + n2 * 64 + 16 * ks + 8 * h);
                const v4u t = __builtin_bit_cast(v4u, qf) ^ 0x80008000u; const bf16x8_t qn = __builtin_bit_cast(bf16x8_t, t);
                xr = __builtin_amdgcn_mfma_f32_32x32x16_bf16(pf, cf, xr, 0, 0, 0); xi = __builtin_amdgcn_mfma_f32_32x32x16_bf16(pf, sf, xi, 0, 0, 0);
                xi = __builtin_amdgcn_mfma_f32_32x32x16_bf16(qf, cf, xi, 0, 0, 0); xr = __builtin_amdgcn_mfma_f32_32x32x16_bf16(qn, sf, xr, 0, 0, 0); }
            bf16x8_t bre[2], bim[2];
            const LAS float* tap = (const LAS float*)(lds + FT_TA) + 2 * ((rb * 2 + h) * 64 + k1); const float ac_ = tap[0], as_ = tap[1];
            const LAS float* trp = (const LAS float*)(lds + FT_TR) + 2 * k1;
#pragma unroll
            for (int sblk = 0; sblk < 2; ++sblk) {
                float tr[8], ti[8];
#pragma unroll
                for (int r8 = 0; r8 < 8; ++r8) { const int r = 8 * sblk + r8; const float rc = trp[128 * r], rs = trp[128 * r + 1]; const float tc = ac_ * rc - as_ * rs, ts = ac_ * rs + as_ * rc;
                    tr[r8] = xr[r] * tc - xi[r] * ts; ti[r8] = -(xr[r] * ts + xi[r] * tc); }
                v4u a, bq;
                a.x = pg8::cvt_pk_bf16(tr[0], tr[1]); a.y = pg8::cvt_pk_bf16(tr[2], tr[3]); a.z = pg8::cvt_pk_bf16(tr[4], tr[5]); a.w = pg8::cvt_pk_bf16(tr[6], tr[7]);
                bq.x = pg8::cvt_pk_bf16(ti[0], ti[1]); bq.y = pg8::cvt_pk_bf16(ti[2], ti[3]); bq.z = pg8::cvt_pk_bf16(ti[4], ti[5]); bq.w = pg8::cvt_pk_bf16(ti[6], ti[7]);
                bre[sblk] = __builtin_bit_cast(bf16x8_t, a); bim[sblk] = __builtin_bit_cast(bf16x8_t, bq); }
#pragma unroll
            for (int rb2 = 0; rb2 < 4; ++rb2) {
                const int k2 = 32 * rb2 + c;
#pragma unroll
                for (int sblk = 0; sblk < 2; ++sblk) {
                    const bf16x8_t ac = *(const LAS bf16x8_t*)(lds + FT_C128 + (k2 * 136 + 32 * rb + 16 * sblk + 8 * h) * 2), as = *(const LAS bf16x8_t*)(lds + FT_S128 + (k2 * 136 + 32 * rb + 16 * sblk + 8 * h) * 2);
                    acc[rb2] = __builtin_amdgcn_mfma_f32_32x32x16_bf16(ac, bre[sblk], acc[rb2], 0, 0, 0); acc[rb2] = __builtin_amdgcn_mfma_f32_32x32x16_bf16(as, bim[sblk], acc[rb2], 0, 0, 0); }
            }
        }
#pragma unroll
        for (int rb2 = 0; rb2 < 4; ++rb2) {
            LAS unsigned short* st = (LAS unsigned short*)(lds + FT_ST + (rb2 & 1) * 16384);
#pragma unroll
            for (int r = 0; r < 16; ++r) st[((crow16(r, h) * 32 + c) * 8) + w] = (unsigned short)f2bf(acc[rb2][r] * 0.001381067932f);
            LDS_WAIT(); __syncthreads();
#pragma unroll
            for (int j = 0; j < 2; ++j) { const int idx = tid + 512 * j, k2l = idx >> 5, k1l = idx & 31;
                const v4u v = *(const LAS v4u*)(st + idx * 8);
                *(v4u*)(mix + ((size_t)b * SEQ + 32 * kb + k1l + 64 * (32 * rb2 + k2l)) * DM + kcg * 8) = v; }
        }
        __syncthreads();
    }
}
__device__ __forceinline__ void attn_stage_win(LAS unsigned char* lds, const bf16* pxa, int b, int h, int R0, int w, int lane, bool isV) {
    for (int p = w; p < 72; p += 8) {
        const int tokl = p * 8 + (lane >> 3), lr = tokl >> 6, col = tokl & 63, gr = min(R0 + lr, 127), cp = lane & 7;
        const bf16* src = pxa + ((size_t)b * SEQ + gr * 64 + col) * NPXA + h * 64;
        if (!isV) __builtin_amdgcn_global_load_lds((const unsigned*)(src + OFF_K + ((cp ^ ((tokl >> 1) & 7)) * 8)), (LAS unsigned*)(lds + AT_KW + p * 1024), 16, 0, 0);
        else __builtin_amdgcn_global_load_lds((const unsigned*)(src + OFF_V + ((cp ^ (((tokl >> 1) & 3) << 1)) * 8)), (LAS unsigned*)(lds + AT_VW + p * 1024), 16, 0, 0);
    }
}
__device__ __forceinline__ void attn_stage_ctx(LAS unsigned char* lds, const bf16* pxa, int b, int h, int w, int lane, bool isV) {
    for (int p = w; p < 32; p += 8) {
        const int tokl = p * 8 + (lane >> 3), cp = lane & 7;
        const bf16* src = pxa + ((size_t)ML + b * 256 + tokl) * NPXA + h * 64;
        if (!isV) __builtin_amdgcn_global_load_lds((const unsigned*)(src + OFF_K + ((cp ^ ((tokl >> 1) & 7)) * 8)), (LAS unsigned*)(lds + AT_KW + p * 1024), 16, 0, 0);
        else __builtin_amdgcn_global_load_lds((const unsigned*)(src + OFF_V + ((cp ^ (((tokl >> 1) & 3) << 1)) * 8)), (LAS unsigned*)(lds + AT_VW + p * 1024), 16, 0, 0);
    }
}
#define AT_BAR() do { asm volatile("s_waitcnt lgkmcnt(0)" ::: "memory"); __builtin_amdgcn_s_barrier(); asm volatile("" ::: "memory"); } while (0)
__device__ __forceinline__ void ph_attn(const Ctx& C, int l) {
    const bf16* pxa = WSP(const bf16, WS_PXA); bf16* mix = WSP(bf16, WS_HX);
    const float* rb = ARGF(A_RELB) + (size_t)l * 8 * 15 * 31;
    LAS unsigned char* lds = C.lds; LAS float* biasT = (LAS float*)(lds + AT_BT);
    const int lane = C.lane(), w = C.wave, fq = lane >> 4, li = lane & 15, tid = C.tid(), tb = min(tid, 464);
    const int vcu = (C.G % 8 == 0) ? (C.bx % 8) * (C.G / 8) + C.bx / 8 : C.bx;
    __syncthreads();
    int u = vcu;
    if (u < 2048) {
        int b = u >> 9, h = (u >> 6) & 7, rp = u & 63, R0 = min(max(2 * rp - 4, 0), 120);
        attn_stage_win(lds, pxa, b, h, R0, w, lane, false); attn_stage_win(lds, pxa, b, h, R0, w, lane, true);
        bf16x8_t qf[2];
        { const size_t token = (size_t)b * SEQ + (2 * rp + (w >> 2)) * 64 + 16 * (w & 3) + li;
#pragma unroll
          for (int ks = 0; ks < 2; ++ks) qf[ks] = *(const bf16x8_t*)(pxa + token * NPXA + OFF_QQ + h * 64 + 32 * ks + 8 * fq); }
        { const float bv = rb[h * 465 + tb] * 1.4426950408889634f; asm volatile("s_waitcnt vmcnt(0)" ::: "memory"); if (tid < 465) biasT[tid] = bv; }
        AT_BAR();
        for (;;) {
            const int un = u + C.G; const bool has_next = un < 2048;
            const int bn_ = un >> 9, hn = (un >> 6) & 7, rpn = un & 63, R0n = min(max(2 * rpn - 4, 0), 120);
            const int r = 2 * rp + (w >> 2), qc = 16 * (w & 3) + li; const size_t token = (size_t)b * SEQ + r * 64 + qc;
            f32x4 o[4], osum = (f32x4){0.f, 0.f, 0.f, 0.f}; float m = -1e30f;
#pragma unroll
            for (int db = 0; db < 4; ++db) o[db] = (f32x4){0.f, 0.f, 0.f, 0.f};
            int ka[2][2], va[2][4], dcs[4];
            const int cb = w & 3, kc0 = cb == 0 ? 0 : cb == 1 ? 8 : cb == 2 ? 24 : 32;
            attn_addr(kc0, li, fq, ka, va);
            const int csq = min(max(qc - 8, 0), 48); unsigned vmask = 0u;
#pragma unroll
            for (int i = 0; i < 4; ++i) { const int kc_ = kc0 + 4 * fq + i; const bool in0 = kc_ >= csq && kc_ < csq + 16; if (in0) vmask |= 1u << i; dcs[i] = min(max((in0 ? kc_ : kc_ + 16) - qc + 15, 0), 30); }
            const int rsr = min(max(r - 4, 0), 120), lr0 = rsr - R0;
            f32x4 s[8][2];
            attn_qk<true>(lds, ka, lr0 * 8192, qf, s);
            asm volatile("s_waitcnt vmcnt(0)" ::: "memory");
            AT_BAR();
            attn_stage_ctx(lds, pxa, b, h, w, lane, false);
            asm volatile("" ::: "memory");
            bf16x8_t qn[2] = {qf[0], qf[1]}; float bnv = 0.f;
            if (has_next) { const size_t tokn = (size_t)bn_ * SEQ + (2 * rpn + (w >> 2)) * 64 + 16 * (w & 3) + li;
#pragma unroll
                for (int ks = 0; ks < 2; ++ks) qn[ks] = *(const bf16x8_t*)(pxa + tokn * NPXA + OFF_QQ + hn * 64 + 32 * ks + 8 * fq);
                bnv = rb[hn * 465 + tb]; }
            asm volatile("" ::: "memory");
            attn_sm_pv<true>(lds, s, va, lr0 * 8192, biasT + (rsr - r + 7) * 31, dcs, vmask, o, osum, m);
            if (has_next) asm volatile("s_waitcnt vmcnt(3)" ::: "memory"); else asm volatile("s_waitcnt vmcnt(0)" ::: "memory");
            AT_BAR();
            attn_stage_ctx(lds, pxa, b, h, w, lane, true);
            attn_addr(0, li, fq, ka, va);
            attn_qk<false>(lds, ka, 0, qf, s);
            AT_BAR();
            if (has_next) attn_stage_win(lds, pxa, bn_, hn, R0n, w, lane, false);
            asm volatile("" ::: "memory");
            if (has_next) asm volatile("s_waitcnt vmcnt(9)" ::: "memory"); else asm volatile("s_waitcnt vmcnt(0)" ::: "memory");
            AT_BAR();
            attn_sm_pv<false>(lds, s, va, 0, (const LAS float*)nullptr, dcs, 0xfu, o, osum, m);
            asm volatile("s_waitcnt vmcnt(0)" ::: "memory");
            asm volatile("" : "+v"(qn[0]), "+v"(qn[1]), "+v"(bnv));
            if (has_next && tid < 465) biasT[tid] = bnv * 1.4426950408889634f;
            AT_BAR();
            { const float inv = __builtin_amdgcn_rcpf(osum[0]);
              bf16* op = mix + token * DM + 512 + h * 64 + 4 * fq;
#pragma unroll
              for (int db = 0; db < 4; ++db) { v2u ov; ov.x = pk2(o[db][0] * inv, o[db][1] * inv); ov.y = pk2(o[db][2] * inv, o[db][3] * inv); *(v2u*)(op + 16 * db) = ov; } }
            if (!has_next) break;
            attn_stage_win(lds, pxa, bn_, hn, R0n, w, lane, true);
            u = un; b = bn_; h = hn; rp = rpn; R0 = R0n; qf[0] = qn[0]; qf[1] = qn[1];
        }
    }
    if (l == 0 && vcu < 64) {
        const int v = vcu, b = v >> 4, h = (v >> 1) & 7, rp = v & 1;
        asm volatile("s_waitcnt vmcnt(0)" ::: "memory");
        __syncthreads();
        attn_stage_ctx(lds, pxa, b, h, w, lane, false); attn_stage_ctx(lds, pxa, b, h, w, lane, true);
        const size_t token = (size_t)ML + b * 256 + rp * 128 + 16 * w + li;
        bf16x8_t qf[2];
#pragma unroll
        for (int ks = 0; ks < 2; ++ks) qf[ks] = *(const bf16x8_t*)(pxa + token * NPXA + OFF_QQ + h * 64 + 32 * ks + 8 * fq);
        f32x4 o[4], osum = (f32x4){0.f, 0.f, 0.f, 0.f}; float m = -1e30f;
#pragma unroll
        for (int db = 0; db < 4; ++db) o[db] = (f32x4){0.f, 0.f, 0.f, 0.f};
        int ka[2][2], va[2][4], dcs[4] = {0, 0, 0, 0};
        attn_addr(0, li, fq, ka, va);
        asm volatile("s_waitcnt vmcnt(0)" ::: "memory");
        __syncthreads();
        attn_block<false>(lds, ka, va, 0, qf, (const LAS float*)nullptr, dcs, 0xfu, o, osum, m);
        const float inv = __builtin_amdgcn_rcpf(osum[0]);
        bf16* op = mix + token * DM + 512 + h * 64 + 4 * fq;
#pragma unroll
        for (int db = 0; db < 4; ++db) { v2u ov; ov.x = pk2(o[db][0] * inv, o[db][1] * inv); ov.y = pk2(o[db][2] * inv, o[db][3] * inv); *(v2u*)(op + 16 * db) = ov; }
    }
}

template <int KS>
__device__ __forceinline__ void wg_core(const bf16* A, const bf16* W, int li, int fq, f32x4 (&acc)[4][2]) {
    const bf16* ap = A + (size_t)li * DM + 8 * fq; const bf16* wp = W + (size_t)li * DM + 8 * fq;
    bf16x8_t af[4][4], wf[4][2];
#pragma unroll
    for (int s = 0; s < 3; ++s) {
#pragma unroll
        for (int m = 0; m < 4; ++m) af[s][m] = *(const bf16x8_t*)(ap + (size_t)(16 * m) * DM + 32 * s);
#pragma unroll
        for (int n = 0; n < 2; ++n) wf[s][n] = *(const bf16x8_t*)(wp + (size_t)(16 * n) * DM + 32 * s); }
#pragma unroll
    for (int s = 0; s < KS; ++s) {
        if (s + 3 < KS) {
#pragma unroll
            for (int m = 0; m < 4; ++m) af[(s + 3) & 3][m] = *(const bf16x8_t*)(ap + (size_t)(16 * m) * DM + 32 * (s + 3));
#pragma unroll
            for (int n = 0; n < 2; ++n) wf[(s + 3) & 3][n] = *(const bf16x8_t*)(wp + (size_t)(16 * n) * DM + 32 * (s + 3)); }
#pragma unroll
        for (int m = 0; m < 4; ++m)
#pragma unroll
            for (int n = 0; n < 2; ++n) acc[m][n] = __builtin_amdgcn_mfma_f32_16x16x32_bf16(wf[s & 3][n], af[s & 3][m], acc[m][n], 0, 0, 0);
    }
}
__device__ __forceinline__ void wg_merge_ctx(const Ctx& C) {
    if (C.wave >= 2) return;
    const bf16* mix = WSP(const bf16, WS_HX); const bf16* wm = WSP(const bf16, WS_WM); const bf16* pxg = WSP(const bf16, WS_PXG); bf16* mb = WSP(bf16, WS_M);
    const int lane = C.lane(), li = lane & 15, fq = lane >> 4;
    for (int it = C.wave * C.G + C.bx; it < 512; it += 2 * C.G) {
        const int r0 = ML + 64 * (it >> 5), c0 = 32 * (it & 31);
        f32x4 a0[4][2], a1[4][2], a2[4][2];
#pragma unroll
        for (int m = 0; m < 4; ++m)
#pragma unroll
            for (int n = 0; n < 2; ++n) { a0[m][n] = (f32x4){0.f, 0.f, 0.f, 0.f}; a1[m][n] = a0[m][n]; a2[m][n] = a0[m][n]; }
        const bf16* A = mix + (size_t)r0 * DM; const bf16* W = wm + (size_t)c0 * DM;
        wg_core<8>(A, W, li, fq, a0); wg_core<8>(A + 256, W + 256, li, fq, a1); wg_core<16>(A + 512, W + 512, li, fq, a2);
#pragma unroll
        for (int m = 0; m < 4; ++m)
#pragma unroll
            for (int n = 0; n < 2; ++n) { const size_t row = (size_t)(r0 + 16 * m + li); const int col = c0 + 16 * n + 4 * fq;
                const unsigned char* pq = (const unsigned char*)pxg; const unsigned g0 = *(const unsigned*)(pq + gq_elem(0, (int)row, col)), g1 = *(const unsigned*)(pq + gq_elem(1, (int)row, col)), g2 = *(const unsigned*)(pq + gq_elem(2, (int)row, col));
                constexpr float S = 1.0f / 255.0f;
                const float o0 = (a0[m][n][0] * ub0(g0) + a1[m][n][0] * ub0(g1) + a2[m][n][0] * ub0(g2)) * S, o1 = (a0[m][n][1] * ub1(g0) + a1[m][n][1] * ub1(g1) + a2[m][n][1] * ub1(g2)) * S;
                const float o2 = (a0[m][n][2] * ub2(g0) + a1[m][n][2] * ub2(g1) + a2[m][n][2] * ub2(g2)) * S, o3 = (a0[m][n][3] * ub3(g0) + a1[m][n][3] * ub3(g1) + a2[m][n][3] * ub3(g2)) * S;
                v2u w; w.x = cvt_pk_bf16(o0, o1); w.y = cvt_pk_bf16(o2, o3); *(v2u*)(mb + row * DM + col) = w; }
    }
}
__device__ __forceinline__ void wg_wo_ctx(const Ctx& C) {
    if (C.wave >= 2) return;
    const bf16* mb = WSP(const bf16, WS_M); const bf16* wo = WSP(const bf16, WS_WO); const float* base = ARGF(A_CTX); float* out = WSP(float, WS_CTXX);
    const float* gate = WSP(const float, WS_MOD) + 4 * NMOD + 2 * DM; const float* gn = WSP(const float, WS_GN) + (size_t)(1 * 5 + 4) * DM; bf16* ap = WSP(bf16, WS_HX); u64* rs = WSP(u64, WS_RS) + (size_t)1 * MT;
    const int lane = C.lane(), li = lane & 15, fq = lane >> 4;
    for (int it = C.wave * C.G + C.bx; it < 512; it += 2 * C.G) {
        const int r0 = 64 * (it >> 5), c0 = 32 * (it & 31);
        f32x4 acc[4][2];
#pragma unroll
        for (int m = 0; m < 4; ++m)
#pragma unroll
            for (int n = 0; n < 2; ++n) acc[m][n] = (f32x4){0.f, 0.f, 0.f, 0.f};
        wg_core<32>(mb + (size_t)(ML + r0) * DM, wo + (size_t)c0 * DM, li, fq, acc);
#pragma unroll
        for (int m = 0; m < 4; ++m) { const size_t rc = (size_t)(r0 + 16 * m + li); float ss = 0.f;
#pragma unroll
            for (int n = 0; n < 2; ++n) { const int col = c0 + 16 * n + 4 * fq;
                const f32x4 o = *(const f32x4*)(base + rc * DM + col) + *(const f32x4*)(gate + col) * acc[m][n];
                *(f32x4*)(out + rc * DM + col) = o;
                const f32x4 y = o * *(const f32x4*)(gn + col); v2u w; w.x = cvt_pk_bf16(y[0], y[1]); w.y = cvt_pk_bf16(y[2], y[3]); *(v2u*)(ap + (ML + rc) * DM + col) = w;
                ss += (o[0] * o[0] + o[1] * o[1]) + (o[2] * o[2] + o[3] * o[3]); }
            ss += __shfl_xor(ss, 16); ss += __shfl_xor(ss, 32);
            if (fq == 0) __hip_atomic_fetch_add(rs + ML + rc, (u64)(ss * 16777216.0f + 0.5f), __ATOMIC_RELAXED, __HIP_MEMORY_SCOPE_AGENT); }
    }
}
__device__ __forceinline__ void ph_final(const Ctx& C) {
    float* out = (float*)(GAS float*)ldarg(C, A_OUT); const float* fg = ARGF(A_FG); const int lane = C.lane();
    for (int row = C.gw; row < ML; row += C.NGW) {
        float* xr = out + (size_t)row * DM;
        f32x4 v[4]; float s2 = 0.f;
#pragma unroll
        for (int j = 0; j < 4; ++j) { v[j] = *(const f32x4*)(xr + 4 * lane + 256 * j); s2 += (v[j].x * v[j].x + v[j].y * v[j].y) + (v[j].z * v[j].z + v[j].w * v[j].w); }
        const float rstd = 1.0f / sqrtf(wave_sum(s2) * (1.0f / DM) + EPS);
#pragma unroll
        for (int j = 0; j < 4; ++j) { const int c0 = 4 * lane + 256 * j; const f32x4 gg = *(const f32x4*)(fg + c0); *(f32x4*)(xr + c0) = v[j] * rstd * gg; }
    }
}

struct Args { const void* p[A_NARGS]; int ph_lo, ph_hi; };

__global__ void __launch_bounds__(NTHR, 2) fwd_kernel(Args args) {
    extern __shared__ __attribute__((aligned(16))) unsigned char lds_raw[];
    LAS unsigned char* const lds0 = (LAS unsigned char*)lds_raw;
    const int wave0 = __builtin_amdgcn_readfirstlane(threadIdx.x >> 6);
    { const int t0 = threadIdx.x;
      for (int u = t0; u < (LDS_BYTES - LDSCTL_OFF) / 4; u += NTHR) ((LAS unsigned*)(lds0 + LDSCTL_OFF))[u] = 0u;
      __syncthreads();
      if (t0 < A_NARGS) ((LAS unsigned long long*)(lds0 + LARGS_OFF))[t0] = (unsigned long long)args.p[t0];
      __syncthreads(); }
    const int lo = args.ph_lo, hi = args.ph_hi;
    const unsigned xcc = xb_xcc_id();
    int vbx = blockIdx.x;
    if (!MK_MULTI) { Ctx C; C.lds = lds0; C.wave = wave0; gu32* ctl0 = (gu32*)WSP(unsigned, WS_CTL); (void)xcd_barrier_post((unsigned*)(ctl0 + CW_BAR), (volatile LAS unsigned*)(lds0 + MISC_OFF) + 8, C.tid() == 0); }
    for (int step = lo; step < hi; ++step) {
        const int ls = step - 2, l = ls >= NS ? 1 : 0, k = (step < 2) ? -1 - step : ls - l * NS;
        const int nrep = (PROBE_K != -99 && k == PROBE_K) ? PROBE_N : 1;
        for (int rep = 0; rep < nrep; ++rep) {
        Ctx C;
        C.lds = lds0; C.wave = wave0; C.G = gridDim.x; C.bx = vbx;
        asm volatile("" : "+s"(C.wave), "+s"(C.bx), "+s"(C.G));
        C.gw = C.bx * NWAVES + C.wave; C.NGW = C.G * NWAVES; C.NGT = C.G * NTHR;
        gu32* ctl = (gu32*)WSP(unsigned, WS_CTL);
        if (k == -1) { ph_mod_partial(C); __syncthreads(); ph_weights(C, 0); }
        else if (k == -2) ph_mod_reduce(C);
        else if (k == 0) {
            if (l == 1) ph_weights(C, l);
            ph_ctab(C, l);
            u64* rsb = WSP(u64, WS_RS) + (size_t)(l == 0 ? 0 : 2) * MT;
            if (l == 0) ph_prenorm(C, ARGF(A_X), ARGF(A_CTX), WSP(const float, WS_GN), WSP(bf16, WS_HX), rsb, 0, MT, (const float*)nullptr, (const float*)nullptr);
            else ph_prenorm(C, ARGF(A_OUT), WSP(const float, WS_CTXX), WSP(const float, WS_GN) + 2 * 5 * DM, WSP(bf16, WS_HX), rsb, ML, MT, WSP(const float, WS_PART), WSP(const float, WS_MOD) + 4 * NMOD + 5 * DM);
        } else if (k == 1) {
            pg8::Prob<false> P{WSP(const bf16, WS_HX), WSP(const bf16, WS_WIN), DM, DM, DM}; pg8::StaticOrder<NIN / 256> S; S.init(MT, NIN, C.G, C.bx);
            EpiIn E{WSP(bf16, WS_PXA), WSP(bf16, WS_PXG), WSP(const u64, WS_RS) + (size_t)(l == 0 ? 0 : 2) * MT, WSP(const float, WS_CIN) + (size_t)l * 5 * NIN};
            pg8::gemm_phase(C.lds, P, S, E, C.tid());
        } else if (k == 2) {
            const int sub = rep == 0 ? 7 : PROBE_SUB;
            if (sub & 1) ph_t1(C);
            if (sub & 2) { if (l == 0) ph_ctx_dft(C); ph_mixers(C, l); }
            if (sub & 4) ph_attn(C, l);
        } else if (k == 3) {
            ph_fft(C);
        } else if (k == 4) {
            pg8::Prob<false> P{WSP(const bf16, WS_HX), WSP(const bf16, WS_WM), DM, DM, DM}; pg8::StaticOrder<DM / 256> S; S.init(ML, DM, C.G, C.bx);
            EpiMerge E{WSP(bf16, WS_M), WSP(const bf16, WS_PXG)};
            pg8::gemm_phase(C.lds, P, S, E, C.tid());
            if (l == 0) wg_merge_ctx(C);
        } else if (k == 5) {
            pg8::Prob<false> P{WSP(const bf16, WS_M), WSP(const bf16, WS_WO), DM, DM, DM}; pg8::StaticOrder<DM / 256> S; S.init(ML, DM, C.G, C.bx);
            const float* gatev = rep > 0 ? WSP(const float, WS_ZERO) : WSP(const float, WS_MOD) + (size_t)l * 5 * NMOD + 2 * DM;
            const float* gnp = WSP(const float, WS_GN) + (size_t)(l * 2 + 1) * 5 * DM; u64* rsp = WSP(u64, WS_RS) + (size_t)(l == 0 ? 1 : 3) * MT;
            if (l == 0) { EpiRes<false> E{(const void*)ARGF(A_X), (bf16*)(GAS bf16*)ldarg(C, A_OUT), gatev, nullptr, gnp, WSP(bf16, WS_HX), rsp}; pg8::gemm_phase(C.lds, P, S, E, C.tid()); }
            else { EpiRes<true> E{(const void*)(const bf16*)(GAS bf16*)ldarg(C, A_OUT), WSP(bf16, WS_STREAM1), gatev, nullptr, gnp, WSP(bf16, WS_HX), rsp}; pg8::gemm_phase(C.lds, P, S, E, C.tid()); }
            if (l == 0 && rep == 0) wg_wo_ctx(C);
        } else if (k == 6) {
            pg8::Prob<false> P{WSP(const bf16, WS_HX), WSP(const bf16, WS_W1), DM, DM, DM}; pg8::StaticOrder<FF / 256> S; S.init(l == 0 ? MT : ML, FF, C.G, C.bx);
            EpiAct E{WSP(bf16, WS_ACT), WSP(const u64, WS_RS) + (size_t)(l == 0 ? 1 : 3) * MT, WSP(const float, WS_CUP) + (size_t)l * 5 * FF};
            pg8::gemm_phase(C.lds, P, S, E, C.tid());
        } else if (k == 7) {
            if (l == 0) {
                pg8::ProbDown P{WSP(const bf16, WS_ACT), WSP(const bf16, WS_W2), FF, FF, FF}; pg8::DownOrder S; S.init(C.G, C.bx);
                EpiRes<true> E{(const void*)(const bf16*)(GAS bf16*)ldarg(C, A_OUT), (bf16*)(GAS bf16*)ldarg(C, A_OUT), WSP(const float, WS_MOD) + (size_t)l * 5 * NMOD + 5 * DM, WSP(float, WS_PART),
                         WSP(const float, WS_GN) + (size_t)2 * 5 * DM, WSP(bf16, WS_HX), WSP(u64, WS_RS) + (size_t)2 * MT};
                pg8::gemm_phase(C.lds, P, S, E, C.tid());
            } else {
                pg8::Prob<false> P{WSP(const bf16, WS_ACT), WSP(const bf16, WS_W2), FF, FF, FF}; pg8::StaticOrder<DM / 256> S; S.init(ML, DM, C.G, C.bx);
                EpiResFinal E{WSP(const bf16, WS_STREAM1), (float*)(GAS float*)ldarg(C, A_OUT), WSP(const float, WS_MOD) + (size_t)l * 5 * NMOD + 5 * DM, ARGF(A_FG), WSP(u64, WS_RS5), WSP(unsigned, WS_FCNT), (unsigned*)WSP(unsigned, WS_CTL) + CW_TMO};
                pg8::gemm_phase(C.lds, P, S, E, C.tid());
            }
        } else ph_final(C);
        if (step + 1 < hi || rep + 1 < nrep) { if (MK_MULTI) { if (C.tid() == 0) __hip_atomic_store(ctl + CW_TMO, 0xBADu, RLX_AGENT); } else { XcdBarrier bar; bar.bar = (unsigned*)(ctl + CW_BAR); bar.x = xcc; bar.st = (volatile LAS unsigned*)(lds0 + MISC_OFF) + 8; xcd_barrier(bar, C.tid() == 0);
                if (step == lo && rep == 0) {
                    volatile LAS unsigned* misc = (volatile LAS unsigned*)(lds0 + MISC_OFF);
                    if (C.tid() == 0) { bool ok = gridDim.x == 256;
                        for (unsigned j = 0; j < 16; ++j) { const unsigned cnt = xb_ld(bar.bar + XB_XCNT(j)); ok = ok && (cnt == (j < 8 ? 32u : 0u)); }
                        misc[11] = ok ? 1u : 0u; }
                    __syncthreads();
                    const unsigned okf = __builtin_amdgcn_readfirstlane(misc[11]), rk = __builtin_amdgcn_readfirstlane(misc[10]);
                    if (okf != 0u && rk < 32u && xcc < 8u) vbx = (int)(rk * 8u + xcc); } } }
        }
    }
}

extern "C" void kernel_launch(void* const* d_in, const int* in_sizes, int n_in, void* d_out, int out_size, void* d_ws, size_t ws_size, hipStream_t stream) {
    static int grid = 0;
    if (grid == 0) {
        if (n_in != 18 || out_size != ML * DM || ws_size < WS_END) { fprintf(stderr, "kernel_launch: unexpected shapes (n_in %d out %d ws %zu)\n", n_in, out_size, ws_size); grid = -1; return; }
        int dev = 0, cus = 0;
        if (hipGetDevice(&dev) != hipSuccess || hipDeviceGetAttribute(&cus, hipDeviceAttributeMultiprocessorCount, dev) != hipSuccess) { grid = -1; return; }
        if (hipFuncSetAttribute((const void*)fwd_kernel, hipFuncAttributeMaxDynamicSharedMemorySize, LDS_BYTES) != hipSuccess) { fprintf(stderr, "kernel_launch: hipFuncSetAttribute failed\n"); grid = -1; return; }
        int per_cu = 0;
        if (hipOccupancyMaxActiveBlocksPerMultiprocessor(&per_cu, (const void*)fwd_kernel, NTHR, LDS_BYTES) != hipSuccess || per_cu < 1) fprintf(stderr, "kernel_launch: occupancy query reports %d\n", per_cu);
        (void)hipGetLastError();
        grid = cus;
    }
    if (grid < 0) return;
    (void)hipMemsetAsync((char*)d_ws + WS_CTL, 0, CTL_ZERO_BYTES, stream);
    Args a{};
    for (int i = 0; i < 18; ++i) a.p[i] = d_in[i];
    a.p[A_OUT] = d_out; a.p[A_WS] = d_ws;
#if MK_MULTI
    for (int s = 0; s < NSTEPS; ++s) { a.ph_lo = s; a.ph_hi = s + 1; hipLaunchKernelGGL(fwd_kernel, dim3(grid), dim3(NTHR), LDS_BYTES, stream, a); }
#else
    a.ph_lo = 0; a.ph_hi = NSTEPS; hipLaunchKernelGGL(fwd_kernel, dim3(grid), dim3(NTHR), LDS_BYTES, stream, a);
#endif
}
```

```cpp
#include <hip/hip_runtime.h>
#include <cstdio>
#include <cstdint>

#ifndef PROBE_K
#define PROBE_K -99
#define PROBE_N 1
#define PROBE_SUB 7
#endif
#ifndef MK_MULTI
#define MK_MULTI 0
#endif

namespace pg8 {
#define PG8_LAS __attribute__((address_space(3)))
typedef unsigned short bf16_t;
typedef short bf16x8 __attribute__((ext_vector_type(8)));
typedef float f32x4 __attribute__((ext_vector_type(4)));
typedef unsigned u32x4 __attribute__((ext_vector_type(4)));
constexpr int BM = 256, BK = 64, HALF = 128, HTB = HALF * BK * 2, STAGE_BYTES = 8 * HTB, NXCD = 8, WGM = 8;

__host__ __device__ __forceinline__ int lds_byte(int r, int c) { const int st = (r >> 4) * 2 + (c >> 5), rr = r & 15, cc = c & 31, ob = rr * 64 + cc * 2; return st * 1024 + (ob ^ (((ob >> 9) & 1) << 5)); }
__host__ __device__ __forceinline__ void stage_rc(int b, int& R, int& C) { const int st = b / 1024, sb = b % 1024, swz = sb ^ (((sb >> 9) & 1) << 5); R = (st >> 1) * 16 + swz / 64; C = (st & 1) * 32 + (swz % 64) / 2; }
__host__ __device__ __forceinline__ int perm32(int rho) { const int n = rho >> 4, i = rho & 15; return 8 * (i >> 2) + 4 * n + (i & 3); }

struct Unit { int pm, pn, br; };

template <int NN  > struct StaticOrder {
    int nM, nwg, G, c;
    __device__ void init(int M, int  , int G_, int c_) { nM = M / BM; nwg = nM * NN; G = G_; c = c_; }
    __device__ __forceinline__ bool next(int i, Unit& u) const {
        u.br = 0;
        const long L = (long)i * G + c; if (L >= nwg) return false;
        int wgid = (int)L; { const int q = nwg >> 3, r = nwg & 7, xcd = wgid & 7, off = wgid >> 3; wgid = (xcd < r ? xcd * (q + 1) : r * (q + 1) + (xcd - r) * q) + off; }
        constexpr int nig = WGM * NN; const int gid = wgid / nig, rem = wgid - gid * nig, fm = gid * WGM, gsz = (nM - fm) < WGM ? (nM - fm) : WGM;
        if (gsz == WGM) { u.pm = fm + (rem & (WGM - 1)); u.pn = rem >> 3; } else { u.pm = fm + (rem % gsz); u.pn = rem / gsz; }
        return true;
    }
};

struct DownOrder {
    StaticOrder<4> lat; int G, c;
    __device__ void init(int G_, int c_) { lat.init(32768, 1024, G_, c_); G = G_; c = c_; }
    __device__ __forceinline__ bool next(int i, Unit& u) const {
        const long L = (long)i * G + c;
        if (L < 512) return lat.next(i, u);
        const int j = (int)L - 512; if (j >= 64) return false;
        const int ct = j >> 2; u.pm = 128 + (ct >> 2); u.pn = ct & 3; u.br = j & 3; return true;
    }
};
struct ProbDown {
    static constexpr bool MT16 = true;
    const bf16_t* A; const bf16_t* Bt; int lda, ldb, K;
    __device__ __forceinline__ int nt(const Unit& u) const { return u.pm >= 128 ? 16 : 64; }
    __device__ __forceinline__ int koff(const Unit& u) const { return u.pm >= 128 ? u.br * 1024 : 0; }
    __device__ __forceinline__ const char* a(const Unit& u) const { return (const char*)(A + (size_t)u.pm * BM * lda + (size_t)koff(u) * 16); }
    __device__ __forceinline__ const char* b(const Unit& u) const { return (const char*)(Bt + (size_t)u.pn * BM * ldb + koff(u)); }
};
template <bool MERGE> struct Prob {
    static constexpr bool MT16 = false;
    const bf16_t* A; const bf16_t* Bt; int lda, ldb, K;
    __device__ __forceinline__ int nt(const Unit& u) const { if (MERGE) return u.br == 2 ? 8 : 4; return K / BK; }
    __device__ __forceinline__ int koff(const Unit& u) const { if (MERGE) return u.br * 256; return 0; }
    __device__ __forceinline__ const char* a(const Unit& u) const { return (const char*)(A + (size_t)u.pm * BM * lda + koff(u)); }
    __device__ __forceinline__ const char* b(const Unit& u) const { return (const char*)(Bt + (size_t)u.pn * BM * ldb + koff(u)); }
};

struct ProbMT {
    static constexpr bool MT16 = true;
    const bf16_t* A; const bf16_t* Bt; int lda, ldb, K;
    __device__ __forceinline__ int nt(const Unit&) const { return K / BK; }
    __device__ __forceinline__ const char* a(const Unit& u) const { return (const char*)(A + (size_t)u.pm * BM * lda); }
    __device__ __forceinline__ const char* b(const Unit& u) const { return (const char*)(Bt + (size_t)u.pn * BM * ldb); }
};
typedef __bf16 bf16x2_cv __attribute__((ext_vector_type(2)));
typedef float f32x2_cv __attribute__((ext_vector_type(2)));
__device__ __forceinline__ unsigned cvt_pk_bf16(float lo, float hi) { const f32x2_cv v = {lo, hi}; const bf16x2_cv r = __builtin_convertvector(v, bf16x2_cv); return __builtin_bit_cast(unsigned, r); }

template <class Epi, class Sched, class PROB>
__device__ __forceinline__ void gemm_phase(PG8_LAS unsigned char* lds, const PROB P, const Sched& S, const Epi& E, const int tid) {
    const int wid = __builtin_amdgcn_readfirstlane(tid >> 6), lane = tid & 63, wr = wid >> 2, wc = wid & 3, fr = lane & 15, fq = lane >> 4;
    unsigned voffA[2], voffB[2];
#pragma unroll
    for (int i = 0; i < 2; ++i) { int R, C; stage_rc(tid * 16 + i * 8192, R, C); const int Rb = Epi::PERM ? ((R & ~31) + perm32(R & 31)) : R;
        voffA[i] = PROB::MT16 ? (unsigned)((((R >> 4) * (P.lda >> 5) + (C >> 5)) * 512 + (R & 15) * 32 + (C & 31)) * 2) : (unsigned)(R * P.lda + C) * 2u; voffB[i] = (unsigned)(Rb * P.ldb + C) * 2u; }
    const size_t kstep = (size_t)(BK * 2), kstepA = PROB::MT16 ? (size_t)2048 : kstep;
    const size_t hstepA = (size_t)HALF * P.lda * 2, hstepB = (size_t)HALF * P.ldb * 2;
    const unsigned ldsw = (unsigned)wid * 1024u;
    const int aoff = lds_byte(wr * 64 + fr, fq * 8), boff = lds_byte(wc * 32 + fr, fq * 8);
#define PG8_SA(b, h) (((b) * 2 + (h)) * HTB)
#define PG8_SB(b, h) ((4 + (b) * 2 + (h)) * HTB)
#define PG8_STAGE(bufoff, gbase, voff) do { _Pragma("unroll") for (int _i = 0; _i < 2; ++_i) \
        __builtin_amdgcn_global_load_lds((const unsigned*)((const char*)(gbase) + (voff)[_i]), (PG8_LAS unsigned*)(lds + (bufoff) + ldsw + _i * 8192), 16, 0, 0); } while (0)
#define PG8_LDA(dst, b, h) do { _Pragma("unroll") for (int m = 0; m < 4; ++m) _Pragma("unroll") for (int k = 0; k < 2; ++k) dst[m][k] = *(const PG8_LAS bf16x8*)(lds + PG8_SA(b, h) + aoff + m * 2048 + k * 1024); } while (0)
#define PG8_LDB(dst, b, h) do { _Pragma("unroll") for (int n = 0; n < 2; ++n) _Pragma("unroll") for (int k = 0; k < 2; ++k) dst[n][k] = *(const PG8_LAS bf16x8*)(lds + PG8_SB(b, h) + boff + n * 2048 + k * 1024); } while (0)
#define PG8_MMA(ai, bj, At, Bt) do { __builtin_amdgcn_s_setprio(1); _Pragma("unroll") for (int m = 0; m < 4; ++m) _Pragma("unroll") for (int n = 0; n < 2; ++n) _Pragma("unroll") for (int k = 0; k < 2; ++k) \
        acc[ai][bj][m][n] = __builtin_amdgcn_mfma_f32_16x16x32_bf16(Bt[n][k], At[m][k], acc[ai][bj][m][n], 0, 0, 0); __builtin_amdgcn_s_setprio(0); } while (0)
#define PG8_WAIT_V(n) asm volatile("s_waitcnt vmcnt(" #n ")" ::: "memory")
#define PG8_WAIT_L(n) asm volatile("s_waitcnt lgkmcnt(" #n ")" ::: "memory")
#define PG8_BAR __builtin_amdgcn_s_barrier()
#define PG8_WAIT_SEL1(N, H) asm volatile("s_waitcnt vmcnt(" #N ")\n\tv_cmp_eq_u32_e32 vcc, 1, %0\n\ts_cbranch_vccnz .Lpg8w%=\n\ts_waitcnt vmcnt(" #H ")\n\tv_cmp_eq_u32_e32 vcc, 2, %0\n\ts_cbranch_vccnz .Lpg8w%=\n\ts_waitcnt vmcnt(8)\n.Lpg8w%=:" :: "v"(fst) : "memory", "vcc")
#define PG8_WAIT_SEL(NF16, NH16, NF32) do { if (Epi::NST == 16) PG8_WAIT_SEL1(NF16, NH16); else PG8_WAIT_SEL1(NF32, NF32); } while (0)
#define PG8_SCHED __builtin_amdgcn_sched_barrier(0)
    Unit cur, nxt; int ui = 0, pcls = 1;
    if (!S.next(0, cur)) return;
    f32x4 acc[2][2][4][2];
#pragma unroll
    for (int a = 0; a < 2; ++a)
#pragma unroll
        for (int b = 0; b < 2; ++b)
#pragma unroll
            for (int m = 0; m < 4; ++m)
#pragma unroll
                for (int n = 0; n < 2; ++n) acc[a][b][m][n] = (f32x4){0.f, 0.f, 0.f, 0.f};
    bf16x8 At[4][2], B0[2][2], B1[2][2];
    const char* cA = P.a(cur); const char* cB = P.b(cur);
    PG8_STAGE(PG8_SB(0, 0), cB, voffB); PG8_STAGE(PG8_SB(0, 1), cB + hstepB, voffB); PG8_STAGE(PG8_SA(0, 0), cA, voffA); PG8_STAGE(PG8_SA(0, 1), cA + hstepA, voffA);
    if (wr == 1) PG8_BAR;
    PG8_WAIT_V(2); PG8_BAR;
    PG8_STAGE(PG8_SB(1, 0), cB + kstep, voffB); PG8_STAGE(PG8_SA(1, 0), cA + kstepA, voffA); PG8_STAGE(PG8_SB(1, 1), cB + hstepB + kstep, voffB);
    PG8_WAIT_V(6); PG8_BAR;
    for (;;) {
        const bool has_next = S.next(ui + 1, nxt);
        const char* nA = has_next ? P.a(nxt) : cA; const char* nB = has_next ? P.b(nxt) : cB;
        const int nt = P.nt(cur);
        for (int t = 0; t < nt; t += 2) {
            const bool last = (t == nt - 2); const int fst = (t == 0 && ui > 0) ? pcls : 0;
            if constexpr (Epi::HOOKS) { if (t == 4 || t == 8) E.hook(acc, cur, t, wr, wc, fr, fq); }
            const char* a1 = cA + (size_t)(t + 1) * kstepA;
            const char* a2 = last ? nA : cA + (size_t)(t + 2) * kstepA; const char* b2 = last ? nB : cB + (size_t)(t + 2) * kstep;
            const char* a3 = a2 + kstepA; const char* b3 = b2 + kstep;
            PG8_LDB(B0, 0, 0); PG8_LDB(B1, 0, 1); PG8_SCHED; PG8_LDA(At, 0, 0); PG8_STAGE(PG8_SA(1, 1), a1 + hstepA, voffA);
            PG8_WAIT_SEL(18, 10, 34); PG8_WAIT_L(0); PG8_BAR; PG8_MMA(0, 0, At, B0); PG8_MMA(0, 1, At, B1); PG8_BAR; PG8_SCHED;
            PG8_LDA(At, 0, 1); PG8_STAGE(PG8_SB(0, 0), b2, voffB); PG8_STAGE(PG8_SB(0, 1), b2 + hstepB, voffB); PG8_STAGE(PG8_SA(0, 0), a2, voffA);
            PG8_WAIT_SEL(24, 16, 40); PG8_WAIT_L(0); PG8_BAR; PG8_MMA(1, 0, At, B0); PG8_MMA(1, 1, At, B1); PG8_BAR; PG8_SCHED;
            PG8_LDB(B0, 1, 0); PG8_LDB(B1, 1, 1); PG8_SCHED; PG8_LDA(At, 1, 0); PG8_STAGE(PG8_SA(0, 1), a2 + hstepA, voffA);
            PG8_WAIT_SEL(26, 18, 42); PG8_WAIT_L(0); PG8_BAR; PG8_MMA(0, 0, At, B0); PG8_MMA(0, 1, At, B1); PG8_BAR; PG8_SCHED;
            PG8_LDA(At, 1, 1); PG8_STAGE(PG8_SB(1, 0), b3, voffB); PG8_STAGE(PG8_SB(1, 1), b3 + hstepB, voffB); PG8_STAGE(PG8_SA(1, 0), a3, voffA);
            PG8_WAIT_V(8); PG8_WAIT_L(0); PG8_BAR; PG8_MMA(1, 0, At, B0); PG8_MMA(1, 1, At, B1); PG8_BAR; PG8_SCHED;
        }
        if (wr == 0) PG8_BAR;
        E(acc, cur, wr, wc, fr, fq); pcls = E.cls(cur);
        if (!has_next) break;
#pragma unroll
        for (int a = 0; a < 2; ++a)
#pragma unroll
            for (int b = 0; b < 2; ++b)
#pragma unroll
                for (int m = 0; m < 4; ++m)
#pragma unroll
                    for (int n = 0; n < 2; ++n) acc[a][b][m][n] = (f32x4){0.f, 0.f, 0.f, 0.f};
        cur = nxt; cA = nA; cB = nB; ++ui;
        if (wr == 1) PG8_BAR;
    }
    PG8_WAIT_V(0);
    PG8_BAR;
#undef PG8_SA
#undef PG8_SB
#undef PG8_STAGE
#undef PG8_LDA
#undef PG8_LDB
#undef PG8_MMA
#undef PG8_WAIT_V
#undef PG8_WAIT_L
#undef PG8_BAR
#undef PG8_WAIT_SEL
#undef PG8_WAIT_SEL1
#undef PG8_SCHED
}
}

constexpr int NWAVES = 8, NTHR = 512;
constexpr int DM = 1024, NB = 4, SEQ = 8192, ML = NB * SEQ, CTXL = 256, MC = NB * CTXL, MT = ML + MC;
constexpr int NIN_ORIG = 5632, NPXA = 2816, NPXG = 3072, NIN = NPXA + NPXG;
constexpr int OFF_P = 0, OFF_Q = 256, OFF_CU = 512, OFF_CB = 768, OFF_CC = 1024, OFF_QQ = 1280, OFF_K = 1792, OFF_V = 2304;
constexpr int FF = 4096, NMOD = 6 * DM, NGRP = 5;
constexpr float EPS = 1e-6f;

constexpr size_t MiB = 1u << 20;
constexpr size_t WS_CTL = 0, CTL_ZERO_BYTES = 2 * MiB;
constexpr size_t WS_RS = 262144;
constexpr size_t WS_FCNT = 1441792;
constexpr size_t WS_ZERO = 1572864;
constexpr size_t WS_RS5 = 1703936;
constexpr size_t WS_TW = 2 * MiB;
constexpr size_t WS_MOD = 2 * MiB + 65536;
constexpr size_t WS_GN = 2 * MiB + 524288;
constexpr size_t WS_CIN = 2 * MiB + 786432;
constexpr size_t WS_CUP = 3 * MiB;
constexpr size_t WS_MODP = 510 * MiB;
constexpr size_t WS_CTXX = 4 * MiB;
constexpr size_t WS_WIN = 8 * MiB, WS_WM = 20 * MiB, WS_WO = 22 * MiB, WS_W1 = 24 * MiB, WS_W2 = 32 * MiB;
constexpr size_t WS_HX = 40 * MiB;
constexpr size_t WS_PXA = 106 * MiB;
constexpr size_t WS_PXG = 288 * MiB;
constexpr size_t WS_TB = 486 * MiB;
constexpr size_t WS_M = WS_PXA;
constexpr size_t WS_ACT = WS_PXA;
constexpr size_t WS_PART = 400 * MiB;
constexpr size_t WS_STREAM1 = 416 * MiB;
constexpr size_t WS_END = 512 * MiB;
static_assert(WS_PXA + (size_t)MT * NPXA * 2 <= WS_PXG && WS_PXG + (size_t)MT * NPXG * 2 <= WS_TB && WS_ACT + (size_t)MT * FF * 2 <= WS_TB && WS_HX + (size_t)MT * DM * 2 <= WS_PXA, "ws map");
constexpr int CW_TMO = 0, CW_BAR = 4096;

constexpr int RING_BYTES = 131072, LDSCTL_OFF = 155648, MISC_OFF = LDSCTL_OFF + 320, LDS_BYTES = 163840;

#define GAS __attribute__((address_space(1)))
#define LAS __attribute__((address_space(3)))
typedef unsigned short bf16;
typedef unsigned v4u __attribute__((ext_vector_type(4)));
typedef unsigned v2u __attribute__((ext_vector_type(2)));
typedef float f32x4 __attribute__((ext_vector_type(4)));
typedef GAS unsigned gu32;
#define RLX_AGENT __ATOMIC_RELAXED, __HIP_MEMORY_SCOPE_AGENT
#define LDS_WAIT() asm volatile("s_waitcnt lgkmcnt(0)" ::: "memory")
__device__ __forceinline__ unsigned pk2(float lo, float hi) { return pg8::cvt_pk_bf16(lo, hi); }
__device__ __forceinline__ unsigned f2bf(float f) { return pg8::cvt_pk_bf16(f, 0.0f) & 0xffffu; }
__device__ __forceinline__ float bf2f(unsigned h) { return __uint_as_float(h << 16); }
__device__ __forceinline__ float bflo(unsigned w) { return __uint_as_float(w << 16); }
__device__ __forceinline__ float bfhi(unsigned w) { return __uint_as_float(w & 0xffff0000u); }

#define XB_TMO      128
#define XB_XCNT(j)  (256  + 64 * (j))
#define XB_XSUB(j)  (1280 + 64 * (j))
#define XB_XGEN(j)  (2304 + 64 * (j))
#define XB_TOP      3328
#define XB_TOPGEN   3392
#define XCD_BAR_WORDS 3456
#define XB_SPIN_CAP (1u << 22)
__device__ __forceinline__ unsigned xb_ld(unsigned* p)              { return __hip_atomic_load(p, __ATOMIC_RELAXED, __HIP_MEMORY_SCOPE_AGENT); }
__device__ __forceinline__ unsigned xb_add(unsigned* p, unsigned v) { return __hip_atomic_fetch_add(p, v, __ATOMIC_RELAXED, __HIP_MEMORY_SCOPE_AGENT); }
__device__ __forceinline__ unsigned xb_xcc_id() { return (unsigned)__builtin_amdgcn_s_getreg((3 << 11) | 20) & 0xFu; }
#define XB_SPIN(cond, bar) do { unsigned _sp = 0; while (cond) { __builtin_amdgcn_s_sleep(1); \
    if ((++_sp & 255u) == 0u) { if (xb_ld(&(bar)[XB_TMO])) break; if (_sp > XB_SPIN_CAP) { atomicAdd(&(bar)[XB_TMO], 1u); break; } } } } while (0)
struct XcdBarrier { unsigned* bar; unsigned x; volatile LAS unsigned* st; };
__device__ __forceinline__ XcdBarrier xcd_barrier_post(unsigned* bar, volatile LAS unsigned* st, bool leader) {
    XcdBarrier b; b.bar = bar; b.x = xb_xcc_id(); b.st = st;
    if (leader) { const unsigned rank = xb_add(&bar[XB_XCNT(b.x)], 1u); st[2] = rank; }
    return b;
}
__device__ __forceinline__ void xcd_barrier_complete(unsigned* bar, unsigned x, unsigned& nloc, unsigned& nx) {
    const unsigned G = gridDim.x * gridDim.y * gridDim.z;
    unsigned sum, cnt, mine, sp = 0u;
    for (;;) {
        sum = 0u; cnt = 0u; mine = 0u;
#pragma unroll
        for (unsigned j = 0; j < 16; ++j) { const unsigned c = xb_ld(&bar[XB_XCNT(j)]); sum += c; cnt += (c > 0u) ? 1u : 0u; mine = (j == x) ? c : mine; }
        if (sum == G) break;
        __builtin_amdgcn_s_sleep(1);
        if ((++sp & 255u) == 0u) { if (xb_ld(&bar[XB_TMO])) break; if (sp > XB_SPIN_CAP) { atomicAdd(&bar[XB_TMO], 1u); break; } }
    }
    nloc = mine > 0u ? mine : 1u; nx = cnt > 0u ? cnt : 1u;
}
__device__ __forceinline__ void xcd_barrier(const XcdBarrier& b, bool leader) {
    asm volatile("s_waitcnt vmcnt(0)" ::: "memory");
    __syncthreads();
    if (leader) {
        unsigned* bar = b.bar;
        __builtin_amdgcn_s_waitcnt(0);
        unsigned nloc = b.st[0], nx = b.st[1];
        if (nloc == 0u) { xcd_barrier_complete(bar, b.x, nloc, nx); b.st[0] = nloc; b.st[1] = nx; }
        const unsigned old = xb_add(&bar[XB_XSUB(b.x)], 1u);
        const unsigned gen = old / nloc;
        if (old + 1u == (gen + 1u) * nloc) {
            __builtin_amdgcn_fence(__ATOMIC_RELEASE, "agent");
            asm volatile("s_waitcnt vmcnt(0)" ::: "memory");
            const unsigned og = xb_add(&bar[XB_TOP], 1u);
            const unsigned tg = og / nx;
            if (og + 1u == (tg + 1u) * nx) xb_add(&bar[XB_TOPGEN], 1u);
            else XB_SPIN(xb_ld(&bar[XB_TOPGEN]) == tg, bar);
            __builtin_amdgcn_fence(__ATOMIC_ACQUIRE, "agent");
            xb_add(&bar[XB_XGEN(b.x)], 1u);
            asm volatile("s_waitcnt vmcnt(0)" ::: "memory");
        } else {
            XB_SPIN(xb_ld(&bar[XB_XGEN(b.x)]) == gen, bar);
            __builtin_amdgcn_fence(__ATOMIC_ACQUIRE, "agent");
            asm volatile("s_waitcnt vmcnt(0)" ::: "memory");
        }
    }
    __syncthreads();
}

__device__ __forceinline__ float wave_sum(float v) {
#pragma unroll
    for (int o = 1; o < 64; o <<= 1) v += __shfl_xor(v, o);
    return v;
}
__device__ __forceinline__ float wave_max(float v) {
#pragma unroll
    for (int o = 1; o < 64; o <<= 1) v = fmaxf(v, __shfl_xor(v, o));
    return v;
}

__device__ __forceinline__ void transpose_item(const float* W, int ldw, int ncols, bf16* WT, int ldwt, int row_off, int k_off, LAS float* scr, int item, int lane) {
    const int nblk = ncols / 32, kb = item / nblk, nb = item % nblk, k0 = 64 * kb, n0 = 32 * nb;
#pragma unroll 8
    for (int i = 0; i < 32; ++i) { const int kk = 2 * i + (lane >> 5); scr[kk * 33 + (lane & 31)] = W[(size_t)(k0 + kk) * ldw + n0 + (lane & 31)]; }
    LDS_WAIT(); asm volatile("" ::: "memory");
    const int c = lane & 7;
#pragma unroll
    for (int j = 0; j < 4; ++j) { const int n = (lane >> 3) + 8 * j; const LAS float* s = scr + (8 * c) * 33 + n;
        v4u o; o.x = pk2(s[0 * 33], s[1 * 33]); o.y = pk2(s[2 * 33], s[3 * 33]); o.z = pk2(s[4 * 33], s[5 * 33]); o.w = pk2(s[6 * 33], s[7 * 33]);
        *(v4u*)(WT + (size_t)(row_off + n0 + n) * ldwt + k_off + k0 + 8 * c) = o; }
    LDS_WAIT(); asm volatile("" ::: "memory");
}

using pg8::Unit; using pg8::cvt_pk_bf16;
typedef unsigned long long u64;
constexpr int NTM = MT / 256;
__device__ __forceinline__ size_t gate_tile(int g, int pm, int pn) { return (size_t)((g * NTM + pm) * 4 + pn) * 65536; }
__device__ __forceinline__ int gate_piece(int ai, int m, int bj, int wave, int lane) { return ((((ai * 4 + m) * 2 + bj) * 8 + wave) * 64 + lane) * 8; }
__device__ __forceinline__ size_t gq_tile(int g, int pm, int pn) { return (size_t)((g * NTM + pm) * 4 + pn) * 65536; }
__device__ __forceinline__ int gq_piece(int ai, int m, int wave, int lane) { return (((ai * 4 + m) * 8 + wave) * 64 + lane) * 16; }
__device__ __forceinline__ size_t gq_elem(int g, int row, int col) { const int r = row & 255, c = col & 255;
    return gq_tile(g, row >> 8, col >> 8) + gq_piece(r >> 7, (r >> 4) & 3, ((r >> 6) & 1) * 4 + ((c >> 5) & 3), ((c >> 3) & 3) * 16 + (r & 15)) + (c >> 7) * 8 + (c & 7); }
__device__ __forceinline__ unsigned pk4q(float a, float b, float c, float d) {
    const unsigned lo = __builtin_amdgcn_perm(__builtin_bit_cast(unsigned, b), __builtin_bit_cast(unsigned, a), 0x0c0c0400u), hi = __builtin_amdgcn_perm(__builtin_bit_cast(unsigned, d), __builtin_bit_cast(unsigned, c), 0x0c0c0400u);
    return lo | (hi << 16); }
__device__ __forceinline__ float ub0(unsigned v) { return (float)(v & 0xffu); }
__device__ __forceinline__ float ub1(unsigned v) { return (float)((v >> 8) & 0xffu); }
__device__ __forceinline__ float ub2(unsigned v) { return (float)((v >> 16) & 0xffu); }
__device__ __forceinline__ float ub3(unsigned v) { return (float)(v >> 24); }
__device__ __forceinline__ size_t gate_elem(int g, int row, int col) {
    const int r = row & 255, c = col & 255;
    return gate_tile(g, row >> 8, col >> 8) + gate_piece(r >> 7, (r >> 4) & 3, c >> 7, ((r >> 6) & 1) * 4 + ((c >> 5) & 3), ((c >> 3) & 3) * 16 + (r & 15)) + (c & 7);
}
__device__ __forceinline__ float rs_to_rstd(u64 q) { return __builtin_amdgcn_rsqf((float)q * (1.0f / (16777216.0f * DM)) + EPS); }
struct EpiIn {
    static constexpr bool PERM = true, HOOKS = false; static constexpr int NST = 16;
    __device__ __forceinline__ int cls(const Unit&) const { return 1; }
    bf16* pxa; bf16* pxg; const u64* rs; const float* cin;
    __device__ __forceinline__ void operator()(const f32x4 (&acc)[2][2][4][2], const Unit& u, int wr, int wc, int fr, int fq) const {
        { int l_; asm volatile("v_mbcnt_lo_u32_b32 %0, -1, 0\n\tv_mbcnt_hi_u32_b32 %0, -1, %0" : "=v"(l_)); fr = l_ & 15; fq = l_ >> 4; }
        const bool gate = u.pn >= 11; bf16* base = gate ? pxg : pxa; const int ldc = gate ? NPXG : NPXA; const int colt = (gate ? u.pn - 11 : u.pn) * 256;
        const int grp = u.pm >= 128 ? 4 : (u.pm >> 5);
        const int row0 = u.pm * 256 + wr * 64 + fr, col0 = colt + wc * 32 + 8 * fq;
        const float* cp = cin + grp * NIN + u.pn * 256 + wc * 32 + 8 * fq;
        unsigned char* gbase = (unsigned char*)pxg + (gate ? gq_tile((u.pn - 11) >> 2, u.pm, (u.pn - 11) & 3) : 0);
        const float gsc = gate ? -1.4426950408889634f : 1.0f;
        f32x4 cv[2][2];
#pragma unroll
        for (int bj = 0; bj < 2; ++bj) { cv[bj][0] = *(const f32x4*)(cp + bj * 128) * gsc; cv[bj][1] = *(const f32x4*)(cp + bj * 128 + 4) * gsc; }
        u64 rq[2][4]; float rsv[2][4];
#pragma unroll
        for (int ai = 0; ai < 2; ++ai)
#pragma unroll
            for (int m = 0; m < 4; ++m) rq[ai][m] = rs[row0 + ai * 128 + m * 16];
        asm volatile("" ::: "memory");
#pragma unroll
        for (int ai = 0; ai < 2; ++ai)
#pragma unroll
            for (int m = 0; m < 4; ++m) rsv[ai][m] = rs_to_rstd(rq[ai][m]) * gsc;
#pragma unroll
        for (int ai = 0; ai < 2; ++ai)
#pragma unroll
            for (int m = 0; m < 4; ++m) { const int row = row0 + ai * 128 + m * 16; bf16* rowp = base + (size_t)row * ldc + col0; const float rstd = rsv[ai][m];
#pragma unroll
                for (int bj = 0; bj < 2; ++bj) { f32x4 v0 = acc[ai][bj][m][0] * rstd + cv[bj][0], v1 = acc[ai][bj][m][1] * rstd + cv[bj][1];
                    if (gate) {
#pragma unroll
                        for (int e = 0; e < 4; ++e) { v0[e] = __builtin_fmaf(fmaxf(__builtin_amdgcn_rcpf(1.0f + __builtin_amdgcn_exp2f(v0[e])), 1.0f / 255.0f), 255.0f, 8388608.0f);
                                                      v1[e] = __builtin_fmaf(fmaxf(__builtin_amdgcn_rcpf(1.0f + __builtin_amdgcn_exp2f(v1[e])), 1.0f / 255.0f), 255.0f, 8388608.0f); }
                        v2u gq; gq.x = pk4q(v0[0], v0[1], v0[2], v0[3]); gq.y = pk4q(v1[0], v1[1], v1[2], v1[3]);
                        *(v2u*)(gbase + gq_piece(ai, m, wr * 4 + wc, fq * 16 + fr) + bj * 8) = gq;
                    } else {
                        v4u w; w.x = cvt_pk_bf16(v0[0], v0[1]); w.y = cvt_pk_bf16(v0[2], v0[3]); w.z = cvt_pk_bf16(v1[0], v1[1]); w.w = cvt_pk_bf16(v1[2], v1[3]);
                        *(v4u*)(rowp + bj * 128) = w; } }
            }
    }
};
struct EpiMerge {
    static constexpr bool PERM = true, HOOKS = true; static constexpr int NST = 16;
    __device__ __forceinline__ int cls(const Unit&) const { return 1; }
    bf16* m; const bf16* pxg;
    __device__ __forceinline__ void hook(f32x4 (&acc)[2][2][4][2], const Unit& u, int t, int wr, int wc, int fr, int fq) const {
        asm volatile("" : "+v"(fr), "+v"(fq));
        const int wv = wr * 4 + wc, ln = fq * 16 + fr;
        const unsigned char* gnum = (const unsigned char*)pxg + gq_tile(t == 4 ? 0 : 1, u.pm, u.pn); const unsigned char* gden = (const unsigned char*)pxg + gq_tile(t == 4 ? 1 : 2, u.pm, u.pn);
#pragma unroll
        for (int ai = 0; ai < 2; ++ai) {
            v4u gn[4], gd[4];
#pragma unroll
            for (int mm = 0; mm < 4; ++mm) { const int ro = gq_piece(ai, mm, wv, ln); gn[mm] = *(const v4u*)(gnum + ro); gd[mm] = *(const v4u*)(gden + ro); }
            asm volatile("" ::: "memory");
#pragma unroll
            for (int mm = 0; mm < 4; ++mm)
#pragma unroll
                for (int bj = 0; bj < 2; ++bj) {
                    const unsigned a0 = bj ? gn[mm].z : gn[mm].x, a1 = bj ? gn[mm].w : gn[mm].y, d0 = bj ? gd[mm].z : gd[mm].x, d1 = bj ? gd[mm].w : gd[mm].y;
                    f32x4& v0 = acc[ai][bj][mm][0]; f32x4& v1 = acc[ai][bj][mm][1];
                    v0[0] *= ub0(a0) * __builtin_amdgcn_rcpf(ub0(d0)); v0[1] *= ub1(a0) * __builtin_amdgcn_rcpf(ub1(d0)); v0[2] *= ub2(a0) * __builtin_amdgcn_rcpf(ub2(d0)); v0[3] *= ub3(a0) * __builtin_amdgcn_rcpf(ub3(d0));
                    v1[0] *= ub0(a1) * __builtin_amdgcn_rcpf(ub0(d1)); v1[1] *= ub1(a1) * __builtin_amdgcn_rcpf(ub1(d1)); v1[2] *= ub2(a1) * __builtin_amdgcn_rcpf(ub2(d1)); v1[3] *= ub3(a1) * __builtin_amdgcn_rcpf(ub3(d1)); }
        }
    }
    __device__ __forceinline__ void operator()(const f32x4 (&acc)[2][2][4][2], const Unit& u, int wr, int wc, int fr, int fq) const {
        asm volatile("" : "+v"(fr), "+v"(fq));
        const int row0 = u.pm * 256 + wr * 64 + fr, col0 = u.pn * 256 + wc * 32 + 8 * fq;
        const unsigned char* ga = (const unsigned char*)pxg + gq_tile(2, u.pm, u.pn);
        constexpr float S = 1.0f / 255.0f;
#pragma unroll
        for (int ai = 0; ai < 2; ++ai) {
            v4u g[4];
#pragma unroll
            for (int mm = 0; mm < 4; ++mm) g[mm] = *(const v4u*)(ga + gq_piece(ai, mm, wr * 4 + wc, fq * 16 + fr));
            asm volatile("" ::: "memory");
#pragma unroll
            for (int mm = 0; mm < 4; ++mm)
#pragma unroll
                for (int bj = 0; bj < 2; ++bj) { const f32x4 v0 = acc[ai][bj][mm][0], v1 = acc[ai][bj][mm][1]; const unsigned q0 = bj ? g[mm].z : g[mm].x, q1 = bj ? g[mm].w : g[mm].y;
                    v4u w; w.x = cvt_pk_bf16(v0[0] * (ub0(q0) * S), v0[1] * (ub1(q0) * S)); w.y = cvt_pk_bf16(v0[2] * (ub2(q0) * S), v0[3] * (ub3(q0) * S));
                    w.z = cvt_pk_bf16(v1[0] * (ub0(q1) * S), v1[1] * (ub1(q1) * S)); w.w = cvt_pk_bf16(v1[2] * (ub2(q1) * S), v1[3] * (ub3(q1) * S));
                    *(v4u*)(m + ((size_t)(((u.pm * 16 + ai * 8 + wr * 4 + mm) * (DM / 32) + u.pn * 8 + wc + bj * 4) * 512) + fr * 32 + 8 * fq)) = w; }
        }
    }
};
template <bool BF  >
struct EpiRes {
    static constexpr bool PERM = true, HOOKS = false; static constexpr int NST = 32;
    __device__ __forceinline__ int cls(const Unit&) const { return 1; }
    const void* base_l; bf16* out; const float* gate;
    float* part;
    const float* gn; bf16* ap; u64* rs;
    __device__ __forceinline__ void operator()(const f32x4 (&acc)[2][2][4][2], const Unit& u, int wr, int wc, int fr, int fq) const {
        asm volatile("" : "+v"(fr), "+v"(fq));
        const bool isc = u.pm >= 128; const int grp = isc ? 4 : (u.pm >> 5);
        const int row0 = (isc ? (u.pm - 128) : u.pm) * 256 + wr * 64 + fr, col0 = u.pn * 256 + wc * 32 + 8 * fq;
        if (isc) {
            if (part == nullptr) return;
            float* po = part + (size_t)u.br * 1024 * 1024;
#pragma unroll
            for (int ai = 0; ai < 2; ++ai)
#pragma unroll
                for (int m = 0; m < 4; ++m)
#pragma unroll
                    for (int bj = 0; bj < 2; ++bj)
#pragma unroll
                        for (int n = 0; n < 2; ++n) *(f32x4*)(po + (size_t)(row0 + ai * 128 + m * 16) * DM + col0 + bj * 128 + n * 4) = acc[ai][bj][m][n];
            return;
        }
        const size_t stile = (size_t)(u.pm * 4 + u.pn) * 65536;
        f32x4 gv[2][2], gnv[2][2];
#pragma unroll
        for (int bj = 0; bj < 2; ++bj)
#pragma unroll
            for (int n = 0; n < 2; ++n) { gv[bj][n] = *(const f32x4*)(gate + grp * NMOD + col0 + bj * 128 + n * 4); gnv[bj][n] = *(const f32x4*)(gn + grp * DM + col0 + bj * 128 + n * 4); }
#pragma unroll
        for (int ai = 0; ai < 2; ++ai)
#pragma unroll
            for (int mp = 0; mp < 2; ++mp) {
                f32x4 bs[2][2][2];
                if constexpr (BF) {
                    v4u bb[2][2];
#pragma unroll
                    for (int mq = 0; mq < 2; ++mq)
#pragma unroll
                        for (int bj = 0; bj < 2; ++bj) bb[mq][bj] = *(const v4u*)((const bf16*)base_l + stile + gate_piece(ai, 2 * mp + mq, bj, wr * 4 + wc, fq * 16 + fr));
                    asm volatile("" ::: "memory");
#pragma unroll
                    for (int mq = 0; mq < 2; ++mq)
#pragma unroll
                        for (int bj = 0; bj < 2; ++bj) { const v4u b = bb[mq][bj]; bs[mq][bj][0] = (f32x4){bflo(b.x), bfhi(b.x), bflo(b.y), bfhi(b.y)}; bs[mq][bj][1] = (f32x4){bflo(b.z), bfhi(b.z), bflo(b.w), bfhi(b.w)}; }
                } else {
#pragma unroll
                    for (int mq = 0; mq < 2; ++mq)
#pragma unroll
                        for (int bj = 0; bj < 2; ++bj)
#pragma unroll
                            for (int n = 0; n < 2; ++n) bs[mq][bj][n] = *(const f32x4*)((const float*)base_l + (size_t)(row0 + ai * 128 + (2 * mp + mq) * 16) * DM + col0 + bj * 128 + n * 4);
                    asm volatile("" ::: "memory");
                }
#pragma unroll
                for (int mq = 0; mq < 2; ++mq) { const int m = 2 * mp + mq; float ss = 0.f; const size_t ro = (size_t)(row0 + ai * 128 + m * 16) * DM + col0;
#pragma unroll
                    for (int bj = 0; bj < 2; ++bj) {
                        const f32x4 o0 = bs[mq][bj][0] + gv[bj][0] * acc[ai][bj][m][0], o1 = bs[mq][bj][1] + gv[bj][1] * acc[ai][bj][m][1];
                        v4u ow; ow.x = cvt_pk_bf16(o0[0], o0[1]); ow.y = cvt_pk_bf16(o0[2], o0[3]); ow.z = cvt_pk_bf16(o1[0], o1[1]); ow.w = cvt_pk_bf16(o1[2], o1[3]);
                        *(v4u*)(out + stile + gate_piece(ai, m, bj, wr * 4 + wc, fq * 16 + fr)) = ow;
                        const f32x4 y0 = o0 * gnv[bj][0], y1 = o1 * gnv[bj][1];
                        v4u w; w.x = cvt_pk_bf16(y0[0], y0[1]); w.y = cvt_pk_bf16(y0[2], y0[3]); w.z = cvt_pk_bf16(y1[0], y1[1]); w.w = cvt_pk_bf16(y1[2], y1[3]);
                        *(v4u*)(ap + ((size_t)(((u.pm * 16 + ai * 8 + wr * 4 + m) * (DM / 32) + u.pn * 8 + wc + bj * 4) * 512) + fr * 32 + 8 * fq)) = w;
                        ss += ((o0[0] * o0[0] + o0[1] * o0[1]) + (o0[2] * o0[2] + o0[3] * o0[3])) + ((o1[0] * o1[0] + o1[1] * o1[1]) + (o1[2] * o1[2] + o1[3] * o1[3])); }
                    ss += __shfl_xor(ss, 16); ss += __shfl_xor(ss, 32);
                    if (fq == 0) __hip_atomic_fetch_add(rs + row0 + ai * 128 + m * 16, (u64)(ss * 16777216.0f + 0.5f), __ATOMIC_RELAXED, __HIP_MEMORY_SCOPE_AGENT); }
            }
    }
};
struct EpiResFinal {
    static constexpr bool PERM = true, HOOKS = false; static constexpr int NST = 32;
    __device__ __forceinline__ int cls(const Unit&) const { return 1; }
    const bf16* xs; float* xo; const float* gate; const float* fg; u64* rs; unsigned* cnt; unsigned* tmo;
    __device__ __forceinline__ void operator()(f32x4 (&acc)[2][2][4][2], const Unit& u, int wr, int wc, int fr, int fq) const {
        asm volatile("" : "+v"(fr), "+v"(fq));
        const int grp = u.pm >> 5, row0 = u.pm * 256 + wr * 64 + fr, col0 = u.pn * 256 + wc * 32 + 8 * fq;
        f32x4 gv[2][2];
#pragma unroll
        for (int bj = 0; bj < 2; ++bj)
#pragma unroll
            for (int n = 0; n < 2; ++n) gv[bj][n] = *(const f32x4*)(gate + grp * NMOD + col0 + bj * 128 + n * 4);
#pragma unroll
        for (int ai = 0; ai < 2; ++ai)
#pragma unroll
            for (int mp = 0; mp < 2; ++mp) {
                f32x4 bs[2][2][2];
                { v4u bb[2][2];
#pragma unroll
                  for (int mq = 0; mq < 2; ++mq)
#pragma unroll
                      for (int bj = 0; bj < 2; ++bj) bb[mq][bj] = *(const v4u*)(xs + (size_t)(u.pm * 4 + u.pn) * 65536 + gate_piece(ai, 2 * mp + mq, bj, wr * 4 + wc, fq * 16 + fr));
                  asm volatile("" ::: "memory");
#pragma unroll
                  for (int mq = 0; mq < 2; ++mq)
#pragma unroll
                      for (int bj = 0; bj < 2; ++bj) { const v4u b = bb[mq][bj]; bs[mq][bj][0] = (f32x4){bflo(b.x), bfhi(b.x), bflo(b.y), bfhi(b.y)}; bs[mq][bj][1] = (f32x4){bflo(b.z), bfhi(b.z), bflo(b.w), bfhi(b.w)}; } }
#pragma unroll
                for (int mq = 0; mq < 2; ++mq) { const int m = 2 * mp + mq; float ss = 0.f;
#pragma unroll
                    for (int bj = 0; bj < 2; ++bj)
#pragma unroll
                        for (int n = 0; n < 2; ++n) { const f32x4 o = bs[mq][bj][n] + gv[bj][n] * acc[ai][bj][m][n]; acc[ai][bj][m][n] = o; ss += (o[0] * o[0] + o[1] * o[1]) + (o[2] * o[2] + o[3] * o[3]); }
                    ss += __shfl_xor(ss, 16); ss += __shfl_xor(ss, 32);
                    if (fq == 0) __hip_atomic_fetch_add(rs + row0 + ai * 128 + m * 16, (u64)(ss * 16777216.0f + 0.5f), __ATOMIC_RELAXED, __HIP_MEMORY_SCOPE_AGENT); }
            }
        asm volatile("s_waitcnt vmcnt(0)" ::: "memory");
        unsigned* pc = cnt + 64 * u.pm;
        if (__builtin_amdgcn_mbcnt_hi(~0u, __builtin_amdgcn_mbcnt_lo(~0u, 0u)) == 0) __hip_atomic_fetch_add(pc, 1u, __ATOMIC_RELAXED, __HIP_MEMORY_SCOPE_AGENT);
        { unsigned spins = 0;
          while ((unsigned)__builtin_amdgcn_readfirstlane(__hip_atomic_load(pc, __ATOMIC_RELAXED, __HIP_MEMORY_SCOPE_AGENT)) < 32u) {
              __builtin_amdgcn_s_sleep(2);
              if (++spins > (1u << 22)) { __hip_atomic_store(tmo, 1u, __ATOMIC_RELAXED, __HIP_MEMORY_SCOPE_AGENT); break; } } }
        f32x4 fgv[2][2];
#pragma unroll
        for (int bj = 0; bj < 2; ++bj)
#pragma unroll
            for (int n = 0; n < 2; ++n) fgv[bj][n] = *(const f32x4*)(fg + col0 + bj * 128 + n * 4);
#pragma unroll
        for (int ai = 0; ai < 2; ++ai)
#pragma unroll
            for (int m = 0; m < 4; ++m) { const int row = row0 + ai * 128 + m * 16;
                const float rstd = rs_to_rstd(__hip_atomic_load(rs + row, __ATOMIC_RELAXED, __HIP_MEMORY_SCOPE_AGENT));
#pragma unroll
                for (int bj = 0; bj < 2; ++bj)
#pragma unroll
                    for (int n = 0; n < 2; ++n) *(f32x4*)(xo + (size_t)row * DM + col0 + bj * 128 + n * 4) = acc[ai][bj][m][n] * rstd * fgv[bj][n]; }
    }
};
struct EpiAct {
    static constexpr bool PERM = true, HOOKS = false; static constexpr int NST = 16;
    __device__ __forceinline__ int cls(const Unit&) const { return 1; }
    bf16* a; const u64* rs; const float* cup;
    __device__ __forceinline__ void operator()(const f32x4 (&acc)[2][2][4][2], const Unit& u, int wr, int wc, int fr, int fq) const {
        asm volatile("" : "+v"(fr), "+v"(fq));
        const int grp = u.pm >= 128 ? 4 : (u.pm >> 5);
        const int row0 = u.pm * 256 + wr * 64 + fr, col0 = u.pn * 256 + wc * 32 + 8 * fq;
        const float* cp = cup + grp * FF + col0;
        f32x4 cv[2][2];
#pragma unroll
        for (int bj = 0; bj < 2; ++bj) { cv[bj][0] = *(const f32x4*)(cp + bj * 128); cv[bj][1] = *(const f32x4*)(cp + bj * 128 + 4); }
        u64 rq[2][4]; float rsv[2][4];
#pragma unroll
        for (int ai = 0; ai < 2; ++ai)
#pragma unroll
            for (int m = 0; m < 4; ++m) rq[ai][m] = rs[row0 + ai * 128 + m * 16];
        asm volatile("" ::: "memory");
#pragma unroll
        for (int ai = 0; ai < 2; ++ai)
#pragma unroll
            for (int m = 0; m < 4; ++m) rsv[ai][m] = rs_to_rstd(rq[ai][m]);
#pragma unroll
        for (int ai = 0; ai < 2; ++ai)
#pragma unroll
            for (int m = 0; m < 4; ++m) { const int row = row0 + ai * 128 + m * 16; bf16* rowp = a + (size_t)row * FF + col0; const float rstd = rsv[ai][m];
#pragma unroll
                for (int bj = 0; bj < 2; ++bj) { f32x4 v0 = acc[ai][bj][m][0] * rstd + cv[bj][0], v1 = acc[ai][bj][m][1] * rstd + cv[bj][1];
#pragma unroll
                    for (int e = 0; e < 4; ++e) { const float r0 = fmaxf(v0[e], 0.f), r1 = fmaxf(v1[e], 0.f); v0[e] = r0 * r0; v1[e] = r1 * r1; }
                    v4u w; w.x = cvt_pk_bf16(v0[0], v0[1]); w.y = cvt_pk_bf16(v0[2], v0[3]); w.z = cvt_pk_bf16(v1[0], v1[1]); w.w = cvt_pk_bf16(v1[2], v1[3]);
                    *(v4u*)(a + ((size_t)(((u.pm * 16 + ai * 8 + wr * 4 + m) * (FF / 32) + u.pn * 8 + wc + bj * 4) * 512) + fr * 32 + 8 * fq)) = w; } }
    }
};

constexpr int NS = 8;
constexpr int NSTEPS = 2 + 2 * NS;
constexpr int LARGS_OFF = LDSCTL_OFF + 1024;
enum { A_X = 0, A_C, A_CTX, A_CCTX, A_ADAW, A_ADAB, A_N1G, A_N2G, A_WIN, A_CONVW, A_RELB, A_WF, A_WC, A_WA, A_WO, A_W1, A_W2, A_FG, A_OUT, A_WS, A_NARGS };

struct Ctx { LAS unsigned char* lds; int wave, G, bx, gw, NGW, NGT;
    __device__ __forceinline__ int lane() const { int l; asm volatile("v_mbcnt_lo_u32_b32 %0, -1, 0\n\tv_mbcnt_hi_u32_b32 %0, -1, %0" : "=v"(l)); return l; }
    __device__ __forceinline__ int tid() const { return wave * 64 + lane(); }
    __device__ __forceinline__ int gt() const { return bx * NTHR + tid(); }
};
template <int I> __device__ __forceinline__ unsigned long long ldarg_t() {
    unsigned long long v; unsigned tmp;
    asm volatile("v_mov_b32 %1, %2\n\tds_read_b64 %0, %1 offset:%3\n\ts_waitcnt lgkmcnt(0)" : "=&v"(v), "=&v"(tmp) : "i"(LARGS_OFF), "i"(I * 8) : "memory");
    const unsigned lo = __builtin_amdgcn_readfirstlane((unsigned)v), hi = __builtin_amdgcn_readfirstlane((unsigned)(v >> 32));
    return ((unsigned long long)hi << 32) | lo;
}
#define ldarg(C, i) ldarg_t<(i)>()
#define ARGF(i) ((const float*)(const GAS float*)ldarg(C, (i)))
#define WSP(T, off) ((T*)(GAS T*)((GAS unsigned char*)ldarg(C, A_WS) + (off)))

__device__ __forceinline__ void ph_mod_partial(const Ctx& C) {
    const float* cvec = ARGF(A_C); const float* cctx = ARGF(A_CCTX); const float* ada_w = ARGF(A_ADAW);
    float* modp = WSP(float, WS_MODP); float2* tw = WSP(float2, WS_TW);
    LAS float* sl = (LAS float*)C.lds;
    for (int item = C.bx; item < 2 * 8 * 12; item += C.G) {
        const int l = item / 96, rem = item % 96, kc = rem / 12, jb = rem % 12;
        __syncthreads();
        for (int e = C.tid(); e < 5 * 128; e += NTHR) { const int g = e >> 7, k = kc * 128 + (e & 127); const float v = g < 4 ? cvec[g * DM + k] : cctx[k]; sl[e] = v / (1.0f + __expf(-v)); }
        __syncthreads();
        const int tid = C.tid(), jq = tid & 127, kq = tid >> 7;
        const float* wp = ada_w + ((size_t)l * DM + kc * 128 + kq * 32) * NMOD + jb * 512 + 4 * jq;
        f32x4 a[5];
#pragma unroll
        for (int g = 0; g < 5; ++g) a[g] = (f32x4){0.f, 0.f, 0.f, 0.f};
#pragma unroll 16
        for (int k = 0; k < 32; ++k) { const f32x4 wv = *(const f32x4*)(wp + (size_t)k * NMOD);
#pragma unroll
            for (int g = 0; g < 5; ++g) a[g] += sl[g * 128 + kq * 32 + k] * wv; }
        LAS float* red = sl + 1024;
#pragma unroll
        for (int g = 0; g < 5; ++g) { LAS float* rp = red + (kq * 5 + g) * 512 + 4 * jq; rp[0] = a[g][0]; rp[1] = a[g][1]; rp[2] = a[g][2]; rp[3] = a[g][3]; }
        __syncthreads();
        for (int e = tid; e < 5 * 512; e += NTHR) { const int g = e >> 9, c = e & 511;
            modp[((size_t)(l * 8 + kc) * 5 + g) * NMOD + jb * 512 + c] = (red[(0 * 5 + g) * 512 + c] + red[(1 * 5 + g) * 512 + c]) + (red[(2 * 5 + g) * 512 + c] + red[(3 * 5 + g) * 512 + c]); }
    }
    for (int m = C.gt(); m < 8192; m += C.NGT) { float s, c; sincospif((float)m * (1.0f / 4096.0f), &s, &c); tw[m] = make_float2(c, s); }
}
__device__ __forceinline__ void ph_mod_reduce(const Ctx& C) {
    const float* ada_b = ARGF(A_ADAB); const float* modp = WSP(float, WS_MODP); float* mod = WSP(float, WS_MOD);
    for (int e = C.gt(); e < 2 * 5 * NMOD; e += C.NGT) { const int l = e / (5 * NMOD), r = e % (5 * NMOD), j = r % NMOD; float s = ada_b[l * NMOD + j];
#pragma unroll
        for (int kc = 0; kc < 8; ++kc) s += modp[(size_t)(l * 8 + kc) * 5 * NMOD + r];
        mod[e] = s; }
    float* gnt = WSP(float, WS_GN); const float* n1g = ARGF(A_N1G); const float* n2g = ARGF(A_N2G);
    for (int e = C.gt(); e < 2 * 2 * 5 * DM; e += C.NGT) { const int col = e & 1023, grp = (e >> 10) % 5, w = (e / (5 * DM)) & 1, l = e / (10 * DM), j = (w ? 4 : 1) * DM + col;
        float s = ada_b[l * NMOD + j];
#pragma unroll
        for (int kc = 0; kc < 8; ++kc) s += modp[((size_t)(l * 8 + kc) * 5 + grp) * NMOD + j];
        gnt[e] = (w ? n2g : n1g)[l * DM + col] * (1.0f + s); }
}
__device__ __forceinline__ void ph_ctab(const Ctx& C, int l) {
    LAS float* red = (LAS float*)(C.lds + 131072); LAS float* cu = red + 8 * 5 * 64;
    const float* modl = WSP(const float, WS_MOD) + (size_t)l * 5 * NMOD; const float2* tw = WSP(const float2, WS_TW);
    float* cin = WSP(float, WS_CIN) + (size_t)l * 5 * NIN; float* cup = WSP(float, WS_CUP) + (size_t)l * 5 * FF;
    const int lane = C.lane(), w = C.wave, tid = C.tid();
    LAS float* sl = (LAS float*)C.lds;
    for (int it = C.bx; it < 88 + 64; it += C.G) {
        const bool isin = it < 88; const int ldw = isin ? NIN_ORIG : FF, col0 = (isin ? it : it - 88) * 64;
        __syncthreads();
        for (int e = tid; e < 5 * 1024; e += NTHR) sl[e] = modl[(e >> 10) * NMOD + (isin ? 0 : 3 * DM) + (e & 1023)];
        __syncthreads();
        const int rq = lane >> 4, c4 = lane & 15;
        const float* W = (isin ? ARGF(A_WIN) + (size_t)l * DM * NIN_ORIG : ARGF(A_W1) + (size_t)l * DM * FF) + (size_t)(128 * w + rq) * ldw + col0 + 4 * c4;
        f32x4 a[5];
#pragma unroll
        for (int g = 0; g < 5; ++g) a[g] = (f32x4){0.f, 0.f, 0.f, 0.f};
#pragma unroll 8
        for (int i = 0; i < 32; ++i) { const f32x4 wv = *(const f32x4*)(W + (size_t)(4 * i) * ldw); const int kr = 128 * w + 4 * i + rq;
#pragma unroll
            for (int g = 0; g < 5; ++g) a[g] += sl[g * 1024 + kr] * wv; }
#pragma unroll
        for (int g = 0; g < 5; ++g)
#pragma unroll
            for (int e = 0; e < 4; ++e) { float v = a[g][e]; v += __shfl_xor(v, 16); v += __shfl_xor(v, 32); a[g][e] = v; }
        if (lane < 16) {
#pragma unroll
            for (int g = 0; g < 5; ++g) { red[(w * 5 + g) * 64 + 4 * c4] = a[g][0]; red[(w * 5 + g) * 64 + 4 * c4 + 1] = a[g][1]; red[(w * 5 + g) * 64 + 4 * c4 + 2] = a[g][2]; red[(w * 5 + g) * 64 + 4 * c4 + 3] = a[g][3]; } }
        __syncthreads();
        if (tid < 320) { const int g = tid >> 6, c = tid & 63; float v = 0.f;
#pragma unroll
            for (int ww = 0; ww < 8; ++ww) v += red[(ww * 5 + g) * 64 + c];
            if (!isin) cup[g * FF + col0 + c] = v; else if (it >= 4) cin[g * NIN + col0 + c + 256] = v; else cu[g * 64 + c] = v; }
        if (isin && it < 4) { __syncthreads();
            if (tid < 320) { const int g = tid >> 6, kc = tid & 63; float p = 0.f, q = 0.f;
                for (int c = 0; c < 64; ++c) { const float2 t = tw[((c * kc) & 63) * 128]; const float v = cu[g * 64 + c]; p += v * t.x; q += v * t.y; }
                cin[g * NIN + it * 64 + kc] = p; cin[g * NIN + 256 + it * 64 + kc] = q; } }
    }
    __syncthreads();
}
__device__ __forceinline__ void ph_weights(const Ctx& C, int l) {
    LAS float* scr = (LAS float*)(C.lds + C.wave * 16384);
    const int lane = C.lane();
    const float* Win = ARGF(A_WIN) + (size_t)l * DM * NIN_ORIG;
    bf16* win_t = WSP(bf16, WS_WIN); bf16* wm_t = WSP(bf16, WS_WM);
    constexpr int I_IN = (DM / 64) * ((NIN_ORIG - 256) / 32), I_F = (256 / 64) * (DM / 32), I_A = (512 / 64) * (DM / 32), I_O = (DM / 64) * (DM / 32), I_1 = (DM / 64) * (FF / 32), I_2 = (FF / 64) * (DM / 32);
    constexpr int NITEMS = I_IN + 2 * I_F + I_A + I_O + I_1 + I_2;
    for (int it = C.gw; it < NITEMS; it += C.NGW) {
        int r = it;
        if (r < I_IN) { transpose_item(Win + 256, NIN_ORIG, NIN_ORIG - 256, win_t, DM, 512, 0, scr, r, lane); continue; } r -= I_IN;
        if (r < I_F) { transpose_item(ARGF(A_WF) + (size_t)l * 256 * DM, DM, DM, wm_t, DM, 0, 0, scr, r, lane); continue; } r -= I_F;
        if (r < I_F) { transpose_item(ARGF(A_WC) + (size_t)l * 256 * DM, DM, DM, wm_t, DM, 0, 256, scr, r, lane); continue; } r -= I_F;
        if (r < I_A) { transpose_item(ARGF(A_WA) + (size_t)l * 512 * DM, DM, DM, wm_t, DM, 0, 512, scr, r, lane); continue; } r -= I_A;
        if (r < I_O) { transpose_item(ARGF(A_WO) + (size_t)l * DM * DM, DM, DM, WSP(bf16, WS_WO), DM, 0, 0, scr, r, lane); continue; } r -= I_O;
        if (r < I_1) { transpose_item(ARGF(A_W1) + (size_t)l * DM * FF, FF, FF, WSP(bf16, WS_W1), DM, 0, 0, scr, r, lane); continue; } r -= I_1;
        transpose_item(ARGF(A_W2) + (size_t)l * FF * DM, DM, DM, WSP(bf16, WS_W2), FF, 0, 0, scr, r, lane);
    }
    for (int it = C.gw; it < 4 * 32 * 8; it += C.NGW) {
        const int kq = it & 7, g = it >> 8, k0 = ((it >> 3) & 31) * 32, kl = lane & 31, pq = lane >> 5;
        LAS float* tile = scr;
        LAS float* ct = scr + 32 * 65;
        { float s, c; sincospif((float)lane * (1.0f / 32.0f), &s, &c); ct[lane] = c; ct[64 + lane] = s; }
#pragma unroll 8
        for (int kk = 0; kk < 32; ++kk) tile[kk * 65 + lane] = Win[(size_t)(k0 + kk) * NIN_ORIG + g * 64 + lane];
        LDS_WAIT(); asm volatile("" ::: "memory");
        float p[8];
#pragma unroll
        for (int j = 0; j < 8; ++j) p[j] = 0.f;
#pragma unroll 4
        for (int c = 0; c < 64; ++c) { const float wv = tile[kl * 65 + c];
#pragma unroll
            for (int j = 0; j < 8; ++j) p[j] += wv * ct[pq * 64 + ((c * (kq * 8 + j)) & 63)]; }
#pragma unroll
        for (int j = 0; j < 8; ++j) win_t[(size_t)(pq * 256 + g * 64 + kq * 8 + j) * DM + k0 + kl] = (bf16)f2bf(p[j]);
        LDS_WAIT(); asm volatile("" ::: "memory");
    }
}
__device__ __forceinline__ void ph_prenorm(const Ctx& C, const float* xl, const float* xc, const float* gn, bf16* dst, u64* rs, int row_begin, int row_end, const float* part, const float* pgate, bool mt  ) {
    const int lane = C.lane();
    for (int row = row_begin + C.gw; row < row_end; row += C.NGW) {
        const bool isc = row >= ML; const int grp = isc ? 4 : (row >> 13);
        const float* xr = isc ? xc + (size_t)(row - ML) * DM : xl + (size_t)row * DM;
        f32x4 v[4]; float s2 = 0.f;
#pragma unroll
        for (int j = 0; j < 4; ++j) { v[j] = *(const f32x4*)(xr + 4 * lane + 256 * j);
            if (part != nullptr && isc) {
                const size_t po = (size_t)(row - ML) * DM + 4 * lane + 256 * j;
                const f32x4 ps = (*(const f32x4*)(part + po) + *(const f32x4*)(part + po + 1048576)) + (*(const f32x4*)(part + po + 2 * 1048576) + *(const f32x4*)(part + po + 3 * 1048576));
                v[j] = v[j] + *(const f32x4*)(pgate + 4 * lane + 256 * j) * ps; }
            s2 += (v[j].x * v[j].x + v[j].y * v[j].y) + (v[j].z * v[j].z + v[j].w * v[j].w); }
        s2 = wave_sum(s2);
        if (lane == 0) rs[row] = (u64)(s2 * 16777216.0f + 0.5f);
#pragma unroll
        for (int j = 0; j < 4; ++j) { const int c0 = 4 * lane + 256 * j; const f32x4 y = v[j] * *(const f32x4*)(gn + grp * DM + c0);
            v2u o; o.x = pk2(y.x, y.y); o.y = pk2(y.z, y.w); *(v2u*)(dst + (mt ? ((size_t)(row >> 4) * (DM / 32) + (c0 >> 5)) * 512 + (row & 15) * 32 + (c0 & 31) : (size_t)row * DM + c0)) = o; }
    }
}
__device__ __forceinline__ void ph_mixers(const Ctx& C, int l) {
    const bf16* pxa = WSP(const bf16, WS_PXA); bf16* mix = WSP(bf16, WS_HX);
    const float* cw = ARGF(A_CONVW) + l * 3 * 256;
    const int nrows = l == 0 ? MT : ML;
    for (int e = C.gt(); e < nrows * 32; e += C.NGT) {
        const int row = e >> 5, ch = (e & 31) * 8;
        const int pos = row < ML ? (row & (SEQ - 1)) : ((row - ML) & 255), len = row < ML ? SEQ : 256;
        const bf16* pr = pxa + (size_t)row * NPXA;
        const v4u u1 = *(const v4u*)(pr + OFF_CU + ch), c1 = *(const v4u*)(pr + OFF_CC + ch), b1 = *(const v4u*)(pr + OFF_CB + ch);
        v4u u0 = (v4u){0, 0, 0, 0}, c0 = u0, u2 = u0, c2 = u0;
        if (pos > 0) { u0 = *(const v4u*)(pr - NPXA + OFF_CU + ch); c0 = *(const v4u*)(pr - NPXA + OFF_CC + ch); }
        if (pos < len - 1) { u2 = *(const v4u*)(pr + NPXA + OFF_CU + ch); c2 = *(const v4u*)(pr + NPXA + OFF_CC + ch); }
        float o[8]; float w0[8], w1[8], w2[8];
        { const f32x4 t0 = *(const f32x4*)(cw + ch), t1 = *(const f32x4*)(cw + ch + 4), t2 = *(const f32x4*)(cw + 256 + ch), t3 = *(const f32x4*)(cw + 256 + ch + 4), t4 = *(const f32x4*)(cw + 512 + ch), t5 = *(const f32x4*)(cw + 512 + ch + 4);
#pragma unroll
          for (int j = 0; j < 4; ++j) { w0[j] = t0[j]; w0[4 + j] = t1[j]; w1[j] = t2[j]; w1[4 + j] = t3[j]; w2[j] = t4[j]; w2[4 + j] = t5[j]; } }
#pragma unroll
        for (int j = 0; j < 4; ++j) {
            const unsigned a0 = u0[j], d0 = c0[j], a1 = u1[j], d1 = c1[j], a2 = u2[j], d2 = c2[j], bb = b1[j];
            o[2 * j] = bflo(bb) * (w0[2 * j] * bflo(a0) * bflo(d0) + w1[2 * j] * bflo(a1) * bflo(d1) + w2[2 * j] * bflo(a2) * bflo(d2));
            o[2 * j + 1] = bfhi(bb) * (w0[2 * j + 1] * bfhi(a0) * bfhi(d0) + w1[2 * j + 1] * bfhi(a1) * bfhi(d1) + w2[2 * j + 1] * bfhi(a2) * bfhi(d2));
        }
        v4u w; w.x = pk2(o[0], o[1]); w.y = pk2(o[2], o[3]); w.z = pk2(o[4], o[5]); w.w = pk2(o[6], o[7]);
        *(v4u*)(mix + (size_t)row * DM + 256 + ch) = w;
    }
}

typedef short bf16x8_t __attribute__((ext_vector_type(8)));
typedef short v4i16_t __attribute__((ext_vector_type(4)));
constexpr int AT_KW = 0, AT_VW = 73728, AT_BT = 147456;
template <bool WIN>
__device__ __forceinline__ void attn_qk(LAS unsigned char* lds, const int (&ka)[2][2], int rowoff0, const bf16x8_t (&qf)[2], f32x4 (&s)[8][2]) {
    constexpr int RS = WIN ? 8192 : 4096;
#pragma unroll
    for (int j = 0; j < 8; ++j)
#pragma unroll
        for (int t = 0; t < 2; ++t) { s[j][t] = (f32x4){0.f, 0.f, 0.f, 0.f};
#pragma unroll
            for (int ks = 0; ks < 2; ++ks) { const bf16x8_t kf = *(const LAS bf16x8_t*)(lds + ka[t][ks] + rowoff0 + j * RS); s[j][t] = __builtin_amdgcn_mfma_f32_16x16x32_bf16(kf, qf[ks], s[j][t], 0, 0, 0); } }
}
template <bool WIN>
__device__ __forceinline__ void attn_sm_pv(LAS unsigned char* lds, f32x4 (&s)[8][2], const int (&va)[2][4], int rowoff0,
                                           const LAS float* brow  , const int (&dcs)[4]  , unsigned vmask  ,
                                           f32x4 (&o)[4], f32x4& osum, float& m) {
    constexpr float SC = 0.18033688011112042f;
    constexpr int RS = WIN ? 8192 : 4096;
    const v4u onesw = (v4u){0x3F803F80u, 0x3F803F80u, 0x3F803F80u, 0x3F803F80u}; const bf16x8_t ones = __builtin_bit_cast(bf16x8_t, onesw);
    if constexpr (WIN) {
        const bool v0 = vmask & 1u, v1 = vmask & 2u, v2 = vmask & 4u, v3 = vmask & 8u;
        const unsigned hm01 = (v0 ? 0xFFFFu : 0u) | (v1 ? 0xFFFF0000u : 0u), hm23 = (v2 ? 0xFFFFu : 0u) | (v3 ? 0xFFFF0000u : 0u);
        float tmax = -1e30f;
#pragma unroll
        for (int j = 0; j < 8; ++j) {
            f32x4 v;
            v[0] = (v0 ? s[j][0][0] : s[j][1][0]) * SC + brow[j * 31 + dcs[0]]; v[1] = (v1 ? s[j][0][1] : s[j][1][1]) * SC + brow[j * 31 + dcs[1]];
            v[2] = (v2 ? s[j][0][2] : s[j][1][2]) * SC + brow[j * 31 + dcs[2]]; v[3] = (v3 ? s[j][0][3] : s[j][1][3]) * SC + brow[j * 31 + dcs[3]];
            s[j][0] = v; tmax = fmaxf(tmax, fmaxf(fmaxf(v[0], v[1]), fmaxf(v[2], v[3]))); }
        tmax = fmaxf(tmax, __shfl_xor(tmax, 16)); tmax = fmaxf(tmax, __shfl_xor(tmax, 32));
        const float mn = fmaxf(m, tmax), alpha = __builtin_amdgcn_exp2f(m - mn); m = mn;
#pragma unroll
        for (int db = 0; db < 4; ++db) o[db] = o[db] * alpha;
        osum = osum * alpha;
#pragma unroll
        for (int j = 0; j < 8; ++j) {
            const unsigned p01 = pg8::cvt_pk_bf16(__builtin_amdgcn_exp2f(s[j][0][0] - mn), __builtin_amdgcn_exp2f(s[j][0][1] - mn)), p23 = pg8::cvt_pk_bf16(__builtin_amdgcn_exp2f(s[j][0][2] - mn), __builtin_amdgcn_exp2f(s[j][0][3] - mn));
            v4u pw; pw.x = p01 & hm01; pw.y = p23 & hm23; pw.z = p01 & ~hm01; pw.w = p23 & ~hm23;
            const bf16x8_t pf = __builtin_bit_cast(bf16x8_t, pw);
            osum = __builtin_amdgcn_mfma_f32_16x16x32_bf16(ones, pf, osum, 0, 0, 0);
#pragma unroll
            for (int db = 0; db < 4; ++db) {
                const v4i16_t lo = __builtin_amdgcn_ds_read_tr16_b64_v4i16((LAS v4i16_t*)(lds + va[0][db] + rowoff0 + j * RS));
                const v4i16_t hi = __builtin_amdgcn_ds_read_tr16_b64_v4i16((LAS v4i16_t*)(lds + va[1][db] + rowoff0 + j * RS));
                const bf16x8_t vf = (bf16x8_t){lo[0], lo[1], lo[2], lo[3], hi[0], hi[1], hi[2], hi[3]};
                o[db] = __builtin_amdgcn_mfma_f32_16x16x32_bf16(vf, pf, o[db], 0, 0, 0);
            }
        }
    } else {
        float tmax = -1e30f;
#pragma unroll
        for (int j = 0; j < 8; ++j)
#pragma unroll
            for (int t = 0; t < 2; ++t) tmax = fmaxf(tmax, fmaxf(fmaxf(s[j][t][0], s[j][t][1]), fmaxf(s[j][t][2], s[j][t][3])));
        tmax = fmaxf(tmax, __shfl_xor(tmax, 16)); tmax = fmaxf(tmax, __shfl_xor(tmax, 32));
        const float mn = fmaxf(m, tmax * SC), alpha = __builtin_amdgcn_exp2f(m - mn); m = mn;
#pragma unroll
        for (int db = 0; db < 4; ++db) o[db] = o[db] * alpha;
        osum = osum * alpha;
#pragma unroll
        for (int j = 0; j < 8; ++j) {
            v4u pw;
            pw.x = pg8::cvt_pk_bf16(__builtin_amdgcn_exp2f(s[j][0][0] * SC - mn), __builtin_amdgcn_exp2f(s[j][0][1] * SC - mn)); pw.y = pg8::cvt_pk_bf16(__builtin_amdgcn_exp2f(s[j][0][2] * SC - mn), __builtin_amdgcn_exp2f(s[j][0][3] * SC - mn));
            pw.z = pg8::cvt_pk_bf16(__builtin_amdgcn_exp2f(s[j][1][0] * SC - mn), __builtin_amdgcn_exp2f(s[j][1][1] * SC - mn)); pw.w = pg8::cvt_pk_bf16(__builtin_amdgcn_exp2f(s[j][1][2] * SC - mn), __builtin_amdgcn_exp2f(s[j][1][3] * SC - mn));
            const bf16x8_t pf = __builtin_bit_cast(bf16x8_t, pw);
            osum = __builtin_amdgcn_mfma_f32_16x16x32_bf16(ones, pf, osum, 0, 0, 0);
#pragma unroll
            for (int db = 0; db < 4; ++db) {
                const v4i16_t lo = __builtin_amdgcn_ds_read_tr16_b64_v4i16((LAS v4i16_t*)(lds + va[0][db] + rowoff0 + j * RS));
                const v4i16_t hi = __builtin_amdgcn_ds_read_tr16_b64_v4i16((LAS v4i16_t*)(lds + va[1][db] + rowoff0 + j * RS));
                const bf16x8_t vf = (bf16x8_t){lo[0], lo[1], lo[2], lo[3], hi[0], hi[1], hi[2], hi[3]};
                o[db] = __builtin_amdgcn_mfma_f32_16x16x32_bf16(vf, pf, o[db], 0, 0, 0);
            }
        }
    }
}
template <bool WIN>
__device__ __forceinline__ void attn_block(LAS unsigned char* lds, const int (&ka)[2][2], const int (&va)[2][4], int rowoff0, const bf16x8_t (&qf)[2],
                                           const LAS float* brow, const int (&dcs)[4], unsigned vmask, f32x4 (&o)[4], f32x4& osum, float& m) {
    f32x4 s[8][2];
    attn_qk<WIN>(lds, ka, rowoff0, qf, s);
    attn_sm_pv<WIN>(lds, s, va, rowoff0, brow, dcs, vmask, o, osum, m);
}
__device__ __forceinline__ void attn_addr(int kc0off, int li, int fq, int (&ka)[2][2], int (&va)[2][4]) {
#pragma unroll
    for (int t = 0; t < 2; ++t) {
        const int rk = kc0off + 16 * t + li;
#pragma unroll
        for (int ks = 0; ks < 2; ++ks) ka[t][ks] = AT_KW + rk * 128 + (((4 * ks + fq) ^ ((rk >> 1) & 7)) * 16);
        const int rv = kc0off + 16 * t + 4 * fq + (li >> 2), p = li & 3;
#pragma unroll
        for (int db = 0; db < 4; ++db) va[t][db] = AT_VW + rv * 128 + (((2 * db + (p >> 1)) ^ (((rv >> 1) & 3) << 1)) * 16) + (p & 1) * 8;
    }
}

__device__ __forceinline__ void ph_ctx_dft(const Ctx& C) {
    if (C.bx >= 32) return;
    constexpr int DF_Q = 32768, DF_TW = AT_VW + 65536;
    static_assert(DF_TW + 2048 <= AT_BT, "ctx dft lds");
    const float2* tw = WSP(const float2, WS_TW); const bf16* pxa = WSP(const bf16, WS_PXA); bf16* mix = WSP(bf16, WS_HX);
    LAS unsigned char* lds = C.lds; LAS float* twl = (LAS float*)(lds + DF_TW);
    const int lane = C.lane(), w = C.wave, li = lane & 15, fq = lane >> 4, tid = C.tid();
    const int b = C.bx >> 3, kcb = (C.bx >> 1) & 3, kh = C.bx & 1;
    if (tid < 256) { const float2 v = tw[tid * 32]; twl[2 * tid] = v.x; twl[2 * tid + 1] = v.y; }
    for (int p = w; p < 32; p += 8) {
        const int tokl = p * 8 + (lane >> 3), cp = lane & 7;
        const bf16* src = pxa + ((size_t)ML + b * 256 + tokl) * NPXA + kcb * 64 + ((cp ^ (((tokl >> 1) & 3) << 1)) * 8);
        __builtin_amdgcn_global_load_lds((const unsigned*)(src + OFF_P), (LAS unsigned*)(lds + AT_VW + p * 1024), 16, 0, 0);
        __builtin_amdgcn_global_load_lds((const unsigned*)(src + OFF_Q), (LAS unsigned*)(lds + AT_VW + DF_Q + p * 1024), 16, 0, 0);
    }
    int ka[2][2], va[2][4]; attn_addr(0, li, fq, ka, va);
    asm volatile("s_waitcnt vmcnt(0) lgkmcnt(0)" ::: "memory");
    __syncthreads();
    const int k = 128 * kh + 16 * w + li;
    f32x4 o[4];
#pragma unroll
    for (int db = 0; db < 4; ++db) o[db] = (f32x4){0.f, 0.f, 0.f, 0.f};
#pragma unroll 2
    for (int j = 0; j < 8; ++j) {
        float cs[8], sn[8];
#pragma unroll
        for (int t = 0; t < 2; ++t)
#pragma unroll
            for (int i = 0; i < 4; ++i) { const int n = 32 * j + 16 * t + 4 * fq + i, idx = (n * k) & 255; cs[4 * t + i] = twl[2 * idx]; sn[4 * t + i] = -twl[2 * idx + 1]; }
        v4u cw, sw;
        cw.x = pg8::cvt_pk_bf16(cs[0], cs[1]); cw.y = pg8::cvt_pk_bf16(cs[2], cs[3]); cw.z = pg8::cvt_pk_bf16(cs[4], cs[5]); cw.w = pg8::cvt_pk_bf16(cs[6], cs[7]);
        sw.x = pg8::cvt_pk_bf16(sn[0], sn[1]); sw.y = pg8::cvt_pk_bf16(sn[2], sn[3]); sw.z = pg8::cvt_pk_bf16(sn[4], sn[5]); sw.w = pg8::cvt_pk_bf16(sn[6], sn[7]);
        const bf16x8_t cf = __builtin_bit_cast(bf16x8_t, cw), sf = __builtin_bit_cast(bf16x8_t, sw);
#pragma unroll
        for (int db = 0; db < 4; ++db) {
            const v4i16_t plo = __builtin_amdgcn_ds_read_tr16_b64_v4i16((LAS v4i16_t*)(lds + va[0][db] + j * 4096)), phi = __builtin_amdgcn_ds_read_tr16_b64_v4i16((LAS v4i16_t*)(lds + va[1][db] + j * 4096));
            const v4i16_t qlo = __builtin_amdgcn_ds_read_tr16_b64_v4i16((LAS v4i16_t*)(lds + va[0][db] + DF_Q + j * 4096)), qhi = __builtin_amdgcn_ds_read_tr16_b64_v4i16((LAS v4i16_t*)(lds + va[1][db] + DF_Q + j * 4096));
            const bf16x8_t pf = (bf16x8_t){plo[0], plo[1], plo[2], plo[3], phi[0], phi[1], phi[2], phi[3]}, qf = (bf16x8_t){qlo[0], qlo[1], qlo[2], qlo[3], qhi[0], qhi[1], qhi[2], qhi[3]};
            o[db] = __builtin_amdgcn_mfma_f32_16x16x32_bf16(pf, cf, o[db], 0, 0, 0);
            o[db] = __builtin_amdgcn_mfma_f32_16x16x32_bf16(qf, sf, o[db], 0, 0, 0);
        }
    }
    bf16* op = mix + ((size_t)ML + b * 256 + k) * DM + kcb * 64 + 4 * fq;
#pragma unroll
    for (int db = 0; db < 4; ++db) { v2u ov; ov.x = pk2(o[db][0] * (1.0f / 128.0f), o[db][1] * (1.0f / 128.0f)); ov.y = pk2(o[db][2] * (1.0f / 128.0f), o[db][3] * (1.0f / 128.0f)); *(v2u*)(op + 16 * db) = ov; }
}

__device__ __forceinline__ size_t zt_off(int b) { return b < 2 ? WS_TB + (size_t)b * 8 * MiB : (b == 2 ? (size_t)502 * MiB : WS_WIN); }
__device__ __forceinline__ void ph_t1(const Ctx& C) {
    const bf16* pxa = WSP(const bf16, WS_PXA); const int lane = C.lane();
    LAS unsigned short* tile = (LAS unsigned short*)(C.lds + C.wave * 9216);
    for (int it = C.gw; it < 4 * 2 * 128 * 4; it += C.NGW) {
        const int n2 = (it & 7) | (((it >> 5) & 15) << 3), kcb = (it >> 3) & 3, pq = (it >> 9) & 1, b = it >> 10;
#pragma unroll
        for (int i = 0; i < 8; ++i) { const int q = i * 64 + lane, n1 = q >> 3, cc = q & 7;
            const v4u v = *(const v4u*)(pxa + ((size_t)b * SEQ + n1 * 128 + n2) * NPXA + pq * 256 + kcb * 64 + cc * 8);
            *(LAS v4u*)(tile + n1 * 72 + cc * 8) = v; }
        LDS_WAIT(); asm volatile("" ::: "memory");
        bf16* zt = WSP(bf16, zt_off(b)) + ((size_t)(pq * 256 + kcb * 64 + lane) * SEQ + n2 * 64);
#pragma unroll
        for (int c = 0; c < 8; ++c) { v4u o;
            o.x = (unsigned)tile[(8 * c + 0) * 72 + lane] | ((unsigned)tile[(8 * c + 1) * 72 + lane] << 16); o.y = (unsigned)tile[(8 * c + 2) * 72 + lane] | ((unsigned)tile[(8 * c + 3) * 72 + lane] << 16);
            o.z = (unsigned)tile[(8 * c + 4) * 72 + lane] | ((unsigned)tile[(8 * c + 5) * 72 + lane] << 16); o.w = (unsigned)tile[(8 * c + 6) * 72 + lane] | ((unsigned)tile[(8 * c + 7) * 72 + lane] << 16);
            *(v4u*)(zt + 8 * c) = o; }
        LDS_WAIT(); asm volatile("" ::: "memory");
    }
}
typedef float f32x16 __attribute__((ext_vector_type(16)));
constexpr int FT_C64 = 0, FT_S64 = 9216, FT_C128 = 18432, FT_S128 = FT_C128 + 34816, FT_TA = FT_S128 + 34816, FT_TR = FT_TA + 4096, FT_ST = FT_TR + 8192;
static_assert(FT_ST + 32768 <= LDSCTL_OFF, "fft lds");
__device__ __forceinline__ void hw_sincos_rev(float rev, float& sn, float& cs) { sn = __builtin_amdgcn_sinf(rev); cs = __builtin_amdgcn_cosf(rev); }
__device__ __forceinline__ int crow16(int r, int h) { return (r & 3) + 8 * (r >> 2) + 4 * h; }
__device__ __forceinline__ void ph_fft(const Ctx& C) {
    LAS unsigned char* lds = C.lds; const int tid = C.tid(), lane = C.lane(), w = C.wave, h = lane >> 5, c = lane & 31;
    const float2* tw = WSP(const float2, WS_TW); bf16* mix = WSP(bf16, WS_HX);
    { LAS unsigned short* c64 = (LAS unsigned short*)(lds + FT_C64); LAS unsigned short* s64 = (LAS unsigned short*)(lds + FT_S64);
#pragma unroll 4
      for (int e = tid; e < 4096; e += NTHR) { const int k1 = e >> 6, n1 = e & 63; float sn, cs; hw_sincos_rev(0.5f * ((float)((n1 * k1) & 63) * (1.0f / 32.0f)), sn, cs); c64[k1 * 72 + n1] = (unsigned short)f2bf(cs); s64[k1 * 72 + n1] = (unsigned short)f2bf(sn); }
      LAS unsigned short* c128 = (LAS unsigned short*)(lds + FT_C128); LAS unsigned short* s128 = (LAS unsigned short*)(lds + FT_S128);
#pragma unroll 4
      for (int e = tid; e < 16384; e += NTHR) { const int k2 = e >> 7, p = e & 127, q = p & 15, n2 = (p & ~15) + (q & 3) + ((q >> 2) & 1) * 8 + ((q >> 3) & 1) * 4;
          float sn, cs; hw_sincos_rev(0.5f * ((float)((n2 * k2) & 127) * (1.0f / 64.0f)), sn, cs); c128[k2 * 136 + p] = (unsigned short)f2bf(cs); s128[k2 * 136 + p] = (unsigned short)f2bf(sn); }
      LAS float* ta = (LAS float*)(lds + FT_TA); LAS float* trt = (LAS float*)(lds + FT_TR);
      { const int e = tid, g = e >> 6, kk = e & 63; float sn, cs; hw_sincos_rev(0.5f * ((float)((32 * (g >> 1) + 4 * (g & 1)) * kk) * (1.0f / 4096.0f)), sn, cs); ta[2 * e] = cs; ta[2 * e + 1] = sn; }
      for (int e = tid; e < 1024; e += NTHR) { const int r = e >> 6, kk = e & 63; float sn, cs; hw_sincos_rev(0.5f * ((float)(crow16(r, 0) * kk) * (1.0f / 4096.0f)), sn, cs); trt[2 * e] = cs; trt[2 * e + 1] = sn; }
    }
    __syncthreads();
    const int vcu = (C.G % 8 == 0) ? (C.bx % 8) * (C.G / 8) + C.bx / 8 : C.bx;
    for (int it = vcu; it < 256; it += C.G) {
        const int kb = it & 1, kcg = (it >> 1) & 31, b = it >> 6, kc = kcg * 8 + w, k1 = 32 * kb + c;
        const bf16* zp = WSP(const bf16, zt_off(b)) + (size_t)kc * SEQ; const bf16* zq = zp + (size_t)256 * SEQ;
        f32x16 acc[4];
#pragma unroll
        for (int rb2 = 0; rb2 < 4; ++rb2) acc[rb2] = (f32x16){};
#pragma unroll 1
        for (int rb = 0; rb < 4; ++rb) {
            const int n2 = 32 * rb + c;
            f32x16 xr = {}, xi = {};
#pragma unroll
            for (int ks = 0; ks < 4; ++ks) {
                const bf16x8_t cf = *(const LAS bf16x8_t*)(lds + FT_C64 + (k1 * 72 + 16 * ks + 8 * h) * 2), sf = *(const LAS bf16x8_t*)(lds + FT_S64 + (k1 * 72 + 16 * ks + 8 * h) * 2);
                const bf16x8_t pf = *(const bf16x8_t*)(zp + n2 * 64 + 16 * ks + 8 * h), qf = *(const bf16x8_t*)(zq + n2 * 64 + 16 * ks + 8 * h);
                const v4u t = __builtin_bit_cast(v4u, qf) ^ 0x80008000u; const bf16x8_t qn = __builtin_bit_cast(bf16x8_t, t);
                xr = __builtin_amdgcn_mfma_f32_32x32x16_bf16(pf, cf, xr, 0, 0, 0); xi = __builtin_amdgcn_mfma_f32_32x32x16_bf16(pf, sf, xi, 0, 0, 0);
                xi = __builtin_amdgcn_mfma_f32_32x32x16_bf16(qf, cf, xi, 0, 0, 0); xr = __builtin_amdgcn_mfma_f32_32x32x16_bf16(qn, sf, xr, 0, 0, 0); }
            bf16x8_t bre[2], bim[2];
            const LAS float* tap = (const LAS float*)(lds + FT_TA) + 2 * ((rb * 2 + h) * 64 + k1); const float ac_ = tap[0], as_ = tap[1];
            const LAS float* trp = (const LAS float*)(lds + FT_TR) + 2 * k1;
#pragma unroll
            for (int sblk = 0; sblk < 2; ++sblk) {
                float tr[8], ti[8];
#pragma unroll
                for (int r8 = 0; r8 < 8; ++r8) { const int r = 8 * sblk + r8; const float rc = trp[128 * r], rs = trp[128 * r + 1]; const float tc = ac_ * rc - as_ * rs, ts = ac_ * rs + as_ * rc;
                    tr[r8] = xr[r] * tc - xi[r] * ts; ti[r8] = -(xr[r] * ts + xi[r] * tc); }
                v4u a, bq;
                a.x = pg8::cvt_pk_bf16(tr[0], tr[1]); a.y = pg8::cvt_pk_bf16(tr[2], tr[3]); a.z = pg8::cvt_pk_bf16(tr[4], tr[5]); a.w = pg8::cvt_pk_bf16(tr[6], tr[7]);
                bq.x = pg8::cvt_pk_bf16(ti[0], ti[1]); bq.y = pg8::cvt_pk_bf16(ti[2], ti[3]); bq.z = pg8::cvt_pk_bf16(ti[4], ti[5]); bq.w = pg8::cvt_pk_bf16(ti[6], ti[7]);
                bre[sblk] = __builtin_bit_cast(bf16x8_t, a); bim[sblk] = __builtin_bit_cast(bf16x8_t, bq); }
#pragma unroll
            for (int rb2 = 0; rb2 < 4; ++rb2) {
                const int k2 = 32 * rb2 + c;
#pragma unroll
                for (int sblk = 0; sblk < 2; ++sblk) {
                    const bf16x8_t ac = *(const LAS bf16x8_t*)(lds + FT_C128 + (k2 * 136 + 32 * rb + 16 * sblk + 8 * h) * 2), as = *(const LAS bf16x8_t*)(lds + FT_S128 + (k2 * 136 + 32 * rb + 16 * sblk + 8 * h) * 2);
                    acc[rb2] = __builtin_amdgcn_mfma_f32_32x32x16_bf16(ac, bre[sblk], acc[rb2], 0, 0, 0); acc[rb2] = __builtin_amdgcn_mfma_f32_32x32x16_bf16(as, bim[sblk], acc[rb2], 0, 0, 0); }
            }
        }
#pragma unroll
        for (int rb2 = 0; rb2 < 4; ++rb2) {
            LAS unsigned short* st = (LAS unsigned short*)(lds + FT_ST + (rb2 & 1) * 16384);
#pragma unroll
            for (int r = 0; r < 16; ++r) st[((crow16(r, h) * 32 + c) * 8) + w] = (unsigned short)f2bf(acc[rb2][r] * 0.001381067932f);
            LDS_WAIT(); __syncthreads();
#pragma unroll
            for (int j = 0; j < 2; ++j) { const int idx = tid + 512 * j, k2l = idx >> 5, k1l = idx & 31;
                const v4u v = *(const LAS v4u*)(st + idx * 8);
                *(v4u*)(mix + ((size_t)b * SEQ + 32 * kb + k1l + 64 * (32 * rb2 + k2l)) * DM + kcg * 8) = v; }
        }
        __syncthreads();
    }
}
__device__ __forceinline__ void attn_stage_win(LAS unsigned char* lds, const bf16* pxa, int b, int h, int R0, int w, int lane, bool isV) {
    for (int p = w; p < 72; p += 8) {
        const int tokl = p * 8 + (lane >> 3), lr = tokl >> 6, col = tokl & 63, gr = min(R0 + lr, 127), cp = lane & 7;
        const bf16* src = pxa + ((size_t)b * SEQ + gr * 64 + col) * NPXA + h * 64;
        if (!isV) __builtin_amdgcn_global_load_lds((const unsigned*)(src + OFF_K + ((cp ^ ((tokl >> 1) & 7)) * 8)), (LAS unsigned*)(lds + AT_KW + p * 1024), 16, 0, 0);
        else __builtin_amdgcn_global_load_lds((const unsigned*)(src + OFF_V + ((cp ^ (((tokl >> 1) & 3) << 1)) * 8)), (LAS unsigned*)(lds + AT_VW + p * 1024), 16, 0, 0);
    }
}
__device__ __forceinline__ void attn_stage_ctx(LAS unsigned char* lds, const bf16* pxa, int b, int h, int w, int lane, bool isV) {
    for (int p = w; p < 32; p += 8) {
        const int tokl = p * 8 + (lane >> 3), cp = lane & 7;
        const bf16* src = pxa + ((size_t)ML + b * 256 + tokl) * NPXA + h * 64;
        if (!isV) __builtin_amdgcn_global_load_lds((const unsigned*)(src + OFF_K + ((cp ^ ((tokl >> 1) & 7)) * 8)), (LAS unsigned*)(lds + AT_KW + p * 1024), 16, 0, 0);
        else __builtin_amdgcn_global_load_lds((const unsigned*)(src + OFF_V + ((cp ^ (((tokl >> 1) & 3) << 1)) * 8)), (LAS unsigned*)(lds + AT_VW + p * 1024), 16, 0, 0);
    }
}
#define AT_BAR() do { asm volatile("s_waitcnt lgkmcnt(0)" ::: "memory"); __builtin_amdgcn_s_barrier(); asm volatile("" ::: "memory"); } while (0)
__device__ __forceinline__ void ph_attn(const Ctx& C, int l) {
    const bf16* pxa = WSP(const bf16, WS_PXA); bf16* mix = WSP(bf16, WS_HX);
    const float* rb = ARGF(A_RELB) + (size_t)l * 8 * 15 * 31;
    LAS unsigned char* lds = C.lds; LAS float* biasT = (LAS float*)(lds + AT_BT);
    const int lane = C.lane(), w = C.wave, fq = lane >> 4, li = lane & 15, tid = C.tid(), tb = min(tid, 464);
    const int vcu = (C.G % 8 == 0) ? (C.bx % 8) * (C.G / 8) + C.bx / 8 : C.bx;
    __syncthreads();
    int u = vcu;
    if (u < 2048) {
        int b = u >> 9, h = (u >> 6) & 7, rp = u & 63, R0 = min(max(2 * rp - 4, 0), 120);
        attn_stage_win(lds, pxa, b, h, R0, w, lane, false); attn_stage_win(lds, pxa, b, h, R0, w, lane, true);
        bf16x8_t qf[2];
        { const size_t token = (size_t)b * SEQ + (2 * rp + (w >> 2)) * 64 + 16 * (w & 3) + li;
#pragma unroll
          for (int ks = 0; ks < 2; ++ks) qf[ks] = *(const bf16x8_t*)(pxa + token * NPXA + OFF_QQ + h * 64 + 32 * ks + 8 * fq); }
        { const float bv = rb[h * 465 + tb] * 1.4426950408889634f; asm volatile("s_waitcnt vmcnt(0)" ::: "memory"); if (tid < 465) biasT[tid] = bv; }
        AT_BAR();
        for (;;) {
            const int un = u + C.G; const bool has_next = un < 2048;
            const int bn_ = un >> 9, hn = (un >> 6) & 7, rpn = un & 63, R0n = min(max(2 * rpn - 4, 0), 120);
            const int r = 2 * rp + (w >> 2), qc = 16 * (w & 3) + li; const size_t token = (size_t)b * SEQ + r * 64 + qc;
            f32x4 o[4], osum = (f32x4){0.f, 0.f, 0.f, 0.f}; float m = -1e30f;
#pragma unroll
            for (int db = 0; db < 4; ++db) o[db] = (f32x4){0.f, 0.f, 0.f, 0.f};
            int ka[2][2], va[2][4], dcs[4];
            const int cb = w & 3, kc0 = cb == 0 ? 0 : cb == 1 ? 8 : cb == 2 ? 24 : 32;
            attn_addr(kc0, li, fq, ka, va);
            const int csq = min(max(qc - 8, 0), 48); unsigned vmask = 0u;
#pragma unroll
            for (int i = 0; i < 4; ++i) { const int kc_ = kc0 + 4 * fq + i; const bool in0 = kc_ >= csq && kc_ < csq + 16; if (in0) vmask |= 1u << i; dcs[i] = min(max((in0 ? kc_ : kc_ + 16) - qc + 15, 0), 30); }
            const int rsr = min(max(r - 4, 0), 120), lr0 = rsr - R0;
            f32x4 s[8][2];
            attn_qk<true>(lds, ka, lr0 * 8192, qf, s);
            asm volatile("s_waitcnt vmcnt(0)" ::: "memory");
            AT_BAR();
            attn_stage_ctx(lds, pxa, b, h, w, lane, false);
            asm volatile("" ::: "memory");
            bf16x8_t qn[2] = {qf[0], qf[1]}; float bnv = 0.f;
            if (has_next) { const size_t tokn = (size_t)bn_ * SEQ + (2 * rpn + (w >> 2)) * 64 + 16 * (w & 3) + li;
#pragma unroll
                for (int ks = 0; ks < 2; ++ks) qn[ks] = *(const bf16x8_t*)(pxa + tokn * NPXA + OFF_QQ + hn * 64 + 32 * ks + 8 * fq);
                bnv = rb[hn * 465 + tb]; }
            asm volatile("" ::: "memory");
            attn_sm_pv<true>(lds, s, va, lr0 * 8192, biasT + (rsr - r + 7) * 31, dcs, vmask, o, osum, m);
            if (has_next) asm volatile("s_waitcnt vmcnt(3)" ::: "memory"); else asm volatile("s_waitcnt vmcnt(0)" ::: "memory");
            AT_BAR();
            attn_stage_ctx(lds, pxa, b, h, w, lane, true);
            attn_addr(0, li, fq, ka, va);
            attn_qk<false>(lds, ka, 0, qf, s);
            AT_BAR();
            if (has_next) attn_stage_win(lds, pxa, bn_, hn, R0n, w, lane, false);
            asm volatile("" ::: "memory");
            if (has_next) asm volatile("s_waitcnt vmcnt(9)" ::: "memory"); else asm volatile("s_waitcnt vmcnt(0)" ::: "memory");
            AT_BAR();
            attn_sm_pv<false>(lds, s, va, 0, (const LAS float*)nullptr, dcs, 0xfu, o, osum, m);
            asm volatile("s_waitcnt vmcnt(0)" ::: "memory");
            asm volatile("" : "+v"(qn[0]), "+v"(qn[1]), "+v"(bnv));
            if (has_next && tid < 465) biasT[tid] = bnv * 1.4426950408889634f;
            AT_BAR();
            { const float inv = __builtin_amdgcn_rcpf(osum[0]);
              bf16* op = mix + token * DM + 512 + h * 64 + 4 * fq;
#pragma unroll
              for (int db = 0; db < 4; ++db) { v2u ov; ov.x = pk2(o[db][0] * inv, o[db][1] * inv); ov.y = pk2(o[db][2] * inv, o[db][3] * inv); *(v2u*)(op + 16 * db) = ov; } }
            if (!has_next) break;
            attn_stage_win(lds, pxa, bn_, hn, R0n, w, lane, true);
            u = un; b = bn_; h = hn; rp = rpn; R0 = R0n; qf[0] = qn[0]; qf[1] = qn[1];
        }
    }
    if (l == 0 && vcu < 64) {
        const int v = vcu, b = v >> 4, h = (v >> 1) & 7, rp = v & 1;
        asm volatile("s_waitcnt vmcnt(0)" ::: "memory");
        __syncthreads();
        attn_stage_ctx(lds, pxa, b, h, w, lane, false); attn_stage_ctx(lds, pxa, b, h, w, lane, true);
        const size_t token = (size_t)ML + b * 256 + rp * 128 + 16 * w + li;
        bf16x8_t qf[2];
#pragma unroll
        for (int ks = 0; ks < 2; ++ks) qf[ks] = *(const bf16x8_t*)(pxa + token * NPXA + OFF_QQ + h * 64 + 32 * ks + 8 * fq);
        f32x4 o[4], osum = (f32x4){0.f, 0.f, 0.f, 0.f}; float m = -1e30f;
#pragma unroll
        for (int db = 0; db < 4; ++db) o[db] = (f32x4){0.f, 0.f, 0.f, 0.f};
        int ka[2][2], va[2][4], dcs[4] = {0, 0, 0, 0};
        attn_addr(0, li, fq, ka, va);
        asm volatile("s_waitcnt vmcnt(0)" ::: "memory");
        __syncthreads();
        attn_block<false>(lds, ka, va, 0, qf, (const LAS float*)nullptr, dcs, 0xfu, o, osum, m);
        const float inv = __builtin_amdgcn_rcpf(osum[0]);
        bf16* op = mix + token * DM + 512 + h * 64 + 4 * fq;
#pragma unroll
        for (int db = 0; db < 4; ++db) { v2u ov; ov.x = pk2(o[db][0] * inv, o[db][1] * inv); ov.y = pk2(o[db][2] * inv, o[db][3] * inv); *(v2u*)(op + 16 * db) = ov; }
    }
}

template <int KS>
__device__ __forceinline__ void wg_core(const bf16* A, const bf16* W, int li, int fq, f32x4 (&acc)[4][2]) {
    const bf16* ap = A + (size_t)li * DM + 8 * fq; const bf16* wp = W + (size_t)li * DM + 8 * fq;
    bf16x8_t af[4][4], wf[4][2];
#pragma unroll
    for (int s = 0; s < 3; ++s) {
#pragma unroll
        for (int m = 0; m < 4; ++m) af[s][m] = *(const bf16x8_t*)(ap + (size_t)(16 * m) * DM + 32 * s);
#pragma unroll
        for (int n = 0; n < 2; ++n) wf[s][n] = *(const bf16x8_t*)(wp + (size_t)(16 * n) * DM + 32 * s); }
#pragma unroll
    for (int s = 0; s < KS; ++s) {
        if (s + 3 < KS) {
#pragma unroll
            for (int m = 0; m < 4; ++m) af[(s + 3) & 3][m] = *(const bf16x8_t*)(ap + (size_t)(16 * m) * DM + 32 * (s + 3));
#pragma unroll
            for (int n = 0; n < 2; ++n) wf[(s + 3) & 3][n] = *(const bf16x8_t*)(wp + (size_t)(16 * n) * DM + 32 * (s + 3)); }
#pragma unroll
        for (int m = 0; m < 4; ++m)
#pragma unroll
            for (int n = 0; n < 2; ++n) acc[m][n] = __builtin_amdgcn_mfma_f32_16x16x32_bf16(wf[s & 3][n], af[s & 3][m], acc[m][n], 0, 0, 0);
    }
}
__device__ __forceinline__ void wg_merge_ctx(const Ctx& C) {
    if (C.wave >= 2) return;
    const bf16* mix = WSP(const bf16, WS_HX); const bf16* wm = WSP(const bf16, WS_WM); const bf16* pxg = WSP(const bf16, WS_PXG); bf16* mb = WSP(bf16, WS_M);
    const int lane = C.lane(), li = lane & 15, fq = lane >> 4;
    for (int it = C.wave * C.G + C.bx; it < 512; it += 2 * C.G) {
        const int r0 = ML + 64 * (it >> 5), c0 = 32 * (it & 31);
        f32x4 a0[4][2], a1[4][2], a2[4][2];
#pragma unroll
        for (int m = 0; m < 4; ++m)
#pragma unroll
            for (int n = 0; n < 2; ++n) { a0[m][n] = (f32x4){0.f, 0.f, 0.f, 0.f}; a1[m][n] = a0[m][n]; a2[m][n] = a0[m][n]; }
        const bf16* A = mix + (size_t)r0 * DM; const bf16* W = wm + (size_t)c0 * DM;
        wg_core<8>(A, W, li, fq, a0); wg_core<8>(A + 256, W + 256, li, fq, a1); wg_core<16>(A + 512, W + 512, li, fq, a2);
#pragma unroll
        for (int m = 0; m < 4; ++m)
#pragma unroll
            for (int n = 0; n < 2; ++n) { const size_t row = (size_t)(r0 + 16 * m + li); const int col = c0 + 16 * n + 4 * fq;
                const unsigned char* pq = (const unsigned char*)pxg; const unsigned g0 = *(const unsigned*)(pq + gq_elem(0, (int)row, col)), g1 = *(const unsigned*)(pq + gq_elem(1, (int)row, col)), g2 = *(const unsigned*)(pq + gq_elem(2, (int)row, col));
                constexpr float S = 1.0f / 255.0f;
                const float o0 = (a0[m][n][0] * ub0(g0) + a1[m][n][0] * ub0(g1) + a2[m][n][0] * ub0(g2)) * S, o1 = (a0[m][n][1] * ub1(g0) + a1[m][n][1] * ub1(g1) + a2[m][n][1] * ub1(g2)) * S;
                const float o2 = (a0[m][n][2] * ub2(g0) + a1[m][n][2] * ub2(g1) + a2[m][n][2] * ub2(g2)) * S, o3 = (a0[m][n][3] * ub3(g0) + a1[m][n][3] * ub3(g1) + a2[m][n][3] * ub3(g2)) * S;
                v2u w; w.x = cvt_pk_bf16(o0, o1); w.y = cvt_pk_bf16(o2, o3); *(v2u*)(mb + row * DM + col) = w; }
    }
}
__device__ __forceinline__ void wg_wo_ctx(const Ctx& C) {
    if (C.wave >= 2) return;
    const bf16* mb = WSP(const bf16, WS_M); const bf16* wo = WSP(const bf16, WS_WO); const float* base = ARGF(A_CTX); float* out = WSP(float, WS_CTXX);
    const float* gate = WSP(const float, WS_MOD) + 4 * NMOD + 2 * DM; const float* gn = WSP(const float, WS_GN) + (size_t)(1 * 5 + 4) * DM; bf16* ap = WSP(bf16, WS_HX); u64* rs = WSP(u64, WS_RS) + (size_t)1 * MT;
    const int lane = C.lane(), li = lane & 15, fq = lane >> 4;
    for (int it = C.wave * C.G + C.bx; it < 512; it += 2 * C.G) {
        const int r0 = 64 * (it >> 5), c0 = 32 * (it & 31);
        f32x4 acc[4][2];
#pragma unroll
        for (int m = 0; m < 4; ++m)
#pragma unroll
            for (int n = 0; n < 2; ++n) acc[m][n] = (f32x4){0.f, 0.f, 0.f, 0.f};
        wg_core<32>(mb + (size_t)(ML + r0) * DM, wo + (size_t)c0 * DM, li, fq, acc);
#pragma unroll
        for (int m = 0; m < 4; ++m) { const size_t rc = (size_t)(r0 + 16 * m + li); float ss = 0.f;
#pragma unroll
            for (int n = 0; n < 2; ++n) { const int col = c0 + 16 * n + 4 * fq;
                const f32x4 o = *(const f32x4*)(base + rc * DM + col) + *(const f32x4*)(gate + col) * acc[m][n];
                *(f32x4*)(out + rc * DM + col) = o;
                const f32x4 y = o * *(const f32x4*)(gn + col); v2u w; w.x = cvt_pk_bf16(y[0], y[1]); w.y = cvt_pk_bf16(y[2], y[3]); { const size_t R = ML + rc; *(v2u*)(ap + ((R >> 4) * (DM / 32) + (col >> 5)) * 512 + (R & 15) * 32 + (col & 31)) = w; }
                ss += (o[0] * o[0] + o[1] * o[1]) + (o[2] * o[2] + o[3] * o[3]); }
            ss += __shfl_xor(ss, 16); ss += __shfl_xor(ss, 32);
            if (fq == 0) __hip_atomic_fetch_add(rs + ML + rc, (u64)(ss * 16777216.0f + 0.5f), __ATOMIC_RELAXED, __HIP_MEMORY_SCOPE_AGENT); }
    }
}
__device__ __forceinline__ void ph_final(const Ctx& C) {
    float* out = (float*)(GAS float*)ldarg(C, A_OUT); const float* fg = ARGF(A_FG); const int lane = C.lane();
    for (int row = C.gw; row < ML; row += C.NGW) {
        float* xr = out + (size_t)row * DM;
        f32x4 v[4]; float s2 = 0.f;
#pragma unroll
        for (int j = 0; j < 4; ++j) { v[j] = *(const f32x4*)(xr + 4 * lane + 256 * j); s2 += (v[j].x * v[j].x + v[j].y * v[j].y) + (v[j].z * v[j].z + v[j].w * v[j].w); }
        const float rstd = 1.0f / sqrtf(wave_sum(s2) * (1.0f / DM) + EPS);
#pragma unroll
        for (int j = 0; j < 4; ++j) { const int c0 = 4 * lane + 256 * j; const f32x4 gg = *(const f32x4*)(fg + c0); *(f32x4*)(xr + c0) = v[j] * rstd * gg; }
    }
}

struct Args { const void* p[A_NARGS]; int ph_lo, ph_hi; };

__global__ void __launch_bounds__(NTHR, 2) fwd_kernel(Args args) {
    extern __shared__ __attribute__((aligned(16))) unsigned char lds_raw[];
    LAS unsigned char* const lds0 = (LAS unsigned char*)lds_raw;
    const int wave0 = __builtin_amdgcn_readfirstlane(threadIdx.x >> 6);
    { const int t0 = threadIdx.x;
      for (int u = t0; u < (LDS_BYTES - LDSCTL_OFF) / 4; u += NTHR) ((LAS unsigned*)(lds0 + LDSCTL_OFF))[u] = 0u;
      __syncthreads();
      if (t0 < A_NARGS) ((LAS unsigned long long*)(lds0 + LARGS_OFF))[t0] = (unsigned long long)args.p[t0];
      __syncthreads(); }
    const int lo = args.ph_lo, hi = args.ph_hi;
    const unsigned xcc = xb_xcc_id();
    int vbx = blockIdx.x;
    if (!MK_MULTI) { Ctx C; C.lds = lds0; C.wave = wave0; gu32* ctl0 = (gu32*)WSP(unsigned, WS_CTL); (void)xcd_barrier_post((unsigned*)(ctl0 + CW_BAR), (volatile LAS unsigned*)(lds0 + MISC_OFF) + 8, C.tid() == 0); }
    for (int step = lo; step < hi; ++step) {
        const int ls = step - 2, l = ls >= NS ? 1 : 0, k = (step < 2) ? -1 - step : ls - l * NS;
        const int nrep = (PROBE_K != -99 && k == PROBE_K) ? PROBE_N : 1;
        for (int rep = 0; rep < nrep; ++rep) {
        Ctx C;
        C.lds = lds0; C.wave = wave0; C.G = gridDim.x; C.bx = vbx;
        asm volatile("" : "+s"(C.wave), "+s"(C.bx), "+s"(C.G));
        C.gw = C.bx * NWAVES + C.wave; C.NGW = C.G * NWAVES; C.NGT = C.G * NTHR;
        gu32* ctl = (gu32*)WSP(unsigned, WS_CTL);
        if (k == -1) { ph_mod_partial(C); __syncthreads(); ph_weights(C, 0); }
        else if (k == -2) ph_mod_reduce(C);
        else if (k == 0) {
            if (l == 1) ph_weights(C, l);
            ph_ctab(C, l);
            u64* rsb = WSP(u64, WS_RS) + (size_t)(l == 0 ? 0 : 2) * MT;
            if (l == 0) ph_prenorm(C, ARGF(A_X), ARGF(A_CTX), WSP(const float, WS_GN), WSP(bf16, WS_HX), rsb, 0, MT, (const float*)nullptr, (const float*)nullptr, false);
            else ph_prenorm(C, ARGF(A_OUT), WSP(const float, WS_CTXX), WSP(const float, WS_GN) + 2 * 5 * DM, WSP(bf16, WS_HX), rsb, ML, MT, WSP(const float, WS_PART), WSP(const float, WS_MOD) + 4 * NMOD + 5 * DM, true);
        } else if (k == 1) {
            pg8::StaticOrder<NIN / 256> S; S.init(MT, NIN, C.G, C.bx);
            EpiIn E{WSP(bf16, WS_PXA), WSP(bf16, WS_PXG), WSP(const u64, WS_RS) + (size_t)(l == 0 ? 0 : 2) * MT, WSP(const float, WS_CIN) + (size_t)l * 5 * NIN};
            if (l == 0) { pg8::Prob<false> P{WSP(const bf16, WS_HX), WSP(const bf16, WS_WIN), DM, DM, DM}; pg8::gemm_phase(C.lds, P, S, E, C.tid()); }
            else { pg8::ProbMT P{WSP(const bf16, WS_HX), WSP(const bf16, WS_WIN), DM, DM, DM}; pg8::gemm_phase(C.lds, P, S, E, C.tid()); }
        } else if (k == 2) {
            const int sub = rep == 0 ? 7 : PROBE_SUB;
            if (sub & 1) ph_t1(C);
            if (sub & 2) { if (l == 0) ph_ctx_dft(C); ph_mixers(C, l); }
            if (sub & 4) ph_attn(C, l);
        } else if (k == 3) {
            ph_fft(C);
        } else if (k == 4) {
            pg8::Prob<false> P{WSP(const bf16, WS_HX), WSP(const bf16, WS_WM), DM, DM, DM}; pg8::StaticOrder<DM / 256> S; S.init(ML, DM, C.G, C.bx);
            EpiMerge E{WSP(bf16, WS_M), WSP(const bf16, WS_PXG)};
            pg8::gemm_phase(C.lds, P, S, E, C.tid());
            if (l == 0) wg_merge_ctx(C);
        } else if (k == 5) {
            pg8::ProbMT P{WSP(const bf16, WS_M), WSP(const bf16, WS_WO), DM, DM, DM}; pg8::StaticOrder<DM / 256> S; S.init(ML, DM, C.G, C.bx);
            const float* gatev = rep > 0 ? WSP(const float, WS_ZERO) : WSP(const float, WS_MOD) + (size_t)l * 5 * NMOD + 2 * DM;
            const float* gnp = WSP(const float, WS_GN) + (size_t)(l * 2 + 1) * 5 * DM; u64* rsp = WSP(u64, WS_RS) + (size_t)(l == 0 ? 1 : 3) * MT;
            if (l == 0) { EpiRes<false> E{(const void*)ARGF(A_X), (bf16*)(GAS bf16*)ldarg(C, A_OUT), gatev, nullptr, gnp, WSP(bf16, WS_HX), rsp}; pg8::gemm_phase(C.lds, P, S, E, C.tid()); }
            else { EpiRes<true> E{(const void*)(const bf16*)(GAS bf16*)ldarg(C, A_OUT), WSP(bf16, WS_STREAM1), gatev, nullptr, gnp, WSP(bf16, WS_HX), rsp}; pg8::gemm_phase(C.lds, P, S, E, C.tid()); }
            if (l == 0 && rep == 0) wg_wo_ctx(C);
        } else if (k == 6) {
            pg8::ProbMT P{WSP(const bf16, WS_HX), WSP(const bf16, WS_W1), DM, DM, DM}; pg8::StaticOrder<FF / 256> S; S.init(l == 0 ? MT : ML, FF, C.G, C.bx);
            EpiAct E{WSP(bf16, WS_ACT), WSP(const u64, WS_RS) + (size_t)(l == 0 ? 1 : 3) * MT, WSP(const float, WS_CUP) + (size_t)l * 5 * FF};
            pg8::gemm_phase(C.lds, P, S, E, C.tid());
        } else if (k == 7) {
            if (l == 0) {
                pg8::ProbDown P{WSP(const bf16, WS_ACT), WSP(const bf16, WS_W2), FF, FF, FF}; pg8::DownOrder S; S.init(C.G, C.bx);
                EpiRes<true> E{(const void*)(const bf16*)(GAS bf16*)ldarg(C, A_OUT), (bf16*)(GAS bf16*)ldarg(C, A_OUT), WSP(const float, WS_MOD) + (size_t)l * 5 * NMOD + 5 * DM, WSP(float, WS_PART),
                         WSP(const float, WS_GN) + (size_t)2 * 5 * DM, WSP(bf16, WS_HX), WSP(u64, WS_RS) + (size_t)2 * MT};
                pg8::gemm_phase(C.lds, P, S, E, C.tid());
            } else {
                pg8::ProbMT P{WSP(const bf16, WS_ACT), WSP(const bf16, WS_W2), FF, FF, FF}; pg8::StaticOrder<DM / 256> S; S.init(ML, DM, C.G, C.bx);
                EpiResFinal E{WSP(const bf16, WS_STREAM1), (float*)(GAS float*)ldarg(C, A_OUT), WSP(const float, WS_MOD) + (size_t)l * 5 * NMOD + 5 * DM, ARGF(A_FG), WSP(u64, WS_RS5), WSP(unsigned, WS_FCNT), (unsigned*)WSP(unsigned, WS_CTL) + CW_TMO};
                pg8::gemm_phase(C.lds, P, S, E, C.tid());
            }
        } else ph_final(C);
        if (step + 1 < hi || rep + 1 < nrep) { if (MK_MULTI) { if (C.tid() == 0) __hip_atomic_store(ctl + CW_TMO, 0xBADu, RLX_AGENT); } else { XcdBarrier bar; bar.bar = (unsigned*)(ctl + CW_BAR); bar.x = xcc; bar.st = (volatile LAS unsigned*)(lds0 + MISC_OFF) + 8; xcd_barrier(bar, C.tid() == 0);
                if (step == lo && rep == 0) {
                    volatile LAS unsigned* misc = (volatile LAS unsigned*)(lds0 + MISC_OFF);
                    if (C.tid() == 0) { bool ok = gridDim.x == 256;
                        for (unsigned j = 0; j < 16; ++j) { const unsigned cnt = xb_ld(bar.bar + XB_XCNT(j)); ok = ok && (cnt == (j < 8 ? 32u : 0u)); }
                        misc[11] = ok ? 1u : 0u; }
                    __syncthreads();
                    const unsigned okf = __builtin_amdgcn_readfirstlane(misc[11]), rk = __builtin_amdgcn_readfirstlane(misc[10]);
                    if (okf != 0u && rk < 32u && xcc < 8u) vbx = (int)(rk * 8u + xcc); } } }
        }
    }
}

extern "C" void kernel_launch(void* const* d_in, const int* in_sizes, int n_in, void* d_out, int out_size, void* d_ws, size_t ws_size, hipStream_t stream) {
    static int grid = 0;
    if (grid == 0) {
        if (n_in != 18 || out_size != ML * DM || ws_size < WS_END) { fprintf(stderr, "kernel_launch: unexpected shapes (n_in %d out %d ws %zu)\n", n_in, out_size, ws_size); grid = -1; return; }
        int dev = 0, cus = 0;
        if (hipGetDevice(&dev) != hipSuccess || hipDeviceGetAttribute(&cus, hipDeviceAttributeMultiprocessorCount, dev) != hipSuccess) { grid = -1; return; }
        if (hipFuncSetAttribute((const void*)fwd_kernel, hipFuncAttributeMaxDynamicSharedMemorySize, LDS_BYTES) != hipSuccess) { fprintf(stderr, "kernel_launch: hipFuncSetAttribute failed\n"); grid = -1; return; }
        int per_cu = 0;
        if (hipOccupancyMaxActiveBlocksPerMultiprocessor(&per_cu, (const void*)fwd_kernel, NTHR, LDS_BYTES) != hipSuccess || per_cu < 1) fprintf(stderr, "kernel_launch: occupancy query reports %d\n", per_cu);
        (void)hipGetLastError();
        grid = cus;
    }
    if (grid < 0) return;
    (void)hipMemsetAsync((char*)d_ws + WS_CTL, 0, CTL_ZERO_BYTES, stream);
    Args a{};
    for (int i = 0; i < 18; ++i) a.p[i] = d_in[i];
    a.p[A_OUT] = d_out; a.p[A_WS] = d_ws;
#if MK_MULTI
    for (int s = 0; s < NSTEPS; ++s) { a.ph_lo = s; a.ph_hi = s + 1; hipLaunchKernelGGL(fwd_kernel, dim3(grid), dim3(NTHR), LDS_BYTES, stream, a); }
#else
    a.ph_lo = 0; a.ph_hi = NSTEPS; hipLaunchKernelGGL(fwd_kernel, dim3(grid), dim3(NTHR), LDS_BYTES, stream, a);
#endif
}
```

```cpp
#include <hip/hip_runtime.h>
#include <cstdio>
#include <cstdint>

#ifndef PROBE_K
#define PROBE_K -99
#define PROBE_N 1
#define PROBE_SUB 7
#endif
#ifndef MK_MULTI
#define MK_MULTI 0
#endif

namespace pg8 {
#define PG8_LAS __attribute__((address_space(3)))
typedef unsigned short bf16_t;
typedef short bf16x8 __attribute__((ext_vector_type(8)));
typedef float f32x4 __attribute__((ext_vector_type(4)));
typedef unsigned u32x4 __attribute__((ext_vector_type(4)));
constexpr int BM = 256, BK = 64, HALF = 128, HTB = HALF * BK * 2, STAGE_BYTES = 8 * HTB, NXCD = 8, WGM = 8;

__host__ __device__ __forceinline__ int lds_byte(int r, int c) { const int st = (r >> 4) * 2 + (c >> 5), rr = r & 15, cc = c & 31, ob = rr * 64 + cc * 2; return st * 1024 + (ob ^ (((ob >> 9) & 1) << 5)); }
__host__ __device__ __forceinline__ void stage_rc(int b, int& R, int& C) { const int st = b / 1024, sb = b % 1024, swz = sb ^ (((sb >> 9) & 1) << 5); R = (st >> 1) * 16 + swz / 64; C = (st & 1) * 32 + (swz % 64) / 2; }
__host__ __device__ __forceinline__ int perm32(int rho) { const int n = rho >> 4, i = rho & 15; return 8 * (i >> 2) + 4 * n + (i & 3); }

struct Unit { int pm, pn, br; };

template <int NN  > struct StaticOrder {
    int nM, nwg, G, c;
    __device__ void init(int M, int  , int G_, int c_) { nM = M / BM; nwg = nM * NN; G = G_; c = c_; }
    __device__ __forceinline__ bool next(int i, Unit& u) const {
        u.br = 0;
        const long L = (long)i * G + c; if (L >= nwg) return false;
        int wgid = (int)L; { const int q = nwg >> 3, r = nwg & 7, xcd = wgid & 7, off = wgid >> 3; wgid = (xcd < r ? xcd * (q + 1) : r * (q + 1) + (xcd - r) * q) + off; }
        constexpr int nig = WGM * NN; const int gid = wgid / nig, rem = wgid - gid * nig, fm = gid * WGM, gsz = (nM - fm) < WGM ? (nM - fm) : WGM;
        if (gsz == WGM) { u.pm = fm + (rem & (WGM - 1)); u.pn = rem >> 3; } else { u.pm = fm + (rem % gsz); u.pn = rem / gsz; }
        return true;
    }
};

struct DownOrder {
    StaticOrder<4> lat; int G, c;
    __device__ void init(int G_, int c_) { lat.init(32768, 1024, G_, c_); G = G_; c = c_; }
    __device__ __forceinline__ bool next(int i, Unit& u) const {
        const long L = (long)i * G + c;
        if (L < 512) return lat.next(i, u);
        const int j = (int)L - 512; if (j >= 64) return false;
        const int ct = j >> 2; u.pm = 128 + (ct >> 2); u.pn = ct & 3; u.br = j & 3; return true;
    }
};
struct ProbDown {
    static constexpr bool MT16 = true;
    const bf16_t* A; const bf16_t* Bt; int lda, ldb, K;
    __device__ __forceinline__ int nt(const Unit& u) const { return u.pm >= 128 ? 16 : 64; }
    __device__ __forceinline__ int koff(const Unit& u) const { return u.pm >= 128 ? u.br * 1024 : 0; }
    __device__ __forceinline__ const char* a(const Unit& u) const { return (const char*)(A + (size_t)u.pm * BM * lda + (size_t)koff(u) * 16); }
    __device__ __forceinline__ const char* b(const Unit& u) const { return (const char*)(Bt + (size_t)u.pn * BM * ldb + koff(u)); }
};
template <bool MERGE> struct Prob {
    static constexpr bool MT16 = false;
    const bf16_t* A; const bf16_t* Bt; int lda, ldb, K;
    __device__ __forceinline__ int nt(const Unit& u) const { if (MERGE) return u.br == 2 ? 8 : 4; return K / BK; }
    __device__ __forceinline__ int koff(const Unit& u) const { if (MERGE) return u.br * 256; return 0; }
    __device__ __forceinline__ const char* a(const Unit& u) const { return (const char*)(A + (size_t)u.pm * BM * lda + koff(u)); }
    __device__ __forceinline__ const char* b(const Unit& u) const { return (const char*)(Bt + (size_t)u.pn * BM * ldb + koff(u)); }
};

struct ProbMT {
    static constexpr bool MT16 = true;
    const bf16_t* A; const bf16_t* Bt; int lda, ldb, K;
    __device__ __forceinline__ int nt(const Unit&) const { return K / BK; }
    __device__ __forceinline__ const char* a(const Unit& u) const { return (const char*)(A + (size_t)u.pm * BM * lda); }
    __device__ __forceinline__ const char* b(const Unit& u) const { return (const char*)(Bt + (size_t)u.pn * BM * ldb); }
};
struct ProbMTSplit {
    static constexpr bool MT16 = true;
    const bf16_t* A; const bf16_t* Bt; const bf16_t* Bt2; int lda, ldb, K;
    __device__ __forceinline__ int nt(const Unit&) const { return K / BK; }
    __device__ __forceinline__ const char* a(const Unit& u) const { return (const char*)(A + (size_t)u.pm * BM * lda); }
    __device__ __forceinline__ const char* b(const Unit& u) const { return (const char*)((u.pn < 3 ? Bt : Bt2) + (size_t)u.pn * BM * ldb); }
};
typedef __bf16 bf16x2_cv __attribute__((ext_vector_type(2)));
typedef float f32x2_cv __attribute__((ext_vector_type(2)));
__device__ __forceinline__ unsigned cvt_pk_bf16(float lo, float hi) { const f32x2_cv v = {lo, hi}; const bf16x2_cv r = __builtin_convertvector(v, bf16x2_cv); return __builtin_bit_cast(unsigned, r); }

template <class Epi, class Sched, class PROB>
__device__ __forceinline__ void gemm_phase(PG8_LAS unsigned char* lds, const PROB P, const Sched& S, const Epi& E, const int tid) {
    const int wid = __builtin_amdgcn_readfirstlane(tid >> 6), lane = tid & 63, wr = wid >> 2, wc = wid & 3, fr = lane & 15, fq = lane >> 4;
    unsigned voffA[2], voffB[2];
#pragma unroll
    for (int i = 0; i < 2; ++i) { int R, C; stage_rc(tid * 16 + i * 8192, R, C); const int Rb = Epi::PERM ? ((R & ~31) + perm32(R & 31)) : R;
        voffA[i] = PROB::MT16 ? (unsigned)((((R >> 4) * (P.lda >> 5) + (C >> 5)) * 512 + (R & 15) * 32 + (C & 31)) * 2) : (unsigned)(R * P.lda + C) * 2u; voffB[i] = (unsigned)(Rb * P.ldb + C) * 2u; }
    const size_t kstep = (size_t)(BK * 2), kstepA = PROB::MT16 ? (size_t)2048 : kstep;
    const size_t hstepA = (size_t)HALF * P.lda * 2, hstepB = (size_t)HALF * P.ldb * 2;
    const unsigned ldsw = (unsigned)wid * 1024u;
    const int aoff = lds_byte(wr * 64 + fr, fq * 8), boff = lds_byte(wc * 32 + fr, fq * 8);
#define PG8_SA(b, h) (((b) * 2 + (h)) * HTB)
#define PG8_SB(b, h) ((4 + (b) * 2 + (h)) * HTB)
#define PG8_STAGE(bufoff, gbase, voff) do { _Pragma("unroll") for (int _i = 0; _i < 2; ++_i) \
        __builtin_amdgcn_global_load_lds((const unsigned*)((const char*)(gbase) + (voff)[_i]), (PG8_LAS unsigned*)(lds + (bufoff) + ldsw + _i * 8192), 16, 0, 0); } while (0)
#define PG8_LDA(dst, b, h) do { _Pragma("unroll") for (int m = 0; m < 4; ++m) _Pragma("unroll") for (int k = 0; k < 2; ++k) dst[m][k] = *(const PG8_LAS bf16x8*)(lds + PG8_SA(b, h) + aoff + m * 2048 + k * 1024); } while (0)
#define PG8_LDB(dst, b, h) do { _Pragma("unroll") for (int n = 0; n < 2; ++n) _Pragma("unroll") for (int k = 0; k < 2; ++k) dst[n][k] = *(const PG8_LAS bf16x8*)(lds + PG8_SB(b, h) + boff + n * 2048 + k * 1024); } while (0)
#define PG8_MMA(ai, bj, At, Bt) do { __builtin_amdgcn_s_setprio(1); _Pragma("unroll") for (int m = 0; m < 4; ++m) _Pragma("unroll") for (int n = 0; n < 2; ++n) _Pragma("unroll") for (int k = 0; k < 2; ++k) \
        acc[ai][bj][m][n] = __builtin_amdgcn_mfma_f32_16x16x32_bf16(Bt[n][k], At[m][k], acc[ai][bj][m][n], 0, 0, 0); __builtin_amdgcn_s_setprio(0); } while (0)
#define PG8_WAIT_V(n) asm volatile("s_waitcnt vmcnt(" #n ")" ::: "memory")
#define PG8_WAIT_L(n) asm volatile("s_waitcnt lgkmcnt(" #n ")" ::: "memory")
#define PG8_BAR __builtin_amdgcn_s_barrier()
#define PG8_WAIT_SEL1(N, H) asm volatile("s_waitcnt vmcnt(" #N ")\n\tv_cmp_eq_u32_e32 vcc, 1, %0\n\ts_cbranch_vccnz .Lpg8w%=\n\ts_waitcnt vmcnt(" #H ")\n\tv_cmp_eq_u32_e32 vcc, 2, %0\n\ts_cbranch_vccnz .Lpg8w%=\n\ts_waitcnt vmcnt(8)\n.Lpg8w%=:" :: "v"(fst) : "memory", "vcc")
#define PG8_WAIT_SEL(NF16, NH16, NF32) do { if (Epi::NST == 16) PG8_WAIT_SEL1(NF16, NH16); else PG8_WAIT_SEL1(NF32, NF32); } while (0)
#define PG8_SCHED __builtin_amdgcn_sched_barrier(0)
    Unit cur, nxt; int ui = 0, pcls = 1;
    if (!S.next(0, cur)) return;
    f32x4 acc[2][2][4][2];
#pragma unroll
    for (int a = 0; a < 2; ++a)
#pragma unroll
        for (int b = 0; b < 2; ++b)
#pragma unroll
            for (int m = 0; m < 4; ++m)
#pragma unroll
                for (int n = 0; n < 2; ++n) acc[a][b][m][n] = (f32x4){0.f, 0.f, 0.f, 0.f};
    bf16x8 At[4][2], B0[2][2], B1[2][2];
    const char* cA = P.a(cur); const char* cB = P.b(cur);
    PG8_STAGE(PG8_SB(0, 0), cB, voffB); PG8_STAGE(PG8_SB(0, 1), cB + hstepB, voffB); PG8_STAGE(PG8_SA(0, 0), cA, voffA); PG8_STAGE(PG8_SA(0, 1), cA + hstepA, voffA);
    if (wr == 1) PG8_BAR;
    PG8_WAIT_V(2); PG8_BAR;
    PG8_STAGE(PG8_SB(1, 0), cB + kstep, voffB); PG8_STAGE(PG8_SA(1, 0), cA + kstepA, voffA); PG8_STAGE(PG8_SB(1, 1), cB + hstepB + kstep, voffB);
    PG8_WAIT_V(6); PG8_BAR;
    for (;;) {
        const bool has_next = S.next(ui + 1, nxt);
        const char* nA = has_next ? P.a(nxt) : cA; const char* nB = has_next ? P.b(nxt) : cB;
        const int nt = P.nt(cur);
        for (int t = 0; t < nt; t += 2) {
            const bool last = (t == nt - 2); const int fst = (t == 0 && ui > 0) ? pcls : 0;
            if constexpr (Epi::HOOKS) { if (t == 4 || t == 8) E.hook(acc, cur, t, wr, wc, fr, fq); }
            const char* a1 = cA + (size_t)(t + 1) * kstepA;
            const char* a2 = last ? nA : cA + (size_t)(t + 2) * kstepA; const char* b2 = last ? nB : cB + (size_t)(t + 2) * kstep;
            const char* a3 = a2 + kstepA; const char* b3 = b2 + kstep;
            PG8_LDB(B0, 0, 0); PG8_LDB(B1, 0, 1); PG8_SCHED; PG8_LDA(At, 0, 0); PG8_STAGE(PG8_SA(1, 1), a1 + hstepA, voffA);
            PG8_WAIT_SEL(18, 10, 34); PG8_WAIT_L(0); PG8_BAR; PG8_MMA(0, 0, At, B0); PG8_MMA(0, 1, At, B1); PG8_BAR; PG8_SCHED;
            PG8_LDA(At, 0, 1); PG8_STAGE(PG8_SB(0, 0), b2, voffB); PG8_STAGE(PG8_SB(0, 1), b2 + hstepB, voffB); PG8_STAGE(PG8_SA(0, 0), a2, voffA);
            PG8_WAIT_SEL(24, 16, 40); PG8_WAIT_L(0); PG8_BAR; PG8_MMA(1, 0, At, B0); PG8_MMA(1, 1, At, B1); PG8_BAR; PG8_SCHED;
            PG8_LDB(B0, 1, 0); PG8_LDB(B1, 1, 1); PG8_SCHED; PG8_LDA(At, 1, 0); PG8_STAGE(PG8_SA(0, 1), a2 + hstepA, voffA);
            PG8_WAIT_SEL(26, 18, 42); PG8_WAIT_L(0); PG8_BAR; PG8_MMA(0, 0, At, B0); PG8_MMA(0, 1, At, B1); PG8_BAR; PG8_SCHED;
            PG8_LDA(At, 1, 1); PG8_STAGE(PG8_SB(1, 0), b3, voffB); PG8_STAGE(PG8_SB(1, 1), b3 + hstepB, voffB); PG8_STAGE(PG8_SA(1, 0), a3, voffA);
            PG8_WAIT_V(8); PG8_WAIT_L(0); PG8_BAR; PG8_MMA(1, 0, At, B0); PG8_MMA(1, 1, At, B1); PG8_BAR; PG8_SCHED;
        }
        if (wr == 0) PG8_BAR;
        E(acc, cur, wr, wc, fr, fq); pcls = E.cls(cur);
        if (!has_next) break;
#pragma unroll
        for (int a = 0; a < 2; ++a)
#pragma unroll
            for (int b = 0; b < 2; ++b)
#pragma unroll
                for (int m = 0; m < 4; ++m)
#pragma unroll
                    for (int n = 0; n < 2; ++n) acc[a][b][m][n] = (f32x4){0.f, 0.f, 0.f, 0.f};
        cur = nxt; cA = nA; cB = nB; ++ui;
        if (wr == 1) PG8_BAR;
    }
    PG8_WAIT_V(0);
    PG8_BAR;
#undef PG8_SA
#undef PG8_SB
#undef PG8_STAGE
#undef PG8_LDA
#undef PG8_LDB
#undef PG8_MMA
#undef PG8_WAIT_V
#undef PG8_WAIT_L
#undef PG8_BAR
#undef PG8_WAIT_SEL
#undef PG8_WAIT_SEL1
#undef PG8_SCHED
}
}

constexpr int NWAVES = 8, NTHR = 512;
constexpr int DM = 1024, NB = 4, SEQ = 8192, ML = NB * SEQ, CTXL = 256, MC = NB * CTXL, MT = ML + MC;
constexpr int NIN_ORIG = 5632, NPXA = 2816, NPXG = 3072, NIN = NPXA + NPXG;
constexpr int OFF_P = 0, OFF_Q = 256, OFF_CU = 512, OFF_CB = 768, OFF_CC = 1024, OFF_QQ = 1280, OFF_K = 1792, OFF_V = 2304;
constexpr int FF = 4096, NMOD = 6 * DM, NGRP = 5;
constexpr float EPS = 1e-6f;

constexpr size_t MiB = 1u << 20;
constexpr size_t WS_CTL = 0, CTL_ZERO_BYTES = 2 * MiB;
constexpr size_t WS_RS = 262144;
constexpr size_t WS_FCNT = 1441792;
constexpr size_t WS_ZERO = 1572864;
constexpr size_t WS_RS5 = 1703936;
constexpr size_t WS_TW = 2 * MiB;
constexpr size_t WS_MOD = 2 * MiB + 65536;
constexpr size_t WS_GN = 2 * MiB + 524288;
constexpr size_t WS_CIN = 2 * MiB + 786432;
constexpr size_t WS_CUP = 3 * MiB;
constexpr size_t WS_MODP = 510 * MiB;
constexpr size_t WS_CTXX = 4 * MiB;
constexpr size_t WS_WIN = 8 * MiB, WS_WM = 20 * MiB, WS_WO = 22 * MiB, WS_W1 = 24 * MiB, WS_W2 = 32 * MiB;
constexpr size_t WS_HX = 40 * MiB;
constexpr size_t WS_PXA = 106 * MiB;
constexpr size_t WS_PXG = 288 * MiB;
constexpr size_t WS_TB = 486 * MiB;
constexpr size_t WS_M = WS_PXA;
constexpr size_t WS_ACT = WS_PXA;
constexpr size_t WS_PART = 456 * MiB;
constexpr size_t WS_STREAM1 = 416 * MiB;
constexpr size_t WS_RGN = 2 * MiB + 524288 + 131072;
constexpr size_t WS_MIX1 = 387 * MiB;
static_assert(WS_PXG + (size_t)3 * MT * 1024 <= WS_MIX1 && WS_MIX1 + (size_t)MT * DM * 2 <= WS_PART && WS_PART + (size_t)4 * 1024 * 1024 * 4 <= WS_TB, "operand / partial-sum regions");
constexpr size_t WS_W1B = 472 * MiB;
static_assert(WS_PART + (size_t)16 * MiB <= WS_W1B && WS_W1B + (size_t)8 * MiB <= WS_TB, "layer-1 MLP-up weight copy");
constexpr size_t WS_W2B_LO = 480 * MiB, WS_W2B_HI = 504 * MiB;
static_assert(WS_W1B + (size_t)8 * MiB == WS_W2B_LO && WS_W2B_LO + (size_t)768 * 4096 * 2 <= WS_TB && WS_W2B_HI + (size_t)768 * 4096 * 2 == WS_MODP && WS_MODP + (size_t)2 * MiB <= 512 * MiB, "layer-1 mlp_w2 copy");
constexpr size_t WS_END = 512 * MiB;
static_assert(WS_PXA + (size_t)MT * NPXA * 2 <= WS_PXG && WS_PXG + (size_t)MT * NPXG * 2 <= WS_TB && WS_ACT + (size_t)MT * FF * 2 <= WS_TB && WS_HX + (size_t)MT * DM * 2 <= WS_PXA, "ws map");
constexpr int CW_TMO = 0, CW_BAR = 4096, CW_WQ = 32768;

constexpr int RING_BYTES = 131072, LDSCTL_OFF = 155648, MISC_OFF = LDSCTL_OFF + 320, LDS_BYTES = 163840;

#define GAS __attribute__((address_space(1)))
#define LAS __attribute__((address_space(3)))
typedef unsigned short bf16;
typedef unsigned v4u __attribute__((ext_vector_type(4)));
typedef unsigned v2u __attribute__((ext_vector_type(2)));
typedef float f32x4 __attribute__((ext_vector_type(4)));
typedef GAS unsigned gu32;
#define RLX_AGENT __ATOMIC_RELAXED, __HIP_MEMORY_SCOPE_AGENT
#define LDS_WAIT() asm volatile("s_waitcnt lgkmcnt(0)" ::: "memory")
__device__ __forceinline__ unsigned pk2(float lo, float hi) { return pg8::cvt_pk_bf16(lo, hi); }
__device__ __forceinline__ unsigned f2bf(float f) { return pg8::cvt_pk_bf16(f, 0.0f) & 0xffffu; }
__device__ __forceinline__ float bf2f(unsigned h) { return __uint_as_float(h << 16); }
__device__ __forceinline__ float bflo(unsigned w) { return __uint_as_float(w << 16); }
__device__ __forceinline__ float bfhi(unsigned w) { return __uint_as_float(w & 0xffff0000u); }

#define XB_TMO      128
#define XB_XCNT(j)  (256  + 64 * (j))
#define XB_XSUB(j)  (1280 + 64 * (j))
#define XB_XGEN(j)  (2304 + 64 * (j))
#define XB_TOP      3328
#define XB_TOPGEN   3392
#define XCD_BAR_WORDS 3456
#define XB_SPIN_CAP (1u << 22)
__device__ __forceinline__ unsigned xb_ld(unsigned* p)              { return __hip_atomic_load(p, __ATOMIC_RELAXED, __HIP_MEMORY_SCOPE_AGENT); }
__device__ __forceinline__ unsigned xb_add(unsigned* p, unsigned v) { return __hip_atomic_fetch_add(p, v, __ATOMIC_RELAXED, __HIP_MEMORY_SCOPE_AGENT); }
__device__ __forceinline__ unsigned xb_xcc_id() { return (unsigned)__builtin_amdgcn_s_getreg((3 << 11) | 20) & 0xFu; }
#define XB_SPIN(cond, bar) do { unsigned _sp = 0; while (cond) { __builtin_amdgcn_s_sleep(1); \
    if ((++_sp & 255u) == 0u) { if (xb_ld(&(bar)[XB_TMO])) break; if (_sp > XB_SPIN_CAP) { atomicAdd(&(bar)[XB_TMO], 1u); break; } } } } while (0)
struct XcdBarrier { unsigned* bar; unsigned x; volatile LAS unsigned* st; };
__device__ __forceinline__ XcdBarrier xcd_barrier_post(unsigned* bar, volatile LAS unsigned* st, bool leader) {
    XcdBarrier b; b.bar = bar; b.x = xb_xcc_id(); b.st = st;
    if (leader) { const unsigned rank = xb_add(&bar[XB_XCNT(b.x)], 1u); st[2] = rank; }
    return b;
}
__device__ __forceinline__ void xcd_barrier_complete(unsigned* bar, unsigned x, unsigned& nloc, unsigned& nx) {
    const unsigned G = gridDim.x * gridDim.y * gridDim.z;
    unsigned sum, cnt, mine, sp = 0u;
    for (;;) {
        sum = 0u; cnt = 0u; mine = 0u;
#pragma unroll
        for (unsigned j = 0; j < 16; ++j) { const unsigned c = xb_ld(&bar[XB_XCNT(j)]); sum += c; cnt += (c > 0u) ? 1u : 0u; mine = (j == x) ? c : mine; }
        if (sum == G) break;
        __builtin_amdgcn_s_sleep(1);
        if ((++sp & 255u) == 0u) { if (xb_ld(&bar[XB_TMO])) break; if (sp > XB_SPIN_CAP) { atomicAdd(&bar[XB_TMO], 1u); break; } }
    }
    nloc = mine > 0u ? mine : 1u; nx = cnt > 0u ? cnt : 1u;
}
__device__ __forceinline__ void xcd_barrier(const XcdBarrier& b, bool leader) {
    asm volatile("s_waitcnt vmcnt(0)" ::: "memory");
    __syncthreads();
    if (leader) {
        unsigned* bar = b.bar;
        __builtin_amdgcn_s_waitcnt(0);
        unsigned nloc = b.st[0], nx = b.st[1];
        if (nloc == 0u) { xcd_barrier_complete(bar, b.x, nloc, nx); b.st[0] = nloc; b.st[1] = nx; }
        const unsigned old = xb_add(&bar[XB_XSUB(b.x)], 1u);
        const unsigned gen = old / nloc;
        if (old + 1u == (gen + 1u) * nloc) {
            __builtin_amdgcn_fence(__ATOMIC_RELEASE, "agent");
            asm volatile("s_waitcnt vmcnt(0)" ::: "memory");
            const unsigned og = xb_add(&bar[XB_TOP], 1u);
            const unsigned tg = og / nx;
            if (og + 1u == (tg + 1u) * nx) xb_add(&bar[XB_TOPGEN], 1u);
            else XB_SPIN(xb_ld(&bar[XB_TOPGEN]) == tg, bar);
            __builtin_amdgcn_fence(__ATOMIC_ACQUIRE, "agent");
            xb_add(&bar[XB_XGEN(b.x)], 1u);
            asm volatile("s_waitcnt vmcnt(0)" ::: "memory");
        } else {
            XB_SPIN(xb_ld(&bar[XB_XGEN(b.x)]) == gen, bar);
            __builtin_amdgcn_fence(__ATOMIC_ACQUIRE, "agent");
            asm volatile("s_waitcnt vmcnt(0)" ::: "memory");
        }
    }
    __syncthreads();
}

__device__ __forceinline__ float wave_sum(float v) {
#pragma unroll
    for (int o = 1; o < 64; o <<= 1) v += __shfl_xor(v, o);
    return v;
}
__device__ __forceinline__ float wave_max(float v) {
#pragma unroll
    for (int o = 1; o < 64; o <<= 1) v = fmaxf(v, __shfl_xor(v, o));
    return v;
}

__device__ __forceinline__ void transpose_item(const float* W, int ldw, int ncols, bf16* WT, int ldwt, int row_off, int k_off, LAS float* scr, int item, int lane) {
    const int nblk = ncols / 32, kb = item / nblk, nb = item % nblk, k0 = 64 * kb, n0 = 32 * nb;
#pragma unroll 8
    for (int i = 0; i < 32; ++i) { const int kk = 2 * i + (lane >> 5); scr[kk * 33 + (lane & 31)] = W[(size_t)(k0 + kk) * ldw + n0 + (lane & 31)]; }
    LDS_WAIT(); asm volatile("" ::: "memory");
    const int c = lane & 7;
#pragma unroll
    for (int j = 0; j < 4; ++j) { const int n = (lane >> 3) + 8 * j; const LAS float* s = scr + (8 * c) * 33 + n;
        v4u o; o.x = pk2(s[0 * 33], s[1 * 33]); o.y = pk2(s[2 * 33], s[3 * 33]); o.z = pk2(s[4 * 33], s[5 * 33]); o.w = pk2(s[6 * 33], s[7 * 33]);
        __builtin_nontemporal_store(o, (v4u*)(WT + (size_t)(row_off + n0 + n) * ldwt + k_off + k0 + 8 * c)); }
    LDS_WAIT(); asm volatile("" ::: "memory");
}

using pg8::Unit; using pg8::cvt_pk_bf16;
typedef unsigned long long u64;
constexpr int NTM = MT / 256;
__device__ __forceinline__ size_t gate_tile(int g, int pm, int pn) { return (size_t)((g * NTM + pm) * 4 + pn) * 65536; }
__device__ __forceinline__ int gate_piece(int ai, int m, int bj, int wave, int lane) { return ((((ai * 4 + m) * 2 + bj) * 8 + wave) * 64 + lane) * 8; }
__device__ __forceinline__ size_t gq_tile(int g, int pm, int pn) { return (size_t)((g * NTM + pm) * 4 + pn) * 65536; }
__device__ __forceinline__ int gq_piece(int ai, int m, int bj, int wave, int lane) { return ((((ai * 4 + m) * 2 + bj) * 8 + wave) * 64 + lane) * 8; }
__device__ __forceinline__ size_t gq_elem(int g, int row, int col) { const int r = row & 255, c = col & 255;
    return gq_tile(g, row >> 8, col >> 8) + gq_piece(r >> 7, (r >> 4) & 3, c >> 7, ((r >> 6) & 1) * 4 + ((c >> 5) & 3), ((c >> 3) & 3) * 16 + (r & 15)) + (c & 7); }
__device__ __forceinline__ unsigned pk4q(float a, float b, float c, float d) {
    const unsigned lo = __builtin_amdgcn_perm(__builtin_bit_cast(unsigned, b), __builtin_bit_cast(unsigned, a), 0x0c0c0400u), hi = __builtin_amdgcn_perm(__builtin_bit_cast(unsigned, d), __builtin_bit_cast(unsigned, c), 0x0c0c0400u);
    return lo | (hi << 16); }
__device__ __forceinline__ float ub0(unsigned v) { return (float)(v & 0xffu); }
__device__ __forceinline__ float ub1(unsigned v) { return (float)((v >> 8) & 0xffu); }
__device__ __forceinline__ float ub2(unsigned v) { return (float)((v >> 16) & 0xffu); }
__device__ __forceinline__ float ub3(unsigned v) { return (float)(v >> 24); }
__device__ __forceinline__ size_t gate_elem(int g, int row, int col) {
    const int r = row & 255, c = col & 255;
    return gate_tile(g, row >> 8, col >> 8) + gate_piece(r >> 7, (r >> 4) & 3, c >> 7, ((r >> 6) & 1) * 4 + ((c >> 5) & 3), ((c >> 3) & 3) * 16 + (r & 15)) + (c & 7);
}
__device__ __forceinline__ float rs_to_rstd(u64 q) { return __builtin_amdgcn_rsqf((float)q * (1.0f / (16777216.0f * DM)) + EPS); }
struct EpiIn {
    static constexpr bool PERM = true, HOOKS = false; static constexpr int NST = 16;
    __device__ __forceinline__ int cls(const Unit&) const { return 1; }
    bf16* pxa; bf16* pxg; const u64* rs; const float* cin;
    __device__ __forceinline__ void operator()(const f32x4 (&acc)[2][2][4][2], const Unit& u, int wr, int wc, int fr, int fq) const {
        { int l_; asm volatile("v_mbcnt_lo_u32_b32 %0, -1, 0\n\tv_mbcnt_hi_u32_b32 %0, -1, %0" : "=v"(l_)); fr = l_ & 15; fq = l_ >> 4; }
        const bool gate = u.pn >= 11; bf16* base = gate ? pxg : pxa; const int ldc = gate ? NPXG : NPXA; const int colt = (gate ? u.pn - 11 : u.pn) * 256;
        const int grp = u.pm >= 128 ? 4 : (u.pm >> 5);
        const int row0 = u.pm * 256 + wr * 64 + fr, col0 = colt + wc * 32 + 8 * fq;
        const float* cp = cin + grp * NIN + u.pn * 256 + wc * 32 + 8 * fq;
        unsigned char* gbase = (unsigned char*)pxg + (gate ? gq_tile((u.pn - 11) >> 2, u.pm, (u.pn - 11) & 3) : 0);
        const float gsc = gate ? -1.4426950408889634f : 1.0f;
        f32x4 cv[2][2];
#pragma unroll
        for (int bj = 0; bj < 2; ++bj) { cv[bj][0] = *(const f32x4*)(cp + bj * 128) * gsc; cv[bj][1] = *(const f32x4*)(cp + bj * 128 + 4) * gsc; }
        u64 rq[2][4]; float rsv[2][4];
#pragma unroll
        for (int ai = 0; ai < 2; ++ai)
#pragma unroll
            for (int m = 0; m < 4; ++m) rq[ai][m] = rs[row0 + ai * 128 + m * 16];
        asm volatile("" ::: "memory");
#pragma unroll
        for (int ai = 0; ai < 2; ++ai)
#pragma unroll
            for (int m = 0; m < 4; ++m) rsv[ai][m] = rs_to_rstd(rq[ai][m]) * gsc;
#pragma unroll
        for (int ai = 0; ai < 2; ++ai)
#pragma unroll
            for (int m = 0; m < 4; ++m) { const int row = row0 + ai * 128 + m * 16; bf16* rowp = base + (size_t)row * ldc + col0; const float rstd = rsv[ai][m];
#pragma unroll
                for (int bj = 0; bj < 2; ++bj) { f32x4 v0 = acc[ai][bj][m][0] * rstd + cv[bj][0], v1 = acc[ai][bj][m][1] * rstd + cv[bj][1];
                    if (gate) {
#pragma unroll
                        for (int e = 0; e < 4; ++e) { v0[e] = __builtin_amdgcn_exp2f(v0[e]); v1[e] = __builtin_amdgcn_exp2f(v1[e]); }
                        v0 = v0 + 1.0f; v1 = v1 + 1.0f;
#pragma unroll
                        for (int e = 0; e < 4; ++e) { v0[e] = __builtin_amdgcn_fmed3f(__builtin_amdgcn_rcpf(v0[e]), 1.0f / 255.0f, 1.0f); v1[e] = __builtin_amdgcn_fmed3f(__builtin_amdgcn_rcpf(v1[e]), 1.0f / 255.0f, 1.0f); }
                        v0 = v0 * 255.0f + 8388608.0f; v1 = v1 * 255.0f + 8388608.0f;
                        v2u gq; gq.x = pk4q(v0[0], v0[1], v0[2], v0[3]); gq.y = pk4q(v1[0], v1[1], v1[2], v1[3]);
                        __builtin_nontemporal_store(gq, (v2u*)(gbase + gq_piece(ai, m, bj, wr * 4 + wc, fq * 16 + fr)));
                    } else {
                        v4u w; w.x = cvt_pk_bf16(v0[0], v0[1]); w.y = cvt_pk_bf16(v0[2], v0[3]); w.z = cvt_pk_bf16(v1[0], v1[1]); w.w = cvt_pk_bf16(v1[2], v1[3]);
                        *(v4u*)(rowp + bj * 128) = w; } }
            }
    }
};
struct EpiMerge {
    static constexpr bool PERM = true, HOOKS = true; static constexpr int NST = 16;
    __device__ __forceinline__ int cls(const Unit&) const { return 1; }
    bf16* m; const bf16* pxg;
    __device__ __forceinline__ void hook(f32x4 (&acc)[2][2][4][2], const Unit& u, int t, int wr, int wc, int fr, int fq) const {
        asm volatile("" : "+v"(fr), "+v"(fq));
        const int wv = wr * 4 + wc, ln = fq * 16 + fr;
        const unsigned char* gnum = (const unsigned char*)pxg + gq_tile(t == 4 ? 0 : 1, u.pm, u.pn); const unsigned char* gden = (const unsigned char*)pxg + gq_tile(t == 4 ? 1 : 2, u.pm, u.pn);
        v2u gn[2][4][2], gd[2][4][2];
#pragma unroll
        for (int ai = 0; ai < 2; ++ai)
#pragma unroll
            for (int mm = 0; mm < 4; ++mm)
#pragma unroll
                for (int bj = 0; bj < 2; ++bj) { const int ro = gq_piece(ai, mm, bj, wv, ln); gn[ai][mm][bj] = *(const v2u*)(gnum + ro); gd[ai][mm][bj] = *(const v2u*)(gden + ro); }
        asm volatile("" ::: "memory");
#pragma unroll
        for (int ai = 0; ai < 2; ++ai)
#pragma unroll
            for (int mm = 0; mm < 4; ++mm)
#pragma unroll
                for (int bj = 0; bj < 2; ++bj) {
                    const unsigned a0 = gn[ai][mm][bj].x, a1 = gn[ai][mm][bj].y, d0 = gd[ai][mm][bj].x, d1 = gd[ai][mm][bj].y;
                    f32x4& v0 = acc[ai][bj][mm][0]; f32x4& v1 = acc[ai][bj][mm][1];
                    v0[0] *= ub0(a0) * __builtin_amdgcn_rcpf(ub0(d0)); v0[1] *= ub1(a0) * __builtin_amdgcn_rcpf(ub1(d0)); v0[2] *= ub2(a0) * __builtin_amdgcn_rcpf(ub2(d0)); v0[3] *= ub3(a0) * __builtin_amdgcn_rcpf(ub3(d0));
                    v1[0] *= ub0(a1) * __builtin_amdgcn_rcpf(ub0(d1)); v1[1] *= ub1(a1) * __builtin_amdgcn_rcpf(ub1(d1)); v1[2] *= ub2(a1) * __builtin_amdgcn_rcpf(ub2(d1)); v1[3] *= ub3(a1) * __builtin_amdgcn_rcpf(ub3(d1)); }
    }
    __device__ __forceinline__ void operator()(const f32x4 (&acc)[2][2][4][2], const Unit& u, int wr, int wc, int fr, int fq) const {
        asm volatile("" : "+v"(fr), "+v"(fq));
        const int row0 = u.pm * 256 + wr * 64 + fr, col0 = u.pn * 256 + wc * 32 + 8 * fq;
        const unsigned char* ga = (const unsigned char*)pxg + gq_tile(2, u.pm, u.pn);
        constexpr float S = 1.0f / 255.0f;
        v2u g[2][4][2];
#pragma unroll
        for (int ai = 0; ai < 2; ++ai)
#pragma unroll
            for (int mm = 0; mm < 4; ++mm)
#pragma unroll
                for (int bj = 0; bj < 2; ++bj) g[ai][mm][bj] = *(const v2u*)(ga + gq_piece(ai, mm, bj, wr * 4 + wc, fq * 16 + fr));
        asm volatile("" ::: "memory");
#pragma unroll
        for (int ai = 0; ai < 2; ++ai)
#pragma unroll
            for (int mm = 0; mm < 4; ++mm)
#pragma unroll
                for (int bj = 0; bj < 2; ++bj) { const f32x4 v0 = acc[ai][bj][mm][0], v1 = acc[ai][bj][mm][1]; const unsigned q0 = g[ai][mm][bj].x, q1 = g[ai][mm][bj].y;
                    v4u w; w.x = cvt_pk_bf16(v0[0] * (ub0(q0) * S), v0[1] * (ub1(q0) * S)); w.y = cvt_pk_bf16(v0[2] * (ub2(q0) * S), v0[3] * (ub3(q0) * S));
                    w.z = cvt_pk_bf16(v1[0] * (ub0(q1) * S), v1[1] * (ub1(q1) * S)); w.w = cvt_pk_bf16(v1[2] * (ub2(q1) * S), v1[3] * (ub3(q1) * S));
                    *(v4u*)(m + ((size_t)(((u.pm * 16 + ai * 8 + wr * 4 + mm) * (DM / 32) + u.pn * 8 + wc + bj * 4) * 512) + fr * 32 + 8 * fq)) = w; }
    }
};
template <int BF  >
struct EpiRes {
    static constexpr bool PERM = true, HOOKS = false; static constexpr int NST = 16;
    __device__ __forceinline__ int cls(const Unit&) const { return 1; }
    const void* base_l; bf16* out; const float* gate;
    float* part;
    const float* gn; bf16* ap; u64* rs; bool wst; const float* rgn;
    __device__ __forceinline__ void operator()(const f32x4 (&acc)[2][2][4][2], const Unit& u, int wr, int wc, int fr, int fq) const {
        asm volatile("" : "+v"(fr), "+v"(fq));
        const bool isc = u.pm >= 128; const int grp = isc ? 4 : (u.pm >> 5);
        const int row0 = (isc ? (u.pm - 128) : u.pm) * 256 + wr * 64 + fr, col0 = u.pn * 256 + wc * 32 + 8 * fq;
        if (isc) {
            if (part == nullptr) return;
            float* po = part + (size_t)u.br * 1024 * 1024;
#pragma unroll
            for (int ai = 0; ai < 2; ++ai)
#pragma unroll
                for (int m = 0; m < 4; ++m)
#pragma unroll
                    for (int bj = 0; bj < 2; ++bj)
#pragma unroll
                        for (int n = 0; n < 2; ++n) *(f32x4*)(po + (size_t)(row0 + ai * 128 + m * 16) * DM + col0 + bj * 128 + n * 4) = acc[ai][bj][m][n];
            return;
        }
        const size_t stile = (size_t)(u.pm * 4 + u.pn) * 65536;
        f32x4 gv[2][2], gnv[2][2];
#pragma unroll
        for (int bj = 0; bj < 2; ++bj)
#pragma unroll
            for (int n = 0; n < 2; ++n) { gv[bj][n] = *(const f32x4*)(gate + grp * NMOD + col0 + bj * 128 + n * 4); gnv[bj][n] = *(const f32x4*)(gn + grp * DM + col0 + bj * 128 + n * 4); }
#pragma unroll
        for (int ai = 0; ai < 2; ++ai)
#pragma unroll
            for (int mp = 0; mp < 2; ++mp) {
                f32x4 bs[2][2][2];
                if constexpr (BF != 0) {
                    v4u bb[2][2]; f32x4 rg[2][2];
#pragma unroll
                    for (int mq = 0; mq < 2; ++mq)
#pragma unroll
                        for (int bj = 0; bj < 2; ++bj) bb[mq][bj] = (BF == 1) ? *(const v4u*)((const bf16*)base_l + stile + gate_piece(ai, 2 * mp + mq, bj, wr * 4 + wc, fq * 16 + fr))
                                                                  : (BF == 2) ? *(const v4u*)((const bf16*)base_l + ((size_t)(((u.pm * 16 + ai * 8 + wr * 4 + 2 * mp + mq) * (DM / 32) + u.pn * 8 + wc + bj * 4) * 512) + fr * 32 + 8 * fq))
                                                                              : *(const v4u*)((const bf16*)base_l + (size_t)(row0 + ai * 128 + (2 * mp + mq) * 16) * DM + col0 + bj * 128);
                    if constexpr (BF >= 2) {
#pragma unroll
                        for (int bj = 0; bj < 2; ++bj)
#pragma unroll
                            for (int n = 0; n < 2; ++n) rg[bj][n] = *(const f32x4*)(rgn + grp * DM + col0 + bj * 128 + n * 4); }
                    asm volatile("" ::: "memory");
#pragma unroll
                    for (int mq = 0; mq < 2; ++mq)
#pragma unroll
                        for (int bj = 0; bj < 2; ++bj) { const v4u b = bb[mq][bj]; bs[mq][bj][0] = (f32x4){bflo(b.x), bfhi(b.x), bflo(b.y), bfhi(b.y)}; bs[mq][bj][1] = (f32x4){bflo(b.z), bfhi(b.z), bflo(b.w), bfhi(b.w)};
                            if constexpr (BF >= 2) { bs[mq][bj][0] = bs[mq][bj][0] * rg[bj][0]; bs[mq][bj][1] = bs[mq][bj][1] * rg[bj][1]; } }
                } else {
#pragma unroll
                    for (int mq = 0; mq < 2; ++mq)
#pragma unroll
                        for (int bj = 0; bj < 2; ++bj)
#pragma unroll
                            for (int n = 0; n < 2; ++n) bs[mq][bj][n] = *(const f32x4*)((const float*)base_l + (size_t)(row0 + ai * 128 + (2 * mp + mq) * 16) * DM + col0 + bj * 128 + n * 4);
                    asm volatile("" ::: "memory");
                }
#pragma unroll
                for (int mq = 0; mq < 2; ++mq) { const int m = 2 * mp + mq; float ss = 0.f; const size_t ro = (size_t)(row0 + ai * 128 + m * 16) * DM + col0;
#pragma unroll
                    for (int bj = 0; bj < 2; ++bj) {
                        const f32x4 o0 = bs[mq][bj][0] + gv[bj][0] * acc[ai][bj][m][0], o1 = bs[mq][bj][1] + gv[bj][1] * acc[ai][bj][m][1];
                        v4u ow; ow.x = cvt_pk_bf16(o0[0], o0[1]); ow.y = cvt_pk_bf16(o0[2], o0[3]); ow.z = cvt_pk_bf16(o1[0], o1[1]); ow.w = cvt_pk_bf16(o1[2], o1[3]);
                        if (wst) *(v4u*)(out + stile + gate_piece(ai, m, bj, wr * 4 + wc, fq * 16 + fr)) = ow;
                        const f32x4 y0 = o0 * gnv[bj][0], y1 = o1 * gnv[bj][1];
                        v4u w; w.x = cvt_pk_bf16(y0[0], y0[1]); w.y = cvt_pk_bf16(y0[2], y0[3]); w.z = cvt_pk_bf16(y1[0], y1[1]); w.w = cvt_pk_bf16(y1[2], y1[3]);
                        *(v4u*)(ap + ((size_t)(((u.pm * 16 + ai * 8 + wr * 4 + m) * (DM / 32) + u.pn * 8 + wc + bj * 4) * 512) + fr * 32 + 8 * fq)) = w;
                        ss += ((o0[0] * o0[0] + o0[1] * o0[1]) + (o0[2] * o0[2] + o0[3] * o0[3])) + ((o1[0] * o1[0] + o1[1] * o1[1]) + (o1[2] * o1[2] + o1[3] * o1[3])); }
                    ss += __shfl_xor(ss, 16); ss += __shfl_xor(ss, 32);
                    if (fq == 0) __hip_atomic_fetch_add(rs + row0 + ai * 128 + m * 16, (u64)(ss * 16777216.0f + 0.5f), __ATOMIC_RELAXED, __HIP_MEMORY_SCOPE_AGENT); }
            }
    }
};
struct EpiResFinal {
    static constexpr bool PERM = true, HOOKS = false; static constexpr int NST = 32;
    __device__ __forceinline__ int cls(const Unit&) const { return 1; }
    const bf16* xs; const float* rgn; float* xo; const float* gate; const float* fg; u64* rs; unsigned* cnt; unsigned* tmo;
    __device__ __forceinline__ void operator()(f32x4 (&acc)[2][2][4][2], const Unit& u, int wr, int wc, int fr, int fq) const {
        asm volatile("" : "+v"(fr), "+v"(fq));
        const int grp = u.pm >> 5, row0 = u.pm * 256 + wr * 64 + fr, col0 = u.pn * 256 + wc * 32 + 8 * fq;
        f32x4 gv[2][2], rg[2][2];
#pragma unroll
        for (int bj = 0; bj < 2; ++bj)
#pragma unroll
            for (int n = 0; n < 2; ++n) { gv[bj][n] = *(const f32x4*)(gate + grp * NMOD + col0 + bj * 128 + n * 4); rg[bj][n] = *(const f32x4*)(rgn + grp * DM + col0 + bj * 128 + n * 4); }
#pragma unroll
        for (int ai = 0; ai < 2; ++ai)
#pragma unroll
            for (int mp = 0; mp < 2; ++mp) {
                f32x4 bs[2][2][2];
                { v4u bb[2][2];
#pragma unroll
                  for (int mq = 0; mq < 2; ++mq)
#pragma unroll
                      for (int bj = 0; bj < 2; ++bj) bb[mq][bj] = *(const v4u*)(xs + ((size_t)(((u.pm * 16 + ai * 8 + wr * 4 + 2 * mp + mq) * (DM / 32) + u.pn * 8 + wc + bj * 4) * 512) + fr * 32 + 8 * fq));
                  asm volatile("" ::: "memory");
#pragma unroll
                  for (int mq = 0; mq < 2; ++mq)
#pragma unroll
                      for (int bj = 0; bj < 2; ++bj) { const v4u b = bb[mq][bj]; bs[mq][bj][0] = (f32x4){bflo(b.x), bfhi(b.x), bflo(b.y), bfhi(b.y)}; bs[mq][bj][1] = (f32x4){bflo(b.z), bfhi(b.z), bflo(b.w), bfhi(b.w)}; } }
#pragma unroll
                for (int mq = 0; mq < 2; ++mq) { const int m = 2 * mp + mq; float ss = 0.f;
#pragma unroll
                    for (int bj = 0; bj < 2; ++bj)
#pragma unroll
                        for (int n = 0; n < 2; ++n) { const f32x4 o = bs[mq][bj][n] * rg[bj][n] + gv[bj][n] * acc[ai][bj][m][n]; acc[ai][bj][m][n] = o; ss += (o[0] * o[0] + o[1] * o[1]) + (o[2] * o[2] + o[3] * o[3]); }
                    ss += __shfl_xor(ss, 16); ss += __shfl_xor(ss, 32);
                    if (fq == 0) __hip_atomic_fetch_add(rs + row0 + ai * 128 + m * 16, (u64)(ss * 16777216.0f + 0.5f), __ATOMIC_RELAXED, __HIP_MEMORY_SCOPE_AGENT); }
            }
        asm volatile("s_waitcnt vmcnt(0)" ::: "memory");
        unsigned* pc = cnt + 64 * u.pm;
        if (__builtin_amdgcn_mbcnt_hi(~0u, __builtin_amdgcn_mbcnt_lo(~0u, 0u)) == 0) __hip_atomic_fetch_add(pc, 1u, __ATOMIC_RELAXED, __HIP_MEMORY_SCOPE_AGENT);
        { unsigned spins = 0;
          while ((unsigned)__builtin_amdgcn_readfirstlane(__hip_atomic_load(pc, __ATOMIC_RELAXED, __HIP_MEMORY_SCOPE_AGENT)) < 32u) {
              __builtin_amdgcn_s_sleep(2);
              if (++spins > (1u << 22)) { __hip_atomic_store(tmo, 1u, __ATOMIC_RELAXED, __HIP_MEMORY_SCOPE_AGENT); break; } } }
        f32x4 fgv[2][2];
#pragma unroll
        for (int bj = 0; bj < 2; ++bj)
#pragma unroll
            for (int n = 0; n < 2; ++n) fgv[bj][n] = *(const f32x4*)(fg + col0 + bj * 128 + n * 4);
#pragma unroll
        for (int ai = 0; ai < 2; ++ai)
#pragma unroll
            for (int m = 0; m < 4; ++m) { const int row = row0 + ai * 128 + m * 16;
                const float rstd = rs_to_rstd(__hip_atomic_load(rs + row, __ATOMIC_RELAXED, __HIP_MEMORY_SCOPE_AGENT));
#pragma unroll
                for (int bj = 0; bj < 2; ++bj)
#pragma unroll
                    for (int n = 0; n < 2; ++n) *(f32x4*)(xo + (size_t)row * DM + col0 + bj * 128 + n * 4) = acc[ai][bj][m][n] * rstd * fgv[bj][n]; }
    }
};
struct EpiAct {
    static constexpr bool PERM = true, HOOKS = false; static constexpr int NST = 16;
    __device__ __forceinline__ int cls(const Unit&) const { return 1; }
    bf16* a; const u64* rs; const float* cup;
    __device__ __forceinline__ void operator()(const f32x4 (&acc)[2][2][4][2], const Unit& u, int wr, int wc, int fr, int fq) const {
        asm volatile("" : "+v"(fr), "+v"(fq));
        const int grp = u.pm >= 128 ? 4 : (u.pm >> 5);
        const int row0 = u.pm * 256 + wr * 64 + fr, col0 = u.pn * 256 + wc * 32 + 8 * fq;
        const float* cp = cup + grp * FF + col0;
        f32x4 cv[2][2];
#pragma unroll
        for (int bj = 0; bj < 2; ++bj) { cv[bj][0] = *(const f32x4*)(cp + bj * 128); cv[bj][1] = *(const f32x4*)(cp + bj * 128 + 4); }
        u64 rq[2][4]; float rsv[2][4];
#pragma unroll
        for (int ai = 0; ai < 2; ++ai)
#pragma unroll
            for (int m = 0; m < 4; ++m) rq[ai][m] = rs[row0 + ai * 128 + m * 16];
        asm volatile("" ::: "memory");
#pragma unroll
        for (int ai = 0; ai < 2; ++ai)
#pragma unroll
            for (int m = 0; m < 4; ++m) rsv[ai][m] = rs_to_rstd(rq[ai][m]);
#pragma unroll
        for (int ai = 0; ai < 2; ++ai)
#pragma unroll
            for (int m = 0; m < 4; ++m) { const int row = row0 + ai * 128 + m * 16; bf16* rowp = a + (size_t)row * FF + col0; const float rstd = rsv[ai][m];
#pragma unroll
                for (int bj = 0; bj < 2; ++bj) { f32x4 v0 = acc[ai][bj][m][0] * rstd + cv[bj][0], v1 = acc[ai][bj][m][1] * rstd + cv[bj][1];
#pragma unroll
                    for (int e = 0; e < 4; ++e) { const float r0 = fmaxf(v0[e], 0.f), r1 = fmaxf(v1[e], 0.f); v0[e] = r0 * r0; v1[e] = r1 * r1; }
                    v4u w; w.x = cvt_pk_bf16(v0[0], v0[1]); w.y = cvt_pk_bf16(v0[2], v0[3]); w.z = cvt_pk_bf16(v1[0], v1[1]); w.w = cvt_pk_bf16(v1[2], v1[3]);
                    __builtin_nontemporal_store(w, (v4u*)(a + ((size_t)(((u.pm * 16 + ai * 8 + wr * 4 + m) * (FF / 32) + u.pn * 8 + wc + bj * 4) * 512) + fr * 32 + 8 * fq))); } }
    }
};

constexpr int NS = 8;
constexpr int NSTEPS = 2 + 2 * NS;
constexpr int LARGS_OFF = LDSCTL_OFF + 1024;
enum { A_X = 0, A_C, A_CTX, A_CCTX, A_ADAW, A_ADAB, A_N1G, A_N2G, A_WIN, A_CONVW, A_RELB, A_WF, A_WC, A_WA, A_WO, A_W1, A_W2, A_FG, A_OUT, A_WS, A_NARGS };

struct Ctx { LAS unsigned char* lds; int wave, G, bx, gw, NGW, NGT;
    __device__ __forceinline__ int lane() const { int l; asm volatile("v_mbcnt_lo_u32_b32 %0, -1, 0\n\tv_mbcnt_hi_u32_b32 %0, -1, %0" : "=v"(l)); return l; }
    __device__ __forceinline__ int tid() const { return wave * 64 + lane(); }
    __device__ __forceinline__ int gt() const { return bx * NTHR + tid(); }
};
template <int I> __device__ __forceinline__ unsigned long long ldarg_t() {
    unsigned long long v; unsigned tmp;
    asm volatile("v_mov_b32 %1, %2\n\tds_read_b64 %0, %1 offset:%3\n\ts_waitcnt lgkmcnt(0)" : "=&v"(v), "=&v"(tmp) : "i"(LARGS_OFF), "i"(I * 8) : "memory");
    const unsigned lo = __builtin_amdgcn_readfirstlane((unsigned)v), hi = __builtin_amdgcn_readfirstlane((unsigned)(v >> 32));
    return ((unsigned long long)hi << 32) | lo;
}
#define ldarg(C, i) ldarg_t<(i)>()
#define ARGF(i) ((const float*)(const GAS float*)ldarg(C, (i)))
#define WSP(T, off) ((T*)(GAS T*)((GAS unsigned char*)ldarg(C, A_WS) + (off)))

__device__ __forceinline__ void ph_mod_partial(const Ctx& C) {
    const float* cvec = ARGF(A_C); const float* cctx = ARGF(A_CCTX); const float* ada_w = ARGF(A_ADAW);
    float* modp = WSP(float, WS_MODP); float2* tw = WSP(float2, WS_TW);
    LAS float* sl = (LAS float*)C.lds;
    for (int item = C.bx; item < 2 * 8 * 12; item += C.G) {
        const int l = item / 96, rem = item % 96, kc = rem / 12, jb = rem % 12;
        __syncthreads();
        for (int e = C.tid(); e < 5 * 128; e += NTHR) { const int g = e >> 7, k = kc * 128 + (e & 127); const float v = g < 4 ? cvec[g * DM + k] : cctx[k]; sl[e] = v / (1.0f + __expf(-v)); }
        __syncthreads();
        const int tid = C.tid(), jq = tid & 127, kq = tid >> 7;
        const float* wp = ada_w + ((size_t)l * DM + kc * 128 + kq * 32) * NMOD + jb * 512 + 4 * jq;
        f32x4 a[5];
#pragma unroll
        for (int g = 0; g < 5; ++g) a[g] = (f32x4){0.f, 0.f, 0.f, 0.f};
#pragma unroll 16
        for (int k = 0; k < 32; ++k) { const f32x4 wv = *(const f32x4*)(wp + (size_t)k * NMOD);
#pragma unroll
            for (int g = 0; g < 5; ++g) a[g] += sl[g * 128 + kq * 32 + k] * wv; }
        LAS float* red = sl + 1024;
#pragma unroll
        for (int g = 0; g < 5; ++g) { LAS float* rp = red + (kq * 5 + g) * 512 + 4 * jq; rp[0] = a[g][0]; rp[1] = a[g][1]; rp[2] = a[g][2]; rp[3] = a[g][3]; }
        __syncthreads();
        for (int e = tid; e < 5 * 512; e += NTHR) { const int g = e >> 9, c = e & 511;
            modp[((size_t)(l * 8 + kc) * 5 + g) * NMOD + jb * 512 + c] = (red[(0 * 5 + g) * 512 + c] + red[(1 * 5 + g) * 512 + c]) + (red[(2 * 5 + g) * 512 + c] + red[(3 * 5 + g) * 512 + c]); }
    }
    for (int m = C.gt(); m < 8192; m += C.NGT) { float s, c; sincospif((float)m * (1.0f / 4096.0f), &s, &c); tw[m] = make_float2(c, s); }
}
__device__ __forceinline__ void ph_mod_reduce(const Ctx& C) {
    const float* ada_b = ARGF(A_ADAB); const float* modp = WSP(float, WS_MODP); float* mod = WSP(float, WS_MOD);
    for (int e = C.gt(); e < 2 * 5 * NMOD; e += C.NGT) { const int l = e / (5 * NMOD), r = e % (5 * NMOD), j = r % NMOD; float s = ada_b[l * NMOD + j];
#pragma unroll
        for (int kc = 0; kc < 8; ++kc) s += modp[(size_t)(l * 8 + kc) * 5 * NMOD + r];
        mod[e] = s; }
    float* gnt = WSP(float, WS_GN); float* rgt = WSP(float, WS_RGN); const float* n1g = ARGF(A_N1G); const float* n2g = ARGF(A_N2G);
    for (int e = C.gt(); e < 2 * 2 * 5 * DM; e += C.NGT) { const int col = e & 1023, grp = (e >> 10) % 5, w = (e / (5 * DM)) & 1, l = e / (10 * DM), j = (w ? 4 : 1) * DM + col;
        float s = ada_b[l * NMOD + j];
#pragma unroll
        for (int kc = 0; kc < 8; ++kc) s += modp[((size_t)(l * 8 + kc) * 5 + grp) * NMOD + j];
        float g = (w ? n2g : n1g)[l * DM + col] * (1.0f + s);
        if (fabsf(g) < 1e-8f) g = (g < 0.f) ? -1e-8f : 1e-8f;
        gnt[e] = g; rgt[e] = 1.0f / g; }
}
__device__ __forceinline__ void ph_ctab(const Ctx& C, int l, bool rev = false) {
    LAS float* red = (LAS float*)(C.lds + 131072); LAS float* cu = red + 8 * 5 * 64;
    const float* modl = WSP(const float, WS_MOD) + (size_t)l * 5 * NMOD; const float2* tw = WSP(const float2, WS_TW);
    float* cin = WSP(float, WS_CIN) + (size_t)l * 5 * NIN; float* cup = WSP(float, WS_CUP) + (size_t)l * 5 * FF;
    const int lane = C.lane(), w = C.wave, tid = C.tid();
    LAS float* sl = (LAS float*)C.lds;
    for (int it = rev ? C.G - 1 - C.bx : C.bx; it < 88 + 64; it += C.G) {
        const bool isin = it < 88; const int ldw = isin ? NIN_ORIG : FF, col0 = (isin ? it : it - 88) * 64;
        __syncthreads();
        for (int e = tid; e < 5 * 1024; e += NTHR) sl[e] = modl[(e >> 10) * NMOD + (isin ? 0 : 3 * DM) + (e & 1023)];
        __syncthreads();
        const int rq = lane >> 4, c4 = lane & 15;
        const float* W = (isin ? ARGF(A_WIN) + (size_t)l * DM * NIN_ORIG : ARGF(A_W1) + (size_t)l * DM * FF) + (size_t)(128 * w + rq) * ldw + col0 + 4 * c4;
        f32x4 a[5];
#pragma unroll
        for (int g = 0; g < 5; ++g) a[g] = (f32x4){0.f, 0.f, 0.f, 0.f};
#pragma unroll 16
        for (int i = 0; i < 32; ++i) { const f32x4 wv = *(const f32x4*)(W + (size_t)(4 * i) * ldw); const int kr = 128 * w + 4 * i + rq;
#pragma unroll
            for (int g = 0; g < 5; ++g) a[g] += sl[g * 1024 + kr] * wv; }
#pragma unroll
        for (int g = 0; g < 5; ++g)
#pragma unroll
            for (int e = 0; e < 4; ++e) { float v = a[g][e]; v += __shfl_xor(v, 16); v += __shfl_xor(v, 32); a[g][e] = v; }
        if (lane < 16) {
#pragma unroll
            for (int g = 0; g < 5; ++g) { red[(w * 5 + g) * 64 + 4 * c4] = a[g][0]; red[(w * 5 + g) * 64 + 4 * c4 + 1] = a[g][1]; red[(w * 5 + g) * 64 + 4 * c4 + 2] = a[g][2]; red[(w * 5 + g) * 64 + 4 * c4 + 3] = a[g][3]; } }
        __syncthreads();
        if (tid < 320) { const int g = tid >> 6, c = tid & 63; float v = 0.f;
#pragma unroll
            for (int ww = 0; ww < 8; ++ww) v += red[(ww * 5 + g) * 64 + c];
            if (!isin) cup[g * FF + col0 + c] = v; else if (it >= 4) cin[g * NIN + col0 + c + 256] = v; else cu[g * 64 + c] = v; }
        if (isin && it < 4) { __syncthreads();
            if (tid < 320) { const int g = tid >> 6, kc = tid & 63; float p = 0.f, q = 0.f;
                for (int c = 0; c < 64; ++c) { const float2 t = tw[((c * kc) & 63) * 128]; const float v = cu[g * 64 + c]; p += v * t.x; q += v * t.y; }
                cin[g * NIN + it * 64 + kc] = p; cin[g * NIN + 256 + it * 64 + kc] = q; } }
    }
    __syncthreads();
}
template <int MODE> __device__ __forceinline__ void ph_weights(const Ctx& C, int l) {
    constexpr bool DYN = MODE != 0;
    LAS float* scr = (LAS float*)(C.lds + C.wave * 16384);
    const int lane = C.lane();
    const float* Win = ARGF(A_WIN) + (size_t)l * DM * NIN_ORIG;
    bf16* win_t = WSP(bf16, WS_WIN); bf16* wm_t = WSP(bf16, WS_WM);
    constexpr int I_IN = (DM / 64) * ((NIN_ORIG - 256) / 32), I_F = (256 / 64) * (DM / 32), I_A = (512 / 64) * (DM / 32), I_O = (DM / 64) * (DM / 32), I_1 = (DM / 64) * (FF / 32), I_2 = (FF / 64) * (DM / 32);
    constexpr int NALL = MODE == 2 ? I_2 : I_IN + 2 * I_F + I_A + I_O + I_1 + (MODE == 0 ? I_2 : 0) + 4 * 32 * 8;
    unsigned* wq = (unsigned*)WSP(unsigned, WS_CTL) + CW_WQ + (MODE == 2 ? 64 : 0);
    volatile LAS unsigned* tk = (volatile LAS unsigned*)(C.lds + MISC_OFF) + 16;
    for (int it = C.gw;; it += C.NGW) {
        if (DYN) { __syncthreads(); if (C.wave == 0 && lane == 0) tk[0] = __hip_atomic_fetch_add(wq, 8u, __ATOMIC_RELAXED, __HIP_MEMORY_SCOPE_AGENT); __syncthreads();
            const int base = (int)__builtin_amdgcn_readfirstlane(tk[0]); if (base >= NALL) break; it = base + C.wave; if (it >= NALL) continue; }
        else if (it >= NALL) break;
        int r = it;
        if (MODE == 2) { transpose_item(ARGF(A_W2) + (size_t)l * FF * DM, DM, DM, (r & 31) < 24 ? WSP(bf16, WS_W2B_LO) : WSP(bf16, WS_W2B_HI), FF, 0, 0, scr, r, lane); continue; }
        if (r < I_IN) { transpose_item(Win + 256, NIN_ORIG, NIN_ORIG - 256, win_t, DM, 512, 0, scr, r, lane); continue; } r -= I_IN;
        if (r < I_F) { transpose_item(ARGF(A_WF) + (size_t)l * 256 * DM, DM, DM, wm_t, DM, 0, 0, scr, r, lane); continue; } r -= I_F;
        if (r < I_F) { transpose_item(ARGF(A_WC) + (size_t)l * 256 * DM, DM, DM, wm_t, DM, 0, 256, scr, r, lane); continue; } r -= I_F;
        if (r < I_A) { transpose_item(ARGF(A_WA) + (size_t)l * 512 * DM, DM, DM, wm_t, DM, 0, 512, scr, r, lane); continue; } r -= I_A;
        if (r < I_O) { transpose_item(ARGF(A_WO) + (size_t)l * DM * DM, DM, DM, WSP(bf16, WS_WO), DM, 0, 0, scr, r, lane); continue; } r -= I_O;
        if (r < I_1) { transpose_item(ARGF(A_W1) + (size_t)l * DM * FF, FF, FF, WSP(bf16, l == 0 ? WS_W1 : WS_W1B), DM, 0, 0, scr, r, lane); continue; } r -= I_1;
        if (MODE == 0) { if (r < I_2) { transpose_item(ARGF(A_W2) + (size_t)l * FF * DM, DM, DM, WSP(bf16, WS_W2), FF, 0, 0, scr, r, lane); continue; } r -= I_2; }
        const int kq = r & 7, g = r >> 8, k0 = ((r >> 3) & 31) * 32, kl = lane & 31, pq = lane >> 5;
        LAS float* tile = scr;
        LAS float* ct = scr + 32 * 65;
        { float s, c; sincospif((float)lane * (1.0f / 32.0f), &s, &c); ct[lane] = c; ct[64 + lane] = s; }
#pragma unroll 8
        for (int kk = 0; kk < 32; ++kk) tile[kk * 65 + lane] = Win[(size_t)(k0 + kk) * NIN_ORIG + g * 64 + lane];
        LDS_WAIT(); asm volatile("" ::: "memory");
        float p[8];
#pragma unroll
        for (int j = 0; j < 8; ++j) p[j] = 0.f;
#pragma unroll 4
        for (int c = 0; c < 64; ++c) { const float wv = tile[kl * 65 + c];
#pragma unroll
            for (int j = 0; j < 8; ++j) p[j] += wv * ct[pq * 64 + ((c * (kq * 8 + j)) & 63)]; }
#pragma unroll
        for (int j = 0; j < 8; ++j) win_t[(size_t)(pq * 256 + g * 64 + kq * 8 + j) * DM + k0 + kl] = (bf16)f2bf(p[j]);
        LDS_WAIT(); asm volatile("" ::: "memory");
    }
}
__device__ __forceinline__ void ph_prenorm(const Ctx& C, const float* xl, const float* xc, const float* gn, bf16* dst, u64* rs, int row_begin, int row_end, const float* part, const float* pgate, bool mt  ) {
    const int lane = C.lane();
    for (int row = row_begin + C.gw; row < row_end; row += C.NGW) {
        const bool isc = row >= ML; const int grp = isc ? 4 : (row >> 13);
        const float* xr = isc ? xc + (size_t)(row - ML) * DM : xl + (size_t)row * DM;
        f32x4 v[4]; float s2 = 0.f;
#pragma unroll
        for (int j = 0; j < 4; ++j) { v[j] = __builtin_nontemporal_load((const f32x4*)(xr + 4 * lane + 256 * j));
            if (part != nullptr && isc) {
                const size_t po = (size_t)(row - ML) * DM + 4 * lane + 256 * j;
                const f32x4 ps = (*(const f32x4*)(part + po) + *(const f32x4*)(part + po + 1048576)) + (*(const f32x4*)(part + po + 2 * 1048576) + *(const f32x4*)(part + po + 3 * 1048576));
                v[j] = v[j] + *(const f32x4*)(pgate + 4 * lane + 256 * j) * ps; }
            s2 += (v[j].x * v[j].x + v[j].y * v[j].y) + (v[j].z * v[j].z + v[j].w * v[j].w); }
        s2 = wave_sum(s2);
        if (lane == 0) rs[row] = (u64)(s2 * 16777216.0f + 0.5f);
#pragma unroll
        for (int j = 0; j < 4; ++j) { const int c0 = 4 * lane + 256 * j; const f32x4 y = v[j] * *(const f32x4*)(gn + grp * DM + c0);
            v2u o; o.x = pk2(y.x, y.y); o.y = pk2(y.z, y.w);
            *(v2u*)(dst + (mt ? ((size_t)(row >> 4) * (DM / 32) + (c0 >> 5)) * 512 + (row & 15) * 32 + (c0 & 31) : (size_t)row * DM + c0)) = o; }
    }
}
__device__ __forceinline__ void ph_mixers(const Ctx& C, int l) {
    const bf16* pxa = WSP(const bf16, WS_PXA); bf16* mix = WSP(bf16, l == 0 ? WS_MIX1 : WS_HX);
    const float* cw = ARGF(A_CONVW) + l * 3 * 256;
    const int nrows = l == 0 ? MT : ML;
    for (int e = C.gt(); e < nrows * 32; e += C.NGT) {
        const int row = e >> 5, ch = (e & 31) * 8;
        const int pos = row < ML ? (row & (SEQ - 1)) : ((row - ML) & 255), len = row < ML ? SEQ : 256;
        const bf16* pr = pxa + (size_t)row * NPXA;
        const v4u u1 = *(const v4u*)(pr + OFF_CU + ch), c1 = *(const v4u*)(pr + OFF_CC + ch), b1 = *(const v4u*)(pr + OFF_CB + ch);
        v4u u0 = (v4u){0, 0, 0, 0}, c0 = u0, u2 = u0, c2 = u0;
        if (pos > 0) { u0 = *(const v4u*)(pr - NPXA + OFF_CU + ch); c0 = *(const v4u*)(pr - NPXA + OFF_CC + ch); }
        if (pos < len - 1) { u2 = *(const v4u*)(pr + NPXA + OFF_CU + ch); c2 = *(const v4u*)(pr + NPXA + OFF_CC + ch); }
        float o[8]; float w0[8], w1[8], w2[8];
        { const f32x4 t0 = *(const f32x4*)(cw + ch), t1 = *(const f32x4*)(cw + ch + 4), t2 = *(const f32x4*)(cw + 256 + ch), t3 = *(const f32x4*)(cw + 256 + ch + 4), t4 = *(const f32x4*)(cw + 512 + ch), t5 = *(const f32x4*)(cw + 512 + ch + 4);
#pragma unroll
          for (int j = 0; j < 4; ++j) { w0[j] = t0[j]; w0[4 + j] = t1[j]; w1[j] = t2[j]; w1[4 + j] = t3[j]; w2[j] = t4[j]; w2[4 + j] = t5[j]; } }
#pragma unroll
        for (int j = 0; j < 4; ++j) {
            const unsigned a0 = u0[j], d0 = c0[j], a1 = u1[j], d1 = c1[j], a2 = u2[j], d2 = c2[j], bb = b1[j];
            o[2 * j] = bflo(bb) * (w0[2 * j] * bflo(a0) * bflo(d0) + w1[2 * j] * bflo(a1) * bflo(d1) + w2[2 * j] * bflo(a2) * bflo(d2));
            o[2 * j + 1] = bfhi(bb) * (w0[2 * j + 1] * bfhi(a0) * bfhi(d0) + w1[2 * j + 1] * bfhi(a1) * bfhi(d1) + w2[2 * j + 1] * bfhi(a2) * bfhi(d2));
        }
        v4u w; w.x = pk2(o[0], o[1]); w.y = pk2(o[2], o[3]); w.z = pk2(o[4], o[5]); w.w = pk2(o[6], o[7]);
        *(v4u*)(mix + (size_t)row * DM + 256 + ch) = w;
    }
}

typedef short bf16x8_t __attribute__((ext_vector_type(8)));
typedef short v4i16_t __attribute__((ext_vector_type(4)));
constexpr int AT_KW = 0, AT_VW = 73728, AT_BT = 147456;
template <bool WIN>
__device__ __forceinline__ void attn_qk(LAS unsigned char* lds, const int (&ka)[2][2], int rowoff0, const bf16x8_t (&qf)[2], f32x4 (&s)[8][2]) {
    constexpr int RS = WIN ? 8192 : 4096;
#pragma unroll
    for (int j = 0; j < 8; ++j)
#pragma unroll
        for (int t = 0; t < 2; ++t) { s[j][t] = (f32x4){0.f, 0.f, 0.f, 0.f};
#pragma unroll
            for (int ks = 0; ks < 2; ++ks) { const bf16x8_t kf = *(const LAS bf16x8_t*)(lds + ka[t][ks] + rowoff0 + j * RS); s[j][t] = __builtin_amdgcn_mfma_f32_16x16x32_bf16(kf, qf[ks], s[j][t], 0, 0, 0); } }
}
template <bool WIN>
__device__ __forceinline__ void attn_sm_pv(LAS unsigned char* lds, f32x4 (&s)[8][2], const int (&va)[2][4], int rowoff0,
                                           const LAS float* brow  , const int (&dcs)[4]  , unsigned vmask  ,
                                           f32x4 (&o)[4], f32x4& osum, float& m) {
    constexpr float SC = 0.18033688011112042f;
    constexpr int RS = WIN ? 8192 : 4096;
    const v4u onesw = (v4u){0x3F803F80u, 0x3F803F80u, 0x3F803F80u, 0x3F803F80u}; const bf16x8_t ones = __builtin_bit_cast(bf16x8_t, onesw);
    if constexpr (WIN) {
        const bool v0 = vmask & 1u, v1 = vmask & 2u, v2 = vmask & 4u, v3 = vmask & 8u;
        const unsigned hm01 = (v0 ? 0xFFFFu : 0u) | (v1 ? 0xFFFF0000u : 0u), hm23 = (v2 ? 0xFFFFu : 0u) | (v3 ? 0xFFFF0000u : 0u);
        float tmax = -1e30f;
#pragma unroll
        for (int j = 0; j < 8; ++j) {
            f32x4 v;
            v[0] = (v0 ? s[j][0][0] : s[j][1][0]) * SC + brow[j * 31 + dcs[0]]; v[1] = (v1 ? s[j][0][1] : s[j][1][1]) * SC + brow[j * 31 + dcs[1]];
            v[2] = (v2 ? s[j][0][2] : s[j][1][2]) * SC + brow[j * 31 + dcs[2]]; v[3] = (v3 ? s[j][0][3] : s[j][1][3]) * SC + brow[j * 31 + dcs[3]];
            s[j][0] = v; tmax = fmaxf(tmax, fmaxf(fmaxf(v[0], v[1]), fmaxf(v[2], v[3]))); }
        tmax = fmaxf(tmax, __shfl_xor(tmax, 16)); tmax = fmaxf(tmax, __shfl_xor(tmax, 32));
        const float mn = fmaxf(m, tmax), alpha = __builtin_amdgcn_exp2f(m - mn); m = mn;
#pragma unroll
        for (int db = 0; db < 4; ++db) o[db] = o[db] * alpha;
        osum = osum * alpha;
#pragma unroll
        for (int j = 0; j < 8; ++j) {
            const unsigned p01 = pg8::cvt_pk_bf16(__builtin_amdgcn_exp2f(s[j][0][0] - mn), __builtin_amdgcn_exp2f(s[j][0][1] - mn)), p23 = pg8::cvt_pk_bf16(__builtin_amdgcn_exp2f(s[j][0][2] - mn), __builtin_amdgcn_exp2f(s[j][0][3] - mn));
            v4u pw; pw.x = p01 & hm01; pw.y = p23 & hm23; pw.z = p01 & ~hm01; pw.w = p23 & ~hm23;
            const bf16x8_t pf = __builtin_bit_cast(bf16x8_t, pw);
            osum = __builtin_amdgcn_mfma_f32_16x16x32_bf16(ones, pf, osum, 0, 0, 0);
#pragma unroll
            for (int db = 0; db < 4; ++db) {
                const v4i16_t lo = __builtin_amdgcn_ds_read_tr16_b64_v4i16((LAS v4i16_t*)(lds + va[0][db] + rowoff0 + j * RS));
                const v4i16_t hi = __builtin_amdgcn_ds_read_tr16_b64_v4i16((LAS v4i16_t*)(lds + va[1][db] + rowoff0 + j * RS));
                const bf16x8_t vf = (bf16x8_t){lo[0], lo[1], lo[2], lo[3], hi[0], hi[1], hi[2], hi[3]};
                o[db] = __builtin_amdgcn_mfma_f32_16x16x32_bf16(vf, pf, o[db], 0, 0, 0);
            }
        }
    } else {
        float tmax = -1e30f;
#pragma unroll
        for (int j = 0; j < 8; ++j)
#pragma unroll
            for (int t = 0; t < 2; ++t) tmax = fmaxf(tmax, fmaxf(fmaxf(s[j][t][0], s[j][t][1]), fmaxf(s[j][t][2], s[j][t][3])));
        tmax = fmaxf(tmax, __shfl_xor(tmax, 16)); tmax = fmaxf(tmax, __shfl_xor(tmax, 32));
        const float mn = fmaxf(m, tmax * SC), alpha = __builtin_amdgcn_exp2f(m - mn); m = mn;
#pragma unroll
        for (int db = 0; db < 4; ++db) o[db] = o[db] * alpha;
        osum = osum * alpha;
#pragma unroll
        for (int j = 0; j < 8; ++j) {
            v4u pw;
            pw.x = pg8::cvt_pk_bf16(__builtin_amdgcn_exp2f(s[j][0][0] * SC - mn), __builtin_amdgcn_exp2f(s[j][0][1] * SC - mn)); pw.y = pg8::cvt_pk_bf16(__builtin_amdgcn_exp2f(s[j][0][2] * SC - mn), __builtin_amdgcn_exp2f(s[j][0][3] * SC - mn));
            pw.z = pg8::cvt_pk_bf16(__builtin_amdgcn_exp2f(s[j][1][0] * SC - mn), __builtin_amdgcn_exp2f(s[j][1][1] * SC - mn)); pw.w = pg8::cvt_pk_bf16(__builtin_amdgcn_exp2f(s[j][1][2] * SC - mn), __builtin_amdgcn_exp2f(s[j][1][3] * SC - mn));
            const bf16x8_t pf = __builtin_bit_cast(bf16x8_t, pw);
            osum = __builtin_amdgcn_mfma_f32_16x16x32_bf16(ones, pf, osum, 0, 0, 0);
#pragma unroll
            for (int db = 0; db < 4; ++db) {
                const v4i16_t lo = __builtin_amdgcn_ds_read_tr16_b64_v4i16((LAS v4i16_t*)(lds + va[0][db] + rowoff0 + j * RS));
                const v4i16_t hi = __builtin_amdgcn_ds_read_tr16_b64_v4i16((LAS v4i16_t*)(lds + va[1][db] + rowoff0 + j * RS));
                const bf16x8_t vf = (bf16x8_t){lo[0], lo[1], lo[2], lo[3], hi[0], hi[1], hi[2], hi[3]};
                o[db] = __builtin_amdgcn_mfma_f32_16x16x32_bf16(vf, pf, o[db], 0, 0, 0);
            }
        }
    }
}
template <bool WIN>
__device__ __forceinline__ void attn_block(LAS unsigned char* lds, const int (&ka)[2][2], const int (&va)[2][4], int rowoff0, const bf16x8_t (&qf)[2],
                                           const LAS float* brow, const int (&dcs)[4], unsigned vmask, f32x4 (&o)[4], f32x4& osum, float& m) {
    f32x4 s[8][2];
    attn_qk<WIN>(lds, ka, rowoff0, qf, s);
    attn_sm_pv<WIN>(lds, s, va, rowoff0, brow, dcs, vmask, o, osum, m);
}
__device__ __forceinline__ void attn_addr(int kc0off, int li, int fq, int (&ka)[2][2], int (&va)[2][4]) {
#pragma unroll
    for (int t = 0; t < 2; ++t) {
        const int rk = kc0off + 16 * t + li;
#pragma unroll
        for (int ks = 0; ks < 2; ++ks) ka[t][ks] = AT_KW + rk * 128 + (((4 * ks + fq) ^ ((rk >> 1) & 7)) * 16);
        const int rv = kc0off + 16 * t + 4 * fq + (li >> 2), p = li & 3;
#pragma unroll
        for (int db = 0; db < 4; ++db) va[t][db] = AT_VW + rv * 128 + (((2 * db + (p >> 1)) ^ (((rv >> 1) & 3) << 1)) * 16) + (p & 1) * 8;
    }
}

__device__ __forceinline__ void ph_ctx_dft(const Ctx& C) {
    int cit = C.bx;
    if (C.G == 256) { if ((C.bx & 7) != 4) return; cit = C.bx >> 3; } else if (C.bx >= 32) return;
    constexpr int DF_Q = 32768, DF_TW = AT_VW + 65536;
    static_assert(DF_TW + 2048 <= AT_BT, "ctx dft lds");
    const float2* tw = WSP(const float2, WS_TW); const bf16* pxa = WSP(const bf16, WS_PXA); bf16* mix = WSP(bf16, WS_MIX1);
    LAS unsigned char* lds = C.lds; LAS float* twl = (LAS float*)(lds + DF_TW);
    const int lane = C.lane(), w = C.wave, li = lane & 15, fq = lane >> 4, tid = C.tid();
    const int b = cit >> 3, kcb = (cit >> 1) & 3, kh = cit & 1;
    if (tid < 256) { const float2 v = tw[tid * 32]; twl[2 * tid] = v.x; twl[2 * tid + 1] = v.y; }
    for (int p = w; p < 32; p += 8) {
        const int tokl = p * 8 + (lane >> 3), cp = lane & 7;
        const bf16* src = pxa + ((size_t)ML + b * 256 + tokl) * NPXA + kcb * 64 + ((cp ^ (((tokl >> 1) & 3) << 1)) * 8);
        __builtin_amdgcn_global_load_lds((const unsigned*)(src + OFF_P), (LAS unsigned*)(lds + AT_VW + p * 1024), 16, 0, 0);
        __builtin_amdgcn_global_load_lds((const unsigned*)(src + OFF_Q), (LAS unsigned*)(lds + AT_VW + DF_Q + p * 1024), 16, 0, 0);
    }
    int ka[2][2], va[2][4]; attn_addr(0, li, fq, ka, va);
    asm volatile("s_waitcnt vmcnt(0) lgkmcnt(0)" ::: "memory");
    __syncthreads();
    const int k = 128 * kh + 16 * w + li;
    f32x4 o[4];
#pragma unroll
    for (int db = 0; db < 4; ++db) o[db] = (f32x4){0.f, 0.f, 0.f, 0.f};
#pragma unroll 2
    for (int j = 0; j < 8; ++j) {
        float cs[8], sn[8];
#pragma unroll
        for (int t = 0; t < 2; ++t)
#pragma unroll
            for (int i = 0; i < 4; ++i) { const int n = 32 * j + 16 * t + 4 * fq + i, idx = (n * k) & 255; cs[4 * t + i] = twl[2 * idx]; sn[4 * t + i] = -twl[2 * idx + 1]; }
        v4u cw, sw;
        cw.x = pg8::cvt_pk_bf16(cs[0], cs[1]); cw.y = pg8::cvt_pk_bf16(cs[2], cs[3]); cw.z = pg8::cvt_pk_bf16(cs[4], cs[5]); cw.w = pg8::cvt_pk_bf16(cs[6], cs[7]);
        sw.x = pg8::cvt_pk_bf16(sn[0], sn[1]); sw.y = pg8::cvt_pk_bf16(sn[2], sn[3]); sw.z = pg8::cvt_pk_bf16(sn[4], sn[5]); sw.w = pg8::cvt_pk_bf16(sn[6], sn[7]);
        const bf16x8_t cf = __builtin_bit_cast(bf16x8_t, cw), sf = __builtin_bit_cast(bf16x8_t, sw);
#pragma unroll
        for (int db = 0; db < 4; ++db) {
            const v4i16_t plo = __builtin_amdgcn_ds_read_tr16_b64_v4i16((LAS v4i16_t*)(lds + va[0][db] + j * 4096)), phi = __builtin_amdgcn_ds_read_tr16_b64_v4i16((LAS v4i16_t*)(lds + va[1][db] + j * 4096));
            const v4i16_t qlo = __builtin_amdgcn_ds_read_tr16_b64_v4i16((LAS v4i16_t*)(lds + va[0][db] + DF_Q + j * 4096)), qhi = __builtin_amdgcn_ds_read_tr16_b64_v4i16((LAS v4i16_t*)(lds + va[1][db] + DF_Q + j * 4096));
            const bf16x8_t pf = (bf16x8_t){plo[0], plo[1], plo[2], plo[3], phi[0], phi[1], phi[2], phi[3]}, qf = (bf16x8_t){qlo[0], qlo[1], qlo[2], qlo[3], qhi[0], qhi[1], qhi[2], qhi[3]};
            o[db] = __builtin_amdgcn_mfma_f32_16x16x32_bf16(pf, cf, o[db], 0, 0, 0);
            o[db] = __builtin_amdgcn_mfma_f32_16x16x32_bf16(qf, sf, o[db], 0, 0, 0);
        }
    }
    bf16* op = mix + ((size_t)ML + b * 256 + k) * DM + kcb * 64 + 4 * fq;
#pragma unroll
    for (int db = 0; db < 4; ++db) { v2u ov; ov.x = pk2(o[db][0] * (1.0f / 128.0f), o[db][1] * (1.0f / 128.0f)); ov.y = pk2(o[db][2] * (1.0f / 128.0f), o[db][3] * (1.0f / 128.0f)); *(v2u*)(op + 16 * db) = ov; }
}

__device__ __forceinline__ size_t zt_off(int b) { return b < 2 ? WS_TB + (size_t)b * 8 * MiB : (b == 2 ? (size_t)502 * MiB : WS_WIN); }
__device__ __forceinline__ void ph_t1(const Ctx& C) {
    const bf16* pxa = WSP(const bf16, WS_PXA); const int lane = C.lane();
    LAS unsigned short* tile = (LAS unsigned short*)(C.lds + C.wave * 9216);
    auto t1_load = [&](int it, v4u (&v)[8]) {
        const int n2 = (it & 7) | (((it >> 5) & 15) << 3), kcb = (it >> 3) & 3, pq = (it >> 9) & 1, b = it >> 10;
#pragma unroll
        for (int i = 0; i < 8; ++i) { const int q = i * 64 + lane, n1 = q >> 3, cc = q & 7; v[i] = *(const v4u*)(pxa + ((size_t)b * SEQ + n1 * 128 + n2) * NPXA + pq * 256 + kcb * 64 + cc * 8); } };
    constexpr int NIT = 4 * 2 * 128 * 4;
    v4u nx[8];
    if (C.gw < NIT) t1_load(C.gw, nx);
    for (int it = C.gw; it < NIT; it += C.NGW) {
        const int n2 = (it & 7) | (((it >> 5) & 15) << 3), kcb = (it >> 3) & 3, pq = (it >> 9) & 1, b = it >> 10;
        v4u cur[8];
#pragma unroll
        for (int i = 0; i < 8; ++i) cur[i] = nx[i];
        if (it + C.NGW < NIT) t1_load(it + C.NGW, nx);
#pragma unroll
        for (int i = 0; i < 8; ++i) { const int q = i * 64 + lane, n1 = q >> 3, cc = q & 7; *(LAS v4u*)(tile + n1 * 72 + ((cc + i) & 7) * 8) = cur[i]; }
        LDS_WAIT(); asm volatile("" ::: "memory");
        const int c = lane & 7, chl = lane >> 3;
        bf16* zt = WSP(bf16, zt_off(b)) + ((size_t)(pq * 256 + kcb * 64 + chl) * SEQ + n2 * 64 + 8 * c);
#pragma unroll
        for (int i = 0; i < 8; ++i) { v4u o; const LAS unsigned short* tp = tile + (8 * c) * 72 + ((8 * i + chl + 8 * c) & 63);
            o.x = (unsigned)tp[0 * 72] | ((unsigned)tp[1 * 72] << 16); o.y = (unsigned)tp[2 * 72] | ((unsigned)tp[3 * 72] << 16);
            o.z = (unsigned)tp[4 * 72] | ((unsigned)tp[5 * 72] << 16); o.w = (unsigned)tp[6 * 72] | ((unsigned)tp[7 * 72] << 16);
            *(v4u*)(zt + (size_t)(8 * i) * SEQ) = o; }
        LDS_WAIT(); asm volatile("" ::: "memory");
    }
}
typedef float f32x16 __attribute__((ext_vector_type(16)));
constexpr int FT_C64 = 0, FT_S64 = 9216, FT_C128 = 18432, FT_S128 = FT_C128 + 34816, FT_TA = FT_S128 + 34816, FT_TR = FT_TA + 4096, FT_ST = FT_TR + 8192;
static_assert(FT_ST + 32768 <= LDSCTL_OFF, "fft lds");
__device__ __forceinline__ void hw_sincos_rev(float rev, float& sn, float& cs) { sn = __builtin_amdgcn_sinf(rev); cs = __builtin_amdgcn_cosf(rev); }
__device__ __forceinline__ int crow16(int r, int h) { return (r & 3) + 8 * (r >> 2) + 4 * h; }
__device__ __forceinline__ void ph_fft(const Ctx& C, int l) {
    LAS unsigned char* lds = C.lds; const int tid = C.tid(), lane = C.lane(), w = C.wave, h = lane >> 5, c = lane & 31;
    const float2* tw = WSP(const float2, WS_TW); bf16* mix = WSP(bf16, l == 0 ? WS_MIX1 : WS_HX);
    { LAS unsigned short* c64 = (LAS unsigned short*)(lds + FT_C64); LAS unsigned short* s64 = (LAS unsigned short*)(lds + FT_S64);
#pragma unroll 4
      for (int e = tid; e < 4096; e += NTHR) { const int k1 = e >> 6, n1 = e & 63; float sn, cs; hw_sincos_rev(0.5f * ((float)((n1 * k1) & 63) * (1.0f / 32.0f)), sn, cs); c64[k1 * 72 + n1] = (unsigned short)f2bf(cs); s64[k1 * 72 + n1] = (unsigned short)f2bf(sn); }
      LAS unsigned short* c128 = (LAS unsigned short*)(lds + FT_C128); LAS unsigned short* s128 = (LAS unsigned short*)(lds + FT_S128);
#pragma unroll 4
      for (int e = tid; e < 16384; e += NTHR) { const int k2 = e >> 7, p = e & 127, q = p & 15, n2 = (p & ~15) + (q & 3) + ((q >> 2) & 1) * 8 + ((q >> 3) & 1) * 4;
          float sn, cs; hw_sincos_rev(0.5f * ((float)((n2 * k2) & 127) * (1.0f / 64.0f)), sn, cs); c128[k2 * 136 + p] = (unsigned short)f2bf(cs); s128[k2 * 136 + p] = (unsigned short)f2bf(sn); }
      LAS float* ta = (LAS float*)(lds + FT_TA); LAS float* trt = (LAS float*)(lds + FT_TR);
      { const int e = tid, g = e >> 6, kk = e & 63; float sn, cs; hw_sincos_rev(0.5f * ((float)((32 * (g >> 1) + 4 * (g & 1)) * kk) * (1.0f / 4096.0f)), sn, cs); ta[2 * e] = cs; ta[2 * e + 1] = sn; }
      for (int e = tid; e < 1024; e += NTHR) { const int r = e >> 6, kk = e & 63; float sn, cs; hw_sincos_rev(0.5f * ((float)(crow16(r, 0) * kk) * (1.0f / 4096.0f)), sn, cs); trt[2 * e] = cs; trt[2 * e + 1] = sn; }
    }
    __syncthreads();
    const int vcu = (C.G % 8 == 0) ? (C.bx % 8) * (C.G / 8) + C.bx / 8 : C.bx;
    for (int it = vcu; it < 256; it += C.G) {
        const int kb = it & 1, kcg = (it >> 1) & 31, b = it >> 6, kc = kcg * 8 + w, k1 = 32 * kb + c;
        const bf16* zp = WSP(const bf16, zt_off(b)) + (size_t)kc * SEQ; const bf16* zq = zp + (size_t)256 * SEQ;
        f32x16 acc[4];
#pragma unroll
        for (int rb2 = 0; rb2 < 4; ++rb2) acc[rb2] = (f32x16){};
#pragma unroll 1
        for (int rb = 0; rb < 4; ++rb) {
            const int n2 = 32 * rb + c;
            f32x16 xr = {}, xi = {};
#pragma unroll
            for (int ks = 0; ks < 4; ++ks) {
                const bf16x8_t cf = *(const LAS bf16x8_t*)(lds + FT_C64 + (k1 * 72 + 16 * ks + 8 * h) * 2), sf = *(const LAS bf16x8_t*)(lds + FT_S64 + (k1 * 72 + 16 * ks + 8 * h) * 2);
                const bf16x8_t pf = *(const bf16x8_t*)(zp + n2 * 64 + 16 * ks + 8 * h), qf = *(const bf16x8_t*)(zq + n2 * 64 + 16 * ks + 8 * h);
                const v4u t = __builtin_bit_cast(v4u, qf) ^ 0x80008000u; const bf16x8_t qn = __builtin_bit_cast(bf16x8_t, t);
                xr = __builtin_amdgcn_mfma_f32_32x32x16_bf16(pf, cf, xr, 0, 0, 0); xi = __builtin_amdgcn_mfma_f32_32x32x16_bf16(pf, sf, xi, 0, 0, 0);
                xi = __builtin_amdgcn_mfma_f32_32x32x16_bf16(qf, cf, xi, 0, 0, 0); xr = __builtin_amdgcn_mfma_f32_32x32x16_bf16(qn, sf, xr, 0, 0, 0); }
            bf16x8_t bre[2], bim[2];
            const LAS float* tap = (const LAS float*)(lds + FT_TA) + 2 * ((rb * 2 + h) * 64 + k1); const float ac_ = tap[0], as_ = tap[1];
            const LAS float* trp = (const LAS float*)(lds + FT_TR) + 2 * k1;
#pragma unroll
            for (int sblk = 0; sblk < 2; ++sblk) {
                float tr[8], ti[8];
#pragma unroll
                for (int r8 = 0; r8 < 8; ++r8) { const int r = 8 * sblk + r8; const float rc = trp[128 * r], rs = trp[128 * r + 1]; const float tc = ac_ * rc - as_ * rs, ts = ac_ * rs + as_ * rc;
                    tr[r8] = xr[r] * tc - xi[r] * ts; ti[r8] = -(xr[r] * ts + xi[r] * tc); }
                v4u a, bq;
                a.x = pg8::cvt_pk_bf16(tr[0], tr[1]); a.y = pg8::cvt_pk_bf16(tr[2], tr[3]); a.z = pg8::cvt_pk_bf16(tr[4], tr[5]); a.w = pg8::cvt_pk_bf16(tr[6], tr[7]);
                bq.x = pg8::cvt_pk_bf16(ti[0], ti[1]); bq.y = pg8::cvt_pk_bf16(ti[2], ti[3]); bq.z = pg8::cvt_pk_bf16(ti[4], ti[5]); bq.w = pg8::cvt_pk_bf16(ti[6], ti[7]);
                bre[sblk] = __builtin_bit_cast(bf16x8_t, a); bim[sblk] = __builtin_bit_cast(bf16x8_t, bq); }
#pragma unroll
            for (int rb2 = 0; rb2 < 4; ++rb2) {
                const int k2 = 32 * rb2 + c;
#pragma unroll
                for (int sblk = 0; sblk < 2; ++sblk) {
                    const bf16x8_t ac = *(const LAS bf16x8_t*)(lds + FT_C128 + (k2 * 136 + 32 * rb + 16 * sblk + 8 * h) * 2), as = *(const LAS bf16x8_t*)(lds + FT_S128 + (k2 * 136 + 32 * rb + 16 * sblk + 8 * h) * 2);
                    acc[rb2] = __builtin_amdgcn_mfma_f32_32x32x16_bf16(ac, bre[sblk], acc[rb2], 0, 0, 0); acc[rb2] = __builtin_amdgcn_mfma_f32_32x32x16_bf16(as, bim[sblk], acc[rb2], 0, 0, 0); }
            }
        }
#pragma unroll
        for (int rb2 = 0; rb2 < 4; ++rb2) {
            LAS unsigned short* st = (LAS unsigned short*)(lds + FT_ST + (rb2 & 1) * 16384);
#pragma unroll
            for (int r = 0; r < 16; ++r) st[((crow16(r, h) * 32 + c) * 8) + w] = (unsigned short)f2bf(acc[rb2][r] * 0.001381067932f);
            LDS_WAIT(); __builtin_amdgcn_s_barrier(); asm volatile("" ::: "memory");
#pragma unroll
            for (int j = 0; j < 2; ++j) { const int idx = tid + 512 * j, k2l = idx >> 5, k1l = idx & 31;
                const v4u v = *(const LAS v4u*)(st + idx * 8);
                *(v4u*)(mix + ((size_t)b * SEQ + 32 * kb + k1l + 64 * (32 * rb2 + k2l)) * DM + kcg * 8) = v; }
        }
        __syncthreads();
    }
}
__device__ __forceinline__ void attn_stage_win(LAS unsigned char* lds, const bf16* pxa, int b, int h, int R0, int w, int lane, bool isV) {
    for (int p = w; p < 72; p += 8) {
        const int tokl = p * 8 + (lane >> 3), lr = tokl >> 6, col = tokl & 63, gr = min(R0 + lr, 127), cp = lane & 7;
        const bf16* src = pxa + ((size_t)b * SEQ + gr * 64 + col) * NPXA + h * 64;
        if (!isV) __builtin_amdgcn_global_load_lds((const unsigned*)(src + OFF_K + ((cp ^ ((tokl >> 1) & 7)) * 8)), (LAS unsigned*)(lds + AT_KW + p * 1024), 16, 0, 0);
        else __builtin_amdgcn_global_load_lds((const unsigned*)(src + OFF_V + ((cp ^ (((tokl >> 1) & 3) << 1)) * 8)), (LAS unsigned*)(lds + AT_VW + p * 1024), 16, 0, 0);
    }
}
__device__ __forceinline__ void attn_stage_ctx(LAS unsigned char* lds, const bf16* pxa, int b, int h, int w, int lane, bool isV) {
    for (int p = w; p < 32; p += 8) {
        const int tokl = p * 8 + (lane >> 3), cp = lane & 7;
        const bf16* src = pxa + ((size_t)ML + b * 256 + tokl) * NPXA + h * 64;
        if (!isV) __builtin_amdgcn_global_load_lds((const unsigned*)(src + OFF_K + ((cp ^ ((tokl >> 1) & 7)) * 8)), (LAS unsigned*)(lds + AT_KW + p * 1024), 16, 0, 0);
        else __builtin_amdgcn_global_load_lds((const unsigned*)(src + OFF_V + ((cp ^ (((tokl >> 1) & 3) << 1)) * 8)), (LAS unsigned*)(lds + AT_VW + p * 1024), 16, 0, 0);
    }
}
#define AT_BAR() do { asm volatile("s_waitcnt lgkmcnt(0)" ::: "memory"); __builtin_amdgcn_s_barrier(); asm volatile("" ::: "memory"); } while (0)
__device__ __forceinline__ void ph_attn(const Ctx& C, int l) {
    const bf16* pxa = WSP(const bf16, WS_PXA); bf16* mix = WSP(bf16, l == 0 ? WS_MIX1 : WS_HX);
    const float* rb = ARGF(A_RELB) + (size_t)l * 8 * 15 * 31;
    LAS unsigned char* lds = C.lds; LAS float* biasT = (LAS float*)(lds + AT_BT);
    const int lane = C.lane(), w = C.wave, fq = lane >> 4, li = lane & 15, tid = C.tid(), tb = min(tid, 464);
    const int vcu = (C.G % 8 == 0) ? (C.bx % 8) * (C.G / 8) + C.bx / 8 : C.bx;
    __syncthreads();
    int u = vcu;
    if (u < 2048) {
        int b = u >> 9, h = (u >> 6) & 7, rp = u & 63, R0 = min(max(2 * rp - 4, 0), 120);
        attn_stage_win(lds, pxa, b, h, R0, w, lane, false); attn_stage_win(lds, pxa, b, h, R0, w, lane, true);
        bf16x8_t qf[2];
        { const size_t token = (size_t)b * SEQ + (2 * rp + (w >> 2)) * 64 + 16 * (w & 3) + li;
#pragma unroll
          for (int ks = 0; ks < 2; ++ks) qf[ks] = *(const bf16x8_t*)(pxa + token * NPXA + OFF_QQ + h * 64 + 32 * ks + 8 * fq); }
        { const float bv = rb[h * 465 + tb] * 1.4426950408889634f; asm volatile("s_waitcnt vmcnt(0)" ::: "memory"); if (tid < 465) biasT[tid] = bv; }
        AT_BAR();
        for (;;) {
            const int un = u + C.G; const bool has_next = un < 2048;
            const int bn_ = un >> 9, hn = (un >> 6) & 7, rpn = un & 63, R0n = min(max(2 * rpn - 4, 0), 120);
            const int r = 2 * rp + (w >> 2), qc = 16 * (w & 3) + li; const size_t token = (size_t)b * SEQ + r * 64 + qc;
            f32x4 o[4], osum = (f32x4){0.f, 0.f, 0.f, 0.f}; float m = -1e30f;
#pragma unroll
            for (int db = 0; db < 4; ++db) o[db] = (f32x4){0.f, 0.f, 0.f, 0.f};
            int ka[2][2], va[2][4], dcs[4];
            const int cb = w & 3, kc0 = cb == 0 ? 0 : cb == 1 ? 8 : cb == 2 ? 24 : 32;
            attn_addr(kc0, li, fq, ka, va);
            const int csq = min(max(qc - 8, 0), 48); unsigned vmask = 0u;
#pragma unroll
            for (int i = 0; i < 4; ++i) { const int kc_ = kc0 + 4 * fq + i; const bool in0 = kc_ >= csq && kc_ < csq + 16; if (in0) vmask |= 1u << i; dcs[i] = min(max((in0 ? kc_ : kc_ + 16) - qc + 15, 0), 30); }
            const int rsr = min(max(r - 4, 0), 120), lr0 = rsr - R0;
            f32x4 s[8][2];
            attn_qk<true>(lds, ka, lr0 * 8192, qf, s);
            asm volatile("s_waitcnt vmcnt(0)" ::: "memory");
            AT_BAR();
            attn_stage_ctx(lds, pxa, b, h, w, lane, false);
            asm volatile("" ::: "memory");
            bf16x8_t qn[2] = {qf[0], qf[1]}; float bnv = 0.f;
            if (has_next) { const size_t tokn = (size_t)bn_ * SEQ + (2 * rpn + (w >> 2)) * 64 + 16 * (w & 3) + li;
#pragma unroll
                for (int ks = 0; ks < 2; ++ks) qn[ks] = *(const bf16x8_t*)(pxa + tokn * NPXA + OFF_QQ + hn * 64 + 32 * ks + 8 * fq);
                bnv = rb[hn * 465 + tb]; }
            asm volatile("" ::: "memory");
            attn_sm_pv<true>(lds, s, va, lr0 * 8192, biasT + (rsr - r + 7) * 31, dcs, vmask, o, osum, m);
            if (has_next) asm volatile("s_waitcnt vmcnt(3)" ::: "memory"); else asm volatile("s_waitcnt vmcnt(0)" ::: "memory");
            AT_BAR();
            attn_stage_ctx(lds, pxa, b, h, w, lane, true);
            attn_addr(0, li, fq, ka, va);
            attn_qk<false>(lds, ka, 0, qf, s);
            AT_BAR();
            if (has_next) attn_stage_win(lds, pxa, bn_, hn, R0n, w, lane, false);
            asm volatile("" ::: "memory");
            if (has_next) asm volatile("s_waitcnt vmcnt(9)" ::: "memory"); else asm volatile("s_waitcnt vmcnt(0)" ::: "memory");
            AT_BAR();
            attn_sm_pv<false>(lds, s, va, 0, (const LAS float*)nullptr, dcs, 0xfu, o, osum, m);
            asm volatile("s_waitcnt vmcnt(0)" ::: "memory");
            asm volatile("" : "+v"(qn[0]), "+v"(qn[1]), "+v"(bnv));
            if (has_next && tid < 465) biasT[tid] = bnv * 1.4426950408889634f;
            AT_BAR();
            { const float inv = __builtin_amdgcn_rcpf(osum[0]);
              bf16* op = mix + token * DM + 512 + h * 64 + 4 * fq;
#pragma unroll
              for (int db = 0; db < 4; ++db) { v2u ov; ov.x = pk2(o[db][0] * inv, o[db][1] * inv); ov.y = pk2(o[db][2] * inv, o[db][3] * inv); *(v2u*)(op + 16 * db) = ov; } }
            if (!has_next) break;
            attn_stage_win(lds, pxa, bn_, hn, R0n, w, lane, true);
            u = un; b = bn_; h = hn; rp = rpn; R0 = R0n; qf[0] = qn[0]; qf[1] = qn[1];
        }
    }
    if (l == 0 && vcu < 64) {
        const int v = vcu, b = v >> 4, h = (v >> 1) & 7, rp = v & 1;
        asm volatile("s_waitcnt vmcnt(0)" ::: "memory");
        __syncthreads();
        attn_stage_ctx(lds, pxa, b, h, w, lane, false); attn_stage_ctx(lds, pxa, b, h, w, lane, true);
        const size_t token = (size_t)ML + b * 256 + rp * 128 + 16 * w + li;
        bf16x8_t qf[2];
#pragma unroll
        for (int ks = 0; ks < 2; ++ks) qf[ks] = *(const bf16x8_t*)(pxa + token * NPXA + OFF_QQ + h * 64 + 32 * ks + 8 * fq);
        f32x4 o[4], osum = (f32x4){0.f, 0.f, 0.f, 0.f}; float m = -1e30f;
#pragma unroll
        for (int db = 0; db < 4; ++db) o[db] = (f32x4){0.f, 0.f, 0.f, 0.f};
        int ka[2][2], va[2][4], dcs[4] = {0, 0, 0, 0};
        attn_addr(0, li, fq, ka, va);
        asm volatile("s_waitcnt vmcnt(0)" ::: "memory");
        __syncthreads();
        attn_block<false>(lds, ka, va, 0, qf, (const LAS float*)nullptr, dcs, 0xfu, o, osum, m);
        const float inv = __builtin_amdgcn_rcpf(osum[0]);
        bf16* op = mix + token * DM + 512 + h * 64 + 4 * fq;
#pragma unroll
        for (int db = 0; db < 4; ++db) { v2u ov; ov.x = pk2(o[db][0] * inv, o[db][1] * inv); ov.y = pk2(o[db][2] * inv, o[db][3] * inv); *(v2u*)(op + 16 * db) = ov; }
    }
}

template <int KS>
__device__ __forceinline__ void wg_core(const bf16* A, const bf16* W, int li, int fq, f32x4 (&acc)[4][2]) {
    const bf16* ap = A + (size_t)li * DM + 8 * fq; const bf16* wp = W + (size_t)li * DM + 8 * fq;
    bf16x8_t af[4][4], wf[4][2];
#pragma unroll
    for (int s = 0; s < 3; ++s) {
#pragma unroll
        for (int m = 0; m < 4; ++m) af[s][m] = *(const bf16x8_t*)(ap + (size_t)(16 * m) * DM + 32 * s);
#pragma unroll
        for (int n = 0; n < 2; ++n) wf[s][n] = *(const bf16x8_t*)(wp + (size_t)(16 * n) * DM + 32 * s); }
#pragma unroll
    for (int s = 0; s < KS; ++s) {
        if (s + 3 < KS) {
#pragma unroll
            for (int m = 0; m < 4; ++m) af[(s + 3) & 3][m] = *(const bf16x8_t*)(ap + (size_t)(16 * m) * DM + 32 * (s + 3));
#pragma unroll
            for (int n = 0; n < 2; ++n) wf[(s + 3) & 3][n] = *(const bf16x8_t*)(wp + (size_t)(16 * n) * DM + 32 * (s + 3)); }
#pragma unroll
        for (int m = 0; m < 4; ++m)
#pragma unroll
            for (int n = 0; n < 2; ++n) acc[m][n] = __builtin_amdgcn_mfma_f32_16x16x32_bf16(wf[s & 3][n], af[s & 3][m], acc[m][n], 0, 0, 0);
    }
}
__device__ __forceinline__ void wg_merge_ctx(const Ctx& C) {
    const bf16* mix = WSP(const bf16, WS_MIX1); const bf16* wm = WSP(const bf16, WS_WM); const unsigned char* pq = WSP(const unsigned char, WS_PXG); bf16* mb = WSP(bf16, WS_M);
    const int lane = C.lane(), li = lane & 15, fq = lane >> 4, q = C.wave & 3, tg = C.wave >> 2;
    LAS f32x4* red = (LAS f32x4*)(C.lds + (tg * 3 + (q > 0 ? q - 1 : 0)) * 8192) + lane;
    for (int base = C.bx; base < 512; base += 2 * C.G) {
        const int it = base + tg * C.G; const bool valid = it < 512;
        const int r0 = ML + 64 * ((valid ? it : 0) >> 5), c0 = 32 * ((valid ? it : 0) & 31);
        f32x4 acc[4][2];
#pragma unroll
        for (int m = 0; m < 4; ++m)
#pragma unroll
            for (int n = 0; n < 2; ++n) acc[m][n] = (f32x4){0.f, 0.f, 0.f, 0.f};
        if (valid) wg_core<8>(mix + (size_t)r0 * DM + 256 * q, wm + (size_t)c0 * DM + 256 * q, li, fq, acc);
        const int g = q < 2 ? q : 2;
#pragma unroll
        for (int m = 0; m < 4; ++m)
#pragma unroll
            for (int n = 0; n < 2; ++n) { const int row = r0 + 16 * m + li, col = c0 + 16 * n + 4 * fq; const unsigned gg = valid ? *(const unsigned*)(pq + gq_elem(g, row, col)) : 0u;
                constexpr float S = 1.0f / 255.0f;
                acc[m][n][0] *= ub0(gg) * S; acc[m][n][1] *= ub1(gg) * S; acc[m][n][2] *= ub2(gg) * S; acc[m][n][3] *= ub3(gg) * S;
                if (q > 0) red[(m * 2 + n) * 64] = acc[m][n]; }
        __syncthreads();
        if (q == 0 && valid) {
#pragma unroll
            for (int m = 0; m < 4; ++m)
#pragma unroll
                for (int n = 0; n < 2; ++n) { const size_t row = (size_t)(r0 + 16 * m + li); const int col = c0 + 16 * n + 4 * fq;
                    const f32x4 o = (acc[m][n] + red[(m * 2 + n) * 64]) + (red[2048 / 4 * 1 + (m * 2 + n) * 64] + red[2048 / 4 * 2 + (m * 2 + n) * 64]);
                    v2u w; w.x = cvt_pk_bf16(o[0], o[1]); w.y = cvt_pk_bf16(o[2], o[3]); *(v2u*)(mb + row * DM + col) = w; }
        }
        __syncthreads();
    }
}
__device__ __forceinline__ void wg_wo_ctx(const Ctx& C) {
    const bf16* mb = WSP(const bf16, WS_M); const bf16* wo = WSP(const bf16, WS_WO); const float* base = ARGF(A_CTX); float* out = WSP(float, WS_CTXX);
    const float* gate = WSP(const float, WS_MOD) + 4 * NMOD + 2 * DM; const float* gn = WSP(const float, WS_GN) + (size_t)(1 * 5 + 4) * DM; bf16* ap = WSP(bf16, WS_MIX1); u64* rs = WSP(u64, WS_RS) + (size_t)1 * MT;
    const int lane = C.lane(), li = lane & 15, fq = lane >> 4, q = C.wave & 3, tg = C.wave >> 2;
    LAS f32x4* red = (LAS f32x4*)(C.lds + (tg * 3 + (q > 0 ? q - 1 : 0)) * 8192) + lane;
    for (int base_it = C.bx; base_it < 512; base_it += 2 * C.G) {
        const int it = base_it + tg * C.G; const bool valid = it < 512;
        const int r0 = 64 * ((valid ? it : 0) >> 5), c0 = 32 * ((valid ? it : 0) & 31);
        f32x4 acc[4][2];
#pragma unroll
        for (int m = 0; m < 4; ++m)
#pragma unroll
            for (int n = 0; n < 2; ++n) acc[m][n] = (f32x4){0.f, 0.f, 0.f, 0.f};
        if (valid) wg_core<8>(mb + (size_t)(ML + r0) * DM + 256 * q, wo + (size_t)c0 * DM + 256 * q, li, fq, acc);
        if (q > 0) {
#pragma unroll
            for (int m = 0; m < 4; ++m)
#pragma unroll
                for (int n = 0; n < 2; ++n) red[(m * 2 + n) * 64] = acc[m][n]; }
        __syncthreads();
        if (q == 0 && valid) {
#pragma unroll
            for (int m = 0; m < 4; ++m) { const size_t rc = (size_t)(r0 + 16 * m + li); float ss = 0.f;
#pragma unroll
                for (int n = 0; n < 2; ++n) { const int col = c0 + 16 * n + 4 * fq;
                    const f32x4 a = (acc[m][n] + red[(m * 2 + n) * 64]) + (red[512 + (m * 2 + n) * 64] + red[1024 + (m * 2 + n) * 64]);
                    const f32x4 o = *(const f32x4*)(base + rc * DM + col) + *(const f32x4*)(gate + col) * a;
                    *(f32x4*)(out + rc * DM + col) = o;
                    const f32x4 y = o * *(const f32x4*)(gn + col); v2u w; w.x = cvt_pk_bf16(y[0], y[1]); w.y = cvt_pk_bf16(y[2], y[3]); { const size_t R = ML + rc; *(v2u*)(ap + ((R >> 4) * (DM / 32) + (col >> 5)) * 512 + (R & 15) * 32 + (col & 31)) = w; }
                    ss += (o[0] * o[0] + o[1] * o[1]) + (o[2] * o[2] + o[3] * o[3]); }
                ss += __shfl_xor(ss, 16); ss += __shfl_xor(ss, 32);
                if (fq == 0) __hip_atomic_fetch_add(rs + ML + rc, (u64)(ss * 16777216.0f + 0.5f), __ATOMIC_RELAXED, __HIP_MEMORY_SCOPE_AGENT); }
        }
        __syncthreads();
    }
}
__device__ __forceinline__ void ph_final(const Ctx& C) {
    float* out = (float*)(GAS float*)ldarg(C, A_OUT); const float* fg = ARGF(A_FG); const int lane = C.lane();
    for (int row = C.gw; row < ML; row += C.NGW) {
        float* xr = out + (size_t)row * DM;
        f32x4 v[4]; float s2 = 0.f;
#pragma unroll
        for (int j = 0; j < 4; ++j) { v[j] = *(const f32x4*)(xr + 4 * lane + 256 * j); s2 += (v[j].x * v[j].x + v[j].y * v[j].y) + (v[j].z * v[j].z + v[j].w * v[j].w); }
        const float rstd = 1.0f / sqrtf(wave_sum(s2) * (1.0f / DM) + EPS);
#pragma unroll
        for (int j = 0; j < 4; ++j) { const int c0 = 4 * lane + 256 * j; const f32x4 gg = *(const f32x4*)(fg + c0); *(f32x4*)(xr + c0) = v[j] * rstd * gg; }
    }
}

struct Args { const void* p[A_NARGS]; int ph_lo, ph_hi; };

__global__ void __launch_bounds__(NTHR, 2) fwd_kernel(Args args) {
    extern __shared__ __attribute__((aligned(16))) unsigned char lds_raw[];
    LAS unsigned char* const lds0 = (LAS unsigned char*)lds_raw;
    const int wave0 = __builtin_amdgcn_readfirstlane(threadIdx.x >> 6);
    { const int t0 = threadIdx.x;
      for (int u = t0; u < (LDS_BYTES - LDSCTL_OFF) / 4; u += NTHR) ((LAS unsigned*)(lds0 + LDSCTL_OFF))[u] = 0u;
      __syncthreads();
      if (t0 < A_NARGS) ((LAS unsigned long long*)(lds0 + LARGS_OFF))[t0] = (unsigned long long)args.p[t0];
      __syncthreads(); }
    const int lo = args.ph_lo, hi = args.ph_hi;
    const unsigned xcc = xb_xcc_id();
    int vbx = blockIdx.x;
    if (!MK_MULTI) { Ctx C; C.lds = lds0; C.wave = wave0; gu32* ctl0 = (gu32*)WSP(unsigned, WS_CTL); (void)xcd_barrier_post((unsigned*)(ctl0 + CW_BAR), (volatile LAS unsigned*)(lds0 + MISC_OFF) + 8, C.tid() == 0); }
    for (int step = lo; step < hi; ++step) {
        const int ls = step - 2, l = ls >= NS ? 1 : 0, k = (step < 2) ? -1 - step : ls - l * NS;
        const int nrep = (PROBE_K != -99 && k == PROBE_K) ? PROBE_N : 1;
        for (int rep = 0; rep < nrep; ++rep) {
        Ctx C;
        C.lds = lds0; C.wave = wave0; C.G = gridDim.x; C.bx = vbx;
        asm volatile("" : "+s"(C.wave), "+s"(C.bx), "+s"(C.G));
        C.gw = C.bx * NWAVES + C.wave; C.NGW = C.G * NWAVES; C.NGT = C.G * NTHR;
        gu32* ctl = (gu32*)WSP(unsigned, WS_CTL);
        if (k == -1) { ph_mod_partial(C); __syncthreads(); ph_weights<0>(C, 0); }
        else if (k == -2) ph_mod_reduce(C);
        else if (k == 0) {
            if (l == 0) ph_ctab(C, l);
            u64* rsb = WSP(u64, WS_RS) + (size_t)(l == 0 ? 0 : 2) * MT;
            if (l == 0) ph_prenorm(C, ARGF(A_X), ARGF(A_CTX), WSP(const float, WS_GN), WSP(bf16, WS_HX), rsb, 0, MT, (const float*)nullptr, (const float*)nullptr, false);
            else ph_prenorm(C, ARGF(A_OUT), WSP(const float, WS_CTXX), WSP(const float, WS_GN) + 2 * 5 * DM, WSP(bf16, WS_MIX1), rsb, ML, MT, WSP(const float, WS_PART), WSP(const float, WS_MOD) + 4 * NMOD + 5 * DM, true);
        } else if (k == 1) {
            pg8::StaticOrder<NIN / 256> S; S.init(MT, NIN, C.G, C.bx);
            EpiIn E{WSP(bf16, WS_PXA), WSP(bf16, WS_PXG), WSP(const u64, WS_RS) + (size_t)(l == 0 ? 0 : 2) * MT, WSP(const float, WS_CIN) + (size_t)l * 5 * NIN};
            if (l == 0) { pg8::Prob<false> P{WSP(const bf16, WS_HX), WSP(const bf16, WS_WIN), DM, DM, DM}; pg8::gemm_phase(C.lds, P, S, E, C.tid()); }
            else { pg8::ProbMT P{WSP(const bf16, WS_MIX1), WSP(const bf16, WS_WIN), DM, DM, DM}; pg8::gemm_phase(C.lds, P, S, E, C.tid()); }
        } else if (k == 2) {
            const int sub = rep == 0 ? 7 : PROBE_SUB;
            if (sub & 4) ph_attn(C, l);
            if (sub & 2) { __syncthreads(); if (l == 0) ph_ctx_dft(C); ph_mixers(C, l); }
            if (sub & 1) { __syncthreads(); ph_t1(C); }
        } else if (k == 3) {
            ph_fft(C, l);
        } else if (k == 4) {
            pg8::Prob<false> P{WSP(const bf16, l == 0 ? WS_MIX1 : WS_HX), WSP(const bf16, WS_WM), DM, DM, DM}; pg8::StaticOrder<DM / 256> S; S.init(ML, DM, C.G, C.bx);
            EpiMerge E{WSP(bf16, WS_M), WSP(const bf16, WS_PXG)};
            pg8::gemm_phase(C.lds, P, S, E, C.tid());
            if (l == 0) wg_merge_ctx(C);
        } else if (k == 5) {
            pg8::ProbMT P{WSP(const bf16, WS_M), WSP(const bf16, WS_WO), DM, DM, DM}; pg8::StaticOrder<DM / 256> S; S.init(ML, DM, C.G, C.bx);
            const float* gatev = rep > 0 ? WSP(const float, WS_ZERO) : WSP(const float, WS_MOD) + (size_t)l * 5 * NMOD + 2 * DM;
            const float* gnp = WSP(const float, WS_GN) + (size_t)(l * 2 + 1) * 5 * DM; u64* rsp = WSP(u64, WS_RS) + (size_t)(l == 0 ? 1 : 3) * MT;
            if (l == 0) { EpiRes<3> E{(const void*)WSP(const bf16, WS_HX), (bf16*)nullptr, gatev, nullptr, gnp, WSP(bf16, WS_MIX1), rsp, false, WSP(const float, WS_RGN)}; pg8::gemm_phase(C.lds, P, S, E, C.tid()); }
            else { EpiRes<2> E{(const void*)WSP(const bf16, WS_MIX1), (bf16*)nullptr, gatev, nullptr, gnp, WSP(bf16, WS_MIX1), rsp, false, WSP(const float, WS_RGN) + (size_t)(1 * 2 + 0) * 5 * DM}; pg8::gemm_phase(C.lds, P, S, E, C.tid()); }
            if (l == 0 && rep == 0) wg_wo_ctx(C);
        } else if (k == 6) {
            pg8::ProbMT P{WSP(const bf16, WS_MIX1), WSP(const bf16, l == 0 ? WS_W1 : WS_W1B), DM, DM, DM}; pg8::StaticOrder<FF / 256> S; S.init(l == 0 ? MT : ML, FF, C.G, C.bx);
            EpiAct E{WSP(bf16, WS_ACT), WSP(const u64, WS_RS) + (size_t)(l == 0 ? 1 : 3) * MT, WSP(const float, WS_CUP) + (size_t)l * 5 * FF};
            pg8::gemm_phase(C.lds, P, S, E, C.tid());
            if (l == 0 && rep == 0) { ph_weights<1>(C, 1); ph_ctab(C, 1, true); }
        } else if (k == 7) {
            if (l == 0) {
                pg8::ProbDown P{WSP(const bf16, WS_ACT), WSP(const bf16, WS_W2), FF, FF, FF}; pg8::DownOrder S; S.init(C.G, C.bx);
                EpiRes<2> E{(const void*)WSP(const bf16, WS_MIX1), (bf16*)nullptr, WSP(const float, WS_MOD) + (size_t)l * 5 * NMOD + 5 * DM, WSP(float, WS_PART),
                         WSP(const float, WS_GN) + (size_t)2 * 5 * DM, WSP(bf16, WS_MIX1), WSP(u64, WS_RS) + (size_t)2 * MT, false, WSP(const float, WS_RGN) + (size_t)1 * 5 * DM};
                pg8::gemm_phase(C.lds, P, S, E, C.tid());
                if (rep == 0) ph_weights<2>(C, 1);
            } else {
                pg8::ProbMTSplit P{WSP(const bf16, WS_ACT), WSP(const bf16, WS_W2B_LO), WSP(const bf16, WS_W2B_HI), FF, FF, FF}; pg8::StaticOrder<DM / 256> S; S.init(ML, DM, C.G, C.bx);
                EpiResFinal E{WSP(const bf16, WS_MIX1), WSP(const float, WS_RGN) + (size_t)(1 * 2 + 1) * 5 * DM, (float*)(GAS float*)ldarg(C, A_OUT), WSP(const float, WS_MOD) + (size_t)l * 5 * NMOD + 5 * DM, ARGF(A_FG), WSP(u64, WS_RS5), WSP(unsigned, WS_FCNT), (unsigned*)WSP(unsigned, WS_CTL) + CW_TMO};
                pg8::gemm_phase(C.lds, P, S, E, C.tid());
            }
        } else ph_final(C);
        if (step + 1 < hi || rep + 1 < nrep) { if (MK_MULTI) { if (C.tid() == 0) __hip_atomic_store(ctl + CW_TMO, 0xBADu, RLX_AGENT); } else { XcdBarrier bar; bar.bar = (unsigned*)(ctl + CW_BAR); bar.x = xcc; bar.st = (volatile LAS unsigned*)(lds0 + MISC_OFF) + 8; xcd_barrier(bar, C.tid() == 0);
                if (step == lo && rep == 0) {
                    volatile LAS unsigned* misc = (volatile LAS unsigned*)(lds0 + MISC_OFF);
                    if (C.tid() == 0) { bool ok = gridDim.x == 256;
                        for (unsigned j = 0; j < 16; ++j) { const unsigned cnt = xb_ld(bar.bar + XB_XCNT(j)); ok = ok && (cnt == (j < 8 ? 32u : 0u)); }
                        misc[11] = ok ? 1u : 0u; }
                    __syncthreads();
                    const unsigned okf = __builtin_amdgcn_readfirstlane(misc[11]), rk = __builtin_amdgcn_readfirstlane(misc[10]);
                    if (okf != 0u && rk < 32u && xcc < 8u) vbx = (int)(rk * 8u + xcc); } } }
        }
    }
}

extern "C" void kernel_launch(void* const* d_in, const int* in_sizes, int n_in, void* d_out, int out_size, void* d_ws, size_t ws_size, hipStream_t stream) {
    static int grid = 0;
    if (grid == 0) {
        if (n_in != 18 || out_size != ML * DM || ws_size < WS_END) { fprintf(stderr, "kernel_launch: unexpected shapes (n_in %d out %d ws %zu)\n", n_in, out_size, ws_size); grid = -1; return; }
        int dev = 0, cus = 0;
        if (hipGetDevice(&dev) != hipSuccess || hipDeviceGetAttribute(&cus, hipDeviceAttributeMultiprocessorCount, dev) != hipSuccess) { grid = -1; return; }
        if (hipFuncSetAttribute((const void*)fwd_kernel, hipFuncAttributeMaxDynamicSharedMemorySize, LDS_BYTES) != hipSuccess) { fprintf(stderr, "kernel_launch: hipFuncSetAttribute failed\n"); grid = -1; return; }
        int per_cu = 0;
        if (hipOccupancyMaxActiveBlocksPerMultiprocessor(&per_cu, (const void*)fwd_kernel, NTHR, LDS_BYTES) != hipSuccess || per_cu < 1) fprintf(stderr, "kernel_launch: occupancy query reports %d\n", per_cu);
        (void)hipGetLastError();
        grid = cus;
    }
    if (grid < 0) return;
    (void)hipMemsetAsync((char*)d_ws + WS_CTL, 0, CTL_ZERO_BYTES, stream);
    Args a{};
    for (int i = 0; i < 18; ++i) a.p[i] = d_in[i];
    a.p[A_OUT] = d_out; a.p[A_WS] = d_ws;
#if MK_MULTI
    for (int s = 0; s < NSTEPS; ++s) { a.ph_lo = s; a.ph_hi = s + 1; hipLaunchKernelGGL(fwd_kernel, dim3(grid), dim3(NTHR), LDS_BYTES, stream, a); }
#else
    a.ph_lo = 0; a.ph_hi = NSTEPS; hipLaunchKernelGGL(fwd_kernel, dim3(grid), dim3(NTHR), LDS_BYTES, stream, a);
#endif
}
```
